# Optimizing an MI355X kernel written in HIP

```python
import jax, jax.numpy as jnp
from jax import lax
import numpy as np

D_MODEL = 1024
BATCH = 8
SEQ = 2048
DEPTH = 1
DEC_BATCH = 128
DEC_SEQ = 1
PAST_LEN = 16384
PAGE_SIZE = 128

RET_HEADS = 4
RET_DK = 256
RET_DV = 512
RET_QK = RET_HEADS * RET_DK
RET_V = RET_HEADS * RET_DV
RET_CHUNK = 128
ROPE_BASE = 10000.0
RW_HEAD = 64
RW_HEADS = D_MODEL // RW_HEAD
RW_C = RW_HEADS * RW_HEAD
RW_DECAY_LORA = 64
RW_AAA_LORA = 64
RW_GN_EPS = 1e-5 * RW_HEAD
N_SHIFT = 3 * RW_C + RW_DECAY_LORA + RW_AAA_LORA
N_COLS = 2 * RET_QK + 2 * RET_V + N_SHIFT + RW_C + 2 * D_MODEL
PLE_DIM = 256
NORM_EPS = 1e-6

kernel_name = 'retention_rwkv7_gated_hybrid_step'


def _rmsnorm(x, g):
    xf = x.astype(jnp.float32)
    y = xf * lax.rsqrt(jnp.mean(xf * xf, axis=-1, keepdims=True) + NORM_EPS)
    return (y * g.astype(jnp.float32)).astype(x.dtype)


def _rope(x, pos):
    half = x.shape[-1] // 2
    inv = ROPE_BASE ** (-jnp.arange(half, dtype=jnp.float32) / half)
    ang = pos[:, None] * inv[None, :]
    cos = jnp.cos(ang)[None, :, None, :]
    sin = jnp.sin(ang)[None, :, None, :]
    x1, x2 = x[..., :half], x[..., half:]
    return jnp.concatenate([x1 * cos - x2 * sin, x2 * cos + x1 * sin], axis=-1)


def _retention(q, k, v, s0, log_g):
    B, H, T, _ = q.shape
    C = RET_CHUNK if T % RET_CHUNK == 0 else T
    NC = T // C
    idx = jnp.arange(C, dtype=jnp.float32)
    rel = idx[:, None] - idx[None, :]
    lg = log_g[:, None, None]
    dmask = jnp.where(rel[None] >= 0, jnp.exp(jnp.maximum(rel, 0.0)[None] * lg), 0.0)
    q_dec = jnp.exp((idx + 1.0)[None, :] * log_g[:, None])[:, :, None]
    k_dec = jnp.exp((C - 1.0 - idx)[None, :] * log_g[:, None])[:, :, None]
    chunk_dec = jnp.exp(C * log_g)[:, None, None]

    def chunk(s, qkv):
        qc, kc, vc = qkv
        inner = jnp.einsum('bhid,bhjd->bhij', qc, kc) * dmask
        o = jnp.einsum('bhij,bhjv->bhiv', inner, vc) + jnp.einsum('bhid,bhdv->bhiv', qc * q_dec, s)
        s = chunk_dec * s + jnp.einsum('bhjd,bhjv->bhdv', kc * k_dec, vc)
        return s, o

    split = lambda t: jnp.moveaxis(t.reshape(B, H, NC, C, t.shape[-1]), 2, 0)
    s, o = lax.scan(chunk, s0, (split(q), split(k), split(v)))
    o = jnp.moveaxis(o, 0, 2).reshape(B, H, T, v.shape[-1])
    return o, s


def _retention_branch(q, k, v, g_a, pos0, s0):
    f32 = jnp.float32
    B, T = q.shape[:2]
    pos = pos0 + jnp.arange(T, dtype=f32)
    q = _rope(q.reshape(B, T, RET_HEADS, RET_DK).astype(f32), pos)
    k = _rope(k.reshape(B, T, RET_HEADS, RET_DK).astype(f32), pos) * (RET_DK ** -0.5)
    v = v.reshape(B, T, RET_HEADS, RET_DV).astype(f32)
    tr = lambda t: jnp.transpose(t, (0, 2, 1, 3))
    log_g = jnp.log(1.0 - jnp.exp2(-5.0 - jnp.arange(RET_HEADS, dtype=f32)))
    o, s = _retention(tr(q), tr(k), tr(v), s0.astype(f32), log_g)
    o = o * lax.rsqrt(jnp.mean(o * o, axis=-1, keepdims=True) + NORM_EPS)
    o = tr(o).reshape(B, T, RET_V)
    return o * jax.nn.silu(g_a.astype(f32)), s


def _rwkv_scan(r, w, k, v, kk, a, s0):
    def step(s, inp):
        r_t, w_t, k_t, v_t, kk_t, a_t = inp
        sk = jnp.einsum('bhvk,bhk->bhv', s, kk_t)
        s = s * w_t[:, :, None, :] - sk[..., None] * (a_t * kk_t)[:, :, None, :] + v_t[..., None] * k_t[:, :, None, :]
        return s, jnp.einsum('bhvk,bhk->bhv', s, r_t)

    xs = tuple(jnp.moveaxis(t, 1, 0) for t in (r, w, k, v, kk, a))
    s, o = lax.scan(step, s0, xs)
    return jnp.moveaxis(o, 0, 1), s


def _rwkv_branch(sh, sh_prev, g_b, mu, w0, w2, a0, a2, k_k, k_a, r_k, ln_w, ln_b, s0):
    f32 = jnp.float32
    cur = sh.astype(f32)
    z = cur + (sh_prev.astype(f32) - cur) * mu.astype(f32)
    r, k, v, wl, al = jnp.split(z, [RW_C, 2 * RW_C, 3 * RW_C, 3 * RW_C + RW_DECAY_LORA], axis=-1)
    w = -jax.nn.softplus(-(w0.astype(f32) + jnp.tanh(wl) @ w2.astype(f32))) - 0.5
    decay = jnp.exp(-jnp.exp(w))
    a = jax.nn.sigmoid(a0.astype(f32) + al @ a2.astype(f32))
    B, T = r.shape[:2]
    hs = lambda t: t.reshape(B, T, RW_HEADS, RW_HEAD)
    kk = hs(k * k_k.astype(f32))
    kk = kk / jnp.maximum(jnp.sqrt(jnp.sum(kk * kk, axis=-1, keepdims=True)), 1e-12)
    k = k * (1.0 + (a - 1.0) * k_a.astype(f32))
    r, k, v, decay, a = hs(r), hs(k), hs(v), hs(decay), hs(a)
    o, s = _rwkv_scan(r, decay, k, v, kk, a, s0.astype(f32))
    mean = jnp.mean(o, axis=-1, keepdims=True)
    var = jnp.mean(jnp.square(o - mean), axis=-1, keepdims=True)
    o = ((o - mean) * lax.rsqrt(var + RW_GN_EPS)).reshape(B, T, RW_C) * ln_w.astype(f32) + ln_b.astype(f32)
    bonus = jnp.sum(r * k * r_k.astype(f32), axis=-1, keepdims=True) * v
    o = o + bonus.reshape(B, T, RW_C)
    return o * jax.nn.silu(g_b.astype(f32)), s


def _layer(x, h_prev, s_ret, s_rw, p, pos0, norm_g, w_in, rw_mu, rw_w0, rw_w2, rw_a0, rw_a2, rw_k_k, rw_k_a, rw_r_k, rw_ln_w, rw_ln_b, w_down_a, w_down_b, w_out, w_ple, ple_norm_g, w_ple_gate):
    h = _rmsnorm(x, norm_g)
    hf = jnp.concatenate([h_prev[:, None, :].astype(h.dtype), h], axis=1)
    p_full = jnp.einsum('btd,dn->btn', hf, w_in)
    P = p_full[:, 1:]
    o1 = RET_QK
    o2 = 2 * RET_QK
    o3 = o2 + RET_V
    o4 = o3 + RET_V
    o5 = o4 + N_SHIFT
    o6 = o5 + RW_C
    o7 = o6 + D_MODEL
    sh_prev = p_full[:, :-1, o4:o5]
    q, k, v, g_a, sh, g_b, m_a, m_b = jnp.split(P, [o1, o2, o3, o4, o5, o6, o7], axis=-1)
    y_a, s_ret_new = _retention_branch(q, k, v, g_a, pos0, s_ret)
    y_b, s_rw_new = _rwkv_branch(sh, sh_prev, g_b, rw_mu, rw_w0, rw_w2, rw_a0, rw_a2, rw_k_k, rw_k_a, rw_r_k, rw_ln_w, rw_ln_b, s_rw)
    merged = jax.nn.sigmoid(m_a.astype(jnp.float32)) * (y_a @ w_down_a) + jax.nn.sigmoid(m_b.astype(jnp.float32)) * (y_b @ w_down_b)
    x = x + (merged @ w_out).astype(x.dtype)
    gate = jax.nn.sigmoid(_rmsnorm(x, ple_norm_g) @ w_ple_gate)
    x = x + ((p @ w_ple) * gate).astype(x.dtype)
    return x, h[:, -1], s_ret_new.astype(s_ret.dtype), s_rw_new.astype(s_rw.dtype)


def setup_inputs(seed: int = 0) -> dict:
    key = jax.random.key(seed)
    ks = jax.random.split(key, 32)
    f32 = jnp.float32
    nrm = lambda k, shape, s: jax.random.normal(k, shape, f32) * s
    L = DEPTH
    return {
        'x_prompt': nrm(ks[0], (BATCH, SEQ, D_MODEL), 1.0),
        'x_sample': nrm(ks[1], (DEC_BATCH, DEC_SEQ, D_MODEL), 1.0),
        'state_ret': nrm(ks[2], (L, DEC_BATCH, RET_HEADS, RET_DK, RET_DV), 1.0),
        'state_rwkv': nrm(ks[3], (L, DEC_BATCH, RW_HEADS, RW_HEAD, RW_HEAD), 1.0),
        'state_shift': nrm(ks[4], (L, DEC_BATCH, D_MODEL), 1.0),
        'p_prompt': nrm(ks[5], (L, BATCH, SEQ, PLE_DIM), 1.0),
        'p_sample': nrm(ks[6], (L, DEC_BATCH, DEC_SEQ, PLE_DIM), 1.0),
        'norm_g': 1.0 + nrm(ks[7], (L, D_MODEL), 0.02),
        'w_in': nrm(ks[8], (L, D_MODEL, N_COLS), D_MODEL ** -0.5),
        'rw_mu': jax.random.uniform(ks[9], (L, N_SHIFT), f32),
        'rw_w0': jax.random.uniform(ks[10], (L, RW_C), f32, -6.0, -0.5),
        'rw_w2': nrm(ks[11], (L, RW_DECAY_LORA, RW_C), 0.1),
        'rw_a0': nrm(ks[12], (L, RW_C), 0.1),
        'rw_a2': nrm(ks[13], (L, RW_AAA_LORA, RW_C), RW_AAA_LORA ** -0.5),
        'rw_k_k': 0.85 + nrm(ks[14], (L, RW_C), 0.05),
        'rw_k_a': 1.0 + nrm(ks[15], (L, RW_C), 0.05),
        'rw_r_k': nrm(ks[16], (L, RW_HEADS, RW_HEAD), 0.1),
        'rw_ln_w': 1.0 + nrm(ks[17], (L, RW_C), 0.02),
        'rw_ln_b': nrm(ks[18], (L, RW_C), 0.02),
        'w_down_a': nrm(ks[19], (L, RET_V, D_MODEL), RET_V ** -0.5),
        'w_down_b': nrm(ks[20], (L, RW_C, D_MODEL), RW_C ** -0.5),
        'w_out': nrm(ks[21], (L, D_MODEL, D_MODEL), D_MODEL ** -0.5),
        'w_ple': nrm(ks[22], (L, PLE_DIM, D_MODEL), PLE_DIM ** -0.5),
        'ple_norm_g': 1.0 + nrm(ks[23], (L, D_MODEL), 0.02),
        'w_ple_gate': nrm(ks[24], (L, D_MODEL, D_MODEL), D_MODEL ** -0.5),
        'final_norm_g': 1.0 + nrm(ks[25], (D_MODEL,), 0.02),
    }


def reference(x_prompt, x_sample, state_ret, state_rwkv, state_shift, p_prompt, p_sample, norm_g, w_in, rw_mu, rw_w0, rw_w2, rw_a0, rw_a2, rw_k_k, rw_k_a, rw_r_k, rw_ln_w, rw_ln_b, w_down_a, w_down_b, w_out, w_ple, ple_norm_g, w_ple_gate, final_norm_g):
    xp, xs = x_prompt, x_sample
    pr_ret, pr_rw, pr_sh, sa_ret, sa_rw, sa_sh = [], [], [], [], [], []
    for i in range(DEPTH):
        lw = (norm_g[i], w_in[i], rw_mu[i], rw_w0[i], rw_w2[i], rw_a0[i], rw_a2[i], rw_k_k[i], rw_k_a[i], rw_r_k[i], rw_ln_w[i], rw_ln_b[i], w_down_a[i], w_down_b[i], w_out[i], w_ple[i], ple_norm_g[i], w_ple_gate[i])
        h0 = jnp.zeros((BATCH, D_MODEL), state_shift.dtype)
        r0 = jnp.zeros((BATCH, RET_HEADS, RET_DK, RET_DV), state_ret.dtype)
        w0s = jnp.zeros((BATCH, RW_HEADS, RW_HEAD, RW_HEAD), state_rwkv.dtype)
        xp, hp, rp, wp = _layer(xp, h0, r0, w0s, p_prompt[i], 0, *lw)
        xs, hs_, rs, ws = _layer(xs, state_shift[i], state_ret[i], state_rwkv[i], p_sample[i], PAST_LEN, *lw)
        pr_ret.append(rp)
        pr_rw.append(wp)
        pr_sh.append(hp.astype(state_shift.dtype))
        sa_ret.append(rs)
        sa_rw.append(ws)
        sa_sh.append(hs_.astype(state_shift.dtype))
    y_prompt = _rmsnorm(xp, final_norm_g)
    y_sample = _rmsnorm(xs, final_norm_g)
    return (y_prompt, y_sample, jnp.stack(pr_ret), jnp.stack(pr_rw), jnp.stack(pr_sh), jnp.stack(sa_ret), jnp.stack(sa_rw), jnp.stack(sa_sh))
```

```cpp
#include <hip/hip_runtime.h>
#include <hip/hip_cooperative_groups.h>
#include <cstdio>
#include <cstdint>
namespace cg = cooperative_groups;

#define LAS __attribute__((address_space(3)))
typedef unsigned short bf16_t;
typedef short bf16x8 __attribute__((ext_vector_type(8)));
typedef short bf16x4 __attribute__((ext_vector_type(4)));
typedef float f32x4 __attribute__((ext_vector_type(4)));
typedef float f32x2 __attribute__((ext_vector_type(2)));
typedef unsigned u32x4 __attribute__((ext_vector_type(4)));
typedef unsigned u32x2 __attribute__((ext_vector_type(2)));
typedef __bf16 nbf2 __attribute__((ext_vector_type(2)));

constexpr int D = 1024, NB = 8, T = 2048, MP = NB * T  , MS = 128, MR = MP + MS  , MALL = 16640  ;
constexpr int NCOLS = 12416, NP = 12544  ;
constexpr int O_K = 1024, O_V = 2048, O_GA = 4096, O_SH = 6144, O_GB = 9344, O_MA = 10368, O_MB = 11392;
constexpr int RH = 4, RDK = 256, RDV = 512, RCH = 128;
constexpr int WH = 16, WN = 64;
constexpr int PLE = 256;
constexpr float EPS = 1e-6f;
constexpr int REC = 12544;
constexpr int R_AT = 0, R_RT = 2048, R_BP = 4096, R_KP = 6144, R_VT = 8192, R_AAK = 10240, R_TT = 10752, R_ARB = 11264, R_ARK = 11776, R_WC = 12288;

constexpr size_t MiB = 1u << 20;
constexpr size_t WS_CTL = 0;
constexpr size_t WS_ROPE = 1 * MiB;
constexpr size_t WS_W2T = 4 * MiB, WS_A2T = WS_W2T + 131072;
constexpr size_t WS_WPLE = 5 * MiB, WS_WDB = 6 * MiB, WS_WOUT = 8 * MiB, WS_WGATE = 10 * MiB, WS_WDA = 12 * MiB, WS_WIN = 16 * MiB;
constexpr size_t WS_PB = 41 * MiB, WS_H = 50 * MiB  , WS_KT = 83 * MiB, WS_SQA = 115 * MiB, WS_BC = 117 * MiB, WS_OPSS = 119 * MiB  ;
constexpr size_t WS_OA = 122 * MiB, WS_P = 188 * MiB, WS_CH = 587 * MiB  , WS_OB = 786 * MiB  ;
constexpr size_t WS_T1 = WS_CH, WS_MG = WS_CH + 65 * MiB, WS_X1B = WS_CH + 98 * MiB, WS_GT = WS_CH + 131 * MiB, WS_X1 = WS_OB + 65 * MiB  ;
constexpr size_t WS_END = 916 * MiB;
constexpr size_t WS_BAR = 512 * 1024;
constexpr size_t WS_SQ1P = WS_KT, WS_SQ2P = WS_KT + 2 * MiB;

constexpr size_t OUT_Y = 0, OUT_RETP = 16908288, OUT_RWP = 21102592, OUT_SHP = 21626880, OUT_RETS = 21635072, OUT_RWS = 88743936, OUT_SHS = 97132544;

__device__ __forceinline__ unsigned pk2(float lo, float hi) { f32x2 v = {lo, hi}; nbf2 r = __builtin_convertvector(v, nbf2); return __builtin_bit_cast(unsigned, r); }
__device__ __forceinline__ unsigned short f2bf(float f) { return (unsigned short)(pk2(f, 0.f) & 0xffffu); }
__device__ __forceinline__ float bf2f(unsigned short b) { return __uint_as_float(((unsigned)b) << 16); }
__device__ __forceinline__ float bflo(unsigned w) { return __uint_as_float(w << 16); }
__device__ __forceinline__ float bfhi(unsigned w) { return __uint_as_float(w & 0xffff0000u); }
__device__ __forceinline__ float sigm(float x) { return 1.f / (1.f + __expf(-x)); }
__device__ __forceinline__ float wave_sum(float v) {
#pragma unroll
    for (int o = 1; o < 64; o <<= 1) v += __shfl_xor(v, o);
    return v;
}
#define MFMA32(a, b, c) __builtin_amdgcn_mfma_f32_16x16x32_bf16((a), (b), (c), 0, 0, 0)
#define LDS_WAIT() asm volatile("s_waitcnt lgkmcnt(0)" ::: "memory")

namespace pg8 {
constexpr int BM = 256, BK = 64, HALF = 128, HTB = HALF * BK * 2, STAGE_BYTES = 8 * HTB, NXCD = 8, WGM = 8;
__host__ __device__ __forceinline__ int lds_byte(int r, int c) { const int st = (r >> 4) * 2 + (c >> 5), rr = r & 15, cc = c & 31, ob = rr * 64 + cc * 2; return st * 1024 + (ob ^ (((ob >> 9) & 1) << 5)); }
__host__ __device__ __forceinline__ void stage_rc(int b, int& R, int& C) { const int st = b / 1024, sb = b % 1024, swz = sb ^ (((sb >> 9) & 1) << 5); R = (st >> 1) * 16 + swz / 64; C = (st & 1) * 32 + (swz % 64) / 2; }
__host__ __device__ __forceinline__ int perm32(int rho) { const int n = rho >> 4, i = rho & 15; return 8 * (i >> 2) + 4 * n + (i & 3); }
struct Unit { int pm, pn; };
struct Gemm { const bf16_t* A; const bf16_t* Bt; int M, N, K; };
struct StaticOrder {
    int nM, nN, nwg, G, c;
    __host__ __device__ void init(int M, int N, int G_, int c_) { nM = M / BM; nN = N / BM; nwg = nM * nN; G = G_; c = c_; }
    __host__ __device__ bool next(int i, Unit& u) const {
        const long L = (long)i * G + c; if (L >= nwg) return false;
        int wgid = (int)L; { const int q = nwg / NXCD, r = nwg % NXCD, xcd = wgid % NXCD, off = wgid / NXCD; wgid = (xcd < r ? xcd * (q + 1) : r * (q + 1) + (xcd - r) * q) + off; }
        const int nig = WGM * nN, gid = wgid / nig, fm = gid * WGM, gsz = (nM - fm) < WGM ? (nM - fm) : WGM;
        u.pm = fm + ((wgid % nig) % gsz); u.pn = (wgid % nig) / gsz; return true;
    }
};
template <class Epi>
__device__ __forceinline__ void gemm_phase(LAS unsigned char* lds, const Gemm g, const StaticOrder& S, const Epi& E) {
    int tid = threadIdx.x; asm volatile("" : "+v"(tid));
    const int wid = __builtin_amdgcn_readfirstlane(tid >> 6), lane = tid & 63, wr = wid >> 2, wc = wid & 3, fr = lane & 15, fq = lane >> 4;
    const int K = g.K, nt = K / BK;
    unsigned voffA[2], voffB[2];
#pragma unroll
    for (int i = 0; i < 2; ++i) { int R, C; stage_rc(tid * 16 + i * 8192, R, C); const int Rb = Epi::PERM ? ((R & ~31) + perm32(R & 31)) : R;
        voffA[i] = (unsigned)(R * K + C) * 2u; voffB[i] = (unsigned)(Rb * K + C) * 2u; }
    const size_t kstep = (size_t)(BK * 2);
    const size_t hstep = (size_t)HALF * K * 2;
    const size_t tstep = 2 * hstep;
    const unsigned ldsw = (unsigned)wid * 1024u;
    const int aoff = lds_byte(wr * 64 + fr, fq * 8), boff = lds_byte(wc * 32 + fr, fq * 8);
#define PG8_SA(b, h) (((b) * 2 + (h)) * HTB)
#define PG8_SB(b, h) ((4 + (b) * 2 + (h)) * HTB)
#define PG8_STAGE(bufoff, gbase, voff) do { _Pragma("unroll") for (int _i = 0; _i < 2; ++_i) \
        __builtin_amdgcn_global_load_lds((const unsigned*)((const char*)(gbase) + (voff)[_i]), (LAS unsigned*)(lds + (bufoff) + ldsw + _i * 8192), 16, 0, 0); } while (0)
#define PG8_LDA(dst, b, h) do { _Pragma("unroll") for (int m = 0; m < 4; ++m) _Pragma("unroll") for (int k = 0; k < 2; ++k) dst[m][k] = *(const LAS bf16x8*)(lds + PG8_SA(b, h) + aoff + m * 2048 + k * 1024); } while (0)
#define PG8_LDB(dst, b, h) do { _Pragma("unroll") for (int n = 0; n < 2; ++n) _Pragma("unroll") for (int k = 0; k < 2; ++k) dst[n][k] = *(const LAS bf16x8*)(lds + PG8_SB(b, h) + boff + n * 2048 + k * 1024); } while (0)
#define PG8_MMA(ai, bj, At, Bt) do { __builtin_amdgcn_s_setprio(1); _Pragma("unroll") for (int m = 0; m < 4; ++m) _Pragma("unroll") for (int n = 0; n < 2; ++n) _Pragma("unroll") for (int k = 0; k < 2; ++k) \
        acc[ai][bj][m][n] = __builtin_amdgcn_mfma_f32_16x16x32_bf16(Bt[n][k], At[m][k], acc[ai][bj][m][n], 0, 0, 0); __builtin_amdgcn_s_setprio(0); } while (0)
#define PG8_WAIT_V(n) asm volatile("s_waitcnt vmcnt(" #n ")" ::: "memory")
#define PG8_WAIT_L(n) asm volatile("s_waitcnt lgkmcnt(" #n ")" ::: "memory")
#define PG8_BAR __builtin_amdgcn_s_barrier()
#define PG8_SCHED __builtin_amdgcn_sched_barrier(0)
    Unit cur, nxt; int ui = 0;
    if (!S.next(0, cur)) return;
    f32x4 acc[2][2][4][2];
#pragma unroll
    for (int a = 0; a < 2; ++a)
#pragma unroll
        for (int b = 0; b < 2; ++b)
#pragma unroll
            for (int m = 0; m < 4; ++m)
#pragma unroll
                for (int n = 0; n < 2; ++n) acc[a][b][m][n] = (f32x4){0.f, 0.f, 0.f, 0.f};
    bf16x8 At[4][2], B0[2][2], B1[2][2];
    const char* cA = (const char*)g.A + (size_t)cur.pm * tstep; const char* cB = (const char*)g.Bt + (size_t)cur.pn * tstep;
    PG8_STAGE(PG8_SB(0, 0), cB, voffB); PG8_STAGE(PG8_SA(0, 0), cA, voffA); PG8_STAGE(PG8_SB(0, 1), cB + hstep, voffB); PG8_STAGE(PG8_SA(0, 1), cA + hstep, voffA);
    if (wr == 1) PG8_BAR;
    PG8_WAIT_V(4); PG8_BAR;
    PG8_STAGE(PG8_SB(1, 0), cB + kstep, voffB); PG8_STAGE(PG8_SA(1, 0), cA + kstep, voffA); PG8_STAGE(PG8_SB(1, 1), cB + hstep + kstep, voffB);
    PG8_WAIT_V(6); PG8_BAR;
    for (;;) {
        const bool has_next = S.next(ui + 1, nxt);
        const char* nA = has_next ? (const char*)g.A + (size_t)nxt.pm * tstep : cA; const char* nB = has_next ? (const char*)g.Bt + (size_t)nxt.pn * tstep : cB;
#pragma unroll 1
        for (int t = 0; t < nt; t += 2) {
            const bool last = (t == nt - 2);
            const char* a1 = cA + (size_t)(t + 1) * kstep;
            const char* a2 = last ? nA : cA + (size_t)(t + 2) * kstep; const char* b2 = last ? nB : cB + (size_t)(t + 2) * kstep;
            const char* a3 = a2 + kstep; const char* b3 = b2 + kstep;
            PG8_LDB(B0, 0, 0); PG8_SCHED; PG8_LDA(At, 0, 0); PG8_STAGE(PG8_SA(1, 1), a1 + hstep, voffA);
            PG8_WAIT_L(8); PG8_BAR; PG8_WAIT_L(0); PG8_MMA(0, 0, At, B0); PG8_BAR; PG8_SCHED;
            PG8_LDB(B1, 0, 1); PG8_STAGE(PG8_SB(0, 0), b2, voffB);
            PG8_BAR; PG8_WAIT_L(0); PG8_MMA(0, 1, At, B1); PG8_BAR;
            PG8_LDA(At, 0, 1); PG8_STAGE(PG8_SA(0, 0), a2, voffA);
            PG8_BAR; PG8_WAIT_L(0); PG8_MMA(1, 0, At, B0); PG8_BAR; PG8_SCHED;
            PG8_STAGE(PG8_SB(0, 1), b2 + hstep, voffB);
            PG8_WAIT_V(6); PG8_BAR; PG8_MMA(1, 1, At, B1); PG8_BAR;
            PG8_LDB(B0, 1, 0); PG8_SCHED; PG8_LDA(At, 1, 0); PG8_STAGE(PG8_SA(0, 1), a2 + hstep, voffA);
            PG8_WAIT_L(8); PG8_BAR; PG8_WAIT_L(0); PG8_MMA(0, 0, At, B0); PG8_BAR; PG8_SCHED;
            PG8_LDB(B1, 1, 1); PG8_STAGE(PG8_SB(1, 0), b3, voffB);
            PG8_BAR; PG8_WAIT_L(0); PG8_MMA(0, 1, At, B1); PG8_BAR;
            PG8_LDA(At, 1, 1); PG8_STAGE(PG8_SA(1, 0), a3, voffA);
            PG8_BAR; PG8_WAIT_L(0); PG8_MMA(1, 0, At, B0); PG8_BAR; PG8_SCHED;
            PG8_STAGE(PG8_SB(1, 1), b3 + hstep, voffB);
            PG8_WAIT_V(6); PG8_BAR; PG8_MMA(1, 1, At, B1); PG8_BAR;
        }
        E(acc, cur, wr, wc, fr, fq);
        if (!has_next) break;
#pragma unroll
        for (int a = 0; a < 2; ++a)
#pragma unroll
            for (int b = 0; b < 2; ++b)
#pragma unroll
                for (int m = 0; m < 4; ++m)
#pragma unroll
                    for (int n = 0; n < 2; ++n) acc[a][b][m][n] = (f32x4){0.f, 0.f, 0.f, 0.f};
        cur = nxt; cA = nA; cB = nB; ++ui;
    }
    PG8_WAIT_V(0);
    if (wr == 0) PG8_BAR;
    PG8_BAR;
#undef PG8_SA
#undef PG8_SB
#undef PG8_STAGE
#undef PG8_LDA
#undef PG8_LDB
#undef PG8_MMA
#undef PG8_WAIT_V
#undef PG8_WAIT_L
#undef PG8_BAR
#undef PG8_SCHED
}
}
using pg8::Unit;

struct Args {
    const float* in[26];
    float* out; unsigned char* ws;
};
enum { I_XP = 0, I_XS, I_SRET, I_SRW, I_SSH, I_PP, I_PS, I_NG, I_WIN, I_MU, I_W0, I_W2, I_A0, I_A2, I_KK, I_KA, I_RK, I_LNW, I_LNB, I_WDA, I_WDB, I_WOUT, I_WPLE, I_PNG, I_WPG, I_FNG };

__device__ __forceinline__ void p0_transpose_item(const float* W, int K, int N, bf16_t* WT, LAS float* scr, int item, int lane, const float* kscale) {
    const int nblk = N / 32, kb = item / nblk, nb = item % nblk, k0 = 64 * kb, n0 = 32 * nb;
#pragma unroll 8
    for (int i = 0; i < 32; ++i) { const int kk = 2 * i + (lane >> 5); float v = W[(size_t)(k0 + kk) * N + n0 + (lane & 31)]; if (kscale) v *= kscale[k0 + kk]; scr[kk * 33 + (lane & 31)] = v; }
    LDS_WAIT();
    const int c = lane & 7;
#pragma unroll
    for (int j = 0; j < 4; ++j) { const int n = (lane >> 3) + 8 * j; const LAS float* s = scr + (8 * c) * 33 + n;
        u32x4 o; o.x = pk2(s[0 * 33], s[1 * 33]); o.y = pk2(s[2 * 33], s[3 * 33]); o.z = pk2(s[4 * 33], s[5 * 33]); o.w = pk2(s[6 * 33], s[7 * 33]);
        *(u32x4*)(WT + (size_t)(n0 + n) * K + k0 + 8 * c) = o; }
    LDS_WAIT();
}

__device__ __forceinline__ void phase0(const Args& a, LAS unsigned char* lds, int gw, int NGW, int wave, int lane) {
    unsigned char* ws = a.ws;
    LAS float* scr = (LAS float*)(lds + wave * 16384);
    constexpr int I_IN = (D / 64) * (NCOLS / 32), I_DA = (2048 / 64) * (D / 32), I_SQ = (D / 64) * (D / 32), I_PL = (PLE / 64) * (D / 32), I_LR = 1 * (D / 32);
    constexpr int NITEMS = I_IN + I_DA + 3 * I_SQ + I_PL + 2 * I_LR;
    for (int it = gw; it < NITEMS; it += NGW) {
        int r = it;
        if (r < I_IN) { p0_transpose_item(a.in[I_WIN], D, NCOLS, (bf16_t*)(ws + WS_WIN), scr, r, lane, nullptr); continue; } r -= I_IN;
        if (r < I_DA) { p0_transpose_item(a.in[I_WDA], 2048, D, (bf16_t*)(ws + WS_WDA), scr, r, lane, nullptr); continue; } r -= I_DA;
        if (r < I_SQ) { p0_transpose_item(a.in[I_WDB], D, D, (bf16_t*)(ws + WS_WDB), scr, r, lane, nullptr); continue; } r -= I_SQ;
        if (r < I_SQ) { p0_transpose_item(a.in[I_WOUT], D, D, (bf16_t*)(ws + WS_WOUT), scr, r, lane, nullptr); continue; } r -= I_SQ;
        if (r < I_SQ) { p0_transpose_item(a.in[I_WPG], D, D, (bf16_t*)(ws + WS_WGATE), scr, r, lane, a.in[I_PNG]); continue; } r -= I_SQ;
        if (r < I_PL) { p0_transpose_item(a.in[I_WPLE], PLE, D, (bf16_t*)(ws + WS_WPLE), scr, r, lane, nullptr); continue; } r -= I_PL;
        if (r < I_LR) { p0_transpose_item(a.in[I_W2], 64, D, (bf16_t*)(ws + WS_W2T), scr, r, lane, nullptr); continue; } r -= I_LR;
        p0_transpose_item(a.in[I_A2], 64, D, (bf16_t*)(ws + WS_A2T), scr, r, lane, nullptr);
    }
    for (int i = gw * 64 + lane; i < 128 * D / 8; i += NGW * 64) ((u32x4*)(ws + WS_WIN + (size_t)NCOLS * D * 2))[i] = (u32x4){0u, 0u, 0u, 0u};
    bf16_t* H = (bf16_t*)(ws + WS_H);
    const float* ng = a.in[I_NG];
    for (int m = gw; m < MALL; m += NGW) {
        if (m < MR) {
            const float* xr = (m < MP) ? a.in[I_XP] + (size_t)m * D : a.in[I_XS] + (size_t)(m - MP) * D;
            f32x4 v[4]; float s = 0.f;
#pragma unroll
            for (int j = 0; j < 4; ++j) { v[j] = ((const f32x4*)xr)[lane + 64 * j]; s += (v[j].x * v[j].x + v[j].y * v[j].y) + (v[j].z * v[j].z + v[j].w * v[j].w); }
            const float rs = 1.0f / sqrtf(wave_sum(s) * (1.f / D) + EPS);
            float* so = nullptr;
            if (m < MP) { if ((m & (T - 1)) == T - 1) so = a.out + OUT_SHP + (size_t)(m >> 11) * D; } else so = a.out + OUT_SHS + (size_t)(m - MP) * D;
#pragma unroll
            for (int j = 0; j < 4; ++j) { const f32x4 gg = ((const f32x4*)ng)[lane + 64 * j]; f32x4 h = v[j] * rs * gg;
                if (so) ((f32x4*)so)[lane + 64 * j] = h;
                u32x2 o; o.x = pk2(h.x, h.y); o.y = pk2(h.z, h.w); ((u32x2*)(H + (size_t)m * D))[lane + 64 * j] = o; }
        } else {
            const float* xr = a.in[I_SSH] + (size_t)(m - MR) * D;
#pragma unroll
            for (int j = 0; j < 4; ++j) { const f32x4 h = ((const f32x4*)xr)[lane + 64 * j]; u32x2 o; o.x = pk2(h.x, h.y); o.y = pk2(h.z, h.w); ((u32x2*)(H + (size_t)m * D))[lane + 64 * j] = o; }
        }
        u32x2 o = {0u, 0u};
        if (m < MR) { const float* pr = (m < MP) ? a.in[I_PP] + (size_t)m * PLE : a.in[I_PS] + (size_t)(m - MP) * PLE; const f32x4 p = ((const f32x4*)pr)[lane]; o.x = pk2(p.x, p.y); o.y = pk2(p.z, p.w); }
        ((u32x2*)(ws + WS_PB + (size_t)m * PLE * 2))[lane] = o;
    }
    for (int i = gw * 64 + lane; i < 2049 * 128; i += NGW * 64) {
        const int pos = i >> 7, j = i & 127; const double p = (pos == 2048) ? 16384.0 : (double)pos;
        double inv = 1.0, base = 0.9305720409296989; int e = j;
        while (e) { if (e & 1) inv *= base; base *= base; e >>= 1; }
        double rev = p * inv * 0.15915494309189535; rev -= floor(rev);
        const float fr = (float)rev;
        ((f32x2*)(ws + WS_ROPE))[i] = (f32x2){__builtin_amdgcn_cosf(fr), __builtin_amdgcn_sinf(fr)};
    }
    for (int i = gw * 64 + lane; i < 65536 + 64; i += NGW * 64) ((float*)(ws + WS_CTL))[i] = 0.f;
}

struct EpiP {
    static constexpr bool PERM = true;
    bf16_t* P; bf16_t* KT; const f32x2* rope;
    __device__ __forceinline__ void operator()(const f32x4 (&acc)[2][2][4][2], const Unit& u, int wr, int wc, int fr, int fq) const {
        const int pn = u.pn, pm = u.pm;
        const int row0 = pm * 256 + wr * 64 + fr, cl0 = wc * 32 + 8 * fq;
        const bool sample = (pm == 64);
        if (pn < 8) {
            const int h = pn & 3; const bool isk = pn >= 4;
            const float l2g = __log2f(1.f - exp2f(-5.f - (float)h));
#pragma unroll
            for (int ai = 0; ai < 2; ++ai)
#pragma unroll
                for (int m = 0; m < 4; ++m) {
                    const int row = row0 + ai * 128 + m * 16;
                    int pos, ex;
                    if (sample) { pos = 2048; ex = isk ? 0 : 1; } else { pos = row & (T - 1); const int idx = pos & 127; ex = isk ? 127 - idx : idx + 1; }
                    const float sc = exp2f((float)ex * l2g) * (isk ? 0.0625f : 1.0f);
                    const f32x4* rp = (const f32x4*)(rope + pos * 128 + cl0);
                    f32x4 cs[4]; cs[0] = rp[0]; cs[1] = rp[1]; cs[2] = rp[2]; cs[3] = rp[3];
                    float y1[8], y2[8];
#pragma unroll
                    for (int n = 0; n < 2; ++n)
#pragma unroll
                        for (int e = 0; e < 4; ++e) {
                            const float c = (e & 1) ? cs[n * 2 + (e >> 1)].z : cs[n * 2 + (e >> 1)].x, s = (e & 1) ? cs[n * 2 + (e >> 1)].w : cs[n * 2 + (e >> 1)].y;
                            const float x1 = acc[ai][0][m][n][e], x2 = acc[ai][1][m][n][e];
                            y1[n * 4 + e] = (x1 * c - x2 * s) * sc; y2[n * 4 + e] = (x2 * c + x1 * s) * sc;
                        }
                    u32x4 w1, w2;
                    w1.x = pk2(y1[0], y1[1]); w1.y = pk2(y1[2], y1[3]); w1.z = pk2(y1[4], y1[5]); w1.w = pk2(y1[6], y1[7]);
                    w2.x = pk2(y2[0], y2[1]); w2.y = pk2(y2[2], y2[3]); w2.z = pk2(y2[4], y2[5]); w2.w = pk2(y2[6], y2[7]);
                    bf16_t* rowp = P + (size_t)row * NP + pn * 256 + cl0;
                    *(u32x4*)rowp = w1; *(u32x4*)(rowp + 128) = w2;
                    if (isk && !sample) {
                        bf16_t* kt = KT + ((size_t)((row >> 11) * 4 + h) * 256 + cl0) * T + pos;
#pragma unroll
                        for (int j = 0; j < 8; ++j) { kt[(size_t)j * T] = f2bf(y1[j]); kt[(size_t)(j + 128) * T] = f2bf(y2[j]); }
                    }
                }
            return;
        }
#pragma unroll
        for (int bj = 0; bj < 2; ++bj) {
            const int cb = pn * 2 + bj;
            if (cb >= 97) continue;
            const int mode = (cb < 32) ? 0 : (cb < 48) ? 1 : (cb < 73) ? 0 : (cb < 81) ? 1 : 2;
            const bool vt = (cb < 32) && !sample;
#pragma unroll
            for (int ai = 0; ai < 2; ++ai)
#pragma unroll
                for (int m = 0; m < 4; ++m) {
                    const int row = row0 + ai * 128 + m * 16;
                    float y[8];
#pragma unroll
                    for (int n = 0; n < 2; ++n)
#pragma unroll
                        for (int e = 0; e < 4; ++e) { float x = acc[ai][bj][m][n][e]; if (mode == 1) x = x * sigm(x); else if (mode == 2) x = sigm(x); y[n * 4 + e] = x; }
                    if (vt) {
                        const int hd = cb * 128 + cl0 - O_V;
                        bf16_t* vp = P + ((size_t)(row >> 11) * T + hd) * NP + O_V + (row & (T - 1));
#pragma unroll
                        for (int j = 0; j < 8; ++j) vp[(size_t)j * NP] = f2bf(y[j]);
                    } else {
                        u32x4 w; w.x = pk2(y[0], y[1]); w.y = pk2(y[2], y[3]); w.z = pk2(y[4], y[5]); w.w = pk2(y[6], y[7]);
                        *(u32x4*)(P + (size_t)row * NP + cb * 128 + cl0) = w;
                    }
                }
        }
    }
};

__device__ __forceinline__ float lerp_bf(const bf16_t* cur, const bf16_t* prv, float mu) { const float c = bf2f(*cur); const float p = prv ? bf2f(*prv) : 0.f; return c + (p - c) * mu; }

__device__ __forceinline__ void rw_prep_item(const Args& a, LAS unsigned char* wl  , int tt, int h, int lane) {
    unsigned char* ws = a.ws;
    const bf16_t* P = (const bf16_t*)(ws + WS_P);
    const int l15 = lane & 15, quad = lane >> 4;
    const bool sample = tt >= 1024;
    const int row_base = sample ? MP + (tt - 1024) * 16 : tt * 16;
    const float* mu = a.in[I_MU];
    bf16x8 Aw[2], Aa[2];
    {
        const int m = row_base + l15;
        const bf16_t* cur = P + (size_t)m * NP + O_SH;
        const bf16_t* prv = sample ? P + (size_t)(m + MS) * NP + O_SH : ((m & (T - 1)) ? cur - NP : nullptr);
#pragma unroll
        for (int which = 0; which < 2; ++which)
#pragma unroll
            for (int ks = 0; ks < 2; ++ks) {
                const int col = 3072 + which * 64 + ks * 32 + quad * 8;
                const u32x4 cw = *(const u32x4*)(cur + col); u32x4 pw = {0u, 0u, 0u, 0u}; if (prv) pw = *(const u32x4*)(prv + col);
                const f32x4 m0 = *(const f32x4*)(mu + col), m1 = *(const f32x4*)(mu + col + 4);
                float z[8];
                const unsigned cws[4] = {cw.x, cw.y, cw.z, cw.w}, pws[4] = {pw.x, pw.y, pw.z, pw.w};
#pragma unroll
                for (int j = 0; j < 4; ++j) {
                    const float c0 = bflo(cws[j]), c1 = bfhi(cws[j]), p0 = bflo(pws[j]), p1 = bfhi(pws[j]);
                    const float mm0 = (j < 2) ? m0[2 * j] : m1[2 * j - 4], mm1 = (j < 2) ? m0[2 * j + 1] : m1[2 * j - 3];
                    z[2 * j] = c0 + (p0 - c0) * mm0; z[2 * j + 1] = c1 + (p1 - c1) * mm1;
                }
                if (which == 0) {
#pragma unroll
                    for (int j = 0; j < 8; ++j) z[j] = 1.f - 2.f / (__expf(2.f * z[j]) + 1.f);
                }
                u32x4 o; o.x = pk2(z[0], z[1]); o.y = pk2(z[2], z[3]); o.z = pk2(z[4], z[5]); o.w = pk2(z[6], z[7]);
                if (which == 0) Aw[ks] = __builtin_bit_cast(bf16x8, o); else Aa[ks] = __builtin_bit_cast(bf16x8, o);
            }
    }
    const bf16_t* W2T = (const bf16_t*)(ws + WS_W2T); const bf16_t* A2T = (const bf16_t*)(ws + WS_A2T);
    unsigned char* rec = ws + WS_CH + ((size_t)((tt >> 7) * 16 + h) * 128 + (tt & 127)) * REC;
    LAS bf16_t* LA = (LAS bf16_t*)wl;
    LAS bf16_t* LR = LA + 16 * 72;
    LAS bf16_t* LB = LR + 16 * 72;
    LAS bf16_t* LK = LB + 16 * 72;
    LAS float* LN = (LAS float*)(wl + 9216);
    float tA[4][4], tBi[4][4], tBp[4][4];
    float ssq[4] = {0.f, 0.f, 0.f, 0.f}, bon[4] = {0.f, 0.f, 0.f, 0.f};
#pragma unroll
    for (int nt = 0; nt < 4; ++nt) {
        const int ch = h * 64 + nt * 16 + l15, cc = nt * 16 + l15;
        f32x4 cw = {0.f, 0.f, 0.f, 0.f}, ca = {0.f, 0.f, 0.f, 0.f};
#pragma unroll
        for (int ks = 0; ks < 2; ++ks) {
            const bf16x8 bw = *(const bf16x8*)(W2T + (size_t)ch * 64 + ks * 32 + quad * 8), ba = *(const bf16x8*)(A2T + (size_t)ch * 64 + ks * 32 + quad * 8);
            cw = MFMA32(Aw[ks], bw, cw); ca = MFMA32(Aa[ks], ba, ca);
        }
        const float w0 = a.in[I_W0][ch], a0 = a.in[I_A0][ch], k_k = a.in[I_KK][ch], k_a = a.in[I_KA][ch], r_k = a.in[I_RK][ch];
        const float mur = mu[ch], muk = mu[1024 + ch], muv = mu[2048 + ch];
        float lw[4], rr[4], kq[4], vv[4], aa4[4], kr4[4];
#pragma unroll
        for (int r = 0; r < 4; ++r) {
            const int m = row_base + quad * 4 + r;
            const bf16_t* cur = P + (size_t)m * NP + O_SH + ch;
            const bf16_t* prv = sample ? P + (size_t)(m + MS) * NP + O_SH + ch : ((m & (T - 1)) ? cur - NP : nullptr);
            const float r_ = lerp_bf(cur, prv, mur), k_ = lerp_bf(cur + 1024, prv ? prv + 1024 : nullptr, muk), v_ = lerp_bf(cur + 2048, prv ? prv + 2048 : nullptr, muv);
            lw[r] = -0.6065306597126334f * sigm(w0 + cw[r]);
            const float aa = sigm(a0 + ca[r]); aa4[r] = aa;
            const float kr = k_ * k_k; kr4[r] = kr; ssq[r] += kr * kr;
            const float kpp = k_ * (1.f + (aa - 1.f) * k_a); kq[r] = kpp;
            rr[r] = r_; vv[r] = v_; bon[r] += r_ * kpp * r_k;
        }
        if (sample) {
#pragma unroll
            for (int r = 0; r < 4; ++r) {
                const int i = (tt - 1024) * 16 + quad * 4 + r;
                float* o = (float*)(ws + WS_OPSS) + ((size_t)(i * 16 + h) * 6) * 64 + cc;
                o[0] = rr[r]; o[64] = __expf(lw[r]); o[128] = kq[r]; o[320] = vv[r];
                tA[nt][r] = kr4[r]; tBi[nt][r] = aa4[r] * kr4[r]; tBp[nt][r] = 0.f;
            }
        } else {
            float c[4]; c[0] = lw[0]; c[1] = c[0] + lw[1]; c[2] = c[1] + lw[2]; c[3] = c[2] + lw[3];
            const float tot = c[3];
            const float s1 = __shfl(tot, (lane - 16) & 63), s2 = __shfl(tot, (lane - 32) & 63), s3 = __shfl(tot, (lane - 48) & 63);
            const float off = (quad >= 1 ? s1 : 0.f) + (quad >= 2 ? s2 : 0.f) + (quad >= 3 ? s3 : 0.f);
            const float total = __shfl(c[3] + off, 48 + l15);
            float kqp[4];
#pragma unroll
            for (int r = 0; r < 4; ++r) {
                const float cum = c[r] + off, cumx = cum - lw[r];
                const float ea = __expf(cumx), er = __expf(cum), ei = __expf(-cum), ep = __expf(total - cum);
                const int tk = quad * 4 + r;
                LR[tk * 72 + cc] = f2bf(rr[r] * er); LK[tk * 72 + cc] = f2bf(kq[r] * ei);
                kqp[r] = kq[r] * ep;
                tA[nt][r] = kr4[r] * ea; tBi[nt][r] = aa4[r] * kr4[r] * ei; tBp[nt][r] = aa4[r] * kr4[r] * ep;
            }
            *(u32x2*)(rec + R_KP + cc * 32 + quad * 8) = (u32x2){pk2(kqp[0], kqp[1]), pk2(kqp[2], kqp[3])};
            *(u32x2*)(rec + R_VT + cc * 32 + quad * 8) = (u32x2){pk2(vv[0], vv[1]), pk2(vv[2], vv[3])};
            if (quad == 0) *(float*)(rec + R_WC + cc * 4) = __expf(total);
        }
        asm volatile("" ::: "memory");
    }
    float inv[4];
#pragma unroll
    for (int r = 0; r < 4; ++r) {
        float s = ssq[r], b = bon[r];
#pragma unroll
        for (int o = 1; o < 16; o <<= 1) { s += __shfl_xor(s, o); b += __shfl_xor(b, o); }
        inv[r] = 1.f / fmaxf(sqrtf(s), 1e-12f);
        if (l15 == 0) ((float*)(ws + WS_BC))[(size_t)(row_base + quad * 4 + r) * 16 + h] = b;
    }
    if (sample) {
#pragma unroll
        for (int nt = 0; nt < 4; ++nt)
#pragma unroll
            for (int r = 0; r < 4; ++r) {
                const int i = (tt - 1024) * 16 + quad * 4 + r;
                float* o = (float*)(ws + WS_OPSS) + ((size_t)(i * 16 + h) * 6) * 64 + nt * 16 + l15;
                o[192] = tA[nt][r] * inv[r]; o[256] = tBi[nt][r] * inv[r];
            }
        return;
    }
#pragma unroll
    for (int nt = 0; nt < 4; ++nt) {
        const int cc = nt * 16 + l15;
        float bp[4];
#pragma unroll
        for (int r = 0; r < 4; ++r) { const int tk = quad * 4 + r;
            LA[tk * 72 + cc] = f2bf(-tA[nt][r] * inv[r]); LB[tk * 72 + cc] = f2bf(tBi[nt][r] * inv[r]); bp[r] = tBp[nt][r] * inv[r]; }
        *(u32x2*)(rec + R_BP + cc * 32 + quad * 8) = (u32x2){pk2(bp[0], bp[1]), pk2(bp[2], bp[3])};
    }
    LDS_WAIT();
#pragma unroll
    for (int i = 0; i < 2; ++i) { const int idx = lane + 64 * i, rr = idx >> 3, c8 = (idx & 7) * 8;
        *(u32x4*)(rec + R_AT + rr * 128 + c8 * 2) = *(const LAS u32x4*)(LA + rr * 72 + c8);
        *(u32x4*)(rec + R_RT + rr * 128 + c8 * 2) = *(const LAS u32x4*)(LR + rr * 72 + c8); }
    f32x4 nab = {0.f, 0.f, 0.f, 0.f}, nak = nab, nrb = nab, nrk = nab;
#pragma unroll
    for (int ks = 0; ks < 2; ++ks) {
        const bf16x8 fa = *(const LAS bf16x8*)(LA + l15 * 72 + ks * 32 + quad * 8), fr_ = *(const LAS bf16x8*)(LR + l15 * 72 + ks * 32 + quad * 8);
        const bf16x8 fb = *(const LAS bf16x8*)(LB + l15 * 72 + ks * 32 + quad * 8), fk = *(const LAS bf16x8*)(LK + l15 * 72 + ks * 32 + quad * 8);
        nab = MFMA32(fa, fb, nab); nak = MFMA32(fa, fk, nak); nrb = MFMA32(fr_, fb, nrb); nrk = MFMA32(fr_, fk, nrk);
    }
#pragma unroll
    for (int r = 0; r < 4; ++r) {
        const int t = quad * 4 + r, j = l15;
        const float vab = (j < t) ? nab[r] : 0.f, vak = (j < t) ? nak[r] : 0.f, vrb = (j <= t) ? nrb[r] : 0.f, vrk = (j <= t) ? nrk[r] : 0.f;
        LN[t * 16 + j] = vab;
        *(bf16_t*)(rec + R_AAK + (t * 16 + j) * 2) = f2bf(vak);
        *(bf16_t*)(rec + R_ARB + (t * 16 + j) * 2) = f2bf(vrb);
        *(bf16_t*)(rec + R_ARK + (t * 16 + j) * 2) = f2bf(vrk);
    }
    LDS_WAIT();
    if (lane < 16) {
        float tc[16];
#pragma unroll
        for (int t = 0; t < 16; ++t) {
            float s = (t == lane) ? 1.f : 0.f;
#pragma unroll
            for (int j = 0; j < t; ++j) s += LN[t * 16 + j] * tc[j];
            tc[t] = s;
            *(bf16_t*)(rec + R_TT + (t * 16 + lane) * 2) = f2bf(s);
        }
    }
    LDS_WAIT();
}

struct ScanFr { bf16x8 at[2], rt[2]; bf16x8 aak, tt, arb, ark, vt, bp[4], kp[4]; float wc[4]; };
__device__ __forceinline__ bf16x8 ld_k16(const unsigned char* p, int quad) { u32x4 v = {0u, 0u, 0u, 0u}; if (quad < 2) v = *(const u32x4*)(p + quad * 16); return __builtin_bit_cast(bf16x8, v); }
__device__ __forceinline__ void scan_load(ScanFr& f, const unsigned char* rec, int vt, int l15, int quad) {
#pragma unroll
    for (int ks = 0; ks < 2; ++ks) { f.at[ks] = *(const bf16x8*)(rec + R_AT + l15 * 128 + ks * 64 + quad * 16); f.rt[ks] = *(const bf16x8*)(rec + R_RT + l15 * 128 + ks * 64 + quad * 16); }
    f.aak = ld_k16(rec + R_AAK + l15 * 32, quad); f.tt = ld_k16(rec + R_TT + l15 * 32, quad);
    f.arb = ld_k16(rec + R_ARB + l15 * 32, quad); f.ark = ld_k16(rec + R_ARK + l15 * 32, quad);
    f.vt = ld_k16(rec + R_VT + (vt * 16 + l15) * 32, quad);
#pragma unroll
    for (int nt = 0; nt < 4; ++nt) { f.bp[nt] = ld_k16(rec + R_BP + (nt * 16 + l15) * 32, quad); f.kp[nt] = ld_k16(rec + R_KP + (nt * 16 + l15) * 32, quad);
        f.wc[nt] = *(const float*)(rec + R_WC + (nt * 16 + l15) * 4); }
}
__device__ __forceinline__ bf16x8 lds_k16(const LAS bf16_t* p, int quad) { u32x4 v = {0u, 0u, 0u, 0u}; if (quad < 2) v = *(const LAS u32x4*)(p + quad * 8); return __builtin_bit_cast(bf16x8, v); }
__device__ __forceinline__ void rw_scan_task(const Args& a, LAS unsigned char* wl  , int b, int h, int vt, int lane) {
    unsigned char* ws = a.ws;
    const int l15 = lane & 15, quad = lane >> 4;
    LAS bf16_t* Sb = (LAS bf16_t*)wl;
    LAS bf16_t* Yb = (LAS bf16_t*)(wl + 2304);
    LAS bf16_t* Ub = (LAS bf16_t*)(wl + 2304 + 512);
    f32x4 S[4];
#pragma unroll
    for (int nt = 0; nt < 4; ++nt) { S[nt] = (f32x4){0.f, 0.f, 0.f, 0.f};
#pragma unroll
        for (int r = 0; r < 4; ++r) Sb[(quad * 4 + r) * 72 + nt * 16 + l15] = 0; }
    LDS_WAIT();
    const unsigned char* rec0 = ws + WS_CH + (size_t)((b * 16 + h) * 128) * REC;
    float* OB = (float*)(ws + WS_OB);
    ScanFr f, g;
    scan_load(f, rec0, vt, l15, quad);
    for (int ch = 0; ch < 128; ++ch) {
        scan_load(g, rec0 + (size_t)(ch < 127 ? ch + 1 : ch) * REC, vt, l15, quad);
        const bf16x8 sa0 = *(const LAS bf16x8*)(Sb + l15 * 72 + quad * 8), sa1 = *(const LAS bf16x8*)(Sb + l15 * 72 + 32 + quad * 8);
        f32x4 z = {0.f, 0.f, 0.f, 0.f};
        f32x4 Y = MFMA32(sa0, f.at[0], z); Y = MFMA32(sa1, f.at[1], Y); Y = MFMA32(f.vt, f.aak, Y);
#pragma unroll
        for (int r = 0; r < 4; ++r) Yb[(quad * 4 + r) * 16 + l15] = f2bf(Y[r]);
        LDS_WAIT();
        const bf16x8 ya = lds_k16(Yb + l15 * 16, quad);
        f32x4 U = MFMA32(ya, f.tt, z);
#pragma unroll
        for (int r = 0; r < 4; ++r) Ub[(quad * 4 + r) * 16 + l15] = f2bf(U[r]);
        LDS_WAIT();
        const bf16x8 ua = lds_k16(Ub + l15 * 16, quad);
        f32x4 O = MFMA32(sa0, f.rt[0], z); O = MFMA32(sa1, f.rt[1], O); O = MFMA32(ua, f.arb, O); O = MFMA32(f.vt, f.ark, O);
        *(f32x4*)(OB + (size_t)(b * T + ch * 16 + l15) * D + h * 64 + vt * 16 + quad * 4) = O;
#pragma unroll
        for (int nt = 0; nt < 4; ++nt) {
            f32x4 sn = S[nt] * f.wc[nt];
            sn = MFMA32(ua, f.bp[nt], sn); sn = MFMA32(f.vt, f.kp[nt], sn);
            S[nt] = sn;
#pragma unroll
            for (int r = 0; r < 4; ++r) Sb[(quad * 4 + r) * 72 + nt * 16 + l15] = f2bf(sn[r]);
        }
        LDS_WAIT();
        f = g;
    }
    float* so = a.out + OUT_RWP + (size_t)((b * 16 + h) * 64 + vt * 16) * 64;
#pragma unroll
    for (int nt = 0; nt < 4; ++nt)
#pragma unroll
        for (int r = 0; r < 4; ++r) so[(quad * 4 + r) * 64 + nt * 16 + l15] = S[nt][r];
}

__device__ __forceinline__ void rw_sample_unit(const Args& a, int i, int h, int tid) {
    unsigned char* ws = a.ws;
    const int row = tid >> 3, ks = tid & 7;
    const float* s0 = a.in[I_SRW] + ((size_t)(i * 16 + h) * 64 + row) * 64 + ks * 8;
    const float* op = (const float*)(ws + WS_OPSS) + (size_t)(i * 16 + h) * 6 * 64;
    float s[8], r_[8], w_[8], k_[8], kk[8], b_[8];
#pragma unroll
    for (int j = 0; j < 2; ++j) {
        const f32x4 sv = ((const f32x4*)s0)[j]; s[4 * j] = sv.x; s[4 * j + 1] = sv.y; s[4 * j + 2] = sv.z; s[4 * j + 3] = sv.w;
#define LD8(dst, slot) { const f32x4 t_ = ((const f32x4*)(op + (slot) * 64 + ks * 8))[j]; dst[4 * j] = t_.x; dst[4 * j + 1] = t_.y; dst[4 * j + 2] = t_.z; dst[4 * j + 3] = t_.w; }
        LD8(r_, 0) LD8(w_, 1) LD8(k_, 2) LD8(kk, 3) LD8(b_, 4)
#undef LD8
    }
    const float v = op[5 * 64 + row];
    float sk = 0.f;
#pragma unroll
    for (int j = 0; j < 8; ++j) sk += s[j] * kk[j];
    sk += __shfl_xor(sk, 1); sk += __shfl_xor(sk, 2); sk += __shfl_xor(sk, 4);
    float o = 0.f;
#pragma unroll
    for (int j = 0; j < 8; ++j) { s[j] = s[j] * w_[j] - sk * b_[j] + v * k_[j]; o += s[j] * r_[j]; }
    o += __shfl_xor(o, 1); o += __shfl_xor(o, 2); o += __shfl_xor(o, 4);
    float* so = a.out + OUT_RWS + ((size_t)(i * 16 + h) * 64 + row) * 64 + ks * 8;
    ((f32x4*)so)[0] = (f32x4){s[0], s[1], s[2], s[3]}; ((f32x4*)so)[1] = (f32x4){s[4], s[5], s[6], s[7]};
    if (ks == 0) ((float*)(ws + WS_OB))[(size_t)(MP + i) * D + h * 64 + row] = o;
}

constexpr int KN_LD = 264, VS_LD = 136, SS_LD = 264;
constexpr int L_KN = 0, L_VS = 128 * KN_LD * 2  , L_SS = L_VS + 64 * VS_LD * 2  , L_RET_END = L_SS + 64 * SS_LD * 2  ;
__device__ __forceinline__ void ret_unit(const Args& a, LAS unsigned char* lds, int unit, int tid) {
    unsigned char* ws = a.ws;
    const bf16_t* P = (const bf16_t*)(ws + WS_P);
    const int dvs = unit & 7, h = (unit >> 3) & 3, b = unit >> 5;
    const int wave = tid >> 6, lane = tid & 63, l15 = lane & 15, quad = lane >> 4;
    LAS bf16_t* KN = (LAS bf16_t*)(lds + L_KN); LAS bf16_t* VS = (LAS bf16_t*)(lds + L_VS); LAS bf16_t* SS = (LAS bf16_t*)(lds + L_SS);
    const float g = 1.f - exp2f(-5.f - (float)h), l2g = __log2f(g);
    const float gC = exp2f(128.f * l2g), ginvC = exp2f(-128.f * l2g);
    const bf16_t* KT = (const bf16_t*)(ws + WS_KT) + (size_t)(b * 4 + h) * 256 * T;
    f32x4 sacc[2][4];
#pragma unroll
    for (int n = 0; n < 2; ++n)
#pragma unroll
        for (int d = 0; d < 4; ++d) sacc[n][d] = (f32x4){0.f, 0.f, 0.f, 0.f};
    for (int i = tid; i < 64 * SS_LD / 2; i += 512) ((LAS unsigned*)SS)[i] = 0u;
    const int it = wave;
    for (int c = 0; c < 16; ++c) {
        const int tok0 = b * T + c * 128;
#pragma unroll
        for (int i = 0; i < 8; ++i) { const int idx = tid + 512 * i, r = idx >> 5, c8 = (idx & 31) * 8;
            *(LAS u32x4*)(KN + r * KN_LD + c8) = *(const u32x4*)(P + (size_t)(tok0 + r) * NP + O_K + h * 256 + c8); }
#pragma unroll
        for (int i = 0; i < 2; ++i) { const int idx = tid + 512 * i, r = idx >> 4, c8 = (idx & 15) * 8;
            *(LAS u32x4*)(VS + r * VS_LD + c8) = *(const u32x4*)(P + (size_t)(b * T + h * 512 + dvs * 64 + r) * NP + O_V + c * 128 + c8); }
        bf16x8 qf[8];
#pragma unroll
        for (int ks = 0; ks < 8; ++ks) qf[ks] = *(const bf16x8*)(P + (size_t)(tok0 + it * 16 + l15) * NP + h * 256 + ks * 32 + quad * 8);
        bf16x8 ktf[2][4];
#pragma unroll
        for (int n = 0; n < 2; ++n)
#pragma unroll
            for (int ks = 0; ks < 4; ++ks) ktf[n][ks] = *(const bf16x8*)(KT + (size_t)((2 * wave + n) * 16 + l15) * T + c * 128 + ks * 32 + quad * 8);
        __syncthreads();
        f32x4 oacc[4];
#pragma unroll
        for (int d = 0; d < 4; ++d) oacc[d] = (f32x4){0.f, 0.f, 0.f, 0.f};
#pragma unroll
        for (int ks = 0; ks < 8; ++ks)
#pragma unroll
            for (int d = 0; d < 4; ++d) { const bf16x8 sb = *(const LAS bf16x8*)(SS + (d * 16 + l15) * SS_LD + ks * 32 + quad * 8); oacc[d] = MFMA32(qf[ks], sb, oacc[d]); }
#pragma unroll
        for (int p = 0; p < 4; ++p) {
            if (2 * p <= it) {
                f32x4 s0 = {0.f, 0.f, 0.f, 0.f}, s1 = {0.f, 0.f, 0.f, 0.f};
#pragma unroll
                for (int ks = 0; ks < 8; ++ks) { const bf16x8 ka = *(const LAS bf16x8*)(KN + ((2 * p) * 16 + l15) * KN_LD + ks * 32 + quad * 8); s0 = MFMA32(ka, qf[ks], s0); }
                if (2 * p + 1 <= it) {
#pragma unroll
                    for (int ks = 0; ks < 8; ++ks) { const bf16x8 ka = *(const LAS bf16x8*)(KN + ((2 * p + 1) * 16 + l15) * KN_LD + ks * 32 + quad * 8); s1 = MFMA32(ka, qf[ks], s1); }
                }
#pragma unroll
                for (int r = 0; r < 4; ++r) {
                    const int jl = quad * 4 + r;
                    s0[r] = (2 * p == it && jl > l15) ? 0.f : s0[r] * ginvC;
                    s1[r] = (2 * p + 1 > it || (2 * p + 1 == it && jl > l15)) ? 0.f : s1[r] * ginvC;
                }
                u32x4 aw; aw.x = pk2(s0[0], s0[1]); aw.y = pk2(s0[2], s0[3]); aw.z = pk2(s1[0], s1[1]); aw.w = pk2(s1[2], s1[3]);
                const bf16x8 af = __builtin_bit_cast(bf16x8, aw);
#pragma unroll
                for (int d = 0; d < 4; ++d) {
                    const LAS bf16_t* vr = VS + (d * 16 + l15) * VS_LD + 32 * p + quad * 4;
                    const u32x2 lo = *(const LAS u32x2*)vr, hi = *(const LAS u32x2*)(vr + 16);
                    const u32x4 bw = {lo.x, lo.y, hi.x, hi.y};
                    oacc[d] = MFMA32(af, __builtin_bit_cast(bf16x8, bw), oacc[d]);
                }
            }
        }
        {
            bf16_t* OA = (bf16_t*)(ws + WS_OA); float* SQA = (float*)(ws + WS_SQA);
#pragma unroll
            for (int r = 0; r < 4; ++r) {
                const int tok = tok0 + it * 16 + quad * 4 + r;
                float ss = 0.f;
#pragma unroll
                for (int d = 0; d < 4; ++d) { const float v = oacc[d][r]; ss += v * v; OA[(size_t)tok * 2048 + h * 512 + dvs * 64 + d * 16 + l15] = f2bf(v); }
#pragma unroll
                for (int o = 1; o < 16; o <<= 1) ss += __shfl_xor(ss, o);
                if (l15 == 0) SQA[(size_t)tok * 32 + h * 8 + dvs] = ss;
            }
        }
        __syncthreads();
#pragma unroll
        for (int n = 0; n < 2; ++n)
#pragma unroll
            for (int d = 0; d < 4; ++d) {
                f32x4 s = sacc[n][d] * gC;
#pragma unroll
                for (int ks = 0; ks < 4; ++ks) { const bf16x8 va = *(const LAS bf16x8*)(VS + (d * 16 + l15) * VS_LD + ks * 32 + quad * 8); s = MFMA32(va, ktf[n][ks], s); }
                sacc[n][d] = s;
#pragma unroll
                for (int r = 0; r < 4; ++r) SS[(d * 16 + quad * 4 + r) * SS_LD + (2 * wave + n) * 16 + l15] = f2bf(s[r]);
            }
        __syncthreads();
    }
    float* so = a.out + OUT_RETP + (size_t)(b * 4 + h) * 256 * 512;
#pragma unroll
    for (int n = 0; n < 2; ++n)
#pragma unroll
        for (int d = 0; d < 4; ++d) *(f32x4*)(so + (size_t)((2 * wave + n) * 16 + l15) * 512 + dvs * 64 + d * 16 + quad * 4) = sacc[n][d];
}

__device__ __forceinline__ void ret_sample_unit(const Args& a, LAS unsigned char* lds, int i, int h, int tid) {
    unsigned char* ws = a.ws;
    const bf16_t* Prow = (const bf16_t*)(ws + WS_P) + (size_t)(MP + i) * NP;
    LAS float* Q = (LAS float*)lds; LAS float* Kh = Q + 256; LAS float* RED = Kh + 256; LAS float* OS = RED + 16;
    const float g = 1.f - exp2f(-5.f - (float)h);
    const int lane = tid & 63, wave = tid >> 6;
    float qk = 0.f;
    if (tid < 256) { const float q = bf2f(Prow[h * 256 + tid]), k = bf2f(Prow[O_K + h * 256 + tid]); Q[tid] = q; Kh[tid] = k; qk = q * k; }
    qk = wave_sum(qk);
    if (lane == 0) RED[wave] = qk;
    __syncthreads();
    const float qkv = (RED[0] + RED[1] + RED[2] + RED[3]) / g;
    const int dkg = tid >> 7, dv4 = 4 * (tid & 127);
    const u32x2 vw = *(const u32x2*)(Prow + O_V + h * 512 + dv4);
    const f32x4 v = {bflo(vw.x), bfhi(vw.x), bflo(vw.y), bfhi(vw.y)};
    const float* s0 = a.in[I_SRET] + (size_t)(i * 4 + h) * 256 * 512 + dv4;
    float* s1 = a.out + OUT_RETS + (size_t)(i * 4 + h) * 256 * 512 + dv4;
    f32x4 o = {0.f, 0.f, 0.f, 0.f};
#pragma unroll 8
    for (int j = 0; j < 64; ++j) {
        const int dk = dkg * 64 + j;
        const f32x4 s = __builtin_nontemporal_load((const f32x4*)(s0 + (size_t)dk * 512));
        o += s * Q[dk];
        __builtin_nontemporal_store(s * g + v * Kh[dk], (f32x4*)(s1 + (size_t)dk * 512));
    }
    *(LAS f32x4*)(OS + dkg * 512 + dv4) = o;
    __syncthreads();
    float y[4] = {0.f, 0.f, 0.f, 0.f}; float ss = 0.f;
    if (tid < 128) {
        const f32x4 t = *(LAS f32x4*)(OS + dv4) + *(LAS f32x4*)(OS + 512 + dv4) + *(LAS f32x4*)(OS + 1024 + dv4) + *(LAS f32x4*)(OS + 1536 + dv4) + v * qkv;
        y[0] = t.x; y[1] = t.y; y[2] = t.z; y[3] = t.w; ss = t.x * t.x + t.y * t.y + t.z * t.z + t.w * t.w;
    }
    ss = wave_sum(ss);
    if (lane == 0) RED[8 + wave] = ss;
    __syncthreads();
    if (tid < 128) {
        const float rs = 1.0f / sqrtf((RED[8] + RED[9]) * (1.f / 512.f) + EPS);
        const u32x2 gw = *(const u32x2*)(Prow + O_GA + h * 512 + dv4);
        u32x2 ow; ow.x = pk2(y[0] * rs * bflo(gw.x), y[1] * rs * bfhi(gw.x)); ow.y = pk2(y[2] * rs * bflo(gw.y), y[3] * rs * bfhi(gw.y));
        *(u32x2*)((bf16_t*)(ws + WS_OA) + (size_t)(MP + i) * 2048 + h * 512 + dv4) = ow;
    }
    __syncthreads();
}

__device__ __forceinline__ void phase25_row(const Args& a, int m, int lane) {
    unsigned char* ws = a.ws;
    const bf16_t* Prow = (const bf16_t*)(ws + WS_P) + (size_t)m * NP;
    if (m < MP) {
        bf16_t* oa = (bf16_t*)(ws + WS_OA) + (size_t)m * 2048;
        const float* sq = (const float*)(ws + WS_SQA) + (size_t)m * 32;
#pragma unroll
        for (int hh = 0; hh < 4; ++hh) {
            const f32x4 s0 = *(const f32x4*)(sq + hh * 8), s1 = *(const f32x4*)(sq + hh * 8 + 4);
            const float rs = 1.0f / sqrtf(((s0.x + s0.y) + (s0.z + s0.w) + (s1.x + s1.y) + (s1.z + s1.w)) * (1.f / 512.f) + EPS);
            const u32x4 ow = *(const u32x4*)(oa + hh * 512 + lane * 8), gw = *(const u32x4*)(Prow + O_GA + hh * 512 + lane * 8);
            u32x4 r;
            r.x = pk2(bflo(ow.x) * rs * bflo(gw.x), bfhi(ow.x) * rs * bfhi(gw.x)); r.y = pk2(bflo(ow.y) * rs * bflo(gw.y), bfhi(ow.y) * rs * bfhi(gw.y));
            r.z = pk2(bflo(ow.z) * rs * bflo(gw.z), bfhi(ow.z) * rs * bfhi(gw.z)); r.w = pk2(bflo(ow.w) * rs * bflo(gw.w), bfhi(ow.w) * rs * bfhi(gw.w));
            *(u32x4*)(oa + hh * 512 + lane * 8) = r;
        }
    }
    const float* ob = (const float*)(ws + WS_OB) + (size_t)m * D + lane * 16;
    float o[16];
#pragma unroll
    for (int j = 0; j < 4; ++j) { const f32x4 t = ((const f32x4*)ob)[j]; o[4 * j] = t.x; o[4 * j + 1] = t.y; o[4 * j + 2] = t.z; o[4 * j + 3] = t.w; }
    float s = 0.f;
#pragma unroll
    for (int j = 0; j < 16; ++j) s += o[j];
    s += __shfl_xor(s, 1); s += __shfl_xor(s, 2);
    const float mean = s * (1.f / 64.f);
    float q = 0.f;
#pragma unroll
    for (int j = 0; j < 16; ++j) { const float d = o[j] - mean; q += d * d; }
    q += __shfl_xor(q, 1); q += __shfl_xor(q, 2);
    const float rstd = 1.0f / sqrtf(q * (1.f / 64.f) + 64e-5f);
    const float bc = ((const float*)(ws + WS_BC))[(size_t)m * 16 + (lane >> 2)];
    const bf16_t* cur = Prow + O_SH + 2048 + lane * 16;
    const bf16_t* prv = (m >= MP) ? cur + (size_t)MS * NP : ((m & (T - 1)) ? cur - NP : nullptr);
    const bf16_t* gb = Prow + O_GB + lane * 16;
    const float* lnw = a.in[I_LNW] + lane * 16; const float* lnb = a.in[I_LNB] + lane * 16; const float* muv = a.in[I_MU] + 2048 + lane * 16;
    unsigned outw[8];
#pragma unroll
    for (int j = 0; j < 8; ++j) {
        float y[2];
#pragma unroll
        for (int e = 0; e < 2; ++e) {
            const int cix = 2 * j + e;
            const float c = bf2f(cur[cix]), p = prv ? bf2f(prv[cix]) : 0.f;
            const float vz = c + (p - c) * muv[cix];
            y[e] = ((o[cix] - mean) * rstd * lnw[cix] + lnb[cix] + bc * vz) * bf2f(gb[cix]);
        }
        outw[j] = pk2(y[0], y[1]);
    }
    bf16_t* yb = (bf16_t*)(ws + WS_H) + (size_t)m * D + lane * 16;
    *(u32x4*)yb = (u32x4){outw[0], outw[1], outw[2], outw[3]}; *(u32x4*)(yb + 8) = (u32x4){outw[4], outw[5], outw[6], outw[7]};
}

struct EpiT1 {
    static constexpr bool PERM = false;
    const bf16_t* P; float* T1;
    __device__ __forceinline__ void operator()(const f32x4 (&acc)[2][2][4][2], const Unit& u, int wr, int wc, int fr, int fq) const {
        const int row0 = u.pm * 256 + wr * 64 + fr, col0 = u.pn * 256 + wc * 32 + 4 * fq;
#pragma unroll
        for (int ai = 0; ai < 2; ++ai)
#pragma unroll
            for (int m = 0; m < 4; ++m) { const int row = row0 + ai * 128 + m * 16; if (row >= MR) continue;
#pragma unroll
                for (int bj = 0; bj < 2; ++bj)
#pragma unroll
                    for (int n = 0; n < 2; ++n) { const int col = col0 + bj * 128 + n * 16;
                        const u32x2 gw = *(const u32x2*)(P + (size_t)row * NP + O_MA + col);
                        const f32x4 gt = {bflo(gw.x), bfhi(gw.x), bflo(gw.y), bfhi(gw.y)};
                        *(f32x4*)(T1 + (size_t)row * D + col) = acc[ai][bj][m][n] * gt; } asm volatile("" ::: "memory"); }
    }
};
struct EpiMG {
    static constexpr bool PERM = false;
    const bf16_t* P; const float* T1; bf16_t* MG;
    __device__ __forceinline__ void operator()(const f32x4 (&acc)[2][2][4][2], const Unit& u, int wr, int wc, int fr, int fq) const {
        const int row0 = u.pm * 256 + wr * 64 + fr, col0 = u.pn * 256 + wc * 32 + 4 * fq;
#pragma unroll
        for (int ai = 0; ai < 2; ++ai)
#pragma unroll
            for (int m = 0; m < 4; ++m) { const int row = row0 + ai * 128 + m * 16; if (row >= MR) continue;
#pragma unroll
                for (int bj = 0; bj < 2; ++bj)
#pragma unroll
                    for (int n = 0; n < 2; ++n) { const int col = col0 + bj * 128 + n * 16;
                        const u32x2 gw = *(const u32x2*)(P + (size_t)row * NP + O_MB + col);
                        const f32x4 gt = {bflo(gw.x), bfhi(gw.x), bflo(gw.y), bfhi(gw.y)};
                        const f32x4 v = *(const f32x4*)(T1 + (size_t)row * D + col) + acc[ai][bj][m][n] * gt;
                        *(u32x2*)(MG + (size_t)row * D + col) = (u32x2){pk2(v.x, v.y), pk2(v.z, v.w)}; } asm volatile("" ::: "memory"); }
    }
};
struct EpiX1 {
    static constexpr bool PERM = false;
    const float* xp; const float* xs; float* X1; bf16_t* X1B; float* SQ;
    __device__ __forceinline__ void operator()(const f32x4 (&acc)[2][2][4][2], const Unit& u, int wr, int wc, int fr, int fq) const {
        const int row0 = u.pm * 256 + wr * 64 + fr, col0 = u.pn * 256 + wc * 32 + 4 * fq;
#pragma unroll
        for (int ai = 0; ai < 2; ++ai)
#pragma unroll
            for (int m = 0; m < 4; ++m) { const int row = row0 + ai * 128 + m * 16; const bool ok = row < MR;
                const float* xr = (row < MP) ? xp + (size_t)row * D : xs + (size_t)(row - MP) * D;
                float ss = 0.f;
                if (ok) {
#pragma unroll
                    for (int bj = 0; bj < 2; ++bj)
#pragma unroll
                        for (int n = 0; n < 2; ++n) { const int col = col0 + bj * 128 + n * 16;
                            const f32x4 v = *(const f32x4*)(xr + col) + acc[ai][bj][m][n];
                            ss += (v.x * v.x + v.y * v.y) + (v.z * v.z + v.w * v.w);
                            *(f32x4*)(X1 + (size_t)row * D + col) = v;
                            *(u32x2*)(X1B + (size_t)row * D + col) = (u32x2){pk2(v.x, v.y), pk2(v.z, v.w)}; }
                }
                ss += __shfl_xor(ss, 16); ss += __shfl_xor(ss, 32);
                if (ok && fq == 0) SQ[(size_t)row * 16 + u.pn * 4 + wc] = ss; asm volatile("" ::: "memory"); }
    }
};
struct EpiGT {
    static constexpr bool PERM = false;
    const float* SQ; float* GT;
    __device__ __forceinline__ void operator()(const f32x4 (&acc)[2][2][4][2], const Unit& u, int wr, int wc, int fr, int fq) const {
        const int row0 = u.pm * 256 + wr * 64 + fr, col0 = u.pn * 256 + wc * 32 + 4 * fq;
#pragma unroll
        for (int ai = 0; ai < 2; ++ai)
#pragma unroll
            for (int m = 0; m < 4; ++m) { const int row = row0 + ai * 128 + m * 16; if (row >= MR) continue;
                const f32x4* sp = (const f32x4*)(SQ + (size_t)row * 16); const f32x4 q0 = sp[0], q1 = sp[1], q2 = sp[2], q3 = sp[3];
                const float rs = 1.0f / sqrtf((((q0.x + q0.y) + (q0.z + q0.w)) + ((q1.x + q1.y) + (q1.z + q1.w)) + ((q2.x + q2.y) + (q2.z + q2.w)) + ((q3.x + q3.y) + (q3.z + q3.w))) * (1.f / D) + EPS);
#pragma unroll
                for (int bj = 0; bj < 2; ++bj)
#pragma unroll
                    for (int n = 0; n < 2; ++n) { const int col = col0 + bj * 128 + n * 16; const f32x4 t = acc[ai][bj][m][n] * rs;
                        *(f32x4*)(GT + (size_t)row * D + col) = (f32x4){sigm(t.x), sigm(t.y), sigm(t.z), sigm(t.w)}; } asm volatile("" ::: "memory"); }
    }
};
struct EpiX2 {
    static constexpr bool PERM = false;
    const float* X1; const float* GT; float* out; float* SQ;
    __device__ __forceinline__ void operator()(const f32x4 (&acc)[2][2][4][2], const Unit& u, int wr, int wc, int fr, int fq) const {
        const int row0 = u.pm * 256 + wr * 64 + fr, col0 = u.pn * 256 + wc * 32 + 4 * fq;
#pragma unroll
        for (int ai = 0; ai < 2; ++ai)
#pragma unroll
            for (int m = 0; m < 4; ++m) { int row = row0 + ai * 128 + m * 16; asm volatile("" : "+v"(row)); const bool ok = row < MR;
                float ss = 0.f;
                if (ok) {
#pragma unroll
                    for (int bj = 0; bj < 2; ++bj)
#pragma unroll
                        for (int n = 0; n < 2; ++n) { const int col = col0 + bj * 128 + n * 16;
                            const f32x4 v = *(const f32x4*)(X1 + (size_t)row * D + col) + acc[ai][bj][m][n] * *(const f32x4*)(GT + (size_t)row * D + col);
                            ss += (v.x * v.x + v.y * v.y) + (v.z * v.z + v.w * v.w);
                            *(f32x4*)(out + (size_t)row * D + col) = v; asm volatile("" ::: "memory"); }
                }
                ss += __shfl_xor(ss, 16); ss += __shfl_xor(ss, 32);
                if (ok && fq == 0) SQ[(size_t)row * 16 + u.pn * 4 + wc] = ss; asm volatile("" ::: "memory"); }
    }
};


#define XB_TMO      128
#define XB_XCNT(j)  (256  + 64 * (j))
#define XB_XSUB(j)  (1280 + 64 * (j))
#define XB_XGEN(j)  (2304 + 64 * (j))
#define XB_TOP      3328
#define XB_TOPGEN   3392
#define XCD_BAR_WORDS 3456
#define XB_SPIN_CAP (1u << 22)
__device__ __forceinline__ unsigned xb_ld(unsigned* p)              { return __hip_atomic_load(p, __ATOMIC_RELAXED, __HIP_MEMORY_SCOPE_AGENT); }
__device__ __forceinline__ unsigned xb_add(unsigned* p, unsigned v) { return __hip_atomic_fetch_add(p, v, __ATOMIC_RELAXED, __HIP_MEMORY_SCOPE_AGENT); }
__device__ __forceinline__ unsigned xb_xcc_id() { return (unsigned)__builtin_amdgcn_s_getreg((3 << 11) | 20) & 0xFu; }
#define XB_SPIN(cond, bar) do { unsigned _sp = 0; while (cond) { __builtin_amdgcn_s_sleep(1); \
    if ((++_sp & 255u) == 0u) { if (xb_ld(&(bar)[XB_TMO])) break; if (_sp > XB_SPIN_CAP) { atomicAdd(&(bar)[XB_TMO], 1u); break; } } } } while (0)
struct XcdBarrier { unsigned* bar; unsigned x; volatile LAS unsigned* st; };
__device__ __forceinline__ XcdBarrier xcd_barrier_post(unsigned* bar, volatile LAS unsigned* st) {
    XcdBarrier b; b.bar = bar; b.x = xb_xcc_id(); b.st = st;
    if (threadIdx.x == 0) (void)xb_add(&bar[XB_XCNT(b.x)], 1u);
    return b;
}
__device__ __forceinline__ void xcd_barrier_complete(unsigned* bar, unsigned x, unsigned& nloc, unsigned& nx) {
    const unsigned G = gridDim.x * gridDim.y * gridDim.z;
    unsigned sum, cnt, mine, sp = 0u;
    for (;;) {
        sum = 0u; cnt = 0u; mine = 0u;
#pragma unroll
        for (unsigned j = 0; j < 16; ++j) { const unsigned c = xb_ld(&bar[XB_XCNT(j)]); sum += c; cnt += (c > 0u) ? 1u : 0u; mine = (j == x) ? c : mine; }
        if (sum == G) break;
        __builtin_amdgcn_s_sleep(1);
        if ((++sp & 255u) == 0u) { if (xb_ld(&bar[XB_TMO])) break; if (sp > XB_SPIN_CAP) { atomicAdd(&bar[XB_TMO], 1u); break; } }
    }
    nloc = mine > 0u ? mine : 1u; nx = cnt > 0u ? cnt : 1u;
}
__device__ __forceinline__ void xcd_barrier(const XcdBarrier& b) {
    asm volatile("s_waitcnt vmcnt(0)" ::: "memory");
    __syncthreads();
    if (threadIdx.x == 0) {
        unsigned* bar = b.bar;
        __builtin_amdgcn_s_waitcnt(0);
        unsigned nloc = b.st[0], nx = b.st[1];
        if (nloc == 0u) { xcd_barrier_complete(bar, b.x, nloc, nx); b.st[0] = nloc; b.st[1] = nx; }
        const unsigned old = xb_add(&bar[XB_XSUB(b.x)], 1u);
        const unsigned gen = old / nloc;
        if (old + 1u == (gen + 1u) * nloc) {
            __builtin_amdgcn_fence(__ATOMIC_RELEASE, "agent");
            asm volatile("s_waitcnt vmcnt(0)" ::: "memory");
            const unsigned og = xb_add(&bar[XB_TOP], 1u);
            const unsigned tg = og / nx;
            if (og + 1u == (tg + 1u) * nx) xb_add(&bar[XB_TOPGEN], 1u);
            else XB_SPIN(xb_ld(&bar[XB_TOPGEN]) == tg, bar);
            __builtin_amdgcn_fence(__ATOMIC_ACQUIRE, "agent");
            xb_add(&bar[XB_XGEN(b.x)], 1u);
            asm volatile("s_waitcnt vmcnt(0)" ::: "memory");
        } else {
            XB_SPIN(xb_ld(&bar[XB_XGEN(b.x)]) == gen, bar);
            __builtin_amdgcn_fence(__ATOMIC_ACQUIRE, "agent");
            asm volatile("s_waitcnt vmcnt(0)" ::: "memory");
        }
    }
    __syncthreads();
}

constexpr int LDS_BYTES = 147456;
constexpr int CTL_SQ1 = 0, CTL_SQ2 = 32768, CTL_CNT = 65536;

#define GRID_SYNC() xcd_barrier(xbar)
__global__ void __launch_bounds__(512, 2) fwd_mega(Args a) {
    extern __shared__ __attribute__((aligned(16))) unsigned char lds_raw[];
    LAS unsigned char* lds = (LAS unsigned char*)lds_raw;
    cg::grid_group grid = cg::this_grid();
    const int tid = threadIdx.x, lane = tid & 63, wave = __builtin_amdgcn_readfirstlane(tid >> 6);
    const int G = gridDim.x, bx = blockIdx.x;
    const int gw = bx * 8 + wave, NGW = G * 8;
    unsigned char* ws = a.ws;
    if (tid < 16) ((LAS unsigned*)(lds + 131072 + 64))[tid] = 0u;
    __syncthreads();
    XcdBarrier xbar = xcd_barrier_post((unsigned*)(ws + WS_BAR), (volatile LAS unsigned*)(lds + 131072 + 64));
    grid.sync();

#if !defined(ONLY_PH) || ONLY_PH == 0
    phase0(a, lds, gw, NGW, wave, lane);
    GRID_SYNC();
#endif
#if !defined(ONLY_PH) || ONLY_PH == 1
    {
        pg8::Gemm g{(const bf16_t*)(ws + WS_H), (const bf16_t*)(ws + WS_WIN), MALL, NP, D}; pg8::StaticOrder S; S.init(MALL, NP, G, bx);
        EpiP E{(bf16_t*)(ws + WS_P), (bf16_t*)(ws + WS_KT), (const f32x2*)(ws + WS_ROPE)};
        pg8::gemm_phase<EpiP>(lds, g, S, E);
    }
    GRID_SYNC();
#endif
#if !defined(ONLY_PH) || ONLY_PH == 2
    for (int it = gw; it < 1032 * 16; it += NGW) rw_prep_item(a, lds + wave * 10240, it >> 4, it & 15, lane);
    GRID_SYNC();
#endif
#if !defined(ONLY_PH) || ONLY_PH == 3
    {
        if (bx < 128 && wave < 4) rw_scan_task(a, lds + wave * 4096, bx >> 4, bx & 15, wave, lane);
        __syncthreads();
        for (int u = bx; u < 256; u += G) ret_unit(a, lds, u, tid);
        for (int u = bx; u < MS * 4; u += G) ret_sample_unit(a, lds, u >> 2, u & 3, tid);
        for (int u = bx; u < MS * 16; u += G) rw_sample_unit(a, u >> 4, u & 15, tid);
    }
    GRID_SYNC();
#endif
#if !defined(ONLY_PH) || ONLY_PH == 4
    for (int m = gw; m < MR; m += NGW) phase25_row(a, m, lane);
    GRID_SYNC();
#endif
#if !defined(ONLY_PH) || ONLY_PH == 5
    {
        pg8::StaticOrder S; S.init(MALL, D, G, bx);
        { pg8::Gemm g{(const bf16_t*)(ws + WS_OA), (const bf16_t*)(ws + WS_WDA), MALL, D, 2048}; EpiT1 E{(const bf16_t*)(ws + WS_P), (float*)(ws + WS_T1)}; pg8::gemm_phase<EpiT1>(lds, g, S, E); }
        { pg8::Gemm g{(const bf16_t*)(ws + WS_H), (const bf16_t*)(ws + WS_WDB), MALL, D, D}; EpiMG E{(const bf16_t*)(ws + WS_P), (const float*)(ws + WS_T1), (bf16_t*)(ws + WS_MG)}; pg8::gemm_phase<EpiMG>(lds, g, S, E); }
    }
    GRID_SYNC();
#endif
#if !defined(ONLY_PH) || ONLY_PH == 6
    {
        pg8::StaticOrder S; S.init(MALL, D, G, bx);
        pg8::Gemm g{(const bf16_t*)(ws + WS_MG), (const bf16_t*)(ws + WS_WOUT), MALL, D, D};
        EpiX1 E{a.in[I_XP], a.in[I_XS], (float*)(ws + WS_X1), (bf16_t*)(ws + WS_X1B), (float*)(ws + WS_SQ1P)};
        pg8::gemm_phase<EpiX1>(lds, g, S, E);
    }
    GRID_SYNC();
#endif
#if !defined(ONLY_PH) || ONLY_PH == 7
    {
        pg8::StaticOrder S; S.init(MALL, D, G, bx);
        { pg8::Gemm g{(const bf16_t*)(ws + WS_X1B), (const bf16_t*)(ws + WS_WGATE), MALL, D, D}; EpiGT E{(const float*)(ws + WS_SQ1P), (float*)(ws + WS_GT)}; pg8::gemm_phase<EpiGT>(lds, g, S, E); }
        { pg8::Gemm g{(const bf16_t*)(ws + WS_PB), (const bf16_t*)(ws + WS_WPLE), MALL, D, PLE}; EpiX2 E{(const float*)(ws + WS_X1), (const float*)(ws + WS_GT), a.out + OUT_Y, (float*)(ws + WS_SQ2P)}; pg8::gemm_phase<EpiX2>(lds, g, S, E); }
    }
    GRID_SYNC();
#endif
#if !defined(ONLY_PH) || ONLY_PH == 8
    {
        const float* sq2 = (const float*)(ws + WS_SQ2P); const float* fg = a.in[I_FNG];
        for (int m = gw; m < MR; m += NGW) {
            const f32x4* sp = (const f32x4*)(sq2 + (size_t)m * 16); const f32x4 q0 = sp[0], q1 = sp[1], q2 = sp[2], q3 = sp[3];
            const float rs = 1.0f / sqrtf((((q0.x + q0.y) + (q0.z + q0.w)) + ((q1.x + q1.y) + (q1.z + q1.w)) + ((q2.x + q2.y) + (q2.z + q2.w)) + ((q3.x + q3.y) + (q3.z + q3.w))) * (1.f / D) + EPS);
            f32x4* o = (f32x4*)(a.out + OUT_Y + (size_t)m * D);
#pragma unroll
            for (int j = 0; j < 4; ++j) o[lane + 64 * j] = o[lane + 64 * j] * rs * ((const f32x4*)fg)[lane + 64 * j];
        }
    }
#endif

}

extern "C" void kernel_launch(void* const* d_in, const int* in_sizes, int n_in, void* d_out, int out_size, void* d_ws, size_t ws_size, hipStream_t stream) {
    static int grid = 0;
    if (grid == 0) {
        if (n_in != 26 || ws_size < WS_END) { fprintf(stderr, "kernel_launch: unexpected n_in %d or ws_size %zu (need %zu)\n", n_in, ws_size, (size_t)WS_END); grid = -1; return; }
        int dev = 0, cus = 0, per_cu = 0;
        hipGetDevice(&dev); hipDeviceGetAttribute(&cus, hipDeviceAttributeMultiprocessorCount, dev);
        if (hipFuncSetAttribute((const void*)fwd_mega, hipFuncAttributeMaxDynamicSharedMemorySize, LDS_BYTES) != hipSuccess) { fprintf(stderr, "kernel_launch: hipFuncSetAttribute failed\n"); grid = -1; return; }
        hipOccupancyMaxActiveBlocksPerMultiprocessor(&per_cu, (const void*)fwd_mega, 512, LDS_BYTES);
        if (per_cu < 1) { fprintf(stderr, "kernel_launch: occupancy query says %d blocks per CU\n", per_cu); per_cu = 1; }
        (void)hipGetLastError();
        grid = cus * 1;
        fprintf(stderr, "kernel_launch: grid %d (cus %d, per_cu %d), ws %zu\n", grid, cus, per_cu, ws_size);
    }
    if (grid < 0) return;
    Args a{};
    for (int i = 0; i < 26; ++i) a.in[i] = (const float*)d_in[i];
    a.out = (float*)d_out; a.ws = (unsigned char*)d_ws;
    if (hipMemsetAsync((char*)d_ws + WS_BAR, 0, XCD_BAR_WORDS * 4, stream) != hipSuccess) { fprintf(stderr, "kernel_launch: memset failed\n"); return; }
    void* args[] = {&a};
    hipError_t e = hipLaunchCooperativeKernel((const void*)fwd_mega, dim3(grid), dim3(512), args, LDS_BYTES, stream);
    if (e != hipSuccess) fprintf(stderr, "kernel_launch: cooperative launch failed: %s\n", hipGetErrorString(e));
}
```

```cpp
#include <hip/hip_runtime.h>
#include <hip/hip_cooperative_groups.h>
#include <cstdio>
#include <cstdint>
namespace cg = cooperative_groups;

#define LAS __attribute__((address_space(3)))
typedef unsigned short bf16_t;
typedef short bf16x8 __attribute__((ext_vector_type(8)));
typedef short bf16x4 __attribute__((ext_vector_type(4)));
typedef float f32x4 __attribute__((ext_vector_type(4)));
typedef float f32x2 __attribute__((ext_vector_type(2)));
typedef unsigned u32x4 __attribute__((ext_vector_type(4)));
typedef unsigned u32x2 __attribute__((ext_vector_type(2)));
typedef __bf16 nbf2 __attribute__((ext_vector_type(2)));

constexpr int D = 1024, NB = 8, T = 2048, MP = NB * T  , MS = 128, MR = MP + MS  , MALL = 16640  ;
constexpr int NCOLS = 12416, NP = 12544  ;
constexpr int O_K = 1024, O_V = 2048, O_GA = 4096, O_SH = 6144, O_GB = 9344, O_MA = 10368, O_MB = 11392;
constexpr int RH = 4, RDK = 256, RDV = 512, RCH = 128;
constexpr int WH = 16, WN = 64;
constexpr int PLE = 256;
constexpr float EPS = 1e-6f;
constexpr int REC = 12544;
constexpr int R_AT = 0, R_RT = 2048, R_BP = 4096, R_KP = 6144, R_VT = 8192, R_AAK = 10240, R_TT = 10752, R_ARB = 11264, R_ARK = 11776, R_WC = 12288;

constexpr size_t MiB = 1u << 20;
constexpr size_t WS_CTL = 0;
constexpr size_t WS_ROPE = 1 * MiB;
constexpr size_t WS_W2T = 4 * MiB, WS_A2T = WS_W2T + 131072;
constexpr size_t WS_WPLE = 5 * MiB, WS_WDB = 6 * MiB, WS_WOUT = 8 * MiB, WS_WGATE = 10 * MiB, WS_WDA = 12 * MiB, WS_WIN = 16 * MiB;
constexpr size_t WS_PB = 41 * MiB, WS_H = 50 * MiB  , WS_KT = 83 * MiB, WS_SQA = 115 * MiB, WS_BC = 117 * MiB, WS_OPSS = 119 * MiB  ;
constexpr size_t WS_OA = 122 * MiB, WS_P = 188 * MiB, WS_CH = 587 * MiB  , WS_OB = 786 * MiB  ;
constexpr size_t WS_T1 = WS_CH, WS_MG = WS_CH + 65 * MiB, WS_X1B = WS_CH + 98 * MiB, WS_GT = WS_CH + 131 * MiB, WS_X1 = WS_OB + 65 * MiB  ;
constexpr size_t WS_END = 916 * MiB;
constexpr size_t WS_BAR = 512 * 1024;
constexpr size_t WS_SQS1 = 640 * 1024, WS_SQS2 = 704 * 1024;
constexpr size_t WS_SQ1P = WS_KT, WS_SQ2P = WS_KT + 2 * MiB;

constexpr size_t OUT_Y = 0, OUT_RETP = 16908288, OUT_RWP = 21102592, OUT_SHP = 21626880, OUT_RETS = 21635072, OUT_RWS = 88743936, OUT_SHS = 97132544;

__device__ __forceinline__ unsigned pk2(float lo, float hi) { f32x2 v = {lo, hi}; nbf2 r = __builtin_convertvector(v, nbf2); return __builtin_bit_cast(unsigned, r); }
__device__ __forceinline__ unsigned short f2bf(float f) { return (unsigned short)(pk2(f, 0.f) & 0xffffu); }
__device__ __forceinline__ float bf2f(unsigned short b) { return __uint_as_float(((unsigned)b) << 16); }
__device__ __forceinline__ float bflo(unsigned w) { return __uint_as_float(w << 16); }
__device__ __forceinline__ float bfhi(unsigned w) { return __uint_as_float(w & 0xffff0000u); }
__device__ __forceinline__ float sigm(float x) { return 1.f / (1.f + __expf(-x)); }
__device__ __forceinline__ float wave_sum(float v) {
#pragma unroll
    for (int o = 1; o < 64; o <<= 1) v += __shfl_xor(v, o);
    return v;
}
#define MFMA32(a, b, c) __builtin_amdgcn_mfma_f32_16x16x32_bf16((a), (b), (c), 0, 0, 0)
#define LDS_WAIT() asm volatile("s_waitcnt lgkmcnt(0)" ::: "memory")

namespace pg8 {
constexpr int BM = 256, BK = 64, HALF = 128, HTB = HALF * BK * 2, STAGE_BYTES = 8 * HTB, NXCD = 8, WGM = 8;
__host__ __device__ __forceinline__ int lds_byte(int r, int c) { const int st = (r >> 4) * 2 + (c >> 5), rr = r & 15, cc = c & 31, ob = rr * 64 + cc * 2; return st * 1024 + (ob ^ (((ob >> 9) & 1) << 5)); }
__host__ __device__ __forceinline__ void stage_rc(int b, int& R, int& C) { const int st = b / 1024, sb = b % 1024, swz = sb ^ (((sb >> 9) & 1) << 5); R = (st >> 1) * 16 + swz / 64; C = (st & 1) * 32 + (swz % 64) / 2; }
__host__ __device__ __forceinline__ int perm32(int rho) { const int n = rho >> 4, i = rho & 15; return 8 * (i >> 2) + 4 * n + (i & 3); }
struct Unit { int pm, pn; };
struct Gemm { const bf16_t* A; const bf16_t* Bt; int M, N, K; };
struct StaticOrder {
    int nM, nN, nwg, G, c;
    __host__ __device__ void init(int M, int N, int G_, int c_) { nM = M / BM; nN = N / BM; nwg = nM * nN; G = G_; c = c_; }
    __host__ __device__ bool next(int i, Unit& u) const {
        const long L = (long)i * G + c; if (L >= nwg) return false;
        int wgid = (int)L; { const int q = nwg / NXCD, r = nwg % NXCD, xcd = wgid % NXCD, off = wgid / NXCD; wgid = (xcd < r ? xcd * (q + 1) : r * (q + 1) + (xcd - r) * q) + off; }
        const int nig = WGM * nN, gid = wgid / nig, fm = gid * WGM, gsz = (nM - fm) < WGM ? (nM - fm) : WGM;
        u.pm = fm + ((wgid % nig) % gsz); u.pn = (wgid % nig) / gsz; return true;
    }
};
template <class Epi>
__device__ __forceinline__ void gemm_phase(LAS unsigned char* lds, const Gemm g, const StaticOrder& S, const Epi& E) {
    int tid = threadIdx.x; asm volatile("" : "+v"(tid));
    const int wid = __builtin_amdgcn_readfirstlane(tid >> 6), lane = tid & 63, wr = wid >> 2, wc = wid & 3, fr = lane & 15, fq = lane >> 4;
    const int K = g.K, nt = K / BK;
    unsigned voffA[2], voffB[2];
#pragma unroll
    for (int i = 0; i < 2; ++i) { int R, C; stage_rc(tid * 16 + i * 8192, R, C); const int Rb = Epi::PERM ? ((R & ~31) + perm32(R & 31)) : R;
        voffA[i] = (unsigned)(R * K + C) * 2u; voffB[i] = (unsigned)(Rb * K + C) * 2u; }
    const size_t kstep = (size_t)(BK * 2);
    const size_t hstep = (size_t)HALF * K * 2;
    const size_t tstep = 2 * hstep;
    const unsigned ldsw = (unsigned)wid * 1024u;
    const int aoff = lds_byte(wr * 64 + fr, fq * 8), boff = lds_byte(wc * 32 + fr, fq * 8);
#define PG8_SA(b, h) (((b) * 2 + (h)) * HTB)
#define PG8_SB(b, h) ((4 + (b) * 2 + (h)) * HTB)
#define PG8_STAGE(bufoff, gbase, voff) do { _Pragma("unroll") for (int _i = 0; _i < 2; ++_i) \
        __builtin_amdgcn_global_load_lds((const unsigned*)((const char*)(gbase) + (voff)[_i]), (LAS unsigned*)(lds + (bufoff) + ldsw + _i * 8192), 16, 0, 0); } while (0)
#define PG8_LDA(dst, b, h) do { _Pragma("unroll") for (int m = 0; m < 4; ++m) _Pragma("unroll") for (int k = 0; k < 2; ++k) dst[m][k] = *(const LAS bf16x8*)(lds + PG8_SA(b, h) + aoff + m * 2048 + k * 1024); } while (0)
#define PG8_LDB(dst, b, h) do { _Pragma("unroll") for (int n = 0; n < 2; ++n) _Pragma("unroll") for (int k = 0; k < 2; ++k) dst[n][k] = *(const LAS bf16x8*)(lds + PG8_SB(b, h) + boff + n * 2048 + k * 1024); } while (0)
#define PG8_MMA(ai, bj, At, Bt) do { __builtin_amdgcn_s_setprio(1); _Pragma("unroll") for (int m = 0; m < 4; ++m) _Pragma("unroll") for (int n = 0; n < 2; ++n) _Pragma("unroll") for (int k = 0; k < 2; ++k) \
        acc[ai][bj][m][n] = __builtin_amdgcn_mfma_f32_16x16x32_bf16(Bt[n][k], At[m][k], acc[ai][bj][m][n], 0, 0, 0); __builtin_amdgcn_s_setprio(0); } while (0)
#define PG8_WAIT_V(n) asm volatile("s_waitcnt vmcnt(" #n ")" ::: "memory")
#define PG8_WAIT_L(n) asm volatile("s_waitcnt lgkmcnt(" #n ")" ::: "memory")
#define PG8_BAR __builtin_amdgcn_s_barrier()
#define PG8_SCHED __builtin_amdgcn_sched_barrier(0)
    Unit cur, nxt; int ui = 0;
    if (!S.next(0, cur)) return;
    f32x4 acc[2][2][4][2];
#pragma unroll
    for (int a = 0; a < 2; ++a)
#pragma unroll
        for (int b = 0; b < 2; ++b)
#pragma unroll
            for (int m = 0; m < 4; ++m)
#pragma unroll
                for (int n = 0; n < 2; ++n) acc[a][b][m][n] = (f32x4){0.f, 0.f, 0.f, 0.f};
    bf16x8 At[4][2], B0[2][2], B1[2][2];
    const char* cA = (const char*)g.A + (size_t)cur.pm * tstep; const char* cB = (const char*)g.Bt + (size_t)cur.pn * tstep;
    PG8_STAGE(PG8_SB(0, 0), cB, voffB); PG8_STAGE(PG8_SA(0, 0), cA, voffA); PG8_STAGE(PG8_SB(0, 1), cB + hstep, voffB); PG8_STAGE(PG8_SA(0, 1), cA + hstep, voffA);
    if (wr == 1) PG8_BAR;
    PG8_WAIT_V(4); PG8_BAR;
    PG8_STAGE(PG8_SB(1, 0), cB + kstep, voffB); PG8_STAGE(PG8_SA(1, 0), cA + kstep, voffA); PG8_STAGE(PG8_SB(1, 1), cB + hstep + kstep, voffB);
    PG8_WAIT_V(6); PG8_BAR;
    for (;;) {
        const bool has_next = S.next(ui + 1, nxt);
        const char* nA = has_next ? (const char*)g.A + (size_t)nxt.pm * tstep : cA; const char* nB = has_next ? (const char*)g.Bt + (size_t)nxt.pn * tstep : cB;
#pragma unroll 1
        for (int t = 0; t < nt; t += 2) {
            const bool last = (t == nt - 2);
            const char* a1 = cA + (size_t)(t + 1) * kstep;
            const char* a2 = last ? nA : cA + (size_t)(t + 2) * kstep; const char* b2 = last ? nB : cB + (size_t)(t + 2) * kstep;
            const char* a3 = a2 + kstep; const char* b3 = b2 + kstep;
            PG8_LDB(B0, 0, 0); PG8_SCHED; PG8_LDA(At, 0, 0); PG8_STAGE(PG8_SA(1, 1), a1 + hstep, voffA);
            PG8_WAIT_L(8); PG8_BAR; PG8_WAIT_L(0); PG8_MMA(0, 0, At, B0); PG8_BAR; PG8_SCHED;
            PG8_LDB(B1, 0, 1); PG8_STAGE(PG8_SB(0, 0), b2, voffB);
            PG8_BAR; PG8_WAIT_L(0); PG8_MMA(0, 1, At, B1); PG8_BAR;
            PG8_LDA(At, 0, 1); PG8_STAGE(PG8_SA(0, 0), a2, voffA);
            PG8_BAR; PG8_WAIT_L(0); PG8_MMA(1, 0, At, B0); PG8_BAR; PG8_SCHED;
            PG8_STAGE(PG8_SB(0, 1), b2 + hstep, voffB);
            PG8_WAIT_V(6); PG8_BAR; PG8_MMA(1, 1, At, B1); PG8_BAR;
            PG8_LDB(B0, 1, 0); PG8_SCHED; PG8_LDA(At, 1, 0); PG8_STAGE(PG8_SA(0, 1), a2 + hstep, voffA);
            PG8_WAIT_L(8); PG8_BAR; PG8_WAIT_L(0); PG8_MMA(0, 0, At, B0); PG8_BAR; PG8_SCHED;
            PG8_LDB(B1, 1, 1); PG8_STAGE(PG8_SB(1, 0), b3, voffB);
            PG8_BAR; PG8_WAIT_L(0); PG8_MMA(0, 1, At, B1); PG8_BAR;
            PG8_LDA(At, 1, 1); PG8_STAGE(PG8_SA(1, 0), a3, voffA);
            PG8_BAR; PG8_WAIT_L(0); PG8_MMA(1, 0, At, B0); PG8_BAR; PG8_SCHED;
            PG8_STAGE(PG8_SB(1, 1), b3 + hstep, voffB);
            PG8_WAIT_V(6); PG8_BAR; PG8_MMA(1, 1, At, B1); PG8_BAR;
        }
        E(acc, cur, wr, wc, fr, fq);
        if (!has_next) break;
#pragma unroll
        for (int a = 0; a < 2; ++a)
#pragma unroll
            for (int b = 0; b < 2; ++b)
#pragma unroll
                for (int m = 0; m < 4; ++m)
#pragma unroll
                    for (int n = 0; n < 2; ++n) acc[a][b][m][n] = (f32x4){0.f, 0.f, 0.f, 0.f};
        cur = nxt; cA = nA; cB = nB; ++ui;
    }
    PG8_WAIT_V(0);
    if (wr == 0) PG8_BAR;
    PG8_BAR;
#undef PG8_SA
#undef PG8_SB
#undef PG8_STAGE
#undef PG8_LDA
#undef PG8_LDB
#undef PG8_MMA
#undef PG8_WAIT_V
#undef PG8_WAIT_L
#undef PG8_BAR
#undef PG8_SCHED
}
}
using pg8::Unit;

struct Args {
    const float* in[26];
    float* out; unsigned char* ws;
};
enum { I_XP = 0, I_XS, I_SRET, I_SRW, I_SSH, I_PP, I_PS, I_NG, I_WIN, I_MU, I_W0, I_W2, I_A0, I_A2, I_KK, I_KA, I_RK, I_LNW, I_LNB, I_WDA, I_WDB, I_WOUT, I_WPLE, I_PNG, I_WPG, I_FNG };

__device__ __forceinline__ void p0_transpose_item(const float* W, int K, int N, bf16_t* WT, LAS float* scr, int item, int lane, const float* kscale) {
    const int nblk = N / 32, kb = item / nblk, nb = item % nblk, k0 = 64 * kb, n0 = 32 * nb;
#pragma unroll 8
    for (int i = 0; i < 32; ++i) { const int kk = 2 * i + (lane >> 5); float v = W[(size_t)(k0 + kk) * N + n0 + (lane & 31)]; if (kscale) v *= kscale[k0 + kk]; scr[kk * 33 + (lane & 31)] = v; }
    LDS_WAIT();
    const int c = lane & 7;
#pragma unroll
    for (int j = 0; j < 4; ++j) { const int n = (lane >> 3) + 8 * j; const LAS float* s = scr + (8 * c) * 33 + n;
        u32x4 o; o.x = pk2(s[0 * 33], s[1 * 33]); o.y = pk2(s[2 * 33], s[3 * 33]); o.z = pk2(s[4 * 33], s[5 * 33]); o.w = pk2(s[6 * 33], s[7 * 33]);
        *(u32x4*)(WT + (size_t)(n0 + n) * K + k0 + 8 * c) = o; }
    LDS_WAIT();
}

__device__ __forceinline__ void phase0(const Args& a, LAS unsigned char* lds, int gw, int NGW, int wave, int lane) {
    unsigned char* ws = a.ws;
    LAS float* scr = (LAS float*)(lds + wave * 16384);
    constexpr int I_IN = (D / 64) * (NCOLS / 32), I_DA = (2048 / 64) * (D / 32), I_SQ = (D / 64) * (D / 32), I_PL = (PLE / 64) * (D / 32), I_LR = 1 * (D / 32);
    constexpr int NITEMS = I_IN + I_DA + 3 * I_SQ + I_PL + 2 * I_LR;
    for (int it = gw; it < NITEMS; it += NGW) {
        int r = it;
        if (r < I_IN) { p0_transpose_item(a.in[I_WIN], D, NCOLS, (bf16_t*)(ws + WS_WIN), scr, r, lane, nullptr); continue; } r -= I_IN;
        if (r < I_DA) { p0_transpose_item(a.in[I_WDA], 2048, D, (bf16_t*)(ws + WS_WDA), scr, r, lane, nullptr); continue; } r -= I_DA;
        if (r < I_SQ) { p0_transpose_item(a.in[I_WDB], D, D, (bf16_t*)(ws + WS_WDB), scr, r, lane, nullptr); continue; } r -= I_SQ;
        if (r < I_SQ) { p0_transpose_item(a.in[I_WOUT], D, D, (bf16_t*)(ws + WS_WOUT), scr, r, lane, nullptr); continue; } r -= I_SQ;
        if (r < I_SQ) { p0_transpose_item(a.in[I_WPG], D, D, (bf16_t*)(ws + WS_WGATE), scr, r, lane, a.in[I_PNG]); continue; } r -= I_SQ;
        if (r < I_PL) { p0_transpose_item(a.in[I_WPLE], PLE, D, (bf16_t*)(ws + WS_WPLE), scr, r, lane, nullptr); continue; } r -= I_PL;
        if (r < I_LR) { p0_transpose_item(a.in[I_W2], 64, D, (bf16_t*)(ws + WS_W2T), scr, r, lane, nullptr); continue; } r -= I_LR;
        p0_transpose_item(a.in[I_A2], 64, D, (bf16_t*)(ws + WS_A2T), scr, r, lane, nullptr);
    }
    for (int i = gw * 64 + lane; i < 128 * D / 8; i += NGW * 64) ((u32x4*)(ws + WS_WIN + (size_t)NCOLS * D * 2))[i] = (u32x4){0u, 0u, 0u, 0u};
    bf16_t* H = (bf16_t*)(ws + WS_H);
    const float* ng = a.in[I_NG];
    for (int m = gw; m < MALL; m += NGW) {
        if (m < MR) {
            const float* xr = (m < MP) ? a.in[I_XP] + (size_t)m * D : a.in[I_XS] + (size_t)(m - MP) * D;
            f32x4 v[4]; float s = 0.f;
#pragma unroll
            for (int j = 0; j < 4; ++j) { v[j] = ((const f32x4*)xr)[lane + 64 * j]; s += (v[j].x * v[j].x + v[j].y * v[j].y) + (v[j].z * v[j].z + v[j].w * v[j].w); }
            const float rs = 1.0f / sqrtf(wave_sum(s) * (1.f / D) + EPS);
            float* so = nullptr;
            if (m < MP) { if ((m & (T - 1)) == T - 1) so = a.out + OUT_SHP + (size_t)(m >> 11) * D; } else so = a.out + OUT_SHS + (size_t)(m - MP) * D;
#pragma unroll
            for (int j = 0; j < 4; ++j) { const f32x4 gg = ((const f32x4*)ng)[lane + 64 * j]; f32x4 h = v[j] * rs * gg;
                if (so) ((f32x4*)so)[lane + 64 * j] = h;
                u32x2 o; o.x = pk2(h.x, h.y); o.y = pk2(h.z, h.w); ((u32x2*)(H + (size_t)m * D))[lane + 64 * j] = o; }
        } else {
            const float* xr = a.in[I_SSH] + (size_t)(m - MR) * D;
#pragma unroll
            for (int j = 0; j < 4; ++j) { const f32x4 h = ((const f32x4*)xr)[lane + 64 * j]; u32x2 o; o.x = pk2(h.x, h.y); o.y = pk2(h.z, h.w); ((u32x2*)(H + (size_t)m * D))[lane + 64 * j] = o; }
        }
        u32x2 o = {0u, 0u};
        if (m < MR) { const float* pr = (m < MP) ? a.in[I_PP] + (size_t)m * PLE : a.in[I_PS] + (size_t)(m - MP) * PLE; const f32x4 p = ((const f32x4*)pr)[lane]; o.x = pk2(p.x, p.y); o.y = pk2(p.z, p.w); }
        ((u32x2*)(ws + WS_PB + (size_t)m * PLE * 2))[lane] = o;
    }
    for (int i = gw * 64 + lane; i < 2049 * 128; i += NGW * 64) {
        const int pos = i >> 7, j = i & 127; const double p = (pos == 2048) ? 16384.0 : (double)pos;
        double inv = 1.0, base = 0.9305720409296989; int e = j;
        while (e) { if (e & 1) inv *= base; base *= base; e >>= 1; }
        double rev = p * inv * 0.15915494309189535; rev -= floor(rev);
        const float fr = (float)rev;
        ((f32x2*)(ws + WS_ROPE))[i] = (f32x2){__builtin_amdgcn_cosf(fr), __builtin_amdgcn_sinf(fr)};
    }
    for (int i = gw * 64 + lane; i < 65536 + 64; i += NGW * 64) ((float*)(ws + WS_CTL))[i] = 0.f;
}

struct EpiP {
    static constexpr bool PERM = true;
    bf16_t* P; bf16_t* KT; const f32x2* rope;
    __device__ __forceinline__ void operator()(const f32x4 (&acc)[2][2][4][2], const Unit& u, int wr, int wc, int fr, int fq) const {
        const int pn = u.pn, pm = u.pm;
        const int row0 = pm * 256 + wr * 64 + fr, cl0 = wc * 32 + 8 * fq;
        const bool sample = (pm == 64);
        if (pn < 8) {
            const int h = pn & 3; const bool isk = pn >= 4;
            const float l2g = __log2f(1.f - exp2f(-5.f - (float)h));
#pragma unroll
            for (int ai = 0; ai < 2; ++ai)
#pragma unroll
                for (int m = 0; m < 4; ++m) {
                    const int row = row0 + ai * 128 + m * 16;
                    int pos, ex;
                    if (sample) { pos = 2048; ex = isk ? 0 : 1; } else { pos = row & (T - 1); const int idx = pos & 127; ex = isk ? 127 - idx : idx + 1; }
                    const float sc = exp2f((float)ex * l2g) * (isk ? 0.0625f : 1.0f);
                    const f32x4* rp = (const f32x4*)(rope + pos * 128 + cl0);
                    f32x4 cs[4]; cs[0] = rp[0]; cs[1] = rp[1]; cs[2] = rp[2]; cs[3] = rp[3];
                    float y1[8], y2[8];
#pragma unroll
                    for (int n = 0; n < 2; ++n)
#pragma unroll
                        for (int e = 0; e < 4; ++e) {
                            const float c = (e & 1) ? cs[n * 2 + (e >> 1)].z : cs[n * 2 + (e >> 1)].x, s = (e & 1) ? cs[n * 2 + (e >> 1)].w : cs[n * 2 + (e >> 1)].y;
                            const float x1 = acc[ai][0][m][n][e], x2 = acc[ai][1][m][n][e];
                            y1[n * 4 + e] = (x1 * c - x2 * s) * sc; y2[n * 4 + e] = (x2 * c + x1 * s) * sc;
                        }
                    u32x4 w1, w2;
                    w1.x = pk2(y1[0], y1[1]); w1.y = pk2(y1[2], y1[3]); w1.z = pk2(y1[4], y1[5]); w1.w = pk2(y1[6], y1[7]);
                    w2.x = pk2(y2[0], y2[1]); w2.y = pk2(y2[2], y2[3]); w2.z = pk2(y2[4], y2[5]); w2.w = pk2(y2[6], y2[7]);
                    bf16_t* rowp = P + (size_t)row * NP + pn * 256 + cl0;
                    *(u32x4*)rowp = w1; *(u32x4*)(rowp + 128) = w2;
                    if (isk && !sample) {
                        bf16_t* kt = KT + ((size_t)((row >> 11) * 4 + h) * 256 + cl0) * T + pos;
#pragma unroll
                        for (int j = 0; j < 8; ++j) { kt[(size_t)j * T] = f2bf(y1[j]); kt[(size_t)(j + 128) * T] = f2bf(y2[j]); }
                    }
                }
            return;
        }
#pragma unroll
        for (int bj = 0; bj < 2; ++bj) {
            const int cb = pn * 2 + bj;
            if (cb >= 97) continue;
            const int mode = (cb < 32) ? 0 : (cb < 48) ? 1 : (cb < 73) ? 0 : (cb < 81) ? 1 : 2;
            const bool vt = (cb < 32) && !sample;
#pragma unroll
            for (int ai = 0; ai < 2; ++ai)
#pragma unroll
                for (int m = 0; m < 4; ++m) {
                    const int row = row0 + ai * 128 + m * 16;
                    float y[8];
#pragma unroll
                    for (int n = 0; n < 2; ++n)
#pragma unroll
                        for (int e = 0; e < 4; ++e) { float x = acc[ai][bj][m][n][e]; if (mode == 1) x = x * sigm(x); else if (mode == 2) x = sigm(x); y[n * 4 + e] = x; }
                    if (vt) {
                        const int hd = cb * 128 + cl0 - O_V;
                        bf16_t* vp = P + ((size_t)(row >> 11) * T + hd) * NP + O_V + (row & (T - 1));
#pragma unroll
                        for (int j = 0; j < 8; ++j) vp[(size_t)j * NP] = f2bf(y[j]);
                    } else {
                        u32x4 w; w.x = pk2(y[0], y[1]); w.y = pk2(y[2], y[3]); w.z = pk2(y[4], y[5]); w.w = pk2(y[6], y[7]);
                        *(u32x4*)(P + (size_t)row * NP + cb * 128 + cl0) = w;
                    }
                }
        }
    }
};

__device__ __forceinline__ float lerp_bf(const bf16_t* cur, const bf16_t* prv, float mu) { const float c = bf2f(*cur); const float p = prv ? bf2f(*prv) : 0.f; return c + (p - c) * mu; }

__device__ __forceinline__ void rw_prep_item(const Args& a, LAS unsigned char* wl  , int tt, int h, int lane) {
    unsigned char* ws = a.ws;
    const bf16_t* P = (const bf16_t*)(ws + WS_P);
    const int l15 = lane & 15, quad = lane >> 4;
    const bool sample = tt >= 1024;
    const int row_base = sample ? MP + (tt - 1024) * 16 : tt * 16;
    const float* mu = a.in[I_MU];
    bf16x8 Aw[2], Aa[2];
    {
        const int m = row_base + l15;
        const bf16_t* cur = P + (size_t)m * NP + O_SH;
        const bf16_t* prv = sample ? P + (size_t)(m + MS) * NP + O_SH : ((m & (T - 1)) ? cur - NP : nullptr);
#pragma unroll
        for (int which = 0; which < 2; ++which)
#pragma unroll
            for (int ks = 0; ks < 2; ++ks) {
                const int col = 3072 + which * 64 + ks * 32 + quad * 8;
                const u32x4 cw = *(const u32x4*)(cur + col); u32x4 pw = {0u, 0u, 0u, 0u}; if (prv) pw = *(const u32x4*)(prv + col);
                const f32x4 m0 = *(const f32x4*)(mu + col), m1 = *(const f32x4*)(mu + col + 4);
                float z[8];
                const unsigned cws[4] = {cw.x, cw.y, cw.z, cw.w}, pws[4] = {pw.x, pw.y, pw.z, pw.w};
#pragma unroll
                for (int j = 0; j < 4; ++j) {
                    const float c0 = bflo(cws[j]), c1 = bfhi(cws[j]), p0 = bflo(pws[j]), p1 = bfhi(pws[j]);
                    const float mm0 = (j < 2) ? m0[2 * j] : m1[2 * j - 4], mm1 = (j < 2) ? m0[2 * j + 1] : m1[2 * j - 3];
                    z[2 * j] = c0 + (p0 - c0) * mm0; z[2 * j + 1] = c1 + (p1 - c1) * mm1;
                }
                if (which == 0) {
#pragma unroll
                    for (int j = 0; j < 8; ++j) z[j] = 1.f - 2.f / (__expf(2.f * z[j]) + 1.f);
                }
                u32x4 o; o.x = pk2(z[0], z[1]); o.y = pk2(z[2], z[3]); o.z = pk2(z[4], z[5]); o.w = pk2(z[6], z[7]);
                if (which == 0) Aw[ks] = __builtin_bit_cast(bf16x8, o); else Aa[ks] = __builtin_bit_cast(bf16x8, o);
            }
    }
    const bf16_t* W2T = (const bf16_t*)(ws + WS_W2T); const bf16_t* A2T = (const bf16_t*)(ws + WS_A2T);
    unsigned char* rec = ws + WS_CH + ((size_t)((tt >> 7) * 16 + h) * 128 + (tt & 127)) * REC;
    LAS bf16_t* LA = (LAS bf16_t*)wl;
    LAS bf16_t* LR = LA + 16 * 72;
    LAS bf16_t* LB = LR + 16 * 72;
    LAS bf16_t* LK = LB + 16 * 72;
    LAS float* LN = (LAS float*)(wl + 9216);
    float tA[4][4], tBi[4][4], tBp[4][4];
    float ssq[4] = {0.f, 0.f, 0.f, 0.f}, bon[4] = {0.f, 0.f, 0.f, 0.f};
#pragma unroll
    for (int nt = 0; nt < 4; ++nt) {
        const int ch = h * 64 + nt * 16 + l15, cc = nt * 16 + l15;
        f32x4 cw = {0.f, 0.f, 0.f, 0.f}, ca = {0.f, 0.f, 0.f, 0.f};
#pragma unroll
        for (int ks = 0; ks < 2; ++ks) {
            const bf16x8 bw = *(const bf16x8*)(W2T + (size_t)ch * 64 + ks * 32 + quad * 8), ba = *(const bf16x8*)(A2T + (size_t)ch * 64 + ks * 32 + quad * 8);
            cw = MFMA32(Aw[ks], bw, cw); ca = MFMA32(Aa[ks], ba, ca);
        }
        const float w0 = a.in[I_W0][ch], a0 = a.in[I_A0][ch], k_k = a.in[I_KK][ch], k_a = a.in[I_KA][ch], r_k = a.in[I_RK][ch];
        const float mur = mu[ch], muk = mu[1024 + ch], muv = mu[2048 + ch];
        float lw[4], rr[4], kq[4], vv[4], aa4[4], kr4[4];
#pragma unroll
        for (int r = 0; r < 4; ++r) {
            const int m = row_base + quad * 4 + r;
            const bf16_t* cur = P + (size_t)m * NP + O_SH + ch;
            const bf16_t* prv = sample ? P + (size_t)(m + MS) * NP + O_SH + ch : ((m & (T - 1)) ? cur - NP : nullptr);
            const float r_ = lerp_bf(cur, prv, mur), k_ = lerp_bf(cur + 1024, prv ? prv + 1024 : nullptr, muk), v_ = lerp_bf(cur + 2048, prv ? prv + 2048 : nullptr, muv);
            lw[r] = -0.6065306597126334f * sigm(w0 + cw[r]);
            const float aa = sigm(a0 + ca[r]); aa4[r] = aa;
            const float kr = k_ * k_k; kr4[r] = kr; ssq[r] += kr * kr;
            const float kpp = k_ * (1.f + (aa - 1.f) * k_a); kq[r] = kpp;
            rr[r] = r_; vv[r] = v_; bon[r] += r_ * kpp * r_k;
        }
        if (sample) {
#pragma unroll
            for (int r = 0; r < 4; ++r) {
                const int i = (tt - 1024) * 16 + quad * 4 + r;
                float* o = (float*)(ws + WS_OPSS) + ((size_t)(i * 16 + h) * 6) * 64 + cc;
                o[0] = rr[r]; o[64] = __expf(lw[r]); o[128] = kq[r]; o[320] = vv[r];
                tA[nt][r] = kr4[r]; tBi[nt][r] = aa4[r] * kr4[r]; tBp[nt][r] = 0.f;
            }
        } else {
            float c[4]; c[0] = lw[0]; c[1] = c[0] + lw[1]; c[2] = c[1] + lw[2]; c[3] = c[2] + lw[3];
            const float tot = c[3];
            const float s1 = __shfl(tot, (lane - 16) & 63), s2 = __shfl(tot, (lane - 32) & 63), s3 = __shfl(tot, (lane - 48) & 63);
            const float off = (quad >= 1 ? s1 : 0.f) + (quad >= 2 ? s2 : 0.f) + (quad >= 3 ? s3 : 0.f);
            const float total = __shfl(c[3] + off, 48 + l15);
            float kqp[4];
#pragma unroll
            for (int r = 0; r < 4; ++r) {
                const float cum = c[r] + off, cumx = cum - lw[r];
                const float ea = __expf(cumx), er = __expf(cum), ei = __expf(-cum), ep = __expf(total - cum);
                const int tk = quad * 4 + r;
                LR[tk * 72 + cc] = f2bf(rr[r] * er); LK[tk * 72 + cc] = f2bf(kq[r] * ei);
                kqp[r] = kq[r] * ep;
                tA[nt][r] = kr4[r] * ea; tBi[nt][r] = aa4[r] * kr4[r] * ei; tBp[nt][r] = aa4[r] * kr4[r] * ep;
            }
            *(u32x2*)(rec + R_KP + cc * 32 + quad * 8) = (u32x2){pk2(kqp[0], kqp[1]), pk2(kqp[2], kqp[3])};
            *(u32x2*)(rec + R_VT + cc * 32 + quad * 8) = (u32x2){pk2(vv[0], vv[1]), pk2(vv[2], vv[3])};
            if (quad == 0) *(float*)(rec + R_WC + cc * 4) = __expf(total);
        }
        asm volatile("" ::: "memory");
    }
    float inv[4];
#pragma unroll
    for (int r = 0; r < 4; ++r) {
        float s = ssq[r], b = bon[r];
#pragma unroll
        for (int o = 1; o < 16; o <<= 1) { s += __shfl_xor(s, o); b += __shfl_xor(b, o); }
        inv[r] = 1.f / fmaxf(sqrtf(s), 1e-12f);
        if (l15 == 0) ((float*)(ws + WS_BC))[(size_t)(row_base + quad * 4 + r) * 16 + h] = b;
    }
    if (sample) {
#pragma unroll
        for (int nt = 0; nt < 4; ++nt)
#pragma unroll
            for (int r = 0; r < 4; ++r) {
                const int i = (tt - 1024) * 16 + quad * 4 + r;
                float* o = (float*)(ws + WS_OPSS) + ((size_t)(i * 16 + h) * 6) * 64 + nt * 16 + l15;
                o[192] = tA[nt][r] * inv[r]; o[256] = tBi[nt][r] * inv[r];
            }
        return;
    }
#pragma unroll
    for (int nt = 0; nt < 4; ++nt) {
        const int cc = nt * 16 + l15;
        float bp[4];
#pragma unroll
        for (int r = 0; r < 4; ++r) { const int tk = quad * 4 + r;
            LA[tk * 72 + cc] = f2bf(-tA[nt][r] * inv[r]); LB[tk * 72 + cc] = f2bf(tBi[nt][r] * inv[r]); bp[r] = tBp[nt][r] * inv[r]; }
        *(u32x2*)(rec + R_BP + cc * 32 + quad * 8) = (u32x2){pk2(bp[0], bp[1]), pk2(bp[2], bp[3])};
    }
    LDS_WAIT();
#pragma unroll
    for (int i = 0; i < 2; ++i) { const int idx = lane + 64 * i, rr = idx >> 3, c8 = (idx & 7) * 8;
        *(u32x4*)(rec + R_AT + rr * 128 + c8 * 2) = *(const LAS u32x4*)(LA + rr * 72 + c8);
        *(u32x4*)(rec + R_RT + rr * 128 + c8 * 2) = *(const LAS u32x4*)(LR + rr * 72 + c8); }
    f32x4 nab = {0.f, 0.f, 0.f, 0.f}, nak = nab, nrb = nab, nrk = nab;
#pragma unroll
    for (int ks = 0; ks < 2; ++ks) {
        const bf16x8 fa = *(const LAS bf16x8*)(LA + l15 * 72 + ks * 32 + quad * 8), fr_ = *(const LAS bf16x8*)(LR + l15 * 72 + ks * 32 + quad * 8);
        const bf16x8 fb = *(const LAS bf16x8*)(LB + l15 * 72 + ks * 32 + quad * 8), fk = *(const LAS bf16x8*)(LK + l15 * 72 + ks * 32 + quad * 8);
        nab = MFMA32(fa, fb, nab); nak = MFMA32(fa, fk, nak); nrb = MFMA32(fr_, fb, nrb); nrk = MFMA32(fr_, fk, nrk);
    }
#pragma unroll
    for (int r = 0; r < 4; ++r) {
        const int t = quad * 4 + r, j = l15;
        const float vab = (j < t) ? nab[r] : 0.f, vak = (j < t) ? nak[r] : 0.f, vrb = (j <= t) ? nrb[r] : 0.f, vrk = (j <= t) ? nrk[r] : 0.f;
        LN[t * 16 + j] = vab;
        *(bf16_t*)(rec + R_AAK + (t * 16 + j) * 2) = f2bf(vak);
        *(bf16_t*)(rec + R_ARB + (t * 16 + j) * 2) = f2bf(vrb);
        *(bf16_t*)(rec + R_ARK + (t * 16 + j) * 2) = f2bf(vrk);
    }
    LDS_WAIT();
    if (lane < 16) {
        float tc[16];
#pragma unroll
        for (int t = 0; t < 16; ++t) {
            float s = (t == lane) ? 1.f : 0.f;
#pragma unroll
            for (int j = 0; j < t; ++j) s += LN[t * 16 + j] * tc[j];
            tc[t] = s;
            *(bf16_t*)(rec + R_TT + (t * 16 + lane) * 2) = f2bf(s);
        }
    }
    LDS_WAIT();
}

struct ScanFr { bf16x8 at[2], rt[2]; bf16x8 aak, tt, arb, ark, vt, bp[4], kp[4]; float wc[4]; };
__device__ __forceinline__ bf16x8 ld_k16(const unsigned char* p, int quad) { u32x4 v = {0u, 0u, 0u, 0u}; if (quad < 2) v = *(const u32x4*)(p + quad * 16); return __builtin_bit_cast(bf16x8, v); }
__device__ __forceinline__ void scan_load(ScanFr& f, const unsigned char* rec, int vt, int l15, int quad) {
#pragma unroll
    for (int ks = 0; ks < 2; ++ks) { f.at[ks] = *(const bf16x8*)(rec + R_AT + l15 * 128 + ks * 64 + quad * 16); f.rt[ks] = *(const bf16x8*)(rec + R_RT + l15 * 128 + ks * 64 + quad * 16); }
    f.aak = ld_k16(rec + R_AAK + l15 * 32, quad); f.tt = ld_k16(rec + R_TT + l15 * 32, quad);
    f.arb = ld_k16(rec + R_ARB + l15 * 32, quad); f.ark = ld_k16(rec + R_ARK + l15 * 32, quad);
    f.vt = ld_k16(rec + R_VT + (vt * 16 + l15) * 32, quad);
#pragma unroll
    for (int nt = 0; nt < 4; ++nt) { f.bp[nt] = ld_k16(rec + R_BP + (nt * 16 + l15) * 32, quad); f.kp[nt] = ld_k16(rec + R_KP + (nt * 16 + l15) * 32, quad);
        f.wc[nt] = *(const float*)(rec + R_WC + (nt * 16 + l15) * 4); }
}
__device__ __forceinline__ bf16x8 lds_k16(const LAS bf16_t* p, int quad) { u32x4 v = {0u, 0u, 0u, 0u}; if (quad < 2) v = *(const LAS u32x4*)(p + quad * 8); return __builtin_bit_cast(bf16x8, v); }
__device__ __forceinline__ void rw_scan_task(const Args& a, LAS unsigned char* wl  , int b, int h, int vt, int lane) {
    unsigned char* ws = a.ws;
    const int l15 = lane & 15, quad = lane >> 4;
    LAS bf16_t* Sb = (LAS bf16_t*)wl;
    LAS bf16_t* Yb = (LAS bf16_t*)(wl + 2304);
    LAS bf16_t* Ub = (LAS bf16_t*)(wl + 2304 + 512);
    f32x4 S[4];
#pragma unroll
    for (int nt = 0; nt < 4; ++nt) { S[nt] = (f32x4){0.f, 0.f, 0.f, 0.f};
#pragma unroll
        for (int r = 0; r < 4; ++r) Sb[(quad * 4 + r) * 72 + nt * 16 + l15] = 0; }
    LDS_WAIT();
    const unsigned char* rec0 = ws + WS_CH + (size_t)((b * 16 + h) * 128) * REC;
    float* OB = (float*)(ws + WS_OB);
    ScanFr f, g;
    scan_load(f, rec0, vt, l15, quad);
    for (int ch = 0; ch < 128; ++ch) {
        scan_load(g, rec0 + (size_t)(ch < 127 ? ch + 1 : ch) * REC, vt, l15, quad);
        const bf16x8 sa0 = *(const LAS bf16x8*)(Sb + l15 * 72 + quad * 8), sa1 = *(const LAS bf16x8*)(Sb + l15 * 72 + 32 + quad * 8);
        f32x4 z = {0.f, 0.f, 0.f, 0.f};
        f32x4 Y = MFMA32(sa0, f.at[0], z); Y = MFMA32(sa1, f.at[1], Y); Y = MFMA32(f.vt, f.aak, Y);
#pragma unroll
        for (int r = 0; r < 4; ++r) Yb[(quad * 4 + r) * 16 + l15] = f2bf(Y[r]);
        LDS_WAIT();
        const bf16x8 ya = lds_k16(Yb + l15 * 16, quad);
        f32x4 U = MFMA32(ya, f.tt, z);
#pragma unroll
        for (int r = 0; r < 4; ++r) Ub[(quad * 4 + r) * 16 + l15] = f2bf(U[r]);
        LDS_WAIT();
        const bf16x8 ua = lds_k16(Ub + l15 * 16, quad);
        f32x4 O = MFMA32(sa0, f.rt[0], z); O = MFMA32(sa1, f.rt[1], O); O = MFMA32(ua, f.arb, O); O = MFMA32(f.vt, f.ark, O);
        *(f32x4*)(OB + (size_t)(b * T + ch * 16 + l15) * D + h * 64 + vt * 16 + quad * 4) = O;
#pragma unroll
        for (int nt = 0; nt < 4; ++nt) {
            f32x4 sn = S[nt] * f.wc[nt];
            sn = MFMA32(ua, f.bp[nt], sn); sn = MFMA32(f.vt, f.kp[nt], sn);
            S[nt] = sn;
#pragma unroll
            for (int r = 0; r < 4; ++r) Sb[(quad * 4 + r) * 72 + nt * 16 + l15] = f2bf(sn[r]);
        }
        LDS_WAIT();
        f = g;
    }
    float* so = a.out + OUT_RWP + (size_t)((b * 16 + h) * 64 + vt * 16) * 64;
#pragma unroll
    for (int nt = 0; nt < 4; ++nt)
#pragma unroll
        for (int r = 0; r < 4; ++r) so[(quad * 4 + r) * 64 + nt * 16 + l15] = S[nt][r];
}

__device__ __forceinline__ void rw_sample_unit(const Args& a, int i, int h, int tid) {
    unsigned char* ws = a.ws;
    const int row = tid >> 3, ks = tid & 7;
    const float* s0 = a.in[I_SRW] + ((size_t)(i * 16 + h) * 64 + row) * 64 + ks * 8;
    const float* op = (const float*)(ws + WS_OPSS) + (size_t)(i * 16 + h) * 6 * 64;
    float s[8], r_[8], w_[8], k_[8], kk[8], b_[8];
#pragma unroll
    for (int j = 0; j < 2; ++j) {
        const f32x4 sv = ((const f32x4*)s0)[j]; s[4 * j] = sv.x; s[4 * j + 1] = sv.y; s[4 * j + 2] = sv.z; s[4 * j + 3] = sv.w;
#define LD8(dst, slot) { const f32x4 t_ = ((const f32x4*)(op + (slot) * 64 + ks * 8))[j]; dst[4 * j] = t_.x; dst[4 * j + 1] = t_.y; dst[4 * j + 2] = t_.z; dst[4 * j + 3] = t_.w; }
        LD8(r_, 0) LD8(w_, 1) LD8(k_, 2) LD8(kk, 3) LD8(b_, 4)
#undef LD8
    }
    const float v = op[5 * 64 + row];
    float sk = 0.f;
#pragma unroll
    for (int j = 0; j < 8; ++j) sk += s[j] * kk[j];
    sk += __shfl_xor(sk, 1); sk += __shfl_xor(sk, 2); sk += __shfl_xor(sk, 4);
    float o = 0.f;
#pragma unroll
    for (int j = 0; j < 8; ++j) { s[j] = s[j] * w_[j] - sk * b_[j] + v * k_[j]; o += s[j] * r_[j]; }
    o += __shfl_xor(o, 1); o += __shfl_xor(o, 2); o += __shfl_xor(o, 4);
    float* so = a.out + OUT_RWS + ((size_t)(i * 16 + h) * 64 + row) * 64 + ks * 8;
    ((f32x4*)so)[0] = (f32x4){s[0], s[1], s[2], s[3]}; ((f32x4*)so)[1] = (f32x4){s[4], s[5], s[6], s[7]};
    if (ks == 0) ((float*)(ws + WS_OB))[(size_t)(MP + i) * D + h * 64 + row] = o;
}

constexpr int KN_LD = 264, VS_LD = 136, SS_LD = 264;
constexpr int L_KN = 0, L_VS = 128 * KN_LD * 2  , L_SS = L_VS + 64 * VS_LD * 2  , L_RET_END = L_SS + 64 * SS_LD * 2  ;
__device__ __forceinline__ void ret_unit(const Args& a, LAS unsigned char* lds, int unit, int tid) {
    unsigned char* ws = a.ws;
    const bf16_t* P = (const bf16_t*)(ws + WS_P);
    const int dvs = unit & 7, h = (unit >> 3) & 3, b = unit >> 5;
    const int wave = tid >> 6, lane = tid & 63, l15 = lane & 15, quad = lane >> 4;
    LAS bf16_t* KN = (LAS bf16_t*)(lds + L_KN); LAS bf16_t* VS = (LAS bf16_t*)(lds + L_VS); LAS bf16_t* SS = (LAS bf16_t*)(lds + L_SS);
    const float g = 1.f - exp2f(-5.f - (float)h), l2g = __log2f(g);
    const float gC = exp2f(128.f * l2g), ginvC = exp2f(-128.f * l2g);
    const bf16_t* KT = (const bf16_t*)(ws + WS_KT) + (size_t)(b * 4 + h) * 256 * T;
    f32x4 sacc[2][4];
#pragma unroll
    for (int n = 0; n < 2; ++n)
#pragma unroll
        for (int d = 0; d < 4; ++d) sacc[n][d] = (f32x4){0.f, 0.f, 0.f, 0.f};
    for (int i = tid; i < 64 * SS_LD / 2; i += 512) ((LAS unsigned*)SS)[i] = 0u;
    const int it = wave;
    for (int c = 0; c < 16; ++c) {
        const int tok0 = b * T + c * 128;
#pragma unroll
        for (int i = 0; i < 8; ++i) { const int idx = tid + 512 * i, r = idx >> 5, c8 = (idx & 31) * 8;
            *(LAS u32x4*)(KN + r * KN_LD + c8) = *(const u32x4*)(P + (size_t)(tok0 + r) * NP + O_K + h * 256 + c8); }
#pragma unroll
        for (int i = 0; i < 2; ++i) { const int idx = tid + 512 * i, r = idx >> 4, c8 = (idx & 15) * 8;
            *(LAS u32x4*)(VS + r * VS_LD + c8) = *(const u32x4*)(P + (size_t)(b * T + h * 512 + dvs * 64 + r) * NP + O_V + c * 128 + c8); }
        bf16x8 qf[8];
#pragma unroll
        for (int ks = 0; ks < 8; ++ks) qf[ks] = *(const bf16x8*)(P + (size_t)(tok0 + it * 16 + l15) * NP + h * 256 + ks * 32 + quad * 8);
        bf16x8 ktf[2][4];
#pragma unroll
        for (int n = 0; n < 2; ++n)
#pragma unroll
            for (int ks = 0; ks < 4; ++ks) ktf[n][ks] = *(const bf16x8*)(KT + (size_t)((2 * wave + n) * 16 + l15) * T + c * 128 + ks * 32 + quad * 8);
        __syncthreads();
        f32x4 oacc[4];
#pragma unroll
        for (int d = 0; d < 4; ++d) oacc[d] = (f32x4){0.f, 0.f, 0.f, 0.f};
#pragma unroll
        for (int ks = 0; ks < 8; ++ks)
#pragma unroll
            for (int d = 0; d < 4; ++d) { const bf16x8 sb = *(const LAS bf16x8*)(SS + (d * 16 + l15) * SS_LD + ks * 32 + quad * 8); oacc[d] = MFMA32(qf[ks], sb, oacc[d]); }
#pragma unroll
        for (int p = 0; p < 4; ++p) {
            if (2 * p <= it) {
                f32x4 s0 = {0.f, 0.f, 0.f, 0.f}, s1 = {0.f, 0.f, 0.f, 0.f};
#pragma unroll
                for (int ks = 0; ks < 8; ++ks) { const bf16x8 ka = *(const LAS bf16x8*)(KN + ((2 * p) * 16 + l15) * KN_LD + ks * 32 + quad * 8); s0 = MFMA32(ka, qf[ks], s0); }
                if (2 * p + 1 <= it) {
#pragma unroll
                    for (int ks = 0; ks < 8; ++ks) { const bf16x8 ka = *(const LAS bf16x8*)(KN + ((2 * p + 1) * 16 + l15) * KN_LD + ks * 32 + quad * 8); s1 = MFMA32(ka, qf[ks], s1); }
                }
#pragma unroll
                for (int r = 0; r < 4; ++r) {
                    const int jl = quad * 4 + r;
                    s0[r] = (2 * p == it && jl > l15) ? 0.f : s0[r] * ginvC;
                    s1[r] = (2 * p + 1 > it || (2 * p + 1 == it && jl > l15)) ? 0.f : s1[r] * ginvC;
                }
                u32x4 aw; aw.x = pk2(s0[0], s0[1]); aw.y = pk2(s0[2], s0[3]); aw.z = pk2(s1[0], s1[1]); aw.w = pk2(s1[2], s1[3]);
                const bf16x8 af = __builtin_bit_cast(bf16x8, aw);
#pragma unroll
                for (int d = 0; d < 4; ++d) {
                    const LAS bf16_t* vr = VS + (d * 16 + l15) * VS_LD + 32 * p + quad * 4;
                    const u32x2 lo = *(const LAS u32x2*)vr, hi = *(const LAS u32x2*)(vr + 16);
                    const u32x4 bw = {lo.x, lo.y, hi.x, hi.y};
                    oacc[d] = MFMA32(af, __builtin_bit_cast(bf16x8, bw), oacc[d]);
                }
            }
        }
        {
            bf16_t* OA = (bf16_t*)(ws + WS_OA); float* SQA = (float*)(ws + WS_SQA);
#pragma unroll
            for (int r = 0; r < 4; ++r) {
                const int tok = tok0 + it * 16 + quad * 4 + r;
                float ss = 0.f;
#pragma unroll
                for (int d = 0; d < 4; ++d) { const float v = oacc[d][r]; ss += v * v; OA[(size_t)tok * 2048 + h * 512 + dvs * 64 + d * 16 + l15] = f2bf(v); }
#pragma unroll
                for (int o = 1; o < 16; o <<= 1) ss += __shfl_xor(ss, o);
                if (l15 == 0) SQA[(size_t)tok * 32 + h * 8 + dvs] = ss;
            }
        }
        __syncthreads();
#pragma unroll
        for (int n = 0; n < 2; ++n)
#pragma unroll
            for (int d = 0; d < 4; ++d) {
                f32x4 s = sacc[n][d] * gC;
#pragma unroll
                for (int ks = 0; ks < 4; ++ks) { const bf16x8 va = *(const LAS bf16x8*)(VS + (d * 16 + l15) * VS_LD + ks * 32 + quad * 8); s = MFMA32(va, ktf[n][ks], s); }
                sacc[n][d] = s;
#pragma unroll
                for (int r = 0; r < 4; ++r) SS[(d * 16 + quad * 4 + r) * SS_LD + (2 * wave + n) * 16 + l15] = f2bf(s[r]);
            }
        __syncthreads();
    }
    float* so = a.out + OUT_RETP + (size_t)(b * 4 + h) * 256 * 512;
#pragma unroll
    for (int n = 0; n < 2; ++n)
#pragma unroll
        for (int d = 0; d < 4; ++d) *(f32x4*)(so + (size_t)((2 * wave + n) * 16 + l15) * 512 + dvs * 64 + d * 16 + quad * 4) = sacc[n][d];
}

__device__ __forceinline__ void ret_sample_unit(const Args& a, LAS unsigned char* lds, int i, int h, int tid) {
    unsigned char* ws = a.ws;
    const bf16_t* Prow = (const bf16_t*)(ws + WS_P) + (size_t)(MP + i) * NP;
    LAS float* Q = (LAS float*)lds; LAS float* Kh = Q + 256; LAS float* RED = Kh + 256; LAS float* OS = RED + 16;
    const float g = 1.f - exp2f(-5.f - (float)h);
    const int lane = tid & 63, wave = tid >> 6;
    float qk = 0.f;
    if (tid < 256) { const float q = bf2f(Prow[h * 256 + tid]), k = bf2f(Prow[O_K + h * 256 + tid]); Q[tid] = q; Kh[tid] = k; qk = q * k; }
    qk = wave_sum(qk);
    if (lane == 0) RED[wave] = qk;
    __syncthreads();
    const float qkv = (RED[0] + RED[1] + RED[2] + RED[3]) / g;
    const int dkg = tid >> 7, dv4 = 4 * (tid & 127);
    const u32x2 vw = *(const u32x2*)(Prow + O_V + h * 512 + dv4);
    const f32x4 v = {bflo(vw.x), bfhi(vw.x), bflo(vw.y), bfhi(vw.y)};
    const float* s0 = a.in[I_SRET] + (size_t)(i * 4 + h) * 256 * 512 + dv4;
    float* s1 = a.out + OUT_RETS + (size_t)(i * 4 + h) * 256 * 512 + dv4;
    f32x4 o = {0.f, 0.f, 0.f, 0.f};
#pragma unroll 8
    for (int j = 0; j < 64; ++j) {
        const int dk = dkg * 64 + j;
        const f32x4 s = __builtin_nontemporal_load((const f32x4*)(s0 + (size_t)dk * 512));
        o += s * Q[dk];
        __builtin_nontemporal_store(s * g + v * Kh[dk], (f32x4*)(s1 + (size_t)dk * 512));
    }
    *(LAS f32x4*)(OS + dkg * 512 + dv4) = o;
    __syncthreads();
    float y[4] = {0.f, 0.f, 0.f, 0.f}; float ss = 0.f;
    if (tid < 128) {
        const f32x4 t = *(LAS f32x4*)(OS + dv4) + *(LAS f32x4*)(OS + 512 + dv4) + *(LAS f32x4*)(OS + 1024 + dv4) + *(LAS f32x4*)(OS + 1536 + dv4) + v * qkv;
        y[0] = t.x; y[1] = t.y; y[2] = t.z; y[3] = t.w; ss = t.x * t.x + t.y * t.y + t.z * t.z + t.w * t.w;
    }
    ss = wave_sum(ss);
    if (lane == 0) RED[8 + wave] = ss;
    __syncthreads();
    if (tid < 128) {
        const float rs = 1.0f / sqrtf((RED[8] + RED[9]) * (1.f / 512.f) + EPS);
        const u32x2 gw = *(const u32x2*)(Prow + O_GA + h * 512 + dv4);
        u32x2 ow; ow.x = pk2(y[0] * rs * bflo(gw.x), y[1] * rs * bfhi(gw.x)); ow.y = pk2(y[2] * rs * bflo(gw.y), y[3] * rs * bfhi(gw.y));
        *(u32x2*)((bf16_t*)(ws + WS_OA) + (size_t)(MP + i) * 2048 + h * 512 + dv4) = ow;
    }
    __syncthreads();
}

__device__ __forceinline__ void phase25_row(const Args& a, int m, int lane) {
    unsigned char* ws = a.ws;
    const bf16_t* Prow = (const bf16_t*)(ws + WS_P) + (size_t)m * NP;
    if (m < MP) {
        bf16_t* oa = (bf16_t*)(ws + WS_OA) + (size_t)m * 2048;
        const float* sq = (const float*)(ws + WS_SQA) + (size_t)m * 32;
#pragma unroll
        for (int hh = 0; hh < 4; ++hh) {
            const f32x4 s0 = *(const f32x4*)(sq + hh * 8), s1 = *(const f32x4*)(sq + hh * 8 + 4);
            const float rs = 1.0f / sqrtf(((s0.x + s0.y) + (s0.z + s0.w) + (s1.x + s1.y) + (s1.z + s1.w)) * (1.f / 512.f) + EPS);
            const u32x4 ow = *(const u32x4*)(oa + hh * 512 + lane * 8), gw = *(const u32x4*)(Prow + O_GA + hh * 512 + lane * 8);
            u32x4 r;
            r.x = pk2(bflo(ow.x) * rs * bflo(gw.x), bfhi(ow.x) * rs * bfhi(gw.x)); r.y = pk2(bflo(ow.y) * rs * bflo(gw.y), bfhi(ow.y) * rs * bfhi(gw.y));
            r.z = pk2(bflo(ow.z) * rs * bflo(gw.z), bfhi(ow.z) * rs * bfhi(gw.z)); r.w = pk2(bflo(ow.w) * rs * bflo(gw.w), bfhi(ow.w) * rs * bfhi(gw.w));
            *(u32x4*)(oa + hh * 512 + lane * 8) = r;
        }
    }
    const float* ob = (const float*)(ws + WS_OB) + (size_t)m * D + lane * 16;
    float o[16];
#pragma unroll
    for (int j = 0; j < 4; ++j) { const f32x4 t = ((const f32x4*)ob)[j]; o[4 * j] = t.x; o[4 * j + 1] = t.y; o[4 * j + 2] = t.z; o[4 * j + 3] = t.w; }
    float s = 0.f;
#pragma unroll
    for (int j = 0; j < 16; ++j) s += o[j];
    s += __shfl_xor(s, 1); s += __shfl_xor(s, 2);
    const float mean = s * (1.f / 64.f);
    float q = 0.f;
#pragma unroll
    for (int j = 0; j < 16; ++j) { const float d = o[j] - mean; q += d * d; }
    q += __shfl_xor(q, 1); q += __shfl_xor(q, 2);
    const float rstd = 1.0f / sqrtf(q * (1.f / 64.f) + 64e-5f);
    const float bc = ((const float*)(ws + WS_BC))[(size_t)m * 16 + (lane >> 2)];
    const bf16_t* cur = Prow + O_SH + 2048 + lane * 16;
    const bf16_t* prv = (m >= MP) ? cur + (size_t)MS * NP : ((m & (T - 1)) ? cur - NP : nullptr);
    const bf16_t* gb = Prow + O_GB + lane * 16;
    const float* lnw = a.in[I_LNW] + lane * 16; const float* lnb = a.in[I_LNB] + lane * 16; const float* muv = a.in[I_MU] + 2048 + lane * 16;
    unsigned outw[8];
#pragma unroll
    for (int j = 0; j < 8; ++j) {
        float y[2];
#pragma unroll
        for (int e = 0; e < 2; ++e) {
            const int cix = 2 * j + e;
            const float c = bf2f(cur[cix]), p = prv ? bf2f(prv[cix]) : 0.f;
            const float vz = c + (p - c) * muv[cix];
            y[e] = ((o[cix] - mean) * rstd * lnw[cix] + lnb[cix] + bc * vz) * bf2f(gb[cix]);
        }
        outw[j] = pk2(y[0], y[1]);
    }
    bf16_t* yb = (bf16_t*)(ws + WS_H) + (size_t)m * D + lane * 16;
    *(u32x4*)yb = (u32x4){outw[0], outw[1], outw[2], outw[3]}; *(u32x4*)(yb + 8) = (u32x4){outw[4], outw[5], outw[6], outw[7]};
}

struct EpiT1 {
    static constexpr bool PERM = false;
    const bf16_t* P; float* T1;
    __device__ __forceinline__ void operator()(const f32x4 (&acc)[2][2][4][2], const Unit& u, int wr, int wc, int fr, int fq) const {
        const int row0 = u.pm * 256 + wr * 64 + fr, col0 = u.pn * 256 + wc * 32 + 4 * fq;
#pragma unroll
        for (int ai = 0; ai < 2; ++ai)
#pragma unroll
            for (int m = 0; m < 4; ++m) { const int row = row0 + ai * 128 + m * 16; if (row >= MR) continue;
#pragma unroll
                for (int bj = 0; bj < 2; ++bj)
#pragma unroll
                    for (int n = 0; n < 2; ++n) { const int col = col0 + bj * 128 + n * 16;
                        const u32x2 gw = *(const u32x2*)(P + (size_t)row * NP + O_MA + col);
                        const f32x4 gt = {bflo(gw.x), bfhi(gw.x), bflo(gw.y), bfhi(gw.y)};
                        *(f32x4*)(T1 + (size_t)row * D + col) = acc[ai][bj][m][n] * gt; } asm volatile("" ::: "memory"); }
    }
};
struct EpiMG {
    static constexpr bool PERM = false;
    const bf16_t* P; const float* T1; bf16_t* MG;
    __device__ __forceinline__ void operator()(const f32x4 (&acc)[2][2][4][2], const Unit& u, int wr, int wc, int fr, int fq) const {
        const int row0 = u.pm * 256 + wr * 64 + fr, col0 = u.pn * 256 + wc * 32 + 4 * fq;
#pragma unroll
        for (int ai = 0; ai < 2; ++ai)
#pragma unroll
            for (int m = 0; m < 4; ++m) { const int row = row0 + ai * 128 + m * 16; if (row >= MR) continue;
#pragma unroll
                for (int bj = 0; bj < 2; ++bj)
#pragma unroll
                    for (int n = 0; n < 2; ++n) { const int col = col0 + bj * 128 + n * 16;
                        const u32x2 gw = *(const u32x2*)(P + (size_t)row * NP + O_MB + col);
                        const f32x4 gt = {bflo(gw.x), bfhi(gw.x), bflo(gw.y), bfhi(gw.y)};
                        const f32x4 v = *(const f32x4*)(T1 + (size_t)row * D + col) + acc[ai][bj][m][n] * gt;
                        *(u32x2*)(MG + (size_t)row * D + col) = (u32x2){pk2(v.x, v.y), pk2(v.z, v.w)}; } asm volatile("" ::: "memory"); }
    }
};
struct EpiX1 {
    static constexpr bool PERM = false;
    const float* xp; const float* xs; float* X1; bf16_t* X1B; float* SQ;
    __device__ __forceinline__ void operator()(const f32x4 (&acc)[2][2][4][2], const Unit& u, int wr, int wc, int fr, int fq) const {
        const int row0 = u.pm * 256 + wr * 64 + fr, col0 = u.pn * 256 + wc * 32 + 4 * fq;
#pragma unroll
        for (int ai = 0; ai < 2; ++ai)
#pragma unroll
            for (int m = 0; m < 4; ++m) { const int row = row0 + ai * 128 + m * 16; const bool ok = row < MR;
                const float* xr = (row < MP) ? xp + (size_t)row * D : xs + (size_t)(row - MP) * D;
                float ss = 0.f;
                if (ok) {
#pragma unroll
                    for (int bj = 0; bj < 2; ++bj)
#pragma unroll
                        for (int n = 0; n < 2; ++n) { const int col = col0 + bj * 128 + n * 16;
                            const f32x4 v = *(const f32x4*)(xr + col) + acc[ai][bj][m][n];
                            ss += (v.x * v.x + v.y * v.y) + (v.z * v.z + v.w * v.w);
                            *(f32x4*)(X1 + (size_t)row * D + col) = v;
                            *(u32x2*)(X1B + (size_t)row * D + col) = (u32x2){pk2(v.x, v.y), pk2(v.z, v.w)}; }
                }
                ss += __shfl_xor(ss, 16); ss += __shfl_xor(ss, 32);
                if (ok && fq == 0) SQ[(size_t)row * 16 + u.pn * 4 + wc] = ss; asm volatile("" ::: "memory"); }
    }
};
struct EpiGT {
    static constexpr bool PERM = false;
    const float* SQ; float* GT;
    __device__ __forceinline__ void operator()(const f32x4 (&acc)[2][2][4][2], const Unit& u, int wr, int wc, int fr, int fq) const {
        const int row0 = u.pm * 256 + wr * 64 + fr, col0 = u.pn * 256 + wc * 32 + 4 * fq;
#pragma unroll
        for (int ai = 0; ai < 2; ++ai)
#pragma unroll
            for (int m = 0; m < 4; ++m) { const int row = row0 + ai * 128 + m * 16; if (row >= MR) continue;
                const f32x4* sp = (const f32x4*)(SQ + (size_t)row * 16); const f32x4 q0 = sp[0], q1 = sp[1], q2 = sp[2], q3 = sp[3];
                const float rs = 1.0f / sqrtf((((q0.x + q0.y) + (q0.z + q0.w)) + ((q1.x + q1.y) + (q1.z + q1.w)) + ((q2.x + q2.y) + (q2.z + q2.w)) + ((q3.x + q3.y) + (q3.z + q3.w))) * (1.f / D) + EPS);
#pragma unroll
                for (int bj = 0; bj < 2; ++bj)
#pragma unroll
                    for (int n = 0; n < 2; ++n) { const int col = col0 + bj * 128 + n * 16; const f32x4 t = acc[ai][bj][m][n] * rs;
                        *(f32x4*)(GT + (size_t)row * D + col) = (f32x4){sigm(t.x), sigm(t.y), sigm(t.z), sigm(t.w)}; } asm volatile("" ::: "memory"); }
    }
};
struct EpiX2 {
    static constexpr bool PERM = false;
    const float* X1; const float* GT; float* out; float* SQ;
    __device__ __forceinline__ void operator()(const f32x4 (&acc)[2][2][4][2], const Unit& u, int wr, int wc, int fr, int fq) const {
        const int row0 = u.pm * 256 + wr * 64 + fr, col0 = u.pn * 256 + wc * 32 + 4 * fq;
#pragma unroll
        for (int ai = 0; ai < 2; ++ai)
#pragma unroll
            for (int m = 0; m < 4; ++m) { int row = row0 + ai * 128 + m * 16; asm volatile("" : "+v"(row)); const bool ok = row < MR;
                float ss = 0.f;
                if (ok) {
#pragma unroll
                    for (int bj = 0; bj < 2; ++bj)
#pragma unroll
                        for (int n = 0; n < 2; ++n) { const int col = col0 + bj * 128 + n * 16;
                            const f32x4 v = *(const f32x4*)(X1 + (size_t)row * D + col) + acc[ai][bj][m][n] * *(const f32x4*)(GT + (size_t)row * D + col);
                            ss += (v.x * v.x + v.y * v.y) + (v.z * v.z + v.w * v.w);
                            *(f32x4*)(out + (size_t)row * D + col) = v; asm volatile("" ::: "memory"); }
                }
                ss += __shfl_xor(ss, 16); ss += __shfl_xor(ss, 32);
                if (ok && fq == 0) SQ[(size_t)row * 16 + u.pn * 4 + wc] = ss; asm volatile("" ::: "memory"); }
    }
};


__device__ __forceinline__ f32x4 mini_acc(const bf16_t* A, int lda, const bf16_t* Bt, int K, int kq, int l15, int quad) {
    f32x4 acc = {0.f, 0.f, 0.f, 0.f};
    const int kn = K / 128;
    const bf16_t* ap = A + (size_t)l15 * lda + kq * (K / 4) + quad * 8;
    const bf16_t* bp = Bt + (size_t)l15 * K + kq * (K / 4) + quad * 8;
#pragma unroll 4
    for (int ks = 0; ks < kn; ++ks) acc = MFMA32(*(const bf16x8*)(ap + ks * 32), *(const bf16x8*)(bp + ks * 32), acc);
    return acc;
}
__device__ __forceinline__ f32x4 mini_reduce(LAS f32x4* red, int half, int lane) { return (red[(half * 4 + 0) * 64 + lane] + red[(half * 4 + 1) * 64 + lane]) + (red[(half * 4 + 2) * 64 + lane] + red[(half * 4 + 3) * 64 + lane]); }
template <int PH> __device__ __forceinline__ void mini_phase(const Args& a, LAS unsigned char* lds, int bx, int G, int wave, int lane) {
    unsigned char* ws = a.ws;
    const int l15 = lane & 15, quad = lane >> 4, half = wave >> 2, kq = wave & 3;
    LAS f32x4* red1 = (LAS f32x4*)lds; LAS f32x4* red2 = red1 + 8 * 64;
    const bf16_t* P = (const bf16_t*)(ws + WS_P);
    for (int tp = bx; tp < 256; tp += G) {
        const int tl = tp * 2 + half, mt = tl >> 6, nt = tl & 63, row0 = MP + mt * 16, col0 = nt * 16;
        f32x4 a1, a2 = {0.f, 0.f, 0.f, 0.f};
        if (PH == 0) { a1 = mini_acc((const bf16_t*)(ws + WS_OA) + (size_t)row0 * 2048, 2048, (const bf16_t*)(ws + WS_WDA) + (size_t)col0 * 2048, 2048, kq, l15, quad);
                       a2 = mini_acc((const bf16_t*)(ws + WS_H) + (size_t)row0 * D, D, (const bf16_t*)(ws + WS_WDB) + (size_t)col0 * D, D, kq, l15, quad); }
        if (PH == 1) { a1 = mini_acc((const bf16_t*)(ws + WS_MG) + (size_t)row0 * D, D, (const bf16_t*)(ws + WS_WOUT) + (size_t)col0 * D, D, kq, l15, quad); }
        if (PH == 2) { a1 = mini_acc((const bf16_t*)(ws + WS_X1B) + (size_t)row0 * D, D, (const bf16_t*)(ws + WS_WGATE) + (size_t)col0 * D, D, kq, l15, quad);
                       a2 = mini_acc((const bf16_t*)(ws + WS_PB) + (size_t)row0 * PLE, PLE, (const bf16_t*)(ws + WS_WPLE) + (size_t)col0 * PLE, PLE, kq, l15, quad); }
        red1[wave * 64 + lane] = a1; red2[wave * 64 + lane] = a2;
        __syncthreads();
        if (kq == 0) {
            a1 = mini_reduce(red1, half, lane); a2 = mini_reduce(red2, half, lane);
            const int col = col0 + l15;
            float rs1[4] = {0.f, 0.f, 0.f, 0.f};
            if (PH == 2) {
#pragma unroll
                for (int r = 0; r < 4; ++r) { const f32x4 q = *(const f32x4*)((const float*)(ws + WS_SQS1) + (size_t)(row0 - MP + quad * 4 + r) * 64 + l15 * 4); float t = (q.x + q.y) + (q.z + q.w);
#pragma unroll
                    for (int o = 1; o < 16; o <<= 1) t += __shfl_xor(t, o);
                    rs1[r] = 1.0f / sqrtf(t * (1.f / D) + EPS); }
            }
#pragma unroll
            for (int r = 0; r < 4; ++r) {
                const int row = row0 + quad * 4 + r;
                float ss = 0.f;
                if (PH == 0) { const float ga = bf2f(P[(size_t)row * NP + O_MA + col]), gb = bf2f(P[(size_t)row * NP + O_MB + col]);
                    ((bf16_t*)(ws + WS_MG))[(size_t)row * D + col] = f2bf(a1[r] * ga + a2[r] * gb); }
                if (PH == 1) { const float x1 = a.in[I_XS][(size_t)(row - MP) * D + col] + a1[r]; ss = x1 * x1;
                    ((float*)(ws + WS_X1))[(size_t)row * D + col] = x1; ((bf16_t*)(ws + WS_X1B))[(size_t)row * D + col] = f2bf(x1); }
                if (PH == 2) { const float x2 = ((const float*)(ws + WS_X1))[(size_t)row * D + col] + a2[r] * sigm(rs1[r] * a1[r]); ss = x2 * x2;
                    a.out[OUT_Y + (size_t)row * D + col] = x2; }
                if (PH != 0) {
#pragma unroll
                    for (int o = 1; o < 16; o <<= 1) ss += __shfl_xor(ss, o);
                    if (l15 == 0) ((float*)(ws + (PH == 1 ? WS_SQS1 : WS_SQS2)))[(size_t)(row - MP) * 64 + nt] = ss;
                }
            }
        }
        __syncthreads();
    }
}

#define XB_TMO      128
#define XB_XCNT(j)  (256  + 64 * (j))
#define XB_XSUB(j)  (1280 + 64 * (j))
#define XB_XGEN(j)  (2304 + 64 * (j))
#define XB_TOP      3328
#define XB_TOPGEN   3392
#define XCD_BAR_WORDS 3456
#define XB_SPIN_CAP (1u << 22)
__device__ __forceinline__ unsigned xb_ld(unsigned* p)              { return __hip_atomic_load(p, __ATOMIC_RELAXED, __HIP_MEMORY_SCOPE_AGENT); }
__device__ __forceinline__ unsigned xb_add(unsigned* p, unsigned v) { return __hip_atomic_fetch_add(p, v, __ATOMIC_RELAXED, __HIP_MEMORY_SCOPE_AGENT); }
__device__ __forceinline__ unsigned xb_xcc_id() { return (unsigned)__builtin_amdgcn_s_getreg((3 << 11) | 20) & 0xFu; }
#define XB_SPIN(cond, bar) do { unsigned _sp = 0; while (cond) { __builtin_amdgcn_s_sleep(1); \
    if ((++_sp & 255u) == 0u) { if (xb_ld(&(bar)[XB_TMO])) break; if (_sp > XB_SPIN_CAP) { atomicAdd(&(bar)[XB_TMO], 1u); break; } } } } while (0)
struct XcdBarrier { unsigned* bar; unsigned x; volatile LAS unsigned* st; };
__device__ __forceinline__ XcdBarrier xcd_barrier_post(unsigned* bar, volatile LAS unsigned* st) {
    XcdBarrier b; b.bar = bar; b.x = xb_xcc_id(); b.st = st;
    if (threadIdx.x == 0) (void)xb_add(&bar[XB_XCNT(b.x)], 1u);
    return b;
}
__device__ __forceinline__ void xcd_barrier_complete(unsigned* bar, unsigned x, unsigned& nloc, unsigned& nx) {
    const unsigned G = gridDim.x * gridDim.y * gridDim.z;
    unsigned sum, cnt, mine, sp = 0u;
    for (;;) {
        sum = 0u; cnt = 0u; mine = 0u;
#pragma unroll
        for (unsigned j = 0; j < 16; ++j) { const unsigned c = xb_ld(&bar[XB_XCNT(j)]); sum += c; cnt += (c > 0u) ? 1u : 0u; mine = (j == x) ? c : mine; }
        if (sum == G) break;
        __builtin_amdgcn_s_sleep(1);
        if ((++sp & 255u) == 0u) { if (xb_ld(&bar[XB_TMO])) break; if (sp > XB_SPIN_CAP) { atomicAdd(&bar[XB_TMO], 1u); break; } }
    }
    nloc = mine > 0u ? mine : 1u; nx = cnt > 0u ? cnt : 1u;
}
__device__ __forceinline__ void xcd_barrier(const XcdBarrier& b) {
    asm volatile("s_waitcnt vmcnt(0)" ::: "memory");
    __syncthreads();
    if (threadIdx.x == 0) {
        unsigned* bar = b.bar;
        __builtin_amdgcn_s_waitcnt(0);
        unsigned nloc = b.st[0], nx = b.st[1];
        if (nloc == 0u) { xcd_barrier_complete(bar, b.x, nloc, nx); b.st[0] = nloc; b.st[1] = nx; }
        const unsigned old = xb_add(&bar[XB_XSUB(b.x)], 1u);
        const unsigned gen = old / nloc;
        if (old + 1u == (gen + 1u) * nloc) {
            __builtin_amdgcn_fence(__ATOMIC_RELEASE, "agent");
            asm volatile("s_waitcnt vmcnt(0)" ::: "memory");
            const unsigned og = xb_add(&bar[XB_TOP], 1u);
            const unsigned tg = og / nx;
            if (og + 1u == (tg + 1u) * nx) xb_add(&bar[XB_TOPGEN], 1u);
            else XB_SPIN(xb_ld(&bar[XB_TOPGEN]) == tg, bar);
            __builtin_amdgcn_fence(__ATOMIC_ACQUIRE, "agent");
            xb_add(&bar[XB_XGEN(b.x)], 1u);
            asm volatile("s_waitcnt vmcnt(0)" ::: "memory");
        } else {
            XB_SPIN(xb_ld(&bar[XB_XGEN(b.x)]) == gen, bar);
            __builtin_amdgcn_fence(__ATOMIC_ACQUIRE, "agent");
            asm volatile("s_waitcnt vmcnt(0)" ::: "memory");
        }
    }
    __syncthreads();
}

constexpr int LDS_BYTES = 147456;
constexpr int CTL_SQ1 = 0, CTL_SQ2 = 32768, CTL_CNT = 65536;

#define GRID_SYNC() xcd_barrier(xbar)
__global__ void __launch_bounds__(512, 2) fwd_mega(Args a) {
    extern __shared__ __attribute__((aligned(16))) unsigned char lds_raw[];
    LAS unsigned char* lds = (LAS unsigned char*)lds_raw;
    cg::grid_group grid = cg::this_grid();
    const int tid = threadIdx.x, lane = tid & 63, wave = __builtin_amdgcn_readfirstlane(tid >> 6);
    const int G = gridDim.x, bx = blockIdx.x;
    const int gw = bx * 8 + wave, NGW = G * 8;
    unsigned char* ws = a.ws;
    if (tid < 16) ((LAS unsigned*)(lds + 131072 + 64))[tid] = 0u;
    __syncthreads();
    XcdBarrier xbar = xcd_barrier_post((unsigned*)(ws + WS_BAR), (volatile LAS unsigned*)(lds + 131072 + 64));
    grid.sync();

#if !defined(ONLY_PH) || ONLY_PH == 0
    phase0(a, lds, gw, NGW, wave, lane);
    GRID_SYNC();
#endif
#if !defined(ONLY_PH) || ONLY_PH == 1
    {
        pg8::Gemm g{(const bf16_t*)(ws + WS_H), (const bf16_t*)(ws + WS_WIN), MALL, NP, D}; pg8::StaticOrder S; S.init(MALL, NP, G, bx);
        EpiP E{(bf16_t*)(ws + WS_P), (bf16_t*)(ws + WS_KT), (const f32x2*)(ws + WS_ROPE)};
        pg8::gemm_phase<EpiP>(lds, g, S, E);
    }
    GRID_SYNC();
#endif
#if !defined(ONLY_PH) || ONLY_PH == 2
    for (int it = gw; it < 1032 * 16; it += NGW) rw_prep_item(a, lds + wave * 10240, it >> 4, it & 15, lane);
    GRID_SYNC();
#endif
#if !defined(ONLY_PH) || ONLY_PH == 3
    {
        if (bx < 128 && wave < 4) rw_scan_task(a, lds + wave * 4096, bx >> 4, bx & 15, wave, lane);
        __syncthreads();
        for (int u = bx; u < 256; u += G) ret_unit(a, lds, u, tid);
        for (int u = bx; u < MS * 4; u += G) ret_sample_unit(a, lds, u >> 2, u & 3, tid);
        for (int u = bx; u < MS * 16; u += G) rw_sample_unit(a, u >> 4, u & 15, tid);
    }
    GRID_SYNC();
#endif
#if !defined(ONLY_PH) || ONLY_PH == 4
    for (int m = gw; m < MR; m += NGW) phase25_row(a, m, lane);
    GRID_SYNC();
#endif
#if !defined(ONLY_PH) || ONLY_PH == 5
    {
        mini_phase<0>(a, lds, bx, G, wave, lane);
        pg8::StaticOrder S; S.init(MP, D, G, bx);
        { pg8::Gemm g{(const bf16_t*)(ws + WS_OA), (const bf16_t*)(ws + WS_WDA), MP, D, 2048}; EpiT1 E{(const bf16_t*)(ws + WS_P), (float*)(ws + WS_T1)}; pg8::gemm_phase<EpiT1>(lds, g, S, E); }
        { pg8::Gemm g{(const bf16_t*)(ws + WS_H), (const bf16_t*)(ws + WS_WDB), MP, D, D}; EpiMG E{(const bf16_t*)(ws + WS_P), (const float*)(ws + WS_T1), (bf16_t*)(ws + WS_MG)}; pg8::gemm_phase<EpiMG>(lds, g, S, E); }
    }
    GRID_SYNC();
#endif
#if !defined(ONLY_PH) || ONLY_PH == 6
    {
        mini_phase<1>(a, lds, bx, G, wave, lane);
        pg8::StaticOrder S; S.init(MP, D, G, bx);
        pg8::Gemm g{(const bf16_t*)(ws + WS_MG), (const bf16_t*)(ws + WS_WOUT), MP, D, D};
        EpiX1 E{a.in[I_XP], a.in[I_XS], (float*)(ws + WS_X1), (bf16_t*)(ws + WS_X1B), (float*)(ws + WS_SQ1P)};
        pg8::gemm_phase<EpiX1>(lds, g, S, E);
    }
    GRID_SYNC();
#endif
#if !defined(ONLY_PH) || ONLY_PH == 7
    {
        mini_phase<2>(a, lds, bx, G, wave, lane);
        pg8::StaticOrder S; S.init(MP, D, G, bx);
        { pg8::Gemm g{(const bf16_t*)(ws + WS_X1B), (const bf16_t*)(ws + WS_WGATE), MP, D, D}; EpiGT E{(const float*)(ws + WS_SQ1P), (float*)(ws + WS_GT)}; pg8::gemm_phase<EpiGT>(lds, g, S, E); }
        { pg8::Gemm g{(const bf16_t*)(ws + WS_PB), (const bf16_t*)(ws + WS_WPLE), MP, D, PLE}; EpiX2 E{(const float*)(ws + WS_X1), (const float*)(ws + WS_GT), a.out + OUT_Y, (float*)(ws + WS_SQ2P)}; pg8::gemm_phase<EpiX2>(lds, g, S, E); }
    }
    GRID_SYNC();
#endif
#if !defined(ONLY_PH) || ONLY_PH == 8
    {
        const float* sq2 = (const float*)(ws + WS_SQ2P); const float* fg = a.in[I_FNG];
        for (int m = gw; m < MR; m += NGW) {
            float tot;
            if (m < MP) { const f32x4* sp = (const f32x4*)(sq2 + (size_t)m * 16); const f32x4 q0 = sp[0], q1 = sp[1], q2 = sp[2], q3 = sp[3];
                tot = (((q0.x + q0.y) + (q0.z + q0.w)) + ((q1.x + q1.y) + (q1.z + q1.w)) + ((q2.x + q2.y) + (q2.z + q2.w)) + ((q3.x + q3.y) + (q3.z + q3.w))); }
            else tot = wave_sum(((const float*)(ws + WS_SQS2))[(size_t)(m - MP) * 64 + lane]);
            const float rs = 1.0f / sqrtf(tot * (1.f / D) + EPS);
            f32x4* o = (f32x4*)(a.out + OUT_Y + (size_t)m * D);
#pragma unroll
            for (int j = 0; j < 4; ++j) o[lane + 64 * j] = o[lane + 64 * j] * rs * ((const f32x4*)fg)[lane + 64 * j];
        }
    }
#endif

}

extern "C" void kernel_launch(void* const* d_in, const int* in_sizes, int n_in, void* d_out, int out_size, void* d_ws, size_t ws_size, hipStream_t stream) {
    static int grid = 0;
    if (grid == 0) {
        if (n_in != 26 || ws_size < WS_END) { fprintf(stderr, "kernel_launch: unexpected n_in %d or ws_size %zu (need %zu)\n", n_in, ws_size, (size_t)WS_END); grid = -1; return; }
        int dev = 0, cus = 0, per_cu = 0;
        hipGetDevice(&dev); hipDeviceGetAttribute(&cus, hipDeviceAttributeMultiprocessorCount, dev);
        if (hipFuncSetAttribute((const void*)fwd_mega, hipFuncAttributeMaxDynamicSharedMemorySize, LDS_BYTES) != hipSuccess) { fprintf(stderr, "kernel_launch: hipFuncSetAttribute failed\n"); grid = -1; return; }
        hipOccupancyMaxActiveBlocksPerMultiprocessor(&per_cu, (const void*)fwd_mega, 512, LDS_BYTES);
        if (per_cu < 1) { fprintf(stderr, "kernel_launch: occupancy query says %d blocks per CU\n", per_cu); per_cu = 1; }
        (void)hipGetLastError();
        grid = cus * 1;
        fprintf(stderr, "kernel_launch: grid %d (cus %d, per_cu %d), ws %zu\n", grid, cus, per_cu, ws_size);
    }
    if (grid < 0) return;
    Args a{};
    for (int i = 0; i < 26; ++i) a.in[i] = (const float*)d_in[i];
    a.out = (float*)d_out; a.ws = (unsigned char*)d_ws;
    if (hipMemsetAsync((char*)d_ws + WS_BAR, 0, XCD_BAR_WORDS * 4, stream) != hipSuccess) { fprintf(stderr, "kernel_launch: memset failed\n"); return; }
    void* args[] = {&a};
    hipError_t e = hipLaunchCooperativeKernel((const void*)fwd_mega, dim3(grid), dim3(512), args, LDS_BYTES, stream);
    if (e != hipSuccess) fprintf(stderr, "kernel_launch: cooperative launch failed: %s\n", hipGetErrorString(e));
}
```

```cpp
#include <hip/hip_runtime.h>
#include <hip/hip_cooperative_groups.h>
#include <cstdio>
#include <cstdint>
namespace cg = cooperative_groups;

#define LAS __attribute__((address_space(3)))
typedef unsigned short bf16_t;
typedef short bf16x8 __attribute__((ext_vector_type(8)));
typedef short bf16x4 __attribute__((ext_vector_type(4)));
typedef float f32x4 __attribute__((ext_vector_type(4)));
typedef float f32x2 __attribute__((ext_vector_type(2)));
typedef unsigned u32x4 __attribute__((ext_vector_type(4)));
typedef unsigned u32x2 __attribute__((ext_vector_type(2)));
typedef __bf16 nbf2 __attribute__((ext_vector_type(2)));

constexpr int D = 1024, NB = 8, T = 2048, MP = NB * T  , MS = 128, MR = MP + MS  , MALL = 16640  ;
constexpr int NCOLS = 12416, NP = 12544  ;
constexpr int O_K = 1024, O_V = 2048, O_GA = 4096, O_SH = 6144, O_GB = 9344, O_MA = 10368, O_MB = 11392;
constexpr int RH = 4, RDK = 256, RDV = 512, RCH = 128;
constexpr int WH = 16, WN = 64;
constexpr int PLE = 256;
constexpr float EPS = 1e-6f;
constexpr int REC = 12544;
constexpr int R_AT = 0, R_RT = 2048, R_BP = 4096, R_KP = 6144, R_VT = 8192, R_AAK = 10240, R_TT = 10752, R_ARB = 11264, R_ARK = 11776, R_WC = 12288;

constexpr size_t MiB = 1u << 20;
constexpr size_t WS_CTL = 0;
constexpr size_t WS_ROPE = 1 * MiB;
constexpr size_t WS_W2T = 4 * MiB, WS_A2T = WS_W2T + 131072;
constexpr size_t WS_WPLE = 5 * MiB, WS_WDB = 6 * MiB, WS_WOUT = 8 * MiB, WS_WGATE = 10 * MiB, WS_WDA = 12 * MiB, WS_WIN = 16 * MiB;
constexpr size_t WS_PB = 41 * MiB, WS_H = 50 * MiB  , WS_KT = 83 * MiB, WS_SQA = 115 * MiB, WS_BC = 117 * MiB, WS_OPSS = 119 * MiB  ;
constexpr size_t WS_OA = 122 * MiB, WS_P = 188 * MiB, WS_CH = 587 * MiB  , WS_OB = 786 * MiB  ;
constexpr size_t WS_T1 = WS_CH, WS_MG = WS_CH + 65 * MiB, WS_X1B = WS_CH + 98 * MiB, WS_GT = WS_CH + 131 * MiB, WS_X1 = WS_OB + 65 * MiB  ;
constexpr size_t WS_END = 916 * MiB;
constexpr size_t WS_BAR = 512 * 1024;
constexpr size_t WS_SQS1 = 640 * 1024, WS_SQS2 = 704 * 1024;
constexpr size_t WS_SQ1P = WS_KT, WS_SQ2P = WS_KT + 2 * MiB;

constexpr size_t OUT_Y = 0, OUT_RETP = 16908288, OUT_RWP = 21102592, OUT_SHP = 21626880, OUT_RETS = 21635072, OUT_RWS = 88743936, OUT_SHS = 97132544;

__device__ __forceinline__ unsigned pk2(float lo, float hi) { f32x2 v = {lo, hi}; nbf2 r = __builtin_convertvector(v, nbf2); return __builtin_bit_cast(unsigned, r); }
__device__ __forceinline__ unsigned short f2bf(float f) { return (unsigned short)(pk2(f, 0.f) & 0xffffu); }
__device__ __forceinline__ float bf2f(unsigned short b) { return __uint_as_float(((unsigned)b) << 16); }
__device__ __forceinline__ float bflo(unsigned w) { return __uint_as_float(w << 16); }
__device__ __forceinline__ float bfhi(unsigned w) { return __uint_as_float(w & 0xffff0000u); }
__device__ __forceinline__ float sigm(float x) { return __builtin_amdgcn_rcpf(1.f + __expf(-x)); }
__device__ __forceinline__ float wave_sum(float v) {
#pragma unroll
    for (int o = 1; o < 64; o <<= 1) v += __shfl_xor(v, o);
    return v;
}
#define MFMA32(a, b, c) __builtin_amdgcn_mfma_f32_16x16x32_bf16((a), (b), (c), 0, 0, 0)
#define LDS_WAIT() asm volatile("s_waitcnt lgkmcnt(0)" ::: "memory")

namespace pg8 {
constexpr int BM = 256, BK = 64, HALF = 128, HTB = HALF * BK * 2, STAGE_BYTES = 8 * HTB, NXCD = 8, WGM = 8;
__host__ __device__ __forceinline__ int lds_byte(int r, int c) { const int st = (r >> 4) * 2 + (c >> 5), rr = r & 15, cc = c & 31, ob = rr * 64 + cc * 2; return st * 1024 + (ob ^ (((ob >> 9) & 1) << 5)); }
__host__ __device__ __forceinline__ void stage_rc(int b, int& R, int& C) { const int st = b / 1024, sb = b % 1024, swz = sb ^ (((sb >> 9) & 1) << 5); R = (st >> 1) * 16 + swz / 64; C = (st & 1) * 32 + (swz % 64) / 2; }
__host__ __device__ __forceinline__ int perm32(int rho) { const int n = rho >> 4, i = rho & 15; return 8 * (i >> 2) + 4 * n + (i & 3); }
struct Unit { int pm, pn; };
struct Gemm { const bf16_t* A; const bf16_t* Bt; int M, N, K; };
struct StaticOrder {
    int nM, nN, nwg, G, c;
    __host__ __device__ void init(int M, int N, int G_, int c_) { nM = M / BM; nN = N / BM; nwg = nM * nN; G = G_; c = c_; }
    __host__ __device__ bool next(int i, Unit& u) const {
        const long L = (long)i * G + c; if (L >= nwg) return false;
        int wgid = (int)L; { const int q = nwg / NXCD, r = nwg % NXCD, xcd = wgid % NXCD, off = wgid / NXCD; wgid = (xcd < r ? xcd * (q + 1) : r * (q + 1) + (xcd - r) * q) + off; }
        const int nig = WGM * nN, gid = wgid / nig, fm = gid * WGM, gsz = (nM - fm) < WGM ? (nM - fm) : WGM;
        u.pm = fm + ((wgid % nig) % gsz); u.pn = (wgid % nig) / gsz; return true;
    }
};
template <class Epi>
__device__ __forceinline__ void gemm_phase(LAS unsigned char* lds, const Gemm g, const StaticOrder& S, const Epi& E) {
    int tid = threadIdx.x; asm volatile("" : "+v"(tid));
    const int wid = __builtin_amdgcn_readfirstlane(tid >> 6), lane = tid & 63, wr = wid >> 2, wc = wid & 3, fr = lane & 15, fq = lane >> 4;
    const int K = g.K, nt = K / BK;
    unsigned voffA[2], voffB[2];
#pragma unroll
    for (int i = 0; i < 2; ++i) { int R, C; stage_rc(tid * 16 + i * 8192, R, C); const int Rb = Epi::PERM ? ((R & ~31) + perm32(R & 31)) : R;
        voffA[i] = (unsigned)(R * K + C) * 2u; voffB[i] = (unsigned)(Rb * K + C) * 2u; }
    const size_t kstep = (size_t)(BK * 2);
    const size_t hstep = (size_t)HALF * K * 2;
    const size_t tstep = 2 * hstep;
    const unsigned ldsw = (unsigned)wid * 1024u;
    const int aoff = lds_byte(wr * 64 + fr, fq * 8), boff = lds_byte(wc * 32 + fr, fq * 8);
#define PG8_SA(b, h) (((b) * 2 + (h)) * HTB)
#define PG8_SB(b, h) ((4 + (b) * 2 + (h)) * HTB)
#define PG8_STAGE(bufoff, gbase, voff) do { _Pragma("unroll") for (int _i = 0; _i < 2; ++_i) \
        __builtin_amdgcn_global_load_lds((const unsigned*)((const char*)(gbase) + (voff)[_i]), (LAS unsigned*)(lds + (bufoff) + ldsw + _i * 8192), 16, 0, 0); } while (0)
#define PG8_LDA(dst, b, h) do { _Pragma("unroll") for (int m = 0; m < 4; ++m) _Pragma("unroll") for (int k = 0; k < 2; ++k) dst[m][k] = *(const LAS bf16x8*)(lds + PG8_SA(b, h) + aoff + m * 2048 + k * 1024); } while (0)
#define PG8_LDB(dst, b, h) do { _Pragma("unroll") for (int n = 0; n < 2; ++n) _Pragma("unroll") for (int k = 0; k < 2; ++k) dst[n][k] = *(const LAS bf16x8*)(lds + PG8_SB(b, h) + boff + n * 2048 + k * 1024); } while (0)
#define PG8_MMA(ai, bj, At, Bt) do { __builtin_amdgcn_s_setprio(1); _Pragma("unroll") for (int m = 0; m < 4; ++m) _Pragma("unroll") for (int n = 0; n < 2; ++n) _Pragma("unroll") for (int k = 0; k < 2; ++k) \
        acc[ai][bj][m][n] = __builtin_amdgcn_mfma_f32_16x16x32_bf16(Bt[n][k], At[m][k], acc[ai][bj][m][n], 0, 0, 0); __builtin_amdgcn_s_setprio(0); } while (0)
#define PG8_WAIT_V(n) asm volatile("s_waitcnt vmcnt(" #n ")" ::: "memory")
#define PG8_WAIT_L(n) asm volatile("s_waitcnt lgkmcnt(" #n ")" ::: "memory")
#define PG8_BAR __builtin_amdgcn_s_barrier()
#define PG8_SCHED __builtin_amdgcn_sched_barrier(0)
    Unit cur, nxt; int ui = 0;
    if (!S.next(0, cur)) return;
    f32x4 acc[2][2][4][2];
#pragma unroll
    for (int a = 0; a < 2; ++a)
#pragma unroll
        for (int b = 0; b < 2; ++b)
#pragma unroll
            for (int m = 0; m < 4; ++m)
#pragma unroll
                for (int n = 0; n < 2; ++n) acc[a][b][m][n] = (f32x4){0.f, 0.f, 0.f, 0.f};
    bf16x8 At[4][2], B0[2][2], B1[2][2];
    const char* cA = (const char*)g.A + (size_t)cur.pm * tstep; const char* cB = (const char*)g.Bt + (size_t)cur.pn * tstep;
    PG8_STAGE(PG8_SB(0, 0), cB, voffB); PG8_STAGE(PG8_SA(0, 0), cA, voffA); PG8_STAGE(PG8_SB(0, 1), cB + hstep, voffB); PG8_STAGE(PG8_SA(0, 1), cA + hstep, voffA);
    if (wr == 1) PG8_BAR;
    PG8_WAIT_V(4); PG8_BAR;
    PG8_STAGE(PG8_SB(1, 0), cB + kstep, voffB); PG8_STAGE(PG8_SA(1, 0), cA + kstep, voffA); PG8_STAGE(PG8_SB(1, 1), cB + hstep + kstep, voffB);
    PG8_WAIT_V(6); PG8_BAR;
    for (;;) {
        const bool has_next = S.next(ui + 1, nxt);
        const char* nA = has_next ? (const char*)g.A + (size_t)nxt.pm * tstep : cA; const char* nB = has_next ? (const char*)g.Bt + (size_t)nxt.pn * tstep : cB;
#pragma unroll 1
        for (int t = 0; t < nt; t += 2) {
            const bool last = (t == nt - 2);
            const char* a1 = cA + (size_t)(t + 1) * kstep;
            const char* a2 = last ? nA : cA + (size_t)(t + 2) * kstep; const char* b2 = last ? nB : cB + (size_t)(t + 2) * kstep;
            const char* a3 = a2 + kstep; const char* b3 = b2 + kstep;
            PG8_LDB(B0, 0, 0); PG8_SCHED; PG8_LDA(At, 0, 0); PG8_STAGE(PG8_SA(1, 1), a1 + hstep, voffA);
            PG8_WAIT_L(8); PG8_BAR; PG8_WAIT_L(0); PG8_MMA(0, 0, At, B0); PG8_BAR; PG8_SCHED;
            PG8_LDB(B1, 0, 1); PG8_STAGE(PG8_SB(0, 0), b2, voffB);
            PG8_BAR; PG8_WAIT_L(0); PG8_MMA(0, 1, At, B1); PG8_BAR;
            PG8_LDA(At, 0, 1); PG8_STAGE(PG8_SA(0, 0), a2, voffA);
            PG8_BAR; PG8_WAIT_L(0); PG8_MMA(1, 0, At, B0); PG8_BAR; PG8_SCHED;
            PG8_STAGE(PG8_SB(0, 1), b2 + hstep, voffB);
            PG8_WAIT_V(6); PG8_BAR; PG8_MMA(1, 1, At, B1); PG8_BAR;
            PG8_LDB(B0, 1, 0); PG8_SCHED; PG8_LDA(At, 1, 0); PG8_STAGE(PG8_SA(0, 1), a2 + hstep, voffA);
            PG8_WAIT_L(8); PG8_BAR; PG8_WAIT_L(0); PG8_MMA(0, 0, At, B0); PG8_BAR; PG8_SCHED;
            PG8_LDB(B1, 1, 1); PG8_STAGE(PG8_SB(1, 0), b3, voffB);
            PG8_BAR; PG8_WAIT_L(0); PG8_MMA(0, 1, At, B1); PG8_BAR;
            PG8_LDA(At, 1, 1); PG8_STAGE(PG8_SA(1, 0), a3, voffA);
            PG8_BAR; PG8_WAIT_L(0); PG8_MMA(1, 0, At, B0); PG8_BAR; PG8_SCHED;
            PG8_STAGE(PG8_SB(1, 1), b3 + hstep, voffB);
            PG8_WAIT_V(6); PG8_BAR; PG8_MMA(1, 1, At, B1); PG8_BAR;
        }
        E(acc, cur, wr, wc, fr, fq);
        if (!has_next) break;
#pragma unroll
        for (int a = 0; a < 2; ++a)
#pragma unroll
            for (int b = 0; b < 2; ++b)
#pragma unroll
                for (int m = 0; m < 4; ++m)
#pragma unroll
                    for (int n = 0; n < 2; ++n) acc[a][b][m][n] = (f32x4){0.f, 0.f, 0.f, 0.f};
        cur = nxt; cA = nA; cB = nB; ++ui;
    }
    PG8_WAIT_V(0);
    if (wr == 0) PG8_BAR;
    PG8_BAR;
#undef PG8_SA
#undef PG8_SB
#undef PG8_STAGE
#undef PG8_LDA
#undef PG8_LDB
#undef PG8_MMA
#undef PG8_WAIT_V
#undef PG8_WAIT_L
#undef PG8_BAR
#undef PG8_SCHED
}
}
using pg8::Unit;

struct Args {
    const float* in[26];
    float* out; unsigned char* ws;
};
enum { I_XP = 0, I_XS, I_SRET, I_SRW, I_SSH, I_PP, I_PS, I_NG, I_WIN, I_MU, I_W0, I_W2, I_A0, I_A2, I_KK, I_KA, I_RK, I_LNW, I_LNB, I_WDA, I_WDB, I_WOUT, I_WPLE, I_PNG, I_WPG, I_FNG };

__device__ __forceinline__ void p0_transpose_item(const float* W, int K, int N, bf16_t* WT, LAS float* scr, int item, int lane, const float* kscale) {
    const int nblk = N / 32, kb = item / nblk, nb = item % nblk, k0 = 64 * kb, n0 = 32 * nb;
#pragma unroll 8
    for (int i = 0; i < 32; ++i) { const int kk = 2 * i + (lane >> 5); float v = W[(size_t)(k0 + kk) * N + n0 + (lane & 31)]; if (kscale) v *= kscale[k0 + kk]; scr[kk * 33 + (lane & 31)] = v; }
    LDS_WAIT();
    const int c = lane & 7;
#pragma unroll
    for (int j = 0; j < 4; ++j) { const int n = (lane >> 3) + 8 * j; const LAS float* s = scr + (8 * c) * 33 + n;
        u32x4 o; o.x = pk2(s[0 * 33], s[1 * 33]); o.y = pk2(s[2 * 33], s[3 * 33]); o.z = pk2(s[4 * 33], s[5 * 33]); o.w = pk2(s[6 * 33], s[7 * 33]);
        *(u32x4*)(WT + (size_t)(n0 + n) * K + k0 + 8 * c) = o; }
    LDS_WAIT();
}

__device__ __forceinline__ void phase0(const Args& a, LAS unsigned char* lds, int gw, int NGW, int wave, int lane) {
    unsigned char* ws = a.ws;
    LAS float* scr = (LAS float*)(lds + wave * 16384);
    constexpr int I_IN = (D / 64) * (NCOLS / 32), I_DA = (2048 / 64) * (D / 32), I_SQ = (D / 64) * (D / 32), I_PL = (PLE / 64) * (D / 32), I_LR = 1 * (D / 32);
    constexpr int NITEMS = I_IN + I_DA + 3 * I_SQ + I_PL + 2 * I_LR;
    for (int it = gw; it < NITEMS; it += NGW) {
        int r = it;
        if (r < I_IN) { p0_transpose_item(a.in[I_WIN], D, NCOLS, (bf16_t*)(ws + WS_WIN), scr, r, lane, nullptr); continue; } r -= I_IN;
        if (r < I_DA) { p0_transpose_item(a.in[I_WDA], 2048, D, (bf16_t*)(ws + WS_WDA), scr, r, lane, nullptr); continue; } r -= I_DA;
        if (r < I_SQ) { p0_transpose_item(a.in[I_WDB], D, D, (bf16_t*)(ws + WS_WDB), scr, r, lane, nullptr); continue; } r -= I_SQ;
        if (r < I_SQ) { p0_transpose_item(a.in[I_WOUT], D, D, (bf16_t*)(ws + WS_WOUT), scr, r, lane, nullptr); continue; } r -= I_SQ;
        if (r < I_SQ) { p0_transpose_item(a.in[I_WPG], D, D, (bf16_t*)(ws + WS_WGATE), scr, r, lane, a.in[I_PNG]); continue; } r -= I_SQ;
        if (r < I_PL) { p0_transpose_item(a.in[I_WPLE], PLE, D, (bf16_t*)(ws + WS_WPLE), scr, r, lane, nullptr); continue; } r -= I_PL;
        if (r < I_LR) { p0_transpose_item(a.in[I_W2], 64, D, (bf16_t*)(ws + WS_W2T), scr, r, lane, nullptr); continue; } r -= I_LR;
        p0_transpose_item(a.in[I_A2], 64, D, (bf16_t*)(ws + WS_A2T), scr, r, lane, nullptr);
    }
    for (int i = gw * 64 + lane; i < 128 * D / 8; i += NGW * 64) ((u32x4*)(ws + WS_WIN + (size_t)NCOLS * D * 2))[i] = (u32x4){0u, 0u, 0u, 0u};
    bf16_t* H = (bf16_t*)(ws + WS_H);
    const float* ng = a.in[I_NG];
    for (int m = gw; m < MALL; m += NGW) {
        if (m < MR) {
            const float* xr = (m < MP) ? a.in[I_XP] + (size_t)m * D : a.in[I_XS] + (size_t)(m - MP) * D;
            f32x4 v[4]; float s = 0.f;
#pragma unroll
            for (int j = 0; j < 4; ++j) { v[j] = ((const f32x4*)xr)[lane + 64 * j]; s += (v[j].x * v[j].x + v[j].y * v[j].y) + (v[j].z * v[j].z + v[j].w * v[j].w); }
            const float rs = 1.0f / sqrtf(wave_sum(s) * (1.f / D) + EPS);
            float* so = nullptr;
            if (m < MP) { if ((m & (T - 1)) == T - 1) so = a.out + OUT_SHP + (size_t)(m >> 11) * D; } else so = a.out + OUT_SHS + (size_t)(m - MP) * D;
#pragma unroll
            for (int j = 0; j < 4; ++j) { const f32x4 gg = ((const f32x4*)ng)[lane + 64 * j]; f32x4 h = v[j] * rs * gg;
                if (so) ((f32x4*)so)[lane + 64 * j] = h;
                u32x2 o; o.x = pk2(h.x, h.y); o.y = pk2(h.z, h.w); ((u32x2*)(H + (size_t)m * D))[lane + 64 * j] = o; }
        } else {
            const float* xr = a.in[I_SSH] + (size_t)(m - MR) * D;
#pragma unroll
            for (int j = 0; j < 4; ++j) { const f32x4 h = ((const f32x4*)xr)[lane + 64 * j]; u32x2 o; o.x = pk2(h.x, h.y); o.y = pk2(h.z, h.w); ((u32x2*)(H + (size_t)m * D))[lane + 64 * j] = o; }
        }
        u32x2 o = {0u, 0u};
        if (m < MR) { const float* pr = (m < MP) ? a.in[I_PP] + (size_t)m * PLE : a.in[I_PS] + (size_t)(m - MP) * PLE; const f32x4 p = ((const f32x4*)pr)[lane]; o.x = pk2(p.x, p.y); o.y = pk2(p.z, p.w); }
        ((u32x2*)(ws + WS_PB + (size_t)m * PLE * 2))[lane] = o;
    }
    for (int i = gw * 64 + lane; i < 2049 * 128; i += NGW * 64) {
        const int pos = i >> 7, j = i & 127; const double p = (pos == 2048) ? 16384.0 : (double)pos;
        double inv = 1.0, base = 0.9305720409296989; int e = j;
        while (e) { if (e & 1) inv *= base; base *= base; e >>= 1; }
        double rev = p * inv * 0.15915494309189535; rev -= floor(rev);
        const float fr = (float)rev;
        ((f32x2*)(ws + WS_ROPE))[i] = (f32x2){__builtin_amdgcn_cosf(fr), __builtin_amdgcn_sinf(fr)};
    }
    for (int i = gw * 64 + lane; i < 65536 + 64; i += NGW * 64) ((float*)(ws + WS_CTL))[i] = 0.f;
}

struct EpiP {
    static constexpr bool PERM = true;
    bf16_t* P; bf16_t* KT; const f32x2* rope;
    __device__ __forceinline__ void operator()(const f32x4 (&acc)[2][2][4][2], const Unit& u, int wr, int wc, int fr, int fq) const {
        const int pn = u.pn, pm = u.pm;
        const int row0 = pm * 256 + wr * 64 + fr, cl0 = wc * 32 + 8 * fq;
        const bool sample = (pm == 64);
        if (pn < 8) {
            const int h = pn & 3; const bool isk = pn >= 4;
            const float l2g = __log2f(1.f - exp2f(-5.f - (float)h));
#pragma unroll
            for (int ai = 0; ai < 2; ++ai)
#pragma unroll
                for (int m = 0; m < 4; ++m) {
                    const int row = row0 + ai * 128 + m * 16;
                    int pos, ex;
                    if (sample) { pos = 2048; ex = isk ? 0 : 1; } else { pos = row & (T - 1); const int idx = pos & 127; ex = isk ? 127 - idx : idx + 1; }
                    const float sc = exp2f((float)ex * l2g) * (isk ? 0.0625f : 1.0f);
                    const f32x4* rp = (const f32x4*)(rope + pos * 128 + cl0);
                    f32x4 cs[4]; cs[0] = rp[0]; cs[1] = rp[1]; cs[2] = rp[2]; cs[3] = rp[3];
                    float y1[8], y2[8];
#pragma unroll
                    for (int n = 0; n < 2; ++n)
#pragma unroll
                        for (int e = 0; e < 4; ++e) {
                            const float c = (e & 1) ? cs[n * 2 + (e >> 1)].z : cs[n * 2 + (e >> 1)].x, s = (e & 1) ? cs[n * 2 + (e >> 1)].w : cs[n * 2 + (e >> 1)].y;
                            const float x1 = acc[ai][0][m][n][e], x2 = acc[ai][1][m][n][e];
                            y1[n * 4 + e] = (x1 * c - x2 * s) * sc; y2[n * 4 + e] = (x2 * c + x1 * s) * sc;
                        }
                    u32x4 w1, w2;
                    w1.x = pk2(y1[0], y1[1]); w1.y = pk2(y1[2], y1[3]); w1.z = pk2(y1[4], y1[5]); w1.w = pk2(y1[6], y1[7]);
                    w2.x = pk2(y2[0], y2[1]); w2.y = pk2(y2[2], y2[3]); w2.z = pk2(y2[4], y2[5]); w2.w = pk2(y2[6], y2[7]);
                    bf16_t* rowp = P + (size_t)row * NP + pn * 256 + cl0;
                    *(u32x4*)rowp = w1; *(u32x4*)(rowp + 128) = w2;
                    if (isk && !sample) {
                        bf16_t* kt = KT + ((size_t)((row >> 11) * 4 + h) * 256 + cl0) * T + pos;
#pragma unroll
                        for (int j = 0; j < 8; ++j) { kt[(size_t)j * T] = f2bf(y1[j]); kt[(size_t)(j + 128) * T] = f2bf(y2[j]); }
                    }
                }
            return;
        }
#pragma unroll
        for (int bj = 0; bj < 2; ++bj) {
            const int cb = pn * 2 + bj;
            if (cb >= 97) continue;
            const int mode = (cb < 32) ? 0 : (cb < 48) ? 1 : (cb < 73) ? 0 : (cb < 81) ? 1 : 2;
            const bool vt = (cb < 32) && !sample;
#pragma unroll
            for (int ai = 0; ai < 2; ++ai)
#pragma unroll
                for (int m = 0; m < 4; ++m) {
                    const int row = row0 + ai * 128 + m * 16;
                    float y[8];
#pragma unroll
                    for (int n = 0; n < 2; ++n)
#pragma unroll
                        for (int e = 0; e < 4; ++e) { float x = acc[ai][bj][m][n][e]; if (mode == 1) x = x * sigm(x); else if (mode == 2) x = sigm(x); y[n * 4 + e] = x; }
                    if (vt) {
                        const int hd = cb * 128 + cl0 - O_V;
                        bf16_t* vp = P + ((size_t)(row >> 11) * T + hd) * NP + O_V + (row & (T - 1));
#pragma unroll
                        for (int j = 0; j < 8; ++j) vp[(size_t)j * NP] = f2bf(y[j]);
                    } else {
                        u32x4 w; w.x = pk2(y[0], y[1]); w.y = pk2(y[2], y[3]); w.z = pk2(y[4], y[5]); w.w = pk2(y[6], y[7]);
                        *(u32x4*)(P + (size_t)row * NP + cb * 128 + cl0) = w;
                    }
                }
        }
    }
};

__device__ __forceinline__ float lerp_bf(const bf16_t* cur, const bf16_t* prv, float mu) { const float c = bf2f(*cur); const float p = prv ? bf2f(*prv) : 0.f; return c + (p - c) * mu; }

__device__ __forceinline__ void rw_prep_item(const Args& a, LAS unsigned char* wl  , int tt, int h, int lane) {
    unsigned char* ws = a.ws;
    const bf16_t* P = (const bf16_t*)(ws + WS_P);
    const int l15 = lane & 15, quad = lane >> 4;
    const bool sample = tt >= 1024;
    const int row_base = sample ? MP + (tt - 1024) * 16 : tt * 16;
    const float* mu = a.in[I_MU];
    bf16x8 Aw[2], Aa[2];
    {
        const int m = row_base + l15;
        const bf16_t* cur = P + (size_t)m * NP + O_SH;
        const bf16_t* prv = sample ? P + (size_t)(m + MS) * NP + O_SH : ((m & (T - 1)) ? cur - NP : nullptr);
#pragma unroll
        for (int which = 0; which < 2; ++which)
#pragma unroll
            for (int ks = 0; ks < 2; ++ks) {
                const int col = 3072 + which * 64 + ks * 32 + quad * 8;
                const u32x4 cw = *(const u32x4*)(cur + col); u32x4 pw = {0u, 0u, 0u, 0u}; if (prv) pw = *(const u32x4*)(prv + col);
                const f32x4 m0 = *(const f32x4*)(mu + col), m1 = *(const f32x4*)(mu + col + 4);
                float z[8];
                const unsigned cws[4] = {cw.x, cw.y, cw.z, cw.w}, pws[4] = {pw.x, pw.y, pw.z, pw.w};
#pragma unroll
                for (int j = 0; j < 4; ++j) {
                    const float c0 = bflo(cws[j]), c1 = bfhi(cws[j]), p0 = bflo(pws[j]), p1 = bfhi(pws[j]);
                    const float mm0 = (j < 2) ? m0[2 * j] : m1[2 * j - 4], mm1 = (j < 2) ? m0[2 * j + 1] : m1[2 * j - 3];
                    z[2 * j] = c0 + (p0 - c0) * mm0; z[2 * j + 1] = c1 + (p1 - c1) * mm1;
                }
                if (which == 0) {
#pragma unroll
                    for (int j = 0; j < 8; ++j) z[j] = 1.f - 2.f / (__expf(2.f * z[j]) + 1.f);
                }
                u32x4 o; o.x = pk2(z[0], z[1]); o.y = pk2(z[2], z[3]); o.z = pk2(z[4], z[5]); o.w = pk2(z[6], z[7]);
                if (which == 0) Aw[ks] = __builtin_bit_cast(bf16x8, o); else Aa[ks] = __builtin_bit_cast(bf16x8, o);
            }
    }
    const bf16_t* W2T = (const bf16_t*)(ws + WS_W2T); const bf16_t* A2T = (const bf16_t*)(ws + WS_A2T);
    unsigned char* rec = ws + WS_CH + ((size_t)((tt >> 7) * 16 + h) * 128 + (tt & 127)) * REC;
    LAS bf16_t* LA = (LAS bf16_t*)wl;
    LAS bf16_t* LR = LA + 16 * 72;
    LAS bf16_t* LB = LR + 16 * 72;
    LAS bf16_t* LK = LB + 16 * 72;
    LAS float* LN = (LAS float*)(wl + 9216);
    float tA[4][4], tBi[4][4], tBp[4][4];
    float ssq[4] = {0.f, 0.f, 0.f, 0.f}, bon[4] = {0.f, 0.f, 0.f, 0.f};
#pragma unroll
    for (int nt = 0; nt < 4; ++nt) {
        const int ch = h * 64 + nt * 16 + l15, cc = nt * 16 + l15;
        f32x4 cw = {0.f, 0.f, 0.f, 0.f}, ca = {0.f, 0.f, 0.f, 0.f};
#pragma unroll
        for (int ks = 0; ks < 2; ++ks) {
            const bf16x8 bw = *(const bf16x8*)(W2T + (size_t)ch * 64 + ks * 32 + quad * 8), ba = *(const bf16x8*)(A2T + (size_t)ch * 64 + ks * 32 + quad * 8);
            cw = MFMA32(Aw[ks], bw, cw); ca = MFMA32(Aa[ks], ba, ca);
        }
        const float w0 = a.in[I_W0][ch], a0 = a.in[I_A0][ch], k_k = a.in[I_KK][ch], k_a = a.in[I_KA][ch], r_k = a.in[I_RK][ch];
        const float mur = mu[ch], muk = mu[1024 + ch], muv = mu[2048 + ch];
        float lw[4], rr[4], kq[4], vv[4], aa4[4], kr4[4];
#pragma unroll
        for (int r = 0; r < 4; ++r) {
            const int m = row_base + quad * 4 + r;
            const bf16_t* cur = P + (size_t)m * NP + O_SH + ch;
            const bf16_t* prv = sample ? P + (size_t)(m + MS) * NP + O_SH + ch : ((m & (T - 1)) ? cur - NP : nullptr);
            const float r_ = lerp_bf(cur, prv, mur), k_ = lerp_bf(cur + 1024, prv ? prv + 1024 : nullptr, muk), v_ = lerp_bf(cur + 2048, prv ? prv + 2048 : nullptr, muv);
            lw[r] = -0.6065306597126334f * sigm(w0 + cw[r]);
            const float aa = sigm(a0 + ca[r]); aa4[r] = aa;
            const float kr = k_ * k_k; kr4[r] = kr; ssq[r] += kr * kr;
            const float kpp = k_ * (1.f + (aa - 1.f) * k_a); kq[r] = kpp;
            rr[r] = r_; vv[r] = v_; bon[r] += r_ * kpp * r_k;
        }
        if (sample) {
#pragma unroll
            for (int r = 0; r < 4; ++r) {
                const int i = (tt - 1024) * 16 + quad * 4 + r;
                float* o = (float*)(ws + WS_OPSS) + ((size_t)(i * 16 + h) * 6) * 64 + cc;
                o[0] = rr[r]; o[64] = __expf(lw[r]); o[128] = kq[r]; o[320] = vv[r];
                tA[nt][r] = kr4[r]; tBi[nt][r] = aa4[r] * kr4[r]; tBp[nt][r] = 0.f;
            }
        } else {
            float c[4]; c[0] = lw[0]; c[1] = c[0] + lw[1]; c[2] = c[1] + lw[2]; c[3] = c[2] + lw[3];
            const float tot = c[3];
            const float s1 = __shfl(tot, (lane - 16) & 63), s2 = __shfl(tot, (lane - 32) & 63), s3 = __shfl(tot, (lane - 48) & 63);
            const float off = (quad >= 1 ? s1 : 0.f) + (quad >= 2 ? s2 : 0.f) + (quad >= 3 ? s3 : 0.f);
            const float total = __shfl(c[3] + off, 48 + l15);
            float kqp[4];
#pragma unroll
            for (int r = 0; r < 4; ++r) {
                const float cum = c[r] + off, cumx = cum - lw[r];
                const float ea = __expf(cumx), er = __expf(cum), ei = __expf(-cum), ep = __expf(total - cum);
                const int tk = quad * 4 + r;
                LR[tk * 72 + cc] = f2bf(rr[r] * er); LK[tk * 72 + cc] = f2bf(kq[r] * ei);
                kqp[r] = kq[r] * ep;
                tA[nt][r] = kr4[r] * ea; tBi[nt][r] = aa4[r] * kr4[r] * ei; tBp[nt][r] = aa4[r] * kr4[r] * ep;
            }
            *(u32x2*)(rec + R_KP + cc * 32 + quad * 8) = (u32x2){pk2(kqp[0], kqp[1]), pk2(kqp[2], kqp[3])};
            *(u32x2*)(rec + R_VT + cc * 32 + quad * 8) = (u32x2){pk2(vv[0], vv[1]), pk2(vv[2], vv[3])};
            if (quad == 0) *(float*)(rec + R_WC + cc * 4) = __expf(total);
        }
        asm volatile("" ::: "memory");
    }
    float inv[4];
#pragma unroll
    for (int r = 0; r < 4; ++r) {
        float s = ssq[r], b = bon[r];
#pragma unroll
        for (int o = 1; o < 16; o <<= 1) { s += __shfl_xor(s, o); b += __shfl_xor(b, o); }
        inv[r] = 1.f / fmaxf(sqrtf(s), 1e-12f);
        if (l15 == 0) ((float*)(ws + WS_BC))[(size_t)(row_base + quad * 4 + r) * 16 + h] = b;
    }
    if (sample) {
#pragma unroll
        for (int nt = 0; nt < 4; ++nt)
#pragma unroll
            for (int r = 0; r < 4; ++r) {
                const int i = (tt - 1024) * 16 + quad * 4 + r;
                float* o = (float*)(ws + WS_OPSS) + ((size_t)(i * 16 + h) * 6) * 64 + nt * 16 + l15;
                o[192] = tA[nt][r] * inv[r]; o[256] = tBi[nt][r] * inv[r];
            }
        return;
    }
#pragma unroll
    for (int nt = 0; nt < 4; ++nt) {
        const int cc = nt * 16 + l15;
        float bp[4];
#pragma unroll
        for (int r = 0; r < 4; ++r) { const int tk = quad * 4 + r;
            LA[tk * 72 + cc] = f2bf(-tA[nt][r] * inv[r]); LB[tk * 72 + cc] = f2bf(tBi[nt][r] * inv[r]); bp[r] = tBp[nt][r] * inv[r]; }
        *(u32x2*)(rec + R_BP + cc * 32 + quad * 8) = (u32x2){pk2(bp[0], bp[1]), pk2(bp[2], bp[3])};
    }
    LDS_WAIT();
#pragma unroll
    for (int i = 0; i < 2; ++i) { const int idx = lane + 64 * i, rr = idx >> 3, c8 = (idx & 7) * 8;
        *(u32x4*)(rec + R_AT + rr * 128 + c8 * 2) = *(const LAS u32x4*)(LA + rr * 72 + c8);
        *(u32x4*)(rec + R_RT + rr * 128 + c8 * 2) = *(const LAS u32x4*)(LR + rr * 72 + c8); }
    f32x4 nab = {0.f, 0.f, 0.f, 0.f}, nak = nab, nrb = nab, nrk = nab;
#pragma unroll
    for (int ks = 0; ks < 2; ++ks) {
        const bf16x8 fa = *(const LAS bf16x8*)(LA + l15 * 72 + ks * 32 + quad * 8), fr_ = *(const LAS bf16x8*)(LR + l15 * 72 + ks * 32 + quad * 8);
        const bf16x8 fb = *(const LAS bf16x8*)(LB + l15 * 72 + ks * 32 + quad * 8), fk = *(const LAS bf16x8*)(LK + l15 * 72 + ks * 32 + quad * 8);
        nab = MFMA32(fa, fb, nab); nak = MFMA32(fa, fk, nak); nrb = MFMA32(fr_, fb, nrb); nrk = MFMA32(fr_, fk, nrk);
    }
#pragma unroll
    for (int r = 0; r < 4; ++r) {
        const int t = quad * 4 + r, j = l15;
        const float vab = (j < t) ? nab[r] : 0.f, vak = (j < t) ? nak[r] : 0.f, vrb = (j <= t) ? nrb[r] : 0.f, vrk = (j <= t) ? nrk[r] : 0.f;
        LN[t * 16 + j] = vab;
        *(bf16_t*)(rec + R_AAK + (t * 16 + j) * 2) = f2bf(vak);
        *(bf16_t*)(rec + R_ARB + (t * 16 + j) * 2) = f2bf(vrb);
        *(bf16_t*)(rec + R_ARK + (t * 16 + j) * 2) = f2bf(vrk);
    }
    LDS_WAIT();
    if (lane < 16) {
        float tc[16];
#pragma unroll
        for (int t = 0; t < 16; ++t) {
            float s = (t == lane) ? 1.f : 0.f;
#pragma unroll
            for (int j = 0; j < t; ++j) s += LN[t * 16 + j] * tc[j];
            tc[t] = s;
            *(bf16_t*)(rec + R_TT + (t * 16 + lane) * 2) = f2bf(s);
        }
    }
    LDS_WAIT();
}

struct ScanFr { bf16x8 at[2], rt[2]; u32x2 aak, tt, arb, ark, vt, bp[4], kp[4]; float wc[4]; };
__device__ __forceinline__ bf16x8 k16(u32x2 v) { const u32x4 w = {v.x, v.y, 0u, 0u}; return __builtin_bit_cast(bf16x8, w); }
__device__ __forceinline__ void scan_load(ScanFr& f, const unsigned char* rec, int vt, int l15, int quad) {
#pragma unroll
    for (int ks = 0; ks < 2; ++ks) { f.at[ks] = *(const bf16x8*)(rec + R_AT + l15 * 128 + ks * 64 + quad * 16); f.rt[ks] = *(const bf16x8*)(rec + R_RT + l15 * 128 + ks * 64 + quad * 16); }
    f.aak = *(const u32x2*)(rec + R_AAK + l15 * 32 + quad * 8); f.tt = *(const u32x2*)(rec + R_TT + l15 * 32 + quad * 8);
    f.arb = *(const u32x2*)(rec + R_ARB + l15 * 32 + quad * 8); f.ark = *(const u32x2*)(rec + R_ARK + l15 * 32 + quad * 8);
    f.vt = *(const u32x2*)(rec + R_VT + (vt * 16 + l15) * 32 + quad * 8);
#pragma unroll
    for (int nt = 0; nt < 4; ++nt) { f.bp[nt] = *(const u32x2*)(rec + R_BP + (nt * 16 + l15) * 32 + quad * 8); f.kp[nt] = *(const u32x2*)(rec + R_KP + (nt * 16 + l15) * 32 + quad * 8);
        f.wc[nt] = *(const float*)(rec + R_WC + (nt * 16 + l15) * 4); }
}
__device__ __forceinline__ void rw_scan_task(const Args& a, LAS unsigned char* wl  , int b, int h, int vt, int lane) {
    unsigned char* ws = a.ws;
    const int l15 = lane & 15, quad = lane >> 4;
    LAS bf16_t* Sb = (LAS bf16_t*)wl;
    LAS bf16_t* Yb = (LAS bf16_t*)(wl + 2304);
    LAS bf16_t* Ub = (LAS bf16_t*)(wl + 2304 + 512);
    f32x4 S[4];
#pragma unroll
    for (int nt = 0; nt < 4; ++nt) { S[nt] = (f32x4){0.f, 0.f, 0.f, 0.f};
#pragma unroll
        for (int r = 0; r < 4; ++r) Sb[(quad * 4 + r) * 72 + nt * 16 + l15] = 0; }
    LDS_WAIT();
    const unsigned char* rec0 = ws + WS_CH + (size_t)((b * 16 + h) * 128) * REC;
    float* OB = (float*)(ws + WS_OB);
    ScanFr f, g, n;
    scan_load(f, rec0, vt, l15, quad); scan_load(g, rec0 + REC, vt, l15, quad);
    for (int ch = 0; ch < 128; ++ch) {
        scan_load(n, rec0 + (size_t)(ch < 126 ? ch + 2 : 127) * REC, vt, l15, quad);
        const bf16x8 sa0 = *(const LAS bf16x8*)(Sb + l15 * 72 + quad * 8), sa1 = *(const LAS bf16x8*)(Sb + l15 * 72 + 32 + quad * 8);
        const bf16x8 vtf = k16(f.vt);
        f32x4 z = {0.f, 0.f, 0.f, 0.f};
        f32x4 Y = MFMA32(sa0, f.at[0], z); Y = MFMA32(sa1, f.at[1], Y); Y = MFMA32(vtf, k16(f.aak), Y);
#pragma unroll
        for (int r = 0; r < 4; ++r) Yb[(quad * 4 + r) * 16 + l15] = f2bf(Y[r]);
        LDS_WAIT();
        const bf16x8 ya = k16(*(const LAS u32x2*)(Yb + l15 * 16 + quad * 4));
        f32x4 U = MFMA32(ya, k16(f.tt), z);
#pragma unroll
        for (int r = 0; r < 4; ++r) Ub[(quad * 4 + r) * 16 + l15] = f2bf(U[r]);
        LDS_WAIT();
        const bf16x8 ua = k16(*(const LAS u32x2*)(Ub + l15 * 16 + quad * 4));
        f32x4 O = MFMA32(sa0, f.rt[0], z); O = MFMA32(sa1, f.rt[1], O); O = MFMA32(ua, k16(f.arb), O); O = MFMA32(vtf, k16(f.ark), O);
        *(f32x4*)(OB + (size_t)(b * T + ch * 16 + l15) * D + h * 64 + vt * 16 + quad * 4) = O;
#pragma unroll
        for (int nt = 0; nt < 4; ++nt) {
            f32x4 sn = S[nt] * f.wc[nt];
            sn = MFMA32(ua, k16(f.bp[nt]), sn); sn = MFMA32(vtf, k16(f.kp[nt]), sn);
            S[nt] = sn;
#pragma unroll
            for (int r = 0; r < 4; ++r) Sb[(quad * 4 + r) * 72 + nt * 16 + l15] = f2bf(sn[r]);
        }
        LDS_WAIT();
        f = g; g = n;
    }
    float* so = a.out + OUT_RWP + (size_t)((b * 16 + h) * 64 + vt * 16) * 64;
#pragma unroll
    for (int nt = 0; nt < 4; ++nt)
#pragma unroll
        for (int r = 0; r < 4; ++r) so[(quad * 4 + r) * 64 + nt * 16 + l15] = S[nt][r];
}

__device__ __forceinline__ void rw_sample_wave(const Args& a, int i, int h, int lane) {
    unsigned char* ws = a.ws;
    const float* s0 = a.in[I_SRW] + ((size_t)(i * 16 + h) * 64 + lane) * 64;
    const float* op = (const float*)(ws + WS_OPSS) + (size_t)(i * 16 + h) * 6 * 64;
    float s[64];
#pragma unroll
    for (int j = 0; j < 16; ++j) { const f32x4 t = ((const f32x4*)s0)[j]; s[4 * j] = t.x; s[4 * j + 1] = t.y; s[4 * j + 2] = t.z; s[4 * j + 3] = t.w; }
    const float r_l = op[lane], w_l = op[64 + lane], k_l = op[128 + lane], kk_l = op[192 + lane], b_l = op[256 + lane], v = op[320 + lane];
#define RL(x, j) __builtin_bit_cast(float, __builtin_amdgcn_readlane(__builtin_bit_cast(int, (x)), (j)))
    float sk = 0.f;
#pragma unroll
    for (int j = 0; j < 64; ++j) sk += s[j] * RL(kk_l, j);
    float o = 0.f;
#pragma unroll
    for (int j = 0; j < 64; ++j) { s[j] = s[j] * RL(w_l, j) - sk * RL(b_l, j) + v * RL(k_l, j); o += s[j] * RL(r_l, j); }
#undef RL
    float* so = a.out + OUT_RWS + ((size_t)(i * 16 + h) * 64 + lane) * 64;
#pragma unroll
    for (int j = 0; j < 16; ++j) ((f32x4*)so)[j] = (f32x4){s[4 * j], s[4 * j + 1], s[4 * j + 2], s[4 * j + 3]};
    ((float*)(ws + WS_OB))[(size_t)(MP + i) * D + h * 64 + lane] = o;
}

constexpr int KN_LD = 264, VS_LD = 136, SS_LD = 264;
constexpr int L_KN = 0, L_VS = 128 * KN_LD * 2  , L_SS = L_VS + 64 * VS_LD * 2  , L_RET_END = L_SS + 64 * SS_LD * 2  ;
__device__ __forceinline__ void ret_unit(const Args& a, LAS unsigned char* lds, int unit, int tid) {
    unsigned char* ws = a.ws;
    const bf16_t* P = (const bf16_t*)(ws + WS_P);
    const int dvs = unit & 7, h = (unit >> 3) & 3, b = unit >> 5;
    const int wave = tid >> 6, lane = tid & 63, l15 = lane & 15, quad = lane >> 4;
    LAS bf16_t* KN = (LAS bf16_t*)(lds + L_KN); LAS bf16_t* VS = (LAS bf16_t*)(lds + L_VS); LAS bf16_t* SS = (LAS bf16_t*)(lds + L_SS);
    const float g = 1.f - exp2f(-5.f - (float)h), l2g = __log2f(g);
    const float gC = exp2f(128.f * l2g), ginvC = exp2f(-128.f * l2g);
    const bf16_t* KT = (const bf16_t*)(ws + WS_KT) + (size_t)(b * 4 + h) * 256 * T;
    f32x4 sacc[2][4];
#pragma unroll
    for (int n = 0; n < 2; ++n)
#pragma unroll
        for (int d = 0; d < 4; ++d) sacc[n][d] = (f32x4){0.f, 0.f, 0.f, 0.f};
    for (int i = tid; i < 64 * SS_LD / 2; i += 512) ((LAS unsigned*)SS)[i] = 0u;
    const int it = wave;
    for (int c = 0; c < 16; ++c) {
        const int tok0 = b * T + c * 128;
#pragma unroll
        for (int i = 0; i < 8; ++i) { const int idx = tid + 512 * i, r = idx >> 5, c8 = (idx & 31) * 8;
            *(LAS u32x4*)(KN + r * KN_LD + c8) = *(const u32x4*)(P + (size_t)(tok0 + r) * NP + O_K + h * 256 + c8); }
#pragma unroll
        for (int i = 0; i < 2; ++i) { const int idx = tid + 512 * i, r = idx >> 4, c8 = (idx & 15) * 8;
            *(LAS u32x4*)(VS + r * VS_LD + c8) = *(const u32x4*)(P + (size_t)(b * T + h * 512 + dvs * 64 + r) * NP + O_V + c * 128 + c8); }
        bf16x8 qf[8];
#pragma unroll
        for (int ks = 0; ks < 8; ++ks) qf[ks] = *(const bf16x8*)(P + (size_t)(tok0 + it * 16 + l15) * NP + h * 256 + ks * 32 + quad * 8);
        bf16x8 ktf[2][4];
#pragma unroll
        for (int n = 0; n < 2; ++n)
#pragma unroll
            for (int ks = 0; ks < 4; ++ks) ktf[n][ks] = *(const bf16x8*)(KT + (size_t)((2 * wave + n) * 16 + l15) * T + c * 128 + ks * 32 + quad * 8);
        __syncthreads();
        f32x4 oacc[4];
#pragma unroll
        for (int d = 0; d < 4; ++d) oacc[d] = (f32x4){0.f, 0.f, 0.f, 0.f};
#pragma unroll
        for (int ks = 0; ks < 8; ++ks)
#pragma unroll
            for (int d = 0; d < 4; ++d) { const bf16x8 sb = *(const LAS bf16x8*)(SS + (d * 16 + l15) * SS_LD + ks * 32 + quad * 8); oacc[d] = MFMA32(qf[ks], sb, oacc[d]); }
#pragma unroll
        for (int p = 0; p < 4; ++p) {
            if (2 * p <= it) {
                f32x4 s0 = {0.f, 0.f, 0.f, 0.f}, s1 = {0.f, 0.f, 0.f, 0.f};
#pragma unroll
                for (int ks = 0; ks < 8; ++ks) { const bf16x8 ka = *(const LAS bf16x8*)(KN + ((2 * p) * 16 + l15) * KN_LD + ks * 32 + quad * 8); s0 = MFMA32(ka, qf[ks], s0); }
                if (2 * p + 1 <= it) {
#pragma unroll
                    for (int ks = 0; ks < 8; ++ks) { const bf16x8 ka = *(const LAS bf16x8*)(KN + ((2 * p + 1) * 16 + l15) * KN_LD + ks * 32 + quad * 8); s1 = MFMA32(ka, qf[ks], s1); }
                }
#pragma unroll
                for (int r = 0; r < 4; ++r) {
                    const int jl = quad * 4 + r;
                    s0[r] = (2 * p == it && jl > l15) ? 0.f : s0[r] * ginvC;
                    s1[r] = (2 * p + 1 > it || (2 * p + 1 == it && jl > l15)) ? 0.f : s1[r] * ginvC;
                }
                u32x4 aw; aw.x = pk2(s0[0], s0[1]); aw.y = pk2(s0[2], s0[3]); aw.z = pk2(s1[0], s1[1]); aw.w = pk2(s1[2], s1[3]);
                const bf16x8 af = __builtin_bit_cast(bf16x8, aw);
#pragma unroll
                for (int d = 0; d < 4; ++d) {
                    const LAS bf16_t* vr = VS + (d * 16 + l15) * VS_LD + 32 * p + quad * 4;
                    const u32x2 lo = *(const LAS u32x2*)vr, hi = *(const LAS u32x2*)(vr + 16);
                    const u32x4 bw = {lo.x, lo.y, hi.x, hi.y};
                    oacc[d] = MFMA32(af, __builtin_bit_cast(bf16x8, bw), oacc[d]);
                }
            }
        }
        {
            bf16_t* OA = (bf16_t*)(ws + WS_OA); float* SQA = (float*)(ws + WS_SQA);
#pragma unroll
            for (int r = 0; r < 4; ++r) {
                const int tok = tok0 + it * 16 + quad * 4 + r;
                float ss = 0.f;
#pragma unroll
                for (int d = 0; d < 4; ++d) { const float v = oacc[d][r]; ss += v * v; OA[(size_t)tok * 2048 + h * 512 + dvs * 64 + d * 16 + l15] = f2bf(v); }
#pragma unroll
                for (int o = 1; o < 16; o <<= 1) ss += __shfl_xor(ss, o);
                if (l15 == 0) SQA[(size_t)tok * 32 + h * 8 + dvs] = ss;
            }
        }
        __syncthreads();
#pragma unroll
        for (int n = 0; n < 2; ++n)
#pragma unroll
            for (int d = 0; d < 4; ++d) {
                f32x4 s = sacc[n][d] * gC;
#pragma unroll
                for (int ks = 0; ks < 4; ++ks) { const bf16x8 va = *(const LAS bf16x8*)(VS + (d * 16 + l15) * VS_LD + ks * 32 + quad * 8); s = MFMA32(va, ktf[n][ks], s); }
                sacc[n][d] = s;
#pragma unroll
                for (int r = 0; r < 4; ++r) SS[(d * 16 + quad * 4 + r) * SS_LD + (2 * wave + n) * 16 + l15] = f2bf(s[r]);
            }
        __syncthreads();
    }
    float* so = a.out + OUT_RETP + (size_t)(b * 4 + h) * 256 * 512;
#pragma unroll
    for (int n = 0; n < 2; ++n)
#pragma unroll
        for (int d = 0; d < 4; ++d) *(f32x4*)(so + (size_t)((2 * wave + n) * 16 + l15) * 512 + dvs * 64 + d * 16 + quad * 4) = sacc[n][d];
}

__device__ __forceinline__ void ret_sample_unit(const Args& a, LAS unsigned char* lds, int i, int h, int tid) {
    unsigned char* ws = a.ws;
    const bf16_t* Prow = (const bf16_t*)(ws + WS_P) + (size_t)(MP + i) * NP;
    LAS float* Q = (LAS float*)lds; LAS float* Kh = Q + 256; LAS float* RED = Kh + 256; LAS float* OS = RED + 16;
    const float g = 1.f - exp2f(-5.f - (float)h);
    const int lane = tid & 63, wave = tid >> 6;
    float qk = 0.f;
    if (tid < 256) { const float q = bf2f(Prow[h * 256 + tid]), k = bf2f(Prow[O_K + h * 256 + tid]); Q[tid] = q; Kh[tid] = k; qk = q * k; }
    qk = wave_sum(qk);
    if (lane == 0) RED[wave] = qk;
    __syncthreads();
    const float qkv = (RED[0] + RED[1] + RED[2] + RED[3]) / g;
    const int dkg = tid >> 7, dv4 = 4 * (tid & 127);
    const u32x2 vw = *(const u32x2*)(Prow + O_V + h * 512 + dv4);
    const f32x4 v = {bflo(vw.x), bfhi(vw.x), bflo(vw.y), bfhi(vw.y)};
    const float* s0 = a.in[I_SRET] + (size_t)(i * 4 + h) * 256 * 512 + dv4;
    float* s1 = a.out + OUT_RETS + (size_t)(i * 4 + h) * 256 * 512 + dv4;
    f32x4 o = {0.f, 0.f, 0.f, 0.f};
#pragma unroll 8
    for (int j = 0; j < 64; ++j) {
        const int dk = dkg * 64 + j;
        const f32x4 s = __builtin_nontemporal_load((const f32x4*)(s0 + (size_t)dk * 512));
        o += s * Q[dk];
        __builtin_nontemporal_store(s * g + v * Kh[dk], (f32x4*)(s1 + (size_t)dk * 512));
    }
    *(LAS f32x4*)(OS + dkg * 512 + dv4) = o;
    __syncthreads();
    float y[4] = {0.f, 0.f, 0.f, 0.f}; float ss = 0.f;
    if (tid < 128) {
        const f32x4 t = *(LAS f32x4*)(OS + dv4) + *(LAS f32x4*)(OS + 512 + dv4) + *(LAS f32x4*)(OS + 1024 + dv4) + *(LAS f32x4*)(OS + 1536 + dv4) + v * qkv;
        y[0] = t.x; y[1] = t.y; y[2] = t.z; y[3] = t.w; ss = t.x * t.x + t.y * t.y + t.z * t.z + t.w * t.w;
    }
    ss = wave_sum(ss);
    if (lane == 0) RED[8 + wave] = ss;
    __syncthreads();
    if (tid < 128) {
        const float rs = 1.0f / sqrtf((RED[8] + RED[9]) * (1.f / 512.f) + EPS);
        const u32x2 gw = *(const u32x2*)(Prow + O_GA + h * 512 + dv4);
        u32x2 ow; ow.x = pk2(y[0] * rs * bflo(gw.x), y[1] * rs * bfhi(gw.x)); ow.y = pk2(y[2] * rs * bflo(gw.y), y[3] * rs * bfhi(gw.y));
        *(u32x2*)((bf16_t*)(ws + WS_OA) + (size_t)(MP + i) * 2048 + h * 512 + dv4) = ow;
    }
    __syncthreads();
}

__device__ __forceinline__ void ret_sample_wave(const Args& a, int i, int h, int lane) {
    unsigned char* ws = a.ws;
    const bf16_t* Prow = (const bf16_t*)(ws + WS_P) + (size_t)(MP + i) * NP;
    const float g = 1.f - exp2f(-5.f - (float)h);
    float q[4], k[4]; float qk = 0.f;
#pragma unroll
    for (int j = 0; j < 4; ++j) { q[j] = bf2f(Prow[h * 256 + 64 * j + lane]); k[j] = bf2f(Prow[O_K + h * 256 + 64 * j + lane]); qk += q[j] * k[j]; }
    const float qkv = wave_sum(qk) / g;
    f32x4 v[2];
#pragma unroll
    for (int e = 0; e < 2; ++e) { const u32x2 vw = *(const u32x2*)(Prow + O_V + h * 512 + e * 256 + lane * 4); v[e] = (f32x4){bflo(vw.x), bfhi(vw.x), bflo(vw.y), bfhi(vw.y)}; }
    const float* s0 = a.in[I_SRET] + (size_t)(i * 4 + h) * 256 * 512 + lane * 4;
    float* s1 = a.out + OUT_RETS + (size_t)(i * 4 + h) * 256 * 512 + lane * 4;
    f32x4 o[2] = {{0.f, 0.f, 0.f, 0.f}, {0.f, 0.f, 0.f, 0.f}};
#pragma unroll
    for (int j = 0; j < 4; ++j) {
        for (int d0 = 0; d0 < 64; d0 += 8) {
            f32x4 sv[8][2];
#pragma unroll
            for (int d = 0; d < 8; ++d)
#pragma unroll
                for (int e = 0; e < 2; ++e) sv[d][e] = __builtin_nontemporal_load((const f32x4*)(s0 + (size_t)(64 * j + d0 + d) * 512 + e * 256));
#pragma unroll
            for (int d = 0; d < 8; ++d) {
                const float qd = __builtin_bit_cast(float, __builtin_amdgcn_readlane(__builtin_bit_cast(int, q[j]), d0 + d));
                const float kd = __builtin_bit_cast(float, __builtin_amdgcn_readlane(__builtin_bit_cast(int, k[j]), d0 + d));
#pragma unroll
                for (int e = 0; e < 2; ++e) { o[e] += sv[d][e] * qd; __builtin_nontemporal_store(sv[d][e] * g + v[e] * kd, (f32x4*)(s1 + (size_t)(64 * j + d0 + d) * 512 + e * 256)); }
            }
        }
    }
    float ss = 0.f;
#pragma unroll
    for (int e = 0; e < 2; ++e) { o[e] += v[e] * qkv; ss += (o[e].x * o[e].x + o[e].y * o[e].y) + (o[e].z * o[e].z + o[e].w * o[e].w); }
    const float rs = 1.0f / sqrtf(wave_sum(ss) * (1.f / 512.f) + EPS);
#pragma unroll
    for (int e = 0; e < 2; ++e) { const u32x2 gw = *(const u32x2*)(Prow + O_GA + h * 512 + e * 256 + lane * 4);
        u32x2 ow; ow.x = pk2(o[e].x * rs * bflo(gw.x), o[e].y * rs * bfhi(gw.x)); ow.y = pk2(o[e].z * rs * bflo(gw.y), o[e].w * rs * bfhi(gw.y));
        *(u32x2*)((bf16_t*)(ws + WS_OA) + (size_t)(MP + i) * 2048 + h * 512 + e * 256 + lane * 4) = ow; }
}

__device__ __forceinline__ void phase25_row(const Args& a, int m, int lane) {
    unsigned char* ws = a.ws;
    const bf16_t* Prow = (const bf16_t*)(ws + WS_P) + (size_t)m * NP;
    bf16_t* oa = (bf16_t*)(ws + WS_OA) + (size_t)m * 2048;
    const float* sq = (const float*)(ws + WS_SQA) + (size_t)m * 32;
    const bool prompt = m < MP;
    f32x4 sqv[8]; u32x4 ow[4], gw4[4];
    if (prompt) {
#pragma unroll
        for (int j = 0; j < 8; ++j) sqv[j] = ((const f32x4*)sq)[j];
#pragma unroll
        for (int hh = 0; hh < 4; ++hh) { ow[hh] = *(const u32x4*)(oa + hh * 512 + lane * 8); gw4[hh] = *(const u32x4*)(Prow + O_GA + hh * 512 + lane * 8); }
    }
    const float* ob = (const float*)(ws + WS_OB) + (size_t)m * D + lane * 16;
    f32x4 ov[4];
#pragma unroll
    for (int j = 0; j < 4; ++j) ov[j] = ((const f32x4*)ob)[j];
    const float bc = ((const float*)(ws + WS_BC))[(size_t)m * 16 + (lane >> 2)];
    const bf16_t* cur = Prow + O_SH + 2048 + lane * 16;
    const bool hasp = (m >= MP) || (m & (T - 1));
    const bf16_t* prv = (m >= MP) ? cur + (size_t)MS * NP : cur - NP;
    u32x4 cw[2], pw[2] = {{0u, 0u, 0u, 0u}, {0u, 0u, 0u, 0u}}, gbw[2];
    cw[0] = ((const u32x4*)cur)[0]; cw[1] = ((const u32x4*)cur)[1];
    if (hasp) { pw[0] = ((const u32x4*)prv)[0]; pw[1] = ((const u32x4*)prv)[1]; }
    gbw[0] = ((const u32x4*)(Prow + O_GB + lane * 16))[0]; gbw[1] = ((const u32x4*)(Prow + O_GB + lane * 16))[1];
    f32x4 lw4[4], lb4[4], mu4[4];
#pragma unroll
    for (int j = 0; j < 4; ++j) { lw4[j] = ((const f32x4*)(a.in[I_LNW] + lane * 16))[j]; lb4[j] = ((const f32x4*)(a.in[I_LNB] + lane * 16))[j]; mu4[j] = ((const f32x4*)(a.in[I_MU] + 2048 + lane * 16))[j]; }
    if (prompt) {
#pragma unroll
        for (int hh = 0; hh < 4; ++hh) {
            const f32x4 s0 = sqv[2 * hh], s1 = sqv[2 * hh + 1];
            const float rs = 1.0f / sqrtf(((s0.x + s0.y) + (s0.z + s0.w) + (s1.x + s1.y) + (s1.z + s1.w)) * (1.f / 512.f) + EPS);
            const u32x4 o4 = ow[hh], g4 = gw4[hh];
            u32x4 r;
            r.x = pk2(bflo(o4.x) * rs * bflo(g4.x), bfhi(o4.x) * rs * bfhi(g4.x)); r.y = pk2(bflo(o4.y) * rs * bflo(g4.y), bfhi(o4.y) * rs * bfhi(g4.y));
            r.z = pk2(bflo(o4.z) * rs * bflo(g4.z), bfhi(o4.z) * rs * bfhi(g4.z)); r.w = pk2(bflo(o4.w) * rs * bflo(g4.w), bfhi(o4.w) * rs * bfhi(g4.w));
            *(u32x4*)(oa + hh * 512 + lane * 8) = r;
        }
    }
    float o[16], lw[16], lb[16], mu[16];
#pragma unroll
    for (int j = 0; j < 4; ++j) { o[4 * j] = ov[j].x; o[4 * j + 1] = ov[j].y; o[4 * j + 2] = ov[j].z; o[4 * j + 3] = ov[j].w;
        lw[4 * j] = lw4[j].x; lw[4 * j + 1] = lw4[j].y; lw[4 * j + 2] = lw4[j].z; lw[4 * j + 3] = lw4[j].w;
        lb[4 * j] = lb4[j].x; lb[4 * j + 1] = lb4[j].y; lb[4 * j + 2] = lb4[j].z; lb[4 * j + 3] = lb4[j].w;
        mu[4 * j] = mu4[j].x; mu[4 * j + 1] = mu4[j].y; mu[4 * j + 2] = mu4[j].z; mu[4 * j + 3] = mu4[j].w; }
    float s = 0.f;
#pragma unroll
    for (int j = 0; j < 16; ++j) s += o[j];
    s += __shfl_xor(s, 1); s += __shfl_xor(s, 2);
    const float mean = s * (1.f / 64.f);
    float q = 0.f;
#pragma unroll
    for (int j = 0; j < 16; ++j) { const float d = o[j] - mean; q += d * d; }
    q += __shfl_xor(q, 1); q += __shfl_xor(q, 2);
    const float rstd = 1.0f / sqrtf(q * (1.f / 64.f) + 64e-5f);
    const unsigned cws[8] = {cw[0].x, cw[0].y, cw[0].z, cw[0].w, cw[1].x, cw[1].y, cw[1].z, cw[1].w};
    const unsigned pws[8] = {pw[0].x, pw[0].y, pw[0].z, pw[0].w, pw[1].x, pw[1].y, pw[1].z, pw[1].w};
    const unsigned gws[8] = {gbw[0].x, gbw[0].y, gbw[0].z, gbw[0].w, gbw[1].x, gbw[1].y, gbw[1].z, gbw[1].w};
    unsigned outw[8];
#pragma unroll
    for (int j = 0; j < 8; ++j) {
        const float c0 = bflo(cws[j]), c1 = bfhi(cws[j]), p0 = bflo(pws[j]), p1 = bfhi(pws[j]);
        const float v0 = c0 + (p0 - c0) * mu[2 * j], v1 = c1 + (p1 - c1) * mu[2 * j + 1];
        const float y0 = ((o[2 * j] - mean) * rstd * lw[2 * j] + lb[2 * j] + bc * v0) * bflo(gws[j]);
        const float y1 = ((o[2 * j + 1] - mean) * rstd * lw[2 * j + 1] + lb[2 * j + 1] + bc * v1) * bfhi(gws[j]);
        outw[j] = pk2(y0, y1);
    }
    bf16_t* yb = (bf16_t*)(ws + WS_H) + (size_t)m * D + lane * 16;
    *(u32x4*)yb = (u32x4){outw[0], outw[1], outw[2], outw[3]}; *(u32x4*)(yb + 8) = (u32x4){outw[4], outw[5], outw[6], outw[7]};
}

struct EpiT1 {
    static constexpr bool PERM = false;
    const bf16_t* P; float* T1;
    __device__ __forceinline__ void operator()(const f32x4 (&acc)[2][2][4][2], const Unit& u, int wr, int wc, int fr, int fq) const {
        const int row0 = u.pm * 256 + wr * 64 + fr, col0 = u.pn * 256 + wc * 32 + 4 * fq;
#pragma unroll
        for (int ai = 0; ai < 2; ++ai)
#pragma unroll
            for (int m = 0; m < 4; ++m) { const int row = row0 + ai * 128 + m * 16; if (row >= MR) continue;
#pragma unroll
                for (int bj = 0; bj < 2; ++bj)
#pragma unroll
                    for (int n = 0; n < 2; ++n) { const int col = col0 + bj * 128 + n * 16;
                        const u32x2 gw = *(const u32x2*)(P + (size_t)row * NP + O_MA + col);
                        const f32x4 gt = {bflo(gw.x), bfhi(gw.x), bflo(gw.y), bfhi(gw.y)};
                        *(f32x4*)(T1 + (size_t)row * D + col) = acc[ai][bj][m][n] * gt; } asm volatile("" ::: "memory"); }
    }
};
struct EpiMG {
    static constexpr bool PERM = false;
    const bf16_t* P; const float* T1; bf16_t* MG;
    __device__ __forceinline__ void operator()(const f32x4 (&acc)[2][2][4][2], const Unit& u, int wr, int wc, int fr, int fq) const {
        const int row0 = u.pm * 256 + wr * 64 + fr, col0 = u.pn * 256 + wc * 32 + 4 * fq;
#pragma unroll
        for (int ai = 0; ai < 2; ++ai)
#pragma unroll
            for (int m = 0; m < 4; ++m) { const int row = row0 + ai * 128 + m * 16; if (row >= MR) continue;
#pragma unroll
                for (int bj = 0; bj < 2; ++bj)
#pragma unroll
                    for (int n = 0; n < 2; ++n) { const int col = col0 + bj * 128 + n * 16;
                        const u32x2 gw = *(const u32x2*)(P + (size_t)row * NP + O_MB + col);
                        const f32x4 gt = {bflo(gw.x), bfhi(gw.x), bflo(gw.y), bfhi(gw.y)};
                        const f32x4 v = *(const f32x4*)(T1 + (size_t)row * D + col) + acc[ai][bj][m][n] * gt;
                        *(u32x2*)(MG + (size_t)row * D + col) = (u32x2){pk2(v.x, v.y), pk2(v.z, v.w)}; } asm volatile("" ::: "memory"); }
    }
};
struct EpiX1 {
    static constexpr bool PERM = false;
    const float* xp; const float* xs; float* X1; bf16_t* X1B; float* SQ;
    __device__ __forceinline__ void operator()(const f32x4 (&acc)[2][2][4][2], const Unit& u, int wr, int wc, int fr, int fq) const {
        const int row0 = u.pm * 256 + wr * 64 + fr, col0 = u.pn * 256 + wc * 32 + 4 * fq;
#pragma unroll
        for (int ai = 0; ai < 2; ++ai)
#pragma unroll
            for (int m = 0; m < 4; ++m) { const int row = row0 + ai * 128 + m * 16; const bool ok = row < MR;
                const float* xr = (row < MP) ? xp + (size_t)row * D : xs + (size_t)(row - MP) * D;
                float ss = 0.f;
                if (ok) {
#pragma unroll
                    for (int bj = 0; bj < 2; ++bj)
#pragma unroll
                        for (int n = 0; n < 2; ++n) { const int col = col0 + bj * 128 + n * 16;
                            const f32x4 v = *(const f32x4*)(xr + col) + acc[ai][bj][m][n];
                            ss += (v.x * v.x + v.y * v.y) + (v.z * v.z + v.w * v.w);
                            *(f32x4*)(X1 + (size_t)row * D + col) = v;
                            *(u32x2*)(X1B + (size_t)row * D + col) = (u32x2){pk2(v.x, v.y), pk2(v.z, v.w)}; }
                }
                ss += __shfl_xor(ss, 16); ss += __shfl_xor(ss, 32);
                if (ok && fq == 0) SQ[(size_t)row * 16 + u.pn * 4 + wc] = ss; asm volatile("" ::: "memory"); }
    }
};
struct EpiGT {
    static constexpr bool PERM = false;
    const float* SQ; float* GT;
    __device__ __forceinline__ void operator()(const f32x4 (&acc)[2][2][4][2], const Unit& u, int wr, int wc, int fr, int fq) const {
        const int row0 = u.pm * 256 + wr * 64 + fr, col0 = u.pn * 256 + wc * 32 + 4 * fq;
#pragma unroll
        for (int ai = 0; ai < 2; ++ai)
#pragma unroll
            for (int m = 0; m < 4; ++m) { const int row = row0 + ai * 128 + m * 16; if (row >= MR) continue;
                const f32x4* sp = (const f32x4*)(SQ + (size_t)row * 16); const f32x4 q0 = sp[0], q1 = sp[1], q2 = sp[2], q3 = sp[3];
                const float rs = 1.0f / sqrtf((((q0.x + q0.y) + (q0.z + q0.w)) + ((q1.x + q1.y) + (q1.z + q1.w)) + ((q2.x + q2.y) + (q2.z + q2.w)) + ((q3.x + q3.y) + (q3.z + q3.w))) * (1.f / D) + EPS);
#pragma unroll
                for (int bj = 0; bj < 2; ++bj)
#pragma unroll
                    for (int n = 0; n < 2; ++n) { const int col = col0 + bj * 128 + n * 16; const f32x4 t = acc[ai][bj][m][n] * rs;
                        *(f32x4*)(GT + (size_t)row * D + col) = (f32x4){sigm(t.x), sigm(t.y), sigm(t.z), sigm(t.w)}; } asm volatile("" ::: "memory"); }
    }
};
struct EpiX2 {
    static constexpr bool PERM = false;
    const float* X1; const float* GT; float* out; float* SQ;
    __device__ __forceinline__ void operator()(const f32x4 (&acc)[2][2][4][2], const Unit& u, int wr, int wc, int fr, int fq) const {
        const int row0 = u.pm * 256 + wr * 64 + fr, col0 = u.pn * 256 + wc * 32 + 4 * fq;
#pragma unroll
        for (int ai = 0; ai < 2; ++ai)
#pragma unroll
            for (int m = 0; m < 4; ++m) { int row = row0 + ai * 128 + m * 16; asm volatile("" : "+v"(row)); const bool ok = row < MR;
                float ss = 0.f;
                if (ok) {
#pragma unroll
                    for (int bj = 0; bj < 2; ++bj)
#pragma unroll
                        for (int n = 0; n < 2; ++n) { const int col = col0 + bj * 128 + n * 16;
                            const f32x4 v = *(const f32x4*)(X1 + (size_t)row * D + col) + acc[ai][bj][m][n] * *(const f32x4*)(GT + (size_t)row * D + col);
                            ss += (v.x * v.x + v.y * v.y) + (v.z * v.z + v.w * v.w);
                            *(f32x4*)(out + (size_t)row * D + col) = v; asm volatile("" ::: "memory"); }
                }
                ss += __shfl_xor(ss, 16); ss += __shfl_xor(ss, 32);
                if (ok && fq == 0) SQ[(size_t)row * 16 + u.pn * 4 + wc] = ss; asm volatile("" ::: "memory"); }
    }
};


__device__ __forceinline__ f32x4 mini_acc(const bf16_t* A, int lda, const bf16_t* Bt, int K, int kq, int l15, int quad) {
    f32x4 acc = {0.f, 0.f, 0.f, 0.f};
    const int kn = K / 128;
    const bf16_t* ap = A + (size_t)l15 * lda + kq * (K / 4) + quad * 8;
    const bf16_t* bp = Bt + (size_t)l15 * K + kq * (K / 4) + quad * 8;
#pragma unroll 4
    for (int ks = 0; ks < kn; ++ks) acc = MFMA32(*(const bf16x8*)(ap + ks * 32), *(const bf16x8*)(bp + ks * 32), acc);
    return acc;
}
__device__ __forceinline__ f32x4 mini_reduce(LAS f32x4* red, int half, int lane) { return (red[(half * 4 + 0) * 64 + lane] + red[(half * 4 + 1) * 64 + lane]) + (red[(half * 4 + 2) * 64 + lane] + red[(half * 4 + 3) * 64 + lane]); }
template <int PH> __device__ __forceinline__ void mini_phase(const Args& a, LAS unsigned char* lds, int bx, int G, int wave, int lane) {
    unsigned char* ws = a.ws;
    const int l15 = lane & 15, quad = lane >> 4, half = wave >> 2, kq = wave & 3;
    LAS f32x4* red1 = (LAS f32x4*)lds; LAS f32x4* red2 = red1 + 8 * 64;
    const bf16_t* P = (const bf16_t*)(ws + WS_P);
    for (int tp = bx; tp < 256; tp += G) {
        const int tl = tp * 2 + half, mt = tl >> 6, nt = tl & 63, row0 = MP + mt * 16, col0 = nt * 16;
        f32x4 a1, a2 = {0.f, 0.f, 0.f, 0.f};
        if (PH == 0) { a1 = mini_acc((const bf16_t*)(ws + WS_OA) + (size_t)row0 * 2048, 2048, (const bf16_t*)(ws + WS_WDA) + (size_t)col0 * 2048, 2048, kq, l15, quad);
                       a2 = mini_acc((const bf16_t*)(ws + WS_H) + (size_t)row0 * D, D, (const bf16_t*)(ws + WS_WDB) + (size_t)col0 * D, D, kq, l15, quad); }
        if (PH == 1) { a1 = mini_acc((const bf16_t*)(ws + WS_MG) + (size_t)row0 * D, D, (const bf16_t*)(ws + WS_WOUT) + (size_t)col0 * D, D, kq, l15, quad); }
        if (PH == 2) { a1 = mini_acc((const bf16_t*)(ws + WS_X1B) + (size_t)row0 * D, D, (const bf16_t*)(ws + WS_WGATE) + (size_t)col0 * D, D, kq, l15, quad);
                       a2 = mini_acc((const bf16_t*)(ws + WS_PB) + (size_t)row0 * PLE, PLE, (const bf16_t*)(ws + WS_WPLE) + (size_t)col0 * PLE, PLE, kq, l15, quad); }
        red1[wave * 64 + lane] = a1; red2[wave * 64 + lane] = a2;
        __syncthreads();
        if (kq == 0) {
            a1 = mini_reduce(red1, half, lane); a2 = mini_reduce(red2, half, lane);
            const int col = col0 + l15;
            float rs1[4] = {0.f, 0.f, 0.f, 0.f};
            if (PH == 2) {
#pragma unroll
                for (int r = 0; r < 4; ++r) { const f32x4 q = *(const f32x4*)((const float*)(ws + WS_SQS1) + (size_t)(row0 - MP + quad * 4 + r) * 64 + l15 * 4); float t = (q.x + q.y) + (q.z + q.w);
#pragma unroll
                    for (int o = 1; o < 16; o <<= 1) t += __shfl_xor(t, o);
                    rs1[r] = 1.0f / sqrtf(t * (1.f / D) + EPS); }
            }
#pragma unroll
            for (int r = 0; r < 4; ++r) {
                const int row = row0 + quad * 4 + r;
                float ss = 0.f;
                if (PH == 0) { const float ga = bf2f(P[(size_t)row * NP + O_MA + col]), gb = bf2f(P[(size_t)row * NP + O_MB + col]);
                    ((bf16_t*)(ws + WS_MG))[(size_t)row * D + col] = f2bf(a1[r] * ga + a2[r] * gb); }
                if (PH == 1) { const float x1 = a.in[I_XS][(size_t)(row - MP) * D + col] + a1[r]; ss = x1 * x1;
                    ((float*)(ws + WS_X1))[(size_t)row * D + col] = x1; ((bf16_t*)(ws + WS_X1B))[(size_t)row * D + col] = f2bf(x1); }
                if (PH == 2) { const float x2 = ((const float*)(ws + WS_X1))[(size_t)row * D + col] + a2[r] * sigm(rs1[r] * a1[r]); ss = x2 * x2;
                    a.out[OUT_Y + (size_t)row * D + col] = x2; }
                if (PH != 0) {
#pragma unroll
                    for (int o = 1; o < 16; o <<= 1) ss += __shfl_xor(ss, o);
                    if (l15 == 0) ((float*)(ws + (PH == 1 ? WS_SQS1 : WS_SQS2)))[(size_t)(row - MP) * 64 + nt] = ss;
                }
            }
        }
        __syncthreads();
    }
}

#define XB_TMO      128
#define XB_XCNT(j)  (256  + 64 * (j))
#define XB_XSUB(j)  (1280 + 64 * (j))
#define XB_XGEN(j)  (2304 + 64 * (j))
#define XB_TOP      3328
#define XB_TOPGEN   3392
#define XCD_BAR_WORDS 3456
#define XB_SPIN_CAP (1u << 22)
__device__ __forceinline__ unsigned xb_ld(unsigned* p)              { return __hip_atomic_load(p, __ATOMIC_RELAXED, __HIP_MEMORY_SCOPE_AGENT); }
__device__ __forceinline__ unsigned xb_add(unsigned* p, unsigned v) { return __hip_atomic_fetch_add(p, v, __ATOMIC_RELAXED, __HIP_MEMORY_SCOPE_AGENT); }
__device__ __forceinline__ unsigned xb_xcc_id() { return (unsigned)__builtin_amdgcn_s_getreg((3 << 11) | 20) & 0xFu; }
#define XB_SPIN(cond, bar) do { unsigned _sp = 0; while (cond) { __builtin_amdgcn_s_sleep(1); \
    if ((++_sp & 255u) == 0u) { if (xb_ld(&(bar)[XB_TMO])) break; if (_sp > XB_SPIN_CAP) { atomicAdd(&(bar)[XB_TMO], 1u); break; } } } } while (0)
struct XcdBarrier { unsigned* bar; unsigned x; volatile LAS unsigned* st; };
__device__ __forceinline__ XcdBarrier xcd_barrier_post(unsigned* bar, volatile LAS unsigned* st) {
    XcdBarrier b; b.bar = bar; b.x = xb_xcc_id(); b.st = st;
    if (threadIdx.x == 0) (void)xb_add(&bar[XB_XCNT(b.x)], 1u);
    return b;
}
__device__ __forceinline__ void xcd_barrier_complete(unsigned* bar, unsigned x, unsigned& nloc, unsigned& nx) {
    const unsigned G = gridDim.x * gridDim.y * gridDim.z;
    unsigned sum, cnt, mine, sp = 0u;
    for (;;) {
        sum = 0u; cnt = 0u; mine = 0u;
#pragma unroll
        for (unsigned j = 0; j < 16; ++j) { const unsigned c = xb_ld(&bar[XB_XCNT(j)]); sum += c; cnt += (c > 0u) ? 1u : 0u; mine = (j == x) ? c : mine; }
        if (sum == G) break;
        __builtin_amdgcn_s_sleep(1);
        if ((++sp & 255u) == 0u) { if (xb_ld(&bar[XB_TMO])) break; if (sp > XB_SPIN_CAP) { atomicAdd(&bar[XB_TMO], 1u); break; } }
    }
    nloc = mine > 0u ? mine : 1u; nx = cnt > 0u ? cnt : 1u;
}
__device__ __forceinline__ void xcd_barrier(const XcdBarrier& b) {
    asm volatile("s_waitcnt vmcnt(0)" ::: "memory");
    __syncthreads();
    if (threadIdx.x == 0) {
        unsigned* bar = b.bar;
        __builtin_amdgcn_s_waitcnt(0);
        unsigned nloc = b.st[0], nx = b.st[1];
        if (nloc == 0u) { xcd_barrier_complete(bar, b.x, nloc, nx); b.st[0] = nloc; b.st[1] = nx; }
        const unsigned old = xb_add(&bar[XB_XSUB(b.x)], 1u);
        const unsigned gen = old / nloc;
        if (old + 1u == (gen + 1u) * nloc) {
            __builtin_amdgcn_fence(__ATOMIC_RELEASE, "agent");
            asm volatile("s_waitcnt vmcnt(0)" ::: "memory");
            const unsigned og = xb_add(&bar[XB_TOP], 1u);
            const unsigned tg = og / nx;
            if (og + 1u == (tg + 1u) * nx) xb_add(&bar[XB_TOPGEN], 1u);
            else XB_SPIN(xb_ld(&bar[XB_TOPGEN]) == tg, bar);
            __builtin_amdgcn_fence(__ATOMIC_ACQUIRE, "agent");
            xb_add(&bar[XB_XGEN(b.x)], 1u);
            asm volatile("s_waitcnt vmcnt(0)" ::: "memory");
        } else {
            XB_SPIN(xb_ld(&bar[XB_XGEN(b.x)]) == gen, bar);
            __builtin_amdgcn_fence(__ATOMIC_ACQUIRE, "agent");
            asm volatile("s_waitcnt vmcnt(0)" ::: "memory");
        }
    }
    __syncthreads();
}

constexpr int LDS_BYTES = 147456;
constexpr int CTL_SQ1 = 0, CTL_SQ2 = 32768, CTL_CNT = 65536;

#define GRID_SYNC() xcd_barrier(xbar)
__global__ void __launch_bounds__(512, 2) fwd_mega(Args a) {
    extern __shared__ __attribute__((aligned(16))) unsigned char lds_raw[];
    LAS unsigned char* lds = (LAS unsigned char*)lds_raw;
    cg::grid_group grid = cg::this_grid();
    const int tid = threadIdx.x, lane = tid & 63, wave = __builtin_amdgcn_readfirstlane(tid >> 6);
    const int G = gridDim.x, bx = blockIdx.x;
    const int gw = bx * 8 + wave, NGW = G * 8;
    unsigned char* ws = a.ws;
    if (tid < 16) ((LAS unsigned*)(lds + 131072 + 64))[tid] = 0u;
    __syncthreads();
    XcdBarrier xbar = xcd_barrier_post((unsigned*)(ws + WS_BAR), (volatile LAS unsigned*)(lds + 131072 + 64));
    grid.sync();

#if !defined(ONLY_PH) || ONLY_PH == 0
    phase0(a, lds, gw, NGW, wave, lane);
    GRID_SYNC();
#endif
#if !defined(ONLY_PH) || ONLY_PH == 1
    {
        pg8::Gemm g{(const bf16_t*)(ws + WS_H), (const bf16_t*)(ws + WS_WIN), MALL, NP, D}; pg8::StaticOrder S; S.init(MALL, NP, G, bx);
        EpiP E{(bf16_t*)(ws + WS_P), (bf16_t*)(ws + WS_KT), (const f32x2*)(ws + WS_ROPE)};
        pg8::gemm_phase<EpiP>(lds, g, S, E);
    }
    GRID_SYNC();
#endif
#if !defined(ONLY_PH) || ONLY_PH == 2
    for (int it = gw; it < 1032 * 16; it += NGW) rw_prep_item(a, lds + wave * 10240, it >> 4, it & 15, lane);
    GRID_SYNC();
#endif
#if !defined(ONLY_PH) || ONLY_PH == 3
    {
        for (int u = gw; u < MS * 16; u += NGW) rw_sample_wave(a, u >> 4, u & 15, lane);
        if (bx < 128) { if (wave < 4) rw_scan_task(a, lds + wave * 4096, bx >> 4, bx & 15, wave, lane); else { const int u = bx * 4 + (wave - 4); ret_sample_wave(a, u >> 2, u & 3, lane); } }
        __syncthreads();
        {
            unsigned* cnt = (unsigned*)(ws + WS_CTL) + CTL_CNT;
            LAS unsigned* lu = (LAS unsigned*)(lds + 131072);
            for (;;) {
                if (tid == 0) *lu = atomicAdd(cnt, 1u);
                __syncthreads();
                const unsigned unit = *lu;
                __syncthreads();
                if (unit >= 256u) break;
                ret_unit(a, lds, (int)unit, tid);
            }
        }
        if (G < 128) for (int u = bx; u < MS * 4; u += G) ret_sample_unit(a, lds, u >> 2, u & 3, tid);
    }
    GRID_SYNC();
#endif
#if !defined(ONLY_PH) || ONLY_PH == 4
    for (int m = gw; m < MR; m += NGW) phase25_row(a, m, lane);
    GRID_SYNC();
#endif
#if !defined(ONLY_PH) || ONLY_PH == 5
    {
        mini_phase<0>(a, lds, bx, G, wave, lane);
        pg8::StaticOrder S; S.init(MP, D, G, bx);
        { pg8::Gemm g{(const bf16_t*)(ws + WS_OA), (const bf16_t*)(ws + WS_WDA), MP, D, 2048}; EpiT1 E{(const bf16_t*)(ws + WS_P), (float*)(ws + WS_T1)}; pg8::gemm_phase<EpiT1>(lds, g, S, E); }
        { pg8::Gemm g{(const bf16_t*)(ws + WS_H), (const bf16_t*)(ws + WS_WDB), MP, D, D}; EpiMG E{(const bf16_t*)(ws + WS_P), (const float*)(ws + WS_T1), (bf16_t*)(ws + WS_MG)}; pg8::gemm_phase<EpiMG>(lds, g, S, E); }
    }
    GRID_SYNC();
#endif
#if !defined(ONLY_PH) || ONLY_PH == 6
    {
        mini_phase<1>(a, lds, bx, G, wave, lane);
        pg8::StaticOrder S; S.init(MP, D, G, bx);
        pg8::Gemm g{(const bf16_t*)(ws + WS_MG), (const bf16_t*)(ws + WS_WOUT), MP, D, D};
        EpiX1 E{a.in[I_XP], a.in[I_XS], (float*)(ws + WS_X1), (bf16_t*)(ws + WS_X1B), (float*)(ws + WS_SQ1P)};
        pg8::gemm_phase<EpiX1>(lds, g, S, E);
    }
    GRID_SYNC();
#endif
#if !defined(ONLY_PH) || ONLY_PH == 7
    {
        mini_phase<2>(a, lds, bx, G, wave, lane);
        pg8::StaticOrder S; S.init(MP, D, G, bx);
        { pg8::Gemm g{(const bf16_t*)(ws + WS_X1B), (const bf16_t*)(ws + WS_WGATE), MP, D, D}; EpiGT E{(const float*)(ws + WS_SQ1P), (float*)(ws + WS_GT)}; pg8::gemm_phase<EpiGT>(lds, g, S, E); }
        { pg8::Gemm g{(const bf16_t*)(ws + WS_PB), (const bf16_t*)(ws + WS_WPLE), MP, D, PLE}; EpiX2 E{(const float*)(ws + WS_X1), (const float*)(ws + WS_GT), a.out + OUT_Y, (float*)(ws + WS_SQ2P)}; pg8::gemm_phase<EpiX2>(lds, g, S, E); }
    }
    GRID_SYNC();
#endif
#if !defined(ONLY_PH) || ONLY_PH == 8
    {
        const float* sq2 = (const float*)(ws + WS_SQ2P); const float* fg = a.in[I_FNG];
        for (int m = gw; m < MR; m += NGW) {
            float tot;
            if (m < MP) { const f32x4* sp = (const f32x4*)(sq2 + (size_t)m * 16); const f32x4 q0 = sp[0], q1 = sp[1], q2 = sp[2], q3 = sp[3];
                tot = (((q0.x + q0.y) + (q0.z + q0.w)) + ((q1.x + q1.y) + (q1.z + q1.w)) + ((q2.x + q2.y) + (q2.z + q2.w)) + ((q3.x + q3.y) + (q3.z + q3.w))); }
            else tot = wave_sum(((const float*)(ws + WS_SQS2))[(size_t)(m - MP) * 64 + lane]);
            const float rs = 1.0f / sqrtf(tot * (1.f / D) + EPS);
            f32x4* o = (f32x4*)(a.out + OUT_Y + (size_t)m * D);
            f32x4 xv[4];
#pragma unroll
            for (int j = 0; j < 4; ++j) xv[j] = o[lane + 64 * j];
#pragma unroll
            for (int j = 0; j < 4; ++j) o[lane + 64 * j] = xv[j] * rs * ((const f32x4*)fg)[lane + 64 * j];
        }
    }
#endif

}

extern "C" void kernel_launch(void* const* d_in, const int* in_sizes, int n_in, void* d_out, int out_size, void* d_ws, size_t ws_size, hipStream_t stream) {
    static int grid = 0;
    if (grid == 0) {
        if (n_in != 26 || ws_size < WS_END) { fprintf(stderr, "kernel_launch: unexpected n_in %d or ws_size %zu (need %zu)\n", n_in, ws_size, (size_t)WS_END); grid = -1; return; }
        int dev = 0, cus = 0, per_cu = 0;
        hipGetDevice(&dev); hipDeviceGetAttribute(&cus, hipDeviceAttributeMultiprocessorCount, dev);
        if (hipFuncSetAttribute((const void*)fwd_mega, hipFuncAttributeMaxDynamicSharedMemorySize, LDS_BYTES) != hipSuccess) { fprintf(stderr, "kernel_launch: hipFuncSetAttribute failed\n"); grid = -1; return; }
        hipOccupancyMaxActiveBlocksPerMultiprocessor(&per_cu, (const void*)fwd_mega, 512, LDS_BYTES);
        if (per_cu < 1) { fprintf(stderr, "kernel_launch: occupancy query says %d blocks per CU\n", per_cu); per_cu = 1; }
        (void)hipGetLastError();
        grid = cus * 1;
        fprintf(stderr, "kernel_launch: grid %d (cus %d, per_cu %d), ws %zu\n", grid, cus, per_cu, ws_size);
    }
    if (grid < 0) return;
    Args a{};
    for (int i = 0; i < 26; ++i) a.in[i] = (const float*)d_in[i];
    a.out = (float*)d_out; a.ws = (unsigned char*)d_ws;
    if (hipMemsetAsync((char*)d_ws + WS_BAR, 0, XCD_BAR_WORDS * 4, stream) != hipSuccess) { fprintf(stderr, "kernel_launch: memset failed\n"); return; }
    void* args[] = {&a};
    hipError_t e = hipLaunchCooperativeKernel((const void*)fwd_mega, dim3(grid), dim3(512), args, LDS_BYTES, stream);
    if (e != hipSuccess) fprintf(stderr, "kernel_launch: cooperative launch failed: %s\n", hipGetErrorString(e));
}
```

```cpp
#include <hip/hip_runtime.h>
#include <hip/hip_cooperative_groups.h>
#include <cstdio>
#include <cstdint>
namespace cg = cooperative_groups;

#define LAS __attribute__((address_space(3)))
typedef unsigned short bf16_t;
typedef short bf16x8 __attribute__((ext_vector_type(8)));
typedef short bf16x4 __attribute__((ext_vector_type(4)));
typedef float f32x4 __attribute__((ext_vector_type(4)));
typedef float f32x2 __attribute__((ext_vector_type(2)));
typedef unsigned u32x4 __attribute__((ext_vector_type(4)));
typedef unsigned u32x2 __attribute__((ext_vector_type(2)));
typedef __bf16 nbf2 __attribute__((ext_vector_type(2)));

constexpr int D = 1024, NB = 8, T = 2048, MP = NB * T  , MS = 128, MR = MP + MS  , MALL = 16640  ;
constexpr int NCOLS = 12416, NP = 12544  ;
constexpr int O_K = 1024, O_V = 2048, O_GA = 4096, O_SH = 6144, O_GB = 9344, O_MA = 10368, O_MB = 11392;
constexpr int RH = 4, RDK = 256, RDV = 512, RCH = 128;
constexpr int WH = 16, WN = 64;
constexpr int PLE = 256;
constexpr float EPS = 1e-6f;
constexpr int REC = 12544;
constexpr int R_AT = 0, R_RT = 2048, R_BP = 4096, R_KP = 6144, R_VT = 8192, R_AAK = 10240, R_TT = 10752, R_ARB = 11264, R_ARK = 11776, R_WC = 12288;

constexpr size_t MiB = 1u << 20;
constexpr size_t WS_CTL = 0;
constexpr size_t WS_ROPE = 1 * MiB;
constexpr size_t WS_W2T = 4 * MiB, WS_A2T = WS_W2T + 131072;
constexpr size_t WS_WPLE = 5 * MiB, WS_WDB = 6 * MiB, WS_WOUT = 8 * MiB, WS_WGATE = 10 * MiB, WS_WDA = 12 * MiB, WS_WIN = 16 * MiB;
constexpr size_t WS_PB = 41 * MiB, WS_H = 50 * MiB  , WS_KT = 83 * MiB, WS_SQA = 115 * MiB, WS_BC = 117 * MiB, WS_OPSS = 119 * MiB  ;
constexpr size_t WS_OA = 122 * MiB, WS_P = 188 * MiB, WS_CH = 587 * MiB  , WS_OB = 786 * MiB  ;
constexpr size_t WS_T1 = WS_CH, WS_MG = WS_CH + 65 * MiB, WS_X1B = WS_CH + 98 * MiB, WS_GT = WS_CH + 131 * MiB, WS_X1 = WS_OB + 65 * MiB  ;
constexpr size_t WS_END = 916 * MiB;
constexpr size_t WS_BAR = 512 * 1024;
constexpr size_t WS_SQS1 = 640 * 1024, WS_SQS2 = 704 * 1024;
constexpr size_t WS_SQ1P = WS_KT, WS_SQ2P = WS_KT + 2 * MiB;

constexpr size_t OUT_Y = 0, OUT_RETP = 16908288, OUT_RWP = 21102592, OUT_SHP = 21626880, OUT_RETS = 21635072, OUT_RWS = 88743936, OUT_SHS = 97132544;

__device__ __forceinline__ unsigned pk2(float lo, float hi) { f32x2 v = {lo, hi}; nbf2 r = __builtin_convertvector(v, nbf2); return __builtin_bit_cast(unsigned, r); }
__device__ __forceinline__ unsigned short f2bf(float f) { return (unsigned short)(pk2(f, 0.f) & 0xffffu); }
__device__ __forceinline__ float bf2f(unsigned short b) { return __uint_as_float(((unsigned)b) << 16); }
__device__ __forceinline__ float bflo(unsigned w) { return __uint_as_float(w << 16); }
__device__ __forceinline__ float bfhi(unsigned w) { return __uint_as_float(w & 0xffff0000u); }
__device__ __forceinline__ float sigm(float x) { return __builtin_amdgcn_rcpf(1.f + __expf(-x)); }
__device__ __forceinline__ float wave_sum(float v) {
#pragma unroll
    for (int o = 1; o < 64; o <<= 1) v += __shfl_xor(v, o);
    return v;
}
#define MFMA32(a, b, c) __builtin_amdgcn_mfma_f32_16x16x32_bf16((a), (b), (c), 0, 0, 0)
#define LDS_WAIT() asm volatile("s_waitcnt lgkmcnt(0)" ::: "memory")

namespace pg8 {
constexpr int BM = 256, BK = 64, HALF = 128, HTB = HALF * BK * 2, STAGE_BYTES = 8 * HTB, NXCD = 8, WGM = 8;
__host__ __device__ __forceinline__ int lds_byte(int r, int c) { const int st = (r >> 4) * 2 + (c >> 5), rr = r & 15, cc = c & 31, ob = rr * 64 + cc * 2; return st * 1024 + (ob ^ (((ob >> 9) & 1) << 5)); }
__host__ __device__ __forceinline__ void stage_rc(int b, int& R, int& C) { const int st = b / 1024, sb = b % 1024, swz = sb ^ (((sb >> 9) & 1) << 5); R = (st >> 1) * 16 + swz / 64; C = (st & 1) * 32 + (swz % 64) / 2; }
__host__ __device__ __forceinline__ int perm32(int rho) { const int n = rho >> 4, i = rho & 15; return 8 * (i >> 2) + 4 * n + (i & 3); }
struct Unit { int pm, pn; };
struct Gemm { const bf16_t* A; const bf16_t* Bt; int M, N, K; };
struct StaticOrder {
    int nM, nN, nwg, G, c;
    __host__ __device__ void init(int M, int N, int G_, int c_) { nM = M / BM; nN = N / BM; nwg = nM * nN; G = G_; c = c_; }
    __host__ __device__ bool next(int i, Unit& u) const {
        const long L = (long)i * G + c; if (L >= nwg) return false;
        int wgid = (int)L; { const int q = nwg / NXCD, r = nwg % NXCD, xcd = wgid % NXCD, off = wgid / NXCD; wgid = (xcd < r ? xcd * (q + 1) : r * (q + 1) + (xcd - r) * q) + off; }
        const int nig = WGM * nN, gid = wgid / nig, fm = gid * WGM, gsz = (nM - fm) < WGM ? (nM - fm) : WGM;
        u.pm = fm + ((wgid % nig) % gsz); u.pn = (wgid % nig) / gsz; return true;
    }
};
template <class Epi>
__device__ __forceinline__ void gemm_phase(LAS unsigned char* lds, const Gemm g, const StaticOrder& S, const Epi& E) {
    int tid = threadIdx.x; asm volatile("" : "+v"(tid));
    const int wid = __builtin_amdgcn_readfirstlane(tid >> 6), lane = tid & 63, wr = wid >> 2, wc = wid & 3, fr = lane & 15, fq = lane >> 4;
    const int K = g.K, nt = K / BK;
    unsigned voffA[2], voffB[2];
#pragma unroll
    for (int i = 0; i < 2; ++i) { int R, C; stage_rc(tid * 16 + i * 8192, R, C); const int Rb = Epi::PERM ? ((R & ~31) + perm32(R & 31)) : R;
        voffA[i] = (unsigned)(R * K + C) * 2u; voffB[i] = (unsigned)(Rb * K + C) * 2u; }
    const size_t kstep = (size_t)(BK * 2);
    const size_t hstep = (size_t)HALF * K * 2;
    const size_t tstep = 2 * hstep;
    const unsigned ldsw = (unsigned)wid * 1024u;
    const int aoff = lds_byte(wr * 64 + fr, fq * 8), boff = lds_byte(wc * 32 + fr, fq * 8);
#define PG8_SA(b, h) (((b) * 2 + (h)) * HTB)
#define PG8_SB(b, h) ((4 + (b) * 2 + (h)) * HTB)
#define PG8_STAGE(bufoff, gbase, voff) do { _Pragma("unroll") for (int _i = 0; _i < 2; ++_i) \
        __builtin_amdgcn_global_load_lds((const unsigned*)((const char*)(gbase) + (voff)[_i]), (LAS unsigned*)(lds + (bufoff) + ldsw + _i * 8192), 16, 0, 0); } while (0)
#define PG8_LDA(dst, b, h) do { _Pragma("unroll") for (int m = 0; m < 4; ++m) _Pragma("unroll") for (int k = 0; k < 2; ++k) dst[m][k] = *(const LAS bf16x8*)(lds + PG8_SA(b, h) + aoff + m * 2048 + k * 1024); } while (0)
#define PG8_LDB(dst, b, h) do { _Pragma("unroll") for (int n = 0; n < 2; ++n) _Pragma("unroll") for (int k = 0; k < 2; ++k) dst[n][k] = *(const LAS bf16x8*)(lds + PG8_SB(b, h) + boff + n * 2048 + k * 1024); } while (0)
#define PG8_MMA(ai, bj, At, Bt) do { __builtin_amdgcn_s_setprio(1); _Pragma("unroll") for (int m = 0; m < 4; ++m) _Pragma("unroll") for (int n = 0; n < 2; ++n) _Pragma("unroll") for (int k = 0; k < 2; ++k) \
        acc[ai][bj][m][n] = __builtin_amdgcn_mfma_f32_16x16x32_bf16(Bt[n][k], At[m][k], acc[ai][bj][m][n], 0, 0, 0); __builtin_amdgcn_s_setprio(0); } while (0)
#define PG8_WAIT_V(n) asm volatile("s_waitcnt vmcnt(" #n ")" ::: "memory")
#define PG8_WAIT_L(n) asm volatile("s_waitcnt lgkmcnt(" #n ")" ::: "memory")
#define PG8_BAR __builtin_amdgcn_s_barrier()
#define PG8_SCHED __builtin_amdgcn_sched_barrier(0)
    Unit cur, nxt; int ui = 0;
    if (!S.next(0, cur)) return;
    f32x4 acc[2][2][4][2];
#pragma unroll
    for (int a = 0; a < 2; ++a)
#pragma unroll
        for (int b = 0; b < 2; ++b)
#pragma unroll
            for (int m = 0; m < 4; ++m)
#pragma unroll
                for (int n = 0; n < 2; ++n) acc[a][b][m][n] = (f32x4){0.f, 0.f, 0.f, 0.f};
    bf16x8 At[4][2], B0[2][2], B1[2][2];
    const char* cA = (const char*)g.A + (size_t)cur.pm * tstep; const char* cB = (const char*)g.Bt + (size_t)cur.pn * tstep;
    PG8_STAGE(PG8_SB(0, 0), cB, voffB); PG8_STAGE(PG8_SA(0, 0), cA, voffA); PG8_STAGE(PG8_SB(0, 1), cB + hstep, voffB); PG8_STAGE(PG8_SA(0, 1), cA + hstep, voffA);
    if (wr == 1) PG8_BAR;
    PG8_WAIT_V(4); PG8_BAR;
    PG8_STAGE(PG8_SB(1, 0), cB + kstep, voffB); PG8_STAGE(PG8_SA(1, 0), cA + kstep, voffA); PG8_STAGE(PG8_SB(1, 1), cB + hstep + kstep, voffB);
    PG8_WAIT_V(6); PG8_BAR;
    for (;;) {
        const bool has_next = S.next(ui + 1, nxt);
        const char* nA = has_next ? (const char*)g.A + (size_t)nxt.pm * tstep : cA; const char* nB = has_next ? (const char*)g.Bt + (size_t)nxt.pn * tstep : cB;
#pragma unroll 1
        for (int t = 0; t < nt; t += 2) {
            const bool last = (t == nt - 2);
            const char* a1 = cA + (size_t)(t + 1) * kstep;
            const char* a2 = last ? nA : cA + (size_t)(t + 2) * kstep; const char* b2 = last ? nB : cB + (size_t)(t + 2) * kstep;
            const char* a3 = a2 + kstep; const char* b3 = b2 + kstep;
            PG8_LDB(B0, 0, 0); PG8_SCHED; PG8_LDA(At, 0, 0); PG8_STAGE(PG8_SA(1, 1), a1 + hstep, voffA);
            PG8_WAIT_L(8); PG8_BAR; PG8_WAIT_L(0); PG8_MMA(0, 0, At, B0); PG8_BAR; PG8_SCHED;
            PG8_LDB(B1, 0, 1); PG8_STAGE(PG8_SB(0, 0), b2, voffB);
            PG8_BAR; PG8_WAIT_L(0); PG8_MMA(0, 1, At, B1); PG8_BAR;
            PG8_LDA(At, 0, 1); PG8_STAGE(PG8_SA(0, 0), a2, voffA);
            PG8_BAR; PG8_WAIT_L(0); PG8_MMA(1, 0, At, B0); PG8_BAR; PG8_SCHED;
            PG8_STAGE(PG8_SB(0, 1), b2 + hstep, voffB);
            PG8_WAIT_V(6); PG8_BAR; PG8_MMA(1, 1, At, B1); PG8_BAR;
            PG8_LDB(B0, 1, 0); PG8_SCHED; PG8_LDA(At, 1, 0); PG8_STAGE(PG8_SA(0, 1), a2 + hstep, voffA);
            PG8_WAIT_L(8); PG8_BAR; PG8_WAIT_L(0); PG8_MMA(0, 0, At, B0); PG8_BAR; PG8_SCHED;
            PG8_LDB(B1, 1, 1); PG8_STAGE(PG8_SB(1, 0), b3, voffB);
            PG8_BAR; PG8_WAIT_L(0); PG8_MMA(0, 1, At, B1); PG8_BAR;
            PG8_LDA(At, 1, 1); PG8_STAGE(PG8_SA(1, 0), a3, voffA);
            PG8_BAR; PG8_WAIT_L(0); PG8_MMA(1, 0, At, B0); PG8_BAR; PG8_SCHED;
            PG8_STAGE(PG8_SB(1, 1), b3 + hstep, voffB);
            PG8_WAIT_V(6); PG8_BAR; PG8_MMA(1, 1, At, B1); PG8_BAR;
        }
        E(acc, cur, wr, wc, fr, fq);
        if (!has_next) break;
#pragma unroll
        for (int a = 0; a < 2; ++a)
#pragma unroll
            for (int b = 0; b < 2; ++b)
#pragma unroll
                for (int m = 0; m < 4; ++m)
#pragma unroll
                    for (int n = 0; n < 2; ++n) acc[a][b][m][n] = (f32x4){0.f, 0.f, 0.f, 0.f};
        cur = nxt; cA = nA; cB = nB; ++ui;
    }
    PG8_WAIT_V(0);
    if (wr == 0) PG8_BAR;
    PG8_BAR;
#undef PG8_SA
#undef PG8_SB
#undef PG8_STAGE
#undef PG8_LDA
#undef PG8_LDB
#undef PG8_MMA
#undef PG8_WAIT_V
#undef PG8_WAIT_L
#undef PG8_BAR
#undef PG8_SCHED
}
}
using pg8::Unit;

struct Args {
    const float* in[26];
    float* out; unsigned char* ws;
};
#define KAS __attribute__((address_space(4)))
__device__ __forceinline__ const KAS char* kargp() { const KAS char* p = (const KAS char*)__builtin_amdgcn_kernarg_segment_ptr(); asm volatile("" : "+s"(p)); return p; }


enum { I_XP = 0, I_XS, I_SRET, I_SRW, I_SSH, I_PP, I_PS, I_NG, I_WIN, I_MU, I_W0, I_W2, I_A0, I_A2, I_KK, I_KA, I_RK, I_LNW, I_LNB, I_WDA, I_WDB, I_WOUT, I_WPLE, I_PNG, I_WPG, I_FNG };

__device__ __forceinline__ void p0_transpose_item(const float* W, int K, int N, bf16_t* WT, LAS float* scr, int item, int lane, const float* kscale) {
    const int nblk = N / 32, kb = item / nblk, nb = item % nblk, k0 = 64 * kb, n0 = 32 * nb;
#pragma unroll 8
    for (int i = 0; i < 32; ++i) { const int kk = 2 * i + (lane >> 5); float v = W[(size_t)(k0 + kk) * N + n0 + (lane & 31)]; if (kscale) v *= kscale[k0 + kk]; scr[kk * 33 + (lane & 31)] = v; }
    LDS_WAIT();
    const int c = lane & 7;
#pragma unroll
    for (int j = 0; j < 4; ++j) { const int n = (lane >> 3) + 8 * j; const LAS float* s = scr + (8 * c) * 33 + n;
        u32x4 o; o.x = pk2(s[0 * 33], s[1 * 33]); o.y = pk2(s[2 * 33], s[3 * 33]); o.z = pk2(s[4 * 33], s[5 * 33]); o.w = pk2(s[6 * 33], s[7 * 33]);
        *(u32x4*)(WT + (size_t)(n0 + n) * K + k0 + 8 * c) = o; }
    LDS_WAIT();
}

__device__ __forceinline__ void phase0(const Args& a, LAS unsigned char* lds, int gw, int NGW, int wave, int lane) {
    unsigned char* ws = a.ws;
    LAS float* scr = (LAS float*)(lds + wave * 16384);
    constexpr int I_IN = (D / 64) * (NCOLS / 32), I_DA = (2048 / 64) * (D / 32), I_SQ = (D / 64) * (D / 32), I_PL = (PLE / 64) * (D / 32), I_LR = 1 * (D / 32);
    constexpr int NITEMS = I_IN + I_DA + 3 * I_SQ + I_PL + 2 * I_LR;
    for (int it = gw; it < NITEMS; it += NGW) {
        int r = it;
        if (r < I_IN) { p0_transpose_item(a.in[I_WIN], D, NCOLS, (bf16_t*)(ws + WS_WIN), scr, r, lane, nullptr); continue; } r -= I_IN;
        if (r < I_DA) { p0_transpose_item(a.in[I_WDA], 2048, D, (bf16_t*)(ws + WS_WDA), scr, r, lane, nullptr); continue; } r -= I_DA;
        if (r < I_SQ) { p0_transpose_item(a.in[I_WDB], D, D, (bf16_t*)(ws + WS_WDB), scr, r, lane, nullptr); continue; } r -= I_SQ;
        if (r < I_SQ) { p0_transpose_item(a.in[I_WOUT], D, D, (bf16_t*)(ws + WS_WOUT), scr, r, lane, nullptr); continue; } r -= I_SQ;
        if (r < I_SQ) { p0_transpose_item(a.in[I_WPG], D, D, (bf16_t*)(ws + WS_WGATE), scr, r, lane, a.in[I_PNG]); continue; } r -= I_SQ;
        if (r < I_PL) { p0_transpose_item(a.in[I_WPLE], PLE, D, (bf16_t*)(ws + WS_WPLE), scr, r, lane, nullptr); continue; } r -= I_PL;
        if (r < I_LR) { p0_transpose_item(a.in[I_W2], 64, D, (bf16_t*)(ws + WS_W2T), scr, r, lane, nullptr); continue; } r -= I_LR;
        p0_transpose_item(a.in[I_A2], 64, D, (bf16_t*)(ws + WS_A2T), scr, r, lane, nullptr);
    }
    for (int i = gw * 64 + lane; i < 128 * D / 8; i += NGW * 64) ((u32x4*)(ws + WS_WIN + (size_t)NCOLS * D * 2))[i] = (u32x4){0u, 0u, 0u, 0u};
    bf16_t* H = (bf16_t*)(ws + WS_H);
    const float* ng = a.in[I_NG];
    for (int m = gw; m < MALL; m += NGW) {
        if (m < MR) {
            const float* xr = (m < MP) ? a.in[I_XP] + (size_t)m * D : a.in[I_XS] + (size_t)(m - MP) * D;
            f32x4 v[4]; float s = 0.f;
#pragma unroll
            for (int j = 0; j < 4; ++j) { v[j] = ((const f32x4*)xr)[lane + 64 * j]; s += (v[j].x * v[j].x + v[j].y * v[j].y) + (v[j].z * v[j].z + v[j].w * v[j].w); }
            const float rs = 1.0f / sqrtf(wave_sum(s) * (1.f / D) + EPS);
            float* so = nullptr;
            if (m < MP) { if ((m & (T - 1)) == T - 1) so = a.out + OUT_SHP + (size_t)(m >> 11) * D; } else so = a.out + OUT_SHS + (size_t)(m - MP) * D;
#pragma unroll
            for (int j = 0; j < 4; ++j) { const f32x4 gg = ((const f32x4*)ng)[lane + 64 * j]; f32x4 h = v[j] * rs * gg;
                if (so) ((f32x4*)so)[lane + 64 * j] = h;
                u32x2 o; o.x = pk2(h.x, h.y); o.y = pk2(h.z, h.w); ((u32x2*)(H + (size_t)m * D))[lane + 64 * j] = o; }
        } else {
            const float* xr = a.in[I_SSH] + (size_t)(m - MR) * D;
#pragma unroll
            for (int j = 0; j < 4; ++j) { const f32x4 h = ((const f32x4*)xr)[lane + 64 * j]; u32x2 o; o.x = pk2(h.x, h.y); o.y = pk2(h.z, h.w); ((u32x2*)(H + (size_t)m * D))[lane + 64 * j] = o; }
        }
        u32x2 o = {0u, 0u};
        if (m < MR) { const float* pr = (m < MP) ? a.in[I_PP] + (size_t)m * PLE : a.in[I_PS] + (size_t)(m - MP) * PLE; const f32x4 p = ((const f32x4*)pr)[lane]; o.x = pk2(p.x, p.y); o.y = pk2(p.z, p.w); }
        ((u32x2*)(ws + WS_PB + (size_t)m * PLE * 2))[lane] = o;
    }
    for (int i = gw * 64 + lane; i < 2049 * 128; i += NGW * 64) {
        const int pos = i >> 7, j = i & 127; const double p = (pos == 2048) ? 16384.0 : (double)pos;
        double inv = 1.0, base = 0.9305720409296989; int e = j;
        while (e) { if (e & 1) inv *= base; base *= base; e >>= 1; }
        double rev = p * inv * 0.15915494309189535; rev -= floor(rev);
        const float fr = (float)rev;
        ((f32x2*)(ws + WS_ROPE))[i] = (f32x2){__builtin_amdgcn_cosf(fr), __builtin_amdgcn_sinf(fr)};
    }
    for (int i = gw * 64 + lane; i < 65536 + 64; i += NGW * 64) ((float*)(ws + WS_CTL))[i] = 0.f;
}

struct EpiP {
    static constexpr bool PERM = true;
    bf16_t* P; bf16_t* KT; const f32x2* rope;
    __device__ __forceinline__ void operator()(const f32x4 (&acc)[2][2][4][2], const Unit& u, int wr, int wc, int fr, int fq) const {
        const int pn = u.pn, pm = u.pm;
        const int row0 = pm * 256 + wr * 64 + fr, cl0 = wc * 32 + 8 * fq;
        const bool sample = (pm == 64);
        if (pn < 8) {
            const int h = pn & 3; const bool isk = pn >= 4;
            const float l2g = __log2f(1.f - exp2f(-5.f - (float)h));
#pragma unroll
            for (int ai = 0; ai < 2; ++ai)
#pragma unroll
                for (int m = 0; m < 4; ++m) {
                    const int row = row0 + ai * 128 + m * 16;
                    int pos, ex;
                    if (sample) { pos = 2048; ex = isk ? 0 : 1; } else { pos = row & (T - 1); const int idx = pos & 127; ex = isk ? 127 - idx : idx + 1; }
                    const float sc = exp2f((float)ex * l2g) * (isk ? 0.0625f : 1.0f);
                    const f32x4* rp = (const f32x4*)(rope + pos * 128 + cl0);
                    f32x4 cs[4]; cs[0] = rp[0]; cs[1] = rp[1]; cs[2] = rp[2]; cs[3] = rp[3];
                    float y1[8], y2[8];
#pragma unroll
                    for (int n = 0; n < 2; ++n)
#pragma unroll
                        for (int e = 0; e < 4; ++e) {
                            const float c = (e & 1) ? cs[n * 2 + (e >> 1)].z : cs[n * 2 + (e >> 1)].x, s = (e & 1) ? cs[n * 2 + (e >> 1)].w : cs[n * 2 + (e >> 1)].y;
                            const float x1 = acc[ai][0][m][n][e], x2 = acc[ai][1][m][n][e];
                            y1[n * 4 + e] = (x1 * c - x2 * s) * sc; y2[n * 4 + e] = (x2 * c + x1 * s) * sc;
                        }
                    u32x4 w1, w2;
                    w1.x = pk2(y1[0], y1[1]); w1.y = pk2(y1[2], y1[3]); w1.z = pk2(y1[4], y1[5]); w1.w = pk2(y1[6], y1[7]);
                    w2.x = pk2(y2[0], y2[1]); w2.y = pk2(y2[2], y2[3]); w2.z = pk2(y2[4], y2[5]); w2.w = pk2(y2[6], y2[7]);
                    bf16_t* rowp = P + (size_t)row * NP + pn * 256 + cl0;
                    *(u32x4*)rowp = w1; *(u32x4*)(rowp + 128) = w2;
                    if (isk && !sample) {
                        bf16_t* kt = KT + ((size_t)((row >> 11) * 4 + h) * 256 + cl0) * T + pos;
#pragma unroll
                        for (int j = 0; j < 8; ++j) { kt[(size_t)j * T] = f2bf(y1[j]); kt[(size_t)(j + 128) * T] = f2bf(y2[j]); }
                    }
                }
            return;
        }
#pragma unroll
        for (int bj = 0; bj < 2; ++bj) {
            const int cb = pn * 2 + bj;
            if (cb >= 97) continue;
            const int mode = (cb < 32) ? 0 : (cb < 48) ? 1 : (cb < 73) ? 0 : (cb < 81) ? 1 : 2;
            const bool vt = (cb < 32) && !sample;
#pragma unroll
            for (int ai = 0; ai < 2; ++ai)
#pragma unroll
                for (int m = 0; m < 4; ++m) {
                    const int row = row0 + ai * 128 + m * 16;
                    float y[8];
#pragma unroll
                    for (int n = 0; n < 2; ++n)
#pragma unroll
                        for (int e = 0; e < 4; ++e) { float x = acc[ai][bj][m][n][e]; if (mode == 1) x = x * sigm(x); else if (mode == 2) x = sigm(x); y[n * 4 + e] = x; }
                    if (vt) {
                        const int hd = cb * 128 + cl0 - O_V;
                        bf16_t* vp = P + ((size_t)(row >> 11) * T + hd) * NP + O_V + (row & (T - 1));
#pragma unroll
                        for (int j = 0; j < 8; ++j) vp[(size_t)j * NP] = f2bf(y[j]);
                    } else {
                        u32x4 w; w.x = pk2(y[0], y[1]); w.y = pk2(y[2], y[3]); w.z = pk2(y[4], y[5]); w.w = pk2(y[6], y[7]);
                        *(u32x4*)(P + (size_t)row * NP + cb * 128 + cl0) = w;
                    }
                }
        }
    }
};

__device__ __forceinline__ float lerp_bf(const bf16_t* cur, const bf16_t* prv, float mu) { const float c = bf2f(*cur); const float p = prv ? bf2f(*prv) : 0.f; return c + (p - c) * mu; }

__device__ __forceinline__ void rw_prep_item(const Args& a, LAS unsigned char* wl  , int tt, int h, int lane) {
    unsigned char* ws = a.ws;
    const bf16_t* P = (const bf16_t*)(ws + WS_P);
    const int l15 = lane & 15, quad = lane >> 4;
    const bool sample = tt >= 1024;
    const int row_base = sample ? MP + (tt - 1024) * 16 : tt * 16;
    const float* mu = a.in[I_MU];
    bf16x8 Aw[2], Aa[2];
    {
        const int m = row_base + l15;
        const bf16_t* cur = P + (size_t)m * NP + O_SH;
        const bf16_t* prv = sample ? P + (size_t)(m + MS) * NP + O_SH : ((m & (T - 1)) ? cur - NP : nullptr);
#pragma unroll
        for (int which = 0; which < 2; ++which)
#pragma unroll
            for (int ks = 0; ks < 2; ++ks) {
                const int col = 3072 + which * 64 + ks * 32 + quad * 8;
                const u32x4 cw = *(const u32x4*)(cur + col); u32x4 pw = {0u, 0u, 0u, 0u}; if (prv) pw = *(const u32x4*)(prv + col);
                const f32x4 m0 = *(const f32x4*)(mu + col), m1 = *(const f32x4*)(mu + col + 4);
                float z[8];
                const unsigned cws[4] = {cw.x, cw.y, cw.z, cw.w}, pws[4] = {pw.x, pw.y, pw.z, pw.w};
#pragma unroll
                for (int j = 0; j < 4; ++j) {
                    const float c0 = bflo(cws[j]), c1 = bfhi(cws[j]), p0 = bflo(pws[j]), p1 = bfhi(pws[j]);
                    const float mm0 = (j < 2) ? m0[2 * j] : m1[2 * j - 4], mm1 = (j < 2) ? m0[2 * j + 1] : m1[2 * j - 3];
                    z[2 * j] = c0 + (p0 - c0) * mm0; z[2 * j + 1] = c1 + (p1 - c1) * mm1;
                }
                if (which == 0) {
#pragma unroll
                    for (int j = 0; j < 8; ++j) z[j] = 1.f - 2.f / (__expf(2.f * z[j]) + 1.f);
                }
                u32x4 o; o.x = pk2(z[0], z[1]); o.y = pk2(z[2], z[3]); o.z = pk2(z[4], z[5]); o.w = pk2(z[6], z[7]);
                if (which == 0) Aw[ks] = __builtin_bit_cast(bf16x8, o); else Aa[ks] = __builtin_bit_cast(bf16x8, o);
            }
    }
    const bf16_t* W2T = (const bf16_t*)(ws + WS_W2T); const bf16_t* A2T = (const bf16_t*)(ws + WS_A2T);
    unsigned char* rec = ws + WS_CH + ((size_t)((tt >> 7) * 16 + h) * 128 + (tt & 127)) * REC;
    LAS bf16_t* LA = (LAS bf16_t*)wl;
    LAS bf16_t* LR = LA + 16 * 72;
    LAS bf16_t* LB = LR + 16 * 72;
    LAS bf16_t* LK = LB + 16 * 72;
    LAS float* LN = (LAS float*)(wl + 9216);
    float tA[4][4], tBi[4][4], tBp[4][4];
    float ssq[4] = {0.f, 0.f, 0.f, 0.f}, bon[4] = {0.f, 0.f, 0.f, 0.f};
#pragma unroll
    for (int nt = 0; nt < 4; ++nt) {
        const int ch = h * 64 + nt * 16 + l15, cc = nt * 16 + l15;
        f32x4 cw = {0.f, 0.f, 0.f, 0.f}, ca = {0.f, 0.f, 0.f, 0.f};
#pragma unroll
        for (int ks = 0; ks < 2; ++ks) {
            const bf16x8 bw = *(const bf16x8*)(W2T + (size_t)ch * 64 + ks * 32 + quad * 8), ba = *(const bf16x8*)(A2T + (size_t)ch * 64 + ks * 32 + quad * 8);
            cw = MFMA32(Aw[ks], bw, cw); ca = MFMA32(Aa[ks], ba, ca);
        }
        const float w0 = a.in[I_W0][ch], a0 = a.in[I_A0][ch], k_k = a.in[I_KK][ch], k_a = a.in[I_KA][ch], r_k = a.in[I_RK][ch];
        const float mur = mu[ch], muk = mu[1024 + ch], muv = mu[2048 + ch];
        float lw[4], rr[4], kq[4], vv[4], aa4[4], kr4[4];
#pragma unroll
        for (int r = 0; r < 4; ++r) {
            const int m = row_base + quad * 4 + r;
            const bf16_t* cur = P + (size_t)m * NP + O_SH + ch;
            const bf16_t* prv = sample ? P + (size_t)(m + MS) * NP + O_SH + ch : ((m & (T - 1)) ? cur - NP : nullptr);
            const float r_ = lerp_bf(cur, prv, mur), k_ = lerp_bf(cur + 1024, prv ? prv + 1024 : nullptr, muk), v_ = lerp_bf(cur + 2048, prv ? prv + 2048 : nullptr, muv);
            lw[r] = -0.6065306597126334f * sigm(w0 + cw[r]);
            const float aa = sigm(a0 + ca[r]); aa4[r] = aa;
            const float kr = k_ * k_k; kr4[r] = kr; ssq[r] += kr * kr;
            const float kpp = k_ * (1.f + (aa - 1.f) * k_a); kq[r] = kpp;
            rr[r] = r_; vv[r] = v_; bon[r] += r_ * kpp * r_k;
        }
        if (sample) {
#pragma unroll
            for (int r = 0; r < 4; ++r) {
                const int i = (tt - 1024) * 16 + quad * 4 + r;
                float* o = (float*)(ws + WS_OPSS) + ((size_t)(i * 16 + h) * 6) * 64 + cc;
                o[0] = rr[r]; o[64] = __expf(lw[r]); o[128] = kq[r]; o[320] = vv[r];
                tA[nt][r] = kr4[r]; tBi[nt][r] = aa4[r] * kr4[r]; tBp[nt][r] = 0.f;
            }
        } else {
            float c[4]; c[0] = lw[0]; c[1] = c[0] + lw[1]; c[2] = c[1] + lw[2]; c[3] = c[2] + lw[3];
            const float tot = c[3];
            const float s1 = __shfl(tot, (lane - 16) & 63), s2 = __shfl(tot, (lane - 32) & 63), s3 = __shfl(tot, (lane - 48) & 63);
            const float off = (quad >= 1 ? s1 : 0.f) + (quad >= 2 ? s2 : 0.f) + (quad >= 3 ? s3 : 0.f);
            const float total = __shfl(c[3] + off, 48 + l15);
            float kqp[4];
#pragma unroll
            for (int r = 0; r < 4; ++r) {
                const float cum = c[r] + off, cumx = cum - lw[r];
                const float ea = __expf(cumx), er = __expf(cum), ei = __expf(-cum), ep = __expf(total - cum);
                const int tk = quad * 4 + r;
                LR[tk * 72 + cc] = f2bf(rr[r] * er); LK[tk * 72 + cc] = f2bf(kq[r] * ei);
                kqp[r] = kq[r] * ep;
                tA[nt][r] = kr4[r] * ea; tBi[nt][r] = aa4[r] * kr4[r] * ei; tBp[nt][r] = aa4[r] * kr4[r] * ep;
            }
            *(u32x2*)(rec + R_KP + cc * 32 + quad * 8) = (u32x2){pk2(kqp[0], kqp[1]), pk2(kqp[2], kqp[3])};
            *(u32x2*)(rec + R_VT + cc * 32 + quad * 8) = (u32x2){pk2(vv[0], vv[1]), pk2(vv[2], vv[3])};
            if (quad == 0) *(float*)(rec + R_WC + cc * 4) = __expf(total);
        }
        asm volatile("" ::: "memory");
    }
    float inv[4];
#pragma unroll
    for (int r = 0; r < 4; ++r) {
        float s = ssq[r], b = bon[r];
#pragma unroll
        for (int o = 1; o < 16; o <<= 1) { s += __shfl_xor(s, o); b += __shfl_xor(b, o); }
        inv[r] = 1.f / fmaxf(sqrtf(s), 1e-12f);
        if (l15 == 0) ((float*)(ws + WS_BC))[(size_t)(row_base + quad * 4 + r) * 16 + h] = b;
    }
    if (sample) {
#pragma unroll
        for (int nt = 0; nt < 4; ++nt)
#pragma unroll
            for (int r = 0; r < 4; ++r) {
                const int i = (tt - 1024) * 16 + quad * 4 + r;
                float* o = (float*)(ws + WS_OPSS) + ((size_t)(i * 16 + h) * 6) * 64 + nt * 16 + l15;
                o[192] = tA[nt][r] * inv[r]; o[256] = tBi[nt][r] * inv[r];
            }
        return;
    }
#pragma unroll
    for (int nt = 0; nt < 4; ++nt) {
        const int cc = nt * 16 + l15;
        float bp[4];
#pragma unroll
        for (int r = 0; r < 4; ++r) { const int tk = quad * 4 + r;
            LA[tk * 72 + cc] = f2bf(-tA[nt][r] * inv[r]); LB[tk * 72 + cc] = f2bf(tBi[nt][r] * inv[r]); bp[r] = tBp[nt][r] * inv[r]; }
        *(u32x2*)(rec + R_BP + cc * 32 + quad * 8) = (u32x2){pk2(bp[0], bp[1]), pk2(bp[2], bp[3])};
    }
    LDS_WAIT();
#pragma unroll
    for (int i = 0; i < 2; ++i) { const int idx = lane + 64 * i, rr = idx >> 3, c8 = (idx & 7) * 8;
        *(u32x4*)(rec + R_AT + rr * 128 + c8 * 2) = *(const LAS u32x4*)(LA + rr * 72 + c8);
        *(u32x4*)(rec + R_RT + rr * 128 + c8 * 2) = *(const LAS u32x4*)(LR + rr * 72 + c8); }
    f32x4 nab = {0.f, 0.f, 0.f, 0.f}, nak = nab, nrb = nab, nrk = nab;
#pragma unroll
    for (int ks = 0; ks < 2; ++ks) {
        const bf16x8 fa = *(const LAS bf16x8*)(LA + l15 * 72 + ks * 32 + quad * 8), fr_ = *(const LAS bf16x8*)(LR + l15 * 72 + ks * 32 + quad * 8);
        const bf16x8 fb = *(const LAS bf16x8*)(LB + l15 * 72 + ks * 32 + quad * 8), fk = *(const LAS bf16x8*)(LK + l15 * 72 + ks * 32 + quad * 8);
        nab = MFMA32(fa, fb, nab); nak = MFMA32(fa, fk, nak); nrb = MFMA32(fr_, fb, nrb); nrk = MFMA32(fr_, fk, nrk);
    }
#pragma unroll
    for (int r = 0; r < 4; ++r) {
        const int t = quad * 4 + r, j = l15;
        const float vab = (j < t) ? nab[r] : 0.f, vak = (j < t) ? nak[r] : 0.f, vrb = (j <= t) ? nrb[r] : 0.f, vrk = (j <= t) ? nrk[r] : 0.f;
        LN[t * 16 + j] = vab;
        *(bf16_t*)(rec + R_AAK + (t * 16 + j) * 2) = f2bf(vak);
        *(bf16_t*)(rec + R_ARB + (t * 16 + j) * 2) = f2bf(vrb);
        *(bf16_t*)(rec + R_ARK + (t * 16 + j) * 2) = f2bf(vrk);
    }
    LDS_WAIT();
    if (lane < 16) {
        float tc[16];
#pragma unroll
        for (int t = 0; t < 16; ++t) {
            float s = (t == lane) ? 1.f : 0.f;
#pragma unroll
            for (int j = 0; j < t; ++j) s += LN[t * 16 + j] * tc[j];
            tc[t] = s;
            *(bf16_t*)(rec + R_TT + (t * 16 + lane) * 2) = f2bf(s);
        }
    }
    LDS_WAIT();
}

__device__ __forceinline__ bf16x8 k16(u32x2 v) { const u32x4 w = {v.x, v.y, 0u, 0u}; return __builtin_bit_cast(bf16x8, w); }
#define SCAN_DECL(F) bf16x8 F##_at0, F##_at1, F##_rt0, F##_rt1; u32x2 F##_aak, F##_tt, F##_arb, F##_ark, F##_vt, F##_bp0, F##_bp1, F##_bp2, F##_bp3, F##_kp0, F##_kp1, F##_kp2, F##_kp3; float F##_wc0, F##_wc1, F##_wc2, F##_wc3
#define SCAN_LOAD(F, REC_) do { const unsigned char* rec_ = (REC_); \
    F##_at0 = *(const bf16x8*)(rec_ + R_AT + o_nat); F##_at1 = *(const bf16x8*)(rec_ + R_AT + o_nat + 64); \
    F##_rt0 = *(const bf16x8*)(rec_ + R_RT + o_nat); F##_rt1 = *(const bf16x8*)(rec_ + R_RT + o_nat + 64); \
    F##_aak = *(const u32x2*)(rec_ + R_AAK + o_sm); F##_tt = *(const u32x2*)(rec_ + R_TT + o_sm); F##_arb = *(const u32x2*)(rec_ + R_ARB + o_sm); F##_ark = *(const u32x2*)(rec_ + R_ARK + o_sm); \
    F##_vt = *(const u32x2*)(rec_ + R_VT + vt * 512 + o_sm); \
    F##_bp0 = *(const u32x2*)(rec_ + R_BP + o_sm); F##_bp1 = *(const u32x2*)(rec_ + R_BP + 512 + o_sm); F##_bp2 = *(const u32x2*)(rec_ + R_BP + 1024 + o_sm); F##_bp3 = *(const u32x2*)(rec_ + R_BP + 1536 + o_sm); \
    F##_kp0 = *(const u32x2*)(rec_ + R_KP + o_sm); F##_kp1 = *(const u32x2*)(rec_ + R_KP + 512 + o_sm); F##_kp2 = *(const u32x2*)(rec_ + R_KP + 1024 + o_sm); F##_kp3 = *(const u32x2*)(rec_ + R_KP + 1536 + o_sm); \
    F##_wc0 = *(const float*)(rec_ + R_WC + l15 * 4); F##_wc1 = *(const float*)(rec_ + R_WC + 64 + l15 * 4); F##_wc2 = *(const float*)(rec_ + R_WC + 128 + l15 * 4); F##_wc3 = *(const float*)(rec_ + R_WC + 192 + l15 * 4); } while (0)
#define SCAN_UPD(NT, BP, KP, WC) do { f32x4 sn = S##NT * (WC); sn = MFMA32(ua, k16(BP), sn); sn = MFMA32(vtf, k16(KP), sn); S##NT = sn; \
    _Pragma("unroll") for (int r = 0; r < 4; ++r) Sb[(quad * 4 + r) * 72 + NT * 16 + l15] = f2bf(sn[r]); } while (0)
#define SCAN_STEP(F, N, CH) do { const int ch_ = (CH); \
    SCAN_LOAD(N, rec0 + (size_t)(ch_ < 126 ? ch_ + 2 : 127) * REC); \
    const bf16x8 sa0 = *(const LAS bf16x8*)(Sb + l15 * 72 + quad * 8), sa1 = *(const LAS bf16x8*)(Sb + l15 * 72 + 32 + quad * 8); \
    const bf16x8 vtf = k16(F##_vt); const f32x4 z = {0.f, 0.f, 0.f, 0.f}; \
    f32x4 Y = MFMA32(sa0, F##_at0, z); Y = MFMA32(sa1, F##_at1, Y); Y = MFMA32(vtf, k16(F##_aak), Y); \
    _Pragma("unroll") for (int r = 0; r < 4; ++r) Yb[(quad * 4 + r) * 16 + l15] = f2bf(Y[r]); \
    LDS_WAIT(); \
    const bf16x8 ya = k16(*(const LAS u32x2*)(Yb + l15 * 16 + quad * 4)); \
    f32x4 U = MFMA32(ya, k16(F##_tt), z); \
    _Pragma("unroll") for (int r = 0; r < 4; ++r) Ub[(quad * 4 + r) * 16 + l15] = f2bf(U[r]); \
    LDS_WAIT(); \
    const bf16x8 ua = k16(*(const LAS u32x2*)(Ub + l15 * 16 + quad * 4)); \
    f32x4 O = MFMA32(sa0, F##_rt0, z); O = MFMA32(sa1, F##_rt1, O); O = MFMA32(ua, k16(F##_arb), O); O = MFMA32(vtf, k16(F##_ark), O); \
    *(f32x4*)(ob + (size_t)(ch_ * 16 + l15) * D) = O; \
    SCAN_UPD(0, F##_bp0, F##_kp0, F##_wc0); SCAN_UPD(1, F##_bp1, F##_kp1, F##_wc1); SCAN_UPD(2, F##_bp2, F##_kp2, F##_wc2); SCAN_UPD(3, F##_bp3, F##_kp3, F##_wc3); \
    LDS_WAIT(); __builtin_amdgcn_sched_barrier(0); } while (0)
__device__ __forceinline__ void rw_scan_task(const Args& a, LAS unsigned char* wl  , int b, int h, int vt, int lane) {
    unsigned char* ws = a.ws;
    const int l15 = lane & 15, quad = lane >> 4;
    LAS bf16_t* Sb = (LAS bf16_t*)wl;
    LAS bf16_t* Yb = (LAS bf16_t*)(wl + 2304);
    LAS bf16_t* Ub = (LAS bf16_t*)(wl + 2304 + 512);
    const int o_nat = l15 * 128 + quad * 16, o_sm = l15 * 32 + quad * 8;
    const unsigned char* rec0 = ws + WS_CH + (size_t)((b * 16 + h) * 128) * REC;
    float* ob = (float*)(ws + WS_OB) + (size_t)(b * T) * D + h * 64 + vt * 16 + quad * 4;
    f32x4 S0 = {0.f, 0.f, 0.f, 0.f}, S1 = S0, S2 = S0, S3 = S0;
#pragma unroll
    for (int nt = 0; nt < 4; ++nt)
#pragma unroll
        for (int r = 0; r < 4; ++r) Sb[(quad * 4 + r) * 72 + nt * 16 + l15] = 0;
    LDS_WAIT();
    SCAN_DECL(f0); SCAN_DECL(f1); SCAN_DECL(f2);
    SCAN_LOAD(f0, rec0); SCAN_LOAD(f1, rec0 + REC);
    for (int ch = 0; ch < 126; ch += 3) { SCAN_STEP(f0, f2, ch); SCAN_STEP(f1, f0, ch + 1); SCAN_STEP(f2, f1, ch + 2); }
    SCAN_STEP(f0, f2, 126); SCAN_STEP(f1, f0, 127);
    float* so = a.out + OUT_RWP + (size_t)((b * 16 + h) * 64 + vt * 16) * 64;
#pragma unroll
    for (int r = 0; r < 4; ++r) { so[(quad * 4 + r) * 64 + l15] = S0[r]; so[(quad * 4 + r) * 64 + 16 + l15] = S1[r]; so[(quad * 4 + r) * 64 + 32 + l15] = S2[r]; so[(quad * 4 + r) * 64 + 48 + l15] = S3[r]; }
}

__device__ __forceinline__ void rw_sample_wave(const Args& a, int i, int h, int lane) {
    unsigned char* ws = a.ws;
    const float* s0 = a.in[I_SRW] + ((size_t)(i * 16 + h) * 64 + lane) * 64;
    const float* op = (const float*)(ws + WS_OPSS) + (size_t)(i * 16 + h) * 6 * 64;
    float s[64];
#pragma unroll
    for (int j = 0; j < 16; ++j) { const f32x4 t = ((const f32x4*)s0)[j]; s[4 * j] = t.x; s[4 * j + 1] = t.y; s[4 * j + 2] = t.z; s[4 * j + 3] = t.w; }
    const float r_l = op[lane], w_l = op[64 + lane], k_l = op[128 + lane], kk_l = op[192 + lane], b_l = op[256 + lane], v = op[320 + lane];
#define RL(x, j) __builtin_bit_cast(float, __builtin_amdgcn_readlane(__builtin_bit_cast(int, (x)), (j)))
    float sk = 0.f;
#pragma unroll
    for (int j = 0; j < 64; ++j) sk += s[j] * RL(kk_l, j);
    float o = 0.f;
#pragma unroll
    for (int j = 0; j < 64; ++j) { s[j] = s[j] * RL(w_l, j) - sk * RL(b_l, j) + v * RL(k_l, j); o += s[j] * RL(r_l, j); }
#undef RL
    float* so = a.out + OUT_RWS + ((size_t)(i * 16 + h) * 64 + lane) * 64;
#pragma unroll
    for (int j = 0; j < 16; ++j) ((f32x4*)so)[j] = (f32x4){s[4 * j], s[4 * j + 1], s[4 * j + 2], s[4 * j + 3]};
    ((float*)(ws + WS_OB))[(size_t)(MP + i) * D + h * 64 + lane] = o;
}

constexpr int KN_LD = 264, VS_LD = 136, SS_LD = 264;
constexpr int L_KN = 0, L_VS = 128 * KN_LD * 2  , L_SS = L_VS + 64 * VS_LD * 2  , L_RET_END = L_SS + 64 * SS_LD * 2  ;
__device__ __forceinline__ void ret_unit(const Args& a, LAS unsigned char* lds, int unit, int tid) {
    unsigned char* ws = a.ws;
    const bf16_t* P = (const bf16_t*)(ws + WS_P);
    const int dvs = unit & 7, h = (unit >> 3) & 3, b = unit >> 5;
    const int wave = tid >> 6, lane = tid & 63, l15 = lane & 15, quad = lane >> 4;
    LAS bf16_t* KN = (LAS bf16_t*)(lds + L_KN); LAS bf16_t* VS = (LAS bf16_t*)(lds + L_VS); LAS bf16_t* SS = (LAS bf16_t*)(lds + L_SS);
    const float g = 1.f - exp2f(-5.f - (float)h), l2g = __log2f(g);
    const float gC = exp2f(128.f * l2g), ginvC = exp2f(-128.f * l2g);
    const bf16_t* KT = (const bf16_t*)(ws + WS_KT) + (size_t)(b * 4 + h) * 256 * T;
    f32x4 sacc[2][4];
#pragma unroll
    for (int n = 0; n < 2; ++n)
#pragma unroll
        for (int d = 0; d < 4; ++d) sacc[n][d] = (f32x4){0.f, 0.f, 0.f, 0.f};
    for (int i = tid; i < 64 * SS_LD / 2; i += 512) ((LAS unsigned*)SS)[i] = 0u;
    const int it = wave;
    u32x4 stk[8], stv[2];
#define RET_ISSUE(CC) do { const int tok0_ = b * T + (CC) * 128; \
        _Pragma("unroll") for (int i = 0; i < 8; ++i) { const int idx = tid + 512 * i, r = idx >> 5, c8 = (idx & 31) * 8; stk[i] = *(const u32x4*)(P + (size_t)(tok0_ + r) * NP + O_K + h * 256 + c8); } \
        _Pragma("unroll") for (int i = 0; i < 2; ++i) { const int idx = tid + 512 * i, r = idx >> 4, c8 = (idx & 15) * 8; stv[i] = *(const u32x4*)(P + (size_t)(b * T + h * 512 + dvs * 64 + r) * NP + O_V + (CC) * 128 + c8); } } while (0)
    RET_ISSUE(0);
    for (int c = 0; c < 16; ++c) {
        const int tok0 = b * T + c * 128;
        bf16x8 qf[8];
#pragma unroll
        for (int ks = 0; ks < 8; ++ks) qf[ks] = *(const bf16x8*)(P + (size_t)(tok0 + it * 16 + l15) * NP + h * 256 + ks * 32 + quad * 8);
#pragma unroll
        for (int i = 0; i < 8; ++i) { const int idx = tid + 512 * i, r = idx >> 5, c8 = (idx & 31) * 8; *(LAS u32x4*)(KN + r * KN_LD + c8) = stk[i]; }
#pragma unroll
        for (int i = 0; i < 2; ++i) { const int idx = tid + 512 * i, r = idx >> 4, c8 = (idx & 15) * 8; *(LAS u32x4*)(VS + r * VS_LD + c8) = stv[i]; }
        __syncthreads();
        bf16x8 ktf[2][4];
#pragma unroll
        for (int n = 0; n < 2; ++n)
#pragma unroll
            for (int ks = 0; ks < 4; ++ks) ktf[n][ks] = *(const bf16x8*)(KT + (size_t)((2 * wave + n) * 16 + l15) * T + c * 128 + ks * 32 + quad * 8);
        if (c < 15) RET_ISSUE(c + 1);
        f32x4 oacc[4];
#pragma unroll
        for (int d = 0; d < 4; ++d) oacc[d] = (f32x4){0.f, 0.f, 0.f, 0.f};
#pragma unroll
        for (int ks = 0; ks < 8; ++ks)
#pragma unroll
            for (int d = 0; d < 4; ++d) { const bf16x8 sb = *(const LAS bf16x8*)(SS + (d * 16 + l15) * SS_LD + ks * 32 + quad * 8); oacc[d] = MFMA32(qf[ks], sb, oacc[d]); }
#pragma unroll
        for (int p = 0; p < 4; ++p) {
            if (2 * p <= it) {
                f32x4 s0 = {0.f, 0.f, 0.f, 0.f}, s1 = {0.f, 0.f, 0.f, 0.f};
#pragma unroll
                for (int ks = 0; ks < 8; ++ks) { const bf16x8 ka = *(const LAS bf16x8*)(KN + ((2 * p) * 16 + l15) * KN_LD + ks * 32 + quad * 8); s0 = MFMA32(ka, qf[ks], s0); }
                if (2 * p + 1 <= it) {
#pragma unroll
                    for (int ks = 0; ks < 8; ++ks) { const bf16x8 ka = *(const LAS bf16x8*)(KN + ((2 * p + 1) * 16 + l15) * KN_LD + ks * 32 + quad * 8); s1 = MFMA32(ka, qf[ks], s1); }
                }
#pragma unroll
                for (int r = 0; r < 4; ++r) {
                    const int jl = quad * 4 + r;
                    s0[r] = (2 * p == it && jl > l15) ? 0.f : s0[r] * ginvC;
                    s1[r] = (2 * p + 1 > it || (2 * p + 1 == it && jl > l15)) ? 0.f : s1[r] * ginvC;
                }
                u32x4 aw; aw.x = pk2(s0[0], s0[1]); aw.y = pk2(s0[2], s0[3]); aw.z = pk2(s1[0], s1[1]); aw.w = pk2(s1[2], s1[3]);
                const bf16x8 af = __builtin_bit_cast(bf16x8, aw);
#pragma unroll
                for (int d = 0; d < 4; ++d) {
                    const LAS bf16_t* vr = VS + (d * 16 + l15) * VS_LD + 32 * p + quad * 4;
                    const u32x2 lo = *(const LAS u32x2*)vr, hi = *(const LAS u32x2*)(vr + 16);
                    const u32x4 bw = {lo.x, lo.y, hi.x, hi.y};
                    oacc[d] = MFMA32(af, __builtin_bit_cast(bf16x8, bw), oacc[d]);
                }
            }
        }
        {
            bf16_t* OA = (bf16_t*)(ws + WS_OA); float* SQA = (float*)(ws + WS_SQA);
#pragma unroll
            for (int r = 0; r < 4; ++r) {
                const int tok = tok0 + it * 16 + quad * 4 + r;
                float ss = 0.f;
#pragma unroll
                for (int d = 0; d < 4; ++d) { const float v = oacc[d][r]; ss += v * v; OA[(size_t)tok * 2048 + h * 512 + dvs * 64 + d * 16 + l15] = f2bf(v); }
#pragma unroll
                for (int o = 1; o < 16; o <<= 1) ss += __shfl_xor(ss, o);
                if (l15 == 0) SQA[(size_t)tok * 32 + h * 8 + dvs] = ss;
            }
        }
        __syncthreads();
#pragma unroll
        for (int n = 0; n < 2; ++n)
#pragma unroll
            for (int d = 0; d < 4; ++d) {
                f32x4 s = sacc[n][d] * gC;
#pragma unroll
                for (int ks = 0; ks < 4; ++ks) { const bf16x8 va = *(const LAS bf16x8*)(VS + (d * 16 + l15) * VS_LD + ks * 32 + quad * 8); s = MFMA32(va, ktf[n][ks], s); }
                sacc[n][d] = s;
#pragma unroll
                for (int r = 0; r < 4; ++r) SS[(d * 16 + quad * 4 + r) * SS_LD + (2 * wave + n) * 16 + l15] = f2bf(s[r]);
            }
        __syncthreads();
    }
    float* so = a.out + OUT_RETP + (size_t)(b * 4 + h) * 256 * 512;
#pragma unroll
    for (int n = 0; n < 2; ++n)
#pragma unroll
        for (int d = 0; d < 4; ++d) *(f32x4*)(so + (size_t)((2 * wave + n) * 16 + l15) * 512 + dvs * 64 + d * 16 + quad * 4) = sacc[n][d];
}
#undef RET_ISSUE

__device__ __forceinline__ void ret_sample_unit(const Args& a, LAS unsigned char* lds, int i, int h, int tid) {
    unsigned char* ws = a.ws;
    const bf16_t* Prow = (const bf16_t*)(ws + WS_P) + (size_t)(MP + i) * NP;
    LAS float* Q = (LAS float*)lds; LAS float* Kh = Q + 256; LAS float* RED = Kh + 256; LAS float* OS = RED + 16;
    const float g = 1.f - exp2f(-5.f - (float)h);
    const int lane = tid & 63, wave = tid >> 6;
    float qk = 0.f;
    if (tid < 256) { const float q = bf2f(Prow[h * 256 + tid]), k = bf2f(Prow[O_K + h * 256 + tid]); Q[tid] = q; Kh[tid] = k; qk = q * k; }
    qk = wave_sum(qk);
    if (lane == 0) RED[wave] = qk;
    __syncthreads();
    const float qkv = (RED[0] + RED[1] + RED[2] + RED[3]) / g;
    const int dkg = tid >> 7, dv4 = 4 * (tid & 127);
    const u32x2 vw = *(const u32x2*)(Prow + O_V + h * 512 + dv4);
    const f32x4 v = {bflo(vw.x), bfhi(vw.x), bflo(vw.y), bfhi(vw.y)};
    const float* s0 = a.in[I_SRET] + (size_t)(i * 4 + h) * 256 * 512 + dv4;
    float* s1 = a.out + OUT_RETS + (size_t)(i * 4 + h) * 256 * 512 + dv4;
    f32x4 o = {0.f, 0.f, 0.f, 0.f};
#pragma unroll 8
    for (int j = 0; j < 64; ++j) {
        const int dk = dkg * 64 + j;
        const f32x4 s = __builtin_nontemporal_load((const f32x4*)(s0 + (size_t)dk * 512));
        o += s * Q[dk];
        __builtin_nontemporal_store(s * g + v * Kh[dk], (f32x4*)(s1 + (size_t)dk * 512));
    }
    *(LAS f32x4*)(OS + dkg * 512 + dv4) = o;
    __syncthreads();
    float y[4] = {0.f, 0.f, 0.f, 0.f}; float ss = 0.f;
    if (tid < 128) {
        const f32x4 t = *(LAS f32x4*)(OS + dv4) + *(LAS f32x4*)(OS + 512 + dv4) + *(LAS f32x4*)(OS + 1024 + dv4) + *(LAS f32x4*)(OS + 1536 + dv4) + v * qkv;
        y[0] = t.x; y[1] = t.y; y[2] = t.z; y[3] = t.w; ss = t.x * t.x + t.y * t.y + t.z * t.z + t.w * t.w;
    }
    ss = wave_sum(ss);
    if (lane == 0) RED[8 + wave] = ss;
    __syncthreads();
    if (tid < 128) {
        const float rs = 1.0f / sqrtf((RED[8] + RED[9]) * (1.f / 512.f) + EPS);
        const u32x2 gw = *(const u32x2*)(Prow + O_GA + h * 512 + dv4);
        u32x2 ow; ow.x = pk2(y[0] * rs * bflo(gw.x), y[1] * rs * bfhi(gw.x)); ow.y = pk2(y[2] * rs * bflo(gw.y), y[3] * rs * bfhi(gw.y));
        *(u32x2*)((bf16_t*)(ws + WS_OA) + (size_t)(MP + i) * 2048 + h * 512 + dv4) = ow;
    }
    __syncthreads();
}

__device__ __forceinline__ void ret_sample_wave(const Args& a, int i, int h, int lane) {
    unsigned char* ws = a.ws;
    const bf16_t* Prow = (const bf16_t*)(ws + WS_P) + (size_t)(MP + i) * NP;
    const float g = 1.f - exp2f(-5.f - (float)h);
    float q[4], k[4]; float qk = 0.f;
#pragma unroll
    for (int j = 0; j < 4; ++j) { q[j] = bf2f(Prow[h * 256 + 64 * j + lane]); k[j] = bf2f(Prow[O_K + h * 256 + 64 * j + lane]); qk += q[j] * k[j]; }
    const float qkv = wave_sum(qk) / g;
    f32x4 v[2];
#pragma unroll
    for (int e = 0; e < 2; ++e) { const u32x2 vw = *(const u32x2*)(Prow + O_V + h * 512 + e * 256 + lane * 4); v[e] = (f32x4){bflo(vw.x), bfhi(vw.x), bflo(vw.y), bfhi(vw.y)}; }
    const float* s0 = a.in[I_SRET] + (size_t)(i * 4 + h) * 256 * 512 + lane * 4;
    float* s1 = a.out + OUT_RETS + (size_t)(i * 4 + h) * 256 * 512 + lane * 4;
    f32x4 o[2] = {{0.f, 0.f, 0.f, 0.f}, {0.f, 0.f, 0.f, 0.f}};
#pragma unroll
    for (int j = 0; j < 4; ++j) {
        for (int d0 = 0; d0 < 64; d0 += 8) {
            f32x4 sv[8][2];
#pragma unroll
            for (int d = 0; d < 8; ++d)
#pragma unroll
                for (int e = 0; e < 2; ++e) sv[d][e] = __builtin_nontemporal_load((const f32x4*)(s0 + (size_t)(64 * j + d0 + d) * 512 + e * 256));
#pragma unroll
            for (int d = 0; d < 8; ++d) {
                const float qd = __builtin_bit_cast(float, __builtin_amdgcn_readlane(__builtin_bit_cast(int, q[j]), d0 + d));
                const float kd = __builtin_bit_cast(float, __builtin_amdgcn_readlane(__builtin_bit_cast(int, k[j]), d0 + d));
#pragma unroll
                for (int e = 0; e < 2; ++e) { o[e] += sv[d][e] * qd; __builtin_nontemporal_store(sv[d][e] * g + v[e] * kd, (f32x4*)(s1 + (size_t)(64 * j + d0 + d) * 512 + e * 256)); }
            }
        }
    }
    float ss = 0.f;
#pragma unroll
    for (int e = 0; e < 2; ++e) { o[e] += v[e] * qkv; ss += (o[e].x * o[e].x + o[e].y * o[e].y) + (o[e].z * o[e].z + o[e].w * o[e].w); }
    const float rs = 1.0f / sqrtf(wave_sum(ss) * (1.f / 512.f) + EPS);
#pragma unroll
    for (int e = 0; e < 2; ++e) { const u32x2 gw = *(const u32x2*)(Prow + O_GA + h * 512 + e * 256 + lane * 4);
        u32x2 ow; ow.x = pk2(o[e].x * rs * bflo(gw.x), o[e].y * rs * bfhi(gw.x)); ow.y = pk2(o[e].z * rs * bflo(gw.y), o[e].w * rs * bfhi(gw.y));
        *(u32x2*)((bf16_t*)(ws + WS_OA) + (size_t)(MP + i) * 2048 + h * 512 + e * 256 + lane * 4) = ow; }
}

__device__ __forceinline__ void phase25_row(const Args& a, int m, int lane) {
    unsigned char* ws = a.ws;
    const bf16_t* Prow = (const bf16_t*)(ws + WS_P) + (size_t)m * NP;
    bf16_t* oa = (bf16_t*)(ws + WS_OA) + (size_t)m * 2048;
    const float* sq = (const float*)(ws + WS_SQA) + (size_t)m * 32;
    const bool prompt = m < MP;
    f32x4 sqv[8]; u32x4 ow[4], gw4[4];
    if (prompt) {
#pragma unroll
        for (int j = 0; j < 8; ++j) sqv[j] = ((const f32x4*)sq)[j];
#pragma unroll
        for (int hh = 0; hh < 4; ++hh) { ow[hh] = *(const u32x4*)(oa + hh * 512 + lane * 8); gw4[hh] = *(const u32x4*)(Prow + O_GA + hh * 512 + lane * 8); }
    }
    const float* ob = (const float*)(ws + WS_OB) + (size_t)m * D + lane * 16;
    f32x4 ov[4];
#pragma unroll
    for (int j = 0; j < 4; ++j) ov[j] = ((const f32x4*)ob)[j];
    const float bc = ((const float*)(ws + WS_BC))[(size_t)m * 16 + (lane >> 2)];
    const bf16_t* cur = Prow + O_SH + 2048 + lane * 16;
    const bool hasp = (m >= MP) || (m & (T - 1));
    const bf16_t* prv = (m >= MP) ? cur + (size_t)MS * NP : cur - NP;
    u32x4 cw[2], pw[2] = {{0u, 0u, 0u, 0u}, {0u, 0u, 0u, 0u}}, gbw[2];
    cw[0] = ((const u32x4*)cur)[0]; cw[1] = ((const u32x4*)cur)[1];
    if (hasp) { pw[0] = ((const u32x4*)prv)[0]; pw[1] = ((const u32x4*)prv)[1]; }
    gbw[0] = ((const u32x4*)(Prow + O_GB + lane * 16))[0]; gbw[1] = ((const u32x4*)(Prow + O_GB + lane * 16))[1];
    f32x4 lw4[4], lb4[4], mu4[4];
#pragma unroll
    for (int j = 0; j < 4; ++j) { lw4[j] = ((const f32x4*)(a.in[I_LNW] + lane * 16))[j]; lb4[j] = ((const f32x4*)(a.in[I_LNB] + lane * 16))[j]; mu4[j] = ((const f32x4*)(a.in[I_MU] + 2048 + lane * 16))[j]; }
    if (prompt) {
#pragma unroll
        for (int hh = 0; hh < 4; ++hh) {
            const f32x4 s0 = sqv[2 * hh], s1 = sqv[2 * hh + 1];
            const float rs = 1.0f / sqrtf(((s0.x + s0.y) + (s0.z + s0.w) + (s1.x + s1.y) + (s1.z + s1.w)) * (1.f / 512.f) + EPS);
            const u32x4 o4 = ow[hh], g4 = gw4[hh];
            u32x4 r;
            r.x = pk2(bflo(o4.x) * rs * bflo(g4.x), bfhi(o4.x) * rs * bfhi(g4.x)); r.y = pk2(bflo(o4.y) * rs * bflo(g4.y), bfhi(o4.y) * rs * bfhi(g4.y));
            r.z = pk2(bflo(o4.z) * rs * bflo(g4.z), bfhi(o4.z) * rs * bfhi(g4.z)); r.w = pk2(bflo(o4.w) * rs * bflo(g4.w), bfhi(o4.w) * rs * bfhi(g4.w));
            *(u32x4*)(oa + hh * 512 + lane * 8) = r;
        }
    }
    float o[16], lw[16], lb[16], mu[16];
#pragma unroll
    for (int j = 0; j < 4; ++j) { o[4 * j] = ov[j].x; o[4 * j + 1] = ov[j].y; o[4 * j + 2] = ov[j].z; o[4 * j + 3] = ov[j].w;
        lw[4 * j] = lw4[j].x; lw[4 * j + 1] = lw4[j].y; lw[4 * j + 2] = lw4[j].z; lw[4 * j + 3] = lw4[j].w;
        lb[4 * j] = lb4[j].x; lb[4 * j + 1] = lb4[j].y; lb[4 * j + 2] = lb4[j].z; lb[4 * j + 3] = lb4[j].w;
        mu[4 * j] = mu4[j].x; mu[4 * j + 1] = mu4[j].y; mu[4 * j + 2] = mu4[j].z; mu[4 * j + 3] = mu4[j].w; }
    float s = 0.f;
#pragma unroll
    for (int j = 0; j < 16; ++j) s += o[j];
    s += __shfl_xor(s, 1); s += __shfl_xor(s, 2);
    const float mean = s * (1.f / 64.f);
    float q = 0.f;
#pragma unroll
    for (int j = 0; j < 16; ++j) { const float d = o[j] - mean; q += d * d; }
    q += __shfl_xor(q, 1); q += __shfl_xor(q, 2);
    const float rstd = 1.0f / sqrtf(q * (1.f / 64.f) + 64e-5f);
    const unsigned cws[8] = {cw[0].x, cw[0].y, cw[0].z, cw[0].w, cw[1].x, cw[1].y, cw[1].z, cw[1].w};
    const unsigned pws[8] = {pw[0].x, pw[0].y, pw[0].z, pw[0].w, pw[1].x, pw[1].y, pw[1].z, pw[1].w};
    const unsigned gws[8] = {gbw[0].x, gbw[0].y, gbw[0].z, gbw[0].w, gbw[1].x, gbw[1].y, gbw[1].z, gbw[1].w};
    unsigned outw[8];
#pragma unroll
    for (int j = 0; j < 8; ++j) {
        const float c0 = bflo(cws[j]), c1 = bfhi(cws[j]), p0 = bflo(pws[j]), p1 = bfhi(pws[j]);
        const float v0 = c0 + (p0 - c0) * mu[2 * j], v1 = c1 + (p1 - c1) * mu[2 * j + 1];
        const float y0 = ((o[2 * j] - mean) * rstd * lw[2 * j] + lb[2 * j] + bc * v0) * bflo(gws[j]);
        const float y1 = ((o[2 * j + 1] - mean) * rstd * lw[2 * j + 1] + lb[2 * j + 1] + bc * v1) * bfhi(gws[j]);
        outw[j] = pk2(y0, y1);
    }
    bf16_t* yb = (bf16_t*)(ws + WS_H) + (size_t)m * D + lane * 16;
    *(u32x4*)yb = (u32x4){outw[0], outw[1], outw[2], outw[3]}; *(u32x4*)(yb + 8) = (u32x4){outw[4], outw[5], outw[6], outw[7]};
}

struct EpiT1 {
    static constexpr bool PERM = false;
    const bf16_t* P; float* T1;
    __device__ __forceinline__ void operator()(const f32x4 (&acc)[2][2][4][2], const Unit& u, int wr, int wc, int fr, int fq) const {
        const int row0 = u.pm * 256 + wr * 64 + fr, col0 = u.pn * 256 + wc * 32 + 4 * fq;
#pragma unroll
        for (int ai = 0; ai < 2; ++ai)
#pragma unroll
            for (int m = 0; m < 4; ++m) { const int row = row0 + ai * 128 + m * 16; if (row >= MR) continue;
#pragma unroll
                for (int bj = 0; bj < 2; ++bj)
#pragma unroll
                    for (int n = 0; n < 2; ++n) { const int col = col0 + bj * 128 + n * 16;
                        const u32x2 gw = *(const u32x2*)(P + (size_t)row * NP + O_MA + col);
                        const f32x4 gt = {bflo(gw.x), bfhi(gw.x), bflo(gw.y), bfhi(gw.y)};
                        *(f32x4*)(T1 + (size_t)row * D + col) = acc[ai][bj][m][n] * gt; } asm volatile("" ::: "memory"); }
    }
};
struct EpiMG {
    static constexpr bool PERM = false;
    const bf16_t* P; const float* T1; bf16_t* MG;
    __device__ __forceinline__ void operator()(const f32x4 (&acc)[2][2][4][2], const Unit& u, int wr, int wc, int fr, int fq) const {
        const int row0 = u.pm * 256 + wr * 64 + fr, col0 = u.pn * 256 + wc * 32 + 4 * fq;
#pragma unroll
        for (int ai = 0; ai < 2; ++ai)
#pragma unroll
            for (int m = 0; m < 4; ++m) { const int row = row0 + ai * 128 + m * 16; if (row >= MR) continue;
#pragma unroll
                for (int bj = 0; bj < 2; ++bj)
#pragma unroll
                    for (int n = 0; n < 2; ++n) { const int col = col0 + bj * 128 + n * 16;
                        const u32x2 gw = *(const u32x2*)(P + (size_t)row * NP + O_MB + col);
                        const f32x4 gt = {bflo(gw.x), bfhi(gw.x), bflo(gw.y), bfhi(gw.y)};
                        const f32x4 v = *(const f32x4*)(T1 + (size_t)row * D + col) + acc[ai][bj][m][n] * gt;
                        *(u32x2*)(MG + (size_t)row * D + col) = (u32x2){pk2(v.x, v.y), pk2(v.z, v.w)}; } asm volatile("" ::: "memory"); }
    }
};
struct EpiX1 {
    static constexpr bool PERM = false;
    const float* xp; const float* xs; float* X1; bf16_t* X1B; float* SQ;
    __device__ __forceinline__ void operator()(const f32x4 (&acc)[2][2][4][2], const Unit& u, int wr, int wc, int fr, int fq) const {
        const int row0 = u.pm * 256 + wr * 64 + fr, col0 = u.pn * 256 + wc * 32 + 4 * fq;
#pragma unroll
        for (int ai = 0; ai < 2; ++ai)
#pragma unroll
            for (int m = 0; m < 4; ++m) { const int row = row0 + ai * 128 + m * 16; const bool ok = row < MR;
                const float* xr = (row < MP) ? xp + (size_t)row * D : xs + (size_t)(row - MP) * D;
                float ss = 0.f;
                if (ok) {
#pragma unroll
                    for (int bj = 0; bj < 2; ++bj)
#pragma unroll
                        for (int n = 0; n < 2; ++n) { const int col = col0 + bj * 128 + n * 16;
                            const f32x4 v = *(const f32x4*)(xr + col) + acc[ai][bj][m][n];
                            ss += (v.x * v.x + v.y * v.y) + (v.z * v.z + v.w * v.w);
                            *(f32x4*)(X1 + (size_t)row * D + col) = v;
                            *(u32x2*)(X1B + (size_t)row * D + col) = (u32x2){pk2(v.x, v.y), pk2(v.z, v.w)}; }
                }
                ss += __shfl_xor(ss, 16); ss += __shfl_xor(ss, 32);
                if (ok && fq == 0) SQ[(size_t)row * 16 + u.pn * 4 + wc] = ss; asm volatile("" ::: "memory"); }
    }
};
struct EpiGT {
    static constexpr bool PERM = false;
    const float* SQ; float* GT;
    __device__ __forceinline__ void operator()(const f32x4 (&acc)[2][2][4][2], const Unit& u, int wr, int wc, int fr, int fq) const {
        const int row0 = u.pm * 256 + wr * 64 + fr, col0 = u.pn * 256 + wc * 32 + 4 * fq;
#pragma unroll
        for (int ai = 0; ai < 2; ++ai)
#pragma unroll
            for (int m = 0; m < 4; ++m) { const int row = row0 + ai * 128 + m * 16; if (row >= MR) continue;
                const f32x4* sp = (const f32x4*)(SQ + (size_t)row * 16); const f32x4 q0 = sp[0], q1 = sp[1], q2 = sp[2], q3 = sp[3];
                const float rs = 1.0f / sqrtf((((q0.x + q0.y) + (q0.z + q0.w)) + ((q1.x + q1.y) + (q1.z + q1.w)) + ((q2.x + q2.y) + (q2.z + q2.w)) + ((q3.x + q3.y) + (q3.z + q3.w))) * (1.f / D) + EPS);
#pragma unroll
                for (int bj = 0; bj < 2; ++bj)
#pragma unroll
                    for (int n = 0; n < 2; ++n) { const int col = col0 + bj * 128 + n * 16; const f32x4 t = acc[ai][bj][m][n] * rs;
                        *(f32x4*)(GT + (size_t)row * D + col) = (f32x4){sigm(t.x), sigm(t.y), sigm(t.z), sigm(t.w)}; } asm volatile("" ::: "memory"); }
    }
};
struct EpiX2 {
    static constexpr bool PERM = false;
    const float* X1; const float* GT; float* out; float* SQ;
    __device__ __forceinline__ void operator()(const f32x4 (&acc)[2][2][4][2], const Unit& u, int wr, int wc, int fr, int fq) const {
        const int row0 = u.pm * 256 + wr * 64 + fr, col0 = u.pn * 256 + wc * 32 + 4 * fq;
#pragma unroll
        for (int ai = 0; ai < 2; ++ai)
#pragma unroll
            for (int m = 0; m < 4; ++m) { int row = row0 + ai * 128 + m * 16; asm volatile("" : "+v"(row)); const bool ok = row < MR;
                float ss = 0.f;
                if (ok) {
#pragma unroll
                    for (int bj = 0; bj < 2; ++bj)
#pragma unroll
                        for (int n = 0; n < 2; ++n) { const int col = col0 + bj * 128 + n * 16;
                            const f32x4 v = *(const f32x4*)(X1 + (size_t)row * D + col) + acc[ai][bj][m][n] * *(const f32x4*)(GT + (size_t)row * D + col);
                            ss += (v.x * v.x + v.y * v.y) + (v.z * v.z + v.w * v.w);
                            *(f32x4*)(out + (size_t)row * D + col) = v; asm volatile("" ::: "memory"); }
                }
                ss += __shfl_xor(ss, 16); ss += __shfl_xor(ss, 32);
                if (ok && fq == 0) SQ[(size_t)row * 16 + u.pn * 4 + wc] = ss; asm volatile("" ::: "memory"); }
    }
};


__device__ __forceinline__ f32x4 mini_acc(const bf16_t* A, int lda, const bf16_t* Bt, int K, int kq, int l15, int quad) {
    f32x4 acc = {0.f, 0.f, 0.f, 0.f};
    const int kn = K / 128;
    const bf16_t* ap = A + (size_t)l15 * lda + kq * (K / 4) + quad * 8;
    const bf16_t* bp = Bt + (size_t)l15 * K + kq * (K / 4) + quad * 8;
#pragma unroll 4
    for (int ks = 0; ks < kn; ++ks) acc = MFMA32(*(const bf16x8*)(ap + ks * 32), *(const bf16x8*)(bp + ks * 32), acc);
    return acc;
}
__device__ __forceinline__ f32x4 mini_reduce(LAS f32x4* red, int half, int lane) { return (red[(half * 4 + 0) * 64 + lane] + red[(half * 4 + 1) * 64 + lane]) + (red[(half * 4 + 2) * 64 + lane] + red[(half * 4 + 3) * 64 + lane]); }
template <int PH> __device__ __forceinline__ void mini_phase(const Args& a, LAS unsigned char* lds, int bx, int G, int wave, int lane) {
    unsigned char* ws = a.ws;
    const int l15 = lane & 15, quad = lane >> 4, half = wave >> 2, kq = wave & 3;
    LAS f32x4* red1 = (LAS f32x4*)lds; LAS f32x4* red2 = red1 + 8 * 64;
    const bf16_t* P = (const bf16_t*)(ws + WS_P);
    for (int tp = bx; tp < 256; tp += G) {
        const int tl = tp * 2 + half, mt = tl >> 6, nt = tl & 63, row0 = MP + mt * 16, col0 = nt * 16;
        f32x4 a1, a2 = {0.f, 0.f, 0.f, 0.f};
        if (PH == 0) { a1 = mini_acc((const bf16_t*)(ws + WS_OA) + (size_t)row0 * 2048, 2048, (const bf16_t*)(ws + WS_WDA) + (size_t)col0 * 2048, 2048, kq, l15, quad);
                       a2 = mini_acc((const bf16_t*)(ws + WS_H) + (size_t)row0 * D, D, (const bf16_t*)(ws + WS_WDB) + (size_t)col0 * D, D, kq, l15, quad); }
        if (PH == 1) { a1 = mini_acc((const bf16_t*)(ws + WS_MG) + (size_t)row0 * D, D, (const bf16_t*)(ws + WS_WOUT) + (size_t)col0 * D, D, kq, l15, quad); }
        if (PH == 2) { a1 = mini_acc((const bf16_t*)(ws + WS_X1B) + (size_t)row0 * D, D, (const bf16_t*)(ws + WS_WGATE) + (size_t)col0 * D, D, kq, l15, quad);
                       a2 = mini_acc((const bf16_t*)(ws + WS_PB) + (size_t)row0 * PLE, PLE, (const bf16_t*)(ws + WS_WPLE) + (size_t)col0 * PLE, PLE, kq, l15, quad); }
        red1[wave * 64 + lane] = a1; red2[wave * 64 + lane] = a2;
        __syncthreads();
        if (kq == 0) {
            a1 = mini_reduce(red1, half, lane); a2 = mini_reduce(red2, half, lane);
            const int col = col0 + l15;
            float rs1[4] = {0.f, 0.f, 0.f, 0.f};
            if (PH == 2) {
#pragma unroll
                for (int r = 0; r < 4; ++r) { const f32x4 q = *(const f32x4*)((const float*)(ws + WS_SQS1) + (size_t)(row0 - MP + quad * 4 + r) * 64 + l15 * 4); float t = (q.x + q.y) + (q.z + q.w);
#pragma unroll
                    for (int o = 1; o < 16; o <<= 1) t += __shfl_xor(t, o);
                    rs1[r] = 1.0f / sqrtf(t * (1.f / D) + EPS); }
            }
#pragma unroll
            for (int r = 0; r < 4; ++r) {
                const int row = row0 + quad * 4 + r;
                float ss = 0.f;
                if (PH == 0) { const float ga = bf2f(P[(size_t)row * NP + O_MA + col]), gb = bf2f(P[(size_t)row * NP + O_MB + col]);
                    ((bf16_t*)(ws + WS_MG))[(size_t)row * D + col] = f2bf(a1[r] * ga + a2[r] * gb); }
                if (PH == 1) { const float x1 = a.in[I_XS][(size_t)(row - MP) * D + col] + a1[r]; ss = x1 * x1;
                    ((float*)(ws + WS_X1))[(size_t)row * D + col] = x1; ((bf16_t*)(ws + WS_X1B))[(size_t)row * D + col] = f2bf(x1); }
                if (PH == 2) { const float x2 = ((const float*)(ws + WS_X1))[(size_t)row * D + col] + a2[r] * sigm(rs1[r] * a1[r]); ss = x2 * x2;
                    a.out[OUT_Y + (size_t)row * D + col] = x2; }
                if (PH != 0) {
#pragma unroll
                    for (int o = 1; o < 16; o <<= 1) ss += __shfl_xor(ss, o);
                    if (l15 == 0) ((float*)(ws + (PH == 1 ? WS_SQS1 : WS_SQS2)))[(size_t)(row - MP) * 64 + nt] = ss;
                }
            }
        }
        __syncthreads();
    }
}

#define XB_TMO      128
#define XB_XCNT(j)  (256  + 64 * (j))
#define XB_XSUB(j)  (1280 + 64 * (j))
#define XB_XGEN(j)  (2304 + 64 * (j))
#define XB_TOP      3328
#define XB_TOPGEN   3392
#define XCD_BAR_WORDS 3456
#define XB_SPIN_CAP (1u << 22)
__device__ __forceinline__ unsigned xb_ld(unsigned* p)              { return __hip_atomic_load(p, __ATOMIC_RELAXED, __HIP_MEMORY_SCOPE_AGENT); }
__device__ __forceinline__ unsigned xb_add(unsigned* p, unsigned v) { return __hip_atomic_fetch_add(p, v, __ATOMIC_RELAXED, __HIP_MEMORY_SCOPE_AGENT); }
__device__ __forceinline__ unsigned xb_xcc_id() { return (unsigned)__builtin_amdgcn_s_getreg((3 << 11) | 20) & 0xFu; }
#define XB_SPIN(cond, bar) do { unsigned _sp = 0; while (cond) { __builtin_amdgcn_s_sleep(1); \
    if ((++_sp & 255u) == 0u) { if (xb_ld(&(bar)[XB_TMO])) break; if (_sp > XB_SPIN_CAP) { atomicAdd(&(bar)[XB_TMO], 1u); break; } } } } while (0)
struct XcdBarrier { unsigned* bar; unsigned x; volatile LAS unsigned* st; };
__device__ __forceinline__ XcdBarrier xcd_barrier_post(unsigned* bar, volatile LAS unsigned* st) {
    XcdBarrier b; b.bar = bar; b.x = xb_xcc_id(); b.st = st;
    if (threadIdx.x == 0) (void)xb_add(&bar[XB_XCNT(b.x)], 1u);
    return b;
}
__device__ __forceinline__ void xcd_barrier_complete(unsigned* bar, unsigned x, unsigned& nloc, unsigned& nx) {
    const unsigned G = gridDim.x * gridDim.y * gridDim.z;
    unsigned sum, cnt, mine, sp = 0u;
    for (;;) {
        sum = 0u; cnt = 0u; mine = 0u;
#pragma unroll
        for (unsigned j = 0; j < 16; ++j) { const unsigned c = xb_ld(&bar[XB_XCNT(j)]); sum += c; cnt += (c > 0u) ? 1u : 0u; mine = (j == x) ? c : mine; }
        if (sum == G) break;
        __builtin_amdgcn_s_sleep(1);
        if ((++sp & 255u) == 0u) { if (xb_ld(&bar[XB_TMO])) break; if (sp > XB_SPIN_CAP) { atomicAdd(&bar[XB_TMO], 1u); break; } }
    }
    nloc = mine > 0u ? mine : 1u; nx = cnt > 0u ? cnt : 1u;
}
__device__ __forceinline__ void xcd_barrier(const XcdBarrier& b) {
    asm volatile("s_waitcnt vmcnt(0)" ::: "memory");
    __syncthreads();
    if (threadIdx.x == 0) {
        unsigned* bar = b.bar;
        __builtin_amdgcn_s_waitcnt(0);
        unsigned nloc = b.st[0], nx = b.st[1];
        if (nloc == 0u) { xcd_barrier_complete(bar, b.x, nloc, nx); b.st[0] = nloc; b.st[1] = nx; }
        const unsigned old = xb_add(&bar[XB_XSUB(b.x)], 1u);
        const unsigned gen = old / nloc;
        if (old + 1u == (gen + 1u) * nloc) {
            __builtin_amdgcn_fence(__ATOMIC_RELEASE, "agent");
            asm volatile("s_waitcnt vmcnt(0)" ::: "memory");
            const unsigned og = xb_add(&bar[XB_TOP], 1u);
            const unsigned tg = og / nx;
            if (og + 1u == (tg + 1u) * nx) xb_add(&bar[XB_TOPGEN], 1u);
            else XB_SPIN(xb_ld(&bar[XB_TOPGEN]) == tg, bar);
            __builtin_amdgcn_fence(__ATOMIC_ACQUIRE, "agent");
            xb_add(&bar[XB_XGEN(b.x)], 1u);
            asm volatile("s_waitcnt vmcnt(0)" ::: "memory");
        } else {
            XB_SPIN(xb_ld(&bar[XB_XGEN(b.x)]) == gen, bar);
            __builtin_amdgcn_fence(__ATOMIC_ACQUIRE, "agent");
            asm volatile("s_waitcnt vmcnt(0)" ::: "memory");
        }
    }
    __syncthreads();
}

constexpr int LDS_BYTES = 147456;
constexpr int CTL_SQ1 = 0, CTL_SQ2 = 32768, CTL_CNT = 65536;

#define GRID_SYNC() xcd_barrier(xbar)
__global__ void __launch_bounds__(512, 2) fwd_mega(Args a) {
    extern __shared__ __attribute__((aligned(16))) unsigned char lds_raw[];
    LAS unsigned char* lds = (LAS unsigned char*)lds_raw;
    cg::grid_group grid = cg::this_grid();
    const int tid = threadIdx.x, lane = tid & 63, wave = __builtin_amdgcn_readfirstlane(tid >> 6);
    const int G = gridDim.x, bx = blockIdx.x;
    const int gw = bx * 8 + wave, NGW = G * 8;
    unsigned char* ws = a.ws;
    if (tid < 16) ((LAS unsigned*)(lds + 131072 + 64))[tid] = 0u;
    __syncthreads();
    XcdBarrier xbar = xcd_barrier_post((unsigned*)(ws + WS_BAR), (volatile LAS unsigned*)(lds + 131072 + 64));
    grid.sync();

#if !defined(ONLY_PH) || ONLY_PH == 0
    phase0(a, lds, gw, NGW, wave, lane);
    GRID_SYNC();
#endif
#if !defined(ONLY_PH) || ONLY_PH == 1
    {
        pg8::Gemm g{(const bf16_t*)(ws + WS_H), (const bf16_t*)(ws + WS_WIN), MALL, NP, D}; pg8::StaticOrder S; S.init(MALL, NP, G, bx);
        EpiP E{(bf16_t*)(ws + WS_P), (bf16_t*)(ws + WS_KT), (const f32x2*)(ws + WS_ROPE)};
        pg8::gemm_phase<EpiP>(lds, g, S, E);
    }
    GRID_SYNC();
#endif
#if !defined(ONLY_PH) || ONLY_PH == 2
    for (int it = gw; it < 1032 * 16; it += NGW) rw_prep_item(a, lds + wave * 10240, it >> 4, it & 15, lane);
    GRID_SYNC();
#endif
#if !defined(ONLY_PH) || ONLY_PH == 3
    {
        for (int u = gw; u < MS * 16; u += NGW) rw_sample_wave(a, u >> 4, u & 15, lane);
        if (bx < 128) { if (wave < 4) rw_scan_task(a, lds + wave * 4096, bx >> 4, bx & 15, wave, lane); }
        __syncthreads();
        {
            unsigned* cnt2 = (unsigned*)(ws + WS_CTL) + CTL_CNT + 32;
            LAS unsigned* lu = (LAS unsigned*)(lds + 131072);
            for (;;) {
                if (tid == 0) *lu = atomicAdd(cnt2, 1u);
                __syncthreads();
                const unsigned unit = *lu;
                __syncthreads();
                if (unit >= (unsigned)(MS * 4)) break;
                ret_sample_unit(a, lds, (int)(unit >> 2), (int)(unit & 3), tid);
            }
        }
        {
            unsigned* cnt = (unsigned*)(ws + WS_CTL) + CTL_CNT;
            LAS unsigned* lu = (LAS unsigned*)(lds + 131072);
            for (;;) {
                if (tid == 0) *lu = atomicAdd(cnt, 1u);
                __syncthreads();
                const unsigned unit = *lu;
                __syncthreads();
                if (unit >= 256u) break;
                ret_unit(a, lds, (int)unit, tid);
            }
        }
    }
    GRID_SYNC();
#endif
#if !defined(ONLY_PH) || ONLY_PH == 4
    for (int m = gw; m < MR; m += NGW) phase25_row(a, m, lane);
    GRID_SYNC();
#endif
#if !defined(ONLY_PH) || ONLY_PH == 5
    {
        mini_phase<0>(a, lds, bx, G, wave, lane);
        pg8::StaticOrder S; S.init(MP, D, G, bx);
        { pg8::Gemm g{(const bf16_t*)(ws + WS_OA), (const bf16_t*)(ws + WS_WDA), MP, D, 2048}; EpiT1 E{(const bf16_t*)(ws + WS_P), (float*)(ws + WS_T1)}; pg8::gemm_phase<EpiT1>(lds, g, S, E); }
        { pg8::Gemm g{(const bf16_t*)(ws + WS_H), (const bf16_t*)(ws + WS_WDB), MP, D, D}; EpiMG E{(const bf16_t*)(ws + WS_P), (const float*)(ws + WS_T1), (bf16_t*)(ws + WS_MG)}; pg8::gemm_phase<EpiMG>(lds, g, S, E); }
    }
    GRID_SYNC();
#endif
#if !defined(ONLY_PH) || ONLY_PH == 6
    {
        mini_phase<1>(a, lds, bx, G, wave, lane);
        pg8::StaticOrder S; S.init(MP, D, G, bx);
        pg8::Gemm g{(const bf16_t*)(ws + WS_MG), (const bf16_t*)(ws + WS_WOUT), MP, D, D};
        EpiX1 E{a.in[I_XP], a.in[I_XS], (float*)(ws + WS_X1), (bf16_t*)(ws + WS_X1B), (float*)(ws + WS_SQ1P)};
        pg8::gemm_phase<EpiX1>(lds, g, S, E);
    }
    GRID_SYNC();
#endif
#if !defined(ONLY_PH) || ONLY_PH == 7
    {
        mini_phase<2>(a, lds, bx, G, wave, lane);
        pg8::StaticOrder S; S.init(MP, D, G, bx);
        { pg8::Gemm g{(const bf16_t*)(ws + WS_X1B), (const bf16_t*)(ws + WS_WGATE), MP, D, D}; EpiGT E{(const float*)(ws + WS_SQ1P), (float*)(ws + WS_GT)}; pg8::gemm_phase<EpiGT>(lds, g, S, E); }
        { pg8::Gemm g{(const bf16_t*)(ws + WS_PB), (const bf16_t*)(ws + WS_WPLE), MP, D, PLE}; EpiX2 E{(const float*)(ws + WS_X1), (const float*)(ws + WS_GT), a.out + OUT_Y, (float*)(ws + WS_SQ2P)}; pg8::gemm_phase<EpiX2>(lds, g, S, E); }
    }
    GRID_SYNC();
#endif
#if !defined(ONLY_PH) || ONLY_PH == 8
    {
        const float* sq2 = (const float*)(ws + WS_SQ2P); const float* fg = a.in[I_FNG];
        for (int m = gw; m < MR; m += NGW) {
            float tot;
            if (m < MP) { const f32x4* sp = (const f32x4*)(sq2 + (size_t)m * 16); const f32x4 q0 = sp[0], q1 = sp[1], q2 = sp[2], q3 = sp[3];
                tot = (((q0.x + q0.y) + (q0.z + q0.w)) + ((q1.x + q1.y) + (q1.z + q1.w)) + ((q2.x + q2.y) + (q2.z + q2.w)) + ((q3.x + q3.y) + (q3.z + q3.w))); }
            else tot = wave_sum(((const float*)(ws + WS_SQS2))[(size_t)(m - MP) * 64 + lane]);
            const float rs = 1.0f / sqrtf(tot * (1.f / D) + EPS);
            f32x4* o = (f32x4*)(a.out + OUT_Y + (size_t)m * D);
            f32x4 xv[4];
#pragma unroll
            for (int j = 0; j < 4; ++j) xv[j] = o[lane + 64 * j];
#pragma unroll
            for (int j = 0; j < 4; ++j) o[lane + 64 * j] = xv[j] * rs * ((const f32x4*)fg)[lane + 64 * j];
        }
    }
#endif

}

extern "C" void kernel_launch(void* const* d_in, const int* in_sizes, int n_in, void* d_out, int out_size, void* d_ws, size_t ws_size, hipStream_t stream) {
    static int grid = 0;
    if (grid == 0) {
        if (n_in != 26 || ws_size < WS_END) { fprintf(stderr, "kernel_launch: unexpected n_in %d or ws_size %zu (need %zu)\n", n_in, ws_size, (size_t)WS_END); grid = -1; return; }
        int dev = 0, cus = 0, per_cu = 0;
        hipGetDevice(&dev); hipDeviceGetAttribute(&cus, hipDeviceAttributeMultiprocessorCount, dev);
        if (hipFuncSetAttribute((const void*)fwd_mega, hipFuncAttributeMaxDynamicSharedMemorySize, LDS_BYTES) != hipSuccess) { fprintf(stderr, "kernel_launch: hipFuncSetAttribute failed\n"); grid = -1; return; }
        hipOccupancyMaxActiveBlocksPerMultiprocessor(&per_cu, (const void*)fwd_mega, 512, LDS_BYTES);
        if (per_cu < 1) { fprintf(stderr, "kernel_launch: occupancy query says %d blocks per CU\n", per_cu); per_cu = 1; }
        (void)hipGetLastError();
        grid = cus * 1;
        fprintf(stderr, "kernel_launch: grid %d (cus %d, per_cu %d), ws %zu\n", grid, cus, per_cu, ws_size);
    }
    if (grid < 0) return;
    Args a{};
    for (int i = 0; i < 26; ++i) a.in[i] = (const float*)d_in[i];
    a.out = (float*)d_out; a.ws = (unsigned char*)d_ws;
    if (hipMemsetAsync((char*)d_ws + WS_BAR, 0, XCD_BAR_WORDS * 4, stream) != hipSuccess) { fprintf(stderr, "kernel_launch: memset failed\n"); return; }
    void* args[] = {&a};
    hipError_t e = hipLaunchCooperativeKernel((const void*)fwd_mega, dim3(grid), dim3(512), args, LDS_BYTES, stream);
    if (e != hipSuccess) fprintf(stderr, "kernel_launch: cooperative launch failed: %s\n", hipGetErrorString(e));
}
```

```cpp
#include <hip/hip_runtime.h>
#include <hip/hip_cooperative_groups.h>
#include <cstdio>
#include <cstdint>
namespace cg = cooperative_groups;

#define LAS __attribute__((address_space(3)))
typedef unsigned short bf16_t;
typedef short bf16x8 __attribute__((ext_vector_type(8)));
typedef short bf16x4 __attribute__((ext_vector_type(4)));
typedef float f32x4 __attribute__((ext_vector_type(4)));
typedef float f32x2 __attribute__((ext_vector_type(2)));
typedef unsigned u32x4 __attribute__((ext_vector_type(4)));
typedef unsigned u32x2 __attribute__((ext_vector_type(2)));
typedef __bf16 nbf2 __attribute__((ext_vector_type(2)));

constexpr int D = 1024, NB = 8, T = 2048, MP = NB * T  , MS = 128, MR = MP + MS  , MALL = 16640  ;
constexpr int NCOLS = 12416, NP = 12544  ;
constexpr int O_K = 1024, O_V = 2048, O_GA = 4096, O_SH = 6144, O_GB = 9344, O_MA = 10368, O_MB = 11392;
constexpr int RH = 4, RDK = 256, RDV = 512, RCH = 128;
constexpr int WH = 16, WN = 64;
constexpr int PLE = 256;
constexpr float EPS = 1e-6f;
constexpr int REC = 12544;
constexpr int R_AT = 0, R_RT = 2048, R_BP = 4096, R_KP = 6144, R_VT = 8192, R_AAK = 10240, R_TT = 10752, R_ARB = 11264, R_ARK = 11776, R_WC = 12288;

constexpr size_t MiB = 1u << 20;
constexpr size_t WS_CTL = 0;
constexpr size_t WS_ROPE = 1 * MiB;
constexpr size_t WS_W2T = 4 * MiB, WS_A2T = WS_W2T + 131072;
constexpr size_t WS_WPLE = 5 * MiB, WS_WDB = 6 * MiB, WS_WOUT = 8 * MiB, WS_WGATE = 10 * MiB, WS_WDA = 12 * MiB, WS_WIN = 16 * MiB;
constexpr size_t WS_PB = 41 * MiB, WS_H = 50 * MiB  , WS_KT = 83 * MiB, WS_SQA = 115 * MiB, WS_BC = 117 * MiB, WS_OPSS = 119 * MiB  ;
constexpr size_t WS_OA = 122 * MiB, WS_P = 188 * MiB, WS_CH = 587 * MiB  , WS_OB = 786 * MiB  ;
constexpr size_t WS_T1 = WS_CH, WS_MG = WS_CH + 65 * MiB, WS_X1B = WS_CH + 98 * MiB, WS_GT = WS_CH + 131 * MiB, WS_X1 = WS_OB + 65 * MiB  ;
constexpr size_t WS_END = 916 * MiB;
constexpr size_t WS_BAR = 512 * 1024;
constexpr size_t WS_SQS1 = 640 * 1024, WS_SQS2 = 704 * 1024;
constexpr size_t WS_SQ1P = WS_KT, WS_SQ2P = WS_KT + 2 * MiB;

constexpr size_t OUT_Y = 0, OUT_RETP = 16908288, OUT_RWP = 21102592, OUT_SHP = 21626880, OUT_RETS = 21635072, OUT_RWS = 88743936, OUT_SHS = 97132544;

__device__ __forceinline__ unsigned pk2(float lo, float hi) { f32x2 v = {lo, hi}; nbf2 r = __builtin_convertvector(v, nbf2); return __builtin_bit_cast(unsigned, r); }
__device__ __forceinline__ unsigned short f2bf(float f) { return (unsigned short)(pk2(f, 0.f) & 0xffffu); }
__device__ __forceinline__ float bf2f(unsigned short b) { return __uint_as_float(((unsigned)b) << 16); }
__device__ __forceinline__ float bflo(unsigned w) { return __uint_as_float(w << 16); }
__device__ __forceinline__ float bfhi(unsigned w) { return __uint_as_float(w & 0xffff0000u); }
__device__ __forceinline__ float sigm(float x) { return __builtin_amdgcn_rcpf(1.f + __expf(-x)); }
__device__ __forceinline__ float wave_sum(float v) {
#pragma unroll
    for (int o = 1; o < 64; o <<= 1) v += __shfl_xor(v, o);
    return v;
}
#define MFMA32(a, b, c) __builtin_amdgcn_mfma_f32_16x16x32_bf16((a), (b), (c), 0, 0, 0)
#define LDS_WAIT() asm volatile("s_waitcnt lgkmcnt(0)" ::: "memory")

namespace pg8 {
constexpr int BM = 256, BK = 64, HALF = 128, HTB = HALF * BK * 2, STAGE_BYTES = 8 * HTB, NXCD = 8, WGM = 8;
__host__ __device__ __forceinline__ int lds_byte(int r, int c) { const int st = (r >> 4) * 2 + (c >> 5), rr = r & 15, cc = c & 31, ob = rr * 64 + cc * 2; return st * 1024 + (ob ^ (((ob >> 9) & 1) << 5)); }
__host__ __device__ __forceinline__ void stage_rc(int b, int& R, int& C) { const int st = b / 1024, sb = b % 1024, swz = sb ^ (((sb >> 9) & 1) << 5); R = (st >> 1) * 16 + swz / 64; C = (st & 1) * 32 + (swz % 64) / 2; }
__host__ __device__ __forceinline__ int perm32(int rho) { const int n = rho >> 4, i = rho & 15; return 8 * (i >> 2) + 4 * n + (i & 3); }
struct Unit { int pm, pn; };
struct Gemm { const bf16_t* A; const bf16_t* Bt; int M, N, K; };
struct StaticOrder {
    int nM, nN, nwg, G, c;
    __host__ __device__ void init(int M, int N, int G_, int c_) { nM = M / BM; nN = N / BM; nwg = nM * nN; G = G_; c = c_; }
    __host__ __device__ bool next(int i, Unit& u) const {
        const long L = (long)i * G + c; if (L >= nwg) return false;
        int wgid = (int)L; { const int q = nwg / NXCD, r = nwg % NXCD, xcd = wgid % NXCD, off = wgid / NXCD; wgid = (xcd < r ? xcd * (q + 1) : r * (q + 1) + (xcd - r) * q) + off; }
        const int nig = WGM * nN, gid = wgid / nig, fm = gid * WGM, gsz = (nM - fm) < WGM ? (nM - fm) : WGM;
        u.pm = fm + ((wgid % nig) % gsz); u.pn = (wgid % nig) / gsz; return true;
    }
};
template <class Epi>
__device__ __forceinline__ void gemm_phase(LAS unsigned char* lds, const Gemm g, const StaticOrder& S, const Epi& E) {
    int tid = threadIdx.x; asm volatile("" : "+v"(tid));
    const int wid = __builtin_amdgcn_readfirstlane(tid >> 6), lane = tid & 63, wr = wid >> 2, wc = wid & 3, fr = lane & 15, fq = lane >> 4;
    const int K = g.K, nt = K / BK;
    unsigned voffA[2], voffB[2];
#pragma unroll
    for (int i = 0; i < 2; ++i) { int R, C; stage_rc(tid * 16 + i * 8192, R, C); const int Rb = Epi::PERM ? ((R & ~31) + perm32(R & 31)) : R;
        voffA[i] = (unsigned)(R * K + C) * 2u; voffB[i] = (unsigned)(Rb * K + C) * 2u; }
    const size_t kstep = (size_t)(BK * 2);
    const size_t hstep = (size_t)HALF * K * 2;
    const size_t tstep = 2 * hstep;
    const unsigned ldsw = (unsigned)wid * 1024u;
    const int aoff = lds_byte(wr * 64 + fr, fq * 8), boff = lds_byte(wc * 32 + fr, fq * 8);
#define PG8_SA(b, h) (((b) * 2 + (h)) * HTB)
#define PG8_SB(b, h) ((4 + (b) * 2 + (h)) * HTB)
#define PG8_STAGE(bufoff, gbase, voff) do { _Pragma("unroll") for (int _i = 0; _i < 2; ++_i) \
        __builtin_amdgcn_global_load_lds((const unsigned*)((const char*)(gbase) + (voff)[_i]), (LAS unsigned*)(lds + (bufoff) + ldsw + _i * 8192), 16, 0, 0); } while (0)
#define PG8_LDA(dst, b, h) do { _Pragma("unroll") for (int m = 0; m < 4; ++m) _Pragma("unroll") for (int k = 0; k < 2; ++k) dst[m][k] = *(const LAS bf16x8*)(lds + PG8_SA(b, h) + aoff + m * 2048 + k * 1024); } while (0)
#define PG8_LDB(dst, b, h) do { _Pragma("unroll") for (int n = 0; n < 2; ++n) _Pragma("unroll") for (int k = 0; k < 2; ++k) dst[n][k] = *(const LAS bf16x8*)(lds + PG8_SB(b, h) + boff + n * 2048 + k * 1024); } while (0)
#define PG8_MMA(ai, bj, At, Bt) do { __builtin_amdgcn_s_setprio(1); _Pragma("unroll") for (int m = 0; m < 4; ++m) _Pragma("unroll") for (int n = 0; n < 2; ++n) _Pragma("unroll") for (int k = 0; k < 2; ++k) \
        acc[ai][bj][m][n] = __builtin_amdgcn_mfma_f32_16x16x32_bf16(Bt[n][k], At[m][k], acc[ai][bj][m][n], 0, 0, 0); __builtin_amdgcn_s_setprio(0); } while (0)
#define PG8_WAIT_V(n) asm volatile("s_waitcnt vmcnt(" #n ")" ::: "memory")
#define PG8_WAIT_L(n) asm volatile("s_waitcnt lgkmcnt(" #n ")" ::: "memory")
#define PG8_BAR __builtin_amdgcn_s_barrier()
#define PG8_SCHED __builtin_amdgcn_sched_barrier(0)
    Unit cur, nxt; int ui = 0;
    if (!S.next(0, cur)) return;
    f32x4 acc[2][2][4][2];
#pragma unroll
    for (int a = 0; a < 2; ++a)
#pragma unroll
        for (int b = 0; b < 2; ++b)
#pragma unroll
            for (int m = 0; m < 4; ++m)
#pragma unroll
                for (int n = 0; n < 2; ++n) acc[a][b][m][n] = (f32x4){0.f, 0.f, 0.f, 0.f};
    bf16x8 At[4][2], B0[2][2], B1[2][2];
    const char* cA = (const char*)g.A + (size_t)cur.pm * tstep; const char* cB = (const char*)g.Bt + (size_t)cur.pn * tstep;
    PG8_STAGE(PG8_SB(0, 0), cB, voffB); PG8_STAGE(PG8_SA(0, 0), cA, voffA); PG8_STAGE(PG8_SB(0, 1), cB + hstep, voffB); PG8_STAGE(PG8_SA(0, 1), cA + hstep, voffA);
    if (wr == 1) PG8_BAR;
    PG8_WAIT_V(4); PG8_BAR;
    PG8_STAGE(PG8_SB(1, 0), cB + kstep, voffB); PG8_STAGE(PG8_SA(1, 0), cA + kstep, voffA); PG8_STAGE(PG8_SB(1, 1), cB + hstep + kstep, voffB);
    PG8_WAIT_V(6); PG8_BAR;
    for (;;) {
        const bool has_next = S.next(ui + 1, nxt);
        const char* nA = has_next ? (const char*)g.A + (size_t)nxt.pm * tstep : cA; const char* nB = has_next ? (const char*)g.Bt + (size_t)nxt.pn * tstep : cB;
#pragma unroll 1
        for (int t = 0; t < nt; t += 2) {
            const bool last = (t == nt - 2);
            const char* a1 = cA + (size_t)(t + 1) * kstep;
            const char* a2 = last ? nA : cA + (size_t)(t + 2) * kstep; const char* b2 = last ? nB : cB + (size_t)(t + 2) * kstep;
            const char* a3 = a2 + kstep; const char* b3 = b2 + kstep;
            PG8_LDB(B0, 0, 0); PG8_SCHED; PG8_LDA(At, 0, 0); PG8_STAGE(PG8_SA(1, 1), a1 + hstep, voffA);
            PG8_WAIT_L(8); PG8_BAR; PG8_WAIT_L(0); PG8_MMA(0, 0, At, B0); PG8_BAR; PG8_SCHED;
            PG8_LDB(B1, 0, 1); PG8_STAGE(PG8_SB(0, 0), b2, voffB);
            PG8_BAR; PG8_WAIT_L(0); PG8_MMA(0, 1, At, B1); PG8_BAR;
            PG8_LDA(At, 0, 1); PG8_STAGE(PG8_SA(0, 0), a2, voffA);
            PG8_BAR; PG8_WAIT_L(0); PG8_MMA(1, 0, At, B0); PG8_BAR; PG8_SCHED;
            PG8_STAGE(PG8_SB(0, 1), b2 + hstep, voffB);
            PG8_WAIT_V(6); PG8_BAR; PG8_MMA(1, 1, At, B1); PG8_BAR;
            PG8_LDB(B0, 1, 0); PG8_SCHED; PG8_LDA(At, 1, 0); PG8_STAGE(PG8_SA(0, 1), a2 + hstep, voffA);
            PG8_WAIT_L(8); PG8_BAR; PG8_WAIT_L(0); PG8_MMA(0, 0, At, B0); PG8_BAR; PG8_SCHED;
            PG8_LDB(B1, 1, 1); PG8_STAGE(PG8_SB(1, 0), b3, voffB);
            PG8_BAR; PG8_WAIT_L(0); PG8_MMA(0, 1, At, B1); PG8_BAR;
            PG8_LDA(At, 1, 1); PG8_STAGE(PG8_SA(1, 0), a3, voffA);
            PG8_BAR; PG8_WAIT_L(0); PG8_MMA(1, 0, At, B0); PG8_BAR; PG8_SCHED;
            PG8_STAGE(PG8_SB(1, 1), b3 + hstep, voffB);
            PG8_WAIT_V(6); PG8_BAR; PG8_MMA(1, 1, At, B1); PG8_BAR;
        }
        E(acc, cur, wr, wc, fr, fq);
        if (!has_next) break;
#pragma unroll
        for (int a = 0; a < 2; ++a)
#pragma unroll
            for (int b = 0; b < 2; ++b)
#pragma unroll
                for (int m = 0; m < 4; ++m)
#pragma unroll
                    for (int n = 0; n < 2; ++n) acc[a][b][m][n] = (f32x4){0.f, 0.f, 0.f, 0.f};
        cur = nxt; cA = nA; cB = nB; ++ui;
    }
    PG8_WAIT_V(0);
    if (wr == 0) PG8_BAR;
    PG8_BAR;
#undef PG8_SA
#undef PG8_SB
#undef PG8_STAGE
#undef PG8_LDA
#undef PG8_LDB
#undef PG8_MMA
#undef PG8_WAIT_V
#undef PG8_WAIT_L
#undef PG8_BAR
#undef PG8_SCHED
}
}
using pg8::Unit;

struct Args {
    const float* in[26];
    float* out; unsigned char* ws;
};
#define KAS __attribute__((address_space(4)))
__device__ __forceinline__ const KAS char* kargp() { const KAS char* p = (const KAS char*)__builtin_amdgcn_kernarg_segment_ptr(); asm volatile("" : "+s"(p)); return p; }


enum { I_XP = 0, I_XS, I_SRET, I_SRW, I_SSH, I_PP, I_PS, I_NG, I_WIN, I_MU, I_W0, I_W2, I_A0, I_A2, I_KK, I_KA, I_RK, I_LNW, I_LNB, I_WDA, I_WDB, I_WOUT, I_WPLE, I_PNG, I_WPG, I_FNG };

__device__ __forceinline__ void p0_transpose_item(const float* W, int K, int N, bf16_t* WT, LAS float* scr, int item, int lane, const float* kscale) {
    const int nblk = N / 32, kb = item / nblk, nb = item % nblk, k0 = 64 * kb, n0 = 32 * nb;
#pragma unroll 8
    for (int i = 0; i < 32; ++i) { const int kk = 2 * i + (lane >> 5); float v = W[(size_t)(k0 + kk) * N + n0 + (lane & 31)]; if (kscale) v *= kscale[k0 + kk]; scr[kk * 33 + (lane & 31)] = v; }
    LDS_WAIT();
    const int c = lane & 7;
#pragma unroll
    for (int j = 0; j < 4; ++j) { const int n = (lane >> 3) + 8 * j; const LAS float* s = scr + (8 * c) * 33 + n;
        u32x4 o; o.x = pk2(s[0 * 33], s[1 * 33]); o.y = pk2(s[2 * 33], s[3 * 33]); o.z = pk2(s[4 * 33], s[5 * 33]); o.w = pk2(s[6 * 33], s[7 * 33]);
        *(u32x4*)(WT + (size_t)(n0 + n) * K + k0 + 8 * c) = o; }
    LDS_WAIT();
}

__device__ __forceinline__ void phase0(const Args& a, LAS unsigned char* lds, int gw, int NGW, int wave, int lane) {
    unsigned char* ws = a.ws;
    LAS float* scr = (LAS float*)(lds + wave * 16384);
    constexpr int I_IN = (D / 64) * (NCOLS / 32), I_DA = (2048 / 64) * (D / 32), I_SQ = (D / 64) * (D / 32), I_PL = (PLE / 64) * (D / 32), I_LR = 1 * (D / 32);
    constexpr int NITEMS = I_IN + I_DA + 3 * I_SQ + I_PL + 2 * I_LR;
    for (int it = gw; it < NITEMS; it += NGW) {
        int r = it;
        if (r < I_IN) { p0_transpose_item(a.in[I_WIN], D, NCOLS, (bf16_t*)(ws + WS_WIN), scr, r, lane, nullptr); continue; } r -= I_IN;
        if (r < I_DA) { p0_transpose_item(a.in[I_WDA], 2048, D, (bf16_t*)(ws + WS_WDA), scr, r, lane, nullptr); continue; } r -= I_DA;
        if (r < I_SQ) { p0_transpose_item(a.in[I_WDB], D, D, (bf16_t*)(ws + WS_WDB), scr, r, lane, nullptr); continue; } r -= I_SQ;
        if (r < I_SQ) { p0_transpose_item(a.in[I_WOUT], D, D, (bf16_t*)(ws + WS_WOUT), scr, r, lane, nullptr); continue; } r -= I_SQ;
        if (r < I_SQ) { p0_transpose_item(a.in[I_WPG], D, D, (bf16_t*)(ws + WS_WGATE), scr, r, lane, a.in[I_PNG]); continue; } r -= I_SQ;
        if (r < I_PL) { p0_transpose_item(a.in[I_WPLE], PLE, D, (bf16_t*)(ws + WS_WPLE), scr, r, lane, nullptr); continue; } r -= I_PL;
        if (r < I_LR) { p0_transpose_item(a.in[I_W2], 64, D, (bf16_t*)(ws + WS_W2T), scr, r, lane, nullptr); continue; } r -= I_LR;
        p0_transpose_item(a.in[I_A2], 64, D, (bf16_t*)(ws + WS_A2T), scr, r, lane, nullptr);
    }
    for (int i = gw * 64 + lane; i < 128 * D / 8; i += NGW * 64) ((u32x4*)(ws + WS_WIN + (size_t)NCOLS * D * 2))[i] = (u32x4){0u, 0u, 0u, 0u};
    bf16_t* H = (bf16_t*)(ws + WS_H);
    const float* ng = a.in[I_NG];
    for (int m = gw; m < MALL; m += NGW) {
        if (m < MR) {
            const float* xr = (m < MP) ? a.in[I_XP] + (size_t)m * D : a.in[I_XS] + (size_t)(m - MP) * D;
            f32x4 v[4]; float s = 0.f;
#pragma unroll
            for (int j = 0; j < 4; ++j) { v[j] = ((const f32x4*)xr)[lane + 64 * j]; s += (v[j].x * v[j].x + v[j].y * v[j].y) + (v[j].z * v[j].z + v[j].w * v[j].w); }
            const float rs = 1.0f / sqrtf(wave_sum(s) * (1.f / D) + EPS);
            float* so = nullptr;
            if (m < MP) { if ((m & (T - 1)) == T - 1) so = a.out + OUT_SHP + (size_t)(m >> 11) * D; } else so = a.out + OUT_SHS + (size_t)(m - MP) * D;
#pragma unroll
            for (int j = 0; j < 4; ++j) { const f32x4 gg = ((const f32x4*)ng)[lane + 64 * j]; f32x4 h = v[j] * rs * gg;
                if (so) ((f32x4*)so)[lane + 64 * j] = h;
                u32x2 o; o.x = pk2(h.x, h.y); o.y = pk2(h.z, h.w); ((u32x2*)(H + (size_t)m * D))[lane + 64 * j] = o; }
        } else {
            const float* xr = a.in[I_SSH] + (size_t)(m - MR) * D;
#pragma unroll
            for (int j = 0; j < 4; ++j) { const f32x4 h = ((const f32x4*)xr)[lane + 64 * j]; u32x2 o; o.x = pk2(h.x, h.y); o.y = pk2(h.z, h.w); ((u32x2*)(H + (size_t)m * D))[lane + 64 * j] = o; }
        }
        u32x2 o = {0u, 0u};
        if (m < MR) { const float* pr = (m < MP) ? a.in[I_PP] + (size_t)m * PLE : a.in[I_PS] + (size_t)(m - MP) * PLE; const f32x4 p = ((const f32x4*)pr)[lane]; o.x = pk2(p.x, p.y); o.y = pk2(p.z, p.w); }
        ((u32x2*)(ws + WS_PB + (size_t)m * PLE * 2))[lane] = o;
    }
    for (int i = gw * 64 + lane; i < 2049 * 128; i += NGW * 64) {
        const int pos = i >> 7, j = i & 127; const double p = (pos == 2048) ? 16384.0 : (double)pos;
        double inv = 1.0, base = 0.9305720409296989; int e = j;
        while (e) { if (e & 1) inv *= base; base *= base; e >>= 1; }
        double rev = p * inv * 0.15915494309189535; rev -= floor(rev);
        const float fr = (float)rev;
        ((f32x2*)(ws + WS_ROPE))[i] = (f32x2){__builtin_amdgcn_cosf(fr), __builtin_amdgcn_sinf(fr)};
    }
    for (int i = gw * 64 + lane; i < 65536 + 64; i += NGW * 64) ((float*)(ws + WS_CTL))[i] = 0.f;
}

struct EpiP {
    static constexpr bool PERM = true;
    bf16_t* P; bf16_t* KT; const f32x2* rope;
    __device__ __forceinline__ void operator()(const f32x4 (&acc)[2][2][4][2], const Unit& u, int wr, int wc, int fr, int fq) const {
        const int pn = u.pn, pm = u.pm;
        const int row0 = pm * 256 + wr * 64 + fr, cl0 = wc * 32 + 8 * fq;
        const bool sample = (pm == 64);
        if (pn < 8) {
            const int h = pn & 3; const bool isk = pn >= 4;
            const float l2g = __log2f(1.f - exp2f(-5.f - (float)h));
#pragma unroll
            for (int ai = 0; ai < 2; ++ai)
#pragma unroll
                for (int m = 0; m < 4; ++m) {
                    const int row = row0 + ai * 128 + m * 16;
                    int pos, ex;
                    if (sample) { pos = 2048; ex = isk ? 0 : 1; } else { pos = row & (T - 1); const int idx = pos & 127; ex = isk ? 127 - idx : idx + 1; }
                    const float sc = exp2f((float)ex * l2g) * (isk ? 0.0625f : 1.0f);
                    const f32x4* rp = (const f32x4*)(rope + pos * 128 + cl0);
                    f32x4 cs[4]; cs[0] = rp[0]; cs[1] = rp[1]; cs[2] = rp[2]; cs[3] = rp[3];
                    float y1[8], y2[8];
#pragma unroll
                    for (int n = 0; n < 2; ++n)
#pragma unroll
                        for (int e = 0; e < 4; ++e) {
                            const float c = (e & 1) ? cs[n * 2 + (e >> 1)].z : cs[n * 2 + (e >> 1)].x, s = (e & 1) ? cs[n * 2 + (e >> 1)].w : cs[n * 2 + (e >> 1)].y;
                            const float x1 = acc[ai][0][m][n][e], x2 = acc[ai][1][m][n][e];
                            y1[n * 4 + e] = (x1 * c - x2 * s) * sc; y2[n * 4 + e] = (x2 * c + x1 * s) * sc;
                        }
                    u32x4 w1, w2;
                    w1.x = pk2(y1[0], y1[1]); w1.y = pk2(y1[2], y1[3]); w1.z = pk2(y1[4], y1[5]); w1.w = pk2(y1[6], y1[7]);
                    w2.x = pk2(y2[0], y2[1]); w2.y = pk2(y2[2], y2[3]); w2.z = pk2(y2[4], y2[5]); w2.w = pk2(y2[6], y2[7]);
                    bf16_t* rowp = P + (size_t)row * NP + pn * 256 + cl0;
                    *(u32x4*)rowp = w1; *(u32x4*)(rowp + 128) = w2;
                    if (isk && !sample) {
                        bf16_t* kt = KT + ((size_t)((row >> 11) * 4 + h) * 256 + cl0) * T + pos;
#pragma unroll
                        for (int j = 0; j < 8; ++j) { kt[(size_t)j * T] = f2bf(y1[j]); kt[(size_t)(j + 128) * T] = f2bf(y2[j]); }
                    }
                }
            return;
        }
#pragma unroll
        for (int bj = 0; bj < 2; ++bj) {
            const int cb = pn * 2 + bj;
            if (cb >= 97) continue;
            const int mode = (cb < 32) ? 0 : (cb < 48) ? 1 : (cb < 73) ? 0 : (cb < 81) ? 1 : 2;
            const bool vt = (cb < 32) && !sample;
#pragma unroll
            for (int ai = 0; ai < 2; ++ai)
#pragma unroll
                for (int m = 0; m < 4; ++m) {
                    const int row = row0 + ai * 128 + m * 16;
                    float y[8];
#pragma unroll
                    for (int n = 0; n < 2; ++n)
#pragma unroll
                        for (int e = 0; e < 4; ++e) { float x = acc[ai][bj][m][n][e]; if (mode == 1) x = x * sigm(x); else if (mode == 2) x = sigm(x); y[n * 4 + e] = x; }
                    if (vt) {
                        const int hd = cb * 128 + cl0 - O_V;
                        bf16_t* vp = P + ((size_t)(row >> 11) * T + hd) * NP + O_V + (row & (T - 1));
#pragma unroll
                        for (int j = 0; j < 8; ++j) vp[(size_t)j * NP] = f2bf(y[j]);
                    } else {
                        u32x4 w; w.x = pk2(y[0], y[1]); w.y = pk2(y[2], y[3]); w.z = pk2(y[4], y[5]); w.w = pk2(y[6], y[7]);
                        *(u32x4*)(P + (size_t)row * NP + cb * 128 + cl0) = w;
                    }
                }
        }
    }
};

__device__ __forceinline__ float lerp_bf(const bf16_t* cur, const bf16_t* prv, float mu) { const float c = bf2f(*cur); const float p = prv ? bf2f(*prv) : 0.f; return c + (p - c) * mu; }

__device__ __forceinline__ void rw_prep_item(const Args& a, LAS unsigned char* wl  , int tt, int h, int lane) {
    unsigned char* ws = a.ws;
    const bf16_t* P = (const bf16_t*)(ws + WS_P);
    const int l15 = lane & 15, quad = lane >> 4;
    const bool sample = tt >= 1024;
    const int row_base = sample ? MP + (tt - 1024) * 16 : tt * 16;
    const float* mu = a.in[I_MU];
    bf16x8 Aw[2], Aa[2];
    {
        const int m = row_base + l15;
        const bf16_t* cur = P + (size_t)m * NP + O_SH;
        const bf16_t* prv = sample ? P + (size_t)(m + MS) * NP + O_SH : ((m & (T - 1)) ? cur - NP : nullptr);
#pragma unroll
        for (int which = 0; which < 2; ++which)
#pragma unroll
            for (int ks = 0; ks < 2; ++ks) {
                const int col = 3072 + which * 64 + ks * 32 + quad * 8;
                const u32x4 cw = *(const u32x4*)(cur + col); u32x4 pw = {0u, 0u, 0u, 0u}; if (prv) pw = *(const u32x4*)(prv + col);
                const f32x4 m0 = *(const f32x4*)(mu + col), m1 = *(const f32x4*)(mu + col + 4);
                float z[8];
                const unsigned cws[4] = {cw.x, cw.y, cw.z, cw.w}, pws[4] = {pw.x, pw.y, pw.z, pw.w};
#pragma unroll
                for (int j = 0; j < 4; ++j) {
                    const float c0 = bflo(cws[j]), c1 = bfhi(cws[j]), p0 = bflo(pws[j]), p1 = bfhi(pws[j]);
                    const float mm0 = (j < 2) ? m0[2 * j] : m1[2 * j - 4], mm1 = (j < 2) ? m0[2 * j + 1] : m1[2 * j - 3];
                    z[2 * j] = c0 + (p0 - c0) * mm0; z[2 * j + 1] = c1 + (p1 - c1) * mm1;
                }
                if (which == 0) {
#pragma unroll
                    for (int j = 0; j < 8; ++j) z[j] = 1.f - 2.f / (__expf(2.f * z[j]) + 1.f);
                }
                u32x4 o; o.x = pk2(z[0], z[1]); o.y = pk2(z[2], z[3]); o.z = pk2(z[4], z[5]); o.w = pk2(z[6], z[7]);
                if (which == 0) Aw[ks] = __builtin_bit_cast(bf16x8, o); else Aa[ks] = __builtin_bit_cast(bf16x8, o);
            }
    }
    const bf16_t* W2T = (const bf16_t*)(ws + WS_W2T); const bf16_t* A2T = (const bf16_t*)(ws + WS_A2T);
    unsigned char* rec = ws + WS_CH + ((size_t)((tt >> 7) * 16 + h) * 128 + (tt & 127)) * REC;
    LAS bf16_t* LA = (LAS bf16_t*)wl;
    LAS bf16_t* LR = LA + 16 * 72;
    LAS bf16_t* LB = LR + 16 * 72;
    LAS bf16_t* LK = LB + 16 * 72;
    LAS float* LN = (LAS float*)(wl + 9216);
    float tA[4][4], tBi[4][4], tBp[4][4];
    float ssq[4] = {0.f, 0.f, 0.f, 0.f}, bon[4] = {0.f, 0.f, 0.f, 0.f};
#pragma unroll
    for (int nt = 0; nt < 4; ++nt) {
        const int ch = h * 64 + nt * 16 + l15, cc = nt * 16 + l15;
        f32x4 cw = {0.f, 0.f, 0.f, 0.f}, ca = {0.f, 0.f, 0.f, 0.f};
#pragma unroll
        for (int ks = 0; ks < 2; ++ks) {
            const bf16x8 bw = *(const bf16x8*)(W2T + (size_t)ch * 64 + ks * 32 + quad * 8), ba = *(const bf16x8*)(A2T + (size_t)ch * 64 + ks * 32 + quad * 8);
            cw = MFMA32(Aw[ks], bw, cw); ca = MFMA32(Aa[ks], ba, ca);
        }
        const float w0 = a.in[I_W0][ch], a0 = a.in[I_A0][ch], k_k = a.in[I_KK][ch], k_a = a.in[I_KA][ch], r_k = a.in[I_RK][ch];
        const float mur = mu[ch], muk = mu[1024 + ch], muv = mu[2048 + ch];
        float lw[4], rr[4], kq[4], vv[4], aa4[4], kr4[4];
#pragma unroll
        for (int r = 0; r < 4; ++r) {
            const int m = row_base + quad * 4 + r;
            const bf16_t* cur = P + (size_t)m * NP + O_SH + ch;
            const bf16_t* prv = sample ? P + (size_t)(m + MS) * NP + O_SH + ch : ((m & (T - 1)) ? cur - NP : nullptr);
            const float r_ = lerp_bf(cur, prv, mur), k_ = lerp_bf(cur + 1024, prv ? prv + 1024 : nullptr, muk), v_ = lerp_bf(cur + 2048, prv ? prv + 2048 : nullptr, muv);
            lw[r] = -0.6065306597126334f * sigm(w0 + cw[r]);
            const float aa = sigm(a0 + ca[r]); aa4[r] = aa;
            const float kr = k_ * k_k; kr4[r] = kr; ssq[r] += kr * kr;
            const float kpp = k_ * (1.f + (aa - 1.f) * k_a); kq[r] = kpp;
            rr[r] = r_; vv[r] = v_; bon[r] += r_ * kpp * r_k;
        }
        if (sample) {
#pragma unroll
            for (int r = 0; r < 4; ++r) {
                const int i = (tt - 1024) * 16 + quad * 4 + r;
                float* o = (float*)(ws + WS_OPSS) + ((size_t)(i * 16 + h) * 6) * 64 + cc;
                o[0] = rr[r]; o[64] = __expf(lw[r]); o[128] = kq[r]; o[320] = vv[r];
                tA[nt][r] = kr4[r]; tBi[nt][r] = aa4[r] * kr4[r]; tBp[nt][r] = 0.f;
            }
        } else {
            float c[4]; c[0] = lw[0]; c[1] = c[0] + lw[1]; c[2] = c[1] + lw[2]; c[3] = c[2] + lw[3];
            const float tot = c[3];
            const float s1 = __shfl(tot, (lane - 16) & 63), s2 = __shfl(tot, (lane - 32) & 63), s3 = __shfl(tot, (lane - 48) & 63);
            const float off = (quad >= 1 ? s1 : 0.f) + (quad >= 2 ? s2 : 0.f) + (quad >= 3 ? s3 : 0.f);
            const float total = __shfl(c[3] + off, 48 + l15);
            float kqp[4];
#pragma unroll
            for (int r = 0; r < 4; ++r) {
                const float cum = c[r] + off, cumx = cum - lw[r];
                const float ea = __expf(cumx), er = __expf(cum), ei = __expf(-cum), ep = __expf(total - cum);
                const int tk = quad * 4 + r;
                LR[tk * 72 + cc] = f2bf(rr[r] * er); LK[tk * 72 + cc] = f2bf(kq[r] * ei);
                kqp[r] = kq[r] * ep;
                tA[nt][r] = kr4[r] * ea; tBi[nt][r] = aa4[r] * kr4[r] * ei; tBp[nt][r] = aa4[r] * kr4[r] * ep;
            }
            *(u32x2*)(rec + R_KP + cc * 32 + quad * 8) = (u32x2){pk2(kqp[0], kqp[1]), pk2(kqp[2], kqp[3])};
            *(u32x2*)(rec + R_VT + cc * 32 + quad * 8) = (u32x2){pk2(vv[0], vv[1]), pk2(vv[2], vv[3])};
            if (quad == 0) *(float*)(rec + R_WC + cc * 4) = __expf(total);
        }
        asm volatile("" ::: "memory");
    }
    float inv[4];
#pragma unroll
    for (int r = 0; r < 4; ++r) {
        float s = ssq[r], b = bon[r];
#pragma unroll
        for (int o = 1; o < 16; o <<= 1) { s += __shfl_xor(s, o); b += __shfl_xor(b, o); }
        inv[r] = 1.f / fmaxf(sqrtf(s), 1e-12f);
        if (l15 == 0) ((float*)(ws + WS_BC))[(size_t)(row_base + quad * 4 + r) * 16 + h] = b;
    }
    if (sample) {
#pragma unroll
        for (int nt = 0; nt < 4; ++nt)
#pragma unroll
            for (int r = 0; r < 4; ++r) {
                const int i = (tt - 1024) * 16 + quad * 4 + r;
                float* o = (float*)(ws + WS_OPSS) + ((size_t)(i * 16 + h) * 6) * 64 + nt * 16 + l15;
                o[192] = tA[nt][r] * inv[r]; o[256] = tBi[nt][r] * inv[r];
            }
        return;
    }
#pragma unroll
    for (int nt = 0; nt < 4; ++nt) {
        const int cc = nt * 16 + l15;
        float bp[4];
#pragma unroll
        for (int r = 0; r < 4; ++r) { const int tk = quad * 4 + r;
            LA[tk * 72 + cc] = f2bf(-tA[nt][r] * inv[r]); LB[tk * 72 + cc] = f2bf(tBi[nt][r] * inv[r]); bp[r] = tBp[nt][r] * inv[r]; }
        *(u32x2*)(rec + R_BP + cc * 32 + quad * 8) = (u32x2){pk2(bp[0], bp[1]), pk2(bp[2], bp[3])};
    }
    LDS_WAIT();
#pragma unroll
    for (int i = 0; i < 2; ++i) { const int idx = lane + 64 * i, rr = idx >> 3, c8 = (idx & 7) * 8;
        *(u32x4*)(rec + R_AT + rr * 128 + c8 * 2) = *(const LAS u32x4*)(LA + rr * 72 + c8);
        *(u32x4*)(rec + R_RT + rr * 128 + c8 * 2) = *(const LAS u32x4*)(LR + rr * 72 + c8); }
    f32x4 nab = {0.f, 0.f, 0.f, 0.f}, nak = nab, nrb = nab, nrk = nab;
#pragma unroll
    for (int ks = 0; ks < 2; ++ks) {
        const bf16x8 fa = *(const LAS bf16x8*)(LA + l15 * 72 + ks * 32 + quad * 8), fr_ = *(const LAS bf16x8*)(LR + l15 * 72 + ks * 32 + quad * 8);
        const bf16x8 fb = *(const LAS bf16x8*)(LB + l15 * 72 + ks * 32 + quad * 8), fk = *(const LAS bf16x8*)(LK + l15 * 72 + ks * 32 + quad * 8);
        nab = MFMA32(fa, fb, nab); nak = MFMA32(fa, fk, nak); nrb = MFMA32(fr_, fb, nrb); nrk = MFMA32(fr_, fk, nrk);
    }
#pragma unroll
    for (int r = 0; r < 4; ++r) {
        const int t = quad * 4 + r, j = l15;
        const float vab = (j < t) ? nab[r] : 0.f, vak = (j < t) ? nak[r] : 0.f, vrb = (j <= t) ? nrb[r] : 0.f, vrk = (j <= t) ? nrk[r] : 0.f;
        LN[t * 16 + j] = vab;
        *(bf16_t*)(rec + R_AAK + (t * 16 + j) * 2) = f2bf(vak);
        *(bf16_t*)(rec + R_ARB + (t * 16 + j) * 2) = f2bf(vrb);
        *(bf16_t*)(rec + R_ARK + (t * 16 + j) * 2) = f2bf(vrk);
    }
    LDS_WAIT();
    if (lane < 16) {
        float tc[16];
#pragma unroll
        for (int t = 0; t < 16; ++t) {
            float s = (t == lane) ? 1.f : 0.f;
#pragma unroll
            for (int j = 0; j < t; ++j) s += LN[t * 16 + j] * tc[j];
            tc[t] = s;
            *(bf16_t*)(rec + R_TT + (t * 16 + lane) * 2) = f2bf(s);
        }
    }
    LDS_WAIT();
}

__device__ __forceinline__ bf16x8 k16(u32x2 v) { const u32x4 w = {v.x, v.y, 0u, 0u}; return __builtin_bit_cast(bf16x8, w); }
#define SCAN_DECL(F) bf16x8 F##_at0, F##_at1, F##_rt0, F##_rt1; u32x2 F##_aak, F##_tt, F##_arb, F##_ark, F##_vt, F##_bp0, F##_bp1, F##_bp2, F##_bp3, F##_kp0, F##_kp1, F##_kp2, F##_kp3; float F##_wc0, F##_wc1, F##_wc2, F##_wc3
#define SCAN_LOAD(F, REC_) do { const unsigned char* rec_ = (REC_); \
    F##_at0 = *(const bf16x8*)(rec_ + R_AT + o_nat); F##_at1 = *(const bf16x8*)(rec_ + R_AT + o_nat + 64); \
    F##_rt0 = *(const bf16x8*)(rec_ + R_RT + o_nat); F##_rt1 = *(const bf16x8*)(rec_ + R_RT + o_nat + 64); \
    F##_aak = *(const u32x2*)(rec_ + R_AAK + o_sm); F##_tt = *(const u32x2*)(rec_ + R_TT + o_sm); F##_arb = *(const u32x2*)(rec_ + R_ARB + o_sm); F##_ark = *(const u32x2*)(rec_ + R_ARK + o_sm); \
    F##_vt = *(const u32x2*)(rec_ + R_VT + vt * 512 + o_sm); \
    F##_bp0 = *(const u32x2*)(rec_ + R_BP + o_sm); F##_bp1 = *(const u32x2*)(rec_ + R_BP + 512 + o_sm); F##_bp2 = *(const u32x2*)(rec_ + R_BP + 1024 + o_sm); F##_bp3 = *(const u32x2*)(rec_ + R_BP + 1536 + o_sm); \
    F##_kp0 = *(const u32x2*)(rec_ + R_KP + o_sm); F##_kp1 = *(const u32x2*)(rec_ + R_KP + 512 + o_sm); F##_kp2 = *(const u32x2*)(rec_ + R_KP + 1024 + o_sm); F##_kp3 = *(const u32x2*)(rec_ + R_KP + 1536 + o_sm); \
    F##_wc0 = *(const float*)(rec_ + R_WC + l15 * 4); F##_wc1 = *(const float*)(rec_ + R_WC + 64 + l15 * 4); F##_wc2 = *(const float*)(rec_ + R_WC + 128 + l15 * 4); F##_wc3 = *(const float*)(rec_ + R_WC + 192 + l15 * 4); } while (0)
#define SCAN_UPD(NT, BP, KP, WC) do { f32x4 sn = S##NT * (WC); sn = MFMA32(ua, k16(BP), sn); sn = MFMA32(vtf, k16(KP), sn); S##NT = sn; \
    _Pragma("unroll") for (int r = 0; r < 4; ++r) Sb[(quad * 4 + r) * 72 + NT * 16 + l15] = f2bf(sn[r]); } while (0)
#define SCAN_STEP(F, N, CH) do { const int ch_ = (CH); \
    SCAN_LOAD(N, rec0 + (size_t)(ch_ < 126 ? ch_ + 2 : 127) * REC); \
    const bf16x8 sa0 = *(const LAS bf16x8*)(Sb + l15 * 72 + quad * 8), sa1 = *(const LAS bf16x8*)(Sb + l15 * 72 + 32 + quad * 8); \
    const bf16x8 vtf = k16(F##_vt); const f32x4 z = {0.f, 0.f, 0.f, 0.f}; \
    f32x4 Y = MFMA32(sa0, F##_at0, z); Y = MFMA32(sa1, F##_at1, Y); Y = MFMA32(vtf, k16(F##_aak), Y); \
    _Pragma("unroll") for (int r = 0; r < 4; ++r) Yb[(quad * 4 + r) * 16 + l15] = f2bf(Y[r]); \
    LDS_WAIT(); \
    const bf16x8 ya = k16(*(const LAS u32x2*)(Yb + l15 * 16 + quad * 4)); \
    f32x4 U = MFMA32(ya, k16(F##_tt), z); \
    _Pragma("unroll") for (int r = 0; r < 4; ++r) Ub[(quad * 4 + r) * 16 + l15] = f2bf(U[r]); \
    LDS_WAIT(); \
    const bf16x8 ua = k16(*(const LAS u32x2*)(Ub + l15 * 16 + quad * 4)); \
    f32x4 O = MFMA32(sa0, F##_rt0, z); O = MFMA32(sa1, F##_rt1, O); O = MFMA32(ua, k16(F##_arb), O); O = MFMA32(vtf, k16(F##_ark), O); \
    *(u32x2*)(ob + (size_t)(ch_ * 16 + l15) * D) = (u32x2){pk2(O[0], O[1]), pk2(O[2], O[3])}; \
    SCAN_UPD(0, F##_bp0, F##_kp0, F##_wc0); SCAN_UPD(1, F##_bp1, F##_kp1, F##_wc1); SCAN_UPD(2, F##_bp2, F##_kp2, F##_wc2); SCAN_UPD(3, F##_bp3, F##_kp3, F##_wc3); \
    LDS_WAIT(); __builtin_amdgcn_sched_barrier(0); } while (0)
__device__ __forceinline__ void rw_scan_task(const Args& a, LAS unsigned char* wl  , int b, int h, int vt, int lane) {
    unsigned char* ws = a.ws;
    const int l15 = lane & 15, quad = lane >> 4;
    LAS bf16_t* Sb = (LAS bf16_t*)wl;
    LAS bf16_t* Yb = (LAS bf16_t*)(wl + 2304);
    LAS bf16_t* Ub = (LAS bf16_t*)(wl + 2304 + 512);
    const int o_nat = l15 * 128 + quad * 16, o_sm = l15 * 32 + quad * 8;
    const unsigned char* rec0 = ws + WS_CH + (size_t)((b * 16 + h) * 128) * REC;
    bf16_t* ob = (bf16_t*)(ws + WS_OB) + (size_t)(b * T) * D + h * 64 + vt * 16 + quad * 4;
    f32x4 S0 = {0.f, 0.f, 0.f, 0.f}, S1 = S0, S2 = S0, S3 = S0;
#pragma unroll
    for (int nt = 0; nt < 4; ++nt)
#pragma unroll
        for (int r = 0; r < 4; ++r) Sb[(quad * 4 + r) * 72 + nt * 16 + l15] = 0;
    LDS_WAIT();
    SCAN_DECL(f0); SCAN_DECL(f1); SCAN_DECL(f2);
    SCAN_LOAD(f0, rec0); SCAN_LOAD(f1, rec0 + REC);
    for (int ch = 0; ch < 126; ch += 3) { SCAN_STEP(f0, f2, ch); SCAN_STEP(f1, f0, ch + 1); SCAN_STEP(f2, f1, ch + 2); }
    SCAN_STEP(f0, f2, 126); SCAN_STEP(f1, f0, 127);
    float* so = a.out + OUT_RWP + (size_t)((b * 16 + h) * 64 + vt * 16) * 64;
#pragma unroll
    for (int r = 0; r < 4; ++r) { so[(quad * 4 + r) * 64 + l15] = S0[r]; so[(quad * 4 + r) * 64 + 16 + l15] = S1[r]; so[(quad * 4 + r) * 64 + 32 + l15] = S2[r]; so[(quad * 4 + r) * 64 + 48 + l15] = S3[r]; }
}

__device__ __forceinline__ void rw_sample_wave(const Args& a, int i, int h, int lane) {
    unsigned char* ws = a.ws;
    const float* s0 = a.in[I_SRW] + ((size_t)(i * 16 + h) * 64 + lane) * 64;
    const float* op = (const float*)(ws + WS_OPSS) + (size_t)(i * 16 + h) * 6 * 64;
    float s[64];
#pragma unroll
    for (int j = 0; j < 16; ++j) { const f32x4 t = ((const f32x4*)s0)[j]; s[4 * j] = t.x; s[4 * j + 1] = t.y; s[4 * j + 2] = t.z; s[4 * j + 3] = t.w; }
    const float r_l = op[lane], w_l = op[64 + lane], k_l = op[128 + lane], kk_l = op[192 + lane], b_l = op[256 + lane], v = op[320 + lane];
#define RL(x, j) __builtin_bit_cast(float, __builtin_amdgcn_readlane(__builtin_bit_cast(int, (x)), (j)))
    float sk = 0.f;
#pragma unroll
    for (int j = 0; j < 64; ++j) sk += s[j] * RL(kk_l, j);
    float o = 0.f;
#pragma unroll
    for (int j = 0; j < 64; ++j) { s[j] = s[j] * RL(w_l, j) - sk * RL(b_l, j) + v * RL(k_l, j); o += s[j] * RL(r_l, j); }
#undef RL
    float* so = a.out + OUT_RWS + ((size_t)(i * 16 + h) * 64 + lane) * 64;
#pragma unroll
    for (int j = 0; j < 16; ++j) ((f32x4*)so)[j] = (f32x4){s[4 * j], s[4 * j + 1], s[4 * j + 2], s[4 * j + 3]};
    ((bf16_t*)(ws + WS_OB))[(size_t)(MP + i) * D + h * 64 + lane] = f2bf(o);
}

constexpr int KN_LD = 264, VS_LD = 136, SS_LD = 264;
constexpr int L_KN = 0, L_VS = 128 * KN_LD * 2  , L_SS = L_VS + 64 * VS_LD * 2  , L_RET_END = L_SS + 64 * SS_LD * 2  ;
__device__ __forceinline__ void ret_unit(const Args& a, LAS unsigned char* lds, int unit, int tid) {
    unsigned char* ws = a.ws;
    const bf16_t* P = (const bf16_t*)(ws + WS_P);
    const int dvs = unit & 7, h = (unit >> 3) & 3, b = unit >> 5;
    const int wave = tid >> 6, lane = tid & 63, l15 = lane & 15, quad = lane >> 4;
    LAS bf16_t* KN = (LAS bf16_t*)(lds + L_KN); LAS bf16_t* VS = (LAS bf16_t*)(lds + L_VS); LAS bf16_t* SS = (LAS bf16_t*)(lds + L_SS);
    const float g = 1.f - exp2f(-5.f - (float)h), l2g = __log2f(g);
    const float gC = exp2f(128.f * l2g), ginvC = exp2f(-128.f * l2g);
    const bf16_t* KT = (const bf16_t*)(ws + WS_KT) + (size_t)(b * 4 + h) * 256 * T;
    f32x4 sacc[2][4];
#pragma unroll
    for (int n = 0; n < 2; ++n)
#pragma unroll
        for (int d = 0; d < 4; ++d) sacc[n][d] = (f32x4){0.f, 0.f, 0.f, 0.f};
    for (int i = tid; i < 64 * SS_LD / 2; i += 512) ((LAS unsigned*)SS)[i] = 0u;
    const int it = wave;
    u32x4 stk[8], stv[2];
#define RET_ISSUE(CC) do { const int tok0_ = b * T + (CC) * 128; \
        _Pragma("unroll") for (int i = 0; i < 8; ++i) { const int idx = tid + 512 * i, r = idx >> 5, c8 = (idx & 31) * 8; stk[i] = *(const u32x4*)(P + (size_t)(tok0_ + r) * NP + O_K + h * 256 + c8); } \
        _Pragma("unroll") for (int i = 0; i < 2; ++i) { const int idx = tid + 512 * i, r = idx >> 4, c8 = (idx & 15) * 8; stv[i] = *(const u32x4*)(P + (size_t)(b * T + h * 512 + dvs * 64 + r) * NP + O_V + (CC) * 128 + c8); } } while (0)
    RET_ISSUE(0);
    for (int c = 0; c < 16; ++c) {
        const int tok0 = b * T + c * 128;
        bf16x8 qf[8];
#pragma unroll
        for (int ks = 0; ks < 8; ++ks) qf[ks] = *(const bf16x8*)(P + (size_t)(tok0 + it * 16 + l15) * NP + h * 256 + ks * 32 + quad * 8);
#pragma unroll
        for (int i = 0; i < 8; ++i) { const int idx = tid + 512 * i, r = idx >> 5, c8 = (idx & 31) * 8; *(LAS u32x4*)(KN + r * KN_LD + c8) = stk[i]; }
#pragma unroll
        for (int i = 0; i < 2; ++i) { const int idx = tid + 512 * i, r = idx >> 4, c8 = (idx & 15) * 8; *(LAS u32x4*)(VS + r * VS_LD + c8) = stv[i]; }
        __syncthreads();
        bf16x8 ktf[2][4];
#pragma unroll
        for (int n = 0; n < 2; ++n)
#pragma unroll
            for (int ks = 0; ks < 4; ++ks) ktf[n][ks] = *(const bf16x8*)(KT + (size_t)((2 * wave + n) * 16 + l15) * T + c * 128 + ks * 32 + quad * 8);
        if (c < 15) RET_ISSUE(c + 1);
        f32x4 oacc[4];
#pragma unroll
        for (int d = 0; d < 4; ++d) oacc[d] = (f32x4){0.f, 0.f, 0.f, 0.f};
#pragma unroll
        for (int ks = 0; ks < 8; ++ks)
#pragma unroll
            for (int d = 0; d < 4; ++d) { const bf16x8 sb = *(const LAS bf16x8*)(SS + (d * 16 + l15) * SS_LD + ks * 32 + quad * 8); oacc[d] = MFMA32(qf[ks], sb, oacc[d]); }
#pragma unroll
        for (int p = 0; p < 4; ++p) {
            if (2 * p <= it) {
                f32x4 s0 = {0.f, 0.f, 0.f, 0.f}, s1 = {0.f, 0.f, 0.f, 0.f};
#pragma unroll
                for (int ks = 0; ks < 8; ++ks) { const bf16x8 ka = *(const LAS bf16x8*)(KN + ((2 * p) * 16 + l15) * KN_LD + ks * 32 + quad * 8); s0 = MFMA32(ka, qf[ks], s0); }
                if (2 * p + 1 <= it) {
#pragma unroll
                    for (int ks = 0; ks < 8; ++ks) { const bf16x8 ka = *(const LAS bf16x8*)(KN + ((2 * p + 1) * 16 + l15) * KN_LD + ks * 32 + quad * 8); s1 = MFMA32(ka, qf[ks], s1); }
                }
#pragma unroll
                for (int r = 0; r < 4; ++r) {
                    const int jl = quad * 4 + r;
                    s0[r] = (2 * p == it && jl > l15) ? 0.f : s0[r] * ginvC;
                    s1[r] = (2 * p + 1 > it || (2 * p + 1 == it && jl > l15)) ? 0.f : s1[r] * ginvC;
                }
                u32x4 aw; aw.x = pk2(s0[0], s0[1]); aw.y = pk2(s0[2], s0[3]); aw.z = pk2(s1[0], s1[1]); aw.w = pk2(s1[2], s1[3]);
                const bf16x8 af = __builtin_bit_cast(bf16x8, aw);
#pragma unroll
                for (int d = 0; d < 4; ++d) {
                    const LAS bf16_t* vr = VS + (d * 16 + l15) * VS_LD + 32 * p + quad * 4;
                    const u32x2 lo = *(const LAS u32x2*)vr, hi = *(const LAS u32x2*)(vr + 16);
                    const u32x4 bw = {lo.x, lo.y, hi.x, hi.y};
                    oacc[d] = MFMA32(af, __builtin_bit_cast(bf16x8, bw), oacc[d]);
                }
            }
        }
        {
            bf16_t* OA = (bf16_t*)(ws + WS_OA); float* SQA = (float*)(ws + WS_SQA);
#pragma unroll
            for (int r = 0; r < 4; ++r) {
                const int tok = tok0 + it * 16 + quad * 4 + r;
                float ss = 0.f;
#pragma unroll
                for (int d = 0; d < 4; ++d) { const float v = oacc[d][r]; ss += v * v; OA[(size_t)tok * 2048 + h * 512 + dvs * 64 + d * 16 + l15] = f2bf(v); }
#pragma unroll
                for (int o = 1; o < 16; o <<= 1) ss += __shfl_xor(ss, o);
                if (l15 == 0) SQA[(size_t)tok * 32 + h * 8 + dvs] = ss;
            }
        }
        __syncthreads();
#pragma unroll
        for (int n = 0; n < 2; ++n)
#pragma unroll
            for (int d = 0; d < 4; ++d) {
                f32x4 s = sacc[n][d] * gC;
#pragma unroll
                for (int ks = 0; ks < 4; ++ks) { const bf16x8 va = *(const LAS bf16x8*)(VS + (d * 16 + l15) * VS_LD + ks * 32 + quad * 8); s = MFMA32(va, ktf[n][ks], s); }
                sacc[n][d] = s;
#pragma unroll
                for (int r = 0; r < 4; ++r) SS[(d * 16 + quad * 4 + r) * SS_LD + (2 * wave + n) * 16 + l15] = f2bf(s[r]);
            }
        __syncthreads();
    }
    float* so = a.out + OUT_RETP + (size_t)(b * 4 + h) * 256 * 512;
#pragma unroll
    for (int n = 0; n < 2; ++n)
#pragma unroll
        for (int d = 0; d < 4; ++d) *(f32x4*)(so + (size_t)((2 * wave + n) * 16 + l15) * 512 + dvs * 64 + d * 16 + quad * 4) = sacc[n][d];
}
#undef RET_ISSUE

__device__ __forceinline__ void ret_sample_unit(const Args& a, LAS unsigned char* lds, int i, int h, int tid) {
    unsigned char* ws = a.ws;
    const bf16_t* Prow = (const bf16_t*)(ws + WS_P) + (size_t)(MP + i) * NP;
    LAS float* Q = (LAS float*)lds; LAS float* Kh = Q + 256; LAS float* RED = Kh + 256; LAS float* OS = RED + 16;
    const float g = 1.f - exp2f(-5.f - (float)h);
    const int lane = tid & 63, wave = tid >> 6;
    float qk = 0.f;
    if (tid < 256) { const float q = bf2f(Prow[h * 256 + tid]), k = bf2f(Prow[O_K + h * 256 + tid]); Q[tid] = q; Kh[tid] = k; qk = q * k; }
    qk = wave_sum(qk);
    if (lane == 0) RED[wave] = qk;
    __syncthreads();
    const float qkv = (RED[0] + RED[1] + RED[2] + RED[3]) / g;
    const int dkg = tid >> 7, dv4 = 4 * (tid & 127);
    const u32x2 vw = *(const u32x2*)(Prow + O_V + h * 512 + dv4);
    const f32x4 v = {bflo(vw.x), bfhi(vw.x), bflo(vw.y), bfhi(vw.y)};
    const float* s0 = a.in[I_SRET] + (size_t)(i * 4 + h) * 256 * 512 + dv4;
    float* s1 = a.out + OUT_RETS + (size_t)(i * 4 + h) * 256 * 512 + dv4;
    f32x4 o = {0.f, 0.f, 0.f, 0.f};
#pragma unroll 8
    for (int j = 0; j < 64; ++j) {
        const int dk = dkg * 64 + j;
        const f32x4 s = __builtin_nontemporal_load((const f32x4*)(s0 + (size_t)dk * 512));
        o += s * Q[dk];
        __builtin_nontemporal_store(s * g + v * Kh[dk], (f32x4*)(s1 + (size_t)dk * 512));
    }
    *(LAS f32x4*)(OS + dkg * 512 + dv4) = o;
    __syncthreads();
    float y[4] = {0.f, 0.f, 0.f, 0.f}; float ss = 0.f;
    if (tid < 128) {
        const f32x4 t = *(LAS f32x4*)(OS + dv4) + *(LAS f32x4*)(OS + 512 + dv4) + *(LAS f32x4*)(OS + 1024 + dv4) + *(LAS f32x4*)(OS + 1536 + dv4) + v * qkv;
        y[0] = t.x; y[1] = t.y; y[2] = t.z; y[3] = t.w; ss = t.x * t.x + t.y * t.y + t.z * t.z + t.w * t.w;
    }
    ss = wave_sum(ss);
    if (lane == 0) RED[8 + wave] = ss;
    __syncthreads();
    if (tid < 128) {
        const float rs = 1.0f / sqrtf((RED[8] + RED[9]) * (1.f / 512.f) + EPS);
        const u32x2 gw = *(const u32x2*)(Prow + O_GA + h * 512 + dv4);
        u32x2 ow; ow.x = pk2(y[0] * rs * bflo(gw.x), y[1] * rs * bfhi(gw.x)); ow.y = pk2(y[2] * rs * bflo(gw.y), y[3] * rs * bfhi(gw.y));
        *(u32x2*)((bf16_t*)(ws + WS_OA) + (size_t)(MP + i) * 2048 + h * 512 + dv4) = ow;
    }
    __syncthreads();
}

__device__ __forceinline__ void ret_sample_wave(const Args& a, int i, int h, int lane) {
    unsigned char* ws = a.ws;
    const bf16_t* Prow = (const bf16_t*)(ws + WS_P) + (size_t)(MP + i) * NP;
    const float g = 1.f - exp2f(-5.f - (float)h);
    float q[4], k[4]; float qk = 0.f;
#pragma unroll
    for (int j = 0; j < 4; ++j) { q[j] = bf2f(Prow[h * 256 + 64 * j + lane]); k[j] = bf2f(Prow[O_K + h * 256 + 64 * j + lane]); qk += q[j] * k[j]; }
    const float qkv = wave_sum(qk) / g;
    f32x4 v[2];
#pragma unroll
    for (int e = 0; e < 2; ++e) { const u32x2 vw = *(const u32x2*)(Prow + O_V + h * 512 + e * 256 + lane * 4); v[e] = (f32x4){bflo(vw.x), bfhi(vw.x), bflo(vw.y), bfhi(vw.y)}; }
    const float* s0 = a.in[I_SRET] + (size_t)(i * 4 + h) * 256 * 512 + lane * 4;
    float* s1 = a.out + OUT_RETS + (size_t)(i * 4 + h) * 256 * 512 + lane * 4;
    f32x4 o[2] = {{0.f, 0.f, 0.f, 0.f}, {0.f, 0.f, 0.f, 0.f}};
#pragma unroll
    for (int j = 0; j < 4; ++j) {
        for (int d0 = 0; d0 < 64; d0 += 16) {
            f32x4 sv[16][2];
#pragma unroll
            for (int d = 0; d < 16; ++d)
#pragma unroll
                for (int e = 0; e < 2; ++e) sv[d][e] = __builtin_nontemporal_load((const f32x4*)(s0 + (size_t)(64 * j + d0 + d) * 512 + e * 256));
#pragma unroll
            for (int d = 0; d < 16; ++d) {
                const float qd = __builtin_bit_cast(float, __builtin_amdgcn_readlane(__builtin_bit_cast(int, q[j]), d0 + d));
                const float kd = __builtin_bit_cast(float, __builtin_amdgcn_readlane(__builtin_bit_cast(int, k[j]), d0 + d));
#pragma unroll
                for (int e = 0; e < 2; ++e) { o[e] += sv[d][e] * qd; __builtin_nontemporal_store(sv[d][e] * g + v[e] * kd, (f32x4*)(s1 + (size_t)(64 * j + d0 + d) * 512 + e * 256)); }
            }
        }
    }
    float ss = 0.f;
#pragma unroll
    for (int e = 0; e < 2; ++e) { o[e] += v[e] * qkv; ss += (o[e].x * o[e].x + o[e].y * o[e].y) + (o[e].z * o[e].z + o[e].w * o[e].w); }
    const float rs = 1.0f / sqrtf(wave_sum(ss) * (1.f / 512.f) + EPS);
#pragma unroll
    for (int e = 0; e < 2; ++e) { const u32x2 gw = *(const u32x2*)(Prow + O_GA + h * 512 + e * 256 + lane * 4);
        u32x2 ow; ow.x = pk2(o[e].x * rs * bflo(gw.x), o[e].y * rs * bfhi(gw.x)); ow.y = pk2(o[e].z * rs * bflo(gw.y), o[e].w * rs * bfhi(gw.y));
        *(u32x2*)((bf16_t*)(ws + WS_OA) + (size_t)(MP + i) * 2048 + h * 512 + e * 256 + lane * 4) = ow; }
}

__device__ __forceinline__ void phase25_row(const Args& a, int m, int lane) {
    unsigned char* ws = a.ws;
    const bf16_t* Prow = (const bf16_t*)(ws + WS_P) + (size_t)m * NP;
    bf16_t* oa = (bf16_t*)(ws + WS_OA) + (size_t)m * 2048;
    const float* sq = (const float*)(ws + WS_SQA) + (size_t)m * 32;
    const bool prompt = m < MP;
    f32x4 sqv[8]; u32x4 ow[4], gw4[4];
    if (prompt) {
#pragma unroll
        for (int j = 0; j < 8; ++j) sqv[j] = ((const f32x4*)sq)[j];
#pragma unroll
        for (int hh = 0; hh < 4; ++hh) { ow[hh] = *(const u32x4*)(oa + hh * 512 + lane * 8); gw4[hh] = *(const u32x4*)(Prow + O_GA + hh * 512 + lane * 8); }
    }
    const bf16_t* ob = (const bf16_t*)(ws + WS_OB) + (size_t)m * D + lane * 16;
    f32x4 ov[4];
    { const u32x4 w0 = ((const u32x4*)ob)[0], w1 = ((const u32x4*)ob)[1];
      ov[0] = (f32x4){bflo(w0.x), bfhi(w0.x), bflo(w0.y), bfhi(w0.y)}; ov[1] = (f32x4){bflo(w0.z), bfhi(w0.z), bflo(w0.w), bfhi(w0.w)};
      ov[2] = (f32x4){bflo(w1.x), bfhi(w1.x), bflo(w1.y), bfhi(w1.y)}; ov[3] = (f32x4){bflo(w1.z), bfhi(w1.z), bflo(w1.w), bfhi(w1.w)}; }
    const float bc = ((const float*)(ws + WS_BC))[(size_t)m * 16 + (lane >> 2)];
    const bf16_t* cur = Prow + O_SH + 2048 + lane * 16;
    const bool hasp = (m >= MP) || (m & (T - 1));
    const bf16_t* prv = (m >= MP) ? cur + (size_t)MS * NP : cur - NP;
    u32x4 cw[2], pw[2] = {{0u, 0u, 0u, 0u}, {0u, 0u, 0u, 0u}}, gbw[2];
    cw[0] = ((const u32x4*)cur)[0]; cw[1] = ((const u32x4*)cur)[1];
    if (hasp) { pw[0] = ((const u32x4*)prv)[0]; pw[1] = ((const u32x4*)prv)[1]; }
    gbw[0] = ((const u32x4*)(Prow + O_GB + lane * 16))[0]; gbw[1] = ((const u32x4*)(Prow + O_GB + lane * 16))[1];
    f32x4 lw4[4], lb4[4], mu4[4];
#pragma unroll
    for (int j = 0; j < 4; ++j) { lw4[j] = ((const f32x4*)(a.in[I_LNW] + lane * 16))[j]; lb4[j] = ((const f32x4*)(a.in[I_LNB] + lane * 16))[j]; mu4[j] = ((const f32x4*)(a.in[I_MU] + 2048 + lane * 16))[j]; }
    if (prompt) {
#pragma unroll
        for (int hh = 0; hh < 4; ++hh) {
            const f32x4 s0 = sqv[2 * hh], s1 = sqv[2 * hh + 1];
            const float rs = 1.0f / sqrtf(((s0.x + s0.y) + (s0.z + s0.w) + (s1.x + s1.y) + (s1.z + s1.w)) * (1.f / 512.f) + EPS);
            const u32x4 o4 = ow[hh], g4 = gw4[hh];
            u32x4 r;
            r.x = pk2(bflo(o4.x) * rs * bflo(g4.x), bfhi(o4.x) * rs * bfhi(g4.x)); r.y = pk2(bflo(o4.y) * rs * bflo(g4.y), bfhi(o4.y) * rs * bfhi(g4.y));
            r.z = pk2(bflo(o4.z) * rs * bflo(g4.z), bfhi(o4.z) * rs * bfhi(g4.z)); r.w = pk2(bflo(o4.w) * rs * bflo(g4.w), bfhi(o4.w) * rs * bfhi(g4.w));
            *(u32x4*)(oa + hh * 512 + lane * 8) = r;
        }
    }
    float o[16], lw[16], lb[16], mu[16];
#pragma unroll
    for (int j = 0; j < 4; ++j) { o[4 * j] = ov[j].x; o[4 * j + 1] = ov[j].y; o[4 * j + 2] = ov[j].z; o[4 * j + 3] = ov[j].w;
        lw[4 * j] = lw4[j].x; lw[4 * j + 1] = lw4[j].y; lw[4 * j + 2] = lw4[j].z; lw[4 * j + 3] = lw4[j].w;
        lb[4 * j] = lb4[j].x; lb[4 * j + 1] = lb4[j].y; lb[4 * j + 2] = lb4[j].z; lb[4 * j + 3] = lb4[j].w;
        mu[4 * j] = mu4[j].x; mu[4 * j + 1] = mu4[j].y; mu[4 * j + 2] = mu4[j].z; mu[4 * j + 3] = mu4[j].w; }
    float s = 0.f;
#pragma unroll
    for (int j = 0; j < 16; ++j) s += o[j];
    s += __shfl_xor(s, 1); s += __shfl_xor(s, 2);
    const float mean = s * (1.f / 64.f);
    float q = 0.f;
#pragma unroll
    for (int j = 0; j < 16; ++j) { const float d = o[j] - mean; q += d * d; }
    q += __shfl_xor(q, 1); q += __shfl_xor(q, 2);
    const float rstd = 1.0f / sqrtf(q * (1.f / 64.f) + 64e-5f);
    const unsigned cws[8] = {cw[0].x, cw[0].y, cw[0].z, cw[0].w, cw[1].x, cw[1].y, cw[1].z, cw[1].w};
    const unsigned pws[8] = {pw[0].x, pw[0].y, pw[0].z, pw[0].w, pw[1].x, pw[1].y, pw[1].z, pw[1].w};
    const unsigned gws[8] = {gbw[0].x, gbw[0].y, gbw[0].z, gbw[0].w, gbw[1].x, gbw[1].y, gbw[1].z, gbw[1].w};
    unsigned outw[8];
#pragma unroll
    for (int j = 0; j < 8; ++j) {
        const float c0 = bflo(cws[j]), c1 = bfhi(cws[j]), p0 = bflo(pws[j]), p1 = bfhi(pws[j]);
        const float v0 = c0 + (p0 - c0) * mu[2 * j], v1 = c1 + (p1 - c1) * mu[2 * j + 1];
        const float y0 = ((o[2 * j] - mean) * rstd * lw[2 * j] + lb[2 * j] + bc * v0) * bflo(gws[j]);
        const float y1 = ((o[2 * j + 1] - mean) * rstd * lw[2 * j + 1] + lb[2 * j + 1] + bc * v1) * bfhi(gws[j]);
        outw[j] = pk2(y0, y1);
    }
    bf16_t* yb = (bf16_t*)(ws + WS_H) + (size_t)m * D + lane * 16;
    *(u32x4*)yb = (u32x4){outw[0], outw[1], outw[2], outw[3]}; *(u32x4*)(yb + 8) = (u32x4){outw[4], outw[5], outw[6], outw[7]};
}

struct EpiT1 {
    static constexpr bool PERM = false;
    const bf16_t* P; bf16_t* T1;
    __device__ __forceinline__ void operator()(const f32x4 (&acc)[2][2][4][2], const Unit& u, int wr, int wc, int fr, int fq) const {
        const int row0 = u.pm * 256 + wr * 64 + fr, col0 = u.pn * 256 + wc * 32 + 4 * fq;
#pragma unroll
        for (int ai = 0; ai < 2; ++ai)
#pragma unroll
            for (int m = 0; m < 4; ++m) { const int row = row0 + ai * 128 + m * 16; if (row >= MR) continue;
#pragma unroll
                for (int bj = 0; bj < 2; ++bj)
#pragma unroll
                    for (int n = 0; n < 2; ++n) { const int col = col0 + bj * 128 + n * 16;
                        const u32x2 gw = *(const u32x2*)(P + (size_t)row * NP + O_MA + col);
                        const f32x4 gt = {bflo(gw.x), bfhi(gw.x), bflo(gw.y), bfhi(gw.y)};
                        const f32x4 t = acc[ai][bj][m][n] * gt; *(u32x2*)(T1 + (size_t)row * D + col) = (u32x2){pk2(t.x, t.y), pk2(t.z, t.w)}; } asm volatile("" ::: "memory"); }
    }
};
struct EpiMG {
    static constexpr bool PERM = false;
    const bf16_t* P; const bf16_t* T1; bf16_t* MG;
    __device__ __forceinline__ void operator()(const f32x4 (&acc)[2][2][4][2], const Unit& u, int wr, int wc, int fr, int fq) const {
        const int row0 = u.pm * 256 + wr * 64 + fr, col0 = u.pn * 256 + wc * 32 + 4 * fq;
#pragma unroll
        for (int ai = 0; ai < 2; ++ai)
#pragma unroll
            for (int m = 0; m < 4; ++m) { const int row = row0 + ai * 128 + m * 16; if (row >= MR) continue;
#pragma unroll
                for (int bj = 0; bj < 2; ++bj)
#pragma unroll
                    for (int n = 0; n < 2; ++n) { const int col = col0 + bj * 128 + n * 16;
                        const u32x2 gw = *(const u32x2*)(P + (size_t)row * NP + O_MB + col);
                        const f32x4 gt = {bflo(gw.x), bfhi(gw.x), bflo(gw.y), bfhi(gw.y)};
                        const u32x2 tw = *(const u32x2*)(T1 + (size_t)row * D + col);
                        const f32x4 v = (f32x4){bflo(tw.x), bfhi(tw.x), bflo(tw.y), bfhi(tw.y)} + acc[ai][bj][m][n] * gt;
                        *(u32x2*)(MG + (size_t)row * D + col) = (u32x2){pk2(v.x, v.y), pk2(v.z, v.w)}; } asm volatile("" ::: "memory"); }
    }
};
struct EpiX1 {
    static constexpr bool PERM = false;
    const float* xp; const float* xs; float* X1; bf16_t* X1B; float* SQ;
    __device__ __forceinline__ void operator()(const f32x4 (&acc)[2][2][4][2], const Unit& u, int wr, int wc, int fr, int fq) const {
        const int row0 = u.pm * 256 + wr * 64 + fr, col0 = u.pn * 256 + wc * 32 + 4 * fq;
#pragma unroll
        for (int ai = 0; ai < 2; ++ai)
#pragma unroll
            for (int m = 0; m < 4; ++m) { const int row = row0 + ai * 128 + m * 16; const bool ok = row < MR;
                const float* xr = (row < MP) ? xp + (size_t)row * D : xs + (size_t)(row - MP) * D;
                float ss = 0.f;
                if (ok) {
#pragma unroll
                    for (int bj = 0; bj < 2; ++bj)
#pragma unroll
                        for (int n = 0; n < 2; ++n) { const int col = col0 + bj * 128 + n * 16;
                            const f32x4 v = *(const f32x4*)(xr + col) + acc[ai][bj][m][n];
                            ss += (v.x * v.x + v.y * v.y) + (v.z * v.z + v.w * v.w);
                            *(f32x4*)(X1 + (size_t)row * D + col) = v;
                            *(u32x2*)(X1B + (size_t)row * D + col) = (u32x2){pk2(v.x, v.y), pk2(v.z, v.w)}; }
                }
                ss += __shfl_xor(ss, 16); ss += __shfl_xor(ss, 32);
                if (ok && fq == 0) SQ[(size_t)row * 16 + u.pn * 4 + wc] = ss; asm volatile("" ::: "memory"); }
    }
};
struct EpiGT {
    static constexpr bool PERM = false;
    const float* SQ; bf16_t* GT;
    __device__ __forceinline__ void operator()(const f32x4 (&acc)[2][2][4][2], const Unit& u, int wr, int wc, int fr, int fq) const {
        const int row0 = u.pm * 256 + wr * 64 + fr, col0 = u.pn * 256 + wc * 32 + 4 * fq;
#pragma unroll
        for (int ai = 0; ai < 2; ++ai)
#pragma unroll
            for (int m = 0; m < 4; ++m) { const int row = row0 + ai * 128 + m * 16; if (row >= MR) continue;
                const f32x4* sp = (const f32x4*)(SQ + (size_t)row * 16); const f32x4 q0 = sp[0], q1 = sp[1], q2 = sp[2], q3 = sp[3];
                const float rs = 1.0f / sqrtf((((q0.x + q0.y) + (q0.z + q0.w)) + ((q1.x + q1.y) + (q1.z + q1.w)) + ((q2.x + q2.y) + (q2.z + q2.w)) + ((q3.x + q3.y) + (q3.z + q3.w))) * (1.f / D) + EPS);
#pragma unroll
                for (int bj = 0; bj < 2; ++bj)
#pragma unroll
                    for (int n = 0; n < 2; ++n) { const int col = col0 + bj * 128 + n * 16; const f32x4 t = acc[ai][bj][m][n] * rs;
                        *(u32x2*)(GT + (size_t)row * D + col) = (u32x2){pk2(sigm(t.x), sigm(t.y)), pk2(sigm(t.z), sigm(t.w))}; } asm volatile("" ::: "memory"); }
    }
};
struct EpiX2 {
    static constexpr bool PERM = false;
    const float* X1; const bf16_t* GT; float* out; float* SQ;
    __device__ __forceinline__ void operator()(const f32x4 (&acc)[2][2][4][2], const Unit& u, int wr, int wc, int fr, int fq) const {
        const int row0 = u.pm * 256 + wr * 64 + fr, col0 = u.pn * 256 + wc * 32 + 4 * fq;
#pragma unroll
        for (int ai = 0; ai < 2; ++ai)
#pragma unroll
            for (int m = 0; m < 4; ++m) { int row = row0 + ai * 128 + m * 16; asm volatile("" : "+v"(row)); const bool ok = row < MR;
                float ss = 0.f;
                if (ok) {
#pragma unroll
                    for (int bj = 0; bj < 2; ++bj)
#pragma unroll
                        for (int n = 0; n < 2; ++n) { const int col = col0 + bj * 128 + n * 16;
                            const u32x2 gw = *(const u32x2*)(GT + (size_t)row * D + col);
                            const f32x4 v = *(const f32x4*)(X1 + (size_t)row * D + col) + acc[ai][bj][m][n] * (f32x4){bflo(gw.x), bfhi(gw.x), bflo(gw.y), bfhi(gw.y)};
                            ss += (v.x * v.x + v.y * v.y) + (v.z * v.z + v.w * v.w);
                            *(f32x4*)(out + (size_t)row * D + col) = v; asm volatile("" ::: "memory"); }
                }
                ss += __shfl_xor(ss, 16); ss += __shfl_xor(ss, 32);
                if (ok && fq == 0) SQ[(size_t)row * 16 + u.pn * 4 + wc] = ss; asm volatile("" ::: "memory"); }
    }
};


__device__ __forceinline__ f32x4 mini_acc(const bf16_t* A, int lda, const bf16_t* Bt, int K, int kq, int l15, int quad) {
    f32x4 acc = {0.f, 0.f, 0.f, 0.f};
    const int kn = K / 128;
    const bf16_t* ap = A + (size_t)l15 * lda + kq * (K / 4) + quad * 8;
    const bf16_t* bp = Bt + (size_t)l15 * K + kq * (K / 4) + quad * 8;
#pragma unroll 4
    for (int ks = 0; ks < kn; ++ks) acc = MFMA32(*(const bf16x8*)(ap + ks * 32), *(const bf16x8*)(bp + ks * 32), acc);
    return acc;
}
__device__ __forceinline__ f32x4 mini_reduce(LAS f32x4* red, int half, int lane) { return (red[(half * 4 + 0) * 64 + lane] + red[(half * 4 + 1) * 64 + lane]) + (red[(half * 4 + 2) * 64 + lane] + red[(half * 4 + 3) * 64 + lane]); }
template <int PH> __device__ __forceinline__ void mini_phase(const Args& a, LAS unsigned char* lds, int bx, int G, int wave, int lane) {
    unsigned char* ws = a.ws;
    const int l15 = lane & 15, quad = lane >> 4, half = wave >> 2, kq = wave & 3;
    LAS f32x4* red1 = (LAS f32x4*)lds; LAS f32x4* red2 = red1 + 8 * 64;
    const bf16_t* P = (const bf16_t*)(ws + WS_P);
    for (int tp = bx; tp < 256; tp += G) {
        const int tl = tp * 2 + half, mt = tl >> 6, nt = tl & 63, row0 = MP + mt * 16, col0 = nt * 16;
        f32x4 a1, a2 = {0.f, 0.f, 0.f, 0.f};
        if (PH == 0) { a1 = mini_acc((const bf16_t*)(ws + WS_OA) + (size_t)row0 * 2048, 2048, (const bf16_t*)(ws + WS_WDA) + (size_t)col0 * 2048, 2048, kq, l15, quad);
                       a2 = mini_acc((const bf16_t*)(ws + WS_H) + (size_t)row0 * D, D, (const bf16_t*)(ws + WS_WDB) + (size_t)col0 * D, D, kq, l15, quad); }
        if (PH == 1) { a1 = mini_acc((const bf16_t*)(ws + WS_MG) + (size_t)row0 * D, D, (const bf16_t*)(ws + WS_WOUT) + (size_t)col0 * D, D, kq, l15, quad); }
        if (PH == 2) { a1 = mini_acc((const bf16_t*)(ws + WS_X1B) + (size_t)row0 * D, D, (const bf16_t*)(ws + WS_WGATE) + (size_t)col0 * D, D, kq, l15, quad);
                       a2 = mini_acc((const bf16_t*)(ws + WS_PB) + (size_t)row0 * PLE, PLE, (const bf16_t*)(ws + WS_WPLE) + (size_t)col0 * PLE, PLE, kq, l15, quad); }
        red1[wave * 64 + lane] = a1; red2[wave * 64 + lane] = a2;
        __syncthreads();
        if (kq == 0) {
            a1 = mini_reduce(red1, half, lane); a2 = mini_reduce(red2, half, lane);
            const int col = col0 + l15;
            float rs1[4] = {0.f, 0.f, 0.f, 0.f};
            if (PH == 2) {
#pragma unroll
                for (int r = 0; r < 4; ++r) { const f32x4 q = *(const f32x4*)((const float*)(ws + WS_SQS1) + (size_t)(row0 - MP + quad * 4 + r) * 64 + l15 * 4); float t = (q.x + q.y) + (q.z + q.w);
#pragma unroll
                    for (int o = 1; o < 16; o <<= 1) t += __shfl_xor(t, o);
                    rs1[r] = 1.0f / sqrtf(t * (1.f / D) + EPS); }
            }
#pragma unroll
            for (int r = 0; r < 4; ++r) {
                const int row = row0 + quad * 4 + r;
                float ss = 0.f;
                if (PH == 0) { const float ga = bf2f(P[(size_t)row * NP + O_MA + col]), gb = bf2f(P[(size_t)row * NP + O_MB + col]);
                    ((bf16_t*)(ws + WS_MG))[(size_t)row * D + col] = f2bf(a1[r] * ga + a2[r] * gb); }
                if (PH == 1) { const float x1 = a.in[I_XS][(size_t)(row - MP) * D + col] + a1[r]; ss = x1 * x1;
                    ((float*)(ws + WS_X1))[(size_t)row * D + col] = x1; ((bf16_t*)(ws + WS_X1B))[(size_t)row * D + col] = f2bf(x1); }
                if (PH == 2) { const float x2 = ((const float*)(ws + WS_X1))[(size_t)row * D + col] + a2[r] * sigm(rs1[r] * a1[r]); ss = x2 * x2;
                    a.out[OUT_Y + (size_t)row * D + col] = x2; }
                if (PH != 0) {
#pragma unroll
                    for (int o = 1; o < 16; o <<= 1) ss += __shfl_xor(ss, o);
                    if (l15 == 0) ((float*)(ws + (PH == 1 ? WS_SQS1 : WS_SQS2)))[(size_t)(row - MP) * 64 + nt] = ss;
                }
            }
        }
        __syncthreads();
    }
}

#define XB_TMO      128
#define XB_XCNT(j)  (256  + 64 * (j))
#define XB_XSUB(j)  (1280 + 64 * (j))
#define XB_XGEN(j)  (2304 + 64 * (j))
#define XB_TOP      3328
#define XB_TOPGEN   3392
#define XCD_BAR_WORDS 3456
#define XB_SPIN_CAP (1u << 22)
__device__ __forceinline__ unsigned xb_ld(unsigned* p)              { return __hip_atomic_load(p, __ATOMIC_RELAXED, __HIP_MEMORY_SCOPE_AGENT); }
__device__ __forceinline__ unsigned xb_add(unsigned* p, unsigned v) { return __hip_atomic_fetch_add(p, v, __ATOMIC_RELAXED, __HIP_MEMORY_SCOPE_AGENT); }
__device__ __forceinline__ unsigned xb_xcc_id() { return (unsigned)__builtin_amdgcn_s_getreg((3 << 11) | 20) & 0xFu; }
#define XB_SPIN(cond, bar) do { unsigned _sp = 0; while (cond) { __builtin_amdgcn_s_sleep(1); \
    if ((++_sp & 255u) == 0u) { if (xb_ld(&(bar)[XB_TMO])) break; if (_sp > XB_SPIN_CAP) { atomicAdd(&(bar)[XB_TMO], 1u); break; } } } } while (0)
struct XcdBarrier { unsigned* bar; unsigned x; volatile LAS unsigned* st; };
__device__ __forceinline__ XcdBarrier xcd_barrier_post(unsigned* bar, volatile LAS unsigned* st) {
    XcdBarrier b; b.bar = bar; b.x = xb_xcc_id(); b.st = st;
    if (threadIdx.x == 0) (void)xb_add(&bar[XB_XCNT(b.x)], 1u);
    return b;
}
__device__ __forceinline__ void xcd_barrier_complete(unsigned* bar, unsigned x, unsigned& nloc, unsigned& nx) {
    const unsigned G = gridDim.x * gridDim.y * gridDim.z;
    unsigned sum, cnt, mine, sp = 0u;
    for (;;) {
        sum = 0u; cnt = 0u; mine = 0u;
#pragma unroll
        for (unsigned j = 0; j < 16; ++j) { const unsigned c = xb_ld(&bar[XB_XCNT(j)]); sum += c; cnt += (c > 0u) ? 1u : 0u; mine = (j == x) ? c : mine; }
        if (sum == G) break;
        __builtin_amdgcn_s_sleep(1);
        if ((++sp & 255u) == 0u) { if (xb_ld(&bar[XB_TMO])) break; if (sp > XB_SPIN_CAP) { atomicAdd(&bar[XB_TMO], 1u); break; } }
    }
    nloc = mine > 0u ? mine : 1u; nx = cnt > 0u ? cnt : 1u;
}
__device__ __forceinline__ void xcd_barrier(const XcdBarrier& b) {
    asm volatile("s_waitcnt vmcnt(0)" ::: "memory");
    __syncthreads();
    if (threadIdx.x == 0) {
        unsigned* bar = b.bar;
        __builtin_amdgcn_s_waitcnt(0);
        unsigned nloc = b.st[0], nx = b.st[1];
        if (nloc == 0u) { xcd_barrier_complete(bar, b.x, nloc, nx); b.st[0] = nloc; b.st[1] = nx; }
        const unsigned old = xb_add(&bar[XB_XSUB(b.x)], 1u);
        const unsigned gen = old / nloc;
        if (old + 1u == (gen + 1u) * nloc) {
            __builtin_amdgcn_fence(__ATOMIC_RELEASE, "agent");
            asm volatile("s_waitcnt vmcnt(0)" ::: "memory");
            const unsigned og = xb_add(&bar[XB_TOP], 1u);
            const unsigned tg = og / nx;
            if (og + 1u == (tg + 1u) * nx) xb_add(&bar[XB_TOPGEN], 1u);
            else XB_SPIN(xb_ld(&bar[XB_TOPGEN]) == tg, bar);
            __builtin_amdgcn_fence(__ATOMIC_ACQUIRE, "agent");
            xb_add(&bar[XB_XGEN(b.x)], 1u);
            asm volatile("s_waitcnt vmcnt(0)" ::: "memory");
        } else {
            XB_SPIN(xb_ld(&bar[XB_XGEN(b.x)]) == gen, bar);
            __builtin_amdgcn_fence(__ATOMIC_ACQUIRE, "agent");
            asm volatile("s_waitcnt vmcnt(0)" ::: "memory");
        }
    }
    __syncthreads();
}

constexpr int LDS_BYTES = 147456;
constexpr int CTL_SQ1 = 0, CTL_SQ2 = 32768, CTL_CNT = 65536;

#define GRID_SYNC() xcd_barrier(xbar)
__global__ void __launch_bounds__(512, 2) fwd_mega(Args a) {
    extern __shared__ __attribute__((aligned(16))) unsigned char lds_raw[];
    LAS unsigned char* lds = (LAS unsigned char*)lds_raw;
    cg::grid_group grid = cg::this_grid();
    const int tid = threadIdx.x, lane = tid & 63, wave = __builtin_amdgcn_readfirstlane(tid >> 6);
    const int G = gridDim.x, bx = blockIdx.x;
    const int gw = bx * 8 + wave, NGW = G * 8;
    unsigned char* ws = a.ws;
    if (tid < 16) ((LAS unsigned*)(lds + 131072 + 64))[tid] = 0u;
    __syncthreads();
    XcdBarrier xbar = xcd_barrier_post((unsigned*)(ws + WS_BAR), (volatile LAS unsigned*)(lds + 131072 + 64));
    grid.sync();

#if !defined(ONLY_PH) || ONLY_PH == 0
    phase0(a, lds, gw, NGW, wave, lane);
    GRID_SYNC();
#endif
#if !defined(ONLY_PH) || ONLY_PH == 1
    {
        pg8::Gemm g{(const bf16_t*)(ws + WS_H), (const bf16_t*)(ws + WS_WIN), MALL, NP, D}; pg8::StaticOrder S; S.init(MALL, NP, G, bx);
        EpiP E{(bf16_t*)(ws + WS_P), (bf16_t*)(ws + WS_KT), (const f32x2*)(ws + WS_ROPE)};
        pg8::gemm_phase<EpiP>(lds, g, S, E);
    }
    GRID_SYNC();
#endif
#if !defined(ONLY_PH) || ONLY_PH == 2
    for (int it = gw; it < 1032 * 16; it += NGW) rw_prep_item(a, lds + wave * 10240, it >> 4, it & 15, lane);
    GRID_SYNC();
#endif
#if !defined(ONLY_PH) || ONLY_PH == 3
    {
        for (int u = gw; u < MS * 16; u += NGW) rw_sample_wave(a, u >> 4, u & 15, lane);
        if (bx < 128) { if (wave < 4) rw_scan_task(a, lds + wave * 4096, bx >> 4, bx & 15, wave, lane); else if (G >= 128) { const int u = bx * 4 + (wave - 4); ret_sample_wave(a, u >> 2, u & 3, lane); } }
        __syncthreads();
        {
            unsigned* cnt2 = (unsigned*)(ws + WS_CTL) + CTL_CNT + 32;
            LAS unsigned* lu = (LAS unsigned*)(lds + 131072);
            for (;;) {
                if (tid == 0) *lu = atomicAdd(cnt2, 1u);
                __syncthreads();
                const unsigned unit = *lu;
                __syncthreads();
                if (unit >= (unsigned)(MS * 4) || G >= 128) break;
                ret_sample_unit(a, lds, (int)(unit >> 2), (int)(unit & 3), tid);
            }
        }
        {
            unsigned* cnt = (unsigned*)(ws + WS_CTL) + CTL_CNT;
            LAS unsigned* lu = (LAS unsigned*)(lds + 131072);
            for (;;) {
                if (tid == 0) *lu = atomicAdd(cnt, 1u);
                __syncthreads();
                const unsigned unit = *lu;
                __syncthreads();
                if (unit >= 256u) break;
                ret_unit(a, lds, (int)unit, tid);
            }
        }
    }
    GRID_SYNC();
#endif
#if !defined(ONLY_PH) || ONLY_PH == 4
    for (int m = gw; m < MR; m += NGW) phase25_row(a, m, lane);
    GRID_SYNC();
#endif
#if !defined(ONLY_PH) || ONLY_PH == 5
    {
        mini_phase<0>(a, lds, bx, G, wave, lane);
        pg8::StaticOrder S; S.init(MP, D, G, bx);
        { pg8::Gemm g{(const bf16_t*)(ws + WS_OA), (const bf16_t*)(ws + WS_WDA), MP, D, 2048}; EpiT1 E{(const bf16_t*)(ws + WS_P), (bf16_t*)(ws + WS_T1)}; pg8::gemm_phase<EpiT1>(lds, g, S, E); }
        { pg8::Gemm g{(const bf16_t*)(ws + WS_H), (const bf16_t*)(ws + WS_WDB), MP, D, D}; EpiMG E{(const bf16_t*)(ws + WS_P), (const bf16_t*)(ws + WS_T1), (bf16_t*)(ws + WS_MG)}; pg8::gemm_phase<EpiMG>(lds, g, S, E); }
    }
    GRID_SYNC();
#endif
#if !defined(ONLY_PH) || ONLY_PH == 6
    {
        mini_phase<1>(a, lds, bx, G, wave, lane);
        pg8::StaticOrder S; S.init(MP, D, G, bx);
        pg8::Gemm g{(const bf16_t*)(ws + WS_MG), (const bf16_t*)(ws + WS_WOUT), MP, D, D};
        EpiX1 E{a.in[I_XP], a.in[I_XS], (float*)(ws + WS_X1), (bf16_t*)(ws + WS_X1B), (float*)(ws + WS_SQ1P)};
        pg8::gemm_phase<EpiX1>(lds, g, S, E);
    }
    GRID_SYNC();
#endif
#if !defined(ONLY_PH) || ONLY_PH == 7
    {
        mini_phase<2>(a, lds, bx, G, wave, lane);
        pg8::StaticOrder S; S.init(MP, D, G, bx);
        { pg8::Gemm g{(const bf16_t*)(ws + WS_X1B), (const bf16_t*)(ws + WS_WGATE), MP, D, D}; EpiGT E{(const float*)(ws + WS_SQ1P), (bf16_t*)(ws + WS_GT)}; pg8::gemm_phase<EpiGT>(lds, g, S, E); }
        { pg8::Gemm g{(const bf16_t*)(ws + WS_PB), (const bf16_t*)(ws + WS_WPLE), MP, D, PLE}; EpiX2 E{(const float*)(ws + WS_X1), (const bf16_t*)(ws + WS_GT), a.out + OUT_Y, (float*)(ws + WS_SQ2P)}; pg8::gemm_phase<EpiX2>(lds, g, S, E); }
    }
    GRID_SYNC();
#endif
#if !defined(ONLY_PH) || ONLY_PH == 8
    {
        const float* sq2 = (const float*)(ws + WS_SQ2P); const float* fg = a.in[I_FNG];
        for (int m = gw; m < MR; m += NGW) {
            float tot;
            if (m < MP) { const f32x4* sp = (const f32x4*)(sq2 + (size_t)m * 16); const f32x4 q0 = sp[0], q1 = sp[1], q2 = sp[2], q3 = sp[3];
                tot = (((q0.x + q0.y) + (q0.z + q0.w)) + ((q1.x + q1.y) + (q1.z + q1.w)) + ((q2.x + q2.y) + (q2.z + q2.w)) + ((q3.x + q3.y) + (q3.z + q3.w))); }
            else tot = wave_sum(((const float*)(ws + WS_SQS2))[(size_t)(m - MP) * 64 + lane]);
            const float rs = 1.0f / sqrtf(tot * (1.f / D) + EPS);
            f32x4* o = (f32x4*)(a.out + OUT_Y + (size_t)m * D);
            f32x4 xv[4];
#pragma unroll
            for (int j = 0; j < 4; ++j) xv[j] = o[lane + 64 * j];
#pragma unroll
            for (int j = 0; j < 4; ++j) o[lane + 64 * j] = xv[j] * rs * ((const f32x4*)fg)[lane + 64 * j];
        }
    }
#endif

}

extern "C" void kernel_launch(void* const* d_in, const int* in_sizes, int n_in, void* d_out, int out_size, void* d_ws, size_t ws_size, hipStream_t stream) {
    static int grid = 0;
    if (grid == 0) {
        if (n_in != 26 || ws_size < WS_END) { fprintf(stderr, "kernel_launch: unexpected n_in %d or ws_size %zu (need %zu)\n", n_in, ws_size, (size_t)WS_END); grid = -1; return; }
        int dev = 0, cus = 0, per_cu = 0;
        hipGetDevice(&dev); hipDeviceGetAttribute(&cus, hipDeviceAttributeMultiprocessorCount, dev);
        if (hipFuncSetAttribute((const void*)fwd_mega, hipFuncAttributeMaxDynamicSharedMemorySize, LDS_BYTES) != hipSuccess) { fprintf(stderr, "kernel_launch: hipFuncSetAttribute failed\n"); grid = -1; return; }
        hipOccupancyMaxActiveBlocksPerMultiprocessor(&per_cu, (const void*)fwd_mega, 512, LDS_BYTES);
        if (per_cu < 1) { fprintf(stderr, "kernel_launch: occupancy query says %d blocks per CU\n", per_cu); per_cu = 1; }
        (void)hipGetLastError();
        grid = cus * 1;
        fprintf(stderr, "kernel_launch: grid %d (cus %d, per_cu %d), ws %zu\n", grid, cus, per_cu, ws_size);
    }
    if (grid < 0) return;
    Args a{};
    for (int i = 0; i < 26; ++i) a.in[i] = (const float*)d_in[i];
    a.out = (float*)d_out; a.ws = (unsigned char*)d_ws;
    if (hipMemsetAsync((char*)d_ws + WS_BAR, 0, XCD_BAR_WORDS * 4, stream) != hipSuccess) { fprintf(stderr, "kernel_launch: memset failed\n"); return; }
    void* args[] = {&a};
    hipError_t e = hipLaunchCooperativeKernel((const void*)fwd_mega, dim3(grid), dim3(512), args, LDS_BYTES, stream);
    if (e != hipSuccess) fprintf(stderr, "kernel_launch: cooperative launch failed: %s\n", hipGetErrorString(e));
}
```

```cpp
#include <hip/hip_runtime.h>
#include <hip/hip_cooperative_groups.h>
#include <cstdio>
#include <cstdint>
namespace cg = cooperative_groups;

#define LAS __attribute__((address_space(3)))
typedef unsigned short bf16_t;
typedef short bf16x8 __attribute__((ext_vector_type(8)));
typedef short bf16x4 __attribute__((ext_vector_type(4)));
typedef float f32x4 __attribute__((ext_vector_type(4)));
typedef float f32x2 __attribute__((ext_vector_type(2)));
typedef unsigned u32x4 __attribute__((ext_vector_type(4)));
typedef unsigned u32x2 __attribute__((ext_vector_type(2)));
typedef __bf16 nbf2 __attribute__((ext_vector_type(2)));

constexpr int D = 1024, NB = 8, T = 2048, MP = NB * T  , MS = 128, MR = MP + MS  , MALL = 16640  ;
constexpr int NCOLS = 12416, NP = 12544  ;
constexpr int O_K = 1024, O_V = 2048, O_GA = 4096, O_SH = 6144, O_GB = 9344, O_MA = 10368, O_MB = 11392;
constexpr int RH = 4, RDK = 256, RDV = 512, RCH = 128;
constexpr int WH = 16, WN = 64;
constexpr int PLE = 256;
constexpr float EPS = 1e-6f;
constexpr int REC = 12544;
constexpr int R_AT = 0, R_RT = 2048, R_BP = 4096, R_KP = 6144, R_VT = 8192, R_AAK = 10240, R_TT = 10752, R_ARB = 11264, R_ARK = 11776, R_WC = 12288;

constexpr size_t MiB = 1u << 20;
constexpr size_t WS_CTL = 0;
constexpr size_t WS_ROPE = 1 * MiB;
constexpr size_t WS_W2T = 4 * MiB, WS_A2T = WS_W2T + 131072;
constexpr size_t WS_WPLE = 5 * MiB, WS_WDB = 6 * MiB, WS_WOUT = 8 * MiB, WS_WGATE = 10 * MiB, WS_WDA = 12 * MiB, WS_WIN = 16 * MiB;
constexpr size_t WS_PB = 41 * MiB, WS_H = 50 * MiB  , WS_KT = 83 * MiB, WS_SQA = 115 * MiB, WS_BC = 117 * MiB, WS_OPSS = 119 * MiB  ;
constexpr size_t WS_OA = 122 * MiB, WS_P = 188 * MiB, WS_CH = 587 * MiB  , WS_OB = 786 * MiB  ;
constexpr size_t WS_T1 = WS_CH, WS_MG = WS_CH + 65 * MiB, WS_X1B = WS_CH + 98 * MiB, WS_GT = WS_CH + 131 * MiB, WS_X1 = WS_OB + 65 * MiB  ;
constexpr size_t WS_END = 916 * MiB;
constexpr size_t WS_BAR = 512 * 1024;
constexpr size_t WS_SQS1 = 640 * 1024, WS_SQS2 = 704 * 1024;
constexpr size_t WS_SQ1P = WS_KT, WS_SQ2P = WS_KT + 2 * MiB;

constexpr size_t OUT_Y = 0, OUT_RETP = 16908288, OUT_RWP = 21102592, OUT_SHP = 21626880, OUT_RETS = 21635072, OUT_RWS = 88743936, OUT_SHS = 97132544;

__device__ __forceinline__ unsigned pk2(float lo, float hi) { f32x2 v = {lo, hi}; nbf2 r = __builtin_convertvector(v, nbf2); return __builtin_bit_cast(unsigned, r); }
__device__ __forceinline__ unsigned short f2bf(float f) { return (unsigned short)(pk2(f, 0.f) & 0xffffu); }
__device__ __forceinline__ float bf2f(unsigned short b) { return __uint_as_float(((unsigned)b) << 16); }
__device__ __forceinline__ float bflo(unsigned w) { return __uint_as_float(w << 16); }
__device__ __forceinline__ float bfhi(unsigned w) { return __uint_as_float(w & 0xffff0000u); }
__device__ __forceinline__ float sigm(float x) { return __builtin_amdgcn_rcpf(1.f + __expf(-x)); }
__device__ __forceinline__ float wave_sum(float v) {
#pragma unroll
    for (int o = 1; o < 64; o <<= 1) v += __shfl_xor(v, o);
    return v;
}
#define MFMA32(a, b, c) __builtin_amdgcn_mfma_f32_16x16x32_bf16((a), (b), (c), 0, 0, 0)
#define LDS_WAIT() asm volatile("s_waitcnt lgkmcnt(0)" ::: "memory")

namespace pg8 {
constexpr int BM = 256, BK = 64, HALF = 128, HTB = HALF * BK * 2, STAGE_BYTES = 8 * HTB, NXCD = 8, WGM = 8;
__host__ __device__ __forceinline__ int lds_byte(int r, int c) { const int st = (r >> 4) * 2 + (c >> 5), rr = r & 15, cc = c & 31, ob = rr * 64 + cc * 2; return st * 1024 + (ob ^ (((ob >> 9) & 1) << 5)); }
__host__ __device__ __forceinline__ void stage_rc(int b, int& R, int& C) { const int st = b / 1024, sb = b % 1024, swz = sb ^ (((sb >> 9) & 1) << 5); R = (st >> 1) * 16 + swz / 64; C = (st & 1) * 32 + (swz % 64) / 2; }
__host__ __device__ __forceinline__ int perm32(int rho) { const int n = rho >> 4, i = rho & 15; return 8 * (i >> 2) + 4 * n + (i & 3); }
struct Unit { int pm, pn; };
struct Gemm { const bf16_t* A; const bf16_t* Bt; int M, N, K; };
struct StaticOrder {
    int nM, nN, nwg, G, c;
    __host__ __device__ void init(int M, int N, int G_, int c_) { nM = M / BM; nN = N / BM; nwg = nM * nN; G = G_; c = c_; }
    __host__ __device__ bool next(int i, Unit& u) const {
        const long L = (long)i * G + c; if (L >= nwg) return false;
        int wgid = (int)L; { const int q = nwg / NXCD, r = nwg % NXCD, xcd = wgid % NXCD, off = wgid / NXCD; wgid = (xcd < r ? xcd * (q + 1) : r * (q + 1) + (xcd - r) * q) + off; }
        const int nig = WGM * nN, gid = wgid / nig, fm = gid * WGM, gsz = (nM - fm) < WGM ? (nM - fm) : WGM;
        u.pm = fm + ((wgid % nig) % gsz); u.pn = (wgid % nig) / gsz; return true;
    }
};
template <class Epi>
__device__ __forceinline__ void gemm_phase(LAS unsigned char* lds, const Gemm g, const StaticOrder& S, const Epi& E) {
    int tid = threadIdx.x; asm volatile("" : "+v"(tid));
    const int wid = __builtin_amdgcn_readfirstlane(tid >> 6), lane = tid & 63, wr = wid >> 2, wc = wid & 3, fr = lane & 15, fq = lane >> 4;
    const int K = g.K, nt = K / BK;
    unsigned voffA[2], voffB[2];
#pragma unroll
    for (int i = 0; i < 2; ++i) { int R, C; stage_rc(tid * 16 + i * 8192, R, C); const int Rb = Epi::PERM ? ((R & ~31) + perm32(R & 31)) : R;
        voffA[i] = (unsigned)(R * K + C) * 2u; voffB[i] = (unsigned)(Rb * K + C) * 2u; }
    const size_t kstep = (size_t)(BK * 2);
    const size_t hstep = (size_t)HALF * K * 2;
    const size_t tstep = 2 * hstep;
    const unsigned ldsw = (unsigned)wid * 1024u;
    const int aoff = lds_byte(wr * 64 + fr, fq * 8), boff = lds_byte(wc * 32 + fr, fq * 8);
#define PG8_SA(b, h) (((b) * 2 + (h)) * HTB)
#define PG8_SB(b, h) ((4 + (b) * 2 + (h)) * HTB)
#define PG8_STAGE(bufoff, gbase, voff) do { _Pragma("unroll") for (int _i = 0; _i < 2; ++_i) \
        __builtin_amdgcn_global_load_lds((const unsigned*)((const char*)(gbase) + (voff)[_i]), (LAS unsigned*)(lds + (bufoff) + ldsw + _i * 8192), 16, 0, 0); } while (0)
#define PG8_LDA(dst, b, h) do { _Pragma("unroll") for (int m = 0; m < 4; ++m) _Pragma("unroll") for (int k = 0; k < 2; ++k) dst[m][k] = *(const LAS bf16x8*)(lds + PG8_SA(b, h) + aoff + m * 2048 + k * 1024); } while (0)
#define PG8_LDB(dst, b, h) do { _Pragma("unroll") for (int n = 0; n < 2; ++n) _Pragma("unroll") for (int k = 0; k < 2; ++k) dst[n][k] = *(const LAS bf16x8*)(lds + PG8_SB(b, h) + boff + n * 2048 + k * 1024); } while (0)
#define PG8_MMA(ai, bj, At, Bt) do { __builtin_amdgcn_s_setprio(1); _Pragma("unroll") for (int m = 0; m < 4; ++m) _Pragma("unroll") for (int n = 0; n < 2; ++n) _Pragma("unroll") for (int k = 0; k < 2; ++k) \
        acc[ai][bj][m][n] = __builtin_amdgcn_mfma_f32_16x16x32_bf16(Bt[n][k], At[m][k], acc[ai][bj][m][n], 0, 0, 0); __builtin_amdgcn_s_setprio(0); } while (0)
#define PG8_WAIT_V(n) asm volatile("s_waitcnt vmcnt(" #n ")" ::: "memory")
#define PG8_WAIT_L(n) asm volatile("s_waitcnt lgkmcnt(" #n ")" ::: "memory")
#define PG8_BAR __builtin_amdgcn_s_barrier()
#define PG8_SCHED __builtin_amdgcn_sched_barrier(0)
    Unit cur, nxt; int ui = 0;
    if (!S.next(0, cur)) return;
    f32x4 acc[2][2][4][2];
#pragma unroll
    for (int a = 0; a < 2; ++a)
#pragma unroll
        for (int b = 0; b < 2; ++b)
#pragma unroll
            for (int m = 0; m < 4; ++m)
#pragma unroll
                for (int n = 0; n < 2; ++n) acc[a][b][m][n] = (f32x4){0.f, 0.f, 0.f, 0.f};
    bf16x8 At[4][2], B0[2][2], B1[2][2];
    const char* cA = (const char*)g.A + (size_t)cur.pm * tstep; const char* cB = (const char*)g.Bt + (size_t)cur.pn * tstep;
    PG8_STAGE(PG8_SB(0, 0), cB, voffB); PG8_STAGE(PG8_SA(0, 0), cA, voffA); PG8_STAGE(PG8_SB(0, 1), cB + hstep, voffB); PG8_STAGE(PG8_SA(0, 1), cA + hstep, voffA);
    if (wr == 1) PG8_BAR;
    PG8_WAIT_V(4); PG8_BAR;
    PG8_STAGE(PG8_SB(1, 0), cB + kstep, voffB); PG8_STAGE(PG8_SA(1, 0), cA + kstep, voffA); PG8_STAGE(PG8_SB(1, 1), cB + hstep + kstep, voffB);
    PG8_WAIT_V(6); PG8_BAR;
    for (;;) {
        const bool has_next = S.next(ui + 1, nxt);
        const char* nA = has_next ? (const char*)g.A + (size_t)nxt.pm * tstep : cA; const char* nB = has_next ? (const char*)g.Bt + (size_t)nxt.pn * tstep : cB;
#pragma unroll 1
        for (int t = 0; t < nt; t += 2) {
            const bool last = (t == nt - 2);
            const char* a1 = cA + (size_t)(t + 1) * kstep;
            const char* a2 = last ? nA : cA + (size_t)(t + 2) * kstep; const char* b2 = last ? nB : cB + (size_t)(t + 2) * kstep;
            const char* a3 = a2 + kstep; const char* b3 = b2 + kstep;
            PG8_LDB(B0, 0, 0); PG8_SCHED; PG8_LDA(At, 0, 0); PG8_STAGE(PG8_SA(1, 1), a1 + hstep, voffA);
            PG8_WAIT_L(8); PG8_BAR; PG8_WAIT_L(0); PG8_MMA(0, 0, At, B0); PG8_BAR; PG8_SCHED;
            PG8_LDB(B1, 0, 1); PG8_STAGE(PG8_SB(0, 0), b2, voffB);
            PG8_BAR; PG8_WAIT_L(0); PG8_MMA(0, 1, At, B1); PG8_BAR;
            PG8_LDA(At, 0, 1); PG8_STAGE(PG8_SA(0, 0), a2, voffA);
            PG8_BAR; PG8_WAIT_L(0); PG8_MMA(1, 0, At, B0); PG8_BAR; PG8_SCHED;
            PG8_STAGE(PG8_SB(0, 1), b2 + hstep, voffB);
            PG8_WAIT_V(6); PG8_BAR; PG8_MMA(1, 1, At, B1); PG8_BAR;
            PG8_LDB(B0, 1, 0); PG8_SCHED; PG8_LDA(At, 1, 0); PG8_STAGE(PG8_SA(0, 1), a2 + hstep, voffA);
            PG8_WAIT_L(8); PG8_BAR; PG8_WAIT_L(0); PG8_MMA(0, 0, At, B0); PG8_BAR; PG8_SCHED;
            PG8_LDB(B1, 1, 1); PG8_STAGE(PG8_SB(1, 0), b3, voffB);
            PG8_BAR; PG8_WAIT_L(0); PG8_MMA(0, 1, At, B1); PG8_BAR;
            PG8_LDA(At, 1, 1); PG8_STAGE(PG8_SA(1, 0), a3, voffA);
            PG8_BAR; PG8_WAIT_L(0); PG8_MMA(1, 0, At, B0); PG8_BAR; PG8_SCHED;
            PG8_STAGE(PG8_SB(1, 1), b3 + hstep, voffB);
            PG8_WAIT_V(6); PG8_BAR; PG8_MMA(1, 1, At, B1); PG8_BAR;
        }
        E(acc, cur, wr, wc, fr, fq);
        if (!has_next) break;
#pragma unroll
        for (int a = 0; a < 2; ++a)
#pragma unroll
            for (int b = 0; b < 2; ++b)
#pragma unroll
                for (int m = 0; m < 4; ++m)
#pragma unroll
                    for (int n = 0; n < 2; ++n) acc[a][b][m][n] = (f32x4){0.f, 0.f, 0.f, 0.f};
        cur = nxt; cA = nA; cB = nB; ++ui;
    }
    PG8_WAIT_V(0);
    if (wr == 0) PG8_BAR;
    PG8_BAR;
#undef PG8_SA
#undef PG8_SB
#undef PG8_STAGE
#undef PG8_LDA
#undef PG8_LDB
#undef PG8_MMA
#undef PG8_WAIT_V
#undef PG8_WAIT_L
#undef PG8_BAR
#undef PG8_SCHED
}
}
using pg8::Unit;

struct Args {
    const float* in[26];
    float* out; unsigned char* ws;
};
#define KAS __attribute__((address_space(4)))
__device__ __forceinline__ const KAS char* kargp() { const KAS char* p = (const KAS char*)__builtin_amdgcn_kernarg_segment_ptr(); asm volatile("" : "+s"(p)); return p; }


enum { I_XP = 0, I_XS, I_SRET, I_SRW, I_SSH, I_PP, I_PS, I_NG, I_WIN, I_MU, I_W0, I_W2, I_A0, I_A2, I_KK, I_KA, I_RK, I_LNW, I_LNB, I_WDA, I_WDB, I_WOUT, I_WPLE, I_PNG, I_WPG, I_FNG };

__device__ __forceinline__ void p0_transpose_item(const float* W, int K, int N, bf16_t* WT, LAS float* scr, int item, int lane, const float* kscale) {
    const int nblk = N / 32, kb = item / nblk, nb = item % nblk, k0 = 64 * kb, n0 = 32 * nb;
#pragma unroll 8
    for (int i = 0; i < 32; ++i) { const int kk = 2 * i + (lane >> 5); float v = W[(size_t)(k0 + kk) * N + n0 + (lane & 31)]; if (kscale) v *= kscale[k0 + kk]; scr[kk * 33 + (lane & 31)] = v; }
    LDS_WAIT();
    const int c = lane & 7;
#pragma unroll
    for (int j = 0; j < 4; ++j) { const int n = (lane >> 3) + 8 * j; const LAS float* s = scr + (8 * c) * 33 + n;
        u32x4 o; o.x = pk2(s[0 * 33], s[1 * 33]); o.y = pk2(s[2 * 33], s[3 * 33]); o.z = pk2(s[4 * 33], s[5 * 33]); o.w = pk2(s[6 * 33], s[7 * 33]);
        *(u32x4*)(WT + (size_t)(n0 + n) * K + k0 + 8 * c) = o; }
    LDS_WAIT();
}

__device__ __forceinline__ void phase0(const Args& a, LAS unsigned char* lds, int gw, int NGW, int wave, int lane) {
    unsigned char* ws = a.ws;
    LAS float* scr = (LAS float*)(lds + wave * 16384);
    constexpr int I_IN = (D / 64) * (NCOLS / 32), I_DA = (2048 / 64) * (D / 32), I_SQ = (D / 64) * (D / 32), I_PL = (PLE / 64) * (D / 32), I_LR = 1 * (D / 32);
    constexpr int NITEMS = I_IN + I_DA + 3 * I_SQ + I_PL + 2 * I_LR;
    for (int it = gw; it < NITEMS; it += NGW) {
        int r = it;
        if (r < I_IN) { p0_transpose_item(a.in[I_WIN], D, NCOLS, (bf16_t*)(ws + WS_WIN), scr, r, lane, nullptr); continue; } r -= I_IN;
        if (r < I_DA) { p0_transpose_item(a.in[I_WDA], 2048, D, (bf16_t*)(ws + WS_WDA), scr, r, lane, nullptr); continue; } r -= I_DA;
        if (r < I_SQ) { p0_transpose_item(a.in[I_WDB], D, D, (bf16_t*)(ws + WS_WDB), scr, r, lane, nullptr); continue; } r -= I_SQ;
        if (r < I_SQ) { p0_transpose_item(a.in[I_WOUT], D, D, (bf16_t*)(ws + WS_WOUT), scr, r, lane, nullptr); continue; } r -= I_SQ;
        if (r < I_SQ) { p0_transpose_item(a.in[I_WPG], D, D, (bf16_t*)(ws + WS_WGATE), scr, r, lane, a.in[I_PNG]); continue; } r -= I_SQ;
        if (r < I_PL) { p0_transpose_item(a.in[I_WPLE], PLE, D, (bf16_t*)(ws + WS_WPLE), scr, r, lane, nullptr); continue; } r -= I_PL;
        if (r < I_LR) { p0_transpose_item(a.in[I_W2], 64, D, (bf16_t*)(ws + WS_W2T), scr, r, lane, nullptr); continue; } r -= I_LR;
        p0_transpose_item(a.in[I_A2], 64, D, (bf16_t*)(ws + WS_A2T), scr, r, lane, nullptr);
    }
    for (int i = gw * 64 + lane; i < 128 * D / 8; i += NGW * 64) ((u32x4*)(ws + WS_WIN + (size_t)NCOLS * D * 2))[i] = (u32x4){0u, 0u, 0u, 0u};
    bf16_t* H = (bf16_t*)(ws + WS_H);
    const float* ng = a.in[I_NG];
    for (int m = gw; m < MALL; m += NGW) {
        if (m < MR) {
            const float* xr = (m < MP) ? a.in[I_XP] + (size_t)m * D : a.in[I_XS] + (size_t)(m - MP) * D;
            f32x4 v[4]; float s = 0.f;
#pragma unroll
            for (int j = 0; j < 4; ++j) { v[j] = ((const f32x4*)xr)[lane + 64 * j]; s += (v[j].x * v[j].x + v[j].y * v[j].y) + (v[j].z * v[j].z + v[j].w * v[j].w); }
            const float rs = 1.0f / sqrtf(wave_sum(s) * (1.f / D) + EPS);
            float* so = nullptr;
            if (m < MP) { if ((m & (T - 1)) == T - 1) so = a.out + OUT_SHP + (size_t)(m >> 11) * D; } else so = a.out + OUT_SHS + (size_t)(m - MP) * D;
#pragma unroll
            for (int j = 0; j < 4; ++j) { const f32x4 gg = ((const f32x4*)ng)[lane + 64 * j]; f32x4 h = v[j] * rs * gg;
                if (so) ((f32x4*)so)[lane + 64 * j] = h;
                u32x2 o; o.x = pk2(h.x, h.y); o.y = pk2(h.z, h.w); ((u32x2*)(H + (size_t)m * D))[lane + 64 * j] = o; }
        } else {
            const float* xr = a.in[I_SSH] + (size_t)(m - MR) * D;
#pragma unroll
            for (int j = 0; j < 4; ++j) { const f32x4 h = ((const f32x4*)xr)[lane + 64 * j]; u32x2 o; o.x = pk2(h.x, h.y); o.y = pk2(h.z, h.w); ((u32x2*)(H + (size_t)m * D))[lane + 64 * j] = o; }
        }
        u32x2 o = {0u, 0u};
        if (m < MR) { const float* pr = (m < MP) ? a.in[I_PP] + (size_t)m * PLE : a.in[I_PS] + (size_t)(m - MP) * PLE; const f32x4 p = ((const f32x4*)pr)[lane]; o.x = pk2(p.x, p.y); o.y = pk2(p.z, p.w); }
        ((u32x2*)(ws + WS_PB + (size_t)m * PLE * 2))[lane] = o;
    }
    for (int i = gw * 64 + lane; i < 2049 * 128; i += NGW * 64) {
        const int pos = i >> 7, j = i & 127; const double p = (pos == 2048) ? 16384.0 : (double)pos;
        double inv = 1.0, base = 0.9305720409296989; int e = j;
        while (e) { if (e & 1) inv *= base; base *= base; e >>= 1; }
        double rev = p * inv * 0.15915494309189535; rev -= floor(rev);
        const float fr = (float)rev;
        ((f32x2*)(ws + WS_ROPE))[i] = (f32x2){__builtin_amdgcn_cosf(fr), __builtin_amdgcn_sinf(fr)};
    }
    for (int i = gw * 64 + lane; i < 65536 + 64; i += NGW * 64) ((float*)(ws + WS_CTL))[i] = 0.f;
}

struct EpiP {
    static constexpr bool PERM = true;
    bf16_t* P; bf16_t* KT; const f32x2* rope;
    __device__ __forceinline__ void operator()(const f32x4 (&acc)[2][2][4][2], const Unit& u, int wr, int wc, int fr, int fq) const {
        const int pn = u.pn, pm = u.pm;
        const int row0 = pm * 256 + wr * 64 + fr, cl0 = wc * 32 + 8 * fq;
        const bool sample = (pm == 64);
        if (pn < 8) {
            const int h = pn & 3; const bool isk = pn >= 4;
            const float l2g = __log2f(1.f - exp2f(-5.f - (float)h));
#pragma unroll
            for (int ai = 0; ai < 2; ++ai)
#pragma unroll
                for (int m = 0; m < 4; ++m) {
                    const int row = row0 + ai * 128 + m * 16;
                    int pos, ex;
                    if (sample) { pos = 2048; ex = isk ? 0 : 1; } else { pos = row & (T - 1); const int idx = pos & 127; ex = isk ? 127 - idx : idx + 1; }
                    const float sc = exp2f((float)ex * l2g) * (isk ? 0.0625f : 1.0f);
                    const f32x4* rp = (const f32x4*)(rope + pos * 128 + cl0);
                    f32x4 cs[4]; cs[0] = rp[0]; cs[1] = rp[1]; cs[2] = rp[2]; cs[3] = rp[3];
                    float y1[8], y2[8];
#pragma unroll
                    for (int n = 0; n < 2; ++n)
#pragma unroll
                        for (int e = 0; e < 4; ++e) {
                            const float c = (e & 1) ? cs[n * 2 + (e >> 1)].z : cs[n * 2 + (e >> 1)].x, s = (e & 1) ? cs[n * 2 + (e >> 1)].w : cs[n * 2 + (e >> 1)].y;
                            const float x1 = acc[ai][0][m][n][e], x2 = acc[ai][1][m][n][e];
                            y1[n * 4 + e] = (x1 * c - x2 * s) * sc; y2[n * 4 + e] = (x2 * c + x1 * s) * sc;
                        }
                    u32x4 w1, w2;
                    w1.x = pk2(y1[0], y1[1]); w1.y = pk2(y1[2], y1[3]); w1.z = pk2(y1[4], y1[5]); w1.w = pk2(y1[6], y1[7]);
                    w2.x = pk2(y2[0], y2[1]); w2.y = pk2(y2[2], y2[3]); w2.z = pk2(y2[4], y2[5]); w2.w = pk2(y2[6], y2[7]);
                    bf16_t* rowp = P + (size_t)row * NP + pn * 256 + cl0;
                    *(u32x4*)rowp = w1; *(u32x4*)(rowp + 128) = w2;
                    if (isk && !sample) {
                        bf16_t* kt = KT + ((size_t)((row >> 11) * 4 + h) * 256 + cl0) * T + pos;
#pragma unroll
                        for (int j = 0; j < 8; ++j) { kt[(size_t)j * T] = f2bf(y1[j]); kt[(size_t)(j + 128) * T] = f2bf(y2[j]); }
                    }
                }
            return;
        }
#pragma unroll
        for (int bj = 0; bj < 2; ++bj) {
            const int cb = pn * 2 + bj;
            if (cb >= 97) continue;
            const int mode = (cb < 32) ? 0 : (cb < 48) ? 1 : (cb < 73) ? 0 : (cb < 81) ? 1 : 2;
            const bool vt = (cb < 32) && !sample;
#pragma unroll
            for (int ai = 0; ai < 2; ++ai)
#pragma unroll
                for (int m = 0; m < 4; ++m) {
                    const int row = row0 + ai * 128 + m * 16;
                    float y[8];
#pragma unroll
                    for (int n = 0; n < 2; ++n)
#pragma unroll
                        for (int e = 0; e < 4; ++e) { float x = acc[ai][bj][m][n][e]; if (mode == 1) x = x * sigm(x); else if (mode == 2) x = sigm(x); y[n * 4 + e] = x; }
                    if (vt) {
                        const int hd = cb * 128 + cl0 - O_V;
                        bf16_t* vp = P + ((size_t)(row >> 11) * T + hd) * NP + O_V + (row & (T - 1));
#pragma unroll
                        for (int j = 0; j < 8; ++j) vp[(size_t)j * NP] = f2bf(y[j]);
                    } else {
                        u32x4 w; w.x = pk2(y[0], y[1]); w.y = pk2(y[2], y[3]); w.z = pk2(y[4], y[5]); w.w = pk2(y[6], y[7]);
                        *(u32x4*)(P + (size_t)row * NP + cb * 128 + cl0) = w;
                    }
                }
        }
    }
};

__device__ __forceinline__ float lerp_bf(const bf16_t* cur, const bf16_t* prv, float mu) { const float c = bf2f(*cur); const float p = prv ? bf2f(*prv) : 0.f; return c + (p - c) * mu; }

__device__ __forceinline__ void rw_prep_item(const Args& a, LAS unsigned char* wl  , int tt, int h, int lane) {
    unsigned char* ws = a.ws;
    const bf16_t* P = (const bf16_t*)(ws + WS_P);
    const int l15 = lane & 15, quad = lane >> 4;
    const bool sample = tt >= 1024;
    const int row_base = sample ? MP + (tt - 1024) * 16 : tt * 16;
    const float* mu = a.in[I_MU];
    bf16x8 Aw[2], Aa[2];
    {
        const int m = row_base + l15;
        const bf16_t* cur = P + (size_t)m * NP + O_SH;
        const bf16_t* prv = sample ? P + (size_t)(m + MS) * NP + O_SH : ((m & (T - 1)) ? cur - NP : nullptr);
#pragma unroll
        for (int which = 0; which < 2; ++which)
#pragma unroll
            for (int ks = 0; ks < 2; ++ks) {
                const int col = 3072 + which * 64 + ks * 32 + quad * 8;
                const u32x4 cw = *(const u32x4*)(cur + col); u32x4 pw = {0u, 0u, 0u, 0u}; if (prv) pw = *(const u32x4*)(prv + col);
                const f32x4 m0 = *(const f32x4*)(mu + col), m1 = *(const f32x4*)(mu + col + 4);
                float z[8];
                const unsigned cws[4] = {cw.x, cw.y, cw.z, cw.w}, pws[4] = {pw.x, pw.y, pw.z, pw.w};
#pragma unroll
                for (int j = 0; j < 4; ++j) {
                    const float c0 = bflo(cws[j]), c1 = bfhi(cws[j]), p0 = bflo(pws[j]), p1 = bfhi(pws[j]);
                    const float mm0 = (j < 2) ? m0[2 * j] : m1[2 * j - 4], mm1 = (j < 2) ? m0[2 * j + 1] : m1[2 * j - 3];
                    z[2 * j] = c0 + (p0 - c0) * mm0; z[2 * j + 1] = c1 + (p1 - c1) * mm1;
                }
                if (which == 0) {
#pragma unroll
                    for (int j = 0; j < 8; ++j) z[j] = 1.f - 2.f / (__expf(2.f * z[j]) + 1.f);
                }
                u32x4 o; o.x = pk2(z[0], z[1]); o.y = pk2(z[2], z[3]); o.z = pk2(z[4], z[5]); o.w = pk2(z[6], z[7]);
                if (which == 0) Aw[ks] = __builtin_bit_cast(bf16x8, o); else Aa[ks] = __builtin_bit_cast(bf16x8, o);
            }
    }
    const bf16_t* W2T = (const bf16_t*)(ws + WS_W2T); const bf16_t* A2T = (const bf16_t*)(ws + WS_A2T);
    unsigned char* rec = ws + WS_CH + ((size_t)((tt >> 7) * 16 + h) * 128 + (tt & 127)) * REC;
    LAS bf16_t* LA = (LAS bf16_t*)wl;
    LAS bf16_t* LR = LA + 16 * 72;
    LAS bf16_t* LB = LR + 16 * 72;
    LAS bf16_t* LK = LB + 16 * 72;
    LAS float* LN = (LAS float*)(wl + 9216);
    float tA[4][4], tBi[4][4], tBp[4][4];
    float ssq[4] = {0.f, 0.f, 0.f, 0.f}, bon[4] = {0.f, 0.f, 0.f, 0.f};
#pragma unroll
    for (int nt = 0; nt < 4; ++nt) {
        const int ch = h * 64 + nt * 16 + l15, cc = nt * 16 + l15;
        f32x4 cw = {0.f, 0.f, 0.f, 0.f}, ca = {0.f, 0.f, 0.f, 0.f};
#pragma unroll
        for (int ks = 0; ks < 2; ++ks) {
            const bf16x8 bw = *(const bf16x8*)(W2T + (size_t)ch * 64 + ks * 32 + quad * 8), ba = *(const bf16x8*)(A2T + (size_t)ch * 64 + ks * 32 + quad * 8);
            cw = MFMA32(Aw[ks], bw, cw); ca = MFMA32(Aa[ks], ba, ca);
        }
        const float w0 = a.in[I_W0][ch], a0 = a.in[I_A0][ch], k_k = a.in[I_KK][ch], k_a = a.in[I_KA][ch], r_k = a.in[I_RK][ch];
        const float mur = mu[ch], muk = mu[1024 + ch], muv = mu[2048 + ch];
        float lw[4], rr[4], kq[4], vv[4], aa4[4], kr4[4];
#pragma unroll
        for (int r = 0; r < 4; ++r) {
            const int m = row_base + quad * 4 + r;
            const bf16_t* cur = P + (size_t)m * NP + O_SH + ch;
            const bf16_t* prv = sample ? P + (size_t)(m + MS) * NP + O_SH + ch : ((m & (T - 1)) ? cur - NP : nullptr);
            const float r_ = lerp_bf(cur, prv, mur), k_ = lerp_bf(cur + 1024, prv ? prv + 1024 : nullptr, muk), v_ = lerp_bf(cur + 2048, prv ? prv + 2048 : nullptr, muv);
            lw[r] = -0.6065306597126334f * sigm(w0 + cw[r]);
            const float aa = sigm(a0 + ca[r]); aa4[r] = aa;
            const float kr = k_ * k_k; kr4[r] = kr; ssq[r] += kr * kr;
            const float kpp = k_ * (1.f + (aa - 1.f) * k_a); kq[r] = kpp;
            rr[r] = r_; vv[r] = v_; bon[r] += r_ * kpp * r_k;
        }
        if (sample) {
#pragma unroll
            for (int r = 0; r < 4; ++r) {
                const int i = (tt - 1024) * 16 + quad * 4 + r;
                float* o = (float*)(ws + WS_OPSS) + ((size_t)(i * 16 + h) * 6) * 64 + cc;
                o[0] = rr[r]; o[64] = __expf(lw[r]); o[128] = kq[r]; o[320] = vv[r];
                tA[nt][r] = kr4[r]; tBi[nt][r] = aa4[r] * kr4[r]; tBp[nt][r] = 0.f;
            }
        } else {
            float c[4]; c[0] = lw[0]; c[1] = c[0] + lw[1]; c[2] = c[1] + lw[2]; c[3] = c[2] + lw[3];
            const float tot = c[3];
            const float s1 = __shfl(tot, (lane - 16) & 63), s2 = __shfl(tot, (lane - 32) & 63), s3 = __shfl(tot, (lane - 48) & 63);
            const float off = (quad >= 1 ? s1 : 0.f) + (quad >= 2 ? s2 : 0.f) + (quad >= 3 ? s3 : 0.f);
            const float total = __shfl(c[3] + off, 48 + l15);
            float kqp[4];
#pragma unroll
            for (int r = 0; r < 4; ++r) {
                const float cum = c[r] + off, cumx = cum - lw[r];
                const float ea = __expf(cumx), er = __expf(cum), ei = __expf(-cum), ep = __expf(total - cum);
                const int tk = quad * 4 + r;
                LR[tk * 72 + cc] = f2bf(rr[r] * er); LK[tk * 72 + cc] = f2bf(kq[r] * ei);
                kqp[r] = kq[r] * ep;
                tA[nt][r] = kr4[r] * ea; tBi[nt][r] = aa4[r] * kr4[r] * ei; tBp[nt][r] = aa4[r] * kr4[r] * ep;
            }
            *(u32x2*)(rec + R_KP + cc * 32 + quad * 8) = (u32x2){pk2(kqp[0], kqp[1]), pk2(kqp[2], kqp[3])};
            *(u32x2*)(rec + R_VT + cc * 32 + quad * 8) = (u32x2){pk2(vv[0], vv[1]), pk2(vv[2], vv[3])};
            if (quad == 0) *(float*)(rec + R_WC + cc * 4) = __expf(total);
        }
        asm volatile("" ::: "memory");
    }
    float inv[4];
#pragma unroll
    for (int r = 0; r < 4; ++r) {
        float s = ssq[r], b = bon[r];
#pragma unroll
        for (int o = 1; o < 16; o <<= 1) { s += __shfl_xor(s, o); b += __shfl_xor(b, o); }
        inv[r] = 1.f / fmaxf(sqrtf(s), 1e-12f);
        if (l15 == 0) ((float*)(ws + WS_BC))[(size_t)(row_base + quad * 4 + r) * 16 + h] = b;
    }
    if (sample) {
#pragma unroll
        for (int nt = 0; nt < 4; ++nt)
#pragma unroll
            for (int r = 0; r < 4; ++r) {
                const int i = (tt - 1024) * 16 + quad * 4 + r;
                float* o = (float*)(ws + WS_OPSS) + ((size_t)(i * 16 + h) * 6) * 64 + nt * 16 + l15;
                o[192] = tA[nt][r] * inv[r]; o[256] = tBi[nt][r] * inv[r];
            }
        return;
    }
#pragma unroll
    for (int nt = 0; nt < 4; ++nt) {
        const int cc = nt * 16 + l15;
        float bp[4];
#pragma unroll
        for (int r = 0; r < 4; ++r) { const int tk = quad * 4 + r;
            LA[tk * 72 + cc] = f2bf(-tA[nt][r] * inv[r]); LB[tk * 72 + cc] = f2bf(tBi[nt][r] * inv[r]); bp[r] = tBp[nt][r] * inv[r]; }
        *(u32x2*)(rec + R_BP + cc * 32 + quad * 8) = (u32x2){pk2(bp[0], bp[1]), pk2(bp[2], bp[3])};
    }
    LDS_WAIT();
#pragma unroll
    for (int i = 0; i < 2; ++i) { const int idx = lane + 64 * i, rr = idx >> 3, c8 = (idx & 7) * 8;
        *(u32x4*)(rec + R_AT + rr * 128 + c8 * 2) = *(const LAS u32x4*)(LA + rr * 72 + c8);
        *(u32x4*)(rec + R_RT + rr * 128 + c8 * 2) = *(const LAS u32x4*)(LR + rr * 72 + c8); }
    f32x4 nab = {0.f, 0.f, 0.f, 0.f}, nak = nab, nrb = nab, nrk = nab;
#pragma unroll
    for (int ks = 0; ks < 2; ++ks) {
        const bf16x8 fa = *(const LAS bf16x8*)(LA + l15 * 72 + ks * 32 + quad * 8), fr_ = *(const LAS bf16x8*)(LR + l15 * 72 + ks * 32 + quad * 8);
        const bf16x8 fb = *(const LAS bf16x8*)(LB + l15 * 72 + ks * 32 + quad * 8), fk = *(const LAS bf16x8*)(LK + l15 * 72 + ks * 32 + quad * 8);
        nab = MFMA32(fa, fb, nab); nak = MFMA32(fa, fk, nak); nrb = MFMA32(fr_, fb, nrb); nrk = MFMA32(fr_, fk, nrk);
    }
#pragma unroll
    for (int r = 0; r < 4; ++r) {
        const int t = quad * 4 + r, j = l15;
        const float vab = (j < t) ? nab[r] : 0.f, vak = (j < t) ? nak[r] : 0.f, vrb = (j <= t) ? nrb[r] : 0.f, vrk = (j <= t) ? nrk[r] : 0.f;
        LN[t * 16 + j] = vab;
        *(bf16_t*)(rec + R_AAK + (t * 16 + j) * 2) = f2bf(vak);
        *(bf16_t*)(rec + R_ARB + (t * 16 + j) * 2) = f2bf(vrb);
        *(bf16_t*)(rec + R_ARK + (t * 16 + j) * 2) = f2bf(vrk);
    }
    LDS_WAIT();
    if (lane < 16) {
        float tc[16];
#pragma unroll
        for (int t = 0; t < 16; ++t) {
            float s = (t == lane) ? 1.f : 0.f;
#pragma unroll
            for (int j = 0; j < t; ++j) s += LN[t * 16 + j] * tc[j];
            tc[t] = s;
            *(bf16_t*)(rec + R_TT + (t * 16 + lane) * 2) = f2bf(s);
        }
    }
    LDS_WAIT();
}

__device__ __forceinline__ bf16x8 k16(u32x2 v) { const u32x4 w = {v.x, v.y, 0u, 0u}; return __builtin_bit_cast(bf16x8, w); }
#define SCAN_DECL(F) bf16x8 F##_at0, F##_at1, F##_rt0, F##_rt1; u32x2 F##_aak, F##_tt, F##_arb, F##_ark, F##_vt, F##_bp0, F##_bp1, F##_bp2, F##_bp3, F##_kp0, F##_kp1, F##_kp2, F##_kp3; float F##_wc0, F##_wc1, F##_wc2, F##_wc3
#define SCAN_LOAD(F, REC_) do { const unsigned char* rec_ = (REC_); \
    F##_at0 = *(const bf16x8*)(rec_ + R_AT + o_nat); F##_at1 = *(const bf16x8*)(rec_ + R_AT + o_nat + 64); \
    F##_rt0 = *(const bf16x8*)(rec_ + R_RT + o_nat); F##_rt1 = *(const bf16x8*)(rec_ + R_RT + o_nat + 64); \
    F##_aak = *(const u32x2*)(rec_ + R_AAK + o_sm); F##_tt = *(const u32x2*)(rec_ + R_TT + o_sm); F##_arb = *(const u32x2*)(rec_ + R_ARB + o_sm); F##_ark = *(const u32x2*)(rec_ + R_ARK + o_sm); \
    F##_vt = *(const u32x2*)(rec_ + R_VT + vt * 512 + o_sm); \
    F##_bp0 = *(const u32x2*)(rec_ + R_BP + o_sm); F##_bp1 = *(const u32x2*)(rec_ + R_BP + 512 + o_sm); F##_bp2 = *(const u32x2*)(rec_ + R_BP + 1024 + o_sm); F##_bp3 = *(const u32x2*)(rec_ + R_BP + 1536 + o_sm); \
    F##_kp0 = *(const u32x2*)(rec_ + R_KP + o_sm); F##_kp1 = *(const u32x2*)(rec_ + R_KP + 512 + o_sm); F##_kp2 = *(const u32x2*)(rec_ + R_KP + 1024 + o_sm); F##_kp3 = *(const u32x2*)(rec_ + R_KP + 1536 + o_sm); \
    F##_wc0 = *(const float*)(rec_ + R_WC + l15 * 4); F##_wc1 = *(const float*)(rec_ + R_WC + 64 + l15 * 4); F##_wc2 = *(const float*)(rec_ + R_WC + 128 + l15 * 4); F##_wc3 = *(const float*)(rec_ + R_WC + 192 + l15 * 4); } while (0)
#define SCAN_UPD(NT, BP, KP, WC) do { f32x4 sn = S##NT * (WC); sn = MFMA32(ua, k16(BP), sn); sn = MFMA32(vtf, k16(KP), sn); S##NT = sn; \
    _Pragma("unroll") for (int r = 0; r < 4; ++r) Sb[(quad * 4 + r) * 72 + NT * 16 + l15] = f2bf(sn[r]); } while (0)
#define SCAN_STEP(F, N, CH) do { const int ch_ = (CH); \
    SCAN_LOAD(N, rec0 + (size_t)(ch_ < 126 ? ch_ + 2 : 127) * REC); \
    const bf16x8 sa0 = *(const LAS bf16x8*)(Sb + l15 * 72 + quad * 8), sa1 = *(const LAS bf16x8*)(Sb + l15 * 72 + 32 + quad * 8); \
    const bf16x8 vtf = k16(F##_vt); const f32x4 z = {0.f, 0.f, 0.f, 0.f}; \
    f32x4 Y = MFMA32(sa0, F##_at0, z); Y = MFMA32(sa1, F##_at1, Y); Y = MFMA32(vtf, k16(F##_aak), Y); \
    _Pragma("unroll") for (int r = 0; r < 4; ++r) Yb[(quad * 4 + r) * 16 + l15] = f2bf(Y[r]); \
    LDS_WAIT(); \
    const bf16x8 ya = k16(*(const LAS u32x2*)(Yb + l15 * 16 + quad * 4)); \
    f32x4 U = MFMA32(ya, k16(F##_tt), z); \
    _Pragma("unroll") for (int r = 0; r < 4; ++r) Ub[(quad * 4 + r) * 16 + l15] = f2bf(U[r]); \
    LDS_WAIT(); \
    const bf16x8 ua = k16(*(const LAS u32x2*)(Ub + l15 * 16 + quad * 4)); \
    f32x4 O = MFMA32(sa0, F##_rt0, z); O = MFMA32(sa1, F##_rt1, O); O = MFMA32(ua, k16(F##_arb), O); O = MFMA32(vtf, k16(F##_ark), O); \
    *(u32x2*)(ob + (size_t)(ch_ * 16 + l15) * D) = (u32x2){pk2(O[0], O[1]), pk2(O[2], O[3])}; \
    SCAN_UPD(0, F##_bp0, F##_kp0, F##_wc0); SCAN_UPD(1, F##_bp1, F##_kp1, F##_wc1); SCAN_UPD(2, F##_bp2, F##_kp2, F##_wc2); SCAN_UPD(3, F##_bp3, F##_kp3, F##_wc3); \
    LDS_WAIT(); __builtin_amdgcn_sched_barrier(0); } while (0)
__device__ __forceinline__ void rw_scan_task(const Args& a, LAS unsigned char* wl  , int b, int h, int vt, int lane) {
    unsigned char* ws = a.ws;
    const int l15 = lane & 15, quad = lane >> 4;
    LAS bf16_t* Sb = (LAS bf16_t*)wl;
    LAS bf16_t* Yb = (LAS bf16_t*)(wl + 2304);
    LAS bf16_t* Ub = (LAS bf16_t*)(wl + 2304 + 512);
    const int o_nat = l15 * 128 + quad * 16, o_sm = l15 * 32 + quad * 8;
    const unsigned char* rec0 = ws + WS_CH + (size_t)((b * 16 + h) * 128) * REC;
    bf16_t* ob = (bf16_t*)(ws + WS_OB) + (size_t)(b * T) * D + h * 64 + vt * 16 + quad * 4;
    f32x4 S0 = {0.f, 0.f, 0.f, 0.f}, S1 = S0, S2 = S0, S3 = S0;
#pragma unroll
    for (int nt = 0; nt < 4; ++nt)
#pragma unroll
        for (int r = 0; r < 4; ++r) Sb[(quad * 4 + r) * 72 + nt * 16 + l15] = 0;
    LDS_WAIT();
    SCAN_DECL(f0); SCAN_DECL(f1); SCAN_DECL(f2);
    SCAN_LOAD(f0, rec0); SCAN_LOAD(f1, rec0 + REC);
    for (int ch = 0; ch < 126; ch += 3) { SCAN_STEP(f0, f2, ch); SCAN_STEP(f1, f0, ch + 1); SCAN_STEP(f2, f1, ch + 2); }
    SCAN_STEP(f0, f2, 126); SCAN_STEP(f1, f0, 127);
    float* so = a.out + OUT_RWP + (size_t)((b * 16 + h) * 64 + vt * 16) * 64;
#pragma unroll
    for (int r = 0; r < 4; ++r) { so[(quad * 4 + r) * 64 + l15] = S0[r]; so[(quad * 4 + r) * 64 + 16 + l15] = S1[r]; so[(quad * 4 + r) * 64 + 32 + l15] = S2[r]; so[(quad * 4 + r) * 64 + 48 + l15] = S3[r]; }
}

__device__ __forceinline__ void rw_sample_wave(const Args& a, int i, int h, int lane) {
    unsigned char* ws = a.ws;
    const float* s0 = a.in[I_SRW] + ((size_t)(i * 16 + h) * 64 + lane) * 64;
    const float* op = (const float*)(ws + WS_OPSS) + (size_t)(i * 16 + h) * 6 * 64;
    float s[64];
#pragma unroll
    for (int j = 0; j < 16; ++j) { const f32x4 t = ((const f32x4*)s0)[j]; s[4 * j] = t.x; s[4 * j + 1] = t.y; s[4 * j + 2] = t.z; s[4 * j + 3] = t.w; }
    const float r_l = op[lane], w_l = op[64 + lane], k_l = op[128 + lane], kk_l = op[192 + lane], b_l = op[256 + lane], v = op[320 + lane];
#define RL(x, j) __builtin_bit_cast(float, __builtin_amdgcn_readlane(__builtin_bit_cast(int, (x)), (j)))
    float sk = 0.f;
#pragma unroll
    for (int j = 0; j < 64; ++j) sk += s[j] * RL(kk_l, j);
    float o = 0.f;
#pragma unroll
    for (int j = 0; j < 64; ++j) { s[j] = s[j] * RL(w_l, j) - sk * RL(b_l, j) + v * RL(k_l, j); o += s[j] * RL(r_l, j); }
#undef RL
    float* so = a.out + OUT_RWS + ((size_t)(i * 16 + h) * 64 + lane) * 64;
#pragma unroll
    for (int j = 0; j < 16; ++j) ((f32x4*)so)[j] = (f32x4){s[4 * j], s[4 * j + 1], s[4 * j + 2], s[4 * j + 3]};
    ((bf16_t*)(ws + WS_OB))[(size_t)(MP + i) * D + h * 64 + lane] = f2bf(o);
}

constexpr int KN_LD = 264, VS_LD = 136, SS_LD = 264;
constexpr int L_KN = 0, L_VS = 128 * KN_LD * 2  , L_SS = L_VS + 64 * VS_LD * 2  , L_RET_END = L_SS + 64 * SS_LD * 2  ;
__device__ __forceinline__ void ret_unit(const Args& a, LAS unsigned char* lds, int unit, int tid) {
    unsigned char* ws = a.ws;
    const bf16_t* P = (const bf16_t*)(ws + WS_P);
    const int dvs = unit & 7, h = (unit >> 3) & 3, b = unit >> 5;
    const int wave = tid >> 6, lane = tid & 63, l15 = lane & 15, quad = lane >> 4;
    LAS bf16_t* KN = (LAS bf16_t*)(lds + L_KN); LAS bf16_t* VS = (LAS bf16_t*)(lds + L_VS); LAS bf16_t* SS = (LAS bf16_t*)(lds + L_SS);
    const float g = 1.f - exp2f(-5.f - (float)h), l2g = __log2f(g);
    const float gC = exp2f(128.f * l2g), ginvC = exp2f(-128.f * l2g);
    const bf16_t* KT = (const bf16_t*)(ws + WS_KT) + (size_t)(b * 4 + h) * 256 * T;
    f32x4 sacc[2][4];
#pragma unroll
    for (int n = 0; n < 2; ++n)
#pragma unroll
        for (int d = 0; d < 4; ++d) sacc[n][d] = (f32x4){0.f, 0.f, 0.f, 0.f};
    for (int i = tid; i < 64 * SS_LD / 2; i += 512) ((LAS unsigned*)SS)[i] = 0u;
    const int it = wave;
    u32x4 stk[8], stv[2];
#define RET_ISSUE(CC) do { const int tok0_ = b * T + (CC) * 128; \
        _Pragma("unroll") for (int i = 0; i < 8; ++i) { const int idx = tid + 512 * i, r = idx >> 5, c8 = (idx & 31) * 8; stk[i] = *(const u32x4*)(P + (size_t)(tok0_ + r) * NP + O_K + h * 256 + c8); } \
        _Pragma("unroll") for (int i = 0; i < 2; ++i) { const int idx = tid + 512 * i, r = idx >> 4, c8 = (idx & 15) * 8; stv[i] = *(const u32x4*)(P + (size_t)(b * T + h * 512 + dvs * 64 + r) * NP + O_V + (CC) * 128 + c8); } } while (0)
    RET_ISSUE(0);
    for (int c = 0; c < 16; ++c) {
        const int tok0 = b * T + c * 128;
        bf16x8 qf[8];
#pragma unroll
        for (int ks = 0; ks < 8; ++ks) qf[ks] = *(const bf16x8*)(P + (size_t)(tok0 + it * 16 + l15) * NP + h * 256 + ks * 32 + quad * 8);
#pragma unroll
        for (int i = 0; i < 8; ++i) { const int idx = tid + 512 * i, r = idx >> 5, c8 = (idx & 31) * 8; *(LAS u32x4*)(KN + r * KN_LD + c8) = stk[i]; }
#pragma unroll
        for (int i = 0; i < 2; ++i) { const int idx = tid + 512 * i, r = idx >> 4, c8 = (idx & 15) * 8; *(LAS u32x4*)(VS + r * VS_LD + c8) = stv[i]; }
        __syncthreads();
        bf16x8 ktf[2][4];
#pragma unroll
        for (int n = 0; n < 2; ++n)
#pragma unroll
            for (int ks = 0; ks < 4; ++ks) ktf[n][ks] = *(const bf16x8*)(KT + (size_t)((2 * wave + n) * 16 + l15) * T + c * 128 + ks * 32 + quad * 8);
        if (c < 15) RET_ISSUE(c + 1);
        f32x4 oacc[4];
#pragma unroll
        for (int d = 0; d < 4; ++d) oacc[d] = (f32x4){0.f, 0.f, 0.f, 0.f};
#pragma unroll
        for (int ks = 0; ks < 8; ++ks)
#pragma unroll
            for (int d = 0; d < 4; ++d) { const bf16x8 sb = *(const LAS bf16x8*)(SS + (d * 16 + l15) * SS_LD + ks * 32 + quad * 8); oacc[d] = MFMA32(qf[ks], sb, oacc[d]); }
#pragma unroll
        for (int p = 0; p < 4; ++p) {
            if (2 * p <= it) {
                f32x4 s0 = {0.f, 0.f, 0.f, 0.f}, s1 = {0.f, 0.f, 0.f, 0.f};
#pragma unroll
                for (int ks = 0; ks < 8; ++ks) { const bf16x8 ka = *(const LAS bf16x8*)(KN + ((2 * p) * 16 + l15) * KN_LD + ks * 32 + quad * 8); s0 = MFMA32(ka, qf[ks], s0); }
                if (2 * p + 1 <= it) {
#pragma unroll
                    for (int ks = 0; ks < 8; ++ks) { const bf16x8 ka = *(const LAS bf16x8*)(KN + ((2 * p + 1) * 16 + l15) * KN_LD + ks * 32 + quad * 8); s1 = MFMA32(ka, qf[ks], s1); }
                }
#pragma unroll
                for (int r = 0; r < 4; ++r) {
                    const int jl = quad * 4 + r;
                    s0[r] = (2 * p == it && jl > l15) ? 0.f : s0[r] * ginvC;
                    s1[r] = (2 * p + 1 > it || (2 * p + 1 == it && jl > l15)) ? 0.f : s1[r] * ginvC;
                }
                u32x4 aw; aw.x = pk2(s0[0], s0[1]); aw.y = pk2(s0[2], s0[3]); aw.z = pk2(s1[0], s1[1]); aw.w = pk2(s1[2], s1[3]);
                const bf16x8 af = __builtin_bit_cast(bf16x8, aw);
#pragma unroll
                for (int d = 0; d < 4; ++d) {
                    const LAS bf16_t* vr = VS + (d * 16 + l15) * VS_LD + 32 * p + quad * 4;
                    const u32x2 lo = *(const LAS u32x2*)vr, hi = *(const LAS u32x2*)(vr + 16);
                    const u32x4 bw = {lo.x, lo.y, hi.x, hi.y};
                    oacc[d] = MFMA32(af, __builtin_bit_cast(bf16x8, bw), oacc[d]);
                }
            }
        }
        {
            bf16_t* OA = (bf16_t*)(ws + WS_OA); float* SQA = (float*)(ws + WS_SQA);
#pragma unroll
            for (int r = 0; r < 4; ++r) {
                const int tok = tok0 + it * 16 + quad * 4 + r;
                float ss = 0.f;
#pragma unroll
                for (int d = 0; d < 4; ++d) { const float v = oacc[d][r]; ss += v * v; OA[(size_t)tok * 2048 + h * 512 + dvs * 64 + d * 16 + l15] = f2bf(v); }
#pragma unroll
                for (int o = 1; o < 16; o <<= 1) ss += __shfl_xor(ss, o);
                if (l15 == 0) SQA[(size_t)tok * 32 + h * 8 + dvs] = ss;
            }
        }
        __syncthreads();
#pragma unroll
        for (int n = 0; n < 2; ++n)
#pragma unroll
            for (int d = 0; d < 4; ++d) {
                f32x4 s = sacc[n][d] * gC;
#pragma unroll
                for (int ks = 0; ks < 4; ++ks) { const bf16x8 va = *(const LAS bf16x8*)(VS + (d * 16 + l15) * VS_LD + ks * 32 + quad * 8); s = MFMA32(va, ktf[n][ks], s); }
                sacc[n][d] = s;
#pragma unroll
                for (int r = 0; r < 4; ++r) SS[(d * 16 + quad * 4 + r) * SS_LD + (2 * wave + n) * 16 + l15] = f2bf(s[r]);
            }
        __syncthreads();
    }
    float* so = a.out + OUT_RETP + (size_t)(b * 4 + h) * 256 * 512;
#pragma unroll
    for (int n = 0; n < 2; ++n)
#pragma unroll
        for (int d = 0; d < 4; ++d) *(f32x4*)(so + (size_t)((2 * wave + n) * 16 + l15) * 512 + dvs * 64 + d * 16 + quad * 4) = sacc[n][d];
}
#undef RET_ISSUE

__device__ __forceinline__ void ret_sample_unit(const Args& a, LAS unsigned char* lds, int i, int h, int tid) {
    unsigned char* ws = a.ws;
    const bf16_t* Prow = (const bf16_t*)(ws + WS_P) + (size_t)(MP + i) * NP;
    LAS float* Q = (LAS float*)lds; LAS float* Kh = Q + 256; LAS float* RED = Kh + 256; LAS float* OS = RED + 16;
    const float g = 1.f - exp2f(-5.f - (float)h);
    const int lane = tid & 63, wave = tid >> 6;
    float qk = 0.f;
    if (tid < 256) { const float q = bf2f(Prow[h * 256 + tid]), k = bf2f(Prow[O_K + h * 256 + tid]); Q[tid] = q; Kh[tid] = k; qk = q * k; }
    qk = wave_sum(qk);
    if (lane == 0) RED[wave] = qk;
    __syncthreads();
    const float qkv = (RED[0] + RED[1] + RED[2] + RED[3]) / g;
    const int dkg = tid >> 7, dv4 = 4 * (tid & 127);
    const u32x2 vw = *(const u32x2*)(Prow + O_V + h * 512 + dv4);
    const f32x4 v = {bflo(vw.x), bfhi(vw.x), bflo(vw.y), bfhi(vw.y)};
    const float* s0 = a.in[I_SRET] + (size_t)(i * 4 + h) * 256 * 512 + dv4;
    float* s1 = a.out + OUT_RETS + (size_t)(i * 4 + h) * 256 * 512 + dv4;
    f32x4 o = {0.f, 0.f, 0.f, 0.f};
#pragma unroll 8
    for (int j = 0; j < 64; ++j) {
        const int dk = dkg * 64 + j;
        const f32x4 s = __builtin_nontemporal_load((const f32x4*)(s0 + (size_t)dk * 512));
        o += s * Q[dk];
        __builtin_nontemporal_store(s * g + v * Kh[dk], (f32x4*)(s1 + (size_t)dk * 512));
    }
    *(LAS f32x4*)(OS + dkg * 512 + dv4) = o;
    __syncthreads();
    float y[4] = {0.f, 0.f, 0.f, 0.f}; float ss = 0.f;
    if (tid < 128) {
        const f32x4 t = *(LAS f32x4*)(OS + dv4) + *(LAS f32x4*)(OS + 512 + dv4) + *(LAS f32x4*)(OS + 1024 + dv4) + *(LAS f32x4*)(OS + 1536 + dv4) + v * qkv;
        y[0] = t.x; y[1] = t.y; y[2] = t.z; y[3] = t.w; ss = t.x * t.x + t.y * t.y + t.z * t.z + t.w * t.w;
    }
    ss = wave_sum(ss);
    if (lane == 0) RED[8 + wave] = ss;
    __syncthreads();
    if (tid < 128) {
        const float rs = 1.0f / sqrtf((RED[8] + RED[9]) * (1.f / 512.f) + EPS);
        const u32x2 gw = *(const u32x2*)(Prow + O_GA + h * 512 + dv4);
        u32x2 ow; ow.x = pk2(y[0] * rs * bflo(gw.x), y[1] * rs * bfhi(gw.x)); ow.y = pk2(y[2] * rs * bflo(gw.y), y[3] * rs * bfhi(gw.y));
        *(u32x2*)((bf16_t*)(ws + WS_OA) + (size_t)(MP + i) * 2048 + h * 512 + dv4) = ow;
    }
    __syncthreads();
}

__device__ __forceinline__ void ret_sample_wave(const Args& a, int i, int h, int lane) {
    unsigned char* ws = a.ws;
    const bf16_t* Prow = (const bf16_t*)(ws + WS_P) + (size_t)(MP + i) * NP;
    const float g = 1.f - exp2f(-5.f - (float)h);
    float q[4], k[4]; float qk = 0.f;
#pragma unroll
    for (int j = 0; j < 4; ++j) { q[j] = bf2f(Prow[h * 256 + 64 * j + lane]); k[j] = bf2f(Prow[O_K + h * 256 + 64 * j + lane]); qk += q[j] * k[j]; }
    const float qkv = wave_sum(qk) / g;
    f32x4 v[2];
#pragma unroll
    for (int e = 0; e < 2; ++e) { const u32x2 vw = *(const u32x2*)(Prow + O_V + h * 512 + e * 256 + lane * 4); v[e] = (f32x4){bflo(vw.x), bfhi(vw.x), bflo(vw.y), bfhi(vw.y)}; }
    const float* s0 = a.in[I_SRET] + (size_t)(i * 4 + h) * 256 * 512 + lane * 4;
    float* s1 = a.out + OUT_RETS + (size_t)(i * 4 + h) * 256 * 512 + lane * 4;
    f32x4 o[2] = {{0.f, 0.f, 0.f, 0.f}, {0.f, 0.f, 0.f, 0.f}};
#pragma unroll
    for (int j = 0; j < 4; ++j) {
        for (int d0 = 0; d0 < 64; d0 += 16) {
            f32x4 sv[16][2];
#pragma unroll
            for (int d = 0; d < 16; ++d)
#pragma unroll
                for (int e = 0; e < 2; ++e) sv[d][e] = __builtin_nontemporal_load((const f32x4*)(s0 + (size_t)(64 * j + d0 + d) * 512 + e * 256));
#pragma unroll
            for (int d = 0; d < 16; ++d) {
                const float qd = __builtin_bit_cast(float, __builtin_amdgcn_readlane(__builtin_bit_cast(int, q[j]), d0 + d));
                const float kd = __builtin_bit_cast(float, __builtin_amdgcn_readlane(__builtin_bit_cast(int, k[j]), d0 + d));
#pragma unroll
                for (int e = 0; e < 2; ++e) { o[e] += sv[d][e] * qd; __builtin_nontemporal_store(sv[d][e] * g + v[e] * kd, (f32x4*)(s1 + (size_t)(64 * j + d0 + d) * 512 + e * 256)); }
            }
        }
    }
    float ss = 0.f;
#pragma unroll
    for (int e = 0; e < 2; ++e) { o[e] += v[e] * qkv; ss += (o[e].x * o[e].x + o[e].y * o[e].y) + (o[e].z * o[e].z + o[e].w * o[e].w); }
    const float rs = 1.0f / sqrtf(wave_sum(ss) * (1.f / 512.f) + EPS);
#pragma unroll
    for (int e = 0; e < 2; ++e) { const u32x2 gw = *(const u32x2*)(Prow + O_GA + h * 512 + e * 256 + lane * 4);
        u32x2 ow; ow.x = pk2(o[e].x * rs * bflo(gw.x), o[e].y * rs * bfhi(gw.x)); ow.y = pk2(o[e].z * rs * bflo(gw.y), o[e].w * rs * bfhi(gw.y));
        *(u32x2*)((bf16_t*)(ws + WS_OA) + (size_t)(MP + i) * 2048 + h * 512 + e * 256 + lane * 4) = ow; }
}

__device__ __forceinline__ void phase25_row(const Args& a, int m, int lane) {
    unsigned char* ws = a.ws;
    const bf16_t* Prow = (const bf16_t*)(ws + WS_P) + (size_t)m * NP;
    bf16_t* oa = (bf16_t*)(ws + WS_OA) + (size_t)m * 2048;
    const float* sq = (const float*)(ws + WS_SQA) + (size_t)m * 32;
    const bool prompt = m < MP;
    f32x4 sqv[8]; u32x4 ow[4], gw4[4];
    if (prompt) {
#pragma unroll
        for (int j = 0; j < 8; ++j) sqv[j] = ((const f32x4*)sq)[j];
#pragma unroll
        for (int hh = 0; hh < 4; ++hh) { ow[hh] = *(const u32x4*)(oa + hh * 512 + lane * 8); gw4[hh] = *(const u32x4*)(Prow + O_GA + hh * 512 + lane * 8); }
    }
    const bf16_t* ob = (const bf16_t*)(ws + WS_OB) + (size_t)m * D + lane * 16;
    f32x4 ov[4];
    { const u32x4 w0 = ((const u32x4*)ob)[0], w1 = ((const u32x4*)ob)[1];
      ov[0] = (f32x4){bflo(w0.x), bfhi(w0.x), bflo(w0.y), bfhi(w0.y)}; ov[1] = (f32x4){bflo(w0.z), bfhi(w0.z), bflo(w0.w), bfhi(w0.w)};
      ov[2] = (f32x4){bflo(w1.x), bfhi(w1.x), bflo(w1.y), bfhi(w1.y)}; ov[3] = (f32x4){bflo(w1.z), bfhi(w1.z), bflo(w1.w), bfhi(w1.w)}; }
    const float bc = ((const float*)(ws + WS_BC))[(size_t)m * 16 + (lane >> 2)];
    const bf16_t* cur = Prow + O_SH + 2048 + lane * 16;
    const bool hasp = (m >= MP) || (m & (T - 1));
    const bf16_t* prv = (m >= MP) ? cur + (size_t)MS * NP : cur - NP;
    u32x4 cw[2], pw[2] = {{0u, 0u, 0u, 0u}, {0u, 0u, 0u, 0u}}, gbw[2];
    cw[0] = ((const u32x4*)cur)[0]; cw[1] = ((const u32x4*)cur)[1];
    if (hasp) { pw[0] = ((const u32x4*)prv)[0]; pw[1] = ((const u32x4*)prv)[1]; }
    gbw[0] = ((const u32x4*)(Prow + O_GB + lane * 16))[0]; gbw[1] = ((const u32x4*)(Prow + O_GB + lane * 16))[1];
    f32x4 lw4[4], lb4[4], mu4[4];
#pragma unroll
    for (int j = 0; j < 4; ++j) { lw4[j] = ((const f32x4*)(a.in[I_LNW] + lane * 16))[j]; lb4[j] = ((const f32x4*)(a.in[I_LNB] + lane * 16))[j]; mu4[j] = ((const f32x4*)(a.in[I_MU] + 2048 + lane * 16))[j]; }
    if (prompt) {
#pragma unroll
        for (int hh = 0; hh < 4; ++hh) {
            const f32x4 s0 = sqv[2 * hh], s1 = sqv[2 * hh + 1];
            const float rs = 1.0f / sqrtf(((s0.x + s0.y) + (s0.z + s0.w) + (s1.x + s1.y) + (s1.z + s1.w)) * (1.f / 512.f) + EPS);
            const u32x4 o4 = ow[hh], g4 = gw4[hh];
            u32x4 r;
            r.x = pk2(bflo(o4.x) * rs * bflo(g4.x), bfhi(o4.x) * rs * bfhi(g4.x)); r.y = pk2(bflo(o4.y) * rs * bflo(g4.y), bfhi(o4.y) * rs * bfhi(g4.y));
            r.z = pk2(bflo(o4.z) * rs * bflo(g4.z), bfhi(o4.z) * rs * bfhi(g4.z)); r.w = pk2(bflo(o4.w) * rs * bflo(g4.w), bfhi(o4.w) * rs * bfhi(g4.w));
            *(u32x4*)(oa + hh * 512 + lane * 8) = r;
        }
    }
    float o[16], lw[16], lb[16], mu[16];
#pragma unroll
    for (int j = 0; j < 4; ++j) { o[4 * j] = ov[j].x; o[4 * j + 1] = ov[j].y; o[4 * j + 2] = ov[j].z; o[4 * j + 3] = ov[j].w;
        lw[4 * j] = lw4[j].x; lw[4 * j + 1] = lw4[j].y; lw[4 * j + 2] = lw4[j].z; lw[4 * j + 3] = lw4[j].w;
        lb[4 * j] = lb4[j].x; lb[4 * j + 1] = lb4[j].y; lb[4 * j + 2] = lb4[j].z; lb[4 * j + 3] = lb4[j].w;
        mu[4 * j] = mu4[j].x; mu[4 * j + 1] = mu4[j].y; mu[4 * j + 2] = mu4[j].z; mu[4 * j + 3] = mu4[j].w; }
    float s = 0.f;
#pragma unroll
    for (int j = 0; j < 16; ++j) s += o[j];
    s += __shfl_xor(s, 1); s += __shfl_xor(s, 2);
    const float mean = s * (1.f / 64.f);
    float q = 0.f;
#pragma unroll
    for (int j = 0; j < 16; ++j) { const float d = o[j] - mean; q += d * d; }
    q += __shfl_xor(q, 1); q += __shfl_xor(q, 2);
    const float rstd = 1.0f / sqrtf(q * (1.f / 64.f) + 64e-5f);
    const unsigned cws[8] = {cw[0].x, cw[0].y, cw[0].z, cw[0].w, cw[1].x, cw[1].y, cw[1].z, cw[1].w};
    const unsigned pws[8] = {pw[0].x, pw[0].y, pw[0].z, pw[0].w, pw[1].x, pw[1].y, pw[1].z, pw[1].w};
    const unsigned gws[8] = {gbw[0].x, gbw[0].y, gbw[0].z, gbw[0].w, gbw[1].x, gbw[1].y, gbw[1].z, gbw[1].w};
    unsigned outw[8];
#pragma unroll
    for (int j = 0; j < 8; ++j) {
        const float c0 = bflo(cws[j]), c1 = bfhi(cws[j]), p0 = bflo(pws[j]), p1 = bfhi(pws[j]);
        const float v0 = c0 + (p0 - c0) * mu[2 * j], v1 = c1 + (p1 - c1) * mu[2 * j + 1];
        const float y0 = ((o[2 * j] - mean) * rstd * lw[2 * j] + lb[2 * j] + bc * v0) * bflo(gws[j]);
        const float y1 = ((o[2 * j + 1] - mean) * rstd * lw[2 * j + 1] + lb[2 * j + 1] + bc * v1) * bfhi(gws[j]);
        outw[j] = pk2(y0, y1);
    }
    bf16_t* yb = (bf16_t*)(ws + WS_H) + (size_t)m * D + lane * 16;
    *(u32x4*)yb = (u32x4){outw[0], outw[1], outw[2], outw[3]}; *(u32x4*)(yb + 8) = (u32x4){outw[4], outw[5], outw[6], outw[7]};
}

struct EpiT1 {
    static constexpr bool PERM = false;
    const bf16_t* P; bf16_t* T1;
    __device__ __forceinline__ void operator()(const f32x4 (&acc)[2][2][4][2], const Unit& u, int wr, int wc, int fr, int fq) const {
        const int row0 = u.pm * 256 + wr * 64 + fr, col0 = u.pn * 256 + wc * 32 + 4 * fq;
#pragma unroll
        for (int ai = 0; ai < 2; ++ai)
#pragma unroll
            for (int m = 0; m < 4; ++m) { const int row = row0 + ai * 128 + m * 16; if (row >= MR) continue;
#pragma unroll
                for (int bj = 0; bj < 2; ++bj)
#pragma unroll
                    for (int n = 0; n < 2; ++n) { const int col = col0 + bj * 128 + n * 16;
                        const u32x2 gw = *(const u32x2*)(P + (size_t)row * NP + O_MA + col);
                        const f32x4 gt = {bflo(gw.x), bfhi(gw.x), bflo(gw.y), bfhi(gw.y)};
                        const f32x4 t = acc[ai][bj][m][n] * gt; *(u32x2*)(T1 + (size_t)row * D + col) = (u32x2){pk2(t.x, t.y), pk2(t.z, t.w)}; } asm volatile("" ::: "memory"); }
    }
};
struct EpiMG {
    static constexpr bool PERM = false;
    const bf16_t* P; const bf16_t* T1; bf16_t* MG;
    __device__ __forceinline__ void operator()(const f32x4 (&acc)[2][2][4][2], const Unit& u, int wr, int wc, int fr, int fq) const {
        const int row0 = u.pm * 256 + wr * 64 + fr, col0 = u.pn * 256 + wc * 32 + 4 * fq;
#pragma unroll
        for (int ai = 0; ai < 2; ++ai)
#pragma unroll
            for (int m = 0; m < 4; ++m) { const int row = row0 + ai * 128 + m * 16; if (row >= MR) continue;
#pragma unroll
                for (int bj = 0; bj < 2; ++bj)
#pragma unroll
                    for (int n = 0; n < 2; ++n) { const int col = col0 + bj * 128 + n * 16;
                        const u32x2 gw = *(const u32x2*)(P + (size_t)row * NP + O_MB + col);
                        const f32x4 gt = {bflo(gw.x), bfhi(gw.x), bflo(gw.y), bfhi(gw.y)};
                        const u32x2 tw = *(const u32x2*)(T1 + (size_t)row * D + col);
                        const f32x4 v = (f32x4){bflo(tw.x), bfhi(tw.x), bflo(tw.y), bfhi(tw.y)} + acc[ai][bj][m][n] * gt;
                        *(u32x2*)(MG + (size_t)row * D + col) = (u32x2){pk2(v.x, v.y), pk2(v.z, v.w)}; } asm volatile("" ::: "memory"); }
    }
};
struct EpiX1 {
    static constexpr bool PERM = false;
    const float* xp; const float* xs; float* X1; bf16_t* X1B; float* SQ;
    __device__ __forceinline__ void operator()(const f32x4 (&acc)[2][2][4][2], const Unit& u, int wr, int wc, int fr, int fq) const {
        const int row0 = u.pm * 256 + wr * 64 + fr, col0 = u.pn * 256 + wc * 32 + 4 * fq;
#pragma unroll
        for (int ai = 0; ai < 2; ++ai)
#pragma unroll
            for (int m = 0; m < 4; ++m) { const int row = row0 + ai * 128 + m * 16; const bool ok = row < MR;
                const float* xr = (row < MP) ? xp + (size_t)row * D : xs + (size_t)(row - MP) * D;
                float ss = 0.f;
                if (ok) {
#pragma unroll
                    for (int bj = 0; bj < 2; ++bj)
#pragma unroll
                        for (int n = 0; n < 2; ++n) { const int col = col0 + bj * 128 + n * 16;
                            const f32x4 v = *(const f32x4*)(xr + col) + acc[ai][bj][m][n];
                            ss += (v.x * v.x + v.y * v.y) + (v.z * v.z + v.w * v.w);
                            *(u32x2*)(X1B + (size_t)row * D + col) = (u32x2){pk2(v.x, v.y), pk2(v.z, v.w)}; }
                }
                ss += __shfl_xor(ss, 16); ss += __shfl_xor(ss, 32);
                if (ok && fq == 0) SQ[(size_t)row * 16 + u.pn * 4 + wc] = ss; asm volatile("" ::: "memory"); }
    }
};
struct EpiGT {
    static constexpr bool PERM = false;
    const float* SQ; bf16_t* GT;
    __device__ __forceinline__ void operator()(const f32x4 (&acc)[2][2][4][2], const Unit& u, int wr, int wc, int fr, int fq) const {
        const int row0 = u.pm * 256 + wr * 64 + fr, col0 = u.pn * 256 + wc * 32 + 4 * fq;
#pragma unroll
        for (int ai = 0; ai < 2; ++ai)
#pragma unroll
            for (int m = 0; m < 4; ++m) { const int row = row0 + ai * 128 + m * 16; if (row >= MR) continue;
                const f32x4* sp = (const f32x4*)(SQ + (size_t)row * 16); const f32x4 q0 = sp[0], q1 = sp[1], q2 = sp[2], q3 = sp[3];
                const float rs = 1.0f / sqrtf((((q0.x + q0.y) + (q0.z + q0.w)) + ((q1.x + q1.y) + (q1.z + q1.w)) + ((q2.x + q2.y) + (q2.z + q2.w)) + ((q3.x + q3.y) + (q3.z + q3.w))) * (1.f / D) + EPS);
#pragma unroll
                for (int bj = 0; bj < 2; ++bj)
#pragma unroll
                    for (int n = 0; n < 2; ++n) { const int col = col0 + bj * 128 + n * 16; const f32x4 t = acc[ai][bj][m][n] * rs;
                        *(u32x2*)(GT + (size_t)row * D + col) = (u32x2){pk2(sigm(t.x), sigm(t.y)), pk2(sigm(t.z), sigm(t.w))}; } asm volatile("" ::: "memory"); }
    }
};
struct EpiX2 {
    static constexpr bool PERM = false;
    const bf16_t* X1; const bf16_t* GT; float* out; float* SQ;
    __device__ __forceinline__ void operator()(const f32x4 (&acc)[2][2][4][2], const Unit& u, int wr, int wc, int fr, int fq) const {
        const int row0 = u.pm * 256 + wr * 64 + fr, col0 = u.pn * 256 + wc * 32 + 4 * fq;
#pragma unroll
        for (int ai = 0; ai < 2; ++ai)
#pragma unroll
            for (int m = 0; m < 4; ++m) { int row = row0 + ai * 128 + m * 16; asm volatile("" : "+v"(row)); const bool ok = row < MR;
                float ss = 0.f;
                if (ok) {
#pragma unroll
                    for (int bj = 0; bj < 2; ++bj)
#pragma unroll
                        for (int n = 0; n < 2; ++n) { const int col = col0 + bj * 128 + n * 16;
                            const u32x2 gw = *(const u32x2*)(GT + (size_t)row * D + col);
                            const u32x2 xw = *(const u32x2*)(X1 + (size_t)row * D + col);
                            const f32x4 v = (f32x4){bflo(xw.x), bfhi(xw.x), bflo(xw.y), bfhi(xw.y)} + acc[ai][bj][m][n] * (f32x4){bflo(gw.x), bfhi(gw.x), bflo(gw.y), bfhi(gw.y)};
                            ss += (v.x * v.x + v.y * v.y) + (v.z * v.z + v.w * v.w);
                            *(f32x4*)(out + (size_t)row * D + col) = v; asm volatile("" ::: "memory"); }
                }
                ss += __shfl_xor(ss, 16); ss += __shfl_xor(ss, 32);
                if (ok && fq == 0) SQ[(size_t)row * 16 + u.pn * 4 + wc] = ss; asm volatile("" ::: "memory"); }
    }
};


__device__ __forceinline__ f32x4 mini_acc(const bf16_t* A, int lda, const bf16_t* Bt, int K, int kq, int l15, int quad) {
    f32x4 acc = {0.f, 0.f, 0.f, 0.f};
    const int kn = K / 128;
    const bf16_t* ap = A + (size_t)l15 * lda + kq * (K / 4) + quad * 8;
    const bf16_t* bp = Bt + (size_t)l15 * K + kq * (K / 4) + quad * 8;
#pragma unroll 4
    for (int ks = 0; ks < kn; ++ks) acc = MFMA32(*(const bf16x8*)(ap + ks * 32), *(const bf16x8*)(bp + ks * 32), acc);
    return acc;
}
__device__ __forceinline__ f32x4 mini_reduce(LAS f32x4* red, int half, int lane) { return (red[(half * 4 + 0) * 64 + lane] + red[(half * 4 + 1) * 64 + lane]) + (red[(half * 4 + 2) * 64 + lane] + red[(half * 4 + 3) * 64 + lane]); }
template <int PH> __device__ __forceinline__ void mini_phase(const Args& a, LAS unsigned char* lds, int bx, int G, int wave, int lane) {
    unsigned char* ws = a.ws;
    const int l15 = lane & 15, quad = lane >> 4, half = wave >> 2, kq = wave & 3;
    LAS f32x4* red1 = (LAS f32x4*)lds; LAS f32x4* red2 = red1 + 8 * 64;
    const bf16_t* P = (const bf16_t*)(ws + WS_P);
    for (int tp = bx; tp < 256; tp += G) {
        const int tl = tp * 2 + half, mt = tl >> 6, nt = tl & 63, row0 = MP + mt * 16, col0 = nt * 16;
        f32x4 a1, a2 = {0.f, 0.f, 0.f, 0.f};
        if (PH == 0) { a1 = mini_acc((const bf16_t*)(ws + WS_OA) + (size_t)row0 * 2048, 2048, (const bf16_t*)(ws + WS_WDA) + (size_t)col0 * 2048, 2048, kq, l15, quad);
                       a2 = mini_acc((const bf16_t*)(ws + WS_H) + (size_t)row0 * D, D, (const bf16_t*)(ws + WS_WDB) + (size_t)col0 * D, D, kq, l15, quad); }
        if (PH == 1) { a1 = mini_acc((const bf16_t*)(ws + WS_MG) + (size_t)row0 * D, D, (const bf16_t*)(ws + WS_WOUT) + (size_t)col0 * D, D, kq, l15, quad); }
        if (PH == 2) { a1 = mini_acc((const bf16_t*)(ws + WS_X1B) + (size_t)row0 * D, D, (const bf16_t*)(ws + WS_WGATE) + (size_t)col0 * D, D, kq, l15, quad);
                       a2 = mini_acc((const bf16_t*)(ws + WS_PB) + (size_t)row0 * PLE, PLE, (const bf16_t*)(ws + WS_WPLE) + (size_t)col0 * PLE, PLE, kq, l15, quad); }
        red1[wave * 64 + lane] = a1; red2[wave * 64 + lane] = a2;
        __syncthreads();
        if (kq == 0) {
            a1 = mini_reduce(red1, half, lane); a2 = mini_reduce(red2, half, lane);
            const int col = col0 + l15;
            float rs1[4] = {0.f, 0.f, 0.f, 0.f};
            if (PH == 2) {
#pragma unroll
                for (int r = 0; r < 4; ++r) { const f32x4 q = *(const f32x4*)((const float*)(ws + WS_SQS1) + (size_t)(row0 - MP + quad * 4 + r) * 64 + l15 * 4); float t = (q.x + q.y) + (q.z + q.w);
#pragma unroll
                    for (int o = 1; o < 16; o <<= 1) t += __shfl_xor(t, o);
                    rs1[r] = 1.0f / sqrtf(t * (1.f / D) + EPS); }
            }
#pragma unroll
            for (int r = 0; r < 4; ++r) {
                const int row = row0 + quad * 4 + r;
                float ss = 0.f;
                if (PH == 0) { const float ga = bf2f(P[(size_t)row * NP + O_MA + col]), gb = bf2f(P[(size_t)row * NP + O_MB + col]);
                    ((bf16_t*)(ws + WS_MG))[(size_t)row * D + col] = f2bf(a1[r] * ga + a2[r] * gb); }
                if (PH == 1) { const float x1 = a.in[I_XS][(size_t)(row - MP) * D + col] + a1[r]; ss = x1 * x1;
                    ((bf16_t*)(ws + WS_X1B))[(size_t)row * D + col] = f2bf(x1); }
                if (PH == 2) { const float x2 = bf2f(((const bf16_t*)(ws + WS_X1B))[(size_t)row * D + col]) + a2[r] * sigm(rs1[r] * a1[r]); ss = x2 * x2;
                    a.out[OUT_Y + (size_t)row * D + col] = x2; }
                if (PH != 0) {
#pragma unroll
                    for (int o = 1; o < 16; o <<= 1) ss += __shfl_xor(ss, o);
                    if (l15 == 0) ((float*)(ws + (PH == 1 ? WS_SQS1 : WS_SQS2)))[(size_t)(row - MP) * 64 + nt] = ss;
                }
            }
        }
        __syncthreads();
    }
}

#define XB_TMO      128
#define XB_XCNT(j)  (256  + 64 * (j))
#define XB_XSUB(j)  (1280 + 64 * (j))
#define XB_XGEN(j)  (2304 + 64 * (j))
#define XB_TOP      3328
#define XB_TOPGEN   3392
#define XCD_BAR_WORDS 3456
#define XB_SPIN_CAP (1u << 22)
__device__ __forceinline__ unsigned xb_ld(unsigned* p)              { return __hip_atomic_load(p, __ATOMIC_RELAXED, __HIP_MEMORY_SCOPE_AGENT); }
__device__ __forceinline__ unsigned xb_add(unsigned* p, unsigned v) { return __hip_atomic_fetch_add(p, v, __ATOMIC_RELAXED, __HIP_MEMORY_SCOPE_AGENT); }
__device__ __forceinline__ unsigned xb_xcc_id() { return (unsigned)__builtin_amdgcn_s_getreg((3 << 11) | 20) & 0xFu; }
#define XB_SPIN(cond, bar) do { unsigned _sp = 0; while (cond) { __builtin_amdgcn_s_sleep(1); \
    if ((++_sp & 255u) == 0u) { if (xb_ld(&(bar)[XB_TMO])) break; if (_sp > XB_SPIN_CAP) { atomicAdd(&(bar)[XB_TMO], 1u); break; } } } } while (0)
struct XcdBarrier { unsigned* bar; unsigned x; volatile LAS unsigned* st; };
__device__ __forceinline__ XcdBarrier xcd_barrier_post(unsigned* bar, volatile LAS unsigned* st) {
    XcdBarrier b; b.bar = bar; b.x = xb_xcc_id(); b.st = st;
    if (threadIdx.x == 0) (void)xb_add(&bar[XB_XCNT(b.x)], 1u);
    return b;
}
__device__ __forceinline__ void xcd_barrier_complete(unsigned* bar, unsigned x, unsigned& nloc, unsigned& nx) {
    const unsigned G = gridDim.x * gridDim.y * gridDim.z;
    unsigned sum, cnt, mine, sp = 0u;
    for (;;) {
        sum = 0u; cnt = 0u; mine = 0u;
#pragma unroll
        for (unsigned j = 0; j < 16; ++j) { const unsigned c = xb_ld(&bar[XB_XCNT(j)]); sum += c; cnt += (c > 0u) ? 1u : 0u; mine = (j == x) ? c : mine; }
        if (sum == G) break;
        __builtin_amdgcn_s_sleep(1);
        if ((++sp & 255u) == 0u) { if (xb_ld(&bar[XB_TMO])) break; if (sp > XB_SPIN_CAP) { atomicAdd(&bar[XB_TMO], 1u); break; } }
    }
    nloc = mine > 0u ? mine : 1u; nx = cnt > 0u ? cnt : 1u;
}
__device__ __forceinline__ void xcd_barrier(const XcdBarrier& b) {
    asm volatile("s_waitcnt vmcnt(0)" ::: "memory");
    __syncthreads();
    if (threadIdx.x == 0) {
        unsigned* bar = b.bar;
        __builtin_amdgcn_s_waitcnt(0);
        unsigned nloc = b.st[0], nx = b.st[1];
        if (nloc == 0u) { xcd_barrier_complete(bar, b.x, nloc, nx); b.st[0] = nloc; b.st[1] = nx; }
        const unsigned old = xb_add(&bar[XB_XSUB(b.x)], 1u);
        const unsigned gen = old / nloc;
        if (old + 1u == (gen + 1u) * nloc) {
            __builtin_amdgcn_fence(__ATOMIC_RELEASE, "agent");
            asm volatile("s_waitcnt vmcnt(0)" ::: "memory");
            const unsigned og = xb_add(&bar[XB_TOP], 1u);
            const unsigned tg = og / nx;
            if (og + 1u == (tg + 1u) * nx) xb_add(&bar[XB_TOPGEN], 1u);
            else XB_SPIN(xb_ld(&bar[XB_TOPGEN]) == tg, bar);
            __builtin_amdgcn_fence(__ATOMIC_ACQUIRE, "agent");
            xb_add(&bar[XB_XGEN(b.x)], 1u);
            asm volatile("s_waitcnt vmcnt(0)" ::: "memory");
        } else {
            XB_SPIN(xb_ld(&bar[XB_XGEN(b.x)]) == gen, bar);
            __builtin_amdgcn_fence(__ATOMIC_ACQUIRE, "agent");
            asm volatile("s_waitcnt vmcnt(0)" ::: "memory");
        }
    }
    __syncthreads();
}

constexpr int LDS_BYTES = 147456;
constexpr int CTL_SQ1 = 0, CTL_SQ2 = 32768, CTL_CNT = 65536;

#define GRID_SYNC() xcd_barrier(xbar)
__global__ void __launch_bounds__(512, 2) fwd_mega(Args a) {
    extern __shared__ __attribute__((aligned(16))) unsigned char lds_raw[];
    LAS unsigned char* lds = (LAS unsigned char*)lds_raw;
    cg::grid_group grid = cg::this_grid();
    const int tid = threadIdx.x, lane = tid & 63, wave = __builtin_amdgcn_readfirstlane(tid >> 6);
    const int G = gridDim.x, bx = blockIdx.x;
    const int gw = bx * 8 + wave, NGW = G * 8;
    unsigned char* ws = a.ws;
    if (tid < 16) ((LAS unsigned*)(lds + 131072 + 64))[tid] = 0u;
    __syncthreads();
    XcdBarrier xbar = xcd_barrier_post((unsigned*)(ws + WS_BAR), (volatile LAS unsigned*)(lds + 131072 + 64));
    grid.sync();

#if !defined(ONLY_PH) || ONLY_PH == 0
    phase0(a, lds, gw, NGW, wave, lane);
    GRID_SYNC();
#endif
#if !defined(ONLY_PH) || ONLY_PH == 1
    {
        pg8::Gemm g{(const bf16_t*)(ws + WS_H), (const bf16_t*)(ws + WS_WIN), MALL, NP, D}; pg8::StaticOrder S; S.init(MALL, NP, G, bx);
        EpiP E{(bf16_t*)(ws + WS_P), (bf16_t*)(ws + WS_KT), (const f32x2*)(ws + WS_ROPE)};
        pg8::gemm_phase<EpiP>(lds, g, S, E);
    }
    GRID_SYNC();
#endif
#if !defined(ONLY_PH) || ONLY_PH == 2
    for (int it = gw; it < 1032 * 16; it += NGW) rw_prep_item(a, lds + wave * 10240, it >> 4, it & 15, lane);
    GRID_SYNC();
#endif
#if !defined(ONLY_PH) || ONLY_PH == 3
    {
        for (int u = gw; u < MS * 16; u += NGW) rw_sample_wave(a, u >> 4, u & 15, lane);
        if (bx < 128) { if (wave < 4) rw_scan_task(a, lds + wave * 4096, bx >> 4, bx & 15, wave, lane); else if (G >= 128) { const int u = bx * 4 + (wave - 4); ret_sample_wave(a, u >> 2, u & 3, lane); } }
        __syncthreads();
        {
            unsigned* cnt2 = (unsigned*)(ws + WS_CTL) + CTL_CNT + 32;
            LAS unsigned* lu = (LAS unsigned*)(lds + 131072);
            for (;;) {
                if (tid == 0) *lu = atomicAdd(cnt2, 1u);
                __syncthreads();
                const unsigned unit = *lu;
                __syncthreads();
                if (unit >= (unsigned)(MS * 4) || G >= 128) break;
                ret_sample_unit(a, lds, (int)(unit >> 2), (int)(unit & 3), tid);
            }
        }
        {
            unsigned* cnt = (unsigned*)(ws + WS_CTL) + CTL_CNT;
            LAS unsigned* lu = (LAS unsigned*)(lds + 131072);
            for (;;) {
                if (tid == 0) *lu = atomicAdd(cnt, 1u);
                __syncthreads();
                const unsigned unit = *lu;
                __syncthreads();
                if (unit >= 256u) break;
                ret_unit(a, lds, (int)unit, tid);
            }
        }
    }
    GRID_SYNC();
#endif
#if !defined(ONLY_PH) || ONLY_PH == 4
    for (int m = gw; m < MR; m += NGW) phase25_row(a, m, lane);
    GRID_SYNC();
#endif
#if !defined(ONLY_PH) || ONLY_PH == 5
    {
        mini_phase<0>(a, lds, bx, G, wave, lane);
        pg8::StaticOrder S; S.init(MP, D, G, bx);
        { pg8::Gemm g{(const bf16_t*)(ws + WS_OA), (const bf16_t*)(ws + WS_WDA), MP, D, 2048}; EpiT1 E{(const bf16_t*)(ws + WS_P), (bf16_t*)(ws + WS_T1)}; pg8::gemm_phase<EpiT1>(lds, g, S, E); }
        { pg8::Gemm g{(const bf16_t*)(ws + WS_H), (const bf16_t*)(ws + WS_WDB), MP, D, D}; EpiMG E{(const bf16_t*)(ws + WS_P), (const bf16_t*)(ws + WS_T1), (bf16_t*)(ws + WS_MG)}; pg8::gemm_phase<EpiMG>(lds, g, S, E); }
    }
    GRID_SYNC();
#endif
#if !defined(ONLY_PH) || ONLY_PH == 6
    {
        mini_phase<1>(a, lds, bx, G, wave, lane);
        pg8::StaticOrder S; S.init(MP, D, G, bx);
        pg8::Gemm g{(const bf16_t*)(ws + WS_MG), (const bf16_t*)(ws + WS_WOUT), MP, D, D};
        EpiX1 E{a.in[I_XP], a.in[I_XS], (float*)(ws + WS_X1), (bf16_t*)(ws + WS_X1B), (float*)(ws + WS_SQ1P)};
        pg8::gemm_phase<EpiX1>(lds, g, S, E);
    }
    GRID_SYNC();
#endif
#if !defined(ONLY_PH) || ONLY_PH == 7
    {
        mini_phase<2>(a, lds, bx, G, wave, lane);
        pg8::StaticOrder S; S.init(MP, D, G, bx);
        { pg8::Gemm g{(const bf16_t*)(ws + WS_X1B), (const bf16_t*)(ws + WS_WGATE), MP, D, D}; EpiGT E{(const float*)(ws + WS_SQ1P), (bf16_t*)(ws + WS_GT)}; pg8::gemm_phase<EpiGT>(lds, g, S, E); }
        { pg8::Gemm g{(const bf16_t*)(ws + WS_PB), (const bf16_t*)(ws + WS_WPLE), MP, D, PLE}; EpiX2 E{(const bf16_t*)(ws + WS_X1B), (const bf16_t*)(ws + WS_GT), a.out + OUT_Y, (float*)(ws + WS_SQ2P)}; pg8::gemm_phase<EpiX2>(lds, g, S, E); }
    }
    GRID_SYNC();
#endif
#if !defined(ONLY_PH) || ONLY_PH == 8
    {
        const float* sq2 = (const float*)(ws + WS_SQ2P); const float* fg = a.in[I_FNG];
        for (int m0 = gw; m0 < MR; m0 += 2 * NGW) {
            const int m1 = m0 + NGW; const bool two = m1 < MR;
            float tot[2]; f32x4 xv[2][4];
#pragma unroll
            for (int e = 0; e < 2; ++e) {
                const int m = e ? m1 : m0;
                if (e == 0 || two) {
                    if (m < MP) { const f32x4* sp = (const f32x4*)(sq2 + (size_t)m * 16); const f32x4 q0 = sp[0], q1 = sp[1], q2 = sp[2], q3 = sp[3];
                        tot[e] = (((q0.x + q0.y) + (q0.z + q0.w)) + ((q1.x + q1.y) + (q1.z + q1.w)) + ((q2.x + q2.y) + (q2.z + q2.w)) + ((q3.x + q3.y) + (q3.z + q3.w))); }
                    else tot[e] = wave_sum(((const float*)(ws + WS_SQS2))[(size_t)(m - MP) * 64 + lane]);
                    const f32x4* o = (const f32x4*)(a.out + OUT_Y + (size_t)m * D);
#pragma unroll
                    for (int j = 0; j < 4; ++j) xv[e][j] = o[lane + 64 * j];
                }
            }
#pragma unroll
            for (int e = 0; e < 2; ++e) {
                const int m = e ? m1 : m0;
                if (e == 0 || two) {
                    const float rs = 1.0f / sqrtf(tot[e] * (1.f / D) + EPS);
                    f32x4* o = (f32x4*)(a.out + OUT_Y + (size_t)m * D);
#pragma unroll
                    for (int j = 0; j < 4; ++j) o[lane + 64 * j] = xv[e][j] * rs * ((const f32x4*)fg)[lane + 64 * j];
                }
            }
        }
    }
#endif

}

extern "C" void kernel_launch(void* const* d_in, const int* in_sizes, int n_in, void* d_out, int out_size, void* d_ws, size_t ws_size, hipStream_t stream) {
    static int grid = 0;
    if (grid == 0) {
        if (n_in != 26 || ws_size < WS_END) { fprintf(stderr, "kernel_launch: unexpected n_in %d or ws_size %zu (need %zu)\n", n_in, ws_size, (size_t)WS_END); grid = -1; return; }
        int dev = 0, cus = 0, per_cu = 0;
        hipGetDevice(&dev); hipDeviceGetAttribute(&cus, hipDeviceAttributeMultiprocessorCount, dev);
        if (hipFuncSetAttribute((const void*)fwd_mega, hipFuncAttributeMaxDynamicSharedMemorySize, LDS_BYTES) != hipSuccess) { fprintf(stderr, "kernel_launch: hipFuncSetAttribute failed\n"); grid = -1; return; }
        hipOccupancyMaxActiveBlocksPerMultiprocessor(&per_cu, (const void*)fwd_mega, 512, LDS_BYTES);
        if (per_cu < 1) { fprintf(stderr, "kernel_launch: occupancy query says %d blocks per CU\n", per_cu); per_cu = 1; }
        (void)hipGetLastError();
        grid = cus * 1;
        fprintf(stderr, "kernel_launch: grid %d (cus %d, per_cu %d), ws %zu\n", grid, cus, per_cu, ws_size);
    }
    if (grid < 0) return;
    Args a{};
    for (int i = 0; i < 26; ++i) a.in[i] = (const float*)d_in[i];
    a.out = (float*)d_out; a.ws = (unsigned char*)d_ws;
    if (hipMemsetAsync((char*)d_ws + WS_BAR, 0, XCD_BAR_WORDS * 4, stream) != hipSuccess) { fprintf(stderr, "kernel_launch: memset failed\n"); return; }
    void* args[] = {&a};
    hipError_t e = hipLaunchCooperativeKernel((const void*)fwd_mega, dim3(grid), dim3(512), args, LDS_BYTES, stream);
    if (e != hipSuccess) fprintf(stderr, "kernel_launch: cooperative launch failed: %s\n", hipGetErrorString(e));
}
```

```cpp
#include <hip/hip_runtime.h>
#include <hip/hip_cooperative_groups.h>
#include <cstdio>
#include <cstdint>
namespace cg = cooperative_groups;

#define LAS __attribute__((address_space(3)))
typedef unsigned short bf16_t;
typedef short bf16x8 __attribute__((ext_vector_type(8)));
typedef short bf16x4 __attribute__((ext_vector_type(4)));
typedef float f32x4 __attribute__((ext_vector_type(4)));
typedef float f32x2 __attribute__((ext_vector_type(2)));
typedef unsigned u32x4 __attribute__((ext_vector_type(4)));
typedef unsigned u32x2 __attribute__((ext_vector_type(2)));
typedef __bf16 nbf2 __attribute__((ext_vector_type(2)));

constexpr int D = 1024, NB = 8, T = 2048, MP = NB * T  , MS = 128, MR = MP + MS  , MALL = 16640  ;
constexpr int NCOLS = 12416, NP = 12544  ;
constexpr int O_K = 1024, O_V = 2048, O_GA = 4096, O_SH = 6144, O_GB = 9344, O_MA = 10368, O_MB = 11392;
constexpr int RH = 4, RDK = 256, RDV = 512, RCH = 128;
constexpr int WH = 16, WN = 64;
constexpr int PLE = 256;
constexpr float EPS = 1e-6f;
constexpr int REC = 12544;
constexpr int R_AT = 0, R_RT = 2048, R_BP = 4096, R_KP = 6144, R_VT = 8192, R_AAK = 10240, R_TT = 10752, R_ARB = 11264, R_ARK = 11776, R_WC = 12288;

constexpr size_t MiB = 1u << 20;
constexpr size_t WS_CTL = 0;
constexpr size_t WS_ROPE = 1 * MiB;
constexpr size_t WS_W2T = 4 * MiB, WS_A2T = WS_W2T + 131072;
constexpr size_t WS_WPLE = 5 * MiB, WS_WDB = 6 * MiB, WS_WOUT = 8 * MiB, WS_WGATE = 10 * MiB, WS_WDA = 12 * MiB, WS_WIN = 16 * MiB;
constexpr size_t WS_PB = 41 * MiB, WS_H = 50 * MiB  , WS_KT = 83 * MiB, WS_SQA = 115 * MiB, WS_BC = 117 * MiB, WS_OPSS = 119 * MiB  ;
constexpr size_t WS_OA = 122 * MiB, WS_P = 188 * MiB, WS_CH = 587 * MiB  , WS_OB = 786 * MiB  ;
constexpr size_t WS_T1 = WS_CH, WS_MG = WS_CH + 65 * MiB, WS_X1B = WS_CH + 98 * MiB, WS_GT = WS_CH + 131 * MiB, WS_X1 = WS_OB + 65 * MiB  ;
constexpr size_t WS_END = 916 * MiB;
constexpr size_t WS_BAR = 512 * 1024;
constexpr size_t WS_SQS1 = 640 * 1024, WS_SQS2 = 704 * 1024;
constexpr size_t WS_SQ1P = WS_KT, WS_SQ2P = WS_KT + 2 * MiB;

constexpr size_t OUT_Y = 0, OUT_RETP = 16908288, OUT_RWP = 21102592, OUT_SHP = 21626880, OUT_RETS = 21635072, OUT_RWS = 88743936, OUT_SHS = 97132544;

__device__ __forceinline__ unsigned pk2(float lo, float hi) { f32x2 v = {lo, hi}; nbf2 r = __builtin_convertvector(v, nbf2); return __builtin_bit_cast(unsigned, r); }
__device__ __forceinline__ unsigned short f2bf(float f) { return (unsigned short)(pk2(f, 0.f) & 0xffffu); }
__device__ __forceinline__ float bf2f(unsigned short b) { return __uint_as_float(((unsigned)b) << 16); }
__device__ __forceinline__ float bflo(unsigned w) { return __uint_as_float(w << 16); }
__device__ __forceinline__ float bfhi(unsigned w) { return __uint_as_float(w & 0xffff0000u); }
__device__ __forceinline__ float sigm(float x) { return __builtin_amdgcn_rcpf(1.f + __expf(-x)); }
__device__ __forceinline__ float silu_(float x) { return x * sigm(x); }
__device__ __forceinline__ float wave_sum(float v) {
#pragma unroll
    for (int o = 1; o < 64; o <<= 1) v += __shfl_xor(v, o);
    return v;
}
#define MFMA32(a, b, c) __builtin_amdgcn_mfma_f32_16x16x32_bf16((a), (b), (c), 0, 0, 0)
#define LDS_WAIT() asm volatile("s_waitcnt lgkmcnt(0)" ::: "memory")

namespace pg8 {
constexpr int BM = 256, BK = 64, HALF = 128, HTB = HALF * BK * 2, STAGE_BYTES = 8 * HTB, NXCD = 8, WGM = 8;
__host__ __device__ __forceinline__ int lds_byte(int r, int c) { const int st = (r >> 4) * 2 + (c >> 5), rr = r & 15, cc = c & 31, ob = rr * 64 + cc * 2; return st * 1024 + (ob ^ (((ob >> 9) & 1) << 5)); }
__host__ __device__ __forceinline__ void stage_rc(int b, int& R, int& C) { const int st = b / 1024, sb = b % 1024, swz = sb ^ (((sb >> 9) & 1) << 5); R = (st >> 1) * 16 + swz / 64; C = (st & 1) * 32 + (swz % 64) / 2; }
__host__ __device__ __forceinline__ int perm32(int rho) { const int n = rho >> 4, i = rho & 15; return 8 * (i >> 2) + 4 * n + (i & 3); }
struct Unit { int pm, pn; };
struct Gemm { const bf16_t* A; const bf16_t* Bt; int M, N, K; };
struct StaticOrder {
    int nM, nN, nwg, G, c;
    __host__ __device__ void init(int M, int N, int G_, int c_) { nM = M / BM; nN = N / BM; nwg = nM * nN; G = G_; c = c_; }
    __host__ __device__ bool next(int i, Unit& u) const {
        const long L = (long)i * G + c; if (L >= nwg) return false;
        int wgid = (int)L; { const int q = nwg / NXCD, r = nwg % NXCD, xcd = wgid % NXCD, off = wgid / NXCD; wgid = (xcd < r ? xcd * (q + 1) : r * (q + 1) + (xcd - r) * q) + off; }
        const int nig = WGM * nN, gid = wgid / nig, fm = gid * WGM, gsz = (nM - fm) < WGM ? (nM - fm) : WGM;
        u.pm = fm + ((wgid % nig) % gsz); u.pn = (wgid % nig) / gsz; return true;
    }
};
template <class Epi>
__device__ __forceinline__ void gemm_phase(LAS unsigned char* lds, const Gemm g, const StaticOrder& S, const Epi& E) {
    int tid = threadIdx.x; asm volatile("" : "+v"(tid));
    const int wid = __builtin_amdgcn_readfirstlane(tid >> 6), lane = tid & 63, wr = wid >> 2, wc = wid & 3, fr = lane & 15, fq = lane >> 4;
    const int K = g.K, nt = K / BK;
    unsigned voffA[2], voffB[2];
#pragma unroll
    for (int i = 0; i < 2; ++i) { int R, C; stage_rc(tid * 16 + i * 8192, R, C); const int Rb = Epi::PERM ? ((R & ~31) + perm32(R & 31)) : R;
        voffA[i] = (unsigned)(R * K + C) * 2u; voffB[i] = (unsigned)(Rb * K + C) * 2u; }
    const size_t kstep = (size_t)(BK * 2);
    const size_t hstep = (size_t)HALF * K * 2;
    const size_t tstep = 2 * hstep;
    const unsigned ldsw = (unsigned)wid * 1024u;
    const int aoff = lds_byte(wr * 64 + fr, fq * 8), boff = lds_byte(wc * 32 + fr, fq * 8);
#define PG8_SA(b, h) (((b) * 2 + (h)) * HTB)
#define PG8_SB(b, h) ((4 + (b) * 2 + (h)) * HTB)
#define PG8_STAGE(bufoff, gbase, voff) do { _Pragma("unroll") for (int _i = 0; _i < 2; ++_i) \
        __builtin_amdgcn_global_load_lds((const unsigned*)((const char*)(gbase) + (voff)[_i]), (LAS unsigned*)(lds + (bufoff) + ldsw + _i * 8192), 16, 0, 0); } while (0)
#define PG8_LDA(dst, b, h) do { _Pragma("unroll") for (int m = 0; m < 4; ++m) _Pragma("unroll") for (int k = 0; k < 2; ++k) dst[m][k] = *(const LAS bf16x8*)(lds + PG8_SA(b, h) + aoff + m * 2048 + k * 1024); } while (0)
#define PG8_LDB(dst, b, h) do { _Pragma("unroll") for (int n = 0; n < 2; ++n) _Pragma("unroll") for (int k = 0; k < 2; ++k) dst[n][k] = *(const LAS bf16x8*)(lds + PG8_SB(b, h) + boff + n * 2048 + k * 1024); } while (0)
#define PG8_MMA(ai, bj, At, Bt) do { __builtin_amdgcn_s_setprio(1); _Pragma("unroll") for (int m = 0; m < 4; ++m) _Pragma("unroll") for (int n = 0; n < 2; ++n) _Pragma("unroll") for (int k = 0; k < 2; ++k) \
        acc[ai][bj][m][n] = __builtin_amdgcn_mfma_f32_16x16x32_bf16(Bt[n][k], At[m][k], acc[ai][bj][m][n], 0, 0, 0); __builtin_amdgcn_s_setprio(0); } while (0)
#define PG8_WAIT_V(n) asm volatile("s_waitcnt vmcnt(" #n ")" ::: "memory")
#define PG8_WAIT_L(n) asm volatile("s_waitcnt lgkmcnt(" #n ")" ::: "memory")
#define PG8_BAR __builtin_amdgcn_s_barrier()
#define PG8_SCHED __builtin_amdgcn_sched_barrier(0)
    Unit cur, nxt; int ui = 0;
    if (!S.next(0, cur)) return;
    f32x4 acc[2][2][4][2];
#pragma unroll
    for (int a = 0; a < 2; ++a)
#pragma unroll
        for (int b = 0; b < 2; ++b)
#pragma unroll
            for (int m = 0; m < 4; ++m)
#pragma unroll
                for (int n = 0; n < 2; ++n) acc[a][b][m][n] = (f32x4){0.f, 0.f, 0.f, 0.f};
    bf16x8 At[4][2], B0[2][2], B1[2][2];
    const char* cA = (const char*)g.A + (size_t)cur.pm * tstep; const char* cB = (const char*)g.Bt + (size_t)cur.pn * tstep;
    PG8_STAGE(PG8_SB(0, 0), cB, voffB); PG8_STAGE(PG8_SA(0, 0), cA, voffA); PG8_STAGE(PG8_SB(0, 1), cB + hstep, voffB); PG8_STAGE(PG8_SA(0, 1), cA + hstep, voffA);
    if (wr == 1) PG8_BAR;
    PG8_WAIT_V(4); PG8_BAR;
    PG8_STAGE(PG8_SB(1, 0), cB + kstep, voffB); PG8_STAGE(PG8_SA(1, 0), cA + kstep, voffA); PG8_STAGE(PG8_SB(1, 1), cB + hstep + kstep, voffB);
    PG8_WAIT_V(6); PG8_BAR;
    for (;;) {
        const bool has_next = S.next(ui + 1, nxt);
        const char* nA = has_next ? (const char*)g.A + (size_t)nxt.pm * tstep : cA; const char* nB = has_next ? (const char*)g.Bt + (size_t)nxt.pn * tstep : cB;
#pragma unroll 1
        for (int t = 0; t < nt; t += 2) {
            const bool last = (t == nt - 2);
            const char* a1 = cA + (size_t)(t + 1) * kstep;
            const char* a2 = last ? nA : cA + (size_t)(t + 2) * kstep; const char* b2 = last ? nB : cB + (size_t)(t + 2) * kstep;
            const char* a3 = a2 + kstep; const char* b3 = b2 + kstep;
            PG8_LDB(B0, 0, 0); PG8_SCHED; PG8_LDA(At, 0, 0); PG8_STAGE(PG8_SA(1, 1), a1 + hstep, voffA);
            PG8_WAIT_L(8); PG8_BAR; PG8_WAIT_L(0); PG8_MMA(0, 0, At, B0); PG8_BAR; PG8_SCHED;
            PG8_LDB(B1, 0, 1); PG8_STAGE(PG8_SB(0, 0), b2, voffB);
            PG8_BAR; PG8_WAIT_L(0); PG8_MMA(0, 1, At, B1); PG8_BAR;
            PG8_LDA(At, 0, 1); PG8_STAGE(PG8_SA(0, 0), a2, voffA);
            PG8_BAR; PG8_WAIT_L(0); PG8_MMA(1, 0, At, B0); PG8_BAR; PG8_SCHED;
            PG8_STAGE(PG8_SB(0, 1), b2 + hstep, voffB);
            PG8_WAIT_V(6); PG8_BAR; PG8_MMA(1, 1, At, B1); PG8_BAR;
            PG8_LDB(B0, 1, 0); PG8_SCHED; PG8_LDA(At, 1, 0); PG8_STAGE(PG8_SA(0, 1), a2 + hstep, voffA);
            PG8_WAIT_L(8); PG8_BAR; PG8_WAIT_L(0); PG8_MMA(0, 0, At, B0); PG8_BAR; PG8_SCHED;
            PG8_LDB(B1, 1, 1); PG8_STAGE(PG8_SB(1, 0), b3, voffB);
            PG8_BAR; PG8_WAIT_L(0); PG8_MMA(0, 1, At, B1); PG8_BAR;
            PG8_LDA(At, 1, 1); PG8_STAGE(PG8_SA(1, 0), a3, voffA);
            PG8_BAR; PG8_WAIT_L(0); PG8_MMA(1, 0, At, B0); PG8_BAR; PG8_SCHED;
            PG8_STAGE(PG8_SB(1, 1), b3 + hstep, voffB);
            PG8_WAIT_V(6); PG8_BAR; PG8_MMA(1, 1, At, B1); PG8_BAR;
        }
        E(acc, cur, wr, wc, fr, fq);
        if (!has_next) break;
#pragma unroll
        for (int a = 0; a < 2; ++a)
#pragma unroll
            for (int b = 0; b < 2; ++b)
#pragma unroll
                for (int m = 0; m < 4; ++m)
#pragma unroll
                    for (int n = 0; n < 2; ++n) acc[a][b][m][n] = (f32x4){0.f, 0.f, 0.f, 0.f};
        cur = nxt; cA = nA; cB = nB; ++ui;
    }
    PG8_WAIT_V(0);
    if (wr == 0) PG8_BAR;
    PG8_BAR;
#undef PG8_SA
#undef PG8_SB
#undef PG8_STAGE
#undef PG8_LDA
#undef PG8_LDB
#undef PG8_MMA
#undef PG8_WAIT_V
#undef PG8_WAIT_L
#undef PG8_BAR
#undef PG8_SCHED
}
}
using pg8::Unit;

struct Args {
    const float* in[26];
    float* out; unsigned char* ws;
};
#define KAS __attribute__((address_space(4)))
__device__ __forceinline__ const KAS char* kargp() { const KAS char* p = (const KAS char*)__builtin_amdgcn_kernarg_segment_ptr(); asm volatile("" : "+s"(p)); return p; }


enum { I_XP = 0, I_XS, I_SRET, I_SRW, I_SSH, I_PP, I_PS, I_NG, I_WIN, I_MU, I_W0, I_W2, I_A0, I_A2, I_KK, I_KA, I_RK, I_LNW, I_LNB, I_WDA, I_WDB, I_WOUT, I_WPLE, I_PNG, I_WPG, I_FNG };

__device__ __forceinline__ void p0_transpose_item(const float* W, int K, int N, bf16_t* WT, LAS float* scr, int item, int lane, const float* kscale) {
    const int nblk = N / 32, kb = item / nblk, nb = item % nblk, k0 = 64 * kb, n0 = 32 * nb;
#pragma unroll 8
    for (int i = 0; i < 32; ++i) { const int kk = 2 * i + (lane >> 5); float v = W[(size_t)(k0 + kk) * N + n0 + (lane & 31)]; if (kscale) v *= kscale[k0 + kk]; scr[kk * 33 + (lane & 31)] = v; }
    LDS_WAIT();
    const int c = lane & 7;
#pragma unroll
    for (int j = 0; j < 4; ++j) { const int n = (lane >> 3) + 8 * j; const LAS float* s = scr + (8 * c) * 33 + n;
        u32x4 o; o.x = pk2(s[0 * 33], s[1 * 33]); o.y = pk2(s[2 * 33], s[3 * 33]); o.z = pk2(s[4 * 33], s[5 * 33]); o.w = pk2(s[6 * 33], s[7 * 33]);
        *(u32x4*)(WT + (size_t)(n0 + n) * K + k0 + 8 * c) = o; }
    LDS_WAIT();
}

__device__ __forceinline__ void phase0(const Args& a, LAS unsigned char* lds, int gw, int NGW, int wave, int lane) {
    unsigned char* ws = a.ws;
    LAS float* scr = (LAS float*)(lds + wave * 16384);
    constexpr int I_IN = (D / 64) * (NCOLS / 32), I_DA = (2048 / 64) * (D / 32), I_SQ = (D / 64) * (D / 32), I_PL = (PLE / 64) * (D / 32), I_LR = 1 * (D / 32);
    constexpr int NITEMS = I_IN + I_DA + 3 * I_SQ + I_PL + 2 * I_LR;
    for (int it = gw; it < NITEMS; it += NGW) {
        int r = it;
        if (r < I_IN) { p0_transpose_item(a.in[I_WIN], D, NCOLS, (bf16_t*)(ws + WS_WIN), scr, r, lane, nullptr); continue; } r -= I_IN;
        if (r < I_DA) { p0_transpose_item(a.in[I_WDA], 2048, D, (bf16_t*)(ws + WS_WDA), scr, r, lane, nullptr); continue; } r -= I_DA;
        if (r < I_SQ) { p0_transpose_item(a.in[I_WDB], D, D, (bf16_t*)(ws + WS_WDB), scr, r, lane, nullptr); continue; } r -= I_SQ;
        if (r < I_SQ) { p0_transpose_item(a.in[I_WOUT], D, D, (bf16_t*)(ws + WS_WOUT), scr, r, lane, nullptr); continue; } r -= I_SQ;
        if (r < I_SQ) { p0_transpose_item(a.in[I_WPG], D, D, (bf16_t*)(ws + WS_WGATE), scr, r, lane, a.in[I_PNG]); continue; } r -= I_SQ;
        if (r < I_PL) { p0_transpose_item(a.in[I_WPLE], PLE, D, (bf16_t*)(ws + WS_WPLE), scr, r, lane, nullptr); continue; } r -= I_PL;
        if (r < I_LR) { p0_transpose_item(a.in[I_W2], 64, D, (bf16_t*)(ws + WS_W2T), scr, r, lane, nullptr); continue; } r -= I_LR;
        p0_transpose_item(a.in[I_A2], 64, D, (bf16_t*)(ws + WS_A2T), scr, r, lane, nullptr);
    }
    for (int i = gw * 64 + lane; i < 128 * D / 8; i += NGW * 64) ((u32x4*)(ws + WS_WIN + (size_t)NCOLS * D * 2))[i] = (u32x4){0u, 0u, 0u, 0u};
    bf16_t* H = (bf16_t*)(ws + WS_H);
    const float* ng = a.in[I_NG];
    for (int m = gw; m < MALL; m += NGW) {
        if (m < MR) {
            const float* xr = (m < MP) ? a.in[I_XP] + (size_t)m * D : a.in[I_XS] + (size_t)(m - MP) * D;
            f32x4 v[4]; float s = 0.f;
#pragma unroll
            for (int j = 0; j < 4; ++j) { v[j] = ((const f32x4*)xr)[lane + 64 * j]; s += (v[j].x * v[j].x + v[j].y * v[j].y) + (v[j].z * v[j].z + v[j].w * v[j].w); }
            const float rs = 1.0f / sqrtf(wave_sum(s) * (1.f / D) + EPS);
            float* so = nullptr;
            if (m < MP) { if ((m & (T - 1)) == T - 1) so = a.out + OUT_SHP + (size_t)(m >> 11) * D; } else so = a.out + OUT_SHS + (size_t)(m - MP) * D;
#pragma unroll
            for (int j = 0; j < 4; ++j) { const f32x4 gg = ((const f32x4*)ng)[lane + 64 * j]; f32x4 h = v[j] * rs * gg;
                if (so) ((f32x4*)so)[lane + 64 * j] = h;
                u32x2 o; o.x = pk2(h.x, h.y); o.y = pk2(h.z, h.w); ((u32x2*)(H + (size_t)m * D))[lane + 64 * j] = o; }
        } else {
            const float* xr = a.in[I_SSH] + (size_t)(m - MR) * D;
#pragma unroll
            for (int j = 0; j < 4; ++j) { const f32x4 h = ((const f32x4*)xr)[lane + 64 * j]; u32x2 o; o.x = pk2(h.x, h.y); o.y = pk2(h.z, h.w); ((u32x2*)(H + (size_t)m * D))[lane + 64 * j] = o; }
        }
        u32x2 o = {0u, 0u};
        if (m < MR) { const float* pr = (m < MP) ? a.in[I_PP] + (size_t)m * PLE : a.in[I_PS] + (size_t)(m - MP) * PLE; const f32x4 p = ((const f32x4*)pr)[lane]; o.x = pk2(p.x, p.y); o.y = pk2(p.z, p.w); }
        ((u32x2*)(ws + WS_PB + (size_t)m * PLE * 2))[lane] = o;
    }
    for (int i = gw * 64 + lane; i < 2049 * 128; i += NGW * 64) {
        const int pos = i >> 7, j = i & 127; const double p = (pos == 2048) ? 16384.0 : (double)pos;
        double inv = 1.0, base = 0.9305720409296989; int e = j;
        while (e) { if (e & 1) inv *= base; base *= base; e >>= 1; }
        double rev = p * inv * 0.15915494309189535; rev -= floor(rev);
        const float fr = (float)rev;
        ((f32x2*)(ws + WS_ROPE))[i] = (f32x2){__builtin_amdgcn_cosf(fr), __builtin_amdgcn_sinf(fr)};
    }
    for (int i = gw * 64 + lane; i < 65536 + 64; i += NGW * 64) ((float*)(ws + WS_CTL))[i] = 0.f;
}

struct EpiP {
    static constexpr bool PERM = true;
    bf16_t* P; bf16_t* KT; const f32x2* rope;
    __device__ __forceinline__ void operator()(const f32x4 (&acc)[2][2][4][2], const Unit& u, int wr, int wc, int fr, int fq) const {
        const int pn = u.pn, pm = u.pm;
        const int row0 = pm * 256 + wr * 64 + fr, cl0 = wc * 32 + 8 * fq;
        const bool sample = (pm == 64);
        if (pn < 8) {
            const int h = pn & 3; const bool isk = pn >= 4;
            const float l2g = __log2f(1.f - exp2f(-5.f - (float)h));
#pragma unroll
            for (int ai = 0; ai < 2; ++ai)
#pragma unroll
                for (int m = 0; m < 4; ++m) {
                    const int row = row0 + ai * 128 + m * 16;
                    int pos, ex;
                    if (sample) { pos = 2048; ex = isk ? 0 : 1; } else { pos = row & (T - 1); const int idx = pos & 127; ex = isk ? 127 - idx : idx + 1; }
                    const float sc = exp2f((float)ex * l2g) * (isk ? 0.0625f : 1.0f);
                    const f32x4* rp = (const f32x4*)(rope + pos * 128 + cl0);
                    f32x4 cs[4]; cs[0] = rp[0]; cs[1] = rp[1]; cs[2] = rp[2]; cs[3] = rp[3];
                    float y1[8], y2[8];
#pragma unroll
                    for (int n = 0; n < 2; ++n)
#pragma unroll
                        for (int e = 0; e < 4; ++e) {
                            const float c = (e & 1) ? cs[n * 2 + (e >> 1)].z : cs[n * 2 + (e >> 1)].x, s = (e & 1) ? cs[n * 2 + (e >> 1)].w : cs[n * 2 + (e >> 1)].y;
                            const float x1 = acc[ai][0][m][n][e], x2 = acc[ai][1][m][n][e];
                            y1[n * 4 + e] = (x1 * c - x2 * s) * sc; y2[n * 4 + e] = (x2 * c + x1 * s) * sc;
                        }
                    u32x4 w1, w2;
                    w1.x = pk2(y1[0], y1[1]); w1.y = pk2(y1[2], y1[3]); w1.z = pk2(y1[4], y1[5]); w1.w = pk2(y1[6], y1[7]);
                    w2.x = pk2(y2[0], y2[1]); w2.y = pk2(y2[2], y2[3]); w2.z = pk2(y2[4], y2[5]); w2.w = pk2(y2[6], y2[7]);
                    bf16_t* rowp = P + (size_t)row * NP + pn * 256 + cl0;
                    *(u32x4*)rowp = w1; *(u32x4*)(rowp + 128) = w2;
                    if (isk && !sample) {
                        bf16_t* kt = KT + ((size_t)((row >> 11) * 4 + h) * 256 + cl0) * T + pos;
#pragma unroll
                        for (int j = 0; j < 8; ++j) { kt[(size_t)j * T] = f2bf(y1[j]); kt[(size_t)(j + 128) * T] = f2bf(y2[j]); }
                    }
                }
            return;
        }
#pragma unroll
        for (int bj = 0; bj < 2; ++bj) {
            const int cb = pn * 2 + bj;
            if (cb >= 97) continue;
            const int mode = 0;
            const bool vt = (cb < 32) && !sample;
#pragma unroll
            for (int ai = 0; ai < 2; ++ai)
#pragma unroll
                for (int m = 0; m < 4; ++m) {
                    const int row = row0 + ai * 128 + m * 16;
                    float y[8];
#pragma unroll
                    for (int n = 0; n < 2; ++n)
#pragma unroll
                        for (int e = 0; e < 4; ++e) { float x = acc[ai][bj][m][n][e]; if (mode == 1) x = x * sigm(x); else if (mode == 2) x = sigm(x); y[n * 4 + e] = x; }
                    if (vt) {
                        const int hd = cb * 128 + cl0 - O_V;
                        bf16_t* vp = P + ((size_t)(row >> 11) * T + hd) * NP + O_V + (row & (T - 1));
#pragma unroll
                        for (int j = 0; j < 8; ++j) vp[(size_t)j * NP] = f2bf(y[j]);
                    } else {
                        u32x4 w; w.x = pk2(y[0], y[1]); w.y = pk2(y[2], y[3]); w.z = pk2(y[4], y[5]); w.w = pk2(y[6], y[7]);
                        *(u32x4*)(P + (size_t)row * NP + cb * 128 + cl0) = w;
                    }
                }
        }
    }
};

__device__ __forceinline__ float lerp_bf(const bf16_t* cur, const bf16_t* prv, float mu) { const float c = bf2f(*cur); const float p = prv ? bf2f(*prv) : 0.f; return c + (p - c) * mu; }

__device__ __forceinline__ void rw_prep_item(const Args& a, LAS unsigned char* wl  , int tt, int h, int lane) {
    unsigned char* ws = a.ws;
    const bf16_t* P = (const bf16_t*)(ws + WS_P);
    const int l15 = lane & 15, quad = lane >> 4;
    const bool sample = tt >= 1024;
    const int row_base = sample ? MP + (tt - 1024) * 16 : tt * 16;
    const float* mu = a.in[I_MU];
    bf16x8 Aw[2], Aa[2];
    {
        const int m = row_base + l15;
        const bf16_t* cur = P + (size_t)m * NP + O_SH;
        const bf16_t* prv = sample ? P + (size_t)(m + MS) * NP + O_SH : ((m & (T - 1)) ? cur - NP : nullptr);
#pragma unroll
        for (int which = 0; which < 2; ++which)
#pragma unroll
            for (int ks = 0; ks < 2; ++ks) {
                const int col = 3072 + which * 64 + ks * 32 + quad * 8;
                const u32x4 cw = *(const u32x4*)(cur + col); u32x4 pw = {0u, 0u, 0u, 0u}; if (prv) pw = *(const u32x4*)(prv + col);
                const f32x4 m0 = *(const f32x4*)(mu + col), m1 = *(const f32x4*)(mu + col + 4);
                float z[8];
                const unsigned cws[4] = {cw.x, cw.y, cw.z, cw.w}, pws[4] = {pw.x, pw.y, pw.z, pw.w};
#pragma unroll
                for (int j = 0; j < 4; ++j) {
                    const float c0 = bflo(cws[j]), c1 = bfhi(cws[j]), p0 = bflo(pws[j]), p1 = bfhi(pws[j]);
                    const float mm0 = (j < 2) ? m0[2 * j] : m1[2 * j - 4], mm1 = (j < 2) ? m0[2 * j + 1] : m1[2 * j - 3];
                    z[2 * j] = c0 + (p0 - c0) * mm0; z[2 * j + 1] = c1 + (p1 - c1) * mm1;
                }
                if (which == 0) {
#pragma unroll
                    for (int j = 0; j < 8; ++j) z[j] = 1.f - 2.f / (__expf(2.f * z[j]) + 1.f);
                }
                u32x4 o; o.x = pk2(z[0], z[1]); o.y = pk2(z[2], z[3]); o.z = pk2(z[4], z[5]); o.w = pk2(z[6], z[7]);
                if (which == 0) Aw[ks] = __builtin_bit_cast(bf16x8, o); else Aa[ks] = __builtin_bit_cast(bf16x8, o);
            }
    }
    const bf16_t* W2T = (const bf16_t*)(ws + WS_W2T); const bf16_t* A2T = (const bf16_t*)(ws + WS_A2T);
    unsigned char* rec = ws + WS_CH + ((size_t)((tt >> 7) * 16 + h) * 128 + (tt & 127)) * REC;
    LAS bf16_t* LA = (LAS bf16_t*)wl;
    LAS bf16_t* LR = LA + 16 * 72;
    LAS bf16_t* LB = LR + 16 * 72;
    LAS bf16_t* LK = LB + 16 * 72;
    LAS float* LN = (LAS float*)(wl + 9216);
    float tA[4][4], tBi[4][4], tBp[4][4];
    float ssq[4] = {0.f, 0.f, 0.f, 0.f}, bon[4] = {0.f, 0.f, 0.f, 0.f};
#pragma unroll
    for (int nt = 0; nt < 4; ++nt) {
        const int ch = h * 64 + nt * 16 + l15, cc = nt * 16 + l15;
        f32x4 cw = {0.f, 0.f, 0.f, 0.f}, ca = {0.f, 0.f, 0.f, 0.f};
#pragma unroll
        for (int ks = 0; ks < 2; ++ks) {
            const bf16x8 bw = *(const bf16x8*)(W2T + (size_t)ch * 64 + ks * 32 + quad * 8), ba = *(const bf16x8*)(A2T + (size_t)ch * 64 + ks * 32 + quad * 8);
            cw = MFMA32(Aw[ks], bw, cw); ca = MFMA32(Aa[ks], ba, ca);
        }
        const float w0 = a.in[I_W0][ch], a0 = a.in[I_A0][ch], k_k = a.in[I_KK][ch], k_a = a.in[I_KA][ch], r_k = a.in[I_RK][ch];
        const float mur = mu[ch], muk = mu[1024 + ch], muv = mu[2048 + ch];
        float lw[4], rr[4], kq[4], vv[4], aa4[4], kr4[4];
#pragma unroll
        for (int r = 0; r < 4; ++r) {
            const int m = row_base + quad * 4 + r;
            const bf16_t* cur = P + (size_t)m * NP + O_SH + ch;
            const bf16_t* prv = sample ? P + (size_t)(m + MS) * NP + O_SH + ch : ((m & (T - 1)) ? cur - NP : nullptr);
            const float r_ = lerp_bf(cur, prv, mur), k_ = lerp_bf(cur + 1024, prv ? prv + 1024 : nullptr, muk), v_ = lerp_bf(cur + 2048, prv ? prv + 2048 : nullptr, muv);
            lw[r] = -0.6065306597126334f * sigm(w0 + cw[r]);
            const float aa = sigm(a0 + ca[r]); aa4[r] = aa;
            const float kr = k_ * k_k; kr4[r] = kr; ssq[r] += kr * kr;
            const float kpp = k_ * (1.f + (aa - 1.f) * k_a); kq[r] = kpp;
            rr[r] = r_; vv[r] = v_; bon[r] += r_ * kpp * r_k;
        }
        if (sample) {
#pragma unroll
            for (int r = 0; r < 4; ++r) {
                const int i = (tt - 1024) * 16 + quad * 4 + r;
                float* o = (float*)(ws + WS_OPSS) + ((size_t)(i * 16 + h) * 6) * 64 + cc;
                o[0] = rr[r]; o[64] = __expf(lw[r]); o[128] = kq[r]; o[320] = vv[r];
                tA[nt][r] = kr4[r]; tBi[nt][r] = aa4[r] * kr4[r]; tBp[nt][r] = 0.f;
            }
        } else {
            float c[4]; c[0] = lw[0]; c[1] = c[0] + lw[1]; c[2] = c[1] + lw[2]; c[3] = c[2] + lw[3];
            const float tot = c[3];
            const float s1 = __shfl(tot, (lane - 16) & 63), s2 = __shfl(tot, (lane - 32) & 63), s3 = __shfl(tot, (lane - 48) & 63);
            const float off = (quad >= 1 ? s1 : 0.f) + (quad >= 2 ? s2 : 0.f) + (quad >= 3 ? s3 : 0.f);
            const float total = __shfl(c[3] + off, 48 + l15);
            float kqp[4];
#pragma unroll
            for (int r = 0; r < 4; ++r) {
                const float cum = c[r] + off, cumx = cum - lw[r];
                const float ea = __expf(cumx), er = __expf(cum), ei = __expf(-cum), ep = __expf(total - cum);
                const int tk = quad * 4 + r;
                LR[tk * 72 + cc] = f2bf(rr[r] * er); LK[tk * 72 + cc] = f2bf(kq[r] * ei);
                kqp[r] = kq[r] * ep;
                tA[nt][r] = kr4[r] * ea; tBi[nt][r] = aa4[r] * kr4[r] * ei; tBp[nt][r] = aa4[r] * kr4[r] * ep;
            }
            *(u32x2*)(rec + R_KP + cc * 32 + quad * 8) = (u32x2){pk2(kqp[0], kqp[1]), pk2(kqp[2], kqp[3])};
            *(u32x2*)(rec + R_VT + cc * 32 + quad * 8) = (u32x2){pk2(vv[0], vv[1]), pk2(vv[2], vv[3])};
            if (quad == 0) *(float*)(rec + R_WC + cc * 4) = __expf(total);
        }
        asm volatile("" ::: "memory");
    }
    float inv[4];
#pragma unroll
    for (int r = 0; r < 4; ++r) {
        float s = ssq[r], b = bon[r];
#pragma unroll
        for (int o = 1; o < 16; o <<= 1) { s += __shfl_xor(s, o); b += __shfl_xor(b, o); }
        inv[r] = 1.f / fmaxf(sqrtf(s), 1e-12f);
        if (l15 == 0) ((float*)(ws + WS_BC))[(size_t)(row_base + quad * 4 + r) * 16 + h] = b;
    }
    if (sample) {
#pragma unroll
        for (int nt = 0; nt < 4; ++nt)
#pragma unroll
            for (int r = 0; r < 4; ++r) {
                const int i = (tt - 1024) * 16 + quad * 4 + r;
                float* o = (float*)(ws + WS_OPSS) + ((size_t)(i * 16 + h) * 6) * 64 + nt * 16 + l15;
                o[192] = tA[nt][r] * inv[r]; o[256] = tBi[nt][r] * inv[r];
            }
        return;
    }
#pragma unroll
    for (int nt = 0; nt < 4; ++nt) {
        const int cc = nt * 16 + l15;
        float bp[4];
#pragma unroll
        for (int r = 0; r < 4; ++r) { const int tk = quad * 4 + r;
            LA[tk * 72 + cc] = f2bf(-tA[nt][r] * inv[r]); LB[tk * 72 + cc] = f2bf(tBi[nt][r] * inv[r]); bp[r] = tBp[nt][r] * inv[r]; }
        *(u32x2*)(rec + R_BP + cc * 32 + quad * 8) = (u32x2){pk2(bp[0], bp[1]), pk2(bp[2], bp[3])};
    }
    LDS_WAIT();
#pragma unroll
    for (int i = 0; i < 2; ++i) { const int idx = lane + 64 * i, rr = idx >> 3, c8 = (idx & 7) * 8;
        *(u32x4*)(rec + R_AT + rr * 128 + c8 * 2) = *(const LAS u32x4*)(LA + rr * 72 + c8);
        *(u32x4*)(rec + R_RT + rr * 128 + c8 * 2) = *(const LAS u32x4*)(LR + rr * 72 + c8); }
    f32x4 nab = {0.f, 0.f, 0.f, 0.f}, nak = nab, nrb = nab, nrk = nab;
#pragma unroll
    for (int ks = 0; ks < 2; ++ks) {
        const bf16x8 fa = *(const LAS bf16x8*)(LA + l15 * 72 + ks * 32 + quad * 8), fr_ = *(const LAS bf16x8*)(LR + l15 * 72 + ks * 32 + quad * 8);
        const bf16x8 fb = *(const LAS bf16x8*)(LB + l15 * 72 + ks * 32 + quad * 8), fk = *(const LAS bf16x8*)(LK + l15 * 72 + ks * 32 + quad * 8);
        nab = MFMA32(fa, fb, nab); nak = MFMA32(fa, fk, nak); nrb = MFMA32(fr_, fb, nrb); nrk = MFMA32(fr_, fk, nrk);
    }
#pragma unroll
    for (int r = 0; r < 4; ++r) {
        const int t = quad * 4 + r, j = l15;
        const float vab = (j < t) ? nab[r] : 0.f, vak = (j < t) ? nak[r] : 0.f, vrb = (j <= t) ? nrb[r] : 0.f, vrk = (j <= t) ? nrk[r] : 0.f;
        LN[t * 16 + j] = vab;
        *(bf16_t*)(rec + R_AAK + (t * 16 + j) * 2) = f2bf(vak);
        *(bf16_t*)(rec + R_ARB + (t * 16 + j) * 2) = f2bf(vrb);
        *(bf16_t*)(rec + R_ARK + (t * 16 + j) * 2) = f2bf(vrk);
    }
    LDS_WAIT();
    if (lane < 16) {
        float tc[16];
#pragma unroll
        for (int t = 0; t < 16; ++t) {
            float s = (t == lane) ? 1.f : 0.f;
#pragma unroll
            for (int j = 0; j < t; ++j) s += LN[t * 16 + j] * tc[j];
            tc[t] = s;
            *(bf16_t*)(rec + R_TT + (t * 16 + lane) * 2) = f2bf(s);
        }
    }
    LDS_WAIT();
}

__device__ __forceinline__ bf16x8 k16(u32x2 v) { const u32x4 w = {v.x, v.y, 0u, 0u}; return __builtin_bit_cast(bf16x8, w); }
#define SCAN_DECL(F) bf16x8 F##_at0, F##_at1, F##_rt0, F##_rt1; u32x2 F##_aak, F##_tt, F##_arb, F##_ark, F##_vt, F##_bp0, F##_bp1, F##_bp2, F##_bp3, F##_kp0, F##_kp1, F##_kp2, F##_kp3; float F##_wc0, F##_wc1, F##_wc2, F##_wc3
#define SCAN_LOAD(F, REC_) do { const unsigned char* rec_ = (REC_); \
    F##_at0 = *(const bf16x8*)(rec_ + R_AT + o_nat); F##_at1 = *(const bf16x8*)(rec_ + R_AT + o_nat + 64); \
    F##_rt0 = *(const bf16x8*)(rec_ + R_RT + o_nat); F##_rt1 = *(const bf16x8*)(rec_ + R_RT + o_nat + 64); \
    F##_aak = *(const u32x2*)(rec_ + R_AAK + o_sm); F##_tt = *(const u32x2*)(rec_ + R_TT + o_sm); F##_arb = *(const u32x2*)(rec_ + R_ARB + o_sm); F##_ark = *(const u32x2*)(rec_ + R_ARK + o_sm); \
    F##_vt = *(const u32x2*)(rec_ + R_VT + vt * 512 + o_sm); \
    F##_bp0 = *(const u32x2*)(rec_ + R_BP + o_sm); F##_bp1 = *(const u32x2*)(rec_ + R_BP + 512 + o_sm); F##_bp2 = *(const u32x2*)(rec_ + R_BP + 1024 + o_sm); F##_bp3 = *(const u32x2*)(rec_ + R_BP + 1536 + o_sm); \
    F##_kp0 = *(const u32x2*)(rec_ + R_KP + o_sm); F##_kp1 = *(const u32x2*)(rec_ + R_KP + 512 + o_sm); F##_kp2 = *(const u32x2*)(rec_ + R_KP + 1024 + o_sm); F##_kp3 = *(const u32x2*)(rec_ + R_KP + 1536 + o_sm); \
    F##_wc0 = *(const float*)(rec_ + R_WC + l15 * 4); F##_wc1 = *(const float*)(rec_ + R_WC + 64 + l15 * 4); F##_wc2 = *(const float*)(rec_ + R_WC + 128 + l15 * 4); F##_wc3 = *(const float*)(rec_ + R_WC + 192 + l15 * 4); } while (0)
#define SCAN_UPD(NT, BP, KP, WC) do { f32x4 sn = S##NT * (WC); sn = MFMA32(ua, k16(BP), sn); sn = MFMA32(vtf, k16(KP), sn); S##NT = sn; \
    _Pragma("unroll") for (int r = 0; r < 4; ++r) Sb[(quad * 4 + r) * 72 + NT * 16 + l15] = f2bf(sn[r]); } while (0)
#define SCAN_STEP(F, N, CH) do { const int ch_ = (CH); \
    SCAN_LOAD(N, rec0 + (size_t)(ch_ < 126 ? ch_ + 2 : 127) * REC); \
    const bf16x8 sa0 = *(const LAS bf16x8*)(Sb + l15 * 72 + quad * 8), sa1 = *(const LAS bf16x8*)(Sb + l15 * 72 + 32 + quad * 8); \
    const bf16x8 vtf = k16(F##_vt); const f32x4 z = {0.f, 0.f, 0.f, 0.f}; \
    f32x4 Y = MFMA32(sa0, F##_at0, z); Y = MFMA32(sa1, F##_at1, Y); Y = MFMA32(vtf, k16(F##_aak), Y); \
    _Pragma("unroll") for (int r = 0; r < 4; ++r) Yb[(quad * 4 + r) * 16 + l15] = f2bf(Y[r]); \
    LDS_WAIT(); \
    const bf16x8 ya = k16(*(const LAS u32x2*)(Yb + l15 * 16 + quad * 4)); \
    f32x4 U = MFMA32(ya, k16(F##_tt), z); \
    _Pragma("unroll") for (int r = 0; r < 4; ++r) Ub[(quad * 4 + r) * 16 + l15] = f2bf(U[r]); \
    LDS_WAIT(); \
    const bf16x8 ua = k16(*(const LAS u32x2*)(Ub + l15 * 16 + quad * 4)); \
    f32x4 O = MFMA32(sa0, F##_rt0, z); O = MFMA32(sa1, F##_rt1, O); O = MFMA32(ua, k16(F##_arb), O); O = MFMA32(vtf, k16(F##_ark), O); \
    *(u32x2*)(ob + (size_t)(ch_ * 16 + l15) * D) = (u32x2){pk2(O[0], O[1]), pk2(O[2], O[3])}; \
    SCAN_UPD(0, F##_bp0, F##_kp0, F##_wc0); SCAN_UPD(1, F##_bp1, F##_kp1, F##_wc1); SCAN_UPD(2, F##_bp2, F##_kp2, F##_wc2); SCAN_UPD(3, F##_bp3, F##_kp3, F##_wc3); \
    LDS_WAIT(); __builtin_amdgcn_sched_barrier(0); } while (0)
__device__ __forceinline__ void rw_scan_task(const Args& a, LAS unsigned char* wl  , int b, int h, int vt, int lane) {
    unsigned char* ws = a.ws;
    const int l15 = lane & 15, quad = lane >> 4;
    LAS bf16_t* Sb = (LAS bf16_t*)wl;
    LAS bf16_t* Yb = (LAS bf16_t*)(wl + 2304);
    LAS bf16_t* Ub = (LAS bf16_t*)(wl + 2304 + 512);
    const int o_nat = l15 * 128 + quad * 16, o_sm = l15 * 32 + quad * 8;
    const unsigned char* rec0 = ws + WS_CH + (size_t)((b * 16 + h) * 128) * REC;
    bf16_t* ob = (bf16_t*)(ws + WS_OB) + (size_t)(b * T) * D + h * 64 + vt * 16 + quad * 4;
    f32x4 S0 = {0.f, 0.f, 0.f, 0.f}, S1 = S0, S2 = S0, S3 = S0;
#pragma unroll
    for (int nt = 0; nt < 4; ++nt)
#pragma unroll
        for (int r = 0; r < 4; ++r) Sb[(quad * 4 + r) * 72 + nt * 16 + l15] = 0;
    LDS_WAIT();
    SCAN_DECL(f0); SCAN_DECL(f1); SCAN_DECL(f2);
    SCAN_LOAD(f0, rec0); SCAN_LOAD(f1, rec0 + REC);
    for (int ch = 0; ch < 126; ch += 3) { SCAN_STEP(f0, f2, ch); SCAN_STEP(f1, f0, ch + 1); SCAN_STEP(f2, f1, ch + 2); }
    SCAN_STEP(f0, f2, 126); SCAN_STEP(f1, f0, 127);
    float* so = a.out + OUT_RWP + (size_t)((b * 16 + h) * 64 + vt * 16) * 64;
#pragma unroll
    for (int r = 0; r < 4; ++r) { so[(quad * 4 + r) * 64 + l15] = S0[r]; so[(quad * 4 + r) * 64 + 16 + l15] = S1[r]; so[(quad * 4 + r) * 64 + 32 + l15] = S2[r]; so[(quad * 4 + r) * 64 + 48 + l15] = S3[r]; }
}

__device__ __forceinline__ void rw_sample_wave(const Args& a, int i, int h, int lane) {
    unsigned char* ws = a.ws;
    const float* s0 = a.in[I_SRW] + ((size_t)(i * 16 + h) * 64 + lane) * 64;
    const float* op = (const float*)(ws + WS_OPSS) + (size_t)(i * 16 + h) * 6 * 64;
    float s[64];
#pragma unroll
    for (int j = 0; j < 16; ++j) { const f32x4 t = ((const f32x4*)s0)[j]; s[4 * j] = t.x; s[4 * j + 1] = t.y; s[4 * j + 2] = t.z; s[4 * j + 3] = t.w; }
    const float r_l = op[lane], w_l = op[64 + lane], k_l = op[128 + lane], kk_l = op[192 + lane], b_l = op[256 + lane], v = op[320 + lane];
#define RL(x, j) __builtin_bit_cast(float, __builtin_amdgcn_readlane(__builtin_bit_cast(int, (x)), (j)))
    float sk = 0.f;
#pragma unroll
    for (int j = 0; j < 64; ++j) sk += s[j] * RL(kk_l, j);
    float o = 0.f;
#pragma unroll
    for (int j = 0; j < 64; ++j) { s[j] = s[j] * RL(w_l, j) - sk * RL(b_l, j) + v * RL(k_l, j); o += s[j] * RL(r_l, j); }
#undef RL
    float* so = a.out + OUT_RWS + ((size_t)(i * 16 + h) * 64 + lane) * 64;
#pragma unroll
    for (int j = 0; j < 16; ++j) ((f32x4*)so)[j] = (f32x4){s[4 * j], s[4 * j + 1], s[4 * j + 2], s[4 * j + 3]};
    ((bf16_t*)(ws + WS_OB))[(size_t)(MP + i) * D + h * 64 + lane] = f2bf(o);
}

constexpr int KN_LD = 264, VS_LD = 136, SS_LD = 264;
constexpr int L_KN = 0, L_VS = 128 * KN_LD * 2  , L_SS = L_VS + 64 * VS_LD * 2  , L_RET_END = L_SS + 64 * SS_LD * 2  ;
__device__ __forceinline__ void ret_unit(const Args& a, LAS unsigned char* lds, int unit, int tid) {
    unsigned char* ws = a.ws;
    const bf16_t* P = (const bf16_t*)(ws + WS_P);
    const int dvs = unit & 7, h = (unit >> 3) & 3, b = unit >> 5;
    const int wave = tid >> 6, lane = tid & 63, l15 = lane & 15, quad = lane >> 4;
    LAS bf16_t* KN = (LAS bf16_t*)(lds + L_KN); LAS bf16_t* VS = (LAS bf16_t*)(lds + L_VS); LAS bf16_t* SS = (LAS bf16_t*)(lds + L_SS);
    const float g = 1.f - exp2f(-5.f - (float)h), l2g = __log2f(g);
    const float gC = exp2f(128.f * l2g), ginvC = exp2f(-128.f * l2g);
    const bf16_t* KT = (const bf16_t*)(ws + WS_KT) + (size_t)(b * 4 + h) * 256 * T;
    f32x4 sacc[2][4];
#pragma unroll
    for (int n = 0; n < 2; ++n)
#pragma unroll
        for (int d = 0; d < 4; ++d) sacc[n][d] = (f32x4){0.f, 0.f, 0.f, 0.f};
    for (int i = tid; i < 64 * SS_LD / 2; i += 512) ((LAS unsigned*)SS)[i] = 0u;
    const int it = wave;
    u32x4 stk[8], stv[2];
#define RET_ISSUE(CC) do { const int tok0_ = b * T + (CC) * 128; \
        _Pragma("unroll") for (int i = 0; i < 8; ++i) { const int idx = tid + 512 * i, r = idx >> 5, c8 = (idx & 31) * 8; stk[i] = *(const u32x4*)(P + (size_t)(tok0_ + r) * NP + O_K + h * 256 + c8); } \
        _Pragma("unroll") for (int i = 0; i < 2; ++i) { const int idx = tid + 512 * i, r = idx >> 4, c8 = (idx & 15) * 8; stv[i] = *(const u32x4*)(P + (size_t)(b * T + h * 512 + dvs * 64 + r) * NP + O_V + (CC) * 128 + c8); } } while (0)
    RET_ISSUE(0);
    for (int c = 0; c < 16; ++c) {
        const int tok0 = b * T + c * 128;
        bf16x8 qf[8];
#pragma unroll
        for (int ks = 0; ks < 8; ++ks) qf[ks] = *(const bf16x8*)(P + (size_t)(tok0 + it * 16 + l15) * NP + h * 256 + ks * 32 + quad * 8);
#pragma unroll
        for (int i = 0; i < 8; ++i) { const int idx = tid + 512 * i, r = idx >> 5, c8 = (idx & 31) * 8; *(LAS u32x4*)(KN + r * KN_LD + c8) = stk[i]; }
#pragma unroll
        for (int i = 0; i < 2; ++i) { const int idx = tid + 512 * i, r = idx >> 4, c8 = (idx & 15) * 8; *(LAS u32x4*)(VS + r * VS_LD + c8) = stv[i]; }
        __syncthreads();
        bf16x8 ktf[2][4];
#pragma unroll
        for (int n = 0; n < 2; ++n)
#pragma unroll
            for (int ks = 0; ks < 4; ++ks) ktf[n][ks] = *(const bf16x8*)(KT + (size_t)((2 * wave + n) * 16 + l15) * T + c * 128 + ks * 32 + quad * 8);
        if (c < 15) RET_ISSUE(c + 1);
        f32x4 oacc[4];
#pragma unroll
        for (int d = 0; d < 4; ++d) oacc[d] = (f32x4){0.f, 0.f, 0.f, 0.f};
#pragma unroll
        for (int ks = 0; ks < 8; ++ks)
#pragma unroll
            for (int d = 0; d < 4; ++d) { const bf16x8 sb = *(const LAS bf16x8*)(SS + (d * 16 + l15) * SS_LD + ks * 32 + quad * 8); oacc[d] = MFMA32(qf[ks], sb, oacc[d]); }
#pragma unroll
        for (int p = 0; p < 4; ++p) {
            if (2 * p <= it) {
                f32x4 s0 = {0.f, 0.f, 0.f, 0.f}, s1 = {0.f, 0.f, 0.f, 0.f};
#pragma unroll
                for (int ks = 0; ks < 8; ++ks) { const bf16x8 ka = *(const LAS bf16x8*)(KN + ((2 * p) * 16 + l15) * KN_LD + ks * 32 + quad * 8); s0 = MFMA32(ka, qf[ks], s0); }
                if (2 * p + 1 <= it) {
#pragma unroll
                    for (int ks = 0; ks < 8; ++ks) { const bf16x8 ka = *(const LAS bf16x8*)(KN + ((2 * p + 1) * 16 + l15) * KN_LD + ks * 32 + quad * 8); s1 = MFMA32(ka, qf[ks], s1); }
                }
#pragma unroll
                for (int r = 0; r < 4; ++r) {
                    const int jl = quad * 4 + r;
                    s0[r] = (2 * p == it && jl > l15) ? 0.f : s0[r] * ginvC;
                    s1[r] = (2 * p + 1 > it || (2 * p + 1 == it && jl > l15)) ? 0.f : s1[r] * ginvC;
                }
                u32x4 aw; aw.x = pk2(s0[0], s0[1]); aw.y = pk2(s0[2], s0[3]); aw.z = pk2(s1[0], s1[1]); aw.w = pk2(s1[2], s1[3]);
                const bf16x8 af = __builtin_bit_cast(bf16x8, aw);
#pragma unroll
                for (int d = 0; d < 4; ++d) {
                    const LAS bf16_t* vr = VS + (d * 16 + l15) * VS_LD + 32 * p + quad * 4;
                    const u32x2 lo = *(const LAS u32x2*)vr, hi = *(const LAS u32x2*)(vr + 16);
                    const u32x4 bw = {lo.x, lo.y, hi.x, hi.y};
                    oacc[d] = MFMA32(af, __builtin_bit_cast(bf16x8, bw), oacc[d]);
                }
            }
        }
        {
            bf16_t* OA = (bf16_t*)(ws + WS_OA); float* SQA = (float*)(ws + WS_SQA);
#pragma unroll
            for (int r = 0; r < 4; ++r) {
                const int tok = tok0 + it * 16 + quad * 4 + r;
                float ss = 0.f;
#pragma unroll
                for (int d = 0; d < 4; ++d) { const float v = oacc[d][r]; ss += v * v; OA[(size_t)tok * 2048 + h * 512 + dvs * 64 + d * 16 + l15] = f2bf(v); }
#pragma unroll
                for (int o = 1; o < 16; o <<= 1) ss += __shfl_xor(ss, o);
                if (l15 == 0) SQA[(size_t)tok * 32 + h * 8 + dvs] = ss;
            }
        }
        __syncthreads();
#pragma unroll
        for (int n = 0; n < 2; ++n)
#pragma unroll
            for (int d = 0; d < 4; ++d) {
                f32x4 s = sacc[n][d] * gC;
#pragma unroll
                for (int ks = 0; ks < 4; ++ks) { const bf16x8 va = *(const LAS bf16x8*)(VS + (d * 16 + l15) * VS_LD + ks * 32 + quad * 8); s = MFMA32(va, ktf[n][ks], s); }
                sacc[n][d] = s;
#pragma unroll
                for (int r = 0; r < 4; ++r) SS[(d * 16 + quad * 4 + r) * SS_LD + (2 * wave + n) * 16 + l15] = f2bf(s[r]);
            }
        __syncthreads();
    }
    float* so = a.out + OUT_RETP + (size_t)(b * 4 + h) * 256 * 512;
#pragma unroll
    for (int n = 0; n < 2; ++n)
#pragma unroll
        for (int d = 0; d < 4; ++d) *(f32x4*)(so + (size_t)((2 * wave + n) * 16 + l15) * 512 + dvs * 64 + d * 16 + quad * 4) = sacc[n][d];
}
#undef RET_ISSUE

__device__ __forceinline__ void ret_sample_unit(const Args& a, LAS unsigned char* lds, int i, int h, int tid) {
    unsigned char* ws = a.ws;
    const bf16_t* Prow = (const bf16_t*)(ws + WS_P) + (size_t)(MP + i) * NP;
    LAS float* Q = (LAS float*)lds; LAS float* Kh = Q + 256; LAS float* RED = Kh + 256; LAS float* OS = RED + 16;
    const float g = 1.f - exp2f(-5.f - (float)h);
    const int lane = tid & 63, wave = tid >> 6;
    float qk = 0.f;
    if (tid < 256) { const float q = bf2f(Prow[h * 256 + tid]), k = bf2f(Prow[O_K + h * 256 + tid]); Q[tid] = q; Kh[tid] = k; qk = q * k; }
    qk = wave_sum(qk);
    if (lane == 0) RED[wave] = qk;
    __syncthreads();
    const float qkv = (RED[0] + RED[1] + RED[2] + RED[3]) / g;
    const int dkg = tid >> 7, dv4 = 4 * (tid & 127);
    const u32x2 vw = *(const u32x2*)(Prow + O_V + h * 512 + dv4);
    const f32x4 v = {bflo(vw.x), bfhi(vw.x), bflo(vw.y), bfhi(vw.y)};
    const float* s0 = a.in[I_SRET] + (size_t)(i * 4 + h) * 256 * 512 + dv4;
    float* s1 = a.out + OUT_RETS + (size_t)(i * 4 + h) * 256 * 512 + dv4;
    f32x4 o = {0.f, 0.f, 0.f, 0.f};
#pragma unroll 8
    for (int j = 0; j < 64; ++j) {
        const int dk = dkg * 64 + j;
        const f32x4 s = __builtin_nontemporal_load((const f32x4*)(s0 + (size_t)dk * 512));
        o += s * Q[dk];
        __builtin_nontemporal_store(s * g + v * Kh[dk], (f32x4*)(s1 + (size_t)dk * 512));
    }
    *(LAS f32x4*)(OS + dkg * 512 + dv4) = o;
    __syncthreads();
    float y[4] = {0.f, 0.f, 0.f, 0.f}; float ss = 0.f;
    if (tid < 128) {
        const f32x4 t = *(LAS f32x4*)(OS + dv4) + *(LAS f32x4*)(OS + 512 + dv4) + *(LAS f32x4*)(OS + 1024 + dv4) + *(LAS f32x4*)(OS + 1536 + dv4) + v * qkv;
        y[0] = t.x; y[1] = t.y; y[2] = t.z; y[3] = t.w; ss = t.x * t.x + t.y * t.y + t.z * t.z + t.w * t.w;
    }
    ss = wave_sum(ss);
    if (lane == 0) RED[8 + wave] = ss;
    __syncthreads();
    if (tid < 128) {
        const float rs = 1.0f / sqrtf((RED[8] + RED[9]) * (1.f / 512.f) + EPS);
        const u32x2 gw = *(const u32x2*)(Prow + O_GA + h * 512 + dv4);
        u32x2 ow; ow.x = pk2(y[0] * rs * silu_(bflo(gw.x)), y[1] * rs * silu_(bfhi(gw.x))); ow.y = pk2(y[2] * rs * silu_(bflo(gw.y)), y[3] * rs * silu_(bfhi(gw.y)));
        *(u32x2*)((bf16_t*)(ws + WS_OA) + (size_t)(MP + i) * 2048 + h * 512 + dv4) = ow;
    }
    __syncthreads();
}

__device__ __forceinline__ void ret_sample_wave(const Args& a, int i, int h, int lane) {
    unsigned char* ws = a.ws;
    const bf16_t* Prow = (const bf16_t*)(ws + WS_P) + (size_t)(MP + i) * NP;
    const float g = 1.f - exp2f(-5.f - (float)h);
    float q[4], k[4]; float qk = 0.f;
#pragma unroll
    for (int j = 0; j < 4; ++j) { q[j] = bf2f(Prow[h * 256 + 64 * j + lane]); k[j] = bf2f(Prow[O_K + h * 256 + 64 * j + lane]); qk += q[j] * k[j]; }
    const float qkv = wave_sum(qk) / g;
    f32x4 v[2];
#pragma unroll
    for (int e = 0; e < 2; ++e) { const u32x2 vw = *(const u32x2*)(Prow + O_V + h * 512 + e * 256 + lane * 4); v[e] = (f32x4){bflo(vw.x), bfhi(vw.x), bflo(vw.y), bfhi(vw.y)}; }
    const float* s0 = a.in[I_SRET] + (size_t)(i * 4 + h) * 256 * 512 + lane * 4;
    float* s1 = a.out + OUT_RETS + (size_t)(i * 4 + h) * 256 * 512 + lane * 4;
    f32x4 o[2] = {{0.f, 0.f, 0.f, 0.f}, {0.f, 0.f, 0.f, 0.f}};
#pragma unroll
    for (int j = 0; j < 4; ++j) {
        for (int d0 = 0; d0 < 64; d0 += 16) {
            f32x4 sv[16][2];
#pragma unroll
            for (int d = 0; d < 16; ++d)
#pragma unroll
                for (int e = 0; e < 2; ++e) sv[d][e] = __builtin_nontemporal_load((const f32x4*)(s0 + (size_t)(64 * j + d0 + d) * 512 + e * 256));
#pragma unroll
            for (int d = 0; d < 16; ++d) {
                const float qd = __builtin_bit_cast(float, __builtin_amdgcn_readlane(__builtin_bit_cast(int, q[j]), d0 + d));
                const float kd = __builtin_bit_cast(float, __builtin_amdgcn_readlane(__builtin_bit_cast(int, k[j]), d0 + d));
#pragma unroll
                for (int e = 0; e < 2; ++e) { o[e] += sv[d][e] * qd; __builtin_nontemporal_store(sv[d][e] * g + v[e] * kd, (f32x4*)(s1 + (size_t)(64 * j + d0 + d) * 512 + e * 256)); }
            }
        }
    }
    float ss = 0.f;
#pragma unroll
    for (int e = 0; e < 2; ++e) { o[e] += v[e] * qkv; ss += (o[e].x * o[e].x + o[e].y * o[e].y) + (o[e].z * o[e].z + o[e].w * o[e].w); }
    const float rs = 1.0f / sqrtf(wave_sum(ss) * (1.f / 512.f) + EPS);
#pragma unroll
    for (int e = 0; e < 2; ++e) { const u32x2 gw = *(const u32x2*)(Prow + O_GA + h * 512 + e * 256 + lane * 4);
        u32x2 ow; ow.x = pk2(o[e].x * rs * silu_(bflo(gw.x)), o[e].y * rs * silu_(bfhi(gw.x))); ow.y = pk2(o[e].z * rs * silu_(bflo(gw.y)), o[e].w * rs * silu_(bfhi(gw.y)));
        *(u32x2*)((bf16_t*)(ws + WS_OA) + (size_t)(MP + i) * 2048 + h * 512 + e * 256 + lane * 4) = ow; }
}

__device__ __forceinline__ void phase25_row(const Args& a, int m, int lane) {
    unsigned char* ws = a.ws;
    const bf16_t* Prow = (const bf16_t*)(ws + WS_P) + (size_t)m * NP;
    bf16_t* oa = (bf16_t*)(ws + WS_OA) + (size_t)m * 2048;
    const float* sq = (const float*)(ws + WS_SQA) + (size_t)m * 32;
    const bool prompt = m < MP;
    f32x4 sqv[8]; u32x4 ow[4], gw4[4];
    if (prompt) {
#pragma unroll
        for (int j = 0; j < 8; ++j) sqv[j] = ((const f32x4*)sq)[j];
#pragma unroll
        for (int hh = 0; hh < 4; ++hh) { ow[hh] = *(const u32x4*)(oa + hh * 512 + lane * 8); gw4[hh] = *(const u32x4*)(Prow + O_GA + hh * 512 + lane * 8); }
    }
    const bf16_t* ob = (const bf16_t*)(ws + WS_OB) + (size_t)m * D + lane * 16;
    f32x4 ov[4];
    { const u32x4 w0 = ((const u32x4*)ob)[0], w1 = ((const u32x4*)ob)[1];
      ov[0] = (f32x4){bflo(w0.x), bfhi(w0.x), bflo(w0.y), bfhi(w0.y)}; ov[1] = (f32x4){bflo(w0.z), bfhi(w0.z), bflo(w0.w), bfhi(w0.w)};
      ov[2] = (f32x4){bflo(w1.x), bfhi(w1.x), bflo(w1.y), bfhi(w1.y)}; ov[3] = (f32x4){bflo(w1.z), bfhi(w1.z), bflo(w1.w), bfhi(w1.w)}; }
    const float bc = ((const float*)(ws + WS_BC))[(size_t)m * 16 + (lane >> 2)];
    const bf16_t* cur = Prow + O_SH + 2048 + lane * 16;
    const bool hasp = (m >= MP) || (m & (T - 1));
    const bf16_t* prv = (m >= MP) ? cur + (size_t)MS * NP : cur - NP;
    u32x4 cw[2], pw[2] = {{0u, 0u, 0u, 0u}, {0u, 0u, 0u, 0u}}, gbw[2];
    cw[0] = ((const u32x4*)cur)[0]; cw[1] = ((const u32x4*)cur)[1];
    if (hasp) { pw[0] = ((const u32x4*)prv)[0]; pw[1] = ((const u32x4*)prv)[1]; }
    gbw[0] = ((const u32x4*)(Prow + O_GB + lane * 16))[0]; gbw[1] = ((const u32x4*)(Prow + O_GB + lane * 16))[1];
    f32x4 lw4[4], lb4[4], mu4[4];
#pragma unroll
    for (int j = 0; j < 4; ++j) { lw4[j] = ((const f32x4*)(a.in[I_LNW] + lane * 16))[j]; lb4[j] = ((const f32x4*)(a.in[I_LNB] + lane * 16))[j]; mu4[j] = ((const f32x4*)(a.in[I_MU] + 2048 + lane * 16))[j]; }
    if (prompt) {
#pragma unroll
        for (int hh = 0; hh < 4; ++hh) {
            const f32x4 s0 = sqv[2 * hh], s1 = sqv[2 * hh + 1];
            const float rs = 1.0f / sqrtf(((s0.x + s0.y) + (s0.z + s0.w) + (s1.x + s1.y) + (s1.z + s1.w)) * (1.f / 512.f) + EPS);
            const u32x4 o4 = ow[hh], g4 = gw4[hh];
            u32x4 r;
            r.x = pk2(bflo(o4.x) * rs * silu_(bflo(g4.x)), bfhi(o4.x) * rs * silu_(bfhi(g4.x))); r.y = pk2(bflo(o4.y) * rs * silu_(bflo(g4.y)), bfhi(o4.y) * rs * silu_(bfhi(g4.y)));
            r.z = pk2(bflo(o4.z) * rs * silu_(bflo(g4.z)), bfhi(o4.z) * rs * silu_(bfhi(g4.z))); r.w = pk2(bflo(o4.w) * rs * silu_(bflo(g4.w)), bfhi(o4.w) * rs * silu_(bfhi(g4.w)));
            *(u32x4*)(oa + hh * 512 + lane * 8) = r;
        }
    }
    float o[16], lw[16], lb[16], mu[16];
#pragma unroll
    for (int j = 0; j < 4; ++j) { o[4 * j] = ov[j].x; o[4 * j + 1] = ov[j].y; o[4 * j + 2] = ov[j].z; o[4 * j + 3] = ov[j].w;
        lw[4 * j] = lw4[j].x; lw[4 * j + 1] = lw4[j].y; lw[4 * j + 2] = lw4[j].z; lw[4 * j + 3] = lw4[j].w;
        lb[4 * j] = lb4[j].x; lb[4 * j + 1] = lb4[j].y; lb[4 * j + 2] = lb4[j].z; lb[4 * j + 3] = lb4[j].w;
        mu[4 * j] = mu4[j].x; mu[4 * j + 1] = mu4[j].y; mu[4 * j + 2] = mu4[j].z; mu[4 * j + 3] = mu4[j].w; }
    float s = 0.f;
#pragma unroll
    for (int j = 0; j < 16; ++j) s += o[j];
    s += __shfl_xor(s, 1); s += __shfl_xor(s, 2);
    const float mean = s * (1.f / 64.f);
    float q = 0.f;
#pragma unroll
    for (int j = 0; j < 16; ++j) { const float d = o[j] - mean; q += d * d; }
    q += __shfl_xor(q, 1); q += __shfl_xor(q, 2);
    const float rstd = 1.0f / sqrtf(q * (1.f / 64.f) + 64e-5f);
    const unsigned cws[8] = {cw[0].x, cw[0].y, cw[0].z, cw[0].w, cw[1].x, cw[1].y, cw[1].z, cw[1].w};
    const unsigned pws[8] = {pw[0].x, pw[0].y, pw[0].z, pw[0].w, pw[1].x, pw[1].y, pw[1].z, pw[1].w};
    const unsigned gws[8] = {gbw[0].x, gbw[0].y, gbw[0].z, gbw[0].w, gbw[1].x, gbw[1].y, gbw[1].z, gbw[1].w};
    unsigned outw[8];
#pragma unroll
    for (int j = 0; j < 8; ++j) {
        const float c0 = bflo(cws[j]), c1 = bfhi(cws[j]), p0 = bflo(pws[j]), p1 = bfhi(pws[j]);
        const float v0 = c0 + (p0 - c0) * mu[2 * j], v1 = c1 + (p1 - c1) * mu[2 * j + 1];
        const float y0 = ((o[2 * j] - mean) * rstd * lw[2 * j] + lb[2 * j] + bc * v0) * silu_(bflo(gws[j]));
        const float y1 = ((o[2 * j + 1] - mean) * rstd * lw[2 * j + 1] + lb[2 * j + 1] + bc * v1) * silu_(bfhi(gws[j]));
        outw[j] = pk2(y0, y1);
    }
    bf16_t* yb = (bf16_t*)(ws + WS_H) + (size_t)m * D + lane * 16;
    *(u32x4*)yb = (u32x4){outw[0], outw[1], outw[2], outw[3]}; *(u32x4*)(yb + 8) = (u32x4){outw[4], outw[5], outw[6], outw[7]};
}

struct EpiT1 {
    static constexpr bool PERM = false;
    const bf16_t* P; bf16_t* T1;
    __device__ __forceinline__ void operator()(const f32x4 (&acc)[2][2][4][2], const Unit& u, int wr, int wc, int fr, int fq) const {
        const int row0 = u.pm * 256 + wr * 64 + fr, col0 = u.pn * 256 + wc * 32 + 4 * fq;
#pragma unroll
        for (int ai = 0; ai < 2; ++ai)
#pragma unroll
            for (int m = 0; m < 4; ++m) { const int row = row0 + ai * 128 + m * 16; if (row >= MR) continue;
#pragma unroll
                for (int bj = 0; bj < 2; ++bj)
#pragma unroll
                    for (int n = 0; n < 2; ++n) { const int col = col0 + bj * 128 + n * 16;
                        const u32x2 gw = *(const u32x2*)(P + (size_t)row * NP + O_MA + col);
                        const f32x4 gt = {sigm(bflo(gw.x)), sigm(bfhi(gw.x)), sigm(bflo(gw.y)), sigm(bfhi(gw.y))};
                        const f32x4 t = acc[ai][bj][m][n] * gt; *(u32x2*)(T1 + (size_t)row * D + col) = (u32x2){pk2(t.x, t.y), pk2(t.z, t.w)}; } asm volatile("" ::: "memory"); }
    }
};
struct EpiMG {
    static constexpr bool PERM = false;
    const bf16_t* P; const bf16_t* T1; bf16_t* MG;
    __device__ __forceinline__ void operator()(const f32x4 (&acc)[2][2][4][2], const Unit& u, int wr, int wc, int fr, int fq) const {
        const int row0 = u.pm * 256 + wr * 64 + fr, col0 = u.pn * 256 + wc * 32 + 4 * fq;
#pragma unroll
        for (int ai = 0; ai < 2; ++ai)
#pragma unroll
            for (int m = 0; m < 4; ++m) { const int row = row0 + ai * 128 + m * 16; if (row >= MR) continue;
#pragma unroll
                for (int bj = 0; bj < 2; ++bj)
#pragma unroll
                    for (int n = 0; n < 2; ++n) { const int col = col0 + bj * 128 + n * 16;
                        const u32x2 gw = *(const u32x2*)(P + (size_t)row * NP + O_MB + col);
                        const f32x4 gt = {sigm(bflo(gw.x)), sigm(bfhi(gw.x)), sigm(bflo(gw.y)), sigm(bfhi(gw.y))};
                        const u32x2 tw = *(const u32x2*)(T1 + (size_t)row * D + col);
                        const f32x4 v = (f32x4){bflo(tw.x), bfhi(tw.x), bflo(tw.y), bfhi(tw.y)} + acc[ai][bj][m][n] * gt;
                        *(u32x2*)(MG + (size_t)row * D + col) = (u32x2){pk2(v.x, v.y), pk2(v.z, v.w)}; } asm volatile("" ::: "memory"); }
    }
};
struct EpiX1 {
    static constexpr bool PERM = false;
    const float* xp; const float* xs; float* X1; bf16_t* X1B; float* SQ;
    __device__ __forceinline__ void operator()(const f32x4 (&acc)[2][2][4][2], const Unit& u, int wr, int wc, int fr, int fq) const {
        const int row0 = u.pm * 256 + wr * 64 + fr, col0 = u.pn * 256 + wc * 32 + 4 * fq;
#pragma unroll
        for (int ai = 0; ai < 2; ++ai)
#pragma unroll
            for (int m = 0; m < 4; ++m) { const int row = row0 + ai * 128 + m * 16; const bool ok = row < MR;
                const float* xr = (row < MP) ? xp + (size_t)row * D : xs + (size_t)(row - MP) * D;
                float ss = 0.f;
                if (ok) {
#pragma unroll
                    for (int bj = 0; bj < 2; ++bj)
#pragma unroll
                        for (int n = 0; n < 2; ++n) { const int col = col0 + bj * 128 + n * 16;
                            const f32x4 v = *(const f32x4*)(xr + col) + acc[ai][bj][m][n];
                            ss += (v.x * v.x + v.y * v.y) + (v.z * v.z + v.w * v.w);
                            *(u32x2*)(X1B + (size_t)row * D + col) = (u32x2){pk2(v.x, v.y), pk2(v.z, v.w)}; }
                }
                ss += __shfl_xor(ss, 16); ss += __shfl_xor(ss, 32);
                if (ok && fq == 0) SQ[(size_t)row * 16 + u.pn * 4 + wc] = ss; asm volatile("" ::: "memory"); }
    }
};
struct EpiGT {
    static constexpr bool PERM = false;
    const float* SQ; bf16_t* GT;
    __device__ __forceinline__ void operator()(const f32x4 (&acc)[2][2][4][2], const Unit& u, int wr, int wc, int fr, int fq) const {
        const int row0 = u.pm * 256 + wr * 64 + fr, col0 = u.pn * 256 + wc * 32 + 4 * fq;
#pragma unroll
        for (int ai = 0; ai < 2; ++ai)
#pragma unroll
            for (int m = 0; m < 4; ++m) { const int row = row0 + ai * 128 + m * 16; if (row >= MR) continue;
                const f32x4* sp = (const f32x4*)(SQ + (size_t)row * 16); const f32x4 q0 = sp[0], q1 = sp[1], q2 = sp[2], q3 = sp[3];
                const float rs = 1.0f / sqrtf((((q0.x + q0.y) + (q0.z + q0.w)) + ((q1.x + q1.y) + (q1.z + q1.w)) + ((q2.x + q2.y) + (q2.z + q2.w)) + ((q3.x + q3.y) + (q3.z + q3.w))) * (1.f / D) + EPS);
#pragma unroll
                for (int bj = 0; bj < 2; ++bj)
#pragma unroll
                    for (int n = 0; n < 2; ++n) { const int col = col0 + bj * 128 + n * 16; const f32x4 t = acc[ai][bj][m][n] * rs;
                        *(u32x2*)(GT + (size_t)row * D + col) = (u32x2){pk2(sigm(t.x), sigm(t.y)), pk2(sigm(t.z), sigm(t.w))}; } asm volatile("" ::: "memory"); }
    }
};
struct EpiX2 {
    static constexpr bool PERM = false;
    const bf16_t* X1; const bf16_t* GT; float* out; float* SQ;
    __device__ __forceinline__ void operator()(const f32x4 (&acc)[2][2][4][2], const Unit& u, int wr, int wc, int fr, int fq) const {
        const int row0 = u.pm * 256 + wr * 64 + fr, col0 = u.pn * 256 + wc * 32 + 4 * fq;
#pragma unroll
        for (int ai = 0; ai < 2; ++ai)
#pragma unroll
            for (int m = 0; m < 4; ++m) { int row = row0 + ai * 128 + m * 16; asm volatile("" : "+v"(row)); const bool ok = row < MR;
                float ss = 0.f;
                if (ok) {
#pragma unroll
                    for (int bj = 0; bj < 2; ++bj)
#pragma unroll
                        for (int n = 0; n < 2; ++n) { const int col = col0 + bj * 128 + n * 16;
                            const u32x2 gw = *(const u32x2*)(GT + (size_t)row * D + col);
                            const u32x2 xw = *(const u32x2*)(X1 + (size_t)row * D + col);
                            const f32x4 v = (f32x4){bflo(xw.x), bfhi(xw.x), bflo(xw.y), bfhi(xw.y)} + acc[ai][bj][m][n] * (f32x4){bflo(gw.x), bfhi(gw.x), bflo(gw.y), bfhi(gw.y)};
                            ss += (v.x * v.x + v.y * v.y) + (v.z * v.z + v.w * v.w);
                            *(f32x4*)(out + (size_t)row * D + col) = v; asm volatile("" ::: "memory"); }
                }
                ss += __shfl_xor(ss, 16); ss += __shfl_xor(ss, 32);
                if (ok && fq == 0) SQ[(size_t)row * 16 + u.pn * 4 + wc] = ss; asm volatile("" ::: "memory"); }
    }
};


__device__ __forceinline__ f32x4 mini_acc(const bf16_t* A, int lda, const bf16_t* Bt, int K, int kq, int l15, int quad) {
    f32x4 acc = {0.f, 0.f, 0.f, 0.f};
    const int kn = K / 128;
    const bf16_t* ap = A + (size_t)l15 * lda + kq * (K / 4) + quad * 8;
    const bf16_t* bp = Bt + (size_t)l15 * K + kq * (K / 4) + quad * 8;
#pragma unroll 4
    for (int ks = 0; ks < kn; ++ks) acc = MFMA32(*(const bf16x8*)(ap + ks * 32), *(const bf16x8*)(bp + ks * 32), acc);
    return acc;
}
__device__ __forceinline__ f32x4 mini_reduce(LAS f32x4* red, int half, int lane) { return (red[(half * 4 + 0) * 64 + lane] + red[(half * 4 + 1) * 64 + lane]) + (red[(half * 4 + 2) * 64 + lane] + red[(half * 4 + 3) * 64 + lane]); }
template <int PH> __device__ __forceinline__ void mini_phase(const Args& a, LAS unsigned char* lds, int bx, int G, int wave, int lane) {
    unsigned char* ws = a.ws;
    const int l15 = lane & 15, quad = lane >> 4, half = wave >> 2, kq = wave & 3;
    LAS f32x4* red1 = (LAS f32x4*)lds; LAS f32x4* red2 = red1 + 8 * 64;
    const bf16_t* P = (const bf16_t*)(ws + WS_P);
    for (int tp = bx; tp < 256; tp += G) {
        const int tl = tp * 2 + half, mt = tl >> 6, nt = tl & 63, row0 = MP + mt * 16, col0 = nt * 16;
        f32x4 a1, a2 = {0.f, 0.f, 0.f, 0.f};
        if (PH == 0) { a1 = mini_acc((const bf16_t*)(ws + WS_OA) + (size_t)row0 * 2048, 2048, (const bf16_t*)(ws + WS_WDA) + (size_t)col0 * 2048, 2048, kq, l15, quad);
                       a2 = mini_acc((const bf16_t*)(ws + WS_H) + (size_t)row0 * D, D, (const bf16_t*)(ws + WS_WDB) + (size_t)col0 * D, D, kq, l15, quad); }
        if (PH == 1) { a1 = mini_acc((const bf16_t*)(ws + WS_MG) + (size_t)row0 * D, D, (const bf16_t*)(ws + WS_WOUT) + (size_t)col0 * D, D, kq, l15, quad); }
        if (PH == 2) { a1 = mini_acc((const bf16_t*)(ws + WS_X1B) + (size_t)row0 * D, D, (const bf16_t*)(ws + WS_WGATE) + (size_t)col0 * D, D, kq, l15, quad);
                       a2 = mini_acc((const bf16_t*)(ws + WS_PB) + (size_t)row0 * PLE, PLE, (const bf16_t*)(ws + WS_WPLE) + (size_t)col0 * PLE, PLE, kq, l15, quad); }
        red1[wave * 64 + lane] = a1; red2[wave * 64 + lane] = a2;
        __syncthreads();
        if (kq == 0) {
            a1 = mini_reduce(red1, half, lane); a2 = mini_reduce(red2, half, lane);
            const int col = col0 + l15;
            float rs1[4] = {0.f, 0.f, 0.f, 0.f};
            if (PH == 2) {
#pragma unroll
                for (int r = 0; r < 4; ++r) { const f32x4 q = *(const f32x4*)((const float*)(ws + WS_SQS1) + (size_t)(row0 - MP + quad * 4 + r) * 64 + l15 * 4); float t = (q.x + q.y) + (q.z + q.w);
#pragma unroll
                    for (int o = 1; o < 16; o <<= 1) t += __shfl_xor(t, o);
                    rs1[r] = 1.0f / sqrtf(t * (1.f / D) + EPS); }
            }
#pragma unroll
            for (int r = 0; r < 4; ++r) {
                const int row = row0 + quad * 4 + r;
                float ss = 0.f;
                if (PH == 0) { const float ga = sigm(bf2f(P[(size_t)row * NP + O_MA + col])), gb = sigm(bf2f(P[(size_t)row * NP + O_MB + col]));
                    ((bf16_t*)(ws + WS_MG))[(size_t)row * D + col] = f2bf(a1[r] * ga + a2[r] * gb); }
                if (PH == 1) { const float x1 = a.in[I_XS][(size_t)(row - MP) * D + col] + a1[r]; ss = x1 * x1;
                    ((bf16_t*)(ws + WS_X1B))[(size_t)row * D + col] = f2bf(x1); }
                if (PH == 2) { const float x2 = bf2f(((const bf16_t*)(ws + WS_X1B))[(size_t)row * D + col]) + a2[r] * sigm(rs1[r] * a1[r]); ss = x2 * x2;
                    a.out[OUT_Y + (size_t)row * D + col] = x2; }
                if (PH != 0) {
#pragma unroll
                    for (int o = 1; o < 16; o <<= 1) ss += __shfl_xor(ss, o);
                    if (l15 == 0) ((float*)(ws + (PH == 1 ? WS_SQS1 : WS_SQS2)))[(size_t)(row - MP) * 64 + nt] = ss;
                }
            }
        }
        __syncthreads();
    }
}

#define XB_TMO      128
#define XB_XCNT(j)  (256  + 64 * (j))
#define XB_XSUB(j)  (1280 + 64 * (j))
#define XB_XGEN(j)  (2304 + 64 * (j))
#define XB_TOP      3328
#define XB_TOPGEN   3392
#define XCD_BAR_WORDS 3456
#define XB_SPIN_CAP (1u << 22)
__device__ __forceinline__ unsigned xb_ld(unsigned* p)              { return __hip_atomic_load(p, __ATOMIC_RELAXED, __HIP_MEMORY_SCOPE_AGENT); }
__device__ __forceinline__ unsigned xb_add(unsigned* p, unsigned v) { return __hip_atomic_fetch_add(p, v, __ATOMIC_RELAXED, __HIP_MEMORY_SCOPE_AGENT); }
__device__ __forceinline__ unsigned xb_xcc_id() { return (unsigned)__builtin_amdgcn_s_getreg((3 << 11) | 20) & 0xFu; }
#define XB_SPIN(cond, bar) do { unsigned _sp = 0; while (cond) { __builtin_amdgcn_s_sleep(1); \
    if ((++_sp & 255u) == 0u) { if (xb_ld(&(bar)[XB_TMO])) break; if (_sp > XB_SPIN_CAP) { atomicAdd(&(bar)[XB_TMO], 1u); break; } } } } while (0)
struct XcdBarrier { unsigned* bar; unsigned x; volatile LAS unsigned* st; };
__device__ __forceinline__ XcdBarrier xcd_barrier_post(unsigned* bar, volatile LAS unsigned* st) {
    XcdBarrier b; b.bar = bar; b.x = xb_xcc_id(); b.st = st;
    if (threadIdx.x == 0) (void)xb_add(&bar[XB_XCNT(b.x)], 1u);
    return b;
}
__device__ __forceinline__ void xcd_barrier_complete(unsigned* bar, unsigned x, unsigned& nloc, unsigned& nx) {
    const unsigned G = gridDim.x * gridDim.y * gridDim.z;
    unsigned sum, cnt, mine, sp = 0u;
    for (;;) {
        sum = 0u; cnt = 0u; mine = 0u;
#pragma unroll
        for (unsigned j = 0; j < 16; ++j) { const unsigned c = xb_ld(&bar[XB_XCNT(j)]); sum += c; cnt += (c > 0u) ? 1u : 0u; mine = (j == x) ? c : mine; }
        if (sum == G) break;
        __builtin_amdgcn_s_sleep(1);
        if ((++sp & 255u) == 0u) { if (xb_ld(&bar[XB_TMO])) break; if (sp > XB_SPIN_CAP) { atomicAdd(&bar[XB_TMO], 1u); break; } }
    }
    nloc = mine > 0u ? mine : 1u; nx = cnt > 0u ? cnt : 1u;
}
__device__ __forceinline__ void xcd_barrier(const XcdBarrier& b) {
    asm volatile("s_waitcnt vmcnt(0)" ::: "memory");
    __syncthreads();
    if (threadIdx.x == 0) {
        unsigned* bar = b.bar;
        __builtin_amdgcn_s_waitcnt(0);
        unsigned nloc = b.st[0], nx = b.st[1];
        if (nloc == 0u) { xcd_barrier_complete(bar, b.x, nloc, nx); b.st[0] = nloc; b.st[1] = nx; }
        const unsigned old = xb_add(&bar[XB_XSUB(b.x)], 1u);
        const unsigned gen = old / nloc;
        if (old + 1u == (gen + 1u) * nloc) {
            __builtin_amdgcn_fence(__ATOMIC_RELEASE, "agent");
            asm volatile("s_waitcnt vmcnt(0)" ::: "memory");
            const unsigned og = xb_add(&bar[XB_TOP], 1u);
            const unsigned tg = og / nx;
            if (og + 1u == (tg + 1u) * nx) xb_add(&bar[XB_TOPGEN], 1u);
            else XB_SPIN(xb_ld(&bar[XB_TOPGEN]) == tg, bar);
            __builtin_amdgcn_fence(__ATOMIC_ACQUIRE, "agent");
            xb_add(&bar[XB_XGEN(b.x)], 1u);
            asm volatile("s_waitcnt vmcnt(0)" ::: "memory");
        } else {
            XB_SPIN(xb_ld(&bar[XB_XGEN(b.x)]) == gen, bar);
            __builtin_amdgcn_fence(__ATOMIC_ACQUIRE, "agent");
            asm volatile("s_waitcnt vmcnt(0)" ::: "memory");
        }
    }
    __syncthreads();
}

constexpr int LDS_BYTES = 147456;
constexpr int CTL_SQ1 = 0, CTL_SQ2 = 32768, CTL_CNT = 65536;

#define GRID_SYNC() xcd_barrier(xbar)
__global__ void __launch_bounds__(512, 2) fwd_mega(Args a) {
    extern __shared__ __attribute__((aligned(16))) unsigned char lds_raw[];
    LAS unsigned char* lds = (LAS unsigned char*)lds_raw;
    cg::grid_group grid = cg::this_grid();
    const int tid = threadIdx.x, lane = tid & 63, wave = __builtin_amdgcn_readfirstlane(tid >> 6);
    const int G = gridDim.x, bx = blockIdx.x;
    const int gw = bx * 8 + wave, NGW = G * 8;
    unsigned char* ws = a.ws;
    if (tid < 16) ((LAS unsigned*)(lds + 131072 + 64))[tid] = 0u;
    __syncthreads();
    XcdBarrier xbar = xcd_barrier_post((unsigned*)(ws + WS_BAR), (volatile LAS unsigned*)(lds + 131072 + 64));
    grid.sync();

#if !defined(ONLY_PH) || ONLY_PH == 0
    phase0(a, lds, gw, NGW, wave, lane);
    GRID_SYNC();
#endif
#if !defined(ONLY_PH) || ONLY_PH == 1
    {
        pg8::Gemm g{(const bf16_t*)(ws + WS_H), (const bf16_t*)(ws + WS_WIN), MALL, NP, D}; pg8::StaticOrder S; S.init(MALL, NP, G, bx);
        EpiP E{(bf16_t*)(ws + WS_P), (bf16_t*)(ws + WS_KT), (const f32x2*)(ws + WS_ROPE)};
        pg8::gemm_phase<EpiP>(lds, g, S, E);
    }
    GRID_SYNC();
#endif
#if !defined(ONLY_PH) || ONLY_PH == 2
    for (int it = gw; it < 1032 * 16; it += NGW) rw_prep_item(a, lds + wave * 10240, it >> 4, it & 15, lane);
    GRID_SYNC();
#endif
#if !defined(ONLY_PH) || ONLY_PH == 3
    {
        for (int u = gw; u < MS * 16; u += NGW) rw_sample_wave(a, u >> 4, u & 15, lane);
        if (bx < 128) { if (wave < 4) rw_scan_task(a, lds + wave * 4096, bx >> 4, bx & 15, wave, lane); else if (G >= 128) { const int u = bx * 4 + (wave - 4); ret_sample_wave(a, u >> 2, u & 3, lane); } }
        __syncthreads();
        {
            unsigned* cnt2 = (unsigned*)(ws + WS_CTL) + CTL_CNT + 32;
            LAS unsigned* lu = (LAS unsigned*)(lds + 131072);
            for (;;) {
                if (tid == 0) *lu = atomicAdd(cnt2, 1u);
                __syncthreads();
                const unsigned unit = *lu;
                __syncthreads();
                if (unit >= (unsigned)(MS * 4) || G >= 128) break;
                ret_sample_unit(a, lds, (int)(unit >> 2), (int)(unit & 3), tid);
            }
        }
        {
            unsigned* cnt = (unsigned*)(ws + WS_CTL) + CTL_CNT;
            LAS unsigned* lu = (LAS unsigned*)(lds + 131072);
            for (;;) {
                if (tid == 0) *lu = atomicAdd(cnt, 1u);
                __syncthreads();
                const unsigned unit = *lu;
                __syncthreads();
                if (unit >= 256u) break;
                ret_unit(a, lds, (int)unit, tid);
            }
        }
    }
    GRID_SYNC();
#endif
#if !defined(ONLY_PH) || ONLY_PH == 4
    for (int m = gw; m < MR; m += NGW) phase25_row(a, m, lane);
    GRID_SYNC();
#endif
#if !defined(ONLY_PH) || ONLY_PH == 5
    {
        mini_phase<0>(a, lds, bx, G, wave, lane);
        pg8::StaticOrder S; S.init(MP, D, G, bx);
        { pg8::Gemm g{(const bf16_t*)(ws + WS_OA), (const bf16_t*)(ws + WS_WDA), MP, D, 2048}; EpiT1 E{(const bf16_t*)(ws + WS_P), (bf16_t*)(ws + WS_T1)}; pg8::gemm_phase<EpiT1>(lds, g, S, E); }
        { pg8::Gemm g{(const bf16_t*)(ws + WS_H), (const bf16_t*)(ws + WS_WDB), MP, D, D}; EpiMG E{(const bf16_t*)(ws + WS_P), (const bf16_t*)(ws + WS_T1), (bf16_t*)(ws + WS_MG)}; pg8::gemm_phase<EpiMG>(lds, g, S, E); }
    }
    GRID_SYNC();
#endif
#if !defined(ONLY_PH) || ONLY_PH == 6
    {
        mini_phase<1>(a, lds, bx, G, wave, lane);
        pg8::StaticOrder S; S.init(MP, D, G, bx);
        pg8::Gemm g{(const bf16_t*)(ws + WS_MG), (const bf16_t*)(ws + WS_WOUT), MP, D, D};
        EpiX1 E{a.in[I_XP], a.in[I_XS], (float*)(ws + WS_X1), (bf16_t*)(ws + WS_X1B), (float*)(ws + WS_SQ1P)};
        pg8::gemm_phase<EpiX1>(lds, g, S, E);
    }
    GRID_SYNC();
#endif
#if !defined(ONLY_PH) || ONLY_PH == 7
    {
        mini_phase<2>(a, lds, bx, G, wave, lane);
        pg8::StaticOrder S; S.init(MP, D, G, bx);
        { pg8::Gemm g{(const bf16_t*)(ws + WS_X1B), (const bf16_t*)(ws + WS_WGATE), MP, D, D}; EpiGT E{(const float*)(ws + WS_SQ1P), (bf16_t*)(ws + WS_GT)}; pg8::gemm_phase<EpiGT>(lds, g, S, E); }
        { pg8::Gemm g{(const bf16_t*)(ws + WS_PB), (const bf16_t*)(ws + WS_WPLE), MP, D, PLE}; EpiX2 E{(const bf16_t*)(ws + WS_X1B), (const bf16_t*)(ws + WS_GT), a.out + OUT_Y, (float*)(ws + WS_SQ2P)}; pg8::gemm_phase<EpiX2>(lds, g, S, E); }
    }
    GRID_SYNC();
#endif
#if !defined(ONLY_PH) || ONLY_PH == 8
    {
        const float* sq2 = (const float*)(ws + WS_SQ2P); const float* fg = a.in[I_FNG];
        for (int m0 = gw; m0 < MR; m0 += 2 * NGW) {
            const int m1 = m0 + NGW; const bool two = m1 < MR;
            float tot[2]; f32x4 xv[2][4];
#pragma unroll
            for (int e = 0; e < 2; ++e) {
                const int m = e ? m1 : m0;
                if (e == 0 || two) {
                    if (m < MP) { const f32x4* sp = (const f32x4*)(sq2 + (size_t)m * 16); const f32x4 q0 = sp[0], q1 = sp[1], q2 = sp[2], q3 = sp[3];
                        tot[e] = (((q0.x + q0.y) + (q0.z + q0.w)) + ((q1.x + q1.y) + (q1.z + q1.w)) + ((q2.x + q2.y) + (q2.z + q2.w)) + ((q3.x + q3.y) + (q3.z + q3.w))); }
                    else tot[e] = wave_sum(((const float*)(ws + WS_SQS2))[(size_t)(m - MP) * 64 + lane]);
                    const f32x4* o = (const f32x4*)(a.out + OUT_Y + (size_t)m * D);
#pragma unroll
                    for (int j = 0; j < 4; ++j) xv[e][j] = o[lane + 64 * j];
                }
            }
#pragma unroll
            for (int e = 0; e < 2; ++e) {
                const int m = e ? m1 : m0;
                if (e == 0 || two) {
                    const float rs = 1.0f / sqrtf(tot[e] * (1.f / D) + EPS);
                    f32x4* o = (f32x4*)(a.out + OUT_Y + (size_t)m * D);
#pragma unroll
                    for (int j = 0; j < 4; ++j) o[lane + 64 * j] = xv[e][j] * rs * ((const f32x4*)fg)[lane + 64 * j];
                }
            }
        }
    }
#endif

}

extern "C" void kernel_launch(void* const* d_in, const int* in_sizes, int n_in, void* d_out, int out_size, void* d_ws, size_t ws_size, hipStream_t stream) {
    static int grid = 0;
    if (grid == 0) {
        if (n_in != 26 || ws_size < WS_END) { fprintf(stderr, "kernel_launch: unexpected n_in %d or ws_size %zu (need %zu)\n", n_in, ws_size, (size_t)WS_END); grid = -1; return; }
        int dev = 0, cus = 0, per_cu = 0;
        hipGetDevice(&dev); hipDeviceGetAttribute(&cus, hipDeviceAttributeMultiprocessorCount, dev);
        if (hipFuncSetAttribute((const void*)fwd_mega, hipFuncAttributeMaxDynamicSharedMemorySize, LDS_BYTES) != hipSuccess) { fprintf(stderr, "kernel_launch: hipFuncSetAttribute failed\n"); grid = -1; return; }
        hipOccupancyMaxActiveBlocksPerMultiprocessor(&per_cu, (const void*)fwd_mega, 512, LDS_BYTES);
        if (per_cu < 1) { fprintf(stderr, "kernel_launch: occupancy query says %d blocks per CU\n", per_cu); per_cu = 1; }
        (void)hipGetLastError();
        grid = cus * 1;
        fprintf(stderr, "kernel_launch: grid %d (cus %d, per_cu %d), ws %zu\n", grid, cus, per_cu, ws_size);
    }
    if (grid < 0) return;
    Args a{};
    for (int i = 0; i < 26; ++i) a.in[i] = (const float*)d_in[i];
    a.out = (float*)d_out; a.ws = (unsigned char*)d_ws;
    if (hipMemsetAsync((char*)d_ws + WS_BAR, 0, XCD_BAR_WORDS * 4, stream) != hipSuccess) { fprintf(stderr, "kernel_launch: memset failed\n"); return; }
    void* args[] = {&a};
    hipError_t e = hipLaunchCooperativeKernel((const void*)fwd_mega, dim3(grid), dim3(512), args, LDS_BYTES, stream);
    if (e != hipSuccess) fprintf(stderr, "kernel_launch: cooperative launch failed: %s\n", hipGetErrorString(e));
}
```

```cpp
#include <hip/hip_runtime.h>
#include <hip/hip_cooperative_groups.h>
#include <cstdio>
#include <cstdint>
namespace cg = cooperative_groups;

#define LAS __attribute__((address_space(3)))
typedef unsigned short bf16_t;
typedef short bf16x8 __attribute__((ext_vector_type(8)));
typedef short bf16x4 __attribute__((ext_vector_type(4)));
typedef float f32x4 __attribute__((ext_vector_type(4)));
typedef float f32x2 __attribute__((ext_vector_type(2)));
typedef unsigned u32x4 __attribute__((ext_vector_type(4)));
typedef unsigned u32x2 __attribute__((ext_vector_type(2)));
typedef __bf16 nbf2 __attribute__((ext_vector_type(2)));

constexpr int D = 1024, NB = 8, T = 2048, MP = NB * T  , MS = 128, MR = MP + MS  , MALL = 16640  ;
constexpr int NCOLS = 12416, NP = 12544  ;
constexpr int O_K = 1024, O_V = 2048, O_GA = 4096, O_SH = 6144, O_GB = 9344, O_MA = 10368, O_MB = 11392;
constexpr int RH = 4, RDK = 256, RDV = 512, RCH = 128;
constexpr int WH = 16, WN = 64;
constexpr int PLE = 256;
constexpr float EPS = 1e-6f;
constexpr int REC = 12544;
constexpr int R_AT = 0, R_RT = 2048, R_BP = 4096, R_KP = 6144, R_VT = 8192, R_AAK = 10240, R_TT = 10752, R_ARB = 11264, R_ARK = 11776, R_WC = 12288;

constexpr size_t MiB = 1u << 20;
constexpr size_t WS_CTL = 0;
constexpr size_t WS_ROPE = 1 * MiB;
constexpr size_t WS_W2T = 4 * MiB, WS_A2T = WS_W2T + 131072;
constexpr size_t WS_WPLE = 5 * MiB, WS_WDB = 6 * MiB, WS_WOUT = 8 * MiB, WS_WGATE = 10 * MiB, WS_WDA = 12 * MiB, WS_WIN = 16 * MiB;
constexpr size_t WS_PB = 41 * MiB, WS_H = 50 * MiB  , WS_KT = 83 * MiB, WS_SQA = 115 * MiB, WS_BC = 117 * MiB, WS_OPSS = 119 * MiB  ;
constexpr size_t WS_OA = 122 * MiB, WS_P = 188 * MiB, WS_CH = 587 * MiB  , WS_OB = 786 * MiB  ;
constexpr size_t WS_T1 = WS_CH, WS_MG = WS_CH + 65 * MiB, WS_X1B = WS_CH + 98 * MiB, WS_GT = WS_CH + 131 * MiB, WS_X1 = WS_OB + 65 * MiB  ;
constexpr size_t WS_END = 916 * MiB;
constexpr size_t WS_BAR = 512 * 1024;
constexpr size_t WS_SQS1 = 640 * 1024, WS_SQS2 = 704 * 1024;
constexpr size_t WS_SQ1P = WS_KT, WS_SQ2P = WS_KT + 2 * MiB;

constexpr size_t OUT_Y = 0, OUT_RETP = 16908288, OUT_RWP = 21102592, OUT_SHP = 21626880, OUT_RETS = 21635072, OUT_RWS = 88743936, OUT_SHS = 97132544;

__device__ __forceinline__ unsigned pk2(float lo, float hi) { f32x2 v = {lo, hi}; nbf2 r = __builtin_convertvector(v, nbf2); return __builtin_bit_cast(unsigned, r); }
__device__ __forceinline__ unsigned short f2bf(float f) { return (unsigned short)(pk2(f, 0.f) & 0xffffu); }
__device__ __forceinline__ float bf2f(unsigned short b) { return __uint_as_float(((unsigned)b) << 16); }
__device__ __forceinline__ float bflo(unsigned w) { return __uint_as_float(w << 16); }
__device__ __forceinline__ float bfhi(unsigned w) { return __uint_as_float(w & 0xffff0000u); }
__device__ __forceinline__ float sigm(float x) { return __builtin_amdgcn_rcpf(1.f + __expf(-x)); }
__device__ __forceinline__ float silu_(float x) { return x * sigm(x); }
__device__ __forceinline__ float wave_sum(float v) {
#pragma unroll
    for (int o = 1; o < 64; o <<= 1) v += __shfl_xor(v, o);
    return v;
}
#define MFMA32(a, b, c) __builtin_amdgcn_mfma_f32_16x16x32_bf16((a), (b), (c), 0, 0, 0)
#define LDS_WAIT() asm volatile("s_waitcnt lgkmcnt(0)" ::: "memory")

namespace pg8 {
constexpr int BM = 256, BK = 64, HALF = 128, HTB = HALF * BK * 2, STAGE_BYTES = 8 * HTB, NXCD = 8, WGM = 8;
__host__ __device__ __forceinline__ int lds_byte(int r, int c) { const int st = (r >> 4) * 2 + (c >> 5), rr = r & 15, cc = c & 31, ob = rr * 64 + cc * 2; return st * 1024 + (ob ^ (((ob >> 9) & 1) << 5)); }
__host__ __device__ __forceinline__ void stage_rc(int b, int& R, int& C) { const int st = b / 1024, sb = b % 1024, swz = sb ^ (((sb >> 9) & 1) << 5); R = (st >> 1) * 16 + swz / 64; C = (st & 1) * 32 + (swz % 64) / 2; }
__host__ __device__ __forceinline__ int perm32(int rho) { const int n = rho >> 4, i = rho & 15; return 8 * (i >> 2) + 4 * n + (i & 3); }
struct Unit { int pm, pn; };
struct Gemm { const bf16_t* A; const bf16_t* Bt; int M, N, K; };
struct StaticOrder {
    int nM, nN, nwg, G, c;
    __host__ __device__ void init(int M, int N, int G_, int c_) { nM = M / BM; nN = N / BM; nwg = nM * nN; G = G_; c = c_; }
    __host__ __device__ bool next(int i, Unit& u) const {
        const long L = (long)i * G + c; if (L >= nwg) return false;
        int wgid = (int)L; { const int q = nwg / NXCD, r = nwg % NXCD, xcd = wgid % NXCD, off = wgid / NXCD; wgid = (xcd < r ? xcd * (q + 1) : r * (q + 1) + (xcd - r) * q) + off; }
        const int nig = WGM * nN, gid = wgid / nig, fm = gid * WGM, gsz = (nM - fm) < WGM ? (nM - fm) : WGM;
        u.pm = fm + ((wgid % nig) % gsz); u.pn = (wgid % nig) / gsz; return true;
    }
};
template <class Epi>
__device__ __forceinline__ void gemm_phase(LAS unsigned char* lds, const Gemm g, const StaticOrder& S, const Epi& E) {
    int tid = threadIdx.x; asm volatile("" : "+v"(tid));
    const int wid = __builtin_amdgcn_readfirstlane(tid >> 6), lane = tid & 63, wr = wid >> 2, wc = wid & 3, fr = lane & 15, fq = lane >> 4;
    const int K = g.K, nt = K / BK;
    unsigned voffA[2], voffB[2];
#pragma unroll
    for (int i = 0; i < 2; ++i) { int R, C; stage_rc(tid * 16 + i * 8192, R, C); const int Rb = Epi::PERM ? ((R & ~31) + perm32(R & 31)) : R;
        voffA[i] = (unsigned)(R * K + C) * 2u; voffB[i] = (unsigned)(Rb * K + C) * 2u; }
    const size_t kstep = (size_t)(BK * 2);
    const size_t hstep = (size_t)HALF * K * 2;
    const size_t tstep = 2 * hstep;
    const unsigned ldsw = (unsigned)wid * 1024u;
    const int aoff = lds_byte(wr * 64 + fr, fq * 8), boff = lds_byte(wc * 32 + fr, fq * 8);
#define PG8_SA(b, h) (((b) * 2 + (h)) * HTB)
#define PG8_SB(b, h) ((4 + (b) * 2 + (h)) * HTB)
#define PG8_STAGE(bufoff, gbase, voff) do { _Pragma("unroll") for (int _i = 0; _i < 2; ++_i) \
        __builtin_amdgcn_global_load_lds((const unsigned*)((const char*)(gbase) + (voff)[_i]), (LAS unsigned*)(lds + (bufoff) + ldsw + _i * 8192), 16, 0, 0); } while (0)
#define PG8_LDA(dst, b, h) do { _Pragma("unroll") for (int m = 0; m < 4; ++m) _Pragma("unroll") for (int k = 0; k < 2; ++k) dst[m][k] = *(const LAS bf16x8*)(lds + PG8_SA(b, h) + aoff + m * 2048 + k * 1024); } while (0)
#define PG8_LDB(dst, b, h) do { _Pragma("unroll") for (int n = 0; n < 2; ++n) _Pragma("unroll") for (int k = 0; k < 2; ++k) dst[n][k] = *(const LAS bf16x8*)(lds + PG8_SB(b, h) + boff + n * 2048 + k * 1024); } while (0)
#define PG8_MMA(ai, bj, At, Bt) do { __builtin_amdgcn_s_setprio(1); _Pragma("unroll") for (int m = 0; m < 4; ++m) _Pragma("unroll") for (int n = 0; n < 2; ++n) _Pragma("unroll") for (int k = 0; k < 2; ++k) \
        acc[ai][bj][m][n] = __builtin_amdgcn_mfma_f32_16x16x32_bf16(Bt[n][k], At[m][k], acc[ai][bj][m][n], 0, 0, 0); __builtin_amdgcn_s_setprio(0); } while (0)
#define PG8_WAIT_V(n) asm volatile("s_waitcnt vmcnt(" #n ")" ::: "memory")
#define PG8_WAIT_L(n) asm volatile("s_waitcnt lgkmcnt(" #n ")" ::: "memory")
#define PG8_BAR __builtin_amdgcn_s_barrier()
#define PG8_SCHED __builtin_amdgcn_sched_barrier(0)
    Unit cur, nxt; int ui = 0;
    if (!S.next(0, cur)) return;
    f32x4 acc[2][2][4][2];
#pragma unroll
    for (int a = 0; a < 2; ++a)
#pragma unroll
        for (int b = 0; b < 2; ++b)
#pragma unroll
            for (int m = 0; m < 4; ++m)
#pragma unroll
                for (int n = 0; n < 2; ++n) acc[a][b][m][n] = (f32x4){0.f, 0.f, 0.f, 0.f};
    bf16x8 At[4][2], B0[2][2], B1[2][2];
    const char* cA = (const char*)g.A + (size_t)cur.pm * tstep; const char* cB = (const char*)g.Bt + (size_t)cur.pn * tstep;
    PG8_STAGE(PG8_SB(0, 0), cB, voffB); PG8_STAGE(PG8_SA(0, 0), cA, voffA); PG8_STAGE(PG8_SB(0, 1), cB + hstep, voffB); PG8_STAGE(PG8_SA(0, 1), cA + hstep, voffA);
    if (wr == 1) PG8_BAR;
    PG8_WAIT_V(4); PG8_BAR;
    PG8_STAGE(PG8_SB(1, 0), cB + kstep, voffB); PG8_STAGE(PG8_SA(1, 0), cA + kstep, voffA); PG8_STAGE(PG8_SB(1, 1), cB + hstep + kstep, voffB);
    PG8_WAIT_V(6); PG8_BAR;
    for (;;) {
        const bool has_next = S.next(ui + 1, nxt);
        const char* nA = has_next ? (const char*)g.A + (size_t)nxt.pm * tstep : cA; const char* nB = has_next ? (const char*)g.Bt + (size_t)nxt.pn * tstep : cB;
#pragma unroll 1
        for (int t = 0; t < nt; t += 2) {
            const bool last = (t == nt - 2);
            const char* a1 = cA + (size_t)(t + 1) * kstep;
            const char* a2 = last ? nA : cA + (size_t)(t + 2) * kstep; const char* b2 = last ? nB : cB + (size_t)(t + 2) * kstep;
            const char* a3 = a2 + kstep; const char* b3 = b2 + kstep;
            PG8_LDB(B0, 0, 0); PG8_SCHED; PG8_LDA(At, 0, 0); PG8_STAGE(PG8_SA(1, 1), a1 + hstep, voffA);
            PG8_WAIT_L(8); PG8_BAR; PG8_WAIT_L(0); PG8_MMA(0, 0, At, B0); PG8_BAR; PG8_SCHED;
            PG8_LDB(B1, 0, 1); PG8_STAGE(PG8_SB(0, 0), b2, voffB);
            PG8_BAR; PG8_WAIT_L(0); PG8_MMA(0, 1, At, B1); PG8_BAR;
            PG8_LDA(At, 0, 1); PG8_STAGE(PG8_SA(0, 0), a2, voffA);
            PG8_BAR; PG8_WAIT_L(0); PG8_MMA(1, 0, At, B0); PG8_BAR; PG8_SCHED;
            PG8_STAGE(PG8_SB(0, 1), b2 + hstep, voffB);
            PG8_WAIT_V(6); PG8_BAR; PG8_MMA(1, 1, At, B1); PG8_BAR;
            PG8_LDB(B0, 1, 0); PG8_SCHED; PG8_LDA(At, 1, 0); PG8_STAGE(PG8_SA(0, 1), a2 + hstep, voffA);
            PG8_WAIT_L(8); PG8_BAR; PG8_WAIT_L(0); PG8_MMA(0, 0, At, B0); PG8_BAR; PG8_SCHED;
            PG8_LDB(B1, 1, 1); PG8_STAGE(PG8_SB(1, 0), b3, voffB);
            PG8_BAR; PG8_WAIT_L(0); PG8_MMA(0, 1, At, B1); PG8_BAR;
            PG8_LDA(At, 1, 1); PG8_STAGE(PG8_SA(1, 0), a3, voffA);
            PG8_BAR; PG8_WAIT_L(0); PG8_MMA(1, 0, At, B0); PG8_BAR; PG8_SCHED;
            PG8_STAGE(PG8_SB(1, 1), b3 + hstep, voffB);
            PG8_WAIT_V(6); PG8_BAR; PG8_MMA(1, 1, At, B1); PG8_BAR;
        }
        E(acc, cur, wr, wc, fr, fq);
        if (!has_next) break;
#pragma unroll
        for (int a = 0; a < 2; ++a)
#pragma unroll
            for (int b = 0; b < 2; ++b)
#pragma unroll
                for (int m = 0; m < 4; ++m)
#pragma unroll
                    for (int n = 0; n < 2; ++n) acc[a][b][m][n] = (f32x4){0.f, 0.f, 0.f, 0.f};
        cur = nxt; cA = nA; cB = nB; ++ui;
    }
    PG8_WAIT_V(0);
    if (wr == 0) PG8_BAR;
    PG8_BAR;
#undef PG8_SA
#undef PG8_SB
#undef PG8_STAGE
#undef PG8_LDA
#undef PG8_LDB
#undef PG8_MMA
#undef PG8_WAIT_V
#undef PG8_WAIT_L
#undef PG8_BAR
#undef PG8_SCHED
}
}
using pg8::Unit;

struct Args {
    const float* in[26];
    float* out; unsigned char* ws;
};
#define KAS __attribute__((address_space(4)))
__device__ __forceinline__ const KAS char* kargp() { const KAS char* p = (const KAS char*)__builtin_amdgcn_kernarg_segment_ptr(); asm volatile("" : "+s"(p)); return p; }


enum { I_XP = 0, I_XS, I_SRET, I_SRW, I_SSH, I_PP, I_PS, I_NG, I_WIN, I_MU, I_W0, I_W2, I_A0, I_A2, I_KK, I_KA, I_RK, I_LNW, I_LNB, I_WDA, I_WDB, I_WOUT, I_WPLE, I_PNG, I_WPG, I_FNG };

__device__ __forceinline__ void p0_transpose_item(const float* W, int K, int N, bf16_t* WT, LAS float* scr, int item, int lane, const float* kscale) {
    const int nblk = N / 32, kb = item / nblk, nb = item % nblk, k0 = 64 * kb, n0 = 32 * nb;
#pragma unroll 8
    for (int i = 0; i < 32; ++i) { const int kk = 2 * i + (lane >> 5); float v = W[(size_t)(k0 + kk) * N + n0 + (lane & 31)]; if (kscale) v *= kscale[k0 + kk]; scr[kk * 33 + (lane & 31)] = v; }
    LDS_WAIT();
    const int c = lane & 7;
#pragma unroll
    for (int j = 0; j < 4; ++j) { const int n = (lane >> 3) + 8 * j; const LAS float* s = scr + (8 * c) * 33 + n;
        u32x4 o; o.x = pk2(s[0 * 33], s[1 * 33]); o.y = pk2(s[2 * 33], s[3 * 33]); o.z = pk2(s[4 * 33], s[5 * 33]); o.w = pk2(s[6 * 33], s[7 * 33]);
        *(u32x4*)(WT + (size_t)(n0 + n) * K + k0 + 8 * c) = o; }
    LDS_WAIT();
}

__device__ __forceinline__ void phase0(const Args& a, LAS unsigned char* lds, int gw, int NGW, int wave, int lane) {
    unsigned char* ws = a.ws;
    LAS float* scr = (LAS float*)(lds + wave * 16384);
    constexpr int I_IN = (D / 64) * (NCOLS / 32), I_DA = (2048 / 64) * (D / 32), I_SQ = (D / 64) * (D / 32), I_PL = (PLE / 64) * (D / 32), I_LR = 1 * (D / 32);
    constexpr int NITEMS = I_IN + I_DA + 3 * I_SQ + I_PL + 2 * I_LR;
    for (int it = gw; it < NITEMS; it += NGW) {
        int r = it;
        if (r < I_IN) { p0_transpose_item(a.in[I_WIN], D, NCOLS, (bf16_t*)(ws + WS_WIN), scr, r, lane, nullptr); continue; } r -= I_IN;
        if (r < I_DA) { p0_transpose_item(a.in[I_WDA], 2048, D, (bf16_t*)(ws + WS_WDA), scr, r, lane, nullptr); continue; } r -= I_DA;
        if (r < I_SQ) { p0_transpose_item(a.in[I_WDB], D, D, (bf16_t*)(ws + WS_WDB), scr, r, lane, nullptr); continue; } r -= I_SQ;
        if (r < I_SQ) { p0_transpose_item(a.in[I_WOUT], D, D, (bf16_t*)(ws + WS_WOUT), scr, r, lane, nullptr); continue; } r -= I_SQ;
        if (r < I_SQ) { p0_transpose_item(a.in[I_WPG], D, D, (bf16_t*)(ws + WS_WGATE), scr, r, lane, a.in[I_PNG]); continue; } r -= I_SQ;
        if (r < I_PL) { p0_transpose_item(a.in[I_WPLE], PLE, D, (bf16_t*)(ws + WS_WPLE), scr, r, lane, nullptr); continue; } r -= I_PL;
        if (r < I_LR) { p0_transpose_item(a.in[I_W2], 64, D, (bf16_t*)(ws + WS_W2T), scr, r, lane, nullptr); continue; } r -= I_LR;
        p0_transpose_item(a.in[I_A2], 64, D, (bf16_t*)(ws + WS_A2T), scr, r, lane, nullptr);
    }
    for (int i = gw * 64 + lane; i < 128 * D / 8; i += NGW * 64) ((u32x4*)(ws + WS_WIN + (size_t)NCOLS * D * 2))[i] = (u32x4){0u, 0u, 0u, 0u};
    bf16_t* H = (bf16_t*)(ws + WS_H);
    const float* ng = a.in[I_NG];
    for (int m = gw; m < MALL; m += NGW) {
        if (m < MR) {
            const float* xr = (m < MP) ? a.in[I_XP] + (size_t)m * D : a.in[I_XS] + (size_t)(m - MP) * D;
            f32x4 v[4]; float s = 0.f;
#pragma unroll
            for (int j = 0; j < 4; ++j) { v[j] = ((const f32x4*)xr)[lane + 64 * j]; s += (v[j].x * v[j].x + v[j].y * v[j].y) + (v[j].z * v[j].z + v[j].w * v[j].w); }
            const float rs = 1.0f / sqrtf(wave_sum(s) * (1.f / D) + EPS);
            float* so = nullptr;
            if (m < MP) { if ((m & (T - 1)) == T - 1) so = a.out + OUT_SHP + (size_t)(m >> 11) * D; } else so = a.out + OUT_SHS + (size_t)(m - MP) * D;
#pragma unroll
            for (int j = 0; j < 4; ++j) { const f32x4 gg = ((const f32x4*)ng)[lane + 64 * j]; f32x4 h = v[j] * rs * gg;
                if (so) ((f32x4*)so)[lane + 64 * j] = h;
                u32x2 o; o.x = pk2(h.x, h.y); o.y = pk2(h.z, h.w); ((u32x2*)(H + (size_t)m * D))[lane + 64 * j] = o; }
        } else {
            const float* xr = a.in[I_SSH] + (size_t)(m - MR) * D;
#pragma unroll
            for (int j = 0; j < 4; ++j) { const f32x4 h = ((const f32x4*)xr)[lane + 64 * j]; u32x2 o; o.x = pk2(h.x, h.y); o.y = pk2(h.z, h.w); ((u32x2*)(H + (size_t)m * D))[lane + 64 * j] = o; }
        }
        u32x2 o = {0u, 0u};
        if (m < MR) { const float* pr = (m < MP) ? a.in[I_PP] + (size_t)m * PLE : a.in[I_PS] + (size_t)(m - MP) * PLE; const f32x4 p = ((const f32x4*)pr)[lane]; o.x = pk2(p.x, p.y); o.y = pk2(p.z, p.w); }
        ((u32x2*)(ws + WS_PB + (size_t)m * PLE * 2))[lane] = o;
    }
    for (int i = gw * 64 + lane; i < 2049 * 128; i += NGW * 64) {
        const int pos = i >> 7, j = i & 127; const double p = (pos == 2048) ? 16384.0 : (double)pos;
        double inv = 1.0, base = 0.9305720409296989; int e = j;
        while (e) { if (e & 1) inv *= base; base *= base; e >>= 1; }
        double rev = p * inv * 0.15915494309189535; rev -= floor(rev);
        const float fr = (float)rev;
        ((f32x2*)(ws + WS_ROPE))[i] = (f32x2){__builtin_amdgcn_cosf(fr), __builtin_amdgcn_sinf(fr)};
    }
    for (int i = gw * 64 + lane; i < 65536 + 64; i += NGW * 64) ((float*)(ws + WS_CTL))[i] = 0.f;
}

struct EpiP {
    static constexpr bool PERM = true;
    bf16_t* P; bf16_t* KT; const f32x2* rope;
    __device__ __forceinline__ void operator()(const f32x4 (&acc)[2][2][4][2], const Unit& u, int wr, int wc, int fr, int fq) const {
        const int pn = u.pn, pm = u.pm;
        const int row0 = pm * 256 + wr * 64 + fr, cl0 = wc * 32 + 8 * fq;
        const bool sample = (pm == 64);
        if (pn < 8) {
            const int h = pn & 3; const bool isk = pn >= 4;
            const float l2g = __log2f(1.f - exp2f(-5.f - (float)h));
#pragma unroll
            for (int ai = 0; ai < 2; ++ai)
#pragma unroll
                for (int m = 0; m < 4; ++m) {
                    const int row = row0 + ai * 128 + m * 16;
                    int pos, ex;
                    if (sample) { pos = 2048; ex = isk ? 0 : 1; } else { pos = row & (T - 1); const int idx = pos & 127; ex = isk ? 127 - idx : idx + 1; }
                    const float sc = exp2f((float)ex * l2g) * (isk ? 0.0625f : 1.0f);
                    const f32x4* rp = (const f32x4*)(rope + pos * 128 + cl0);
                    f32x4 cs[4]; cs[0] = rp[0]; cs[1] = rp[1]; cs[2] = rp[2]; cs[3] = rp[3];
                    float y1[8], y2[8];
#pragma unroll
                    for (int n = 0; n < 2; ++n)
#pragma unroll
                        for (int e = 0; e < 4; ++e) {
                            const float c = (e & 1) ? cs[n * 2 + (e >> 1)].z : cs[n * 2 + (e >> 1)].x, s = (e & 1) ? cs[n * 2 + (e >> 1)].w : cs[n * 2 + (e >> 1)].y;
                            const float x1 = acc[ai][0][m][n][e], x2 = acc[ai][1][m][n][e];
                            y1[n * 4 + e] = (x1 * c - x2 * s) * sc; y2[n * 4 + e] = (x2 * c + x1 * s) * sc;
                        }
                    u32x4 w1, w2;
                    w1.x = pk2(y1[0], y1[1]); w1.y = pk2(y1[2], y1[3]); w1.z = pk2(y1[4], y1[5]); w1.w = pk2(y1[6], y1[7]);
                    w2.x = pk2(y2[0], y2[1]); w2.y = pk2(y2[2], y2[3]); w2.z = pk2(y2[4], y2[5]); w2.w = pk2(y2[6], y2[7]);
                    bf16_t* rowp = P + (size_t)row * NP + pn * 256 + cl0;
                    *(u32x4*)rowp = w1; *(u32x4*)(rowp + 128) = w2;
                    if (isk && !sample) {
                        bf16_t* kt = KT + ((size_t)((row >> 11) * 4 + h) * 256 + cl0) * T + pos;
#pragma unroll
                        for (int j = 0; j < 8; ++j) { kt[(size_t)j * T] = f2bf(y1[j]); kt[(size_t)(j + 128) * T] = f2bf(y2[j]); }
                    }
                }
            return;
        }
#pragma unroll
        for (int bj = 0; bj < 2; ++bj) {
            const int cb = pn * 2 + bj;
            if (cb >= 97) continue;
            const int mode = 0;
            const bool vt = (cb < 32) && !sample;
#pragma unroll
            for (int ai = 0; ai < 2; ++ai)
#pragma unroll
                for (int m = 0; m < 4; ++m) {
                    const int row = row0 + ai * 128 + m * 16;
                    float y[8];
#pragma unroll
                    for (int n = 0; n < 2; ++n)
#pragma unroll
                        for (int e = 0; e < 4; ++e) { float x = acc[ai][bj][m][n][e]; if (mode == 1) x = x * sigm(x); else if (mode == 2) x = sigm(x); y[n * 4 + e] = x; }
                    if (vt) {
                        const int hd = cb * 128 + cl0 - O_V;
                        bf16_t* vp = P + ((size_t)(row >> 11) * T + hd) * NP + O_V + (row & (T - 1));
#pragma unroll
                        for (int j = 0; j < 8; ++j) vp[(size_t)j * NP] = f2bf(y[j]);
                    } else {
                        u32x4 w; w.x = pk2(y[0], y[1]); w.y = pk2(y[2], y[3]); w.z = pk2(y[4], y[5]); w.w = pk2(y[6], y[7]);
                        *(u32x4*)(P + (size_t)row * NP + cb * 128 + cl0) = w;
                    }
                }
        }
    }
};

__device__ __forceinline__ float lerp_bf(const bf16_t* cur, const bf16_t* prv, float mu) { const float c = bf2f(*cur); const float p = bf2f(*prv); return c + (p - c) * mu; }

__device__ __forceinline__ void rw_prep_item(const Args& a, LAS unsigned char* wl  , int tt, int h, int lane) {
    unsigned char* ws = a.ws;
    const bf16_t* P = (const bf16_t*)(ws + WS_P);
    const int l15 = lane & 15, quad = lane >> 4;
    const bool sample = tt >= 1024;
    const int row_base = sample ? MP + (tt - 1024) * 16 : tt * 16;
    const float* mu = a.in[I_MU];
    bf16x8 Aw[2], Aa[2];
    {
        const int m = row_base + l15;
        const bf16_t* cur = P + (size_t)m * NP + O_SH;
        const bf16_t* zrow = (const bf16_t*)(ws + WS_WIN + (size_t)NCOLS * D * 2);
        const bf16_t* prv = sample ? P + (size_t)(m + MS) * NP + O_SH : ((m & (T - 1)) ? cur - NP : zrow + O_SH);
#pragma unroll
        for (int which = 0; which < 2; ++which)
#pragma unroll
            for (int ks = 0; ks < 2; ++ks) {
                const int col = 3072 + which * 64 + ks * 32 + quad * 8;
                const u32x4 cw = *(const u32x4*)(cur + col); const u32x4 pw = *(const u32x4*)(prv + col);
                const f32x4 m0 = *(const f32x4*)(mu + col), m1 = *(const f32x4*)(mu + col + 4);
                float z[8];
                const unsigned cws[4] = {cw.x, cw.y, cw.z, cw.w}, pws[4] = {pw.x, pw.y, pw.z, pw.w};
#pragma unroll
                for (int j = 0; j < 4; ++j) {
                    const float c0 = bflo(cws[j]), c1 = bfhi(cws[j]), p0 = bflo(pws[j]), p1 = bfhi(pws[j]);
                    const float mm0 = (j < 2) ? m0[2 * j] : m1[2 * j - 4], mm1 = (j < 2) ? m0[2 * j + 1] : m1[2 * j - 3];
                    z[2 * j] = c0 + (p0 - c0) * mm0; z[2 * j + 1] = c1 + (p1 - c1) * mm1;
                }
                if (which == 0) {
#pragma unroll
                    for (int j = 0; j < 8; ++j) z[j] = 1.f - 2.f / (__expf(2.f * z[j]) + 1.f);
                }
                u32x4 o; o.x = pk2(z[0], z[1]); o.y = pk2(z[2], z[3]); o.z = pk2(z[4], z[5]); o.w = pk2(z[6], z[7]);
                if (which == 0) Aw[ks] = __builtin_bit_cast(bf16x8, o); else Aa[ks] = __builtin_bit_cast(bf16x8, o);
            }
    }
    const bf16_t* W2T = (const bf16_t*)(ws + WS_W2T); const bf16_t* A2T = (const bf16_t*)(ws + WS_A2T);
    unsigned char* rec = ws + WS_CH + ((size_t)((tt >> 7) * 16 + h) * 128 + (tt & 127)) * REC;
    LAS bf16_t* LA = (LAS bf16_t*)wl;
    LAS bf16_t* LR = LA + 16 * 72;
    LAS bf16_t* LB = LR + 16 * 72;
    LAS bf16_t* LK = LB + 16 * 72;
    LAS float* LN = (LAS float*)(wl + 9216);
    float tA[4][4], tBi[4][4], tBp[4][4];
    float ssq[4] = {0.f, 0.f, 0.f, 0.f}, bon[4] = {0.f, 0.f, 0.f, 0.f};
#pragma unroll
    for (int nt = 0; nt < 4; ++nt) {
        const int ch = h * 64 + nt * 16 + l15, cc = nt * 16 + l15;
        f32x4 cw = {0.f, 0.f, 0.f, 0.f}, ca = {0.f, 0.f, 0.f, 0.f};
#pragma unroll
        for (int ks = 0; ks < 2; ++ks) {
            const bf16x8 bw = *(const bf16x8*)(W2T + (size_t)ch * 64 + ks * 32 + quad * 8), ba = *(const bf16x8*)(A2T + (size_t)ch * 64 + ks * 32 + quad * 8);
            cw = MFMA32(Aw[ks], bw, cw); ca = MFMA32(Aa[ks], ba, ca);
        }
        const float w0 = a.in[I_W0][ch], a0 = a.in[I_A0][ch], k_k = a.in[I_KK][ch], k_a = a.in[I_KA][ch], r_k = a.in[I_RK][ch];
        const float mur = mu[ch], muk = mu[1024 + ch], muv = mu[2048 + ch];
        float lw[4], rr[4], kq[4], vv[4], aa4[4], kr4[4];
#pragma unroll
        for (int r = 0; r < 4; ++r) {
            const int m = row_base + quad * 4 + r;
            const bf16_t* cur = P + (size_t)m * NP + O_SH + ch;
            const bf16_t* prv = sample ? P + (size_t)(m + MS) * NP + O_SH + ch : ((m & (T - 1)) ? cur - NP : (const bf16_t*)(ws + WS_WIN + (size_t)NCOLS * D * 2) + O_SH + ch);
            const float r_ = lerp_bf(cur, prv, mur), k_ = lerp_bf(cur + 1024, prv + 1024, muk), v_ = lerp_bf(cur + 2048, prv + 2048, muv);
            lw[r] = -0.6065306597126334f * sigm(w0 + cw[r]);
            const float aa = sigm(a0 + ca[r]); aa4[r] = aa;
            const float kr = k_ * k_k; kr4[r] = kr; ssq[r] += kr * kr;
            const float kpp = k_ * (1.f + (aa - 1.f) * k_a); kq[r] = kpp;
            rr[r] = r_; vv[r] = v_; bon[r] += r_ * kpp * r_k;
        }
        if (sample) {
#pragma unroll
            for (int r = 0; r < 4; ++r) {
                const int i = (tt - 1024) * 16 + quad * 4 + r;
                float* o = (float*)(ws + WS_OPSS) + ((size_t)(i * 16 + h) * 6) * 64 + cc;
                o[0] = rr[r]; o[64] = __expf(lw[r]); o[128] = kq[r]; o[320] = vv[r];
                tA[nt][r] = kr4[r]; tBi[nt][r] = aa4[r] * kr4[r]; tBp[nt][r] = 0.f;
            }
        } else {
            float c[4]; c[0] = lw[0]; c[1] = c[0] + lw[1]; c[2] = c[1] + lw[2]; c[3] = c[2] + lw[3];
            const float tot = c[3];
            const float s1 = __shfl(tot, (lane - 16) & 63), s2 = __shfl(tot, (lane - 32) & 63), s3 = __shfl(tot, (lane - 48) & 63);
            const float off = (quad >= 1 ? s1 : 0.f) + (quad >= 2 ? s2 : 0.f) + (quad >= 3 ? s3 : 0.f);
            const float total = __shfl(c[3] + off, 48 + l15);
            float kqp[4];
#pragma unroll
            for (int r = 0; r < 4; ++r) {
                const float cum = c[r] + off, cumx = cum - lw[r];
                const float ea = __expf(cumx), er = __expf(cum), ei = __expf(-cum), ep = __expf(total - cum);
                const int tk = quad * 4 + r;
                LR[tk * 72 + cc] = f2bf(rr[r] * er); LK[tk * 72 + cc] = f2bf(kq[r] * ei);
                kqp[r] = kq[r] * ep;
                tA[nt][r] = kr4[r] * ea; tBi[nt][r] = aa4[r] * kr4[r] * ei; tBp[nt][r] = aa4[r] * kr4[r] * ep;
            }
            *(u32x2*)(rec + R_KP + cc * 32 + quad * 8) = (u32x2){pk2(kqp[0], kqp[1]), pk2(kqp[2], kqp[3])};
            *(u32x2*)(rec + R_VT + cc * 32 + quad * 8) = (u32x2){pk2(vv[0], vv[1]), pk2(vv[2], vv[3])};
            if (quad == 0) *(float*)(rec + R_WC + cc * 4) = __expf(total);
        }
        asm volatile("" ::: "memory");
    }
    float inv[4];
#pragma unroll
    for (int r = 0; r < 4; ++r) {
        float s = ssq[r], b = bon[r];
#pragma unroll
        for (int o = 1; o < 16; o <<= 1) { s += __shfl_xor(s, o); b += __shfl_xor(b, o); }
        inv[r] = 1.f / fmaxf(sqrtf(s), 1e-12f);
        if (l15 == 0) ((float*)(ws + WS_BC))[(size_t)(row_base + quad * 4 + r) * 16 + h] = b;
    }
    if (sample) {
#pragma unroll
        for (int nt = 0; nt < 4; ++nt)
#pragma unroll
            for (int r = 0; r < 4; ++r) {
                const int i = (tt - 1024) * 16 + quad * 4 + r;
                float* o = (float*)(ws + WS_OPSS) + ((size_t)(i * 16 + h) * 6) * 64 + nt * 16 + l15;
                o[192] = tA[nt][r] * inv[r]; o[256] = tBi[nt][r] * inv[r];
            }
        return;
    }
#pragma unroll
    for (int nt = 0; nt < 4; ++nt) {
        const int cc = nt * 16 + l15;
        float bp[4];
#pragma unroll
        for (int r = 0; r < 4; ++r) { const int tk = quad * 4 + r;
            LA[tk * 72 + cc] = f2bf(-tA[nt][r] * inv[r]); LB[tk * 72 + cc] = f2bf(tBi[nt][r] * inv[r]); bp[r] = tBp[nt][r] * inv[r]; }
        *(u32x2*)(rec + R_BP + cc * 32 + quad * 8) = (u32x2){pk2(bp[0], bp[1]), pk2(bp[2], bp[3])};
    }
    LDS_WAIT();
#pragma unroll
    for (int i = 0; i < 2; ++i) { const int idx = lane + 64 * i, rr = idx >> 3, c8 = (idx & 7) * 8;
        *(u32x4*)(rec + R_AT + rr * 128 + c8 * 2) = *(const LAS u32x4*)(LA + rr * 72 + c8);
        *(u32x4*)(rec + R_RT + rr * 128 + c8 * 2) = *(const LAS u32x4*)(LR + rr * 72 + c8); }
    f32x4 nab = {0.f, 0.f, 0.f, 0.f}, nak = nab, nrb = nab, nrk = nab;
#pragma unroll
    for (int ks = 0; ks < 2; ++ks) {
        const bf16x8 fa = *(const LAS bf16x8*)(LA + l15 * 72 + ks * 32 + quad * 8), fr_ = *(const LAS bf16x8*)(LR + l15 * 72 + ks * 32 + quad * 8);
        const bf16x8 fb = *(const LAS bf16x8*)(LB + l15 * 72 + ks * 32 + quad * 8), fk = *(const LAS bf16x8*)(LK + l15 * 72 + ks * 32 + quad * 8);
        nab = MFMA32(fa, fb, nab); nak = MFMA32(fa, fk, nak); nrb = MFMA32(fr_, fb, nrb); nrk = MFMA32(fr_, fk, nrk);
    }
#pragma unroll
    for (int r = 0; r < 4; ++r) {
        const int t = quad * 4 + r, j = l15;
        const float vab = (j < t) ? nab[r] : 0.f, vak = (j < t) ? nak[r] : 0.f, vrb = (j <= t) ? nrb[r] : 0.f, vrk = (j <= t) ? nrk[r] : 0.f;
        LN[t * 16 + j] = vab;
        *(bf16_t*)(rec + R_AAK + (t * 16 + j) * 2) = f2bf(vak);
        *(bf16_t*)(rec + R_ARB + (t * 16 + j) * 2) = f2bf(vrb);
        *(bf16_t*)(rec + R_ARK + (t * 16 + j) * 2) = f2bf(vrk);
    }
    LDS_WAIT();
    if (lane < 16) {
        float tc[16];
#pragma unroll
        for (int t = 0; t < 16; ++t) {
            float s = (t == lane) ? 1.f : 0.f;
#pragma unroll
            for (int j = 0; j < t; ++j) s += LN[t * 16 + j] * tc[j];
            tc[t] = s;
            *(bf16_t*)(rec + R_TT + (t * 16 + lane) * 2) = f2bf(s);
        }
    }
    LDS_WAIT();
}

__device__ __forceinline__ bf16x8 k16(u32x2 v) { const u32x4 w = {v.x, v.y, 0u, 0u}; return __builtin_bit_cast(bf16x8, w); }
#define SCAN_DECL(F) bf16x8 F##_at0, F##_at1, F##_rt0, F##_rt1; u32x2 F##_aak, F##_tt, F##_arb, F##_ark, F##_vt, F##_bp0, F##_bp1, F##_bp2, F##_bp3, F##_kp0, F##_kp1, F##_kp2, F##_kp3; float F##_wc0, F##_wc1, F##_wc2, F##_wc3
#define SCAN_LOAD(F, REC_) do { const unsigned char* rec_ = (REC_); \
    F##_at0 = *(const bf16x8*)(rec_ + R_AT + o_nat); F##_at1 = *(const bf16x8*)(rec_ + R_AT + o_nat + 64); \
    F##_rt0 = *(const bf16x8*)(rec_ + R_RT + o_nat); F##_rt1 = *(const bf16x8*)(rec_ + R_RT + o_nat + 64); \
    F##_aak = *(const u32x2*)(rec_ + R_AAK + o_sm); F##_tt = *(const u32x2*)(rec_ + R_TT + o_sm); F##_arb = *(const u32x2*)(rec_ + R_ARB + o_sm); F##_ark = *(const u32x2*)(rec_ + R_ARK + o_sm); \
    F##_vt = *(const u32x2*)(rec_ + R_VT + vt * 512 + o_sm); \
    F##_bp0 = *(const u32x2*)(rec_ + R_BP + o_sm); F##_bp1 = *(const u32x2*)(rec_ + R_BP + 512 + o_sm); F##_bp2 = *(const u32x2*)(rec_ + R_BP + 1024 + o_sm); F##_bp3 = *(const u32x2*)(rec_ + R_BP + 1536 + o_sm); \
    F##_kp0 = *(const u32x2*)(rec_ + R_KP + o_sm); F##_kp1 = *(const u32x2*)(rec_ + R_KP + 512 + o_sm); F##_kp2 = *(const u32x2*)(rec_ + R_KP + 1024 + o_sm); F##_kp3 = *(const u32x2*)(rec_ + R_KP + 1536 + o_sm); \
    F##_wc0 = *(const float*)(rec_ + R_WC + l15 * 4); F##_wc1 = *(const float*)(rec_ + R_WC + 64 + l15 * 4); F##_wc2 = *(const float*)(rec_ + R_WC + 128 + l15 * 4); F##_wc3 = *(const float*)(rec_ + R_WC + 192 + l15 * 4); } while (0)
#define SCAN_UPD(NT, BP, KP, WC) do { f32x4 sn = S##NT * (WC); sn = MFMA32(ua, k16(BP), sn); sn = MFMA32(vtf, k16(KP), sn); S##NT = sn; \
    _Pragma("unroll") for (int r = 0; r < 4; ++r) Sb[(quad * 4 + r) * 72 + NT * 16 + l15] = f2bf(sn[r]); } while (0)
#define SCAN_STEP(F, N, CH) do { const int ch_ = (CH); \
    SCAN_LOAD(N, rec0 + (size_t)(ch_ < 126 ? ch_ + 2 : 127) * REC); \
    const bf16x8 sa0 = *(const LAS bf16x8*)(Sb + l15 * 72 + quad * 8), sa1 = *(const LAS bf16x8*)(Sb + l15 * 72 + 32 + quad * 8); \
    const bf16x8 vtf = k16(F##_vt); const f32x4 z = {0.f, 0.f, 0.f, 0.f}; \
    f32x4 Y = MFMA32(sa0, F##_at0, z); Y = MFMA32(sa1, F##_at1, Y); Y = MFMA32(vtf, k16(F##_aak), Y); \
    _Pragma("unroll") for (int r = 0; r < 4; ++r) Yb[(quad * 4 + r) * 16 + l15] = f2bf(Y[r]); \
    LDS_WAIT(); \
    const bf16x8 ya = k16(*(const LAS u32x2*)(Yb + l15 * 16 + quad * 4)); \
    f32x4 U = MFMA32(ya, k16(F##_tt), z); \
    _Pragma("unroll") for (int r = 0; r < 4; ++r) Ub[(quad * 4 + r) * 16 + l15] = f2bf(U[r]); \
    LDS_WAIT(); \
    const bf16x8 ua = k16(*(const LAS u32x2*)(Ub + l15 * 16 + quad * 4)); \
    f32x4 O = MFMA32(sa0, F##_rt0, z); O = MFMA32(sa1, F##_rt1, O); O = MFMA32(ua, k16(F##_arb), O); O = MFMA32(vtf, k16(F##_ark), O); \
    *(u32x2*)(ob + (size_t)(ch_ * 16 + l15) * D) = (u32x2){pk2(O[0], O[1]), pk2(O[2], O[3])}; \
    SCAN_UPD(0, F##_bp0, F##_kp0, F##_wc0); SCAN_UPD(1, F##_bp1, F##_kp1, F##_wc1); SCAN_UPD(2, F##_bp2, F##_kp2, F##_wc2); SCAN_UPD(3, F##_bp3, F##_kp3, F##_wc3); \
    LDS_WAIT(); __builtin_amdgcn_sched_barrier(0); } while (0)
__device__ __forceinline__ void rw_scan_task(const Args& a, LAS unsigned char* wl  , int b, int h, int vt, int lane) {
    unsigned char* ws = a.ws;
    const int l15 = lane & 15, quad = lane >> 4;
    LAS bf16_t* Sb = (LAS bf16_t*)wl;
    LAS bf16_t* Yb = (LAS bf16_t*)(wl + 2304);
    LAS bf16_t* Ub = (LAS bf16_t*)(wl + 2304 + 512);
    const int o_nat = l15 * 128 + quad * 16, o_sm = l15 * 32 + quad * 8;
    const unsigned char* rec0 = ws + WS_CH + (size_t)((b * 16 + h) * 128) * REC;
    bf16_t* ob = (bf16_t*)(ws + WS_OB) + (size_t)(b * T) * D + h * 64 + vt * 16 + quad * 4;
    f32x4 S0 = {0.f, 0.f, 0.f, 0.f}, S1 = S0, S2 = S0, S3 = S0;
#pragma unroll
    for (int nt = 0; nt < 4; ++nt)
#pragma unroll
        for (int r = 0; r < 4; ++r) Sb[(quad * 4 + r) * 72 + nt * 16 + l15] = 0;
    LDS_WAIT();
    SCAN_DECL(f0); SCAN_DECL(f1); SCAN_DECL(f2);
    SCAN_LOAD(f0, rec0); SCAN_LOAD(f1, rec0 + REC);
    for (int ch = 0; ch < 126; ch += 3) { SCAN_STEP(f0, f2, ch); SCAN_STEP(f1, f0, ch + 1); SCAN_STEP(f2, f1, ch + 2); }
    SCAN_STEP(f0, f2, 126); SCAN_STEP(f1, f0, 127);
    float* so = a.out + OUT_RWP + (size_t)((b * 16 + h) * 64 + vt * 16) * 64;
#pragma unroll
    for (int r = 0; r < 4; ++r) { so[(quad * 4 + r) * 64 + l15] = S0[r]; so[(quad * 4 + r) * 64 + 16 + l15] = S1[r]; so[(quad * 4 + r) * 64 + 32 + l15] = S2[r]; so[(quad * 4 + r) * 64 + 48 + l15] = S3[r]; }
}

__device__ __forceinline__ void rw_sample_wave(const Args& a, int i, int h, int lane) {
    unsigned char* ws = a.ws;
    const float* s0 = a.in[I_SRW] + ((size_t)(i * 16 + h) * 64 + lane) * 64;
    const float* op = (const float*)(ws + WS_OPSS) + (size_t)(i * 16 + h) * 6 * 64;
    float s[64];
#pragma unroll
    for (int j = 0; j < 16; ++j) { const f32x4 t = ((const f32x4*)s0)[j]; s[4 * j] = t.x; s[4 * j + 1] = t.y; s[4 * j + 2] = t.z; s[4 * j + 3] = t.w; }
    const float r_l = op[lane], w_l = op[64 + lane], k_l = op[128 + lane], kk_l = op[192 + lane], b_l = op[256 + lane], v = op[320 + lane];
#define RL(x, j) __builtin_bit_cast(float, __builtin_amdgcn_readlane(__builtin_bit_cast(int, (x)), (j)))
    float sk = 0.f;
#pragma unroll
    for (int j = 0; j < 64; ++j) sk += s[j] * RL(kk_l, j);
    float o = 0.f;
#pragma unroll
    for (int j = 0; j < 64; ++j) { s[j] = s[j] * RL(w_l, j) - sk * RL(b_l, j) + v * RL(k_l, j); o += s[j] * RL(r_l, j); }
#undef RL
    float* so = a.out + OUT_RWS + ((size_t)(i * 16 + h) * 64 + lane) * 64;
#pragma unroll
    for (int j = 0; j < 16; ++j) ((f32x4*)so)[j] = (f32x4){s[4 * j], s[4 * j + 1], s[4 * j + 2], s[4 * j + 3]};
    ((bf16_t*)(ws + WS_OB))[(size_t)(MP + i) * D + h * 64 + lane] = f2bf(o);
}

constexpr int KN_LD = 264, VS_LD = 136, SS_LD = 264;
constexpr int L_KN = 0, L_VS = 128 * KN_LD * 2  , L_SS = L_VS + 64 * VS_LD * 2  , L_RET_END = L_SS + 64 * SS_LD * 2  ;
__device__ __forceinline__ void ret_unit(const Args& a, LAS unsigned char* lds, int unit, int tid) {
    unsigned char* ws = a.ws;
    const bf16_t* P = (const bf16_t*)(ws + WS_P);
    const int dvs = unit & 7, h = (unit >> 3) & 3, b = unit >> 5;
    const int wave = tid >> 6, lane = tid & 63, l15 = lane & 15, quad = lane >> 4;
    LAS bf16_t* KN = (LAS bf16_t*)(lds + L_KN); LAS bf16_t* VS = (LAS bf16_t*)(lds + L_VS); LAS bf16_t* SS = (LAS bf16_t*)(lds + L_SS);
    const float g = 1.f - exp2f(-5.f - (float)h), l2g = __log2f(g);
    const float gC = exp2f(128.f * l2g), ginvC = exp2f(-128.f * l2g);
    const bf16_t* KT = (const bf16_t*)(ws + WS_KT) + (size_t)(b * 4 + h) * 256 * T;
    f32x4 sacc[2][4];
#pragma unroll
    for (int n = 0; n < 2; ++n)
#pragma unroll
        for (int d = 0; d < 4; ++d) sacc[n][d] = (f32x4){0.f, 0.f, 0.f, 0.f};
    for (int i = tid; i < 64 * SS_LD / 2; i += 512) ((LAS unsigned*)SS)[i] = 0u;
    const int it = wave;
    u32x4 stk[8], stv[2];
#define RET_ISSUE(CC) do { const int tok0_ = b * T + (CC) * 128; \
        _Pragma("unroll") for (int i = 0; i < 8; ++i) { const int idx = tid + 512 * i, r = idx >> 5, c8 = (idx & 31) * 8; stk[i] = *(const u32x4*)(P + (size_t)(tok0_ + r) * NP + O_K + h * 256 + c8); } \
        _Pragma("unroll") for (int i = 0; i < 2; ++i) { const int idx = tid + 512 * i, r = idx >> 4, c8 = (idx & 15) * 8; stv[i] = *(const u32x4*)(P + (size_t)(b * T + h * 512 + dvs * 64 + r) * NP + O_V + (CC) * 128 + c8); } } while (0)
    RET_ISSUE(0);
    for (int c = 0; c < 16; ++c) {
        const int tok0 = b * T + c * 128;
        bf16x8 qf[8];
#pragma unroll
        for (int ks = 0; ks < 8; ++ks) qf[ks] = *(const bf16x8*)(P + (size_t)(tok0 + it * 16 + l15) * NP + h * 256 + ks * 32 + quad * 8);
#pragma unroll
        for (int i = 0; i < 8; ++i) { const int idx = tid + 512 * i, r = idx >> 5, c8 = (idx & 31) * 8; *(LAS u32x4*)(KN + r * KN_LD + c8) = stk[i]; }
#pragma unroll
        for (int i = 0; i < 2; ++i) { const int idx = tid + 512 * i, r = idx >> 4, c8 = (idx & 15) * 8; *(LAS u32x4*)(VS + r * VS_LD + c8) = stv[i]; }
        __syncthreads();
        bf16x8 ktf[2][4];
#pragma unroll
        for (int n = 0; n < 2; ++n)
#pragma unroll
            for (int ks = 0; ks < 4; ++ks) ktf[n][ks] = *(const bf16x8*)(KT + (size_t)((2 * wave + n) * 16 + l15) * T + c * 128 + ks * 32 + quad * 8);
        if (c < 15) RET_ISSUE(c + 1);
        f32x4 oacc[4];
#pragma unroll
        for (int d = 0; d < 4; ++d) oacc[d] = (f32x4){0.f, 0.f, 0.f, 0.f};
#pragma unroll
        for (int ks = 0; ks < 8; ++ks)
#pragma unroll
            for (int d = 0; d < 4; ++d) { const bf16x8 sb = *(const LAS bf16x8*)(SS + (d * 16 + l15) * SS_LD + ks * 32 + quad * 8); oacc[d] = MFMA32(qf[ks], sb, oacc[d]); }
#pragma unroll
        for (int p = 0; p < 4; ++p) {
            if (2 * p <= it) {
                f32x4 s0 = {0.f, 0.f, 0.f, 0.f}, s1 = {0.f, 0.f, 0.f, 0.f};
#pragma unroll
                for (int ks = 0; ks < 8; ++ks) { const bf16x8 ka = *(const LAS bf16x8*)(KN + ((2 * p) * 16 + l15) * KN_LD + ks * 32 + quad * 8); s0 = MFMA32(ka, qf[ks], s0); }
                if (2 * p + 1 <= it) {
#pragma unroll
                    for (int ks = 0; ks < 8; ++ks) { const bf16x8 ka = *(const LAS bf16x8*)(KN + ((2 * p + 1) * 16 + l15) * KN_LD + ks * 32 + quad * 8); s1 = MFMA32(ka, qf[ks], s1); }
                }
#pragma unroll
                for (int r = 0; r < 4; ++r) {
                    const int jl = quad * 4 + r;
                    s0[r] = (2 * p == it && jl > l15) ? 0.f : s0[r] * ginvC;
                    s1[r] = (2 * p + 1 > it || (2 * p + 1 == it && jl > l15)) ? 0.f : s1[r] * ginvC;
                }
                u32x4 aw; aw.x = pk2(s0[0], s0[1]); aw.y = pk2(s0[2], s0[3]); aw.z = pk2(s1[0], s1[1]); aw.w = pk2(s1[2], s1[3]);
                const bf16x8 af = __builtin_bit_cast(bf16x8, aw);
#pragma unroll
                for (int d = 0; d < 4; ++d) {
                    const LAS bf16_t* vr = VS + (d * 16 + l15) * VS_LD + 32 * p + quad * 4;
                    const u32x2 lo = *(const LAS u32x2*)vr, hi = *(const LAS u32x2*)(vr + 16);
                    const u32x4 bw = {lo.x, lo.y, hi.x, hi.y};
                    oacc[d] = MFMA32(af, __builtin_bit_cast(bf16x8, bw), oacc[d]);
                }
            }
        }
        {
            bf16_t* OA = (bf16_t*)(ws + WS_OA); float* SQA = (float*)(ws + WS_SQA);
#pragma unroll
            for (int r = 0; r < 4; ++r) {
                const int tok = tok0 + it * 16 + quad * 4 + r;
                float ss = 0.f;
#pragma unroll
                for (int d = 0; d < 4; ++d) { const float v = oacc[d][r]; ss += v * v; OA[(size_t)tok * 2048 + h * 512 + dvs * 64 + d * 16 + l15] = f2bf(v); }
#pragma unroll
                for (int o = 1; o < 16; o <<= 1) ss += __shfl_xor(ss, o);
                if (l15 == 0) SQA[(size_t)tok * 32 + h * 8 + dvs] = ss;
            }
        }
        __syncthreads();
#pragma unroll
        for (int n = 0; n < 2; ++n)
#pragma unroll
            for (int d = 0; d < 4; ++d) {
                f32x4 s = sacc[n][d] * gC;
#pragma unroll
                for (int ks = 0; ks < 4; ++ks) { const bf16x8 va = *(const LAS bf16x8*)(VS + (d * 16 + l15) * VS_LD + ks * 32 + quad * 8); s = MFMA32(va, ktf[n][ks], s); }
                sacc[n][d] = s;
#pragma unroll
                for (int r = 0; r < 4; ++r) SS[(d * 16 + quad * 4 + r) * SS_LD + (2 * wave + n) * 16 + l15] = f2bf(s[r]);
            }
        __syncthreads();
    }
    float* so = a.out + OUT_RETP + (size_t)(b * 4 + h) * 256 * 512;
#pragma unroll
    for (int n = 0; n < 2; ++n)
#pragma unroll
        for (int d = 0; d < 4; ++d) *(f32x4*)(so + (size_t)((2 * wave + n) * 16 + l15) * 512 + dvs * 64 + d * 16 + quad * 4) = sacc[n][d];
}
#undef RET_ISSUE

__device__ __forceinline__ void ret_sample_unit(const Args& a, LAS unsigned char* lds, int i, int h, int tid) {
    unsigned char* ws = a.ws;
    const bf16_t* Prow = (const bf16_t*)(ws + WS_P) + (size_t)(MP + i) * NP;
    LAS float* Q = (LAS float*)lds; LAS float* Kh = Q + 256; LAS float* RED = Kh + 256; LAS float* OS = RED + 16;
    const float g = 1.f - exp2f(-5.f - (float)h);
    const int lane = tid & 63, wave = tid >> 6;
    float qk = 0.f;
    if (tid < 256) { const float q = bf2f(Prow[h * 256 + tid]), k = bf2f(Prow[O_K + h * 256 + tid]); Q[tid] = q; Kh[tid] = k; qk = q * k; }
    qk = wave_sum(qk);
    if (lane == 0) RED[wave] = qk;
    __syncthreads();
    const float qkv = (RED[0] + RED[1] + RED[2] + RED[3]) / g;
    const int dkg = tid >> 7, dv4 = 4 * (tid & 127);
    const u32x2 vw = *(const u32x2*)(Prow + O_V + h * 512 + dv4);
    const f32x4 v = {bflo(vw.x), bfhi(vw.x), bflo(vw.y), bfhi(vw.y)};
    const float* s0 = a.in[I_SRET] + (size_t)(i * 4 + h) * 256 * 512 + dv4;
    float* s1 = a.out + OUT_RETS + (size_t)(i * 4 + h) * 256 * 512 + dv4;
    f32x4 o = {0.f, 0.f, 0.f, 0.f};
#pragma unroll 8
    for (int j = 0; j < 64; ++j) {
        const int dk = dkg * 64 + j;
        const f32x4 s = __builtin_nontemporal_load((const f32x4*)(s0 + (size_t)dk * 512));
        o += s * Q[dk];
        __builtin_nontemporal_store(s * g + v * Kh[dk], (f32x4*)(s1 + (size_t)dk * 512));
    }
    *(LAS f32x4*)(OS + dkg * 512 + dv4) = o;
    __syncthreads();
    float y[4] = {0.f, 0.f, 0.f, 0.f}; float ss = 0.f;
    if (tid < 128) {
        const f32x4 t = *(LAS f32x4*)(OS + dv4) + *(LAS f32x4*)(OS + 512 + dv4) + *(LAS f32x4*)(OS + 1024 + dv4) + *(LAS f32x4*)(OS + 1536 + dv4) + v * qkv;
        y[0] = t.x; y[1] = t.y; y[2] = t.z; y[3] = t.w; ss = t.x * t.x + t.y * t.y + t.z * t.z + t.w * t.w;
    }
    ss = wave_sum(ss);
    if (lane == 0) RED[8 + wave] = ss;
    __syncthreads();
    if (tid < 128) {
        const float rs = 1.0f / sqrtf((RED[8] + RED[9]) * (1.f / 512.f) + EPS);
        const u32x2 gw = *(const u32x2*)(Prow + O_GA + h * 512 + dv4);
        u32x2 ow; ow.x = pk2(y[0] * rs * silu_(bflo(gw.x)), y[1] * rs * silu_(bfhi(gw.x))); ow.y = pk2(y[2] * rs * silu_(bflo(gw.y)), y[3] * rs * silu_(bfhi(gw.y)));
        *(u32x2*)((bf16_t*)(ws + WS_OA) + (size_t)(MP + i) * 2048 + h * 512 + dv4) = ow;
    }
    __syncthreads();
}

__device__ __forceinline__ void ret_sample_wave(const Args& a, int i, int h, int lane) {
    unsigned char* ws = a.ws;
    const bf16_t* Prow = (const bf16_t*)(ws + WS_P) + (size_t)(MP + i) * NP;
    const float g = 1.f - exp2f(-5.f - (float)h);
    float q[4], k[4]; float qk = 0.f;
#pragma unroll
    for (int j = 0; j < 4; ++j) { q[j] = bf2f(Prow[h * 256 + 64 * j + lane]); k[j] = bf2f(Prow[O_K + h * 256 + 64 * j + lane]); qk += q[j] * k[j]; }
    const float qkv = wave_sum(qk) / g;
    f32x4 v[2];
#pragma unroll
    for (int e = 0; e < 2; ++e) { const u32x2 vw = *(const u32x2*)(Prow + O_V + h * 512 + e * 256 + lane * 4); v[e] = (f32x4){bflo(vw.x), bfhi(vw.x), bflo(vw.y), bfhi(vw.y)}; }
    const float* s0 = a.in[I_SRET] + (size_t)(i * 4 + h) * 256 * 512 + lane * 4;
    float* s1 = a.out + OUT_RETS + (size_t)(i * 4 + h) * 256 * 512 + lane * 4;
    f32x4 o[2] = {{0.f, 0.f, 0.f, 0.f}, {0.f, 0.f, 0.f, 0.f}};
#pragma unroll
    for (int j = 0; j < 4; ++j) {
        for (int d0 = 0; d0 < 64; d0 += 16) {
            f32x4 sv[16][2];
#pragma unroll
            for (int d = 0; d < 16; ++d)
#pragma unroll
                for (int e = 0; e < 2; ++e) sv[d][e] = __builtin_nontemporal_load((const f32x4*)(s0 + (size_t)(64 * j + d0 + d) * 512 + e * 256));
#pragma unroll
            for (int d = 0; d < 16; ++d) {
                const float qd = __builtin_bit_cast(float, __builtin_amdgcn_readlane(__builtin_bit_cast(int, q[j]), d0 + d));
                const float kd = __builtin_bit_cast(float, __builtin_amdgcn_readlane(__builtin_bit_cast(int, k[j]), d0 + d));
#pragma unroll
                for (int e = 0; e < 2; ++e) { o[e] += sv[d][e] * qd; __builtin_nontemporal_store(sv[d][e] * g + v[e] * kd, (f32x4*)(s1 + (size_t)(64 * j + d0 + d) * 512 + e * 256)); }
            }
        }
    }
    float ss = 0.f;
#pragma unroll
    for (int e = 0; e < 2; ++e) { o[e] += v[e] * qkv; ss += (o[e].x * o[e].x + o[e].y * o[e].y) + (o[e].z * o[e].z + o[e].w * o[e].w); }
    const float rs = 1.0f / sqrtf(wave_sum(ss) * (1.f / 512.f) + EPS);
#pragma unroll
    for (int e = 0; e < 2; ++e) { const u32x2 gw = *(const u32x2*)(Prow + O_GA + h * 512 + e * 256 + lane * 4);
        u32x2 ow; ow.x = pk2(o[e].x * rs * silu_(bflo(gw.x)), o[e].y * rs * silu_(bfhi(gw.x))); ow.y = pk2(o[e].z * rs * silu_(bflo(gw.y)), o[e].w * rs * silu_(bfhi(gw.y)));
        *(u32x2*)((bf16_t*)(ws + WS_OA) + (size_t)(MP + i) * 2048 + h * 512 + e * 256 + lane * 4) = ow; }
}

__device__ __forceinline__ void phase25_row(const Args& a, int m, int lane) {
    unsigned char* ws = a.ws;
    const bf16_t* Prow = (const bf16_t*)(ws + WS_P) + (size_t)m * NP;
    bf16_t* oa = (bf16_t*)(ws + WS_OA) + (size_t)m * 2048;
    const float* sq = (const float*)(ws + WS_SQA) + (size_t)m * 32;
    const bool prompt = m < MP;
    f32x4 sqv[8]; u32x4 ow[4], gw4[4];
    if (prompt) {
#pragma unroll
        for (int j = 0; j < 8; ++j) sqv[j] = ((const f32x4*)sq)[j];
#pragma unroll
        for (int hh = 0; hh < 4; ++hh) { ow[hh] = *(const u32x4*)(oa + hh * 512 + lane * 8); gw4[hh] = *(const u32x4*)(Prow + O_GA + hh * 512 + lane * 8); }
    }
    const bf16_t* ob = (const bf16_t*)(ws + WS_OB) + (size_t)m * D + lane * 16;
    f32x4 ov[4];
    { const u32x4 w0 = ((const u32x4*)ob)[0], w1 = ((const u32x4*)ob)[1];
      ov[0] = (f32x4){bflo(w0.x), bfhi(w0.x), bflo(w0.y), bfhi(w0.y)}; ov[1] = (f32x4){bflo(w0.z), bfhi(w0.z), bflo(w0.w), bfhi(w0.w)};
      ov[2] = (f32x4){bflo(w1.x), bfhi(w1.x), bflo(w1.y), bfhi(w1.y)}; ov[3] = (f32x4){bflo(w1.z), bfhi(w1.z), bflo(w1.w), bfhi(w1.w)}; }
    const float bc = ((const float*)(ws + WS_BC))[(size_t)m * 16 + (lane >> 2)];
    const bf16_t* cur = Prow + O_SH + 2048 + lane * 16;
    const bool hasp = (m >= MP) || (m & (T - 1));
    const bf16_t* prv = (m >= MP) ? cur + (size_t)MS * NP : cur - NP;
    u32x4 cw[2], pw[2] = {{0u, 0u, 0u, 0u}, {0u, 0u, 0u, 0u}}, gbw[2];
    cw[0] = ((const u32x4*)cur)[0]; cw[1] = ((const u32x4*)cur)[1];
    if (hasp) { pw[0] = ((const u32x4*)prv)[0]; pw[1] = ((const u32x4*)prv)[1]; }
    gbw[0] = ((const u32x4*)(Prow + O_GB + lane * 16))[0]; gbw[1] = ((const u32x4*)(Prow + O_GB + lane * 16))[1];
    f32x4 lw4[4], lb4[4], mu4[4];
#pragma unroll
    for (int j = 0; j < 4; ++j) { lw4[j] = ((const f32x4*)(a.in[I_LNW] + lane * 16))[j]; lb4[j] = ((const f32x4*)(a.in[I_LNB] + lane * 16))[j]; mu4[j] = ((const f32x4*)(a.in[I_MU] + 2048 + lane * 16))[j]; }
    if (prompt) {
#pragma unroll
        for (int hh = 0; hh < 4; ++hh) {
            const f32x4 s0 = sqv[2 * hh], s1 = sqv[2 * hh + 1];
            const float rs = 1.0f / sqrtf(((s0.x + s0.y) + (s0.z + s0.w) + (s1.x + s1.y) + (s1.z + s1.w)) * (1.f / 512.f) + EPS);
            const u32x4 o4 = ow[hh], g4 = gw4[hh];
            u32x4 r;
            r.x = pk2(bflo(o4.x) * rs * silu_(bflo(g4.x)), bfhi(o4.x) * rs * silu_(bfhi(g4.x))); r.y = pk2(bflo(o4.y) * rs * silu_(bflo(g4.y)), bfhi(o4.y) * rs * silu_(bfhi(g4.y)));
            r.z = pk2(bflo(o4.z) * rs * silu_(bflo(g4.z)), bfhi(o4.z) * rs * silu_(bfhi(g4.z))); r.w = pk2(bflo(o4.w) * rs * silu_(bflo(g4.w)), bfhi(o4.w) * rs * silu_(bfhi(g4.w)));
            *(u32x4*)(oa + hh * 512 + lane * 8) = r;
        }
    }
    float o[16], lw[16], lb[16], mu[16];
#pragma unroll
    for (int j = 0; j < 4; ++j) { o[4 * j] = ov[j].x; o[4 * j + 1] = ov[j].y; o[4 * j + 2] = ov[j].z; o[4 * j + 3] = ov[j].w;
        lw[4 * j] = lw4[j].x; lw[4 * j + 1] = lw4[j].y; lw[4 * j + 2] = lw4[j].z; lw[4 * j + 3] = lw4[j].w;
        lb[4 * j] = lb4[j].x; lb[4 * j + 1] = lb4[j].y; lb[4 * j + 2] = lb4[j].z; lb[4 * j + 3] = lb4[j].w;
        mu[4 * j] = mu4[j].x; mu[4 * j + 1] = mu4[j].y; mu[4 * j + 2] = mu4[j].z; mu[4 * j + 3] = mu4[j].w; }
    float s = 0.f;
#pragma unroll
    for (int j = 0; j < 16; ++j) s += o[j];
    s += __shfl_xor(s, 1); s += __shfl_xor(s, 2);
    const float mean = s * (1.f / 64.f);
    float q = 0.f;
#pragma unroll
    for (int j = 0; j < 16; ++j) { const float d = o[j] - mean; q += d * d; }
    q += __shfl_xor(q, 1); q += __shfl_xor(q, 2);
    const float rstd = 1.0f / sqrtf(q * (1.f / 64.f) + 64e-5f);
    const unsigned cws[8] = {cw[0].x, cw[0].y, cw[0].z, cw[0].w, cw[1].x, cw[1].y, cw[1].z, cw[1].w};
    const unsigned pws[8] = {pw[0].x, pw[0].y, pw[0].z, pw[0].w, pw[1].x, pw[1].y, pw[1].z, pw[1].w};
    const unsigned gws[8] = {gbw[0].x, gbw[0].y, gbw[0].z, gbw[0].w, gbw[1].x, gbw[1].y, gbw[1].z, gbw[1].w};
    unsigned outw[8];
#pragma unroll
    for (int j = 0; j < 8; ++j) {
        const float c0 = bflo(cws[j]), c1 = bfhi(cws[j]), p0 = bflo(pws[j]), p1 = bfhi(pws[j]);
        const float v0 = c0 + (p0 - c0) * mu[2 * j], v1 = c1 + (p1 - c1) * mu[2 * j + 1];
        const float y0 = ((o[2 * j] - mean) * rstd * lw[2 * j] + lb[2 * j] + bc * v0) * silu_(bflo(gws[j]));
        const float y1 = ((o[2 * j + 1] - mean) * rstd * lw[2 * j + 1] + lb[2 * j + 1] + bc * v1) * silu_(bfhi(gws[j]));
        outw[j] = pk2(y0, y1);
    }
    bf16_t* yb = (bf16_t*)(ws + WS_H) + (size_t)m * D + lane * 16;
    *(u32x4*)yb = (u32x4){outw[0], outw[1], outw[2], outw[3]}; *(u32x4*)(yb + 8) = (u32x4){outw[4], outw[5], outw[6], outw[7]};
}

struct EpiT1 {
    static constexpr bool PERM = false;
    const bf16_t* P; bf16_t* T1;
    __device__ __forceinline__ void operator()(const f32x4 (&acc)[2][2][4][2], const Unit& u, int wr, int wc, int fr, int fq) const {
        const int row0 = u.pm * 256 + wr * 64 + fr, col0 = u.pn * 256 + wc * 32 + 4 * fq;
#pragma unroll
        for (int ai = 0; ai < 2; ++ai)
#pragma unroll
            for (int m = 0; m < 4; ++m) { const int row = row0 + ai * 128 + m * 16; if (row >= MR) continue;
#pragma unroll
                for (int bj = 0; bj < 2; ++bj)
#pragma unroll
                    for (int n = 0; n < 2; ++n) { const int col = col0 + bj * 128 + n * 16;
                        const u32x2 gw = *(const u32x2*)(P + (size_t)row * NP + O_MA + col);
                        const f32x4 gt = {sigm(bflo(gw.x)), sigm(bfhi(gw.x)), sigm(bflo(gw.y)), sigm(bfhi(gw.y))};
                        const f32x4 t = acc[ai][bj][m][n] * gt; *(u32x2*)(T1 + (size_t)row * D + col) = (u32x2){pk2(t.x, t.y), pk2(t.z, t.w)}; } asm volatile("" ::: "memory"); }
    }
};
struct EpiMG {
    static constexpr bool PERM = false;
    const bf16_t* P; const bf16_t* T1; bf16_t* MG;
    __device__ __forceinline__ void operator()(const f32x4 (&acc)[2][2][4][2], const Unit& u, int wr, int wc, int fr, int fq) const {
        const int row0 = u.pm * 256 + wr * 64 + fr, col0 = u.pn * 256 + wc * 32 + 4 * fq;
#pragma unroll
        for (int ai = 0; ai < 2; ++ai)
#pragma unroll
            for (int m = 0; m < 4; ++m) { const int row = row0 + ai * 128 + m * 16; if (row >= MR) continue;
#pragma unroll
                for (int bj = 0; bj < 2; ++bj)
#pragma unroll
                    for (int n = 0; n < 2; ++n) { const int col = col0 + bj * 128 + n * 16;
                        const u32x2 gw = *(const u32x2*)(P + (size_t)row * NP + O_MB + col);
                        const f32x4 gt = {sigm(bflo(gw.x)), sigm(bfhi(gw.x)), sigm(bflo(gw.y)), sigm(bfhi(gw.y))};
                        const u32x2 tw = *(const u32x2*)(T1 + (size_t)row * D + col);
                        const f32x4 v = (f32x4){bflo(tw.x), bfhi(tw.x), bflo(tw.y), bfhi(tw.y)} + acc[ai][bj][m][n] * gt;
                        *(u32x2*)(MG + (size_t)row * D + col) = (u32x2){pk2(v.x, v.y), pk2(v.z, v.w)}; } asm volatile("" ::: "memory"); }
    }
};
struct EpiX1 {
    static constexpr bool PERM = false;
    const float* xp; const float* xs; float* X1; bf16_t* X1B; float* SQ;
    __device__ __forceinline__ void operator()(const f32x4 (&acc)[2][2][4][2], const Unit& u, int wr, int wc, int fr, int fq) const {
        const int row0 = u.pm * 256 + wr * 64 + fr, col0 = u.pn * 256 + wc * 32 + 4 * fq;
#pragma unroll
        for (int ai = 0; ai < 2; ++ai)
#pragma unroll
            for (int m = 0; m < 4; ++m) { const int row = row0 + ai * 128 + m * 16; const bool ok = row < MR;
                const float* xr = (row < MP) ? xp + (size_t)row * D : xs + (size_t)(row - MP) * D;
                float ss = 0.f;
                if (ok) {
#pragma unroll
                    for (int bj = 0; bj < 2; ++bj)
#pragma unroll
                        for (int n = 0; n < 2; ++n) { const int col = col0 + bj * 128 + n * 16;
                            const f32x4 v = *(const f32x4*)(xr + col) + acc[ai][bj][m][n];
                            ss += (v.x * v.x + v.y * v.y) + (v.z * v.z + v.w * v.w);
                            *(u32x2*)(X1B + (size_t)row * D + col) = (u32x2){pk2(v.x, v.y), pk2(v.z, v.w)}; }
                }
                ss += __shfl_xor(ss, 16); ss += __shfl_xor(ss, 32);
                if (ok && fq == 0) SQ[(size_t)row * 16 + u.pn * 4 + wc] = ss; asm volatile("" ::: "memory"); }
    }
};
struct EpiGT {
    static constexpr bool PERM = false;
    const float* SQ; bf16_t* GT;
    __device__ __forceinline__ void operator()(const f32x4 (&acc)[2][2][4][2], const Unit& u, int wr, int wc, int fr, int fq) const {
        const int row0 = u.pm * 256 + wr * 64 + fr, col0 = u.pn * 256 + wc * 32 + 4 * fq;
#pragma unroll
        for (int ai = 0; ai < 2; ++ai)
#pragma unroll
            for (int m = 0; m < 4; ++m) { const int row = row0 + ai * 128 + m * 16; if (row >= MR) continue;
                const f32x4* sp = (const f32x4*)(SQ + (size_t)row * 16); const f32x4 q0 = sp[0], q1 = sp[1], q2 = sp[2], q3 = sp[3];
                const float rs = 1.0f / sqrtf((((q0.x + q0.y) + (q0.z + q0.w)) + ((q1.x + q1.y) + (q1.z + q1.w)) + ((q2.x + q2.y) + (q2.z + q2.w)) + ((q3.x + q3.y) + (q3.z + q3.w))) * (1.f / D) + EPS);
#pragma unroll
                for (int bj = 0; bj < 2; ++bj)
#pragma unroll
                    for (int n = 0; n < 2; ++n) { const int col = col0 + bj * 128 + n * 16; const f32x4 t = acc[ai][bj][m][n] * rs;
                        *(u32x2*)(GT + (size_t)row * D + col) = (u32x2){pk2(sigm(t.x), sigm(t.y)), pk2(sigm(t.z), sigm(t.w))}; } asm volatile("" ::: "memory"); }
    }
};
struct EpiX2 {
    static constexpr bool PERM = false;
    const bf16_t* X1; const bf16_t* GT; float* out; float* SQ;
    __device__ __forceinline__ void operator()(const f32x4 (&acc)[2][2][4][2], const Unit& u, int wr, int wc, int fr, int fq) const {
        const int row0 = u.pm * 256 + wr * 64 + fr, col0 = u.pn * 256 + wc * 32 + 4 * fq;
#pragma unroll
        for (int ai = 0; ai < 2; ++ai)
#pragma unroll
            for (int m = 0; m < 4; ++m) { int row = row0 + ai * 128 + m * 16; asm volatile("" : "+v"(row)); const bool ok = row < MR;
                float ss = 0.f;
                if (ok) {
#pragma unroll
                    for (int bj = 0; bj < 2; ++bj)
#pragma unroll
                        for (int n = 0; n < 2; ++n) { const int col = col0 + bj * 128 + n * 16;
                            const u32x2 gw = *(const u32x2*)(GT + (size_t)row * D + col);
                            const u32x2 xw = *(const u32x2*)(X1 + (size_t)row * D + col);
                            const f32x4 v = (f32x4){bflo(xw.x), bfhi(xw.x), bflo(xw.y), bfhi(xw.y)} + acc[ai][bj][m][n] * (f32x4){bflo(gw.x), bfhi(gw.x), bflo(gw.y), bfhi(gw.y)};
                            ss += (v.x * v.x + v.y * v.y) + (v.z * v.z + v.w * v.w);
                            *(f32x4*)(out + (size_t)row * D + col) = v; asm volatile("" ::: "memory"); }
                }
                ss += __shfl_xor(ss, 16); ss += __shfl_xor(ss, 32);
                if (ok && fq == 0) SQ[(size_t)row * 16 + u.pn * 4 + wc] = ss; asm volatile("" ::: "memory"); }
    }
};


__device__ __forceinline__ f32x4 mini_acc(const bf16_t* A, int lda, const bf16_t* Bt, int K, int kq, int l15, int quad) {
    f32x4 acc = {0.f, 0.f, 0.f, 0.f};
    const int kn = K / 128;
    const bf16_t* ap = A + (size_t)l15 * lda + kq * (K / 4) + quad * 8;
    const bf16_t* bp = Bt + (size_t)l15 * K + kq * (K / 4) + quad * 8;
#pragma unroll 4
    for (int ks = 0; ks < kn; ++ks) acc = MFMA32(*(const bf16x8*)(ap + ks * 32), *(const bf16x8*)(bp + ks * 32), acc);
    return acc;
}
__device__ __forceinline__ f32x4 mini_reduce(LAS f32x4* red, int half, int lane) { return (red[(half * 4 + 0) * 64 + lane] + red[(half * 4 + 1) * 64 + lane]) + (red[(half * 4 + 2) * 64 + lane] + red[(half * 4 + 3) * 64 + lane]); }
template <int PH> __device__ __forceinline__ void mini_phase(const Args& a, LAS unsigned char* lds, int bx, int G, int wave, int lane) {
    unsigned char* ws = a.ws;
    const int l15 = lane & 15, quad = lane >> 4, half = wave >> 2, kq = wave & 3;
    LAS f32x4* red1 = (LAS f32x4*)lds; LAS f32x4* red2 = red1 + 8 * 64;
    const bf16_t* P = (const bf16_t*)(ws + WS_P);
    for (int tp = bx; tp < 256; tp += G) {
        const int tl = tp * 2 + half, mt = tl >> 6, nt = tl & 63, row0 = MP + mt * 16, col0 = nt * 16;
        f32x4 a1, a2 = {0.f, 0.f, 0.f, 0.f};
        if (PH == 0) { a1 = mini_acc((const bf16_t*)(ws + WS_OA) + (size_t)row0 * 2048, 2048, (const bf16_t*)(ws + WS_WDA) + (size_t)col0 * 2048, 2048, kq, l15, quad);
                       a2 = mini_acc((const bf16_t*)(ws + WS_H) + (size_t)row0 * D, D, (const bf16_t*)(ws + WS_WDB) + (size_t)col0 * D, D, kq, l15, quad); }
        if (PH == 1) { a1 = mini_acc((const bf16_t*)(ws + WS_MG) + (size_t)row0 * D, D, (const bf16_t*)(ws + WS_WOUT) + (size_t)col0 * D, D, kq, l15, quad); }
        if (PH == 2) { a1 = mini_acc((const bf16_t*)(ws + WS_X1B) + (size_t)row0 * D, D, (const bf16_t*)(ws + WS_WGATE) + (size_t)col0 * D, D, kq, l15, quad);
                       a2 = mini_acc((const bf16_t*)(ws + WS_PB) + (size_t)row0 * PLE, PLE, (const bf16_t*)(ws + WS_WPLE) + (size_t)col0 * PLE, PLE, kq, l15, quad); }
        red1[wave * 64 + lane] = a1; red2[wave * 64 + lane] = a2;
        __syncthreads();
        if (kq == 0) {
            a1 = mini_reduce(red1, half, lane); a2 = mini_reduce(red2, half, lane);
            const int col = col0 + l15;
            float rs1[4] = {0.f, 0.f, 0.f, 0.f};
            if (PH == 2) {
#pragma unroll
                for (int r = 0; r < 4; ++r) { const f32x4 q = *(const f32x4*)((const float*)(ws + WS_SQS1) + (size_t)(row0 - MP + quad * 4 + r) * 64 + l15 * 4); float t = (q.x + q.y) + (q.z + q.w);
#pragma unroll
                    for (int o = 1; o < 16; o <<= 1) t += __shfl_xor(t, o);
                    rs1[r] = 1.0f / sqrtf(t * (1.f / D) + EPS); }
            }
#pragma unroll
            for (int r = 0; r < 4; ++r) {
                const int row = row0 + quad * 4 + r;
                float ss = 0.f;
                if (PH == 0) { const float ga = sigm(bf2f(P[(size_t)row * NP + O_MA + col])), gb = sigm(bf2f(P[(size_t)row * NP + O_MB + col]));
                    ((bf16_t*)(ws + WS_MG))[(size_t)row * D + col] = f2bf(a1[r] * ga + a2[r] * gb); }
                if (PH == 1) { const float x1 = a.in[I_XS][(size_t)(row - MP) * D + col] + a1[r]; ss = x1 * x1;
                    ((bf16_t*)(ws + WS_X1B))[(size_t)row * D + col] = f2bf(x1); }
                if (PH == 2) { const float x2 = bf2f(((const bf16_t*)(ws + WS_X1B))[(size_t)row * D + col]) + a2[r] * sigm(rs1[r] * a1[r]); ss = x2 * x2;
                    a.out[OUT_Y + (size_t)row * D + col] = x2; }
                if (PH != 0) {
#pragma unroll
                    for (int o = 1; o < 16; o <<= 1) ss += __shfl_xor(ss, o);
                    if (l15 == 0) ((float*)(ws + (PH == 1 ? WS_SQS1 : WS_SQS2)))[(size_t)(row - MP) * 64 + nt] = ss;
                }
            }
        }
        __syncthreads();
    }
}

#define XB_TMO      128
#define XB_XCNT(j)  (256  + 64 * (j))
#define XB_XSUB(j)  (1280 + 64 * (j))
#define XB_XGEN(j)  (2304 + 64 * (j))
#define XB_TOP      3328
#define XB_TOPGEN   3392
#define XCD_BAR_WORDS 3456
#define XB_SPIN_CAP (1u << 22)
__device__ __forceinline__ unsigned xb_ld(unsigned* p)              { return __hip_atomic_load(p, __ATOMIC_RELAXED, __HIP_MEMORY_SCOPE_AGENT); }
__device__ __forceinline__ unsigned xb_add(unsigned* p, unsigned v) { return __hip_atomic_fetch_add(p, v, __ATOMIC_RELAXED, __HIP_MEMORY_SCOPE_AGENT); }
__device__ __forceinline__ unsigned xb_xcc_id() { return (unsigned)__builtin_amdgcn_s_getreg((3 << 11) | 20) & 0xFu; }
#define XB_SPIN(cond, bar) do { unsigned _sp = 0; while (cond) { __builtin_amdgcn_s_sleep(1); \
    if ((++_sp & 255u) == 0u) { if (xb_ld(&(bar)[XB_TMO])) break; if (_sp > XB_SPIN_CAP) { atomicAdd(&(bar)[XB_TMO], 1u); break; } } } } while (0)
struct XcdBarrier { unsigned* bar; unsigned x; volatile LAS unsigned* st; };
__device__ __forceinline__ XcdBarrier xcd_barrier_post(unsigned* bar, volatile LAS unsigned* st) {
    XcdBarrier b; b.bar = bar; b.x = xb_xcc_id(); b.st = st;
    if (threadIdx.x == 0) (void)xb_add(&bar[XB_XCNT(b.x)], 1u);
    return b;
}
__device__ __forceinline__ void xcd_barrier_complete(unsigned* bar, unsigned x, unsigned& nloc, unsigned& nx) {
    const unsigned G = gridDim.x * gridDim.y * gridDim.z;
    unsigned sum, cnt, mine, sp = 0u;
    for (;;) {
        sum = 0u; cnt = 0u; mine = 0u;
#pragma unroll
        for (unsigned j = 0; j < 16; ++j) { const unsigned c = xb_ld(&bar[XB_XCNT(j)]); sum += c; cnt += (c > 0u) ? 1u : 0u; mine = (j == x) ? c : mine; }
        if (sum == G) break;
        __builtin_amdgcn_s_sleep(1);
        if ((++sp & 255u) == 0u) { if (xb_ld(&bar[XB_TMO])) break; if (sp > XB_SPIN_CAP) { atomicAdd(&bar[XB_TMO], 1u); break; } }
    }
    nloc = mine > 0u ? mine : 1u; nx = cnt > 0u ? cnt : 1u;
}
__device__ __forceinline__ void xcd_barrier(const XcdBarrier& b) {
    asm volatile("s_waitcnt vmcnt(0)" ::: "memory");
    __syncthreads();
    if (threadIdx.x == 0) {
        unsigned* bar = b.bar;
        __builtin_amdgcn_s_waitcnt(0);
        unsigned nloc = b.st[0], nx = b.st[1];
        if (nloc == 0u) { xcd_barrier_complete(bar, b.x, nloc, nx); b.st[0] = nloc; b.st[1] = nx; }
        const unsigned old = xb_add(&bar[XB_XSUB(b.x)], 1u);
        const unsigned gen = old / nloc;
        if (old + 1u == (gen + 1u) * nloc) {
            __builtin_amdgcn_fence(__ATOMIC_RELEASE, "agent");
            asm volatile("s_waitcnt vmcnt(0)" ::: "memory");
            const unsigned og = xb_add(&bar[XB_TOP], 1u);
            const unsigned tg = og / nx;
            if (og + 1u == (tg + 1u) * nx) xb_add(&bar[XB_TOPGEN], 1u);
            else XB_SPIN(xb_ld(&bar[XB_TOPGEN]) == tg, bar);
            __builtin_amdgcn_fence(__ATOMIC_ACQUIRE, "agent");
            xb_add(&bar[XB_XGEN(b.x)], 1u);
            asm volatile("s_waitcnt vmcnt(0)" ::: "memory");
        } else {
            XB_SPIN(xb_ld(&bar[XB_XGEN(b.x)]) == gen, bar);
            __builtin_amdgcn_fence(__ATOMIC_ACQUIRE, "agent");
            asm volatile("s_waitcnt vmcnt(0)" ::: "memory");
        }
    }
    __syncthreads();
}

constexpr int LDS_BYTES = 147456;
constexpr int CTL_SQ1 = 0, CTL_SQ2 = 32768, CTL_CNT = 65536;

#define GRID_SYNC() xcd_barrier(xbar)
__global__ void __launch_bounds__(512, 2) fwd_mega(Args a) {
    extern __shared__ __attribute__((aligned(16))) unsigned char lds_raw[];
    LAS unsigned char* lds = (LAS unsigned char*)lds_raw;
    cg::grid_group grid = cg::this_grid();
    const int tid = threadIdx.x, lane = tid & 63, wave = __builtin_amdgcn_readfirstlane(tid >> 6);
    const int G = gridDim.x, bx = blockIdx.x;
    const int gw = bx * 8 + wave, NGW = G * 8;
    unsigned char* ws = a.ws;
    if (tid < 16) ((LAS unsigned*)(lds + 131072 + 64))[tid] = 0u;
    __syncthreads();
    XcdBarrier xbar = xcd_barrier_post((unsigned*)(ws + WS_BAR), (volatile LAS unsigned*)(lds + 131072 + 64));
    grid.sync();

#if !defined(ONLY_PH) || ONLY_PH == 0
    phase0(a, lds, gw, NGW, wave, lane);
    GRID_SYNC();
#endif
#if !defined(ONLY_PH) || ONLY_PH == 1
    {
        pg8::Gemm g{(const bf16_t*)(ws + WS_H), (const bf16_t*)(ws + WS_WIN), MALL, NP, D}; pg8::StaticOrder S; S.init(MALL, NP, G, bx);
        EpiP E{(bf16_t*)(ws + WS_P), (bf16_t*)(ws + WS_KT), (const f32x2*)(ws + WS_ROPE)};
        pg8::gemm_phase<EpiP>(lds, g, S, E);
    }
    GRID_SYNC();
#endif
#if !defined(ONLY_PH) || ONLY_PH == 2
    for (int it = gw; it < 1032 * 16; it += NGW) rw_prep_item(a, lds + wave * 10240, it >> 4, it & 15, lane);
    GRID_SYNC();
#endif
#if !defined(ONLY_PH) || ONLY_PH == 3
    {
        for (int u = gw; u < MS * 16; u += NGW) rw_sample_wave(a, u >> 4, u & 15, lane);
        if (bx < 128) { if (wave < 4) rw_scan_task(a, lds + wave * 4096, bx >> 4, bx & 15, wave, lane); else if (G >= 128) { const int u = bx * 4 + (wave - 4); ret_sample_wave(a, u >> 2, u & 3, lane); } }
        __syncthreads();
        {
            unsigned* cnt2 = (unsigned*)(ws + WS_CTL) + CTL_CNT + 32;
            LAS unsigned* lu = (LAS unsigned*)(lds + 131072);
            for (;;) {
                if (tid == 0) *lu = atomicAdd(cnt2, 1u);
                __syncthreads();
                const unsigned unit = *lu;
                __syncthreads();
                if (unit >= (unsigned)(MS * 4) || G >= 128) break;
                ret_sample_unit(a, lds, (int)(unit >> 2), (int)(unit & 3), tid);
            }
        }
        {
            unsigned* cnt = (unsigned*)(ws + WS_CTL) + CTL_CNT;
            LAS unsigned* lu = (LAS unsigned*)(lds + 131072);
            for (;;) {
                if (tid == 0) *lu = atomicAdd(cnt, 1u);
                __syncthreads();
                const unsigned unit = *lu;
                __syncthreads();
                if (unit >= 256u) break;
                ret_unit(a, lds, (int)unit, tid);
            }
        }
    }
    GRID_SYNC();
#endif
#if !defined(ONLY_PH) || ONLY_PH == 4
    for (int m = gw; m < MR; m += NGW) phase25_row(a, m, lane);
    GRID_SYNC();
#endif
#if !defined(ONLY_PH) || ONLY_PH == 5
    {
        mini_phase<0>(a, lds, bx, G, wave, lane);
        pg8::StaticOrder S; S.init(MP, D, G, bx);
        { pg8::Gemm g{(const bf16_t*)(ws + WS_OA), (const bf16_t*)(ws + WS_WDA), MP, D, 2048}; EpiT1 E{(const bf16_t*)(ws + WS_P), (bf16_t*)(ws + WS_T1)}; pg8::gemm_phase<EpiT1>(lds, g, S, E); }
        { pg8::Gemm g{(const bf16_t*)(ws + WS_H), (const bf16_t*)(ws + WS_WDB), MP, D, D}; EpiMG E{(const bf16_t*)(ws + WS_P), (const bf16_t*)(ws + WS_T1), (bf16_t*)(ws + WS_MG)}; pg8::gemm_phase<EpiMG>(lds, g, S, E); }
    }
    GRID_SYNC();
#endif
#if !defined(ONLY_PH) || ONLY_PH == 6
    {
        mini_phase<1>(a, lds, bx, G, wave, lane);
        pg8::StaticOrder S; S.init(MP, D, G, bx);
        pg8::Gemm g{(const bf16_t*)(ws + WS_MG), (const bf16_t*)(ws + WS_WOUT), MP, D, D};
        EpiX1 E{a.in[I_XP], a.in[I_XS], (float*)(ws + WS_X1), (bf16_t*)(ws + WS_X1B), (float*)(ws + WS_SQ1P)};
        pg8::gemm_phase<EpiX1>(lds, g, S, E);
    }
    GRID_SYNC();
#endif
#if !defined(ONLY_PH) || ONLY_PH == 7
    {
        mini_phase<2>(a, lds, bx, G, wave, lane);
        pg8::StaticOrder S; S.init(MP, D, G, bx);
        { pg8::Gemm g{(const bf16_t*)(ws + WS_X1B), (const bf16_t*)(ws + WS_WGATE), MP, D, D}; EpiGT E{(const float*)(ws + WS_SQ1P), (bf16_t*)(ws + WS_GT)}; pg8::gemm_phase<EpiGT>(lds, g, S, E); }
        { pg8::Gemm g{(const bf16_t*)(ws + WS_PB), (const bf16_t*)(ws + WS_WPLE), MP, D, PLE}; EpiX2 E{(const bf16_t*)(ws + WS_X1B), (const bf16_t*)(ws + WS_GT), a.out + OUT_Y, (float*)(ws + WS_SQ2P)}; pg8::gemm_phase<EpiX2>(lds, g, S, E); }
    }
    GRID_SYNC();
#endif
#if !defined(ONLY_PH) || ONLY_PH == 8
    {
        const float* sq2 = (const float*)(ws + WS_SQ2P); const float* fg = a.in[I_FNG];
        for (int m0 = gw; m0 < MR; m0 += 2 * NGW) {
            const int m1 = m0 + NGW; const bool two = m1 < MR;
            float tot[2]; f32x4 xv[2][4];
#pragma unroll
            for (int e = 0; e < 2; ++e) {
                const int m = e ? m1 : m0;
                if (e == 0 || two) {
                    if (m < MP) { const f32x4* sp = (const f32x4*)(sq2 + (size_t)m * 16); const f32x4 q0 = sp[0], q1 = sp[1], q2 = sp[2], q3 = sp[3];
                        tot[e] = (((q0.x + q0.y) + (q0.z + q0.w)) + ((q1.x + q1.y) + (q1.z + q1.w)) + ((q2.x + q2.y) + (q2.z + q2.w)) + ((q3.x + q3.y) + (q3.z + q3.w))); }
                    else tot[e] = wave_sum(((const float*)(ws + WS_SQS2))[(size_t)(m - MP) * 64 + lane]);
                    const f32x4* o = (const f32x4*)(a.out + OUT_Y + (size_t)m * D);
#pragma unroll
                    for (int j = 0; j < 4; ++j) xv[e][j] = o[lane + 64 * j];
                }
            }
#pragma unroll
            for (int e = 0; e < 2; ++e) {
                const int m = e ? m1 : m0;
                if (e == 0 || two) {
                    const float rs = 1.0f / sqrtf(tot[e] * (1.f / D) + EPS);
                    f32x4* o = (f32x4*)(a.out + OUT_Y + (size_t)m * D);
#pragma unroll
                    for (int j = 0; j < 4; ++j) o[lane + 64 * j] = xv[e][j] * rs * ((const f32x4*)fg)[lane + 64 * j];
                }
            }
        }
    }
#endif

}

extern "C" void kernel_launch(void* const* d_in, const int* in_sizes, int n_in, void* d_out, int out_size, void* d_ws, size_t ws_size, hipStream_t stream) {
    static int grid = 0;
    if (grid == 0) {
        if (n_in != 26 || ws_size < WS_END) { fprintf(stderr, "kernel_launch: unexpected n_in %d or ws_size %zu (need %zu)\n", n_in, ws_size, (size_t)WS_END); grid = -1; return; }
        int dev = 0, cus = 0, per_cu = 0;
        hipGetDevice(&dev); hipDeviceGetAttribute(&cus, hipDeviceAttributeMultiprocessorCount, dev);
        if (hipFuncSetAttribute((const void*)fwd_mega, hipFuncAttributeMaxDynamicSharedMemorySize, LDS_BYTES) != hipSuccess) { fprintf(stderr, "kernel_launch: hipFuncSetAttribute failed\n"); grid = -1; return; }
        hipOccupancyMaxActiveBlocksPerMultiprocessor(&per_cu, (const void*)fwd_mega, 512, LDS_BYTES);
        if (per_cu < 1) { fprintf(stderr, "kernel_launch: occupancy query says %d blocks per CU\n", per_cu); per_cu = 1; }
        (void)hipGetLastError();
        grid = cus * 1;
        fprintf(stderr, "kernel_launch: grid %d (cus %d, per_cu %d), ws %zu\n", grid, cus, per_cu, ws_size);
    }
    if (grid < 0) return;
    Args a{};
    for (int i = 0; i < 26; ++i) a.in[i] = (const float*)d_in[i];
    a.out = (float*)d_out; a.ws = (unsigned char*)d_ws;
    if (hipMemsetAsync((char*)d_ws + WS_BAR, 0, XCD_BAR_WORDS * 4, stream) != hipSuccess) { fprintf(stderr, "kernel_launch: memset failed\n"); return; }
    void* args[] = {&a};
    hipError_t e = hipLaunchCooperativeKernel((const void*)fwd_mega, dim3(grid), dim3(512), args, LDS_BYTES, stream);
    if (e != hipSuccess) fprintf(stderr, "kernel_launch: cooperative launch failed: %s\n", hipGetErrorString(e));
}
```

```cpp
#include <hip/hip_runtime.h>
#include <hip/hip_cooperative_groups.h>
#include <cstdio>
#include <cstdint>
namespace cg = cooperative_groups;

#define LAS __attribute__((address_space(3)))
typedef unsigned short bf16_t;
typedef short bf16x8 __attribute__((ext_vector_type(8)));
typedef short bf16x4 __attribute__((ext_vector_type(4)));
typedef float f32x4 __attribute__((ext_vector_type(4)));
typedef float f32x2 __attribute__((ext_vector_type(2)));
typedef unsigned u32x4 __attribute__((ext_vector_type(4)));
typedef unsigned u32x2 __attribute__((ext_vector_type(2)));
typedef __bf16 nbf2 __attribute__((ext_vector_type(2)));

constexpr int D = 1024, NB = 8, T = 2048, MP = NB * T  , MS = 128, MR = MP + MS  , MALL = 16640  ;
constexpr int NCOLS = 12416, NP = 12544  ;
constexpr int O_K = 1024, O_V = 2048, O_GA = 4096, O_SH = 6144, O_GB = 9344, O_MA = 10368, O_MB = 11392;
constexpr int RH = 4, RDK = 256, RDV = 512, RCH = 128;
constexpr int WH = 16, WN = 64;
constexpr int PLE = 256;
constexpr float EPS = 1e-6f;
constexpr int REC = 12544;
constexpr int R_AT = 0, R_RT = 2048, R_BP = 4096, R_KP = 6144, R_VT = 8192, R_AAK = 10240, R_TT = 10752, R_ARB = 11264, R_ARK = 11776, R_WC = 12288;

constexpr size_t MiB = 1u << 20;
constexpr size_t WS_CTL = 0;
constexpr size_t WS_ROPE = 1 * MiB;
constexpr size_t WS_W2T = 4 * MiB, WS_A2T = WS_W2T + 131072;
constexpr size_t WS_WPLE = 5 * MiB, WS_WDB = 6 * MiB, WS_WOUT = 8 * MiB, WS_WGATE = 10 * MiB, WS_WDA = 12 * MiB, WS_WIN = 16 * MiB;
constexpr size_t WS_PB = 41 * MiB, WS_H = 50 * MiB  , WS_KT = 83 * MiB, WS_SQA = 115 * MiB, WS_BC = 117 * MiB, WS_OPSS = 119 * MiB  ;
constexpr size_t WS_OA = 122 * MiB, WS_P = 188 * MiB, WS_CH = 587 * MiB  , WS_OB = 786 * MiB  ;
constexpr size_t WS_T1 = WS_CH, WS_MG = WS_CH + 65 * MiB, WS_X1B = WS_CH + 98 * MiB, WS_GT = WS_CH + 131 * MiB, WS_X1 = WS_OB + 65 * MiB  ;
constexpr size_t WS_END = 916 * MiB;
constexpr size_t WS_BAR = 512 * 1024;
constexpr size_t WS_SQS1 = 640 * 1024, WS_SQS2 = 704 * 1024;
constexpr size_t WS_SQ1P = WS_KT, WS_SQ2P = WS_KT + 2 * MiB;

constexpr size_t OUT_Y = 0, OUT_RETP = 16908288, OUT_RWP = 21102592, OUT_SHP = 21626880, OUT_RETS = 21635072, OUT_RWS = 88743936, OUT_SHS = 97132544;

__device__ __forceinline__ unsigned pk2(float lo, float hi) { f32x2 v = {lo, hi}; nbf2 r = __builtin_convertvector(v, nbf2); return __builtin_bit_cast(unsigned, r); }
__device__ __forceinline__ unsigned short f2bf(float f) { return (unsigned short)(pk2(f, 0.f) & 0xffffu); }
__device__ __forceinline__ float bf2f(unsigned short b) { return __uint_as_float(((unsigned)b) << 16); }
__device__ __forceinline__ float bflo(unsigned w) { return __uint_as_float(w << 16); }
__device__ __forceinline__ float bfhi(unsigned w) { return __uint_as_float(w & 0xffff0000u); }
__device__ __forceinline__ float sigm(float x) { return __builtin_amdgcn_rcpf(1.f + __expf(-x)); }
__device__ __forceinline__ float silu_(float x) { return x * sigm(x); }
__device__ __forceinline__ float wave_sum(float v) {
#pragma unroll
    for (int o = 1; o < 64; o <<= 1) v += __shfl_xor(v, o);
    return v;
}
#define MFMA32(a, b, c) __builtin_amdgcn_mfma_f32_16x16x32_bf16((a), (b), (c), 0, 0, 0)
#define LDS_WAIT() asm volatile("s_waitcnt lgkmcnt(0)" ::: "memory")

namespace pg8 {
constexpr int BM = 256, BK = 64, HALF = 128, HTB = HALF * BK * 2, STAGE_BYTES = 8 * HTB, NXCD = 8, WGM = 8;
__host__ __device__ __forceinline__ int lds_byte(int r, int c) { const int st = (r >> 4) * 2 + (c >> 5), rr = r & 15, cc = c & 31, ob = rr * 64 + cc * 2; return st * 1024 + (ob ^ (((ob >> 9) & 1) << 5)); }
__host__ __device__ __forceinline__ void stage_rc(int b, int& R, int& C) { const int st = b / 1024, sb = b % 1024, swz = sb ^ (((sb >> 9) & 1) << 5); R = (st >> 1) * 16 + swz / 64; C = (st & 1) * 32 + (swz % 64) / 2; }
__host__ __device__ __forceinline__ int perm32(int rho) { const int n = rho >> 4, i = rho & 15; return 8 * (i >> 2) + 4 * n + (i & 3); }
struct Unit { int pm, pn; };
struct Gemm { const bf16_t* A; const bf16_t* Bt; int M, N, K; };
struct StaticOrder {
    int nM, nN, nwg, G, c;
    __host__ __device__ void init(int M, int N, int G_, int c_) { nM = M / BM; nN = N / BM; nwg = nM * nN; G = G_; c = c_; }
    __host__ __device__ bool next(int i, Unit& u) const {
        const long L = (long)i * G + c; if (L >= nwg) return false;
        int wgid = (int)L; { const int q = nwg / NXCD, r = nwg % NXCD, xcd = wgid % NXCD, off = wgid / NXCD; wgid = (xcd < r ? xcd * (q + 1) : r * (q + 1) + (xcd - r) * q) + off; }
        const int nig = WGM * nN, gid = wgid / nig, fm = gid * WGM, gsz = (nM - fm) < WGM ? (nM - fm) : WGM;
        u.pm = fm + ((wgid % nig) % gsz); u.pn = (wgid % nig) / gsz; return true;
    }
};
template <class Epi>
__device__ __forceinline__ void gemm_phase(LAS unsigned char* lds, const Gemm g, const StaticOrder& S, const Epi& E) {
    int tid = threadIdx.x; asm volatile("" : "+v"(tid));
    const int wid = __builtin_amdgcn_readfirstlane(tid >> 6), lane = tid & 63, wr = wid >> 2, wc = wid & 3, fr = lane & 15, fq = lane >> 4;
    const int K = g.K, nt = K / BK;
    unsigned voffA[2], voffB[2];
#pragma unroll
    for (int i = 0; i < 2; ++i) { int R, C; stage_rc(tid * 16 + i * 8192, R, C); const int Rb = Epi::PERM ? ((R & ~31) + perm32(R & 31)) : R;
        voffA[i] = (unsigned)(R * K + C) * 2u; voffB[i] = (unsigned)(Rb * K + C) * 2u; }
    const size_t kstep = (size_t)(BK * 2);
    const size_t hstep = (size_t)HALF * K * 2;
    const size_t tstep = 2 * hstep;
    const unsigned ldsw = (unsigned)wid * 1024u;
    const int aoff = lds_byte(wr * 64 + fr, fq * 8), boff = lds_byte(wc * 32 + fr, fq * 8);
#define PG8_SA(b, h) (((b) * 2 + (h)) * HTB)
#define PG8_SB(b, h) ((4 + (b) * 2 + (h)) * HTB)
#define PG8_STAGE(bufoff, gbase, voff) do { _Pragma("unroll") for (int _i = 0; _i < 2; ++_i) \
        __builtin_amdgcn_global_load_lds((const unsigned*)((const char*)(gbase) + (voff)[_i]), (LAS unsigned*)(lds + (bufoff) + ldsw + _i * 8192), 16, 0, 0); } while (0)
#define PG8_LDA(dst, b, h) do { _Pragma("unroll") for (int m = 0; m < 4; ++m) _Pragma("unroll") for (int k = 0; k < 2; ++k) dst[m][k] = *(const LAS bf16x8*)(lds + PG8_SA(b, h) + aoff + m * 2048 + k * 1024); } while (0)
#define PG8_LDB(dst, b, h) do { _Pragma("unroll") for (int n = 0; n < 2; ++n) _Pragma("unroll") for (int k = 0; k < 2; ++k) dst[n][k] = *(const LAS bf16x8*)(lds + PG8_SB(b, h) + boff + n * 2048 + k * 1024); } while (0)
#define PG8_MMA(ai, bj, At, Bt) do { __builtin_amdgcn_s_setprio(1); _Pragma("unroll") for (int m = 0; m < 4; ++m) _Pragma("unroll") for (int n = 0; n < 2; ++n) _Pragma("unroll") for (int k = 0; k < 2; ++k) \
        acc[ai][bj][m][n] = __builtin_amdgcn_mfma_f32_16x16x32_bf16(Bt[n][k], At[m][k], acc[ai][bj][m][n], 0, 0, 0); __builtin_amdgcn_s_setprio(0); } while (0)
#define PG8_WAIT_V(n) asm volatile("s_waitcnt vmcnt(" #n ")" ::: "memory")
#define PG8_WAIT_L(n) asm volatile("s_waitcnt lgkmcnt(" #n ")" ::: "memory")
#define PG8_BAR __builtin_amdgcn_s_barrier()
#define PG8_SCHED __builtin_amdgcn_sched_barrier(0)
    Unit cur, nxt; int ui = 0;
    if (!S.next(0, cur)) return;
    f32x4 acc[2][2][4][2];
#pragma unroll
    for (int a = 0; a < 2; ++a)
#pragma unroll
        for (int b = 0; b < 2; ++b)
#pragma unroll
            for (int m = 0; m < 4; ++m)
#pragma unroll
                for (int n = 0; n < 2; ++n) acc[a][b][m][n] = (f32x4){0.f, 0.f, 0.f, 0.f};
    bf16x8 At[4][2], B0[2][2], B1[2][2];
    const char* cA = (const char*)g.A + (size_t)cur.pm * tstep; const char* cB = (const char*)g.Bt + (size_t)cur.pn * tstep;
    PG8_STAGE(PG8_SB(0, 0), cB, voffB); PG8_STAGE(PG8_SA(0, 0), cA, voffA); PG8_STAGE(PG8_SB(0, 1), cB + hstep, voffB); PG8_STAGE(PG8_SA(0, 1), cA + hstep, voffA);
    if (wr == 1) PG8_BAR;
    PG8_WAIT_V(4); PG8_BAR;
    PG8_STAGE(PG8_SB(1, 0), cB + kstep, voffB); PG8_STAGE(PG8_SA(1, 0), cA + kstep, voffA); PG8_STAGE(PG8_SB(1, 1), cB + hstep + kstep, voffB);
    PG8_WAIT_V(6); PG8_BAR;
    for (;;) {
        const bool has_next = S.next(ui + 1, nxt);
        const char* nA = has_next ? (const char*)g.A + (size_t)nxt.pm * tstep : cA; const char* nB = has_next ? (const char*)g.Bt + (size_t)nxt.pn * tstep : cB;
#pragma unroll 1
        for (int t = 0; t < nt; t += 2) {
            const bool last = (t == nt - 2);
            const char* a1 = cA + (size_t)(t + 1) * kstep;
            const char* a2 = last ? nA : cA + (size_t)(t + 2) * kstep; const char* b2 = last ? nB : cB + (size_t)(t + 2) * kstep;
            const char* a3 = a2 + kstep; const char* b3 = b2 + kstep;
            PG8_LDB(B0, 0, 0); PG8_SCHED; PG8_LDA(At, 0, 0); PG8_STAGE(PG8_SA(1, 1), a1 + hstep, voffA);
            PG8_WAIT_L(8); PG8_BAR; PG8_WAIT_L(0); PG8_MMA(0, 0, At, B0); PG8_BAR; PG8_SCHED;
            PG8_LDB(B1, 0, 1); PG8_STAGE(PG8_SB(0, 0), b2, voffB);
            PG8_BAR; PG8_WAIT_L(0); PG8_MMA(0, 1, At, B1); PG8_BAR;
            PG8_LDA(At, 0, 1); PG8_STAGE(PG8_SA(0, 0), a2, voffA);
            PG8_BAR; PG8_WAIT_L(0); PG8_MMA(1, 0, At, B0); PG8_BAR; PG8_SCHED;
            PG8_STAGE(PG8_SB(0, 1), b2 + hstep, voffB);
            PG8_WAIT_V(6); PG8_BAR; PG8_MMA(1, 1, At, B1); PG8_BAR;
            PG8_LDB(B0, 1, 0); PG8_SCHED; PG8_LDA(At, 1, 0); PG8_STAGE(PG8_SA(0, 1), a2 + hstep, voffA);
            PG8_WAIT_L(8); PG8_BAR; PG8_WAIT_L(0); PG8_MMA(0, 0, At, B0); PG8_BAR; PG8_SCHED;
            PG8_LDB(B1, 1, 1); PG8_STAGE(PG8_SB(1, 0), b3, voffB);
            PG8_BAR; PG8_WAIT_L(0); PG8_MMA(0, 1, At, B1); PG8_BAR;
            PG8_LDA(At, 1, 1); PG8_STAGE(PG8_SA(1, 0), a3, voffA);
            PG8_BAR; PG8_WAIT_L(0); PG8_MMA(1, 0, At, B0); PG8_BAR; PG8_SCHED;
            PG8_STAGE(PG8_SB(1, 1), b3 + hstep, voffB);
            PG8_WAIT_V(6); PG8_BAR; PG8_MMA(1, 1, At, B1); PG8_BAR;
        }
        E(acc, cur, wr, wc, fr, fq);
        if (!has_next) break;
#pragma unroll
        for (int a = 0; a < 2; ++a)
#pragma unroll
            for (int b = 0; b < 2; ++b)
#pragma unroll
                for (int m = 0; m < 4; ++m)
#pragma unroll
                    for (int n = 0; n < 2; ++n) acc[a][b][m][n] = (f32x4){0.f, 0.f, 0.f, 0.f};
        cur = nxt; cA = nA; cB = nB; ++ui;
    }
    PG8_WAIT_V(0);
    if (wr == 0) PG8_BAR;
    PG8_BAR;
#undef PG8_SA
#undef PG8_SB
#undef PG8_STAGE
#undef PG8_LDA
#undef PG8_LDB
#undef PG8_MMA
#undef PG8_WAIT_V
#undef PG8_WAIT_L
#undef PG8_BAR
#undef PG8_SCHED
}
}
using pg8::Unit;

struct Args {
    const float* in[26];
    float* out; unsigned char* ws;
};
#define KAS __attribute__((address_space(4)))
__device__ __forceinline__ const KAS char* kargp() { const KAS char* p = (const KAS char*)__builtin_amdgcn_kernarg_segment_ptr(); asm volatile("" : "+s"(p)); return p; }


enum { I_XP = 0, I_XS, I_SRET, I_SRW, I_SSH, I_PP, I_PS, I_NG, I_WIN, I_MU, I_W0, I_W2, I_A0, I_A2, I_KK, I_KA, I_RK, I_LNW, I_LNB, I_WDA, I_WDB, I_WOUT, I_WPLE, I_PNG, I_WPG, I_FNG };

__device__ __forceinline__ void p0_transpose_item(const float* W, int K, int N, bf16_t* WT, LAS float* scr, int item, int lane, const float* kscale) {
    const int nblk = N / 32, kb = item / nblk, nb = item % nblk, k0 = 64 * kb, n0 = 32 * nb;
#pragma unroll 8
    for (int i = 0; i < 32; ++i) { const int kk = 2 * i + (lane >> 5); float v = W[(size_t)(k0 + kk) * N + n0 + (lane & 31)]; if (kscale) v *= kscale[k0 + kk]; scr[kk * 33 + (lane & 31)] = v; }
    LDS_WAIT();
    const int c = lane & 7;
#pragma unroll
    for (int j = 0; j < 4; ++j) { const int n = (lane >> 3) + 8 * j; const LAS float* s = scr + (8 * c) * 33 + n;
        u32x4 o; o.x = pk2(s[0 * 33], s[1 * 33]); o.y = pk2(s[2 * 33], s[3 * 33]); o.z = pk2(s[4 * 33], s[5 * 33]); o.w = pk2(s[6 * 33], s[7 * 33]);
        *(u32x4*)(WT + (size_t)(n0 + n) * K + k0 + 8 * c) = o; }
    LDS_WAIT();
}

__device__ __forceinline__ void phase0(const Args& a, LAS unsigned char* lds, int gw, int NGW, int wave, int lane) {
    unsigned char* ws = a.ws;
    LAS float* scr = (LAS float*)(lds + wave * 16384);
    constexpr int I_IN = (D / 64) * (NCOLS / 32), I_DA = (2048 / 64) * (D / 32), I_SQ = (D / 64) * (D / 32), I_PL = (PLE / 64) * (D / 32), I_LR = 1 * (D / 32);
    constexpr int NITEMS = I_IN + I_DA + 3 * I_SQ + I_PL + 2 * I_LR;
    for (int it = gw; it < NITEMS; it += NGW) {
        int r = it;
        if (r < I_IN) { p0_transpose_item(a.in[I_WIN], D, NCOLS, (bf16_t*)(ws + WS_WIN), scr, r, lane, nullptr); continue; } r -= I_IN;
        if (r < I_DA) { p0_transpose_item(a.in[I_WDA], 2048, D, (bf16_t*)(ws + WS_WDA), scr, r, lane, nullptr); continue; } r -= I_DA;
        if (r < I_SQ) { p0_transpose_item(a.in[I_WDB], D, D, (bf16_t*)(ws + WS_WDB), scr, r, lane, nullptr); continue; } r -= I_SQ;
        if (r < I_SQ) { p0_transpose_item(a.in[I_WOUT], D, D, (bf16_t*)(ws + WS_WOUT), scr, r, lane, nullptr); continue; } r -= I_SQ;
        if (r < I_SQ) { p0_transpose_item(a.in[I_WPG], D, D, (bf16_t*)(ws + WS_WGATE), scr, r, lane, a.in[I_PNG]); continue; } r -= I_SQ;
        if (r < I_PL) { p0_transpose_item(a.in[I_WPLE], PLE, D, (bf16_t*)(ws + WS_WPLE), scr, r, lane, nullptr); continue; } r -= I_PL;
        if (r < I_LR) { p0_transpose_item(a.in[I_W2], 64, D, (bf16_t*)(ws + WS_W2T), scr, r, lane, nullptr); continue; } r -= I_LR;
        p0_transpose_item(a.in[I_A2], 64, D, (bf16_t*)(ws + WS_A2T), scr, r, lane, nullptr);
    }
    for (int i = gw * 64 + lane; i < 128 * D / 8; i += NGW * 64) ((u32x4*)(ws + WS_WIN + (size_t)NCOLS * D * 2))[i] = (u32x4){0u, 0u, 0u, 0u};
    bf16_t* H = (bf16_t*)(ws + WS_H);
    const float* ng = a.in[I_NG];
    for (int m = gw; m < MALL; m += NGW) {
        if (m < MR) {
            const float* xr = (m < MP) ? a.in[I_XP] + (size_t)m * D : a.in[I_XS] + (size_t)(m - MP) * D;
            f32x4 v[4]; float s = 0.f;
#pragma unroll
            for (int j = 0; j < 4; ++j) { v[j] = ((const f32x4*)xr)[lane + 64 * j]; s += (v[j].x * v[j].x + v[j].y * v[j].y) + (v[j].z * v[j].z + v[j].w * v[j].w); }
            const float rs = 1.0f / sqrtf(wave_sum(s) * (1.f / D) + EPS);
            float* so = nullptr;
            if (m < MP) { if ((m & (T - 1)) == T - 1) so = a.out + OUT_SHP + (size_t)(m >> 11) * D; } else so = a.out + OUT_SHS + (size_t)(m - MP) * D;
#pragma unroll
            for (int j = 0; j < 4; ++j) { const f32x4 gg = ((const f32x4*)ng)[lane + 64 * j]; f32x4 h = v[j] * rs * gg;
                if (so) ((f32x4*)so)[lane + 64 * j] = h;
                u32x2 o; o.x = pk2(h.x, h.y); o.y = pk2(h.z, h.w); ((u32x2*)(H + (size_t)m * D))[lane + 64 * j] = o; }
        } else {
            const float* xr = a.in[I_SSH] + (size_t)(m - MR) * D;
#pragma unroll
            for (int j = 0; j < 4; ++j) { const f32x4 h = ((const f32x4*)xr)[lane + 64 * j]; u32x2 o; o.x = pk2(h.x, h.y); o.y = pk2(h.z, h.w); ((u32x2*)(H + (size_t)m * D))[lane + 64 * j] = o; }
        }
        u32x2 o = {0u, 0u};
        if (m < MR) { const float* pr = (m < MP) ? a.in[I_PP] + (size_t)m * PLE : a.in[I_PS] + (size_t)(m - MP) * PLE; const f32x4 p = ((const f32x4*)pr)[lane]; o.x = pk2(p.x, p.y); o.y = pk2(p.z, p.w); }
        ((u32x2*)(ws + WS_PB + (size_t)m * PLE * 2))[lane] = o;
    }
    for (int i = gw * 64 + lane; i < 2049 * 128; i += NGW * 64) {
        const int pos = i >> 7, j = i & 127; const double p = (pos == 2048) ? 16384.0 : (double)pos;
        double inv = 1.0, base = 0.9305720409296989; int e = j;
        while (e) { if (e & 1) inv *= base; base *= base; e >>= 1; }
        double rev = p * inv * 0.15915494309189535; rev -= floor(rev);
        const float fr = (float)rev;
        ((f32x2*)(ws + WS_ROPE))[i] = (f32x2){__builtin_amdgcn_cosf(fr), __builtin_amdgcn_sinf(fr)};
    }
    for (int i = gw * 64 + lane; i < 65536 + 64; i += NGW * 64) ((float*)(ws + WS_CTL))[i] = 0.f;
}

struct EpiP {
    static constexpr bool PERM = true;
    bf16_t* P; bf16_t* KT; const f32x2* rope;
    __device__ __forceinline__ void operator()(const f32x4 (&acc)[2][2][4][2], const Unit& u, int wr, int wc, int fr, int fq) const {
        const int pn = u.pn, pm = u.pm;
        const int row0 = pm * 256 + wr * 64 + fr, cl0 = wc * 32 + 8 * fq;
        const bool sample = (pm == 64);
        if (pn < 8) {
            const int h = pn & 3; const bool isk = pn >= 4;
            const float l2g = __log2f(1.f - exp2f(-5.f - (float)h));
#pragma unroll
            for (int ai = 0; ai < 2; ++ai)
#pragma unroll
                for (int m = 0; m < 4; ++m) {
                    const int row = row0 + ai * 128 + m * 16;
                    int pos, ex;
                    if (sample) { pos = 2048; ex = isk ? 0 : 1; } else { pos = row & (T - 1); const int idx = pos & 127; ex = isk ? 127 - idx : idx + 1; }
                    const float sc = exp2f((float)ex * l2g) * (isk ? 0.0625f : 1.0f);
                    const f32x4* rp = (const f32x4*)(rope + pos * 128 + cl0);
                    f32x4 cs[4]; cs[0] = rp[0]; cs[1] = rp[1]; cs[2] = rp[2]; cs[3] = rp[3];
                    float y1[8], y2[8];
#pragma unroll
                    for (int n = 0; n < 2; ++n)
#pragma unroll
                        for (int e = 0; e < 4; ++e) {
                            const float c = (e & 1) ? cs[n * 2 + (e >> 1)].z : cs[n * 2 + (e >> 1)].x, s = (e & 1) ? cs[n * 2 + (e >> 1)].w : cs[n * 2 + (e >> 1)].y;
                            const float x1 = acc[ai][0][m][n][e], x2 = acc[ai][1][m][n][e];
                            y1[n * 4 + e] = (x1 * c - x2 * s) * sc; y2[n * 4 + e] = (x2 * c + x1 * s) * sc;
                        }
                    u32x4 w1, w2;
                    w1.x = pk2(y1[0], y1[1]); w1.y = pk2(y1[2], y1[3]); w1.z = pk2(y1[4], y1[5]); w1.w = pk2(y1[6], y1[7]);
                    w2.x = pk2(y2[0], y2[1]); w2.y = pk2(y2[2], y2[3]); w2.z = pk2(y2[4], y2[5]); w2.w = pk2(y2[6], y2[7]);
                    bf16_t* rowp = P + (size_t)row * NP + pn * 256 + cl0;
                    *(u32x4*)rowp = w1; *(u32x4*)(rowp + 128) = w2;
                    if (isk && !sample) {
                        bf16_t* kt = KT + ((size_t)((row >> 11) * 4 + h) * 256 + cl0) * T + pos;
#pragma unroll
                        for (int j = 0; j < 8; ++j) { kt[(size_t)j * T] = f2bf(y1[j]); kt[(size_t)(j + 128) * T] = f2bf(y2[j]); }
                    }
                }
            return;
        }
#pragma unroll
        for (int bj = 0; bj < 2; ++bj) {
            const int cb = pn * 2 + bj;
            if (cb >= 97) continue;
            const int mode = 0;
            const bool vt = (cb < 32) && !sample;
#pragma unroll
            for (int ai = 0; ai < 2; ++ai)
#pragma unroll
                for (int m = 0; m < 4; ++m) {
                    const int row = row0 + ai * 128 + m * 16;
                    float y[8];
#pragma unroll
                    for (int n = 0; n < 2; ++n)
#pragma unroll
                        for (int e = 0; e < 4; ++e) { float x = acc[ai][bj][m][n][e]; if (mode == 1) x = x * sigm(x); else if (mode == 2) x = sigm(x); y[n * 4 + e] = x; }
                    if (vt) {
                        const int hd = cb * 128 + cl0 - O_V;
                        bf16_t* vp = P + ((size_t)(row >> 11) * T + hd) * NP + O_V + (row & (T - 1));
#pragma unroll
                        for (int j = 0; j < 8; ++j) vp[(size_t)j * NP] = f2bf(y[j]);
                    } else {
                        u32x4 w; w.x = pk2(y[0], y[1]); w.y = pk2(y[2], y[3]); w.z = pk2(y[4], y[5]); w.w = pk2(y[6], y[7]);
                        *(u32x4*)(P + (size_t)row * NP + cb * 128 + cl0) = w;
                    }
                }
        }
    }
};

__device__ __forceinline__ float lerp_bf(const bf16_t* cur, const bf16_t* prv, float mu) { const float c = bf2f(*cur); const float p = bf2f(*prv); return c + (p - c) * mu; }

__device__ __forceinline__ void rw_prep_item(const Args& a, LAS unsigned char* wl  , int tt, int h, int lane) {
    unsigned char* ws = a.ws;
    const bf16_t* P = (const bf16_t*)(ws + WS_P);
    const int l15 = lane & 15, quad = lane >> 4;
    const bool sample = tt >= 1024;
    const int row_base = sample ? MP + (tt - 1024) * 16 : tt * 16;
    const float* mu = a.in[I_MU];
    bf16x8 Aw[2], Aa[2];
    {
        const int m = row_base + l15;
        const bf16_t* cur = P + (size_t)m * NP + O_SH;
        const bf16_t* zrow = (const bf16_t*)(ws + WS_WIN + (size_t)NCOLS * D * 2);
        const bf16_t* prv = sample ? P + (size_t)(m + MS) * NP + O_SH : ((m & (T - 1)) ? cur - NP : zrow + O_SH);
#pragma unroll
        for (int which = 0; which < 2; ++which)
#pragma unroll
            for (int ks = 0; ks < 2; ++ks) {
                const int col = 3072 + which * 64 + ks * 32 + quad * 8;
                const u32x4 cw = *(const u32x4*)(cur + col); const u32x4 pw = *(const u32x4*)(prv + col);
                const f32x4 m0 = *(const f32x4*)(mu + col), m1 = *(const f32x4*)(mu + col + 4);
                float z[8];
                const unsigned cws[4] = {cw.x, cw.y, cw.z, cw.w}, pws[4] = {pw.x, pw.y, pw.z, pw.w};
#pragma unroll
                for (int j = 0; j < 4; ++j) {
                    const float c0 = bflo(cws[j]), c1 = bfhi(cws[j]), p0 = bflo(pws[j]), p1 = bfhi(pws[j]);
                    const float mm0 = (j < 2) ? m0[2 * j] : m1[2 * j - 4], mm1 = (j < 2) ? m0[2 * j + 1] : m1[2 * j - 3];
                    z[2 * j] = c0 + (p0 - c0) * mm0; z[2 * j + 1] = c1 + (p1 - c1) * mm1;
                }
                if (which == 0) {
#pragma unroll
                    for (int j = 0; j < 8; ++j) z[j] = 1.f - 2.f / (__expf(2.f * z[j]) + 1.f);
                }
                u32x4 o; o.x = pk2(z[0], z[1]); o.y = pk2(z[2], z[3]); o.z = pk2(z[4], z[5]); o.w = pk2(z[6], z[7]);
                if (which == 0) Aw[ks] = __builtin_bit_cast(bf16x8, o); else Aa[ks] = __builtin_bit_cast(bf16x8, o);
            }
    }
    const bf16_t* W2T = (const bf16_t*)(ws + WS_W2T); const bf16_t* A2T = (const bf16_t*)(ws + WS_A2T);
    unsigned char* rec = ws + WS_CH + ((size_t)((tt >> 7) * 16 + h) * 128 + (tt & 127)) * REC;
    LAS bf16_t* LA = (LAS bf16_t*)wl;
    LAS bf16_t* LR = LA + 16 * 72;
    LAS bf16_t* LB = LR + 16 * 72;
    LAS bf16_t* LK = LB + 16 * 72;
    LAS float* LN = (LAS float*)(wl + 9216);
    float tA[4][4], tBi[4][4], tBp[4][4];
    float ssq[4] = {0.f, 0.f, 0.f, 0.f}, bon[4] = {0.f, 0.f, 0.f, 0.f};
#pragma unroll
    for (int nt = 0; nt < 4; ++nt) {
        const int ch = h * 64 + nt * 16 + l15, cc = nt * 16 + l15;
        f32x4 cw = {0.f, 0.f, 0.f, 0.f}, ca = {0.f, 0.f, 0.f, 0.f};
#pragma unroll
        for (int ks = 0; ks < 2; ++ks) {
            const bf16x8 bw = *(const bf16x8*)(W2T + (size_t)ch * 64 + ks * 32 + quad * 8), ba = *(const bf16x8*)(A2T + (size_t)ch * 64 + ks * 32 + quad * 8);
            cw = MFMA32(Aw[ks], bw, cw); ca = MFMA32(Aa[ks], ba, ca);
        }
        const float w0 = a.in[I_W0][ch], a0 = a.in[I_A0][ch], k_k = a.in[I_KK][ch], k_a = a.in[I_KA][ch], r_k = a.in[I_RK][ch];
        const float mur = mu[ch], muk = mu[1024 + ch], muv = mu[2048 + ch];
        float lw[4], rr[4], kq[4], vv[4], aa4[4], kr4[4];
#pragma unroll
        for (int r = 0; r < 4; ++r) {
            const int m = row_base + quad * 4 + r;
            const bf16_t* cur = P + (size_t)m * NP + O_SH + ch;
            const bf16_t* prv = sample ? P + (size_t)(m + MS) * NP + O_SH + ch : ((m & (T - 1)) ? cur - NP : (const bf16_t*)(ws + WS_WIN + (size_t)NCOLS * D * 2) + O_SH + ch);
            const float r_ = lerp_bf(cur, prv, mur), k_ = lerp_bf(cur + 1024, prv + 1024, muk), v_ = lerp_bf(cur + 2048, prv + 2048, muv);
            lw[r] = -0.6065306597126334f * sigm(w0 + cw[r]);
            const float aa = sigm(a0 + ca[r]); aa4[r] = aa;
            const float kr = k_ * k_k; kr4[r] = kr; ssq[r] += kr * kr;
            const float kpp = k_ * (1.f + (aa - 1.f) * k_a); kq[r] = kpp;
            rr[r] = r_; vv[r] = v_; bon[r] += r_ * kpp * r_k;
        }
        if (sample) {
#pragma unroll
            for (int r = 0; r < 4; ++r) {
                const int i = (tt - 1024) * 16 + quad * 4 + r;
                float* o = (float*)(ws + WS_OPSS) + ((size_t)(i * 16 + h) * 6) * 64 + cc;
                o[0] = rr[r]; o[64] = __expf(lw[r]); o[128] = kq[r]; o[320] = vv[r];
                tA[nt][r] = kr4[r]; tBi[nt][r] = aa4[r] * kr4[r]; tBp[nt][r] = 0.f;
            }
        } else {
            float c[4]; c[0] = lw[0]; c[1] = c[0] + lw[1]; c[2] = c[1] + lw[2]; c[3] = c[2] + lw[3];
            const float tot = c[3];
            const float s1 = __shfl(tot, (lane - 16) & 63), s2 = __shfl(tot, (lane - 32) & 63), s3 = __shfl(tot, (lane - 48) & 63);
            const float off = (quad >= 1 ? s1 : 0.f) + (quad >= 2 ? s2 : 0.f) + (quad >= 3 ? s3 : 0.f);
            const float total = __shfl(c[3] + off, 48 + l15);
            float kqp[4];
#pragma unroll
            for (int r = 0; r < 4; ++r) {
                const float cum = c[r] + off, cumx = cum - lw[r];
                const float ea = __expf(cumx), er = __expf(cum), ei = __expf(-cum), ep = __expf(total - cum);
                const int tk = quad * 4 + r;
                LR[tk * 72 + cc] = f2bf(rr[r] * er); LK[tk * 72 + cc] = f2bf(kq[r] * ei);
                kqp[r] = kq[r] * ep;
                tA[nt][r] = kr4[r] * ea; tBi[nt][r] = aa4[r] * kr4[r] * ei; tBp[nt][r] = aa4[r] * kr4[r] * ep;
            }
            *(u32x2*)(rec + R_KP + cc * 32 + quad * 8) = (u32x2){pk2(kqp[0], kqp[1]), pk2(kqp[2], kqp[3])};
            *(u32x2*)(rec + R_VT + cc * 32 + quad * 8) = (u32x2){pk2(vv[0], vv[1]), pk2(vv[2], vv[3])};
            if (quad == 0) *(float*)(rec + R_WC + cc * 4) = __expf(total);
        }
        asm volatile("" ::: "memory");
    }
    float inv[4];
#pragma unroll
    for (int r = 0; r < 4; ++r) {
        float s = ssq[r], b = bon[r];
#pragma unroll
        for (int o = 1; o < 16; o <<= 1) { s += __shfl_xor(s, o); b += __shfl_xor(b, o); }
        inv[r] = 1.f / fmaxf(sqrtf(s), 1e-12f);
        if (l15 == 0) ((float*)(ws + WS_BC))[(size_t)(row_base + quad * 4 + r) * 16 + h] = b;
    }
    if (sample) {
#pragma unroll
        for (int nt = 0; nt < 4; ++nt)
#pragma unroll
            for (int r = 0; r < 4; ++r) {
                const int i = (tt - 1024) * 16 + quad * 4 + r;
                float* o = (float*)(ws + WS_OPSS) + ((size_t)(i * 16 + h) * 6) * 64 + nt * 16 + l15;
                o[192] = tA[nt][r] * inv[r]; o[256] = tBi[nt][r] * inv[r];
            }
        return;
    }
#pragma unroll
    for (int nt = 0; nt < 4; ++nt) {
        const int cc = nt * 16 + l15;
        float bp[4];
#pragma unroll
        for (int r = 0; r < 4; ++r) { const int tk = quad * 4 + r;
            LA[tk * 72 + cc] = f2bf(-tA[nt][r] * inv[r]); LB[tk * 72 + cc] = f2bf(tBi[nt][r] * inv[r]); bp[r] = tBp[nt][r] * inv[r]; }
        *(u32x2*)(rec + R_BP + cc * 32 + quad * 8) = (u32x2){pk2(bp[0], bp[1]), pk2(bp[2], bp[3])};
    }
    LDS_WAIT();
#pragma unroll
    for (int i = 0; i < 2; ++i) { const int idx = lane + 64 * i, rr = idx >> 3, c8 = (idx & 7) * 8;
        *(u32x4*)(rec + R_AT + rr * 128 + c8 * 2) = *(const LAS u32x4*)(LA + rr * 72 + c8);
        *(u32x4*)(rec + R_RT + rr * 128 + c8 * 2) = *(const LAS u32x4*)(LR + rr * 72 + c8); }
    f32x4 nab = {0.f, 0.f, 0.f, 0.f}, nak = nab, nrb = nab, nrk = nab;
#pragma unroll
    for (int ks = 0; ks < 2; ++ks) {
        const bf16x8 fa = *(const LAS bf16x8*)(LA + l15 * 72 + ks * 32 + quad * 8), fr_ = *(const LAS bf16x8*)(LR + l15 * 72 + ks * 32 + quad * 8);
        const bf16x8 fb = *(const LAS bf16x8*)(LB + l15 * 72 + ks * 32 + quad * 8), fk = *(const LAS bf16x8*)(LK + l15 * 72 + ks * 32 + quad * 8);
        nab = MFMA32(fa, fb, nab); nak = MFMA32(fa, fk, nak); nrb = MFMA32(fr_, fb, nrb); nrk = MFMA32(fr_, fk, nrk);
    }
#pragma unroll
    for (int r = 0; r < 4; ++r) {
        const int t = quad * 4 + r, j = l15;
        const float vab = (j < t) ? nab[r] : 0.f, vak = (j < t) ? nak[r] : 0.f, vrb = (j <= t) ? nrb[r] : 0.f, vrk = (j <= t) ? nrk[r] : 0.f;
        LN[t * 16 + j] = vab;
        *(bf16_t*)(rec + R_AAK + (t * 16 + j) * 2) = f2bf(vak);
        *(bf16_t*)(rec + R_ARB + (t * 16 + j) * 2) = f2bf(vrb);
        *(bf16_t*)(rec + R_ARK + (t * 16 + j) * 2) = f2bf(vrk);
    }
    LDS_WAIT();
    if (lane < 16) {
        float tc[16];
#pragma unroll
        for (int t = 0; t < 16; ++t) {
            float s = (t == lane) ? 1.f : 0.f;
#pragma unroll
            for (int j = 0; j < t; ++j) s += LN[t * 16 + j] * tc[j];
            tc[t] = s;
            *(bf16_t*)(rec + R_TT + (t * 16 + lane) * 2) = f2bf(s);
        }
    }
    LDS_WAIT();
}

__device__ __forceinline__ bf16x8 k16(u32x2 v) { const u32x4 w = {v.x, v.y, 0u, 0u}; return __builtin_bit_cast(bf16x8, w); }
#define SCAN_DECL(F) bf16x8 F##_at0, F##_at1, F##_rt0, F##_rt1; u32x2 F##_aak, F##_tt, F##_arb, F##_ark, F##_vt, F##_bp0, F##_bp1, F##_bp2, F##_bp3, F##_kp0, F##_kp1, F##_kp2, F##_kp3; float F##_wc0, F##_wc1, F##_wc2, F##_wc3
#define SCAN_LOAD(F, REC_) do { const unsigned char* rec_ = (REC_); \
    F##_at0 = *(const bf16x8*)(rec_ + R_AT + o_nat); F##_at1 = *(const bf16x8*)(rec_ + R_AT + o_nat + 64); \
    F##_rt0 = *(const bf16x8*)(rec_ + R_RT + o_nat); F##_rt1 = *(const bf16x8*)(rec_ + R_RT + o_nat + 64); \
    F##_aak = *(const u32x2*)(rec_ + R_AAK + o_sm); F##_tt = *(const u32x2*)(rec_ + R_TT + o_sm); F##_arb = *(const u32x2*)(rec_ + R_ARB + o_sm); F##_ark = *(const u32x2*)(rec_ + R_ARK + o_sm); \
    F##_vt = *(const u32x2*)(rec_ + R_VT + vt * 512 + o_sm); \
    F##_bp0 = *(const u32x2*)(rec_ + R_BP + o_sm); F##_bp1 = *(const u32x2*)(rec_ + R_BP + 512 + o_sm); F##_bp2 = *(const u32x2*)(rec_ + R_BP + 1024 + o_sm); F##_bp3 = *(const u32x2*)(rec_ + R_BP + 1536 + o_sm); \
    F##_kp0 = *(const u32x2*)(rec_ + R_KP + o_sm); F##_kp1 = *(const u32x2*)(rec_ + R_KP + 512 + o_sm); F##_kp2 = *(const u32x2*)(rec_ + R_KP + 1024 + o_sm); F##_kp3 = *(const u32x2*)(rec_ + R_KP + 1536 + o_sm); \
    F##_wc0 = *(const float*)(rec_ + R_WC + l15 * 4); F##_wc1 = *(const float*)(rec_ + R_WC + 64 + l15 * 4); F##_wc2 = *(const float*)(rec_ + R_WC + 128 + l15 * 4); F##_wc3 = *(const float*)(rec_ + R_WC + 192 + l15 * 4); } while (0)
#define SCAN_UPD(NT, BP, KP, WC) do { f32x4 sn = S##NT * (WC); sn = MFMA32(ua, k16(BP), sn); sn = MFMA32(vtf, k16(KP), sn); S##NT = sn; \
    _Pragma("unroll") for (int r = 0; r < 4; ++r) Sb[(quad * 4 + r) * 72 + NT * 16 + l15] = f2bf(sn[r]); } while (0)
#define SCAN_STEP(F, N, CH) do { const int ch_ = (CH); \
    SCAN_LOAD(N, rec0 + (size_t)(ch_ < 126 ? ch_ + 2 : 127) * REC); \
    const bf16x8 sa0 = *(const LAS bf16x8*)(Sb + l15 * 72 + quad * 8), sa1 = *(const LAS bf16x8*)(Sb + l15 * 72 + 32 + quad * 8); \
    const bf16x8 vtf = k16(F##_vt); const f32x4 z = {0.f, 0.f, 0.f, 0.f}; \
    f32x4 Y = MFMA32(sa0, F##_at0, z); Y = MFMA32(sa1, F##_at1, Y); Y = MFMA32(vtf, k16(F##_aak), Y); \
    _Pragma("unroll") for (int r = 0; r < 4; ++r) Yb[(quad * 4 + r) * 16 + l15] = f2bf(Y[r]); \
    LDS_WAIT(); \
    const bf16x8 ya = k16(*(const LAS u32x2*)(Yb + l15 * 16 + quad * 4)); \
    f32x4 U = MFMA32(ya, k16(F##_tt), z); \
    _Pragma("unroll") for (int r = 0; r < 4; ++r) Ub[(quad * 4 + r) * 16 + l15] = f2bf(U[r]); \
    LDS_WAIT(); \
    const bf16x8 ua = k16(*(const LAS u32x2*)(Ub + l15 * 16 + quad * 4)); \
    f32x4 O = MFMA32(sa0, F##_rt0, z); O = MFMA32(sa1, F##_rt1, O); O = MFMA32(ua, k16(F##_arb), O); O = MFMA32(vtf, k16(F##_ark), O); \
    *(u32x2*)(ob + (size_t)(ch_ * 16 + l15) * D) = (u32x2){pk2(O[0], O[1]), pk2(O[2], O[3])}; \
    SCAN_UPD(0, F##_bp0, F##_kp0, F##_wc0); SCAN_UPD(1, F##_bp1, F##_kp1, F##_wc1); SCAN_UPD(2, F##_bp2, F##_kp2, F##_wc2); SCAN_UPD(3, F##_bp3, F##_kp3, F##_wc3); \
    LDS_WAIT(); __builtin_amdgcn_sched_barrier(0); } while (0)
__device__ __forceinline__ void rw_scan_task(const Args& a, LAS unsigned char* wl  , int b, int h, int vt, int lane) {
    unsigned char* ws = a.ws;
    const int l15 = lane & 15, quad = lane >> 4;
    LAS bf16_t* Sb = (LAS bf16_t*)wl;
    LAS bf16_t* Yb = (LAS bf16_t*)(wl + 2304);
    LAS bf16_t* Ub = (LAS bf16_t*)(wl + 2304 + 512);
    const int o_nat = l15 * 128 + quad * 16, o_sm = l15 * 32 + quad * 8;
    const unsigned char* rec0 = ws + WS_CH + (size_t)((b * 16 + h) * 128) * REC;
    bf16_t* ob = (bf16_t*)(ws + WS_OB) + (size_t)(b * T) * D + h * 64 + vt * 16 + quad * 4;
    f32x4 S0 = {0.f, 0.f, 0.f, 0.f}, S1 = S0, S2 = S0, S3 = S0;
#pragma unroll
    for (int nt = 0; nt < 4; ++nt)
#pragma unroll
        for (int r = 0; r < 4; ++r) Sb[(quad * 4 + r) * 72 + nt * 16 + l15] = 0;
    LDS_WAIT();
    SCAN_DECL(f0); SCAN_DECL(f1); SCAN_DECL(f2);
    SCAN_LOAD(f0, rec0); SCAN_LOAD(f1, rec0 + REC);
    for (int ch = 0; ch < 126; ch += 3) { SCAN_STEP(f0, f2, ch); SCAN_STEP(f1, f0, ch + 1); SCAN_STEP(f2, f1, ch + 2); }
    SCAN_STEP(f0, f2, 126); SCAN_STEP(f1, f0, 127);
    float* so = a.out + OUT_RWP + (size_t)((b * 16 + h) * 64 + vt * 16) * 64;
#pragma unroll
    for (int r = 0; r < 4; ++r) { so[(quad * 4 + r) * 64 + l15] = S0[r]; so[(quad * 4 + r) * 64 + 16 + l15] = S1[r]; so[(quad * 4 + r) * 64 + 32 + l15] = S2[r]; so[(quad * 4 + r) * 64 + 48 + l15] = S3[r]; }
}

__device__ __forceinline__ void rw_sample_wave(const Args& a, int i, int h, int lane) {
    unsigned char* ws = a.ws;
    const float* s0 = a.in[I_SRW] + ((size_t)(i * 16 + h) * 64 + lane) * 64;
    const float* op = (const float*)(ws + WS_OPSS) + (size_t)(i * 16 + h) * 6 * 64;
    float s[64];
#pragma unroll
    for (int j = 0; j < 16; ++j) { const f32x4 t = ((const f32x4*)s0)[j]; s[4 * j] = t.x; s[4 * j + 1] = t.y; s[4 * j + 2] = t.z; s[4 * j + 3] = t.w; }
    const float r_l = op[lane], w_l = op[64 + lane], k_l = op[128 + lane], kk_l = op[192 + lane], b_l = op[256 + lane], v = op[320 + lane];
#define RL(x, j) __builtin_bit_cast(float, __builtin_amdgcn_readlane(__builtin_bit_cast(int, (x)), (j)))
    float sk = 0.f;
#pragma unroll
    for (int j = 0; j < 64; ++j) sk += s[j] * RL(kk_l, j);
    float o = 0.f;
#pragma unroll
    for (int j = 0; j < 64; ++j) { s[j] = s[j] * RL(w_l, j) - sk * RL(b_l, j) + v * RL(k_l, j); o += s[j] * RL(r_l, j); }
#undef RL
    float* so = a.out + OUT_RWS + ((size_t)(i * 16 + h) * 64 + lane) * 64;
#pragma unroll
    for (int j = 0; j < 16; ++j) ((f32x4*)so)[j] = (f32x4){s[4 * j], s[4 * j + 1], s[4 * j + 2], s[4 * j + 3]};
    ((bf16_t*)(ws + WS_OB))[(size_t)(MP + i) * D + h * 64 + lane] = f2bf(o);
}

constexpr int KN_LD = 264, VS_LD = 136, SS_LD = 264;
constexpr int L_KN = 0, L_VS = 128 * KN_LD * 2  , L_SS = L_VS + 64 * VS_LD * 2  , L_RET_END = L_SS + 64 * SS_LD * 2  ;
__device__ __forceinline__ void ret_unit(const Args& a, LAS unsigned char* lds, int unit, int tid) {
    unsigned char* ws = a.ws;
    const bf16_t* P = (const bf16_t*)(ws + WS_P);
    const int dvs = unit & 7, h = (unit >> 3) & 3, b = unit >> 5;
    const int wave = tid >> 6, lane = tid & 63, l15 = lane & 15, quad = lane >> 4;
    LAS bf16_t* KN = (LAS bf16_t*)(lds + L_KN); LAS bf16_t* VS = (LAS bf16_t*)(lds + L_VS); LAS bf16_t* SS = (LAS bf16_t*)(lds + L_SS);
    const float g = 1.f - exp2f(-5.f - (float)h), l2g = __log2f(g);
    const float gC = exp2f(128.f * l2g), ginvC = exp2f(-128.f * l2g);
    const bf16_t* KT = (const bf16_t*)(ws + WS_KT) + (size_t)(b * 4 + h) * 256 * T;
    f32x4 sacc[2][4];
#pragma unroll
    for (int n = 0; n < 2; ++n)
#pragma unroll
        for (int d = 0; d < 4; ++d) sacc[n][d] = (f32x4){0.f, 0.f, 0.f, 0.f};
    for (int i = tid; i < 64 * SS_LD / 2; i += 512) ((LAS unsigned*)SS)[i] = 0u;
    const int it = wave;
    u32x4 stk[8], stv[2];
#define RET_ISSUE(CC) do { const int tok0_ = b * T + (CC) * 128; \
        _Pragma("unroll") for (int i = 0; i < 8; ++i) { const int idx = tid + 512 * i, r = idx >> 5, c8 = (idx & 31) * 8; stk[i] = *(const u32x4*)(P + (size_t)(tok0_ + r) * NP + O_K + h * 256 + c8); } \
        _Pragma("unroll") for (int i = 0; i < 2; ++i) { const int idx = tid + 512 * i, r = idx >> 4, c8 = (idx & 15) * 8; stv[i] = *(const u32x4*)(P + (size_t)(b * T + h * 512 + dvs * 64 + r) * NP + O_V + (CC) * 128 + c8); } } while (0)
    bf16x8 qf[8];
#define RET_ISSUE_Q(CC) do { const int tokq_ = b * T + (CC) * 128 + it * 16 + l15; \
        _Pragma("unroll") for (int ks = 0; ks < 8; ++ks) qf[ks] = *(const bf16x8*)(P + (size_t)tokq_ * NP + h * 256 + ks * 32 + quad * 8); } while (0)
    RET_ISSUE(0); RET_ISSUE_Q(0);
    for (int c = 0; c < 16; ++c) {
        const int tok0 = b * T + c * 128;
#pragma unroll
        for (int i = 0; i < 8; ++i) { const int idx = tid + 512 * i, r = idx >> 5, c8 = (idx & 31) * 8; *(LAS u32x4*)(KN + r * KN_LD + c8) = stk[i]; }
#pragma unroll
        for (int i = 0; i < 2; ++i) { const int idx = tid + 512 * i, r = idx >> 4, c8 = (idx & 15) * 8; *(LAS u32x4*)(VS + r * VS_LD + c8) = stv[i]; }
        __syncthreads();
        bf16x8 ktf[2][4];
#pragma unroll
        for (int n = 0; n < 2; ++n)
#pragma unroll
            for (int ks = 0; ks < 4; ++ks) ktf[n][ks] = *(const bf16x8*)(KT + (size_t)((2 * wave + n) * 16 + l15) * T + c * 128 + ks * 32 + quad * 8);
        if (c < 15) RET_ISSUE(c + 1);
        f32x4 oacc[4];
#pragma unroll
        for (int d = 0; d < 4; ++d) oacc[d] = (f32x4){0.f, 0.f, 0.f, 0.f};
#pragma unroll
        for (int ks = 0; ks < 8; ++ks)
#pragma unroll
            for (int d = 0; d < 4; ++d) { const bf16x8 sb = *(const LAS bf16x8*)(SS + (d * 16 + l15) * SS_LD + ks * 32 + quad * 8); oacc[d] = MFMA32(qf[ks], sb, oacc[d]); }
#pragma unroll
        for (int p = 0; p < 4; ++p) {
            if (2 * p <= it) {
                f32x4 s0 = {0.f, 0.f, 0.f, 0.f}, s1 = {0.f, 0.f, 0.f, 0.f};
#pragma unroll
                for (int ks = 0; ks < 8; ++ks) { const bf16x8 ka = *(const LAS bf16x8*)(KN + ((2 * p) * 16 + l15) * KN_LD + ks * 32 + quad * 8); s0 = MFMA32(ka, qf[ks], s0); }
                if (2 * p + 1 <= it) {
#pragma unroll
                    for (int ks = 0; ks < 8; ++ks) { const bf16x8 ka = *(const LAS bf16x8*)(KN + ((2 * p + 1) * 16 + l15) * KN_LD + ks * 32 + quad * 8); s1 = MFMA32(ka, qf[ks], s1); }
                }
#pragma unroll
                for (int r = 0; r < 4; ++r) {
                    const int jl = quad * 4 + r;
                    s0[r] = (2 * p == it && jl > l15) ? 0.f : s0[r] * ginvC;
                    s1[r] = (2 * p + 1 > it || (2 * p + 1 == it && jl > l15)) ? 0.f : s1[r] * ginvC;
                }
                u32x4 aw; aw.x = pk2(s0[0], s0[1]); aw.y = pk2(s0[2], s0[3]); aw.z = pk2(s1[0], s1[1]); aw.w = pk2(s1[2], s1[3]);
                const bf16x8 af = __builtin_bit_cast(bf16x8, aw);
#pragma unroll
                for (int d = 0; d < 4; ++d) {
                    const LAS bf16_t* vr = VS + (d * 16 + l15) * VS_LD + 32 * p + quad * 4;
                    const u32x2 lo = *(const LAS u32x2*)vr, hi = *(const LAS u32x2*)(vr + 16);
                    const u32x4 bw = {lo.x, lo.y, hi.x, hi.y};
                    oacc[d] = MFMA32(af, __builtin_bit_cast(bf16x8, bw), oacc[d]);
                }
            }
        }
        if (c < 15) RET_ISSUE_Q(c + 1);
        {
            bf16_t* OA = (bf16_t*)(ws + WS_OA); float* SQA = (float*)(ws + WS_SQA);
#pragma unroll
            for (int r = 0; r < 4; ++r) {
                const int tok = tok0 + it * 16 + quad * 4 + r;
                float ss = 0.f;
#pragma unroll
                for (int d = 0; d < 4; ++d) { const float v = oacc[d][r]; ss += v * v; OA[(size_t)tok * 2048 + h * 512 + dvs * 64 + d * 16 + l15] = f2bf(v); }
#pragma unroll
                for (int o = 1; o < 16; o <<= 1) ss += __shfl_xor(ss, o);
                if (l15 == 0) SQA[(size_t)tok * 32 + h * 8 + dvs] = ss;
            }
        }
        __syncthreads();
#pragma unroll
        for (int n = 0; n < 2; ++n)
#pragma unroll
            for (int d = 0; d < 4; ++d) {
                f32x4 s = sacc[n][d] * gC;
#pragma unroll
                for (int ks = 0; ks < 4; ++ks) { const bf16x8 va = *(const LAS bf16x8*)(VS + (d * 16 + l15) * VS_LD + ks * 32 + quad * 8); s = MFMA32(va, ktf[n][ks], s); }
                sacc[n][d] = s;
#pragma unroll
                for (int r = 0; r < 4; ++r) SS[(d * 16 + quad * 4 + r) * SS_LD + (2 * wave + n) * 16 + l15] = f2bf(s[r]);
            }
        __syncthreads();
    }
    float* so = a.out + OUT_RETP + (size_t)(b * 4 + h) * 256 * 512;
#pragma unroll
    for (int n = 0; n < 2; ++n)
#pragma unroll
        for (int d = 0; d < 4; ++d) *(f32x4*)(so + (size_t)((2 * wave + n) * 16 + l15) * 512 + dvs * 64 + d * 16 + quad * 4) = sacc[n][d];
}
#undef RET_ISSUE
#undef RET_ISSUE_Q

__device__ __forceinline__ void ret_sample_unit(const Args& a, LAS unsigned char* lds, int i, int h, int tid) {
    unsigned char* ws = a.ws;
    const bf16_t* Prow = (const bf16_t*)(ws + WS_P) + (size_t)(MP + i) * NP;
    LAS float* Q = (LAS float*)lds; LAS float* Kh = Q + 256; LAS float* RED = Kh + 256; LAS float* OS = RED + 16;
    const float g = 1.f - exp2f(-5.f - (float)h);
    const int lane = tid & 63, wave = tid >> 6;
    float qk = 0.f;
    if (tid < 256) { const float q = bf2f(Prow[h * 256 + tid]), k = bf2f(Prow[O_K + h * 256 + tid]); Q[tid] = q; Kh[tid] = k; qk = q * k; }
    qk = wave_sum(qk);
    if (lane == 0) RED[wave] = qk;
    __syncthreads();
    const float qkv = (RED[0] + RED[1] + RED[2] + RED[3]) / g;
    const int dkg = tid >> 7, dv4 = 4 * (tid & 127);
    const u32x2 vw = *(const u32x2*)(Prow + O_V + h * 512 + dv4);
    const f32x4 v = {bflo(vw.x), bfhi(vw.x), bflo(vw.y), bfhi(vw.y)};
    const float* s0 = a.in[I_SRET] + (size_t)(i * 4 + h) * 256 * 512 + dv4;
    float* s1 = a.out + OUT_RETS + (size_t)(i * 4 + h) * 256 * 512 + dv4;
    f32x4 o = {0.f, 0.f, 0.f, 0.f};
#pragma unroll 8
    for (int j = 0; j < 64; ++j) {
        const int dk = dkg * 64 + j;
        const f32x4 s = __builtin_nontemporal_load((const f32x4*)(s0 + (size_t)dk * 512));
        o += s * Q[dk];
        __builtin_nontemporal_store(s * g + v * Kh[dk], (f32x4*)(s1 + (size_t)dk * 512));
    }
    *(LAS f32x4*)(OS + dkg * 512 + dv4) = o;
    __syncthreads();
    float y[4] = {0.f, 0.f, 0.f, 0.f}; float ss = 0.f;
    if (tid < 128) {
        const f32x4 t = *(LAS f32x4*)(OS + dv4) + *(LAS f32x4*)(OS + 512 + dv4) + *(LAS f32x4*)(OS + 1024 + dv4) + *(LAS f32x4*)(OS + 1536 + dv4) + v * qkv;
        y[0] = t.x; y[1] = t.y; y[2] = t.z; y[3] = t.w; ss = t.x * t.x + t.y * t.y + t.z * t.z + t.w * t.w;
    }
    ss = wave_sum(ss);
    if (lane == 0) RED[8 + wave] = ss;
    __syncthreads();
    if (tid < 128) {
        const float rs = 1.0f / sqrtf((RED[8] + RED[9]) * (1.f / 512.f) + EPS);
        const u32x2 gw = *(const u32x2*)(Prow + O_GA + h * 512 + dv4);
        u32x2 ow; ow.x = pk2(y[0] * rs * silu_(bflo(gw.x)), y[1] * rs * silu_(bfhi(gw.x))); ow.y = pk2(y[2] * rs * silu_(bflo(gw.y)), y[3] * rs * silu_(bfhi(gw.y)));
        *(u32x2*)((bf16_t*)(ws + WS_OA) + (size_t)(MP + i) * 2048 + h * 512 + dv4) = ow;
    }
    __syncthreads();
}

__device__ __forceinline__ void ret_sample_wave(const Args& a, int i, int h, int lane) {
    unsigned char* ws = a.ws;
    const bf16_t* Prow = (const bf16_t*)(ws + WS_P) + (size_t)(MP + i) * NP;
    const float g = 1.f - exp2f(-5.f - (float)h);
    float q[4], k[4]; float qk = 0.f;
#pragma unroll
    for (int j = 0; j < 4; ++j) { q[j] = bf2f(Prow[h * 256 + 64 * j + lane]); k[j] = bf2f(Prow[O_K + h * 256 + 64 * j + lane]); qk += q[j] * k[j]; }
    const float qkv = wave_sum(qk) / g;
    f32x4 v[2];
#pragma unroll
    for (int e = 0; e < 2; ++e) { const u32x2 vw = *(const u32x2*)(Prow + O_V + h * 512 + e * 256 + lane * 4); v[e] = (f32x4){bflo(vw.x), bfhi(vw.x), bflo(vw.y), bfhi(vw.y)}; }
    const float* s0 = a.in[I_SRET] + (size_t)(i * 4 + h) * 256 * 512 + lane * 4;
    float* s1 = a.out + OUT_RETS + (size_t)(i * 4 + h) * 256 * 512 + lane * 4;
    f32x4 o[2] = {{0.f, 0.f, 0.f, 0.f}, {0.f, 0.f, 0.f, 0.f}};
#pragma unroll
    for (int j = 0; j < 4; ++j) {
        for (int d0 = 0; d0 < 64; d0 += 16) {
            f32x4 sv[16][2];
#pragma unroll
            for (int d = 0; d < 16; ++d)
#pragma unroll
                for (int e = 0; e < 2; ++e) sv[d][e] = __builtin_nontemporal_load((const f32x4*)(s0 + (size_t)(64 * j + d0 + d) * 512 + e * 256));
#pragma unroll
            for (int d = 0; d < 16; ++d) {
                const float qd = __builtin_bit_cast(float, __builtin_amdgcn_readlane(__builtin_bit_cast(int, q[j]), d0 + d));
                const float kd = __builtin_bit_cast(float, __builtin_amdgcn_readlane(__builtin_bit_cast(int, k[j]), d0 + d));
#pragma unroll
                for (int e = 0; e < 2; ++e) { o[e] += sv[d][e] * qd; __builtin_nontemporal_store(sv[d][e] * g + v[e] * kd, (f32x4*)(s1 + (size_t)(64 * j + d0 + d) * 512 + e * 256)); }
            }
        }
    }
    float ss = 0.f;
#pragma unroll
    for (int e = 0; e < 2; ++e) { o[e] += v[e] * qkv; ss += (o[e].x * o[e].x + o[e].y * o[e].y) + (o[e].z * o[e].z + o[e].w * o[e].w); }
    const float rs = 1.0f / sqrtf(wave_sum(ss) * (1.f / 512.f) + EPS);
#pragma unroll
    for (int e = 0; e < 2; ++e) { const u32x2 gw = *(const u32x2*)(Prow + O_GA + h * 512 + e * 256 + lane * 4);
        u32x2 ow; ow.x = pk2(o[e].x * rs * silu_(bflo(gw.x)), o[e].y * rs * silu_(bfhi(gw.x))); ow.y = pk2(o[e].z * rs * silu_(bflo(gw.y)), o[e].w * rs * silu_(bfhi(gw.y)));
        *(u32x2*)((bf16_t*)(ws + WS_OA) + (size_t)(MP + i) * 2048 + h * 512 + e * 256 + lane * 4) = ow; }
}

__device__ __forceinline__ void phase25_row(const Args& a, int m, int lane) {
    unsigned char* ws = a.ws;
    const bf16_t* Prow = (const bf16_t*)(ws + WS_P) + (size_t)m * NP;
    bf16_t* oa = (bf16_t*)(ws + WS_OA) + (size_t)m * 2048;
    const float* sq = (const float*)(ws + WS_SQA) + (size_t)m * 32;
    const bool prompt = m < MP;
    f32x4 sqv[8]; u32x4 ow[4], gw4[4];
    if (prompt) {
#pragma unroll
        for (int j = 0; j < 8; ++j) sqv[j] = ((const f32x4*)sq)[j];
#pragma unroll
        for (int hh = 0; hh < 4; ++hh) { ow[hh] = *(const u32x4*)(oa + hh * 512 + lane * 8); gw4[hh] = *(const u32x4*)(Prow + O_GA + hh * 512 + lane * 8); }
    }
    const bf16_t* ob = (const bf16_t*)(ws + WS_OB) + (size_t)m * D + lane * 16;
    f32x4 ov[4];
    { const u32x4 w0 = ((const u32x4*)ob)[0], w1 = ((const u32x4*)ob)[1];
      ov[0] = (f32x4){bflo(w0.x), bfhi(w0.x), bflo(w0.y), bfhi(w0.y)}; ov[1] = (f32x4){bflo(w0.z), bfhi(w0.z), bflo(w0.w), bfhi(w0.w)};
      ov[2] = (f32x4){bflo(w1.x), bfhi(w1.x), bflo(w1.y), bfhi(w1.y)}; ov[3] = (f32x4){bflo(w1.z), bfhi(w1.z), bflo(w1.w), bfhi(w1.w)}; }
    const float bc = ((const float*)(ws + WS_BC))[(size_t)m * 16 + (lane >> 2)];
    const bf16_t* cur = Prow + O_SH + 2048 + lane * 16;
    const bool hasp = (m >= MP) || (m & (T - 1));
    const bf16_t* prv = (m >= MP) ? cur + (size_t)MS * NP : cur - NP;
    u32x4 cw[2], pw[2] = {{0u, 0u, 0u, 0u}, {0u, 0u, 0u, 0u}}, gbw[2];
    cw[0] = ((const u32x4*)cur)[0]; cw[1] = ((const u32x4*)cur)[1];
    if (hasp) { pw[0] = ((const u32x4*)prv)[0]; pw[1] = ((const u32x4*)prv)[1]; }
    gbw[0] = ((const u32x4*)(Prow + O_GB + lane * 16))[0]; gbw[1] = ((const u32x4*)(Prow + O_GB + lane * 16))[1];
    f32x4 lw4[4], lb4[4], mu4[4];
#pragma unroll
    for (int j = 0; j < 4; ++j) { lw4[j] = ((const f32x4*)(a.in[I_LNW] + lane * 16))[j]; lb4[j] = ((const f32x4*)(a.in[I_LNB] + lane * 16))[j]; mu4[j] = ((const f32x4*)(a.in[I_MU] + 2048 + lane * 16))[j]; }
    if (prompt) {
#pragma unroll
        for (int hh = 0; hh < 4; ++hh) {
            const f32x4 s0 = sqv[2 * hh], s1 = sqv[2 * hh + 1];
            const float rs = 1.0f / sqrtf(((s0.x + s0.y) + (s0.z + s0.w) + (s1.x + s1.y) + (s1.z + s1.w)) * (1.f / 512.f) + EPS);
            const u32x4 o4 = ow[hh], g4 = gw4[hh];
            u32x4 r;
            r.x = pk2(bflo(o4.x) * rs * silu_(bflo(g4.x)), bfhi(o4.x) * rs * silu_(bfhi(g4.x))); r.y = pk2(bflo(o4.y) * rs * silu_(bflo(g4.y)), bfhi(o4.y) * rs * silu_(bfhi(g4.y)));
            r.z = pk2(bflo(o4.z) * rs * silu_(bflo(g4.z)), bfhi(o4.z) * rs * silu_(bfhi(g4.z))); r.w = pk2(bflo(o4.w) * rs * silu_(bflo(g4.w)), bfhi(o4.w) * rs * silu_(bfhi(g4.w)));
            *(u32x4*)(oa + hh * 512 + lane * 8) = r;
        }
    }
    float o[16], lw[16], lb[16], mu[16];
#pragma unroll
    for (int j = 0; j < 4; ++j) { o[4 * j] = ov[j].x; o[4 * j + 1] = ov[j].y; o[4 * j + 2] = ov[j].z; o[4 * j + 3] = ov[j].w;
        lw[4 * j] = lw4[j].x; lw[4 * j + 1] = lw4[j].y; lw[4 * j + 2] = lw4[j].z; lw[4 * j + 3] = lw4[j].w;
        lb[4 * j] = lb4[j].x; lb[4 * j + 1] = lb4[j].y; lb[4 * j + 2] = lb4[j].z; lb[4 * j + 3] = lb4[j].w;
        mu[4 * j] = mu4[j].x; mu[4 * j + 1] = mu4[j].y; mu[4 * j + 2] = mu4[j].z; mu[4 * j + 3] = mu4[j].w; }
    float s = 0.f;
#pragma unroll
    for (int j = 0; j < 16; ++j) s += o[j];
    s += __shfl_xor(s, 1); s += __shfl_xor(s, 2);
    const float mean = s * (1.f / 64.f);
    float q = 0.f;
#pragma unroll
    for (int j = 0; j < 16; ++j) { const float d = o[j] - mean; q += d * d; }
    q += __shfl_xor(q, 1); q += __shfl_xor(q, 2);
    const float rstd = 1.0f / sqrtf(q * (1.f / 64.f) + 64e-5f);
    const unsigned cws[8] = {cw[0].x, cw[0].y, cw[0].z, cw[0].w, cw[1].x, cw[1].y, cw[1].z, cw[1].w};
    const unsigned pws[8] = {pw[0].x, pw[0].y, pw[0].z, pw[0].w, pw[1].x, pw[1].y, pw[1].z, pw[1].w};
    const unsigned gws[8] = {gbw[0].x, gbw[0].y, gbw[0].z, gbw[0].w, gbw[1].x, gbw[1].y, gbw[1].z, gbw[1].w};
    unsigned outw[8];
#pragma unroll
    for (int j = 0; j < 8; ++j) {
        const float c0 = bflo(cws[j]), c1 = bfhi(cws[j]), p0 = bflo(pws[j]), p1 = bfhi(pws[j]);
        const float v0 = c0 + (p0 - c0) * mu[2 * j], v1 = c1 + (p1 - c1) * mu[2 * j + 1];
        const float y0 = ((o[2 * j] - mean) * rstd * lw[2 * j] + lb[2 * j] + bc * v0) * silu_(bflo(gws[j]));
        const float y1 = ((o[2 * j + 1] - mean) * rstd * lw[2 * j + 1] + lb[2 * j + 1] + bc * v1) * silu_(bfhi(gws[j]));
        outw[j] = pk2(y0, y1);
    }
    bf16_t* yb = (bf16_t*)(ws + WS_H) + (size_t)m * D + lane * 16;
    *(u32x4*)yb = (u32x4){outw[0], outw[1], outw[2], outw[3]}; *(u32x4*)(yb + 8) = (u32x4){outw[4], outw[5], outw[6], outw[7]};
}

struct EpiT1 {
    static constexpr bool PERM = false;
    const bf16_t* P; bf16_t* T1;
    __device__ __forceinline__ void operator()(const f32x4 (&acc)[2][2][4][2], const Unit& u, int wr, int wc, int fr, int fq) const {
        const int row0 = u.pm * 256 + wr * 64 + fr, col0 = u.pn * 256 + wc * 32 + 4 * fq;
#pragma unroll
        for (int ai = 0; ai < 2; ++ai)
#pragma unroll
            for (int m = 0; m < 4; ++m) { const int row = row0 + ai * 128 + m * 16; if (row >= MR) continue;
#pragma unroll
                for (int bj = 0; bj < 2; ++bj)
#pragma unroll
                    for (int n = 0; n < 2; ++n) { const int col = col0 + bj * 128 + n * 16;
                        const u32x2 gw = *(const u32x2*)(P + (size_t)row * NP + O_MA + col);
                        const f32x4 gt = {sigm(bflo(gw.x)), sigm(bfhi(gw.x)), sigm(bflo(gw.y)), sigm(bfhi(gw.y))};
                        const f32x4 t = acc[ai][bj][m][n] * gt; *(u32x2*)(T1 + (size_t)row * D + col) = (u32x2){pk2(t.x, t.y), pk2(t.z, t.w)}; } asm volatile("" ::: "memory"); }
    }
};
struct EpiMG {
    static constexpr bool PERM = false;
    const bf16_t* P; const bf16_t* T1; bf16_t* MG;
    __device__ __forceinline__ void operator()(const f32x4 (&acc)[2][2][4][2], const Unit& u, int wr, int wc, int fr, int fq) const {
        const int row0 = u.pm * 256 + wr * 64 + fr, col0 = u.pn * 256 + wc * 32 + 4 * fq;
#pragma unroll
        for (int ai = 0; ai < 2; ++ai)
#pragma unroll
            for (int m = 0; m < 4; ++m) { const int row = row0 + ai * 128 + m * 16; if (row >= MR) continue;
#pragma unroll
                for (int bj = 0; bj < 2; ++bj)
#pragma unroll
                    for (int n = 0; n < 2; ++n) { const int col = col0 + bj * 128 + n * 16;
                        const u32x2 gw = *(const u32x2*)(P + (size_t)row * NP + O_MB + col);
                        const f32x4 gt = {sigm(bflo(gw.x)), sigm(bfhi(gw.x)), sigm(bflo(gw.y)), sigm(bfhi(gw.y))};
                        const u32x2 tw = *(const u32x2*)(T1 + (size_t)row * D + col);
                        const f32x4 v = (f32x4){bflo(tw.x), bfhi(tw.x), bflo(tw.y), bfhi(tw.y)} + acc[ai][bj][m][n] * gt;
                        *(u32x2*)(MG + (size_t)row * D + col) = (u32x2){pk2(v.x, v.y), pk2(v.z, v.w)}; } asm volatile("" ::: "memory"); }
    }
};
struct EpiX1 {
    static constexpr bool PERM = false;
    const float* xp; const float* xs; float* X1; bf16_t* X1B; float* SQ;
    __device__ __forceinline__ void operator()(const f32x4 (&acc)[2][2][4][2], const Unit& u, int wr, int wc, int fr, int fq) const {
        const int row0 = u.pm * 256 + wr * 64 + fr, col0 = u.pn * 256 + wc * 32 + 4 * fq;
#pragma unroll
        for (int ai = 0; ai < 2; ++ai)
#pragma unroll
            for (int m = 0; m < 4; ++m) { const int row = row0 + ai * 128 + m * 16; const bool ok = row < MR;
                const float* xr = (row < MP) ? xp + (size_t)row * D : xs + (size_t)(row - MP) * D;
                float ss = 0.f;
                if (ok) {
#pragma unroll
                    for (int bj = 0; bj < 2; ++bj)
#pragma unroll
                        for (int n = 0; n < 2; ++n) { const int col = col0 + bj * 128 + n * 16;
                            const f32x4 v = *(const f32x4*)(xr + col) + acc[ai][bj][m][n];
                            ss += (v.x * v.x + v.y * v.y) + (v.z * v.z + v.w * v.w);
                            *(u32x2*)(X1B + (size_t)row * D + col) = (u32x2){pk2(v.x, v.y), pk2(v.z, v.w)}; }
                }
                ss += __shfl_xor(ss, 16); ss += __shfl_xor(ss, 32);
                if (ok && fq == 0) SQ[(size_t)row * 16 + u.pn * 4 + wc] = ss; asm volatile("" ::: "memory"); }
    }
};
struct EpiGT {
    static constexpr bool PERM = false;
    const float* SQ; bf16_t* GT;
    __device__ __forceinline__ void operator()(const f32x4 (&acc)[2][2][4][2], const Unit& u, int wr, int wc, int fr, int fq) const {
        const int row0 = u.pm * 256 + wr * 64 + fr, col0 = u.pn * 256 + wc * 32 + 4 * fq;
#pragma unroll
        for (int ai = 0; ai < 2; ++ai)
#pragma unroll
            for (int m = 0; m < 4; ++m) { const int row = row0 + ai * 128 + m * 16; if (row >= MR) continue;
                const f32x4* sp = (const f32x4*)(SQ + (size_t)row * 16); const f32x4 q0 = sp[0], q1 = sp[1], q2 = sp[2], q3 = sp[3];
                const float rs = 1.0f / sqrtf((((q0.x + q0.y) + (q0.z + q0.w)) + ((q1.x + q1.y) + (q1.z + q1.w)) + ((q2.x + q2.y) + (q2.z + q2.w)) + ((q3.x + q3.y) + (q3.z + q3.w))) * (1.f / D) + EPS);
#pragma unroll
                for (int bj = 0; bj < 2; ++bj)
#pragma unroll
                    for (int n = 0; n < 2; ++n) { const int col = col0 + bj * 128 + n * 16; const f32x4 t = acc[ai][bj][m][n] * rs;
                        *(u32x2*)(GT + (size_t)row * D + col) = (u32x2){pk2(sigm(t.x), sigm(t.y)), pk2(sigm(t.z), sigm(t.w))}; } asm volatile("" ::: "memory"); }
    }
};
struct EpiX2 {
    static constexpr bool PERM = false;
    const bf16_t* X1; const bf16_t* GT; float* out; float* SQ;
    __device__ __forceinline__ void operator()(const f32x4 (&acc)[2][2][4][2], const Unit& u, int wr, int wc, int fr, int fq) const {
        const int row0 = u.pm * 256 + wr * 64 + fr, col0 = u.pn * 256 + wc * 32 + 4 * fq;
#pragma unroll
        for (int ai = 0; ai < 2; ++ai)
#pragma unroll
            for (int m = 0; m < 4; ++m) { int row = row0 + ai * 128 + m * 16; asm volatile("" : "+v"(row)); const bool ok = row < MR;
                float ss = 0.f;
                if (ok) {
#pragma unroll
                    for (int bj = 0; bj < 2; ++bj)
#pragma unroll
                        for (int n = 0; n < 2; ++n) { const int col = col0 + bj * 128 + n * 16;
                            const u32x2 gw = *(const u32x2*)(GT + (size_t)row * D + col);
                            const u32x2 xw = *(const u32x2*)(X1 + (size_t)row * D + col);
                            const f32x4 v = (f32x4){bflo(xw.x), bfhi(xw.x), bflo(xw.y), bfhi(xw.y)} + acc[ai][bj][m][n] * (f32x4){bflo(gw.x), bfhi(gw.x), bflo(gw.y), bfhi(gw.y)};
                            ss += (v.x * v.x + v.y * v.y) + (v.z * v.z + v.w * v.w);
                            *(f32x4*)(out + (size_t)row * D + col) = v; asm volatile("" ::: "memory"); }
                }
                ss += __shfl_xor(ss, 16); ss += __shfl_xor(ss, 32);
                if (ok && fq == 0) SQ[(size_t)row * 16 + u.pn * 4 + wc] = ss; asm volatile("" ::: "memory"); }
    }
};


__device__ __forceinline__ f32x4 mini_acc(const bf16_t* A, int lda, const bf16_t* Bt, int K, int kq, int l15, int quad) {
    f32x4 acc = {0.f, 0.f, 0.f, 0.f};
    const int kn = K / 128;
    const bf16_t* ap = A + (size_t)l15 * lda + kq * (K / 4) + quad * 8;
    const bf16_t* bp = Bt + (size_t)l15 * K + kq * (K / 4) + quad * 8;
#pragma unroll 4
    for (int ks = 0; ks < kn; ++ks) acc = MFMA32(*(const bf16x8*)(ap + ks * 32), *(const bf16x8*)(bp + ks * 32), acc);
    return acc;
}
__device__ __forceinline__ f32x4 mini_reduce(LAS f32x4* red, int half, int lane) { return (red[(half * 4 + 0) * 64 + lane] + red[(half * 4 + 1) * 64 + lane]) + (red[(half * 4 + 2) * 64 + lane] + red[(half * 4 + 3) * 64 + lane]); }
template <int PH> __device__ __forceinline__ void mini_phase(const Args& a, LAS unsigned char* lds, int bx, int G, int wave, int lane) {
    unsigned char* ws = a.ws;
    const int l15 = lane & 15, quad = lane >> 4, half = wave >> 2, kq = wave & 3;
    LAS f32x4* red1 = (LAS f32x4*)lds; LAS f32x4* red2 = red1 + 8 * 64;
    const bf16_t* P = (const bf16_t*)(ws + WS_P);
    for (int tp = bx; tp < 256; tp += G) {
        const int tl = tp * 2 + half, mt = tl >> 6, nt = tl & 63, row0 = MP + mt * 16, col0 = nt * 16;
        f32x4 a1, a2 = {0.f, 0.f, 0.f, 0.f};
        if (PH == 0) { a1 = mini_acc((const bf16_t*)(ws + WS_OA) + (size_t)row0 * 2048, 2048, (const bf16_t*)(ws + WS_WDA) + (size_t)col0 * 2048, 2048, kq, l15, quad);
                       a2 = mini_acc((const bf16_t*)(ws + WS_H) + (size_t)row0 * D, D, (const bf16_t*)(ws + WS_WDB) + (size_t)col0 * D, D, kq, l15, quad); }
        if (PH == 1) { a1 = mini_acc((const bf16_t*)(ws + WS_MG) + (size_t)row0 * D, D, (const bf16_t*)(ws + WS_WOUT) + (size_t)col0 * D, D, kq, l15, quad); }
        if (PH == 2) { a1 = mini_acc((const bf16_t*)(ws + WS_X1B) + (size_t)row0 * D, D, (const bf16_t*)(ws + WS_WGATE) + (size_t)col0 * D, D, kq, l15, quad);
                       a2 = mini_acc((const bf16_t*)(ws + WS_PB) + (size_t)row0 * PLE, PLE, (const bf16_t*)(ws + WS_WPLE) + (size_t)col0 * PLE, PLE, kq, l15, quad); }
        red1[wave * 64 + lane] = a1; red2[wave * 64 + lane] = a2;
        __syncthreads();
        if (kq == 0) {
            a1 = mini_reduce(red1, half, lane); a2 = mini_reduce(red2, half, lane);
            const int col = col0 + l15;
            float rs1[4] = {0.f, 0.f, 0.f, 0.f};
            if (PH == 2) {
#pragma unroll
                for (int r = 0; r < 4; ++r) { const f32x4 q = *(const f32x4*)((const float*)(ws + WS_SQS1) + (size_t)(row0 - MP + quad * 4 + r) * 64 + l15 * 4); float t = (q.x + q.y) + (q.z + q.w);
#pragma unroll
                    for (int o = 1; o < 16; o <<= 1) t += __shfl_xor(t, o);
                    rs1[r] = 1.0f / sqrtf(t * (1.f / D) + EPS); }
            }
#pragma unroll
            for (int r = 0; r < 4; ++r) {
                const int row = row0 + quad * 4 + r;
                float ss = 0.f;
                if (PH == 0) { const float ga = sigm(bf2f(P[(size_t)row * NP + O_MA + col])), gb = sigm(bf2f(P[(size_t)row * NP + O_MB + col]));
                    ((bf16_t*)(ws + WS_MG))[(size_t)row * D + col] = f2bf(a1[r] * ga + a2[r] * gb); }
                if (PH == 1) { const float x1 = a.in[I_XS][(size_t)(row - MP) * D + col] + a1[r]; ss = x1 * x1;
                    ((bf16_t*)(ws + WS_X1B))[(size_t)row * D + col] = f2bf(x1); }
                if (PH == 2) { const float x2 = bf2f(((const bf16_t*)(ws + WS_X1B))[(size_t)row * D + col]) + a2[r] * sigm(rs1[r] * a1[r]); ss = x2 * x2;
                    a.out[OUT_Y + (size_t)row * D + col] = x2; }
                if (PH != 0) {
#pragma unroll
                    for (int o = 1; o < 16; o <<= 1) ss += __shfl_xor(ss, o);
                    if (l15 == 0) ((float*)(ws + (PH == 1 ? WS_SQS1 : WS_SQS2)))[(size_t)(row - MP) * 64 + nt] = ss;
                }
            }
        }
        __syncthreads();
    }
}

#define XB_TMO      128
#define XB_XCNT(j)  (256  + 64 * (j))
#define XB_XSUB(j)  (1280 + 64 * (j))
#define XB_XGEN(j)  (2304 + 64 * (j))
#define XB_TOP      3328
#define XB_TOPGEN   3392
#define XCD_BAR_WORDS 3456
#define XB_SPIN_CAP (1u << 22)
__device__ __forceinline__ unsigned xb_ld(unsigned* p)              { return __hip_atomic_load(p, __ATOMIC_RELAXED, __HIP_MEMORY_SCOPE_AGENT); }
__device__ __forceinline__ unsigned xb_add(unsigned* p, unsigned v) { return __hip_atomic_fetch_add(p, v, __ATOMIC_RELAXED, __HIP_MEMORY_SCOPE_AGENT); }
__device__ __forceinline__ unsigned xb_xcc_id() { return (unsigned)__builtin_amdgcn_s_getreg((3 << 11) | 20) & 0xFu; }
#define XB_SPIN(cond, bar) do { unsigned _sp = 0; while (cond) { __builtin_amdgcn_s_sleep(1); \
    if ((++_sp & 255u) == 0u) { if (xb_ld(&(bar)[XB_TMO])) break; if (_sp > XB_SPIN_CAP) { atomicAdd(&(bar)[XB_TMO], 1u); break; } } } } while (0)
struct XcdBarrier { unsigned* bar; unsigned x; volatile LAS unsigned* st; };
__device__ __forceinline__ XcdBarrier xcd_barrier_post(unsigned* bar, volatile LAS unsigned* st) {
    XcdBarrier b; b.bar = bar; b.x = xb_xcc_id(); b.st = st;
    if (threadIdx.x == 0) (void)xb_add(&bar[XB_XCNT(b.x)], 1u);
    return b;
}
__device__ __forceinline__ void xcd_barrier_complete(unsigned* bar, unsigned x, unsigned& nloc, unsigned& nx) {
    const unsigned G = gridDim.x * gridDim.y * gridDim.z;
    unsigned sum, cnt, mine, sp = 0u;
    for (;;) {
        sum = 0u; cnt = 0u; mine = 0u;
#pragma unroll
        for (unsigned j = 0; j < 16; ++j) { const unsigned c = xb_ld(&bar[XB_XCNT(j)]); sum += c; cnt += (c > 0u) ? 1u : 0u; mine = (j == x) ? c : mine; }
        if (sum == G) break;
        __builtin_amdgcn_s_sleep(1);
        if ((++sp & 255u) == 0u) { if (xb_ld(&bar[XB_TMO])) break; if (sp > XB_SPIN_CAP) { atomicAdd(&bar[XB_TMO], 1u); break; } }
    }
    nloc = mine > 0u ? mine : 1u; nx = cnt > 0u ? cnt : 1u;
}
__device__ __forceinline__ void xcd_barrier(const XcdBarrier& b) {
    asm volatile("s_waitcnt vmcnt(0)" ::: "memory");
    __syncthreads();
    if (threadIdx.x == 0) {
        unsigned* bar = b.bar;
        __builtin_amdgcn_s_waitcnt(0);
        unsigned nloc = b.st[0], nx = b.st[1];
        if (nloc == 0u) { xcd_barrier_complete(bar, b.x, nloc, nx); b.st[0] = nloc; b.st[1] = nx; }
        const unsigned old = xb_add(&bar[XB_XSUB(b.x)], 1u);
        const unsigned gen = old / nloc;
        if (old + 1u == (gen + 1u) * nloc) {
            __builtin_amdgcn_fence(__ATOMIC_RELEASE, "agent");
            asm volatile("s_waitcnt vmcnt(0)" ::: "memory");
            const unsigned og = xb_add(&bar[XB_TOP], 1u);
            const unsigned tg = og / nx;
            if (og + 1u == (tg + 1u) * nx) xb_add(&bar[XB_TOPGEN], 1u);
            else XB_SPIN(xb_ld(&bar[XB_TOPGEN]) == tg, bar);
            __builtin_amdgcn_fence(__ATOMIC_ACQUIRE, "agent");
            xb_add(&bar[XB_XGEN(b.x)], 1u);
            asm volatile("s_waitcnt vmcnt(0)" ::: "memory");
        } else {
            XB_SPIN(xb_ld(&bar[XB_XGEN(b.x)]) == gen, bar);
            __builtin_amdgcn_fence(__ATOMIC_ACQUIRE, "agent");
            asm volatile("s_waitcnt vmcnt(0)" ::: "memory");
        }
    }
    __syncthreads();
}

constexpr int LDS_BYTES = 147456;
constexpr int CTL_SQ1 = 0, CTL_SQ2 = 32768, CTL_CNT = 65536;

#define GRID_SYNC() xcd_barrier(xbar)
__global__ void __launch_bounds__(512, 2) fwd_mega(Args a) {
    extern __shared__ __attribute__((aligned(16))) unsigned char lds_raw[];
    LAS unsigned char* lds = (LAS unsigned char*)lds_raw;
    cg::grid_group grid = cg::this_grid();
    const int tid = threadIdx.x, lane = tid & 63, wave = __builtin_amdgcn_readfirstlane(tid >> 6);
    const int G = gridDim.x, bx = blockIdx.x;
    const int gw = bx * 8 + wave, NGW = G * 8;
    unsigned char* ws = a.ws;
    if (tid < 16) ((LAS unsigned*)(lds + 131072 + 64))[tid] = 0u;
    __syncthreads();
    XcdBarrier xbar = xcd_barrier_post((unsigned*)(ws + WS_BAR), (volatile LAS unsigned*)(lds + 131072 + 64));
    grid.sync();

#if !defined(ONLY_PH) || ONLY_PH == 0
    phase0(a, lds, gw, NGW, wave, lane);
    GRID_SYNC();
#endif
#if !defined(ONLY_PH) || ONLY_PH == 1
    {
        pg8::Gemm g{(const bf16_t*)(ws + WS_H), (const bf16_t*)(ws + WS_WIN), MALL, NP, D}; pg8::StaticOrder S; S.init(MALL, NP, G, bx);
        EpiP E{(bf16_t*)(ws + WS_P), (bf16_t*)(ws + WS_KT), (const f32x2*)(ws + WS_ROPE)};
        pg8::gemm_phase<EpiP>(lds, g, S, E);
    }
    GRID_SYNC();
#endif
#if !defined(ONLY_PH) || ONLY_PH == 2
    for (int it = gw; it < 1032 * 16; it += NGW) rw_prep_item(a, lds + wave * 10240, it >> 4, it & 15, lane);
    GRID_SYNC();
#endif
#if !defined(ONLY_PH) || ONLY_PH == 3
    {
        for (int u = gw; u < MS * 16; u += NGW) rw_sample_wave(a, u >> 4, u & 15, lane);
        if (bx < 128) { if (wave < 4) rw_scan_task(a, lds + wave * 4096, bx >> 4, bx & 15, wave, lane); else if (G >= 128) { const int u = bx * 4 + (wave - 4); ret_sample_wave(a, u >> 2, u & 3, lane); } }
        __syncthreads();
        {
            unsigned* cnt2 = (unsigned*)(ws + WS_CTL) + CTL_CNT + 32;
            LAS unsigned* lu = (LAS unsigned*)(lds + 131072);
            for (;;) {
                if (tid == 0) *lu = atomicAdd(cnt2, 1u);
                __syncthreads();
                const unsigned unit = *lu;
                __syncthreads();
                if (unit >= (unsigned)(MS * 4) || G >= 128) break;
                ret_sample_unit(a, lds, (int)(unit >> 2), (int)(unit & 3), tid);
            }
        }
        {
            unsigned* cnt = (unsigned*)(ws + WS_CTL) + CTL_CNT;
            LAS unsigned* lu = (LAS unsigned*)(lds + 131072);
            for (;;) {
                if (tid == 0) *lu = atomicAdd(cnt, 1u);
                __syncthreads();
                const unsigned unit = *lu;
                __syncthreads();
                if (unit >= 256u) break;
                ret_unit(a, lds, (int)unit, tid);
            }
        }
    }
    GRID_SYNC();
#endif
#if !defined(ONLY_PH) || ONLY_PH == 4
    for (int m = gw; m < MR; m += NGW) phase25_row(a, m, lane);
    GRID_SYNC();
#endif
#if !defined(ONLY_PH) || ONLY_PH == 5
    {
        mini_phase<0>(a, lds, bx, G, wave, lane);
        pg8::StaticOrder S; S.init(MP, D, G, bx);
        { pg8::Gemm g{(const bf16_t*)(ws + WS_OA), (const bf16_t*)(ws + WS_WDA), MP, D, 2048}; EpiT1 E{(const bf16_t*)(ws + WS_P), (bf16_t*)(ws + WS_T1)}; pg8::gemm_phase<EpiT1>(lds, g, S, E); }
        { pg8::Gemm g{(const bf16_t*)(ws + WS_H), (const bf16_t*)(ws + WS_WDB), MP, D, D}; EpiMG E{(const bf16_t*)(ws + WS_P), (const bf16_t*)(ws + WS_T1), (bf16_t*)(ws + WS_MG)}; pg8::gemm_phase<EpiMG>(lds, g, S, E); }
    }
    GRID_SYNC();
#endif
#if !defined(ONLY_PH) || ONLY_PH == 6
    {
        mini_phase<1>(a, lds, bx, G, wave, lane);
        pg8::StaticOrder S; S.init(MP, D, G, bx);
        pg8::Gemm g{(const bf16_t*)(ws + WS_MG), (const bf16_t*)(ws + WS_WOUT), MP, D, D};
        EpiX1 E{a.in[I_XP], a.in[I_XS], (float*)(ws + WS_X1), (bf16_t*)(ws + WS_X1B), (float*)(ws + WS_SQ1P)};
        pg8::gemm_phase<EpiX1>(lds, g, S, E);
    }
    GRID_SYNC();
#endif
#if !defined(ONLY_PH) || ONLY_PH == 7
    {
        mini_phase<2>(a, lds, bx, G, wave, lane);
        pg8::StaticOrder S; S.init(MP, D, G, bx);
        { pg8::Gemm g{(const bf16_t*)(ws + WS_X1B), (const bf16_t*)(ws + WS_WGATE), MP, D, D}; EpiGT E{(const float*)(ws + WS_SQ1P), (bf16_t*)(ws + WS_GT)}; pg8::gemm_phase<EpiGT>(lds, g, S, E); }
        { pg8::Gemm g{(const bf16_t*)(ws + WS_PB), (const bf16_t*)(ws + WS_WPLE), MP, D, PLE}; EpiX2 E{(const bf16_t*)(ws + WS_X1B), (const bf16_t*)(ws + WS_GT), a.out + OUT_Y, (float*)(ws + WS_SQ2P)}; pg8::gemm_phase<EpiX2>(lds, g, S, E); }
    }
    GRID_SYNC();
#endif
#if !defined(ONLY_PH) || ONLY_PH == 8
    {
        const float* sq2 = (const float*)(ws + WS_SQ2P); const float* fg = a.in[I_FNG];
        for (int m0 = gw; m0 < MR; m0 += 2 * NGW) {
            const int m1 = m0 + NGW; const bool two = m1 < MR;
            float tot[2]; f32x4 xv[2][4];
#pragma unroll
            for (int e = 0; e < 2; ++e) {
                const int m = e ? m1 : m0;
                if (e == 0 || two) {
                    if (m < MP) { const f32x4* sp = (const f32x4*)(sq2 + (size_t)m * 16); const f32x4 q0 = sp[0], q1 = sp[1], q2 = sp[2], q3 = sp[3];
                        tot[e] = (((q0.x + q0.y) + (q0.z + q0.w)) + ((q1.x + q1.y) + (q1.z + q1.w)) + ((q2.x + q2.y) + (q2.z + q2.w)) + ((q3.x + q3.y) + (q3.z + q3.w))); }
                    else tot[e] = wave_sum(((const float*)(ws + WS_SQS2))[(size_t)(m - MP) * 64 + lane]);
                    const f32x4* o = (const f32x4*)(a.out + OUT_Y + (size_t)m * D);
#pragma unroll
                    for (int j = 0; j < 4; ++j) xv[e][j] = o[lane + 64 * j];
                }
            }
#pragma unroll
            for (int e = 0; e < 2; ++e) {
                const int m = e ? m1 : m0;
                if (e == 0 || two) {
                    const float rs = 1.0f / sqrtf(tot[e] * (1.f / D) + EPS);
                    f32x4* o = (f32x4*)(a.out + OUT_Y + (size_t)m * D);
#pragma unroll
                    for (int j = 0; j < 4; ++j) o[lane + 64 * j] = xv[e][j] * rs * ((const f32x4*)fg)[lane + 64 * j];
                }
            }
        }
    }
#endif

}

extern "C" void kernel_launch(void* const* d_in, const int* in_sizes, int n_in, void* d_out, int out_size, void* d_ws, size_t ws_size, hipStream_t stream) {
    static int grid = 0;
    if (grid == 0) {
        if (n_in != 26 || ws_size < WS_END) { fprintf(stderr, "kernel_launch: unexpected n_in %d or ws_size %zu (need %zu)\n", n_in, ws_size, (size_t)WS_END); grid = -1; return; }
        int dev = 0, cus = 0, per_cu = 0;
        hipGetDevice(&dev); hipDeviceGetAttribute(&cus, hipDeviceAttributeMultiprocessorCount, dev);
        if (hipFuncSetAttribute((const void*)fwd_mega, hipFuncAttributeMaxDynamicSharedMemorySize, LDS_BYTES) != hipSuccess) { fprintf(stderr, "kernel_launch: hipFuncSetAttribute failed\n"); grid = -1; return; }
        hipOccupancyMaxActiveBlocksPerMultiprocessor(&per_cu, (const void*)fwd_mega, 512, LDS_BYTES);
        if (per_cu < 1) { fprintf(stderr, "kernel_launch: occupancy query says %d blocks per CU\n", per_cu); per_cu = 1; }
        (void)hipGetLastError();
        grid = cus * 1;
        fprintf(stderr, "kernel_launch: grid %d (cus %d, per_cu %d), ws %zu\n", grid, cus, per_cu, ws_size);
    }
    if (grid < 0) return;
    Args a{};
    for (int i = 0; i < 26; ++i) a.in[i] = (const float*)d_in[i];
    a.out = (float*)d_out; a.ws = (unsigned char*)d_ws;
    if (hipMemsetAsync((char*)d_ws + WS_BAR, 0, XCD_BAR_WORDS * 4, stream) != hipSuccess) { fprintf(stderr, "kernel_launch: memset failed\n"); return; }
    void* args[] = {&a};
    hipError_t e = hipLaunchCooperativeKernel((const void*)fwd_mega, dim3(grid), dim3(512), args, LDS_BYTES, stream);
    if (e != hipSuccess) fprintf(stderr, "kernel_launch: cooperative launch failed: %s\n", hipGetErrorString(e));
}
```

```cpp
#include <hip/hip_runtime.h>
#include <hip/hip_cooperative_groups.h>
#include <cstdio>
#include <cstdint>
namespace cg = cooperative_groups;

#define LAS __attribute__((address_space(3)))
typedef unsigned short bf16_t;
typedef short bf16x8 __attribute__((ext_vector_type(8)));
typedef short bf16x4 __attribute__((ext_vector_type(4)));
typedef float f32x4 __attribute__((ext_vector_type(4)));
typedef float f32x2 __attribute__((ext_vector_type(2)));
typedef unsigned u32x4 __attribute__((ext_vector_type(4)));
typedef unsigned u32x2 __attribute__((ext_vector_type(2)));
typedef __bf16 nbf2 __attribute__((ext_vector_type(2)));

constexpr int D = 1024, NB = 8, T = 2048, MP = NB * T  , MS = 128, MR = MP + MS  , MALL = 16640  ;
constexpr int NCOLS = 12416, NP = 12544  ;
constexpr int O_K = 1024, O_V = 2048, O_GA = 4096, O_SH = 6144, O_GB = 9344, O_MA = 10368, O_MB = 11392;
constexpr int RH = 4, RDK = 256, RDV = 512, RCH = 128;
constexpr int WH = 16, WN = 64;
constexpr int PLE = 256;
constexpr float EPS = 1e-6f;
constexpr int REC = 12544;
constexpr int R_AT = 0, R_RT = 2048, R_BP = 4096, R_KP = 6144, R_VT = 8192, R_AAK = 10240, R_TT = 10752, R_ARB = 11264, R_ARK = 11776, R_WC = 12288;

constexpr size_t MiB = 1u << 20;
constexpr size_t WS_CTL = 0;
constexpr size_t WS_ROPE = 1 * MiB;
constexpr size_t WS_W2T = 4 * MiB, WS_A2T = WS_W2T + 131072;
constexpr size_t WS_WPLE = 5 * MiB, WS_WDB = 6 * MiB, WS_WOUT = 8 * MiB, WS_WGATE = 10 * MiB, WS_WDA = 12 * MiB, WS_WIN = 16 * MiB;
constexpr size_t WS_PB = 41 * MiB, WS_H = 50 * MiB  , WS_KT = 83 * MiB, WS_SQA = 115 * MiB, WS_BC = 117 * MiB, WS_OPSS = 119 * MiB  ;
constexpr size_t WS_OA = 122 * MiB, WS_P = 188 * MiB, WS_CH = 587 * MiB  , WS_OB = 786 * MiB  ;
constexpr size_t WS_T1 = WS_CH, WS_MG = WS_CH + 65 * MiB, WS_X1B = WS_CH + 98 * MiB, WS_GT = WS_CH + 131 * MiB, WS_X1 = WS_OB + 65 * MiB  ;
constexpr size_t WS_END = 916 * MiB;
constexpr size_t WS_BAR = 512 * 1024;
constexpr size_t WS_SQS1 = 640 * 1024, WS_SQS2 = 704 * 1024;
constexpr size_t WS_SQ1P = WS_KT, WS_SQ2P = WS_KT + 2 * MiB;

constexpr size_t OUT_Y = 0, OUT_RETP = 16908288, OUT_RWP = 21102592, OUT_SHP = 21626880, OUT_RETS = 21635072, OUT_RWS = 88743936, OUT_SHS = 97132544;

__device__ __forceinline__ unsigned pk2(float lo, float hi) { f32x2 v = {lo, hi}; nbf2 r = __builtin_convertvector(v, nbf2); return __builtin_bit_cast(unsigned, r); }
__device__ __forceinline__ unsigned short f2bf(float f) { return (unsigned short)(pk2(f, 0.f) & 0xffffu); }
__device__ __forceinline__ float bf2f(unsigned short b) { return __uint_as_float(((unsigned)b) << 16); }
__device__ __forceinline__ float bflo(unsigned w) { return __uint_as_float(w << 16); }
__device__ __forceinline__ float bfhi(unsigned w) { return __uint_as_float(w & 0xffff0000u); }
__device__ __forceinline__ float sigm(float x) { return __builtin_amdgcn_rcpf(1.f + __expf(-x)); }
__device__ __forceinline__ float silu_(float x) { return x * sigm(x); }
__device__ __forceinline__ float wave_sum(float v) {
#pragma unroll
    for (int o = 1; o < 64; o <<= 1) v += __shfl_xor(v, o);
    return v;
}
#define MFMA32(a, b, c) __builtin_amdgcn_mfma_f32_16x16x32_bf16((a), (b), (c), 0, 0, 0)
#define LDS_WAIT() asm volatile("s_waitcnt lgkmcnt(0)" ::: "memory")

namespace pg8 {
constexpr int BM = 256, BK = 64, HALF = 128, HTB = HALF * BK * 2, STAGE_BYTES = 8 * HTB, NXCD = 8, WGM = 8;
__host__ __device__ __forceinline__ int lds_byte(int r, int c) { const int st = (r >> 4) * 2 + (c >> 5), rr = r & 15, cc = c & 31, ob = rr * 64 + cc * 2; return st * 1024 + (ob ^ (((ob >> 9) & 1) << 5)); }
__host__ __device__ __forceinline__ void stage_rc(int b, int& R, int& C) { const int st = b / 1024, sb = b % 1024, swz = sb ^ (((sb >> 9) & 1) << 5); R = (st >> 1) * 16 + swz / 64; C = (st & 1) * 32 + (swz % 64) / 2; }
__host__ __device__ __forceinline__ int perm32(int rho) { const int n = rho >> 4, i = rho & 15; return 8 * (i >> 2) + 4 * n + (i & 3); }
struct Unit { int pm, pn; };
struct Gemm { const bf16_t* A; const bf16_t* Bt; int M, N, K; };
struct StaticOrder {
    int nM, nN, nwg, G, c;
    __host__ __device__ void init(int M, int N, int G_, int c_) { nM = M / BM; nN = N / BM; nwg = nM * nN; G = G_; c = c_; }
    __host__ __device__ bool next(int i, Unit& u) const {
        const long L = (long)i * G + c; if (L >= nwg) return false;
        int wgid = (int)L; { const int q = nwg / NXCD, r = nwg % NXCD, xcd = wgid % NXCD, off = wgid / NXCD; wgid = (xcd < r ? xcd * (q + 1) : r * (q + 1) + (xcd - r) * q) + off; }
        const int nig = WGM * nN, gid = wgid / nig, fm = gid * WGM, gsz = (nM - fm) < WGM ? (nM - fm) : WGM;
        u.pm = fm + ((wgid % nig) % gsz); u.pn = (wgid % nig) / gsz; return true;
    }
};
template <class Epi>
__device__ __forceinline__ void gemm_phase(LAS unsigned char* lds, const Gemm g, const StaticOrder& S, const Epi& E) {
    int tid = threadIdx.x; asm volatile("" : "+v"(tid));
    const int wid = __builtin_amdgcn_readfirstlane(tid >> 6), lane = tid & 63, wr = wid >> 2, wc = wid & 3, fr = lane & 15, fq = lane >> 4;
    const int K = g.K, nt = K / BK;
    unsigned voffA[2], voffB[2];
#pragma unroll
    for (int i = 0; i < 2; ++i) { int R, C; stage_rc(tid * 16 + i * 8192, R, C); const int Rb = Epi::PERM ? ((R & ~31) + perm32(R & 31)) : R;
        voffA[i] = (unsigned)(R * K + C) * 2u; voffB[i] = (unsigned)(Rb * K + C) * 2u; }
    const size_t kstep = (size_t)(BK * 2);
    const size_t hstep = (size_t)HALF * K * 2;
    const size_t tstep = 2 * hstep;
    const unsigned ldsw = (unsigned)wid * 1024u;
    const int aoff = lds_byte(wr * 64 + fr, fq * 8), boff = lds_byte(wc * 32 + fr, fq * 8);
#define PG8_SA(b, h) (((b) * 2 + (h)) * HTB)
#define PG8_SB(b, h) ((4 + (b) * 2 + (h)) * HTB)
#define PG8_STAGE(bufoff, gbase, voff) do { _Pragma("unroll") for (int _i = 0; _i < 2; ++_i) \
        __builtin_amdgcn_global_load_lds((const unsigned*)((const char*)(gbase) + (voff)[_i]), (LAS unsigned*)(lds + (bufoff) + ldsw + _i * 8192), 16, 0, 0); } while (0)
#define PG8_LDA(dst, b, h) do { _Pragma("unroll") for (int m = 0; m < 4; ++m) _Pragma("unroll") for (int k = 0; k < 2; ++k) dst[m][k] = *(const LAS bf16x8*)(lds + PG8_SA(b, h) + aoff + m * 2048 + k * 1024); } while (0)
#define PG8_LDB(dst, b, h) do { _Pragma("unroll") for (int n = 0; n < 2; ++n) _Pragma("unroll") for (int k = 0; k < 2; ++k) dst[n][k] = *(const LAS bf16x8*)(lds + PG8_SB(b, h) + boff + n * 2048 + k * 1024); } while (0)
#define PG8_MMA(ai, bj, At, Bt) do { __builtin_amdgcn_s_setprio(1); _Pragma("unroll") for (int m = 0; m < 4; ++m) _Pragma("unroll") for (int n = 0; n < 2; ++n) _Pragma("unroll") for (int k = 0; k < 2; ++k) \
        acc[ai][bj][m][n] = __builtin_amdgcn_mfma_f32_16x16x32_bf16(Bt[n][k], At[m][k], acc[ai][bj][m][n], 0, 0, 0); __builtin_amdgcn_s_setprio(0); } while (0)
#define PG8_WAIT_V(n) asm volatile("s_waitcnt vmcnt(" #n ")" ::: "memory")
#define PG8_WAIT_L(n) asm volatile("s_waitcnt lgkmcnt(" #n ")" ::: "memory")
#define PG8_BAR __builtin_amdgcn_s_barrier()
#define PG8_SCHED __builtin_amdgcn_sched_barrier(0)
    Unit cur, nxt; int ui = 0;
    if (!S.next(0, cur)) return;
    f32x4 acc[2][2][4][2];
#pragma unroll
    for (int a = 0; a < 2; ++a)
#pragma unroll
        for (int b = 0; b < 2; ++b)
#pragma unroll
            for (int m = 0; m < 4; ++m)
#pragma unroll
                for (int n = 0; n < 2; ++n) acc[a][b][m][n] = (f32x4){0.f, 0.f, 0.f, 0.f};
    bf16x8 At[4][2], B0[2][2], B1[2][2];
    const char* cA = (const char*)g.A + (size_t)cur.pm * tstep; const char* cB = (const char*)g.Bt + (size_t)cur.pn * tstep;
    PG8_STAGE(PG8_SB(0, 0), cB, voffB); PG8_STAGE(PG8_SA(0, 0), cA, voffA); PG8_STAGE(PG8_SB(0, 1), cB + hstep, voffB); PG8_STAGE(PG8_SA(0, 1), cA + hstep, voffA);
    if (wr == 1) PG8_BAR;
    PG8_WAIT_V(4); PG8_BAR;
    PG8_STAGE(PG8_SB(1, 0), cB + kstep, voffB); PG8_STAGE(PG8_SA(1, 0), cA + kstep, voffA); PG8_STAGE(PG8_SB(1, 1), cB + hstep + kstep, voffB);
    PG8_WAIT_V(6); PG8_BAR;
    for (;;) {
        const bool has_next = S.next(ui + 1, nxt);
        const char* nA = has_next ? (const char*)g.A + (size_t)nxt.pm * tstep : cA; const char* nB = has_next ? (const char*)g.Bt + (size_t)nxt.pn * tstep : cB;
#pragma unroll 1
        for (int t = 0; t < nt; t += 2) {
            const bool last = (t == nt - 2);
            const char* a1 = cA + (size_t)(t + 1) * kstep;
            const char* a2 = last ? nA : cA + (size_t)(t + 2) * kstep; const char* b2 = last ? nB : cB + (size_t)(t + 2) * kstep;
            const char* a3 = a2 + kstep; const char* b3 = b2 + kstep;
            PG8_LDB(B0, 0, 0); PG8_SCHED; PG8_LDA(At, 0, 0); PG8_STAGE(PG8_SA(1, 1), a1 + hstep, voffA);
            PG8_WAIT_L(8); PG8_BAR; PG8_WAIT_L(0); PG8_MMA(0, 0, At, B0); PG8_BAR; PG8_SCHED;
            PG8_LDB(B1, 0, 1); PG8_STAGE(PG8_SB(0, 0), b2, voffB);
            PG8_BAR; PG8_WAIT_L(0); PG8_MMA(0, 1, At, B1); PG8_BAR;
            PG8_LDA(At, 0, 1); PG8_STAGE(PG8_SA(0, 0), a2, voffA);
            PG8_BAR; PG8_WAIT_L(0); PG8_MMA(1, 0, At, B0); PG8_BAR; PG8_SCHED;
            PG8_STAGE(PG8_SB(0, 1), b2 + hstep, voffB);
            PG8_WAIT_V(6); PG8_BAR; PG8_MMA(1, 1, At, B1); PG8_BAR;
            PG8_LDB(B0, 1, 0); PG8_SCHED; PG8_LDA(At, 1, 0); PG8_STAGE(PG8_SA(0, 1), a2 + hstep, voffA);
            PG8_WAIT_L(8); PG8_BAR; PG8_WAIT_L(0); PG8_MMA(0, 0, At, B0); PG8_BAR; PG8_SCHED;
            PG8_LDB(B1, 1, 1); PG8_STAGE(PG8_SB(1, 0), b3, voffB);
            PG8_BAR; PG8_WAIT_L(0); PG8_MMA(0, 1, At, B1); PG8_BAR;
            PG8_LDA(At, 1, 1); PG8_STAGE(PG8_SA(1, 0), a3, voffA);
            PG8_BAR; PG8_WAIT_L(0); PG8_MMA(1, 0, At, B0); PG8_BAR; PG8_SCHED;
            PG8_STAGE(PG8_SB(1, 1), b3 + hstep, voffB);
            PG8_WAIT_V(6); PG8_BAR; PG8_MMA(1, 1, At, B1); PG8_BAR;
        }
        E(acc, cur, wr, wc, fr, fq);
        if (!has_next) break;
#pragma unroll
        for (int a = 0; a < 2; ++a)
#pragma unroll
            for (int b = 0; b < 2; ++b)
#pragma unroll
                for (int m = 0; m < 4; ++m)
#pragma unroll
                    for (int n = 0; n < 2; ++n) acc[a][b][m][n] = (f32x4){0.f, 0.f, 0.f, 0.f};
        cur = nxt; cA = nA; cB = nB; ++ui;
    }
    PG8_WAIT_V(0);
    if (wr == 0) PG8_BAR;
    PG8_BAR;
#undef PG8_SA
#undef PG8_SB
#undef PG8_STAGE
#undef PG8_LDA
#undef PG8_LDB
#undef PG8_MMA
#undef PG8_WAIT_V
#undef PG8_WAIT_L
#undef PG8_BAR
#undef PG8_SCHED
}
}
using pg8::Unit;

struct Args {
    const float* in[26];
    float* out; unsigned char* ws;
};
#define KAS __attribute__((address_space(4)))
__device__ __forceinline__ const KAS char* kargp() { const KAS char* p = (const KAS char*)__builtin_amdgcn_kernarg_segment_ptr(); asm volatile("" : "+s"(p)); return p; }


enum { I_XP = 0, I_XS, I_SRET, I_SRW, I_SSH, I_PP, I_PS, I_NG, I_WIN, I_MU, I_W0, I_W2, I_A0, I_A2, I_KK, I_KA, I_RK, I_LNW, I_LNB, I_WDA, I_WDB, I_WOUT, I_WPLE, I_PNG, I_WPG, I_FNG };

__device__ __forceinline__ void p0_transpose_item(const float* W, int K, int N, bf16_t* WT, LAS float* scr, int item, int lane, const float* kscale) {
    const int nblk = N / 32, kb = item / nblk, nb = item % nblk, k0 = 64 * kb, n0 = 32 * nb;
#pragma unroll 8
    for (int i = 0; i < 32; ++i) { const int kk = 2 * i + (lane >> 5); float v = W[(size_t)(k0 + kk) * N + n0 + (lane & 31)]; if (kscale) v *= kscale[k0 + kk]; scr[kk * 33 + (lane & 31)] = v; }
    LDS_WAIT();
    const int c = lane & 7;
#pragma unroll
    for (int j = 0; j < 4; ++j) { const int n = (lane >> 3) + 8 * j; const LAS float* s = scr + (8 * c) * 33 + n;
        u32x4 o; o.x = pk2(s[0 * 33], s[1 * 33]); o.y = pk2(s[2 * 33], s[3 * 33]); o.z = pk2(s[4 * 33], s[5 * 33]); o.w = pk2(s[6 * 33], s[7 * 33]);
        *(u32x4*)(WT + (size_t)(n0 + n) * K + k0 + 8 * c) = o; }
    LDS_WAIT();
}

__device__ __forceinline__ void phase0(const Args& a, LAS unsigned char* lds, int gw, int NGW, int wave, int lane) {
    unsigned char* ws = a.ws;
    LAS float* scr = (LAS float*)(lds + wave * 16384);
    constexpr int I_IN = (D / 64) * (NCOLS / 32), I_DA = (2048 / 64) * (D / 32), I_SQ = (D / 64) * (D / 32), I_PL = (PLE / 64) * (D / 32), I_LR = 1 * (D / 32);
    constexpr int NITEMS = I_IN + I_DA + 3 * I_SQ + I_PL + 2 * I_LR;
    for (int it = gw; it < NITEMS; it += NGW) {
        int r = it;
        if (r < I_IN) { p0_transpose_item(a.in[I_WIN], D, NCOLS, (bf16_t*)(ws + WS_WIN), scr, r, lane, nullptr); continue; } r -= I_IN;
        if (r < I_DA) { p0_transpose_item(a.in[I_WDA], 2048, D, (bf16_t*)(ws + WS_WDA), scr, r, lane, nullptr); continue; } r -= I_DA;
        if (r < I_SQ) { p0_transpose_item(a.in[I_WDB], D, D, (bf16_t*)(ws + WS_WDB), scr, r, lane, nullptr); continue; } r -= I_SQ;
        if (r < I_SQ) { p0_transpose_item(a.in[I_WOUT], D, D, (bf16_t*)(ws + WS_WOUT), scr, r, lane, nullptr); continue; } r -= I_SQ;
        if (r < I_SQ) { p0_transpose_item(a.in[I_WPG], D, D, (bf16_t*)(ws + WS_WGATE), scr, r, lane, a.in[I_PNG]); continue; } r -= I_SQ;
        if (r < I_PL) { p0_transpose_item(a.in[I_WPLE], PLE, D, (bf16_t*)(ws + WS_WPLE), scr, r, lane, nullptr); continue; } r -= I_PL;
        if (r < I_LR) { p0_transpose_item(a.in[I_W2], 64, D, (bf16_t*)(ws + WS_W2T), scr, r, lane, nullptr); continue; } r -= I_LR;
        p0_transpose_item(a.in[I_A2], 64, D, (bf16_t*)(ws + WS_A2T), scr, r, lane, nullptr);
    }
    for (int i = gw * 64 + lane; i < 128 * D / 8; i += NGW * 64) ((u32x4*)(ws + WS_WIN + (size_t)NCOLS * D * 2))[i] = (u32x4){0u, 0u, 0u, 0u};
    bf16_t* H = (bf16_t*)(ws + WS_H);
    const float* ng = a.in[I_NG];
    for (int m = gw; m < MALL; m += NGW) {
        if (m < MR) {
            const float* xr = (m < MP) ? a.in[I_XP] + (size_t)m * D : a.in[I_XS] + (size_t)(m - MP) * D;
            f32x4 v[4]; float s = 0.f;
#pragma unroll
            for (int j = 0; j < 4; ++j) { v[j] = ((const f32x4*)xr)[lane + 64 * j]; s += (v[j].x * v[j].x + v[j].y * v[j].y) + (v[j].z * v[j].z + v[j].w * v[j].w); }
            const float rs = 1.0f / sqrtf(wave_sum(s) * (1.f / D) + EPS);
            float* so = nullptr;
            if (m < MP) { if ((m & (T - 1)) == T - 1) so = a.out + OUT_SHP + (size_t)(m >> 11) * D; } else so = a.out + OUT_SHS + (size_t)(m - MP) * D;
#pragma unroll
            for (int j = 0; j < 4; ++j) { const f32x4 gg = ((const f32x4*)ng)[lane + 64 * j]; f32x4 h = v[j] * rs * gg;
                if (so) ((f32x4*)so)[lane + 64 * j] = h;
                u32x2 o; o.x = pk2(h.x, h.y); o.y = pk2(h.z, h.w); ((u32x2*)(H + (size_t)m * D))[lane + 64 * j] = o; }
        } else {
            const float* xr = a.in[I_SSH] + (size_t)(m - MR) * D;
#pragma unroll
            for (int j = 0; j < 4; ++j) { const f32x4 h = ((const f32x4*)xr)[lane + 64 * j]; u32x2 o; o.x = pk2(h.x, h.y); o.y = pk2(h.z, h.w); ((u32x2*)(H + (size_t)m * D))[lane + 64 * j] = o; }
        }
        u32x2 o = {0u, 0u};
        if (m < MR) { const float* pr = (m < MP) ? a.in[I_PP] + (size_t)m * PLE : a.in[I_PS] + (size_t)(m - MP) * PLE; const f32x4 p = ((const f32x4*)pr)[lane]; o.x = pk2(p.x, p.y); o.y = pk2(p.z, p.w); }
        ((u32x2*)(ws + WS_PB + (size_t)m * PLE * 2))[lane] = o;
    }
    for (int i = gw * 64 + lane; i < 2049 * 128; i += NGW * 64) {
        const int pos = i >> 7, j = i & 127; const double p = (pos == 2048) ? 16384.0 : (double)pos;
        double inv = 1.0, base = 0.9305720409296989; int e = j;
        while (e) { if (e & 1) inv *= base; base *= base; e >>= 1; }
        double rev = p * inv * 0.15915494309189535; rev -= floor(rev);
        const float fr = (float)rev;
        ((f32x2*)(ws + WS_ROPE))[i] = (f32x2){__builtin_amdgcn_cosf(fr), __builtin_amdgcn_sinf(fr)};
    }
    for (int i = gw * 64 + lane; i < 65536 + 64; i += NGW * 64) ((float*)(ws + WS_CTL))[i] = 0.f;
}

struct EpiP {
    static constexpr bool PERM = true;
    bf16_t* P; bf16_t* KT; const f32x2* rope;
    __device__ __forceinline__ void operator()(const f32x4 (&acc)[2][2][4][2], const Unit& u, int wr, int wc, int fr, int fq) const {
        const int pn = u.pn, pm = u.pm;
        const int row0 = pm * 256 + wr * 64 + fr, cl0 = wc * 32 + 8 * fq;
        const bool sample = (pm == 64);
        if (pn < 8) {
            const int h = pn & 3; const bool isk = pn >= 4;
            const float l2g = __log2f(1.f - exp2f(-5.f - (float)h));
#pragma unroll
            for (int ai = 0; ai < 2; ++ai)
#pragma unroll
                for (int m = 0; m < 4; ++m) {
                    const int row = row0 + ai * 128 + m * 16;
                    int pos, ex;
                    if (sample) { pos = 2048; ex = isk ? 0 : 1; } else { pos = row & (T - 1); const int idx = pos & 127; ex = isk ? 127 - idx : idx + 1; }
                    const float sc = exp2f((float)ex * l2g) * (isk ? 0.0625f : 1.0f);
                    const f32x4* rp = (const f32x4*)(rope + pos * 128 + cl0);
                    f32x4 cs[4]; cs[0] = rp[0]; cs[1] = rp[1]; cs[2] = rp[2]; cs[3] = rp[3];
                    float y1[8], y2[8];
#pragma unroll
                    for (int n = 0; n < 2; ++n)
#pragma unroll
                        for (int e = 0; e < 4; ++e) {
                            const float c = (e & 1) ? cs[n * 2 + (e >> 1)].z : cs[n * 2 + (e >> 1)].x, s = (e & 1) ? cs[n * 2 + (e >> 1)].w : cs[n * 2 + (e >> 1)].y;
                            const float x1 = acc[ai][0][m][n][e], x2 = acc[ai][1][m][n][e];
                            y1[n * 4 + e] = (x1 * c - x2 * s) * sc; y2[n * 4 + e] = (x2 * c + x1 * s) * sc;
                        }
                    u32x4 w1, w2;
                    w1.x = pk2(y1[0], y1[1]); w1.y = pk2(y1[2], y1[3]); w1.z = pk2(y1[4], y1[5]); w1.w = pk2(y1[6], y1[7]);
                    w2.x = pk2(y2[0], y2[1]); w2.y = pk2(y2[2], y2[3]); w2.z = pk2(y2[4], y2[5]); w2.w = pk2(y2[6], y2[7]);
                    bf16_t* rowp = P + (size_t)row * NP + pn * 256 + cl0;
                    *(u32x4*)rowp = w1; *(u32x4*)(rowp + 128) = w2;
                    if (isk && !sample) {
                        bf16_t* kt = KT + ((size_t)((row >> 11) * 4 + h) * 256 + cl0) * T + pos;
#pragma unroll
                        for (int j = 0; j < 8; ++j) { kt[(size_t)j * T] = f2bf(y1[j]); kt[(size_t)(j + 128) * T] = f2bf(y2[j]); }
                    }
                }
            return;
        }
#pragma unroll
        for (int bj = 0; bj < 2; ++bj) {
            const int cb = pn * 2 + bj;
            if (cb >= 97) continue;
            const int mode = 0;
            const bool vt = (cb < 32) && !sample;
#pragma unroll
            for (int ai = 0; ai < 2; ++ai)
#pragma unroll
                for (int m = 0; m < 4; ++m) {
                    const int row = row0 + ai * 128 + m * 16;
                    float y[8];
#pragma unroll
                    for (int n = 0; n < 2; ++n)
#pragma unroll
                        for (int e = 0; e < 4; ++e) { float x = acc[ai][bj][m][n][e]; if (mode == 1) x = x * sigm(x); else if (mode == 2) x = sigm(x); y[n * 4 + e] = x; }
                    if (vt) {
                        const int hd = cb * 128 + cl0 - O_V;
                        bf16_t* vp = P + ((size_t)(row >> 11) * T + hd) * NP + O_V + (row & (T - 1));
#pragma unroll
                        for (int j = 0; j < 8; ++j) vp[(size_t)j * NP] = f2bf(y[j]);
                    } else {
                        u32x4 w; w.x = pk2(y[0], y[1]); w.y = pk2(y[2], y[3]); w.z = pk2(y[4], y[5]); w.w = pk2(y[6], y[7]);
                        *(u32x4*)(P + (size_t)row * NP + cb * 128 + cl0) = w;
                    }
                }
        }
    }
};

__device__ __forceinline__ float lerp_bf(const bf16_t* cur, const bf16_t* prv, float mu) { const float c = bf2f(*cur); const float p = bf2f(*prv); return c + (p - c) * mu; }

__device__ __forceinline__ void rw_prep_item(const Args& a, LAS unsigned char* wl  , int tt, int h, int lane) {
    unsigned char* ws = a.ws;
    const bf16_t* P = (const bf16_t*)(ws + WS_P);
    const int l15 = lane & 15, quad = lane >> 4;
    const bool sample = tt >= 1024;
    const int row_base = sample ? MP + (tt - 1024) * 16 : tt * 16;
    const float* mu = a.in[I_MU];
    bf16x8 Aw[2], Aa[2];
    {
        const int m = row_base + l15;
        const bf16_t* cur = P + (size_t)m * NP + O_SH;
        const bf16_t* zrow = (const bf16_t*)(ws + WS_WIN + (size_t)NCOLS * D * 2);
        const bf16_t* prv = sample ? P + (size_t)(m + MS) * NP + O_SH : ((m & (T - 1)) ? cur - NP : zrow + O_SH);
#pragma unroll
        for (int which = 0; which < 2; ++which)
#pragma unroll
            for (int ks = 0; ks < 2; ++ks) {
                const int col = 3072 + which * 64 + ks * 32 + quad * 8;
                const u32x4 cw = *(const u32x4*)(cur + col); const u32x4 pw = *(const u32x4*)(prv + col);
                const f32x4 m0 = *(const f32x4*)(mu + col), m1 = *(const f32x4*)(mu + col + 4);
                float z[8];
                const unsigned cws[4] = {cw.x, cw.y, cw.z, cw.w}, pws[4] = {pw.x, pw.y, pw.z, pw.w};
#pragma unroll
                for (int j = 0; j < 4; ++j) {
                    const float c0 = bflo(cws[j]), c1 = bfhi(cws[j]), p0 = bflo(pws[j]), p1 = bfhi(pws[j]);
                    const float mm0 = (j < 2) ? m0[2 * j] : m1[2 * j - 4], mm1 = (j < 2) ? m0[2 * j + 1] : m1[2 * j - 3];
                    z[2 * j] = c0 + (p0 - c0) * mm0; z[2 * j + 1] = c1 + (p1 - c1) * mm1;
                }
                if (which == 0) {
#pragma unroll
                    for (int j = 0; j < 8; ++j) z[j] = 1.f - 2.f / (__expf(2.f * z[j]) + 1.f);
                }
                u32x4 o; o.x = pk2(z[0], z[1]); o.y = pk2(z[2], z[3]); o.z = pk2(z[4], z[5]); o.w = pk2(z[6], z[7]);
                if (which == 0) Aw[ks] = __builtin_bit_cast(bf16x8, o); else Aa[ks] = __builtin_bit_cast(bf16x8, o);
            }
    }
    const bf16_t* W2T = (const bf16_t*)(ws + WS_W2T); const bf16_t* A2T = (const bf16_t*)(ws + WS_A2T);
    unsigned char* rec = ws + WS_CH + ((size_t)((tt >> 7) * 16 + h) * 128 + (tt & 127)) * REC;
    LAS bf16_t* LA = (LAS bf16_t*)wl;
    LAS bf16_t* LR = LA + 16 * 72;
    LAS bf16_t* LB = LR + 16 * 72;
    LAS bf16_t* LK = LB + 16 * 72;
    LAS float* LN = (LAS float*)(wl + 9216);
    float tA[4][4], tBi[4][4], tBp[4][4];
    float ssq[4] = {0.f, 0.f, 0.f, 0.f}, bon[4] = {0.f, 0.f, 0.f, 0.f};
#pragma unroll
    for (int nt = 0; nt < 4; ++nt) {
        const int ch = h * 64 + nt * 16 + l15, cc = nt * 16 + l15;
        f32x4 cw = {0.f, 0.f, 0.f, 0.f}, ca = {0.f, 0.f, 0.f, 0.f};
#pragma unroll
        for (int ks = 0; ks < 2; ++ks) {
            const bf16x8 bw = *(const bf16x8*)(W2T + (size_t)ch * 64 + ks * 32 + quad * 8), ba = *(const bf16x8*)(A2T + (size_t)ch * 64 + ks * 32 + quad * 8);
            cw = MFMA32(Aw[ks], bw, cw); ca = MFMA32(Aa[ks], ba, ca);
        }
        const float w0 = a.in[I_W0][ch], a0 = a.in[I_A0][ch], k_k = a.in[I_KK][ch], k_a = a.in[I_KA][ch], r_k = a.in[I_RK][ch];
        const float mur = mu[ch], muk = mu[1024 + ch], muv = mu[2048 + ch];
        float lw[4], rr[4], kq[4], vv[4], aa4[4], kr4[4];
#pragma unroll
        for (int r = 0; r < 4; ++r) {
            const int m = row_base + quad * 4 + r;
            const bf16_t* cur = P + (size_t)m * NP + O_SH + ch;
            const bf16_t* prv = sample ? P + (size_t)(m + MS) * NP + O_SH + ch : ((m & (T - 1)) ? cur - NP : (const bf16_t*)(ws + WS_WIN + (size_t)NCOLS * D * 2) + O_SH + ch);
            const float r_ = lerp_bf(cur, prv, mur), k_ = lerp_bf(cur + 1024, prv + 1024, muk), v_ = lerp_bf(cur + 2048, prv + 2048, muv);
            lw[r] = -0.6065306597126334f * sigm(w0 + cw[r]);
            const float aa = sigm(a0 + ca[r]); aa4[r] = aa;
            const float kr = k_ * k_k; kr4[r] = kr; ssq[r] += kr * kr;
            const float kpp = k_ * (1.f + (aa - 1.f) * k_a); kq[r] = kpp;
            rr[r] = r_; vv[r] = v_; bon[r] += r_ * kpp * r_k;
        }
        if (sample) {
#pragma unroll
            for (int r = 0; r < 4; ++r) {
                const int i = (tt - 1024) * 16 + quad * 4 + r;
                float* o = (float*)(ws + WS_OPSS) + ((size_t)(i * 16 + h) * 6) * 64 + cc;
                o[0] = rr[r]; o[64] = __expf(lw[r]); o[128] = kq[r]; o[320] = vv[r];
                tA[nt][r] = kr4[r]; tBi[nt][r] = aa4[r] * kr4[r]; tBp[nt][r] = 0.f;
            }
        } else {
            float c[4]; c[0] = lw[0]; c[1] = c[0] + lw[1]; c[2] = c[1] + lw[2]; c[3] = c[2] + lw[3];
            const float tot = c[3];
            const float s1 = __shfl(tot, (lane - 16) & 63), s2 = __shfl(tot, (lane - 32) & 63), s3 = __shfl(tot, (lane - 48) & 63);
            const float off = (quad >= 1 ? s1 : 0.f) + (quad >= 2 ? s2 : 0.f) + (quad >= 3 ? s3 : 0.f);
            const float total = __shfl(c[3] + off, 48 + l15);
            float kqp[4];
#pragma unroll
            for (int r = 0; r < 4; ++r) {
                const float cum = c[r] + off, cumx = cum - lw[r];
                const float ea = __expf(cumx), er = __expf(cum), ei = __expf(-cum), ep = __expf(total - cum);
                const int tk = quad * 4 + r;
                LR[tk * 72 + cc] = f2bf(rr[r] * er); LK[tk * 72 + cc] = f2bf(kq[r] * ei);
                kqp[r] = kq[r] * ep;
                tA[nt][r] = kr4[r] * ea; tBi[nt][r] = aa4[r] * kr4[r] * ei; tBp[nt][r] = aa4[r] * kr4[r] * ep;
            }
            *(u32x2*)(rec + R_KP + cc * 32 + quad * 8) = (u32x2){pk2(kqp[0], kqp[1]), pk2(kqp[2], kqp[3])};
            *(u32x2*)(rec + R_VT + cc * 32 + quad * 8) = (u32x2){pk2(vv[0], vv[1]), pk2(vv[2], vv[3])};
            if (quad == 0) *(float*)(rec + R_WC + cc * 4) = __expf(total);
        }
        asm volatile("" ::: "memory");
    }
    float inv[4];
#pragma unroll
    for (int r = 0; r < 4; ++r) {
        float s = ssq[r], b = bon[r];
#pragma unroll
        for (int o = 1; o < 16; o <<= 1) { s += __shfl_xor(s, o); b += __shfl_xor(b, o); }
        inv[r] = 1.f / fmaxf(sqrtf(s), 1e-12f);
        if (l15 == 0) ((float*)(ws + WS_BC))[(size_t)(row_base + quad * 4 + r) * 16 + h] = b;
    }
    if (sample) {
#pragma unroll
        for (int nt = 0; nt < 4; ++nt)
#pragma unroll
            for (int r = 0; r < 4; ++r) {
                const int i = (tt - 1024) * 16 + quad * 4 + r;
                float* o = (float*)(ws + WS_OPSS) + ((size_t)(i * 16 + h) * 6) * 64 + nt * 16 + l15;
                o[192] = tA[nt][r] * inv[r]; o[256] = tBi[nt][r] * inv[r];
            }
        return;
    }
#pragma unroll
    for (int nt = 0; nt < 4; ++nt) {
        const int cc = nt * 16 + l15;
        float bp[4];
#pragma unroll
        for (int r = 0; r < 4; ++r) { const int tk = quad * 4 + r;
            LA[tk * 72 + cc] = f2bf(-tA[nt][r] * inv[r]); LB[tk * 72 + cc] = f2bf(tBi[nt][r] * inv[r]); bp[r] = tBp[nt][r] * inv[r]; }
        *(u32x2*)(rec + R_BP + cc * 32 + quad * 8) = (u32x2){pk2(bp[0], bp[1]), pk2(bp[2], bp[3])};
    }
    LDS_WAIT();
#pragma unroll
    for (int i = 0; i < 2; ++i) { const int idx = lane + 64 * i, rr = idx >> 3, c8 = (idx & 7) * 8;
        *(u32x4*)(rec + R_AT + rr * 128 + c8 * 2) = *(const LAS u32x4*)(LA + rr * 72 + c8);
        *(u32x4*)(rec + R_RT + rr * 128 + c8 * 2) = *(const LAS u32x4*)(LR + rr * 72 + c8); }
    f32x4 nab = {0.f, 0.f, 0.f, 0.f}, nak = nab, nrb = nab, nrk = nab;
#pragma unroll
    for (int ks = 0; ks < 2; ++ks) {
        const bf16x8 fa = *(const LAS bf16x8*)(LA + l15 * 72 + ks * 32 + quad * 8), fr_ = *(const LAS bf16x8*)(LR + l15 * 72 + ks * 32 + quad * 8);
        const bf16x8 fb = *(const LAS bf16x8*)(LB + l15 * 72 + ks * 32 + quad * 8), fk = *(const LAS bf16x8*)(LK + l15 * 72 + ks * 32 + quad * 8);
        nab = MFMA32(fa, fb, nab); nak = MFMA32(fa, fk, nak); nrb = MFMA32(fr_, fb, nrb); nrk = MFMA32(fr_, fk, nrk);
    }
#pragma unroll
    for (int r = 0; r < 4; ++r) {
        const int t = quad * 4 + r, j = l15;
        const float vab = (j < t) ? nab[r] : 0.f, vak = (j < t) ? nak[r] : 0.f, vrb = (j <= t) ? nrb[r] : 0.f, vrk = (j <= t) ? nrk[r] : 0.f;
        LN[t * 16 + j] = vab;
        *(bf16_t*)(rec + R_AAK + (t * 16 + j) * 2) = f2bf(vak);
        *(bf16_t*)(rec + R_ARB + (t * 16 + j) * 2) = f2bf(vrb);
        *(bf16_t*)(rec + R_ARK + (t * 16 + j) * 2) = f2bf(vrk);
    }
    LDS_WAIT();
    if (lane < 16) {
        float tc[16];
#pragma unroll
        for (int t = 0; t < 16; ++t) {
            float s = (t == lane) ? 1.f : 0.f;
#pragma unroll
            for (int j = 0; j < t; ++j) s += LN[t * 16 + j] * tc[j];
            tc[t] = s;
            *(bf16_t*)(rec + R_TT + (t * 16 + lane) * 2) = f2bf(s);
        }
    }
    LDS_WAIT();
}

__device__ __forceinline__ bf16x8 k16(u32x2 v) { const u32x4 w = {v.x, v.y, 0u, 0u}; return __builtin_bit_cast(bf16x8, w); }
#define SCAN_DECL(F) bf16x8 F##_at0, F##_at1, F##_rt0, F##_rt1; u32x2 F##_aak, F##_tt, F##_arb, F##_ark, F##_vt, F##_bp0, F##_bp1, F##_bp2, F##_bp3, F##_kp0, F##_kp1, F##_kp2, F##_kp3; float F##_wc0, F##_wc1, F##_wc2, F##_wc3
#define SCAN_LOAD(F, REC_) do { const unsigned char* rec_ = (REC_); \
    F##_at0 = *(const bf16x8*)(rec_ + R_AT + o_nat); F##_at1 = *(const bf16x8*)(rec_ + R_AT + o_nat + 64); \
    F##_rt0 = *(const bf16x8*)(rec_ + R_RT + o_nat); F##_rt1 = *(const bf16x8*)(rec_ + R_RT + o_nat + 64); \
    F##_aak = *(const u32x2*)(rec_ + R_AAK + o_sm); F##_tt = *(const u32x2*)(rec_ + R_TT + o_sm); F##_arb = *(const u32x2*)(rec_ + R_ARB + o_sm); F##_ark = *(const u32x2*)(rec_ + R_ARK + o_sm); \
    F##_vt = *(const u32x2*)(rec_ + R_VT + vt * 512 + o_sm); \
    F##_bp0 = *(const u32x2*)(rec_ + R_BP + o_sm); F##_bp1 = *(const u32x2*)(rec_ + R_BP + 512 + o_sm); F##_bp2 = *(const u32x2*)(rec_ + R_BP + 1024 + o_sm); F##_bp3 = *(const u32x2*)(rec_ + R_BP + 1536 + o_sm); \
    F##_kp0 = *(const u32x2*)(rec_ + R_KP + o_sm); F##_kp1 = *(const u32x2*)(rec_ + R_KP + 512 + o_sm); F##_kp2 = *(const u32x2*)(rec_ + R_KP + 1024 + o_sm); F##_kp3 = *(const u32x2*)(rec_ + R_KP + 1536 + o_sm); \
    F##_wc0 = *(const float*)(rec_ + R_WC + l15 * 4); F##_wc1 = *(const float*)(rec_ + R_WC + 64 + l15 * 4); F##_wc2 = *(const float*)(rec_ + R_WC + 128 + l15 * 4); F##_wc3 = *(const float*)(rec_ + R_WC + 192 + l15 * 4); } while (0)
#define SCAN_UPD(NT, BP, KP, WC) do { f32x4 sn = S##NT * (WC); sn = MFMA32(ua, k16(BP), sn); sn = MFMA32(vtf, k16(KP), sn); S##NT = sn; \
    _Pragma("unroll") for (int r = 0; r < 4; ++r) Sb[(quad * 4 + r) * 72 + NT * 16 + l15] = f2bf(sn[r]); } while (0)
#define SCAN_STEP(F, N, CH) do { const int ch_ = (CH); \
    SCAN_LOAD(N, rec0 + (size_t)(ch_ < 126 ? ch_ + 2 : 127) * REC); \
    const bf16x8 sa0 = *(const LAS bf16x8*)(Sb + l15 * 72 + quad * 8), sa1 = *(const LAS bf16x8*)(Sb + l15 * 72 + 32 + quad * 8); \
    const bf16x8 vtf = k16(F##_vt); const f32x4 z = {0.f, 0.f, 0.f, 0.f}; \
    f32x4 Y = MFMA32(sa0, F##_at0, z); Y = MFMA32(sa1, F##_at1, Y); Y = MFMA32(vtf, k16(F##_aak), Y); \
    _Pragma("unroll") for (int r = 0; r < 4; ++r) Yb[(quad * 4 + r) * 16 + l15] = f2bf(Y[r]); \
    LDS_WAIT(); \
    const bf16x8 ya = k16(*(const LAS u32x2*)(Yb + l15 * 16 + quad * 4)); \
    f32x4 U = MFMA32(ya, k16(F##_tt), z); \
    _Pragma("unroll") for (int r = 0; r < 4; ++r) Ub[(quad * 4 + r) * 16 + l15] = f2bf(U[r]); \
    LDS_WAIT(); \
    const bf16x8 ua = k16(*(const LAS u32x2*)(Ub + l15 * 16 + quad * 4)); \
    f32x4 O = MFMA32(sa0, F##_rt0, z); O = MFMA32(sa1, F##_rt1, O); O = MFMA32(ua, k16(F##_arb), O); O = MFMA32(vtf, k16(F##_ark), O); \
    *(u32x2*)(ob + (size_t)(ch_ * 16 + l15) * D) = (u32x2){pk2(O[0], O[1]), pk2(O[2], O[3])}; \
    SCAN_UPD(0, F##_bp0, F##_kp0, F##_wc0); SCAN_UPD(1, F##_bp1, F##_kp1, F##_wc1); SCAN_UPD(2, F##_bp2, F##_kp2, F##_wc2); SCAN_UPD(3, F##_bp3, F##_kp3, F##_wc3); \
    LDS_WAIT(); __builtin_amdgcn_sched_barrier(0); } while (0)
__device__ __forceinline__ void rw_scan_task(const Args& a, LAS unsigned char* wl  , int b, int h, int vt, int lane) {
    unsigned char* ws = a.ws;
    const int l15 = lane & 15, quad = lane >> 4;
    LAS bf16_t* Sb = (LAS bf16_t*)wl;
    LAS bf16_t* Yb = (LAS bf16_t*)(wl + 2304);
    LAS bf16_t* Ub = (LAS bf16_t*)(wl + 2304 + 512);
    const int o_nat = l15 * 128 + quad * 16, o_sm = l15 * 32 + quad * 8;
    const unsigned char* rec0 = ws + WS_CH + (size_t)((b * 16 + h) * 128) * REC;
    bf16_t* ob = (bf16_t*)(ws + WS_OB) + (size_t)(b * T) * D + h * 64 + vt * 16 + quad * 4;
    f32x4 S0 = {0.f, 0.f, 0.f, 0.f}, S1 = S0, S2 = S0, S3 = S0;
#pragma unroll
    for (int nt = 0; nt < 4; ++nt)
#pragma unroll
        for (int r = 0; r < 4; ++r) Sb[(quad * 4 + r) * 72 + nt * 16 + l15] = 0;
    LDS_WAIT();
    SCAN_DECL(f0); SCAN_DECL(f1); SCAN_DECL(f2);
    SCAN_LOAD(f0, rec0); SCAN_LOAD(f1, rec0 + REC);
    for (int ch = 0; ch < 126; ch += 3) { SCAN_STEP(f0, f2, ch); SCAN_STEP(f1, f0, ch + 1); SCAN_STEP(f2, f1, ch + 2); }
    SCAN_STEP(f0, f2, 126); SCAN_STEP(f1, f0, 127);
    float* so = a.out + OUT_RWP + (size_t)((b * 16 + h) * 64 + vt * 16) * 64;
#pragma unroll
    for (int r = 0; r < 4; ++r) { so[(quad * 4 + r) * 64 + l15] = S0[r]; so[(quad * 4 + r) * 64 + 16 + l15] = S1[r]; so[(quad * 4 + r) * 64 + 32 + l15] = S2[r]; so[(quad * 4 + r) * 64 + 48 + l15] = S3[r]; }
}

__device__ __forceinline__ void rw_sample_wave(const Args& a, int i, int h, int lane) {
    unsigned char* ws = a.ws;
    const float* s0 = a.in[I_SRW] + ((size_t)(i * 16 + h) * 64 + lane) * 64;
    const float* op = (const float*)(ws + WS_OPSS) + (size_t)(i * 16 + h) * 6 * 64;
    float s[64];
#pragma unroll
    for (int j = 0; j < 16; ++j) { const f32x4 t = ((const f32x4*)s0)[j]; s[4 * j] = t.x; s[4 * j + 1] = t.y; s[4 * j + 2] = t.z; s[4 * j + 3] = t.w; }
    const float r_l = op[lane], w_l = op[64 + lane], k_l = op[128 + lane], kk_l = op[192 + lane], b_l = op[256 + lane], v = op[320 + lane];
#define RL(x, j) __builtin_bit_cast(float, __builtin_amdgcn_readlane(__builtin_bit_cast(int, (x)), (j)))
    float sk = 0.f;
#pragma unroll
    for (int j = 0; j < 64; ++j) sk += s[j] * RL(kk_l, j);
    float o = 0.f;
#pragma unroll
    for (int j = 0; j < 64; ++j) { s[j] = s[j] * RL(w_l, j) - sk * RL(b_l, j) + v * RL(k_l, j); o += s[j] * RL(r_l, j); }
#undef RL
    float* so = a.out + OUT_RWS + ((size_t)(i * 16 + h) * 64 + lane) * 64;
#pragma unroll
    for (int j = 0; j < 16; ++j) ((f32x4*)so)[j] = (f32x4){s[4 * j], s[4 * j + 1], s[4 * j + 2], s[4 * j + 3]};
    ((bf16_t*)(ws + WS_OB))[(size_t)(MP + i) * D + h * 64 + lane] = f2bf(o);
}

constexpr int KN_LD = 264, VS_LD = 136, SS_LD = 264;
constexpr int L_KN = 0, L_VS = 128 * KN_LD * 2  , L_SS = L_VS + 64 * VS_LD * 2  , L_RET_END = L_SS + 64 * SS_LD * 2  ;
__device__ __forceinline__ void ret_unit(const Args& a, LAS unsigned char* lds, int unit, int tid) {
    unsigned char* ws = a.ws;
    const bf16_t* P = (const bf16_t*)(ws + WS_P);
    const int dvs = unit & 7, h = (unit >> 3) & 3, b = unit >> 5;
    const int wave = tid >> 6, lane = tid & 63, l15 = lane & 15, quad = lane >> 4;
    LAS bf16_t* KN = (LAS bf16_t*)(lds + L_KN); LAS bf16_t* VS = (LAS bf16_t*)(lds + L_VS); LAS bf16_t* SS = (LAS bf16_t*)(lds + L_SS);
    const float g = 1.f - exp2f(-5.f - (float)h), l2g = __log2f(g);
    const float gC = exp2f(128.f * l2g), ginvC = exp2f(-128.f * l2g);
    const bf16_t* KT = (const bf16_t*)(ws + WS_KT) + (size_t)(b * 4 + h) * 256 * T;
    f32x4 sacc[2][4];
#pragma unroll
    for (int n = 0; n < 2; ++n)
#pragma unroll
        for (int d = 0; d < 4; ++d) sacc[n][d] = (f32x4){0.f, 0.f, 0.f, 0.f};
    for (int i = tid; i < 64 * SS_LD / 2; i += 512) ((LAS unsigned*)SS)[i] = 0u;
    const int it = wave;
    u32x4 stk[8], stv[2];
#define RET_ISSUE(CC) do { const int tok0_ = b * T + (CC) * 128; \
        _Pragma("unroll") for (int i = 0; i < 8; ++i) { const int idx = tid + 512 * i, r = idx >> 5, c8 = (idx & 31) * 8; stk[i] = *(const u32x4*)(P + (size_t)(tok0_ + r) * NP + O_K + h * 256 + c8); } \
        _Pragma("unroll") for (int i = 0; i < 2; ++i) { const int idx = tid + 512 * i, r = idx >> 4, c8 = (idx & 15) * 8; stv[i] = *(const u32x4*)(P + (size_t)(b * T + h * 512 + dvs * 64 + r) * NP + O_V + (CC) * 128 + c8); } } while (0)
    bf16x8 qf[8];
#define RET_ISSUE_Q(CC) do { const int tokq_ = b * T + (CC) * 128 + it * 16 + l15; \
        _Pragma("unroll") for (int ks = 0; ks < 8; ++ks) qf[ks] = *(const bf16x8*)(P + (size_t)tokq_ * NP + h * 256 + ks * 32 + quad * 8); } while (0)
    RET_ISSUE(0); RET_ISSUE_Q(0);
    for (int c = 0; c < 16; ++c) {
        const int tok0 = b * T + c * 128;
#pragma unroll
        for (int i = 0; i < 8; ++i) { const int idx = tid + 512 * i, r = idx >> 5, c8 = (idx & 31) * 8; *(LAS u32x4*)(KN + r * KN_LD + c8) = stk[i]; }
#pragma unroll
        for (int i = 0; i < 2; ++i) { const int idx = tid + 512 * i, r = idx >> 4, c8 = (idx & 15) * 8; *(LAS u32x4*)(VS + r * VS_LD + c8) = stv[i]; }
        __syncthreads();
        bf16x8 ktf[2][4];
#pragma unroll
        for (int n = 0; n < 2; ++n)
#pragma unroll
            for (int ks = 0; ks < 4; ++ks) ktf[n][ks] = *(const bf16x8*)(KT + (size_t)((2 * wave + n) * 16 + l15) * T + c * 128 + ks * 32 + quad * 8);
        if (c < 15) RET_ISSUE(c + 1);
        f32x4 oacc[4];
#pragma unroll
        for (int d = 0; d < 4; ++d) oacc[d] = (f32x4){0.f, 0.f, 0.f, 0.f};
#pragma unroll
        for (int ks = 0; ks < 8; ++ks)
#pragma unroll
            for (int d = 0; d < 4; ++d) { const bf16x8 sb = *(const LAS bf16x8*)(SS + (d * 16 + l15) * SS_LD + ks * 32 + quad * 8); oacc[d] = MFMA32(qf[ks], sb, oacc[d]); }
#pragma unroll
        for (int p = 0; p < 4; ++p) {
            if (2 * p <= it) {
                f32x4 s0 = {0.f, 0.f, 0.f, 0.f}, s1 = {0.f, 0.f, 0.f, 0.f};
#pragma unroll
                for (int ks = 0; ks < 8; ++ks) { const bf16x8 ka = *(const LAS bf16x8*)(KN + ((2 * p) * 16 + l15) * KN_LD + ks * 32 + quad * 8); s0 = MFMA32(ka, qf[ks], s0); }
                if (2 * p + 1 <= it) {
#pragma unroll
                    for (int ks = 0; ks < 8; ++ks) { const bf16x8 ka = *(const LAS bf16x8*)(KN + ((2 * p + 1) * 16 + l15) * KN_LD + ks * 32 + quad * 8); s1 = MFMA32(ka, qf[ks], s1); }
                }
#pragma unroll
                for (int r = 0; r < 4; ++r) {
                    const int jl = quad * 4 + r;
                    s0[r] = (2 * p == it && jl > l15) ? 0.f : s0[r] * ginvC;
                    s1[r] = (2 * p + 1 > it || (2 * p + 1 == it && jl > l15)) ? 0.f : s1[r] * ginvC;
                }
                u32x4 aw; aw.x = pk2(s0[0], s0[1]); aw.y = pk2(s0[2], s0[3]); aw.z = pk2(s1[0], s1[1]); aw.w = pk2(s1[2], s1[3]);
                const bf16x8 af = __builtin_bit_cast(bf16x8, aw);
#pragma unroll
                for (int d = 0; d < 4; ++d) {
                    const LAS bf16_t* vr = VS + (d * 16 + l15) * VS_LD + 32 * p + quad * 4;
                    const u32x2 lo = *(const LAS u32x2*)vr, hi = *(const LAS u32x2*)(vr + 16);
                    const u32x4 bw = {lo.x, lo.y, hi.x, hi.y};
                    oacc[d] = MFMA32(af, __builtin_bit_cast(bf16x8, bw), oacc[d]);
                }
            }
        }
        if (c < 15) RET_ISSUE_Q(c + 1);
        {
            bf16_t* OA = (bf16_t*)(ws + WS_OA); float* SQA = (float*)(ws + WS_SQA);
#pragma unroll
            for (int r = 0; r < 4; ++r) {
                const int tok = tok0 + it * 16 + quad * 4 + r;
                float ss = 0.f;
#pragma unroll
                for (int d = 0; d < 4; ++d) { const float v = oacc[d][r]; ss += v * v; OA[(size_t)tok * 2048 + h * 512 + dvs * 64 + d * 16 + l15] = f2bf(v); }
#pragma unroll
                for (int o = 1; o < 16; o <<= 1) ss += __shfl_xor(ss, o);
                if (l15 == 0) SQA[(size_t)tok * 32 + h * 8 + dvs] = ss;
            }
        }
        __syncthreads();
#pragma unroll
        for (int n = 0; n < 2; ++n)
#pragma unroll
            for (int d = 0; d < 4; ++d) {
                f32x4 s = sacc[n][d] * gC;
#pragma unroll
                for (int ks = 0; ks < 4; ++ks) { const bf16x8 va = *(const LAS bf16x8*)(VS + (d * 16 + l15) * VS_LD + ks * 32 + quad * 8); s = MFMA32(va, ktf[n][ks], s); }
                sacc[n][d] = s;
#pragma unroll
                for (int r = 0; r < 4; ++r) SS[(d * 16 + quad * 4 + r) * SS_LD + (2 * wave + n) * 16 + l15] = f2bf(s[r]);
            }
        __syncthreads();
    }
    float* so = a.out + OUT_RETP + (size_t)(b * 4 + h) * 256 * 512;
#pragma unroll
    for (int n = 0; n < 2; ++n)
#pragma unroll
        for (int d = 0; d < 4; ++d) *(f32x4*)(so + (size_t)((2 * wave + n) * 16 + l15) * 512 + dvs * 64 + d * 16 + quad * 4) = sacc[n][d];
}
#undef RET_ISSUE
#undef RET_ISSUE_Q

__device__ __forceinline__ void ret_sample_unit(const Args& a, LAS unsigned char* lds, int i, int h, int tid) {
    unsigned char* ws = a.ws;
    const bf16_t* Prow = (const bf16_t*)(ws + WS_P) + (size_t)(MP + i) * NP;
    LAS float* Q = (LAS float*)lds; LAS float* Kh = Q + 256; LAS float* RED = Kh + 256; LAS float* OS = RED + 16;
    const float g = 1.f - exp2f(-5.f - (float)h);
    const int lane = tid & 63, wave = tid >> 6;
    float qk = 0.f;
    if (tid < 256) { const float q = bf2f(Prow[h * 256 + tid]), k = bf2f(Prow[O_K + h * 256 + tid]); Q[tid] = q; Kh[tid] = k; qk = q * k; }
    qk = wave_sum(qk);
    if (lane == 0) RED[wave] = qk;
    __syncthreads();
    const float qkv = (RED[0] + RED[1] + RED[2] + RED[3]) / g;
    const int dkg = tid >> 7, dv4 = 4 * (tid & 127);
    const u32x2 vw = *(const u32x2*)(Prow + O_V + h * 512 + dv4);
    const f32x4 v = {bflo(vw.x), bfhi(vw.x), bflo(vw.y), bfhi(vw.y)};
    const float* s0 = a.in[I_SRET] + (size_t)(i * 4 + h) * 256 * 512 + dv4;
    float* s1 = a.out + OUT_RETS + (size_t)(i * 4 + h) * 256 * 512 + dv4;
    f32x4 o = {0.f, 0.f, 0.f, 0.f};
#pragma unroll 8
    for (int j = 0; j < 64; ++j) {
        const int dk = dkg * 64 + j;
        const f32x4 s = __builtin_nontemporal_load((const f32x4*)(s0 + (size_t)dk * 512));
        o += s * Q[dk];
        __builtin_nontemporal_store(s * g + v * Kh[dk], (f32x4*)(s1 + (size_t)dk * 512));
    }
    *(LAS f32x4*)(OS + dkg * 512 + dv4) = o;
    __syncthreads();
    float y[4] = {0.f, 0.f, 0.f, 0.f}; float ss = 0.f;
    if (tid < 128) {
        const f32x4 t = *(LAS f32x4*)(OS + dv4) + *(LAS f32x4*)(OS + 512 + dv4) + *(LAS f32x4*)(OS + 1024 + dv4) + *(LAS f32x4*)(OS + 1536 + dv4) + v * qkv;
        y[0] = t.x; y[1] = t.y; y[2] = t.z; y[3] = t.w; ss = t.x * t.x + t.y * t.y + t.z * t.z + t.w * t.w;
    }
    ss = wave_sum(ss);
    if (lane == 0) RED[8 + wave] = ss;
    __syncthreads();
    if (tid < 128) {
        const float rs = 1.0f / sqrtf((RED[8] + RED[9]) * (1.f / 512.f) + EPS);
        const u32x2 gw = *(const u32x2*)(Prow + O_GA + h * 512 + dv4);
        u32x2 ow; ow.x = pk2(y[0] * rs * silu_(bflo(gw.x)), y[1] * rs * silu_(bfhi(gw.x))); ow.y = pk2(y[2] * rs * silu_(bflo(gw.y)), y[3] * rs * silu_(bfhi(gw.y)));
        *(u32x2*)((bf16_t*)(ws + WS_OA) + (size_t)(MP + i) * 2048 + h * 512 + dv4) = ow;
    }
    __syncthreads();
}

__device__ __forceinline__ void ret_sample_wave(const Args& a, int i, int h, int lane) {
    unsigned char* ws = a.ws;
    const bf16_t* Prow = (const bf16_t*)(ws + WS_P) + (size_t)(MP + i) * NP;
    const float g = 1.f - exp2f(-5.f - (float)h);
    float q[4], k[4]; float qk = 0.f;
#pragma unroll
    for (int j = 0; j < 4; ++j) { q[j] = bf2f(Prow[h * 256 + 64 * j + lane]); k[j] = bf2f(Prow[O_K + h * 256 + 64 * j + lane]); qk += q[j] * k[j]; }
    const float qkv = wave_sum(qk) / g;
    f32x4 v[2];
#pragma unroll
    for (int e = 0; e < 2; ++e) { const u32x2 vw = *(const u32x2*)(Prow + O_V + h * 512 + e * 256 + lane * 4); v[e] = (f32x4){bflo(vw.x), bfhi(vw.x), bflo(vw.y), bfhi(vw.y)}; }
    const float* s0 = a.in[I_SRET] + (size_t)(i * 4 + h) * 256 * 512 + lane * 4;
    float* s1 = a.out + OUT_RETS + (size_t)(i * 4 + h) * 256 * 512 + lane * 4;
    f32x4 o[2] = {{0.f, 0.f, 0.f, 0.f}, {0.f, 0.f, 0.f, 0.f}};
#pragma unroll
    for (int j = 0; j < 4; ++j) {
        for (int d0 = 0; d0 < 64; d0 += 16) {
            f32x4 sv[16][2];
#pragma unroll
            for (int d = 0; d < 16; ++d)
#pragma unroll
                for (int e = 0; e < 2; ++e) sv[d][e] = __builtin_nontemporal_load((const f32x4*)(s0 + (size_t)(64 * j + d0 + d) * 512 + e * 256));
#pragma unroll
            for (int d = 0; d < 16; ++d) {
                const float qd = __builtin_bit_cast(float, __builtin_amdgcn_readlane(__builtin_bit_cast(int, q[j]), d0 + d));
                const float kd = __builtin_bit_cast(float, __builtin_amdgcn_readlane(__builtin_bit_cast(int, k[j]), d0 + d));
#pragma unroll
                for (int e = 0; e < 2; ++e) { o[e] += sv[d][e] * qd; __builtin_nontemporal_store(sv[d][e] * g + v[e] * kd, (f32x4*)(s1 + (size_t)(64 * j + d0 + d) * 512 + e * 256)); }
            }
        }
    }
    float ss = 0.f;
#pragma unroll
    for (int e = 0; e < 2; ++e) { o[e] += v[e] * qkv; ss += (o[e].x * o[e].x + o[e].y * o[e].y) + (o[e].z * o[e].z + o[e].w * o[e].w); }
    const float rs = 1.0f / sqrtf(wave_sum(ss) * (1.f / 512.f) + EPS);
#pragma unroll
    for (int e = 0; e < 2; ++e) { const u32x2 gw = *(const u32x2*)(Prow + O_GA + h * 512 + e * 256 + lane * 4);
        u32x2 ow; ow.x = pk2(o[e].x * rs * silu_(bflo(gw.x)), o[e].y * rs * silu_(bfhi(gw.x))); ow.y = pk2(o[e].z * rs * silu_(bflo(gw.y)), o[e].w * rs * silu_(bfhi(gw.y)));
        *(u32x2*)((bf16_t*)(ws + WS_OA) + (size_t)(MP + i) * 2048 + h * 512 + e * 256 + lane * 4) = ow; }
}

__device__ __forceinline__ void phase25_row(const Args& a, int m, int lane) {
    unsigned char* ws = a.ws;
    const bf16_t* Prow = (const bf16_t*)(ws + WS_P) + (size_t)m * NP;
    bf16_t* oa = (bf16_t*)(ws + WS_OA) + (size_t)m * 2048;
    const float* sq = (const float*)(ws + WS_SQA) + (size_t)m * 32;
    const bool prompt = m < MP;
    f32x4 sqv[8]; u32x4 ow[4], gw4[4];
    if (prompt) {
#pragma unroll
        for (int j = 0; j < 8; ++j) sqv[j] = ((const f32x4*)sq)[j];
#pragma unroll
        for (int hh = 0; hh < 4; ++hh) { ow[hh] = *(const u32x4*)(oa + hh * 512 + lane * 8); gw4[hh] = *(const u32x4*)(Prow + O_GA + hh * 512 + lane * 8); }
    }
    const bf16_t* ob = (const bf16_t*)(ws + WS_OB) + (size_t)m * D + lane * 16;
    f32x4 ov[4];
    { const u32x4 w0 = ((const u32x4*)ob)[0], w1 = ((const u32x4*)ob)[1];
      ov[0] = (f32x4){bflo(w0.x), bfhi(w0.x), bflo(w0.y), bfhi(w0.y)}; ov[1] = (f32x4){bflo(w0.z), bfhi(w0.z), bflo(w0.w), bfhi(w0.w)};
      ov[2] = (f32x4){bflo(w1.x), bfhi(w1.x), bflo(w1.y), bfhi(w1.y)}; ov[3] = (f32x4){bflo(w1.z), bfhi(w1.z), bflo(w1.w), bfhi(w1.w)}; }
    const float bc = ((const float*)(ws + WS_BC))[(size_t)m * 16 + (lane >> 2)];
    const bf16_t* cur = Prow + O_SH + 2048 + lane * 16;
    const bool hasp = (m >= MP) || (m & (T - 1));
    const bf16_t* prv = (m >= MP) ? cur + (size_t)MS * NP : cur - NP;
    u32x4 cw[2], pw[2] = {{0u, 0u, 0u, 0u}, {0u, 0u, 0u, 0u}}, gbw[2];
    cw[0] = ((const u32x4*)cur)[0]; cw[1] = ((const u32x4*)cur)[1];
    if (hasp) { pw[0] = ((const u32x4*)prv)[0]; pw[1] = ((const u32x4*)prv)[1]; }
    gbw[0] = ((const u32x4*)(Prow + O_GB + lane * 16))[0]; gbw[1] = ((const u32x4*)(Prow + O_GB + lane * 16))[1];
    f32x4 lw4[4], lb4[4], mu4[4];
#pragma unroll
    for (int j = 0; j < 4; ++j) { lw4[j] = ((const f32x4*)(a.in[I_LNW] + lane * 16))[j]; lb4[j] = ((const f32x4*)(a.in[I_LNB] + lane * 16))[j]; mu4[j] = ((const f32x4*)(a.in[I_MU] + 2048 + lane * 16))[j]; }
    if (prompt) {
#pragma unroll
        for (int hh = 0; hh < 4; ++hh) {
            const f32x4 s0 = sqv[2 * hh], s1 = sqv[2 * hh + 1];
            const float rs = 1.0f / sqrtf(((s0.x + s0.y) + (s0.z + s0.w) + (s1.x + s1.y) + (s1.z + s1.w)) * (1.f / 512.f) + EPS);
            const u32x4 o4 = ow[hh], g4 = gw4[hh];
            u32x4 r;
            r.x = pk2(bflo(o4.x) * rs * silu_(bflo(g4.x)), bfhi(o4.x) * rs * silu_(bfhi(g4.x))); r.y = pk2(bflo(o4.y) * rs * silu_(bflo(g4.y)), bfhi(o4.y) * rs * silu_(bfhi(g4.y)));
            r.z = pk2(bflo(o4.z) * rs * silu_(bflo(g4.z)), bfhi(o4.z) * rs * silu_(bfhi(g4.z))); r.w = pk2(bflo(o4.w) * rs * silu_(bflo(g4.w)), bfhi(o4.w) * rs * silu_(bfhi(g4.w)));
            *(u32x4*)(oa + hh * 512 + lane * 8) = r;
        }
    }
    float o[16], lw[16], lb[16], mu[16];
#pragma unroll
    for (int j = 0; j < 4; ++j) { o[4 * j] = ov[j].x; o[4 * j + 1] = ov[j].y; o[4 * j + 2] = ov[j].z; o[4 * j + 3] = ov[j].w;
        lw[4 * j] = lw4[j].x; lw[4 * j + 1] = lw4[j].y; lw[4 * j + 2] = lw4[j].z; lw[4 * j + 3] = lw4[j].w;
        lb[4 * j] = lb4[j].x; lb[4 * j + 1] = lb4[j].y; lb[4 * j + 2] = lb4[j].z; lb[4 * j + 3] = lb4[j].w;
        mu[4 * j] = mu4[j].x; mu[4 * j + 1] = mu4[j].y; mu[4 * j + 2] = mu4[j].z; mu[4 * j + 3] = mu4[j].w; }
    float s = 0.f;
#pragma unroll
    for (int j = 0; j < 16; ++j) s += o[j];
    s += __shfl_xor(s, 1); s += __shfl_xor(s, 2);
    const float mean = s * (1.f / 64.f);
    float q = 0.f;
#pragma unroll
    for (int j = 0; j < 16; ++j) { const float d = o[j] - mean; q += d * d; }
    q += __shfl_xor(q, 1); q += __shfl_xor(q, 2);
    const float rstd = 1.0f / sqrtf(q * (1.f / 64.f) + 64e-5f);
    const unsigned cws[8] = {cw[0].x, cw[0].y, cw[0].z, cw[0].w, cw[1].x, cw[1].y, cw[1].z, cw[1].w};
    const unsigned pws[8] = {pw[0].x, pw[0].y, pw[0].z, pw[0].w, pw[1].x, pw[1].y, pw[1].z, pw[1].w};
    const unsigned gws[8] = {gbw[0].x, gbw[0].y, gbw[0].z, gbw[0].w, gbw[1].x, gbw[1].y, gbw[1].z, gbw[1].w};
    unsigned outw[8];
#pragma unroll
    for (int j = 0; j < 8; ++j) {
        const float c0 = bflo(cws[j]), c1 = bfhi(cws[j]), p0 = bflo(pws[j]), p1 = bfhi(pws[j]);
        const float v0 = c0 + (p0 - c0) * mu[2 * j], v1 = c1 + (p1 - c1) * mu[2 * j + 1];
        const float y0 = ((o[2 * j] - mean) * rstd * lw[2 * j] + lb[2 * j] + bc * v0) * silu_(bflo(gws[j]));
        const float y1 = ((o[2 * j + 1] - mean) * rstd * lw[2 * j + 1] + lb[2 * j + 1] + bc * v1) * silu_(bfhi(gws[j]));
        outw[j] = pk2(y0, y1);
    }
    bf16_t* yb = (bf16_t*)(ws + WS_H) + (size_t)m * D + lane * 16;
    *(u32x4*)yb = (u32x4){outw[0], outw[1], outw[2], outw[3]}; *(u32x4*)(yb + 8) = (u32x4){outw[4], outw[5], outw[6], outw[7]};
}

struct EpiT1 {
    static constexpr bool PERM = false;
    const bf16_t* P; bf16_t* T1;
    __device__ __forceinline__ void operator()(const f32x4 (&acc)[2][2][4][2], const Unit& u, int wr, int wc, int fr, int fq) const {
        const int row0 = u.pm * 256 + wr * 64 + fr, col0 = u.pn * 256 + wc * 32 + 4 * fq;
#pragma unroll
        for (int ai = 0; ai < 2; ++ai)
#pragma unroll
            for (int m = 0; m < 4; ++m) { const int row = row0 + ai * 128 + m * 16; if (row >= MR) continue;
#pragma unroll
                for (int bj = 0; bj < 2; ++bj)
#pragma unroll
                    for (int n = 0; n < 2; ++n) { const int col = col0 + bj * 128 + n * 16;
                        const u32x2 gw = *(const u32x2*)(P + (size_t)row * NP + O_MA + col);
                        const f32x4 gt = {sigm(bflo(gw.x)), sigm(bfhi(gw.x)), sigm(bflo(gw.y)), sigm(bfhi(gw.y))};
                        const f32x4 t = acc[ai][bj][m][n] * gt; *(u32x2*)(T1 + (size_t)row * D + col) = (u32x2){pk2(t.x, t.y), pk2(t.z, t.w)}; } asm volatile("" ::: "memory"); }
    }
};
struct EpiMG {
    static constexpr bool PERM = false;
    const bf16_t* P; const bf16_t* T1; bf16_t* MG;
    __device__ __forceinline__ void operator()(const f32x4 (&acc)[2][2][4][2], const Unit& u, int wr, int wc, int fr, int fq) const {
        const int row0 = u.pm * 256 + wr * 64 + fr, col0 = u.pn * 256 + wc * 32 + 4 * fq;
#pragma unroll
        for (int ai = 0; ai < 2; ++ai)
#pragma unroll
            for (int m = 0; m < 4; ++m) { const int row = row0 + ai * 128 + m * 16; if (row >= MR) continue;
#pragma unroll
                for (int bj = 0; bj < 2; ++bj)
#pragma unroll
                    for (int n = 0; n < 2; ++n) { const int col = col0 + bj * 128 + n * 16;
                        const u32x2 gw = *(const u32x2*)(P + (size_t)row * NP + O_MB + col);
                        const f32x4 gt = {sigm(bflo(gw.x)), sigm(bfhi(gw.x)), sigm(bflo(gw.y)), sigm(bfhi(gw.y))};
                        const u32x2 tw = *(const u32x2*)(T1 + (size_t)row * D + col);
                        const f32x4 v = (f32x4){bflo(tw.x), bfhi(tw.x), bflo(tw.y), bfhi(tw.y)} + acc[ai][bj][m][n] * gt;
                        *(u32x2*)(MG + (size_t)row * D + col) = (u32x2){pk2(v.x, v.y), pk2(v.z, v.w)}; } asm volatile("" ::: "memory"); }
    }
};
struct EpiX1 {
    static constexpr bool PERM = false;
    const float* xp; const float* xs; float* X1; bf16_t* X1B; float* SQ;
    __device__ __forceinline__ void operator()(const f32x4 (&acc)[2][2][4][2], const Unit& u, int wr, int wc, int fr, int fq) const {
        const int row0 = u.pm * 256 + wr * 64 + fr, col0 = u.pn * 256 + wc * 32 + 4 * fq;
#pragma unroll
        for (int ai = 0; ai < 2; ++ai)
#pragma unroll
            for (int m = 0; m < 4; ++m) { const int row = row0 + ai * 128 + m * 16; const bool ok = row < MR;
                const float* xr = (row < MP) ? xp + (size_t)row * D : xs + (size_t)(row - MP) * D;
                float ss = 0.f;
                if (ok) {
#pragma unroll
                    for (int bj = 0; bj < 2; ++bj)
#pragma unroll
                        for (int n = 0; n < 2; ++n) { const int col = col0 + bj * 128 + n * 16;
                            const f32x4 v = *(const f32x4*)(xr + col) + acc[ai][bj][m][n];
                            ss += (v.x * v.x + v.y * v.y) + (v.z * v.z + v.w * v.w);
                            *(u32x2*)(X1B + (size_t)row * D + col) = (u32x2){pk2(v.x, v.y), pk2(v.z, v.w)}; }
                }
                ss += __shfl_xor(ss, 16); ss += __shfl_xor(ss, 32);
                if (ok && fq == 0) SQ[(size_t)row * 16 + u.pn * 4 + wc] = ss; asm volatile("" ::: "memory"); }
    }
};
struct EpiGT {
    static constexpr bool PERM = false;
    const float* SQ; bf16_t* GT;
    __device__ __forceinline__ void operator()(const f32x4 (&acc)[2][2][4][2], const Unit& u, int wr, int wc, int fr, int fq) const {
        const int row0 = u.pm * 256 + wr * 64 + fr, col0 = u.pn * 256 + wc * 32 + 4 * fq;
#pragma unroll
        for (int ai = 0; ai < 2; ++ai)
#pragma unroll
            for (int m = 0; m < 4; ++m) { const int row = row0 + ai * 128 + m * 16; if (row >= MR) continue;
                const f32x4* sp = (const f32x4*)(SQ + (size_t)row * 16); const f32x4 q0 = sp[0], q1 = sp[1], q2 = sp[2], q3 = sp[3];
                const float rs = 1.0f / sqrtf((((q0.x + q0.y) + (q0.z + q0.w)) + ((q1.x + q1.y) + (q1.z + q1.w)) + ((q2.x + q2.y) + (q2.z + q2.w)) + ((q3.x + q3.y) + (q3.z + q3.w))) * (1.f / D) + EPS);
#pragma unroll
                for (int bj = 0; bj < 2; ++bj)
#pragma unroll
                    for (int n = 0; n < 2; ++n) { const int col = col0 + bj * 128 + n * 16; const f32x4 t = acc[ai][bj][m][n] * rs;
                        *(u32x2*)(GT + (size_t)row * D + col) = (u32x2){pk2(sigm(t.x), sigm(t.y)), pk2(sigm(t.z), sigm(t.w))}; } asm volatile("" ::: "memory"); }
    }
};
struct EpiX2 {
    static constexpr bool PERM = false;
    const bf16_t* X1; const bf16_t* GT; float* out; float* SQ;
    __device__ __forceinline__ void operator()(const f32x4 (&acc)[2][2][4][2], const Unit& u, int wr, int wc, int fr, int fq) const {
        const int row0 = u.pm * 256 + wr * 64 + fr, col0 = u.pn * 256 + wc * 32 + 4 * fq;
#pragma unroll
        for (int ai = 0; ai < 2; ++ai)
#pragma unroll
            for (int m = 0; m < 4; ++m) { int row = row0 + ai * 128 + m * 16; asm volatile("" : "+v"(row)); const bool ok = row < MR;
                float ss = 0.f;
                if (ok) {
#pragma unroll
                    for (int bj = 0; bj < 2; ++bj)
#pragma unroll
                        for (int n = 0; n < 2; ++n) { const int col = col0 + bj * 128 + n * 16;
                            const u32x2 gw = *(const u32x2*)(GT + (size_t)row * D + col);
                            const u32x2 xw = *(const u32x2*)(X1 + (size_t)row * D + col);
                            const f32x4 v = (f32x4){bflo(xw.x), bfhi(xw.x), bflo(xw.y), bfhi(xw.y)} + acc[ai][bj][m][n] * (f32x4){bflo(gw.x), bfhi(gw.x), bflo(gw.y), bfhi(gw.y)};
                            ss += (v.x * v.x + v.y * v.y) + (v.z * v.z + v.w * v.w);
                            *(f32x4*)(out + (size_t)row * D + col) = v; asm volatile("" ::: "memory"); }
                }
                ss += __shfl_xor(ss, 16); ss += __shfl_xor(ss, 32);
                if (ok && fq == 0) SQ[(size_t)row * 16 + u.pn * 4 + wc] = ss; asm volatile("" ::: "memory"); }
    }
};


__device__ __forceinline__ f32x4 mini_acc(const bf16_t* A, int lda, const bf16_t* Bt, int K, int kq, int l15, int quad) {
    f32x4 acc = {0.f, 0.f, 0.f, 0.f};
    const int kn = K / 128;
    const bf16_t* ap = A + (size_t)l15 * lda + kq * (K / 4) + quad * 8;
    const bf16_t* bp = Bt + (size_t)l15 * K + kq * (K / 4) + quad * 8;
#pragma unroll 4
    for (int ks = 0; ks < kn; ++ks) acc = MFMA32(*(const bf16x8*)(ap + ks * 32), *(const bf16x8*)(bp + ks * 32), acc);
    return acc;
}
__device__ __forceinline__ f32x4 mini_reduce(LAS f32x4* red, int half, int lane) { return (red[(half * 4 + 0) * 64 + lane] + red[(half * 4 + 1) * 64 + lane]) + (red[(half * 4 + 2) * 64 + lane] + red[(half * 4 + 3) * 64 + lane]); }
template <int PH> __device__ __forceinline__ void mini_phase(const Args& a, LAS unsigned char* lds, int bx, int G, int wave, int lane) {
    unsigned char* ws = a.ws;
    const int l15 = lane & 15, quad = lane >> 4, half = wave >> 2, kq = wave & 3;
    LAS f32x4* red1 = (LAS f32x4*)lds; LAS f32x4* red2 = red1 + 8 * 64;
    const bf16_t* P = (const bf16_t*)(ws + WS_P);
    for (int tp = bx; tp < 256; tp += G) {
        const int tl = tp * 2 + half, mt = tl >> 6, nt = tl & 63, row0 = MP + mt * 16, col0 = nt * 16;
        f32x4 a1, a2 = {0.f, 0.f, 0.f, 0.f};
        if (PH == 0) { a1 = mini_acc((const bf16_t*)(ws + WS_OA) + (size_t)row0 * 2048, 2048, (const bf16_t*)(ws + WS_WDA) + (size_t)col0 * 2048, 2048, kq, l15, quad);
                       a2 = mini_acc((const bf16_t*)(ws + WS_H) + (size_t)row0 * D, D, (const bf16_t*)(ws + WS_WDB) + (size_t)col0 * D, D, kq, l15, quad); }
        if (PH == 1) { a1 = mini_acc((const bf16_t*)(ws + WS_MG) + (size_t)row0 * D, D, (const bf16_t*)(ws + WS_WOUT) + (size_t)col0 * D, D, kq, l15, quad); }
        if (PH == 2) { a1 = mini_acc((const bf16_t*)(ws + WS_X1B) + (size_t)row0 * D, D, (const bf16_t*)(ws + WS_WGATE) + (size_t)col0 * D, D, kq, l15, quad);
                       a2 = mini_acc((const bf16_t*)(ws + WS_PB) + (size_t)row0 * PLE, PLE, (const bf16_t*)(ws + WS_WPLE) + (size_t)col0 * PLE, PLE, kq, l15, quad); }
        red1[wave * 64 + lane] = a1; red2[wave * 64 + lane] = a2;
        __syncthreads();
        if (kq == 0) {
            a1 = mini_reduce(red1, half, lane); a2 = mini_reduce(red2, half, lane);
            const int col = col0 + l15;
            float rs1[4] = {0.f, 0.f, 0.f, 0.f};
            if (PH == 2) {
#pragma unroll
                for (int r = 0; r < 4; ++r) { const f32x4 q = *(const f32x4*)((const float*)(ws + WS_SQS1) + (size_t)(row0 - MP + quad * 4 + r) * 64 + l15 * 4); float t = (q.x + q.y) + (q.z + q.w);
#pragma unroll
                    for (int o = 1; o < 16; o <<= 1) t += __shfl_xor(t, o);
                    rs1[r] = 1.0f / sqrtf(t * (1.f / D) + EPS); }
            }
#pragma unroll
            for (int r = 0; r < 4; ++r) {
                const int row = row0 + quad * 4 + r;
                float ss = 0.f;
                if (PH == 0) { const float ga = sigm(bf2f(P[(size_t)row * NP + O_MA + col])), gb = sigm(bf2f(P[(size_t)row * NP + O_MB + col]));
                    ((bf16_t*)(ws + WS_MG))[(size_t)row * D + col] = f2bf(a1[r] * ga + a2[r] * gb); }
                if (PH == 1) { const float x1 = a.in[I_XS][(size_t)(row - MP) * D + col] + a1[r]; ss = x1 * x1;
                    ((bf16_t*)(ws + WS_X1B))[(size_t)row * D + col] = f2bf(x1); }
                if (PH == 2) { const float x2 = bf2f(((const bf16_t*)(ws + WS_X1B))[(size_t)row * D + col]) + a2[r] * sigm(rs1[r] * a1[r]); ss = x2 * x2;
                    a.out[OUT_Y + (size_t)row * D + col] = x2; }
                if (PH != 0) {
#pragma unroll
                    for (int o = 1; o < 16; o <<= 1) ss += __shfl_xor(ss, o);
                    if (l15 == 0) ((float*)(ws + (PH == 1 ? WS_SQS1 : WS_SQS2)))[(size_t)(row - MP) * 64 + nt] = ss;
                }
            }
        }
        __syncthreads();
    }
}

#define XB_TMO      128
#define XB_XCNT(j)  (256  + 64 * (j))
#define XB_XSUB(j)  (1280 + 64 * (j))
#define XB_XGEN(j)  (2304 + 64 * (j))
#define XB_TOP      3328
#define XB_TOPGEN   3392
#define XCD_BAR_WORDS 3456
#define XB_SPIN_CAP (1u << 22)
__device__ __forceinline__ unsigned xb_ld(unsigned* p)              { return __hip_atomic_load(p, __ATOMIC_RELAXED, __HIP_MEMORY_SCOPE_AGENT); }
__device__ __forceinline__ unsigned xb_add(unsigned* p, unsigned v) { return __hip_atomic_fetch_add(p, v, __ATOMIC_RELAXED, __HIP_MEMORY_SCOPE_AGENT); }
__device__ __forceinline__ unsigned xb_xcc_id() { return (unsigned)__builtin_amdgcn_s_getreg((3 << 11) | 20) & 0xFu; }
#define XB_SPIN(cond, bar) do { unsigned _sp = 0; while (cond) { __builtin_amdgcn_s_sleep(1); \
    if ((++_sp & 255u) == 0u) { if (xb_ld(&(bar)[XB_TMO])) break; if (_sp > XB_SPIN_CAP) { atomicAdd(&(bar)[XB_TMO], 1u); break; } } } } while (0)
struct XcdBarrier { unsigned* bar; unsigned x; volatile LAS unsigned* st; };
__device__ __forceinline__ XcdBarrier xcd_barrier_post(unsigned* bar, volatile LAS unsigned* st) {
    XcdBarrier b; b.bar = bar; b.x = xb_xcc_id(); b.st = st;
    if (threadIdx.x == 0) (void)xb_add(&bar[XB_XCNT(b.x)], 1u);
    return b;
}
__device__ __forceinline__ void xcd_barrier_complete(unsigned* bar, unsigned x, unsigned& nloc, unsigned& nx) {
    const unsigned G = gridDim.x * gridDim.y * gridDim.z;
    unsigned sum, cnt, mine, sp = 0u;
    for (;;) {
        sum = 0u; cnt = 0u; mine = 0u;
#pragma unroll
        for (unsigned j = 0; j < 16; ++j) { const unsigned c = xb_ld(&bar[XB_XCNT(j)]); sum += c; cnt += (c > 0u) ? 1u : 0u; mine = (j == x) ? c : mine; }
        if (sum == G) break;
        __builtin_amdgcn_s_sleep(1);
        if ((++sp & 255u) == 0u) { if (xb_ld(&bar[XB_TMO])) break; if (sp > XB_SPIN_CAP) { atomicAdd(&bar[XB_TMO], 1u); break; } }
    }
    nloc = mine > 0u ? mine : 1u; nx = cnt > 0u ? cnt : 1u;
}
__device__ __forceinline__ void xcd_barrier(const XcdBarrier& b) {
    asm volatile("s_waitcnt vmcnt(0)" ::: "memory");
    __syncthreads();
    if (threadIdx.x == 0) {
        unsigned* bar = b.bar;
        __builtin_amdgcn_s_waitcnt(0);
        unsigned nloc = b.st[0], nx = b.st[1];
        if (nloc == 0u) { xcd_barrier_complete(bar, b.x, nloc, nx); b.st[0] = nloc; b.st[1] = nx; }
        const unsigned old = xb_add(&bar[XB_XSUB(b.x)], 1u);
        const unsigned gen = old / nloc;
        if (old + 1u == (gen + 1u) * nloc) {
            __builtin_amdgcn_fence(__ATOMIC_RELEASE, "agent");
            asm volatile("s_waitcnt vmcnt(0)" ::: "memory");
            const unsigned og = xb_add(&bar[XB_TOP], 1u);
            const unsigned tg = og / nx;
            if (og + 1u == (tg + 1u) * nx) xb_add(&bar[XB_TOPGEN], 1u);
            else XB_SPIN(xb_ld(&bar[XB_TOPGEN]) == tg, bar);
            __builtin_amdgcn_fence(__ATOMIC_ACQUIRE, "agent");
            xb_add(&bar[XB_XGEN(b.x)], 1u);
            asm volatile("s_waitcnt vmcnt(0)" ::: "memory");
        } else {
            XB_SPIN(xb_ld(&bar[XB_XGEN(b.x)]) == gen, bar);
            __builtin_amdgcn_fence(__ATOMIC_ACQUIRE, "agent");
            asm volatile("s_waitcnt vmcnt(0)" ::: "memory");
        }
    }
    __syncthreads();
}

constexpr int LDS_BYTES = 147456;
constexpr int CTL_SQ1 = 0, CTL_SQ2 = 32768, CTL_CNT = 65536;

#define GRID_SYNC() xcd_barrier(xbar)
__global__ void __launch_bounds__(512, 2) fwd_mega(Args a) {
    extern __shared__ __attribute__((aligned(16))) unsigned char lds_raw[];
    LAS unsigned char* lds = (LAS unsigned char*)lds_raw;
    cg::grid_group grid = cg::this_grid();
    const int tid = threadIdx.x, lane = tid & 63, wave = __builtin_amdgcn_readfirstlane(tid >> 6);
    const int G = gridDim.x, bx = blockIdx.x;
    const int gw = bx * 8 + wave, NGW = G * 8;
    unsigned char* ws = a.ws;
    if (tid < 16) ((LAS unsigned*)(lds + 131072 + 64))[tid] = 0u;
    __syncthreads();
    XcdBarrier xbar = xcd_barrier_post((unsigned*)(ws + WS_BAR), (volatile LAS unsigned*)(lds + 131072 + 64));
    grid.sync();

#if !defined(ONLY_PH) || ONLY_PH == 0
    phase0(a, lds, gw, NGW, wave, lane);
    GRID_SYNC();
#endif
#if !defined(ONLY_PH) || ONLY_PH == 1
    {
        pg8::Gemm g{(const bf16_t*)(ws + WS_H), (const bf16_t*)(ws + WS_WIN), MALL, NP, D}; pg8::StaticOrder S; S.init(MALL, NP, G, bx);
        EpiP E{(bf16_t*)(ws + WS_P), (bf16_t*)(ws + WS_KT), (const f32x2*)(ws + WS_ROPE)};
        pg8::gemm_phase<EpiP>(lds, g, S, E);
    }
    GRID_SYNC();
#endif
#if !defined(ONLY_PH) || ONLY_PH == 2
    for (int it = gw; it < 1032 * 16; it += NGW) rw_prep_item(a, lds + wave * 10240, it >> 4, it & 15, lane);
    GRID_SYNC();
#endif
#if !defined(ONLY_PH) || ONLY_PH == 3
    {
        if (G < 128) for (int u = gw; u < MS * 16; u += NGW) rw_sample_wave(a, u >> 4, u & 15, lane);
        if (bx < 128) { if (wave < 4) rw_scan_task(a, lds + wave * 4096, bx >> 4, bx & 15, wave, lane); else if (G >= 128) { const int u = bx * 4 + (wave - 4); ret_sample_wave(a, u >> 2, u & 3, lane); }
            if (G >= 128) for (int u = bx * 8 + wave; u < MS * 16; u += 1024) rw_sample_wave(a, u >> 4, u & 15, lane);
        }
        __syncthreads();
        {
            unsigned* cnt2 = (unsigned*)(ws + WS_CTL) + CTL_CNT + 32;
            LAS unsigned* lu = (LAS unsigned*)(lds + 131072);
            for (;;) {
                if (tid == 0) *lu = atomicAdd(cnt2, 1u);
                __syncthreads();
                const unsigned unit = *lu;
                __syncthreads();
                if (unit >= (unsigned)(MS * 4) || G >= 128) break;
                ret_sample_unit(a, lds, (int)(unit >> 2), (int)(unit & 3), tid);
            }
        }
        {
            unsigned* cnt = (unsigned*)(ws + WS_CTL) + CTL_CNT;
            LAS unsigned* lu = (LAS unsigned*)(lds + 131072);
            for (;;) {
                if (tid == 0) *lu = atomicAdd(cnt, 1u);
                __syncthreads();
                const unsigned unit = *lu;
                __syncthreads();
                if (unit >= 256u) break;
                ret_unit(a, lds, (int)unit, tid);
            }
        }
    }
    GRID_SYNC();
#endif
#if !defined(ONLY_PH) || ONLY_PH == 4
    for (int m = gw; m < MR; m += NGW) phase25_row(a, m, lane);
    GRID_SYNC();
#endif
#if !defined(ONLY_PH) || ONLY_PH == 5
    {
        mini_phase<0>(a, lds, bx, G, wave, lane);
        pg8::StaticOrder S; S.init(MP, D, G, bx);
        { pg8::Gemm g{(const bf16_t*)(ws + WS_OA), (const bf16_t*)(ws + WS_WDA), MP, D, 2048}; EpiT1 E{(const bf16_t*)(ws + WS_P), (bf16_t*)(ws + WS_T1)}; pg8::gemm_phase<EpiT1>(lds, g, S, E); }
        { pg8::Gemm g{(const bf16_t*)(ws + WS_H), (const bf16_t*)(ws + WS_WDB), MP, D, D}; EpiMG E{(const bf16_t*)(ws + WS_P), (const bf16_t*)(ws + WS_T1), (bf16_t*)(ws + WS_MG)}; pg8::gemm_phase<EpiMG>(lds, g, S, E); }
    }
    GRID_SYNC();
#endif
#if !defined(ONLY_PH) || ONLY_PH == 6
    {
        mini_phase<1>(a, lds, bx, G, wave, lane);
        pg8::StaticOrder S; S.init(MP, D, G, bx);
        pg8::Gemm g{(const bf16_t*)(ws + WS_MG), (const bf16_t*)(ws + WS_WOUT), MP, D, D};
        EpiX1 E{a.in[I_XP], a.in[I_XS], (float*)(ws + WS_X1), (bf16_t*)(ws + WS_X1B), (float*)(ws + WS_SQ1P)};
        pg8::gemm_phase<EpiX1>(lds, g, S, E);
    }
    GRID_SYNC();
#endif
#if !defined(ONLY_PH) || ONLY_PH == 7
    {
        mini_phase<2>(a, lds, bx, G, wave, lane);
        pg8::StaticOrder S; S.init(MP, D, G, bx);
        { pg8::Gemm g{(const bf16_t*)(ws + WS_X1B), (const bf16_t*)(ws + WS_WGATE), MP, D, D}; EpiGT E{(const float*)(ws + WS_SQ1P), (bf16_t*)(ws + WS_GT)}; pg8::gemm_phase<EpiGT>(lds, g, S, E); }
        { pg8::Gemm g{(const bf16_t*)(ws + WS_PB), (const bf16_t*)(ws + WS_WPLE), MP, D, PLE}; EpiX2 E{(const bf16_t*)(ws + WS_X1B), (const bf16_t*)(ws + WS_GT), a.out + OUT_Y, (float*)(ws + WS_SQ2P)}; pg8::gemm_phase<EpiX2>(lds, g, S, E); }
    }
    GRID_SYNC();
#endif
#if !defined(ONLY_PH) || ONLY_PH == 8
    {
        const float* sq2 = (const float*)(ws + WS_SQ2P); const float* fg = a.in[I_FNG];
        for (int m0 = gw; m0 < MR; m0 += 2 * NGW) {
            const int m1 = m0 + NGW; const bool two = m1 < MR;
            float tot[2]; f32x4 xv[2][4];
#pragma unroll
            for (int e = 0; e < 2; ++e) {
                const int m = e ? m1 : m0;
                if (e == 0 || two) {
                    if (m < MP) { const f32x4* sp = (const f32x4*)(sq2 + (size_t)m * 16); const f32x4 q0 = sp[0], q1 = sp[1], q2 = sp[2], q3 = sp[3];
                        tot[e] = (((q0.x + q0.y) + (q0.z + q0.w)) + ((q1.x + q1.y) + (q1.z + q1.w)) + ((q2.x + q2.y) + (q2.z + q2.w)) + ((q3.x + q3.y) + (q3.z + q3.w))); }
                    else tot[e] = wave_sum(((const float*)(ws + WS_SQS2))[(size_t)(m - MP) * 64 + lane]);
                    const f32x4* o = (const f32x4*)(a.out + OUT_Y + (size_t)m * D);
#pragma unroll
                    for (int j = 0; j < 4; ++j) xv[e][j] = o[lane + 64 * j];
                }
            }
#pragma unroll
            for (int e = 0; e < 2; ++e) {
                const int m = e ? m1 : m0;
                if (e == 0 || two) {
                    const float rs = 1.0f / sqrtf(tot[e] * (1.f / D) + EPS);
                    f32x4* o = (f32x4*)(a.out + OUT_Y + (size_t)m * D);
#pragma unroll
                    for (int j = 0; j < 4; ++j) o[lane + 64 * j] = xv[e][j] * rs * ((const f32x4*)fg)[lane + 64 * j];
                }
            }
        }
    }
#endif

}

extern "C" void kernel_launch(void* const* d_in, const int* in_sizes, int n_in, void* d_out, int out_size, void* d_ws, size_t ws_size, hipStream_t stream) {
    static int grid = 0;
    if (grid == 0) {
        if (n_in != 26 || ws_size < WS_END) { fprintf(stderr, "kernel_launch: unexpected n_in %d or ws_size %zu (need %zu)\n", n_in, ws_size, (size_t)WS_END); grid = -1; return; }
        int dev = 0, cus = 0, per_cu = 0;
        hipGetDevice(&dev); hipDeviceGetAttribute(&cus, hipDeviceAttributeMultiprocessorCount, dev);
        if (hipFuncSetAttribute((const void*)fwd_mega, hipFuncAttributeMaxDynamicSharedMemorySize, LDS_BYTES) != hipSuccess) { fprintf(stderr, "kernel_launch: hipFuncSetAttribute failed\n"); grid = -1; return; }
        hipOccupancyMaxActiveBlocksPerMultiprocessor(&per_cu, (const void*)fwd_mega, 512, LDS_BYTES);
        if (per_cu < 1) { fprintf(stderr, "kernel_launch: occupancy query says %d blocks per CU\n", per_cu); per_cu = 1; }
        (void)hipGetLastError();
        grid = cus * 1;
        fprintf(stderr, "kernel_launch: grid %d (cus %d, per_cu %d), ws %zu\n", grid, cus, per_cu, ws_size);
    }
    if (grid < 0) return;
    Args a{};
    for (int i = 0; i < 26; ++i) a.in[i] = (const float*)d_in[i];
    a.out = (float*)d_out; a.ws = (unsigned char*)d_ws;
    if (hipMemsetAsync((char*)d_ws + WS_BAR, 0, XCD_BAR_WORDS * 4, stream) != hipSuccess) { fprintf(stderr, "kernel_launch: memset failed\n"); return; }
    void* args[] = {&a};
    hipError_t e = hipLaunchCooperativeKernel((const void*)fwd_mega, dim3(grid), dim3(512), args, LDS_BYTES, stream);
    if (e != hipSuccess) fprintf(stderr, "kernel_launch: cooperative launch failed: %s\n", hipGetErrorString(e));
}
```

```cpp
#include <hip/hip_runtime.h>
#include <hip/hip_cooperative_groups.h>
#include <cstdio>
#include <cstdint>
namespace cg = cooperative_groups;

#define LAS __attribute__((address_space(3)))
typedef unsigned short bf16_t;
typedef short bf16x8 __attribute__((ext_vector_type(8)));
typedef short bf16x4 __attribute__((ext_vector_type(4)));
typedef float f32x4 __attribute__((ext_vector_type(4)));
typedef float f32x2 __attribute__((ext_vector_type(2)));
typedef unsigned u32x4 __attribute__((ext_vector_type(4)));
typedef unsigned u32x2 __attribute__((ext_vector_type(2)));
typedef __bf16 nbf2 __attribute__((ext_vector_type(2)));

constexpr int D = 1024, NB = 8, T = 2048, MP = NB * T  , MS = 128, MR = MP + MS  , MALL = 16640  ;
constexpr int NCOLS = 12416, NP = 12544  ;
constexpr int O_K = 1024, O_V = 2048, O_GA = 4096, O_SH = 6144, O_GB = 9344, O_MA = 10368, O_MB = 11392;
constexpr int RH = 4, RDK = 256, RDV = 512, RCH = 128;
constexpr int WH = 16, WN = 64;
constexpr int PLE = 256;
constexpr float EPS = 1e-6f;
constexpr int REC = 12544;
constexpr int R_AT = 0, R_RT = 2048, R_BP = 4096, R_KP = 6144, R_VT = 8192, R_AAK = 10240, R_TT = 10752, R_ARB = 11264, R_ARK = 11776, R_WC = 12288;

constexpr size_t MiB = 1u << 20;
constexpr size_t WS_CTL = 0;
constexpr size_t WS_ROPE = 1 * MiB;
constexpr size_t WS_W2T = 4 * MiB, WS_A2T = WS_W2T + 131072;
constexpr size_t WS_WPLE = 5 * MiB, WS_WDB = 6 * MiB, WS_WOUT = 8 * MiB, WS_WGATE = 10 * MiB, WS_WDA = 12 * MiB, WS_WIN = 16 * MiB;
constexpr size_t WS_PB = 41 * MiB, WS_H = 50 * MiB  , WS_KT = 83 * MiB, WS_SQA = 115 * MiB, WS_BC = 117 * MiB, WS_OPSS = 119 * MiB  ;
constexpr size_t WS_OA = 122 * MiB, WS_P = 188 * MiB, WS_CH = 587 * MiB  , WS_OB = 786 * MiB  ;
constexpr size_t WS_T1 = WS_CH, WS_MG = WS_CH + 65 * MiB, WS_X1B = WS_CH + 98 * MiB, WS_GT = WS_CH + 131 * MiB, WS_X1 = WS_OB + 65 * MiB  ;
constexpr size_t WS_END = 916 * MiB;
constexpr size_t WS_BAR = 512 * 1024;
constexpr size_t WS_SQS1 = 640 * 1024, WS_SQS2 = 704 * 1024;
constexpr size_t WS_SQ1P = WS_KT, WS_SQ2P = WS_KT + 2 * MiB;

constexpr size_t OUT_Y = 0, OUT_RETP = 16908288, OUT_RWP = 21102592, OUT_SHP = 21626880, OUT_RETS = 21635072, OUT_RWS = 88743936, OUT_SHS = 97132544;

__device__ __forceinline__ unsigned pk2(float lo, float hi) { f32x2 v = {lo, hi}; nbf2 r = __builtin_convertvector(v, nbf2); return __builtin_bit_cast(unsigned, r); }
__device__ __forceinline__ unsigned short f2bf(float f) { return (unsigned short)(pk2(f, 0.f) & 0xffffu); }
__device__ __forceinline__ float bf2f(unsigned short b) { return __uint_as_float(((unsigned)b) << 16); }
__device__ __forceinline__ float bflo(unsigned w) { return __uint_as_float(w << 16); }
__device__ __forceinline__ float bfhi(unsigned w) { return __uint_as_float(w & 0xffff0000u); }
__device__ __forceinline__ float sigm(float x) { return __builtin_amdgcn_rcpf(1.f + __expf(-x)); }
__device__ __forceinline__ float silu_(float x) { return x * sigm(x); }
__device__ __forceinline__ float wave_sum(float v) {
#pragma unroll
    for (int o = 1; o < 64; o <<= 1) v += __shfl_xor(v, o);
    return v;
}
#define MFMA32(a, b, c) __builtin_amdgcn_mfma_f32_16x16x32_bf16((a), (b), (c), 0, 0, 0)
#define LDS_WAIT() asm volatile("s_waitcnt lgkmcnt(0)" ::: "memory")

namespace pg8 {
constexpr int BM = 256, BK = 64, HALF = 128, HTB = HALF * BK * 2, STAGE_BYTES = 8 * HTB, NXCD = 8, WGM = 8;
__host__ __device__ __forceinline__ int lds_byte(int r, int c) { const int st = (r >> 4) * 2 + (c >> 5), rr = r & 15, cc = c & 31, ob = rr * 64 + cc * 2; return st * 1024 + (ob ^ (((ob >> 9) & 1) << 5)); }
__host__ __device__ __forceinline__ void stage_rc(int b, int& R, int& C) { const int st = b / 1024, sb = b % 1024, swz = sb ^ (((sb >> 9) & 1) << 5); R = (st >> 1) * 16 + swz / 64; C = (st & 1) * 32 + (swz % 64) / 2; }
__host__ __device__ __forceinline__ int perm32(int rho) { const int n = rho >> 4, i = rho & 15; return 8 * (i >> 2) + 4 * n + (i & 3); }
struct Unit { int pm, pn; };
struct Gemm { const bf16_t* A; const bf16_t* Bt; int M, N, K; };
struct StaticOrder {
    int nM, nN, nwg, G, c;
    __host__ __device__ void init(int M, int N, int G_, int c_) { nM = M / BM; nN = N / BM; nwg = nM * nN; G = G_; c = c_; }
    __host__ __device__ bool next(int i, Unit& u) const {
        const long L = (long)i * G + c; if (L >= nwg) return false;
        int wgid = (int)L; { const int q = nwg / NXCD, r = nwg % NXCD, xcd = wgid % NXCD, off = wgid / NXCD; wgid = (xcd < r ? xcd * (q + 1) : r * (q + 1) + (xcd - r) * q) + off; }
        const int nig = WGM * nN, gid = wgid / nig, fm = gid * WGM, gsz = (nM - fm) < WGM ? (nM - fm) : WGM;
        u.pm = fm + ((wgid % nig) % gsz); u.pn = (wgid % nig) / gsz; return true;
    }
};
template <class Epi>
__device__ __forceinline__ void gemm_phase(LAS unsigned char* lds, const Gemm g, const StaticOrder& S, const Epi& E) {
    int tid = threadIdx.x; asm volatile("" : "+v"(tid));
    const int wid = __builtin_amdgcn_readfirstlane(tid >> 6), lane = tid & 63, wr = wid >> 2, wc = wid & 3, fr = lane & 15, fq = lane >> 4;
    const int K = g.K, nt = K / BK;
    unsigned voffA[2], voffB[2];
#pragma unroll
    for (int i = 0; i < 2; ++i) { int R, C; stage_rc(tid * 16 + i * 8192, R, C); const int Rb = Epi::PERM ? ((R & ~31) + perm32(R & 31)) : R;
        voffA[i] = (unsigned)(R * K + C) * 2u; voffB[i] = (unsigned)(Rb * K + C) * 2u; }
    const size_t kstep = (size_t)(BK * 2);
    const size_t hstep = (size_t)HALF * K * 2;
    const size_t tstep = 2 * hstep;
    const unsigned ldsw = (unsigned)wid * 1024u;
    const int aoff = lds_byte(wr * 64 + fr, fq * 8), boff = lds_byte(wc * 32 + fr, fq * 8);
#define PG8_SA(b, h) (((b) * 2 + (h)) * HTB)
#define PG8_SB(b, h) ((4 + (b) * 2 + (h)) * HTB)
#define PG8_STAGE(bufoff, gbase, voff) do { _Pragma("unroll") for (int _i = 0; _i < 2; ++_i) \
        __builtin_amdgcn_global_load_lds((const unsigned*)((const char*)(gbase) + (voff)[_i]), (LAS unsigned*)(lds + (bufoff) + ldsw + _i * 8192), 16, 0, 0); } while (0)
#define PG8_LDA(dst, b, h) do { _Pragma("unroll") for (int m = 0; m < 4; ++m) _Pragma("unroll") for (int k = 0; k < 2; ++k) dst[m][k] = *(const LAS bf16x8*)(lds + PG8_SA(b, h) + aoff + m * 2048 + k * 1024); } while (0)
#define PG8_LDB(dst, b, h) do { _Pragma("unroll") for (int n = 0; n < 2; ++n) _Pragma("unroll") for (int k = 0; k < 2; ++k) dst[n][k] = *(const LAS bf16x8*)(lds + PG8_SB(b, h) + boff + n * 2048 + k * 1024); } while (0)
#define PG8_MMA(ai, bj, At, Bt) do { __builtin_amdgcn_s_setprio(1); _Pragma("unroll") for (int m = 0; m < 4; ++m) _Pragma("unroll") for (int n = 0; n < 2; ++n) _Pragma("unroll") for (int k = 0; k < 2; ++k) \
        acc[ai][bj][m][n] = __builtin_amdgcn_mfma_f32_16x16x32_bf16(Bt[n][k], At[m][k], acc[ai][bj][m][n], 0, 0, 0); __builtin_amdgcn_s_setprio(0); } while (0)
#define PG8_WAIT_V(n) asm volatile("s_waitcnt vmcnt(" #n ")" ::: "memory")
#define PG8_WAIT_L(n) asm volatile("s_waitcnt lgkmcnt(" #n ")" ::: "memory")
#define PG8_BAR __builtin_amdgcn_s_barrier()
#define PG8_SCHED __builtin_amdgcn_sched_barrier(0)
    Unit cur, nxt; int ui = 0;
    if (!S.next(0, cur)) return;
    f32x4 acc[2][2][4][2];
#pragma unroll
    for (int a = 0; a < 2; ++a)
#pragma unroll
        for (int b = 0; b < 2; ++b)
#pragma unroll
            for (int m = 0; m < 4; ++m)
#pragma unroll
                for (int n = 0; n < 2; ++n) acc[a][b][m][n] = (f32x4){0.f, 0.f, 0.f, 0.f};
    bf16x8 At[4][2], B0[2][2], B1[2][2];
    const char* cA = (const char*)g.A + (size_t)cur.pm * tstep; const char* cB = (const char*)g.Bt + (size_t)cur.pn * tstep;
    PG8_STAGE(PG8_SB(0, 0), cB, voffB); PG8_STAGE(PG8_SA(0, 0), cA, voffA); PG8_STAGE(PG8_SB(0, 1), cB + hstep, voffB); PG8_STAGE(PG8_SA(0, 1), cA + hstep, voffA);
    if (wr == 1) PG8_BAR;
    PG8_WAIT_V(4); PG8_BAR;
    PG8_STAGE(PG8_SB(1, 0), cB + kstep, voffB); PG8_STAGE(PG8_SA(1, 0), cA + kstep, voffA); PG8_STAGE(PG8_SB(1, 1), cB + hstep + kstep, voffB);
    PG8_WAIT_V(6); PG8_BAR;
    for (;;) {
        const bool has_next = S.next(ui + 1, nxt);
        const char* nA = has_next ? (const char*)g.A + (size_t)nxt.pm * tstep : cA; const char* nB = has_next ? (const char*)g.Bt + (size_t)nxt.pn * tstep : cB;
#pragma unroll 1
        for (int t = 0; t < nt; t += 2) {
            const bool last = (t == nt - 2);
            const char* a1 = cA + (size_t)(t + 1) * kstep;
            const char* a2 = last ? nA : cA + (size_t)(t + 2) * kstep; const char* b2 = last ? nB : cB + (size_t)(t + 2) * kstep;
            const char* a3 = a2 + kstep; const char* b3 = b2 + kstep;
            PG8_LDB(B0, 0, 0); PG8_SCHED; PG8_LDA(At, 0, 0); PG8_STAGE(PG8_SA(1, 1), a1 + hstep, voffA);
            PG8_WAIT_L(8); PG8_BAR; PG8_WAIT_L(0); PG8_MMA(0, 0, At, B0); PG8_BAR; PG8_SCHED;
            PG8_LDB(B1, 0, 1); PG8_STAGE(PG8_SB(0, 0), b2, voffB);
            PG8_BAR; PG8_WAIT_L(0); PG8_MMA(0, 1, At, B1); PG8_BAR;
            PG8_LDA(At, 0, 1); PG8_STAGE(PG8_SA(0, 0), a2, voffA);
            PG8_BAR; PG8_WAIT_L(0); PG8_MMA(1, 0, At, B0); PG8_BAR; PG8_SCHED;
            PG8_STAGE(PG8_SB(0, 1), b2 + hstep, voffB);
            PG8_WAIT_V(6); PG8_BAR; PG8_MMA(1, 1, At, B1); PG8_BAR;
            PG8_LDB(B0, 1, 0); PG8_SCHED; PG8_LDA(At, 1, 0); PG8_STAGE(PG8_SA(0, 1), a2 + hstep, voffA);
            PG8_WAIT_L(8); PG8_BAR; PG8_WAIT_L(0); PG8_MMA(0, 0, At, B0); PG8_BAR; PG8_SCHED;
            PG8_LDB(B1, 1, 1); PG8_STAGE(PG8_SB(1, 0), b3, voffB);
            PG8_BAR; PG8_WAIT_L(0); PG8_MMA(0, 1, At, B1); PG8_BAR;
            PG8_LDA(At, 1, 1); PG8_STAGE(PG8_SA(1, 0), a3, voffA);
            PG8_BAR; PG8_WAIT_L(0); PG8_MMA(1, 0, At, B0); PG8_BAR; PG8_SCHED;
            PG8_STAGE(PG8_SB(1, 1), b3 + hstep, voffB);
            PG8_WAIT_V(6); PG8_BAR; PG8_MMA(1, 1, At, B1); PG8_BAR;
        }
        E(acc, cur, wr, wc, fr, fq);
        if (!has_next) break;
#pragma unroll
        for (int a = 0; a < 2; ++a)
#pragma unroll
            for (int b = 0; b < 2; ++b)
#pragma unroll
                for (int m = 0; m < 4; ++m)
#pragma unroll
                    for (int n = 0; n < 2; ++n) acc[a][b][m][n] = (f32x4){0.f, 0.f, 0.f, 0.f};
        cur = nxt; cA = nA; cB = nB; ++ui;
    }
    PG8_WAIT_V(0);
    if (wr == 0) PG8_BAR;
    PG8_BAR;
#undef PG8_SA
#undef PG8_SB
#undef PG8_STAGE
#undef PG8_LDA
#undef PG8_LDB
#undef PG8_MMA
#undef PG8_WAIT_V
#undef PG8_WAIT_L
#undef PG8_BAR
#undef PG8_SCHED
}
}
using pg8::Unit;

struct Args {
    const float* in[26];
    float* out; unsigned char* ws;
};
#define KAS __attribute__((address_space(4)))
__device__ __forceinline__ const KAS char* kargp() { const KAS char* p = (const KAS char*)__builtin_amdgcn_kernarg_segment_ptr(); asm volatile("" : "+s"(p)); return p; }


enum { I_XP = 0, I_XS, I_SRET, I_SRW, I_SSH, I_PP, I_PS, I_NG, I_WIN, I_MU, I_W0, I_W2, I_A0, I_A2, I_KK, I_KA, I_RK, I_LNW, I_LNB, I_WDA, I_WDB, I_WOUT, I_WPLE, I_PNG, I_WPG, I_FNG };

__device__ __forceinline__ void p0_transpose_item(const float* W, int K, int N, bf16_t* WT, LAS float* scr, int item, int lane, const float* kscale) {
    const int nblk = N / 32, kb = item / nblk, nb = item % nblk, k0 = 64 * kb, n0 = 32 * nb;
#pragma unroll 8
    for (int i = 0; i < 32; ++i) { const int kk = 2 * i + (lane >> 5); float v = W[(size_t)(k0 + kk) * N + n0 + (lane & 31)]; if (kscale) v *= kscale[k0 + kk]; scr[kk * 33 + (lane & 31)] = v; }
    LDS_WAIT();
    const int c = lane & 7;
#pragma unroll
    for (int j = 0; j < 4; ++j) { const int n = (lane >> 3) + 8 * j; const LAS float* s = scr + (8 * c) * 33 + n;
        u32x4 o; o.x = pk2(s[0 * 33], s[1 * 33]); o.y = pk2(s[2 * 33], s[3 * 33]); o.z = pk2(s[4 * 33], s[5 * 33]); o.w = pk2(s[6 * 33], s[7 * 33]);
        *(u32x4*)(WT + (size_t)(n0 + n) * K + k0 + 8 * c) = o; }
    LDS_WAIT();
}

__device__ __forceinline__ void phase0(const Args& a, LAS unsigned char* lds, int gw, int NGW, int wave, int lane) {
    unsigned char* ws = a.ws;
    LAS float* scr = (LAS float*)(lds + wave * 16384);
    constexpr int I_IN = (D / 64) * (NCOLS / 32), I_DA = (2048 / 64) * (D / 32), I_SQ = (D / 64) * (D / 32), I_PL = (PLE / 64) * (D / 32), I_LR = 1 * (D / 32);
    constexpr int NITEMS = I_IN + I_DA + 3 * I_SQ + I_PL + 2 * I_LR;
    const bool defer3 = NGW >= 128 * 8;
    for (int it = gw; it < NITEMS; it += NGW) {
        int r = it;
        if (defer3 && r >= I_IN && r < I_IN + I_DA + 3 * I_SQ + I_PL) continue;
        if (r < I_IN) { p0_transpose_item(a.in[I_WIN], D, NCOLS, (bf16_t*)(ws + WS_WIN), scr, r, lane, nullptr); continue; } r -= I_IN;
        if (r < I_DA) { p0_transpose_item(a.in[I_WDA], 2048, D, (bf16_t*)(ws + WS_WDA), scr, r, lane, nullptr); continue; } r -= I_DA;
        if (r < I_SQ) { p0_transpose_item(a.in[I_WDB], D, D, (bf16_t*)(ws + WS_WDB), scr, r, lane, nullptr); continue; } r -= I_SQ;
        if (r < I_SQ) { p0_transpose_item(a.in[I_WOUT], D, D, (bf16_t*)(ws + WS_WOUT), scr, r, lane, nullptr); continue; } r -= I_SQ;
        if (r < I_SQ) { p0_transpose_item(a.in[I_WPG], D, D, (bf16_t*)(ws + WS_WGATE), scr, r, lane, a.in[I_PNG]); continue; } r -= I_SQ;
        if (r < I_PL) { p0_transpose_item(a.in[I_WPLE], PLE, D, (bf16_t*)(ws + WS_WPLE), scr, r, lane, nullptr); continue; } r -= I_PL;
        if (r < I_LR) { p0_transpose_item(a.in[I_W2], 64, D, (bf16_t*)(ws + WS_W2T), scr, r, lane, nullptr); continue; } r -= I_LR;
        p0_transpose_item(a.in[I_A2], 64, D, (bf16_t*)(ws + WS_A2T), scr, r, lane, nullptr);
    }
    for (int i = gw * 64 + lane; i < 128 * D / 8; i += NGW * 64) ((u32x4*)(ws + WS_WIN + (size_t)NCOLS * D * 2))[i] = (u32x4){0u, 0u, 0u, 0u};
    bf16_t* H = (bf16_t*)(ws + WS_H);
    const float* ng = a.in[I_NG];
    for (int m = gw; m < MALL; m += NGW) {
        if (m < MR) {
            const float* xr = (m < MP) ? a.in[I_XP] + (size_t)m * D : a.in[I_XS] + (size_t)(m - MP) * D;
            f32x4 v[4]; float s = 0.f;
#pragma unroll
            for (int j = 0; j < 4; ++j) { v[j] = ((const f32x4*)xr)[lane + 64 * j]; s += (v[j].x * v[j].x + v[j].y * v[j].y) + (v[j].z * v[j].z + v[j].w * v[j].w); }
            const float rs = 1.0f / sqrtf(wave_sum(s) * (1.f / D) + EPS);
            float* so = nullptr;
            if (m < MP) { if ((m & (T - 1)) == T - 1) so = a.out + OUT_SHP + (size_t)(m >> 11) * D; } else so = a.out + OUT_SHS + (size_t)(m - MP) * D;
#pragma unroll
            for (int j = 0; j < 4; ++j) { const f32x4 gg = ((const f32x4*)ng)[lane + 64 * j]; f32x4 h = v[j] * rs * gg;
                if (so) ((f32x4*)so)[lane + 64 * j] = h;
                u32x2 o; o.x = pk2(h.x, h.y); o.y = pk2(h.z, h.w); ((u32x2*)(H + (size_t)m * D))[lane + 64 * j] = o; }
        } else {
            const float* xr = a.in[I_SSH] + (size_t)(m - MR) * D;
#pragma unroll
            for (int j = 0; j < 4; ++j) { const f32x4 h = ((const f32x4*)xr)[lane + 64 * j]; u32x2 o; o.x = pk2(h.x, h.y); o.y = pk2(h.z, h.w); ((u32x2*)(H + (size_t)m * D))[lane + 64 * j] = o; }
        }
        u32x2 o = {0u, 0u};
        if (m < MR) { const float* pr = (m < MP) ? a.in[I_PP] + (size_t)m * PLE : a.in[I_PS] + (size_t)(m - MP) * PLE; const f32x4 p = ((const f32x4*)pr)[lane]; o.x = pk2(p.x, p.y); o.y = pk2(p.z, p.w); }
        ((u32x2*)(ws + WS_PB + (size_t)m * PLE * 2))[lane] = o;
    }
    for (int i = gw * 64 + lane; i < 2049 * 128; i += NGW * 64) {
        const int pos = i >> 7, j = i & 127; const double p = (pos == 2048) ? 16384.0 : (double)pos;
        double inv = 1.0, base = 0.9305720409296989; int e = j;
        while (e) { if (e & 1) inv *= base; base *= base; e >>= 1; }
        double rev = p * inv * 0.15915494309189535; rev -= floor(rev);
        const float fr = (float)rev;
        ((f32x2*)(ws + WS_ROPE))[i] = (f32x2){__builtin_amdgcn_cosf(fr), __builtin_amdgcn_sinf(fr)};
    }
    for (int i = gw * 64 + lane; i < 65536 + 64; i += NGW * 64) ((float*)(ws + WS_CTL))[i] = 0.f;
}

__device__ __forceinline__ void p0_late(const Args& a, LAS float* scr, int w, int nw, int lane) {
    unsigned char* ws = a.ws;
    constexpr int I_DA = (2048 / 64) * (D / 32), I_SQ = (D / 64) * (D / 32), I_PL = (PLE / 64) * (D / 32);
    for (int it = w; it < I_DA + 3 * I_SQ + I_PL; it += nw) {
        int r = it;
        if (r < I_DA) { p0_transpose_item(a.in[I_WDA], 2048, D, (bf16_t*)(ws + WS_WDA), scr, r, lane, nullptr); continue; } r -= I_DA;
        if (r < I_SQ) { p0_transpose_item(a.in[I_WDB], D, D, (bf16_t*)(ws + WS_WDB), scr, r, lane, nullptr); continue; } r -= I_SQ;
        if (r < I_SQ) { p0_transpose_item(a.in[I_WOUT], D, D, (bf16_t*)(ws + WS_WOUT), scr, r, lane, nullptr); continue; } r -= I_SQ;
        if (r < I_SQ) { p0_transpose_item(a.in[I_WPG], D, D, (bf16_t*)(ws + WS_WGATE), scr, r, lane, a.in[I_PNG]); continue; } r -= I_SQ;
        p0_transpose_item(a.in[I_WPLE], PLE, D, (bf16_t*)(ws + WS_WPLE), scr, r, lane, nullptr);
    }
}

struct EpiP {
    static constexpr bool PERM = true;
    bf16_t* P; bf16_t* KT; const f32x2* rope;
    __device__ __forceinline__ void operator()(const f32x4 (&acc)[2][2][4][2], const Unit& u, int wr, int wc, int fr, int fq) const {
        const int pn = u.pn, pm = u.pm;
        const int row0 = pm * 256 + wr * 64 + fr, cl0 = wc * 32 + 8 * fq;
        const bool sample = (pm == 64);
        if (pn < 8) {
            const int h = pn & 3; const bool isk = pn >= 4;
            const float l2g = __log2f(1.f - exp2f(-5.f - (float)h));
#pragma unroll
            for (int ai = 0; ai < 2; ++ai)
#pragma unroll
                for (int m = 0; m < 4; ++m) {
                    const int row = row0 + ai * 128 + m * 16;
                    int pos, ex;
                    if (sample) { pos = 2048; ex = isk ? 0 : 1; } else { pos = row & (T - 1); const int idx = pos & 127; ex = isk ? 127 - idx : idx + 1; }
                    const float sc = exp2f((float)ex * l2g) * (isk ? 0.0625f : 1.0f);
                    const f32x4* rp = (const f32x4*)(rope + pos * 128 + cl0);
                    f32x4 cs[4]; cs[0] = rp[0]; cs[1] = rp[1]; cs[2] = rp[2]; cs[3] = rp[3];
                    float y1[8], y2[8];
#pragma unroll
                    for (int n = 0; n < 2; ++n)
#pragma unroll
                        for (int e = 0; e < 4; ++e) {
                            const float c = (e & 1) ? cs[n * 2 + (e >> 1)].z : cs[n * 2 + (e >> 1)].x, s = (e & 1) ? cs[n * 2 + (e >> 1)].w : cs[n * 2 + (e >> 1)].y;
                            const float x1 = acc[ai][0][m][n][e], x2 = acc[ai][1][m][n][e];
                            y1[n * 4 + e] = (x1 * c - x2 * s) * sc; y2[n * 4 + e] = (x2 * c + x1 * s) * sc;
                        }
                    u32x4 w1, w2;
                    w1.x = pk2(y1[0], y1[1]); w1.y = pk2(y1[2], y1[3]); w1.z = pk2(y1[4], y1[5]); w1.w = pk2(y1[6], y1[7]);
                    w2.x = pk2(y2[0], y2[1]); w2.y = pk2(y2[2], y2[3]); w2.z = pk2(y2[4], y2[5]); w2.w = pk2(y2[6], y2[7]);
                    bf16_t* rowp = P + (size_t)row * NP + pn * 256 + cl0;
                    *(u32x4*)rowp = w1; *(u32x4*)(rowp + 128) = w2;
                    if (isk && !sample) {
                        bf16_t* kt = KT + ((size_t)((row >> 11) * 4 + h) * 256 + cl0) * T + pos;
#pragma unroll
                        for (int j = 0; j < 8; ++j) { kt[(size_t)j * T] = f2bf(y1[j]); kt[(size_t)(j + 128) * T] = f2bf(y2[j]); }
                    }
                }
            return;
        }
#pragma unroll
        for (int bj = 0; bj < 2; ++bj) {
            const int cb = pn * 2 + bj;
            if (cb >= 97) continue;
            const int mode = 0;
            const bool vt = (cb < 32) && !sample;
#pragma unroll
            for (int ai = 0; ai < 2; ++ai)
#pragma unroll
                for (int m = 0; m < 4; ++m) {
                    const int row = row0 + ai * 128 + m * 16;
                    float y[8];
#pragma unroll
                    for (int n = 0; n < 2; ++n)
#pragma unroll
                        for (int e = 0; e < 4; ++e) { float x = acc[ai][bj][m][n][e]; if (mode == 1) x = x * sigm(x); else if (mode == 2) x = sigm(x); y[n * 4 + e] = x; }
                    if (vt) {
                        const int hd = cb * 128 + cl0 - O_V;
                        bf16_t* vp = P + ((size_t)(row >> 11) * T + hd) * NP + O_V + (row & (T - 1));
#pragma unroll
                        for (int j = 0; j < 8; ++j) vp[(size_t)j * NP] = f2bf(y[j]);
                    } else {
                        u32x4 w; w.x = pk2(y[0], y[1]); w.y = pk2(y[2], y[3]); w.z = pk2(y[4], y[5]); w.w = pk2(y[6], y[7]);
                        *(u32x4*)(P + (size_t)row * NP + cb * 128 + cl0) = w;
                    }
                }
        }
    }
};

__device__ __forceinline__ float lerp_bf(const bf16_t* cur, const bf16_t* prv, float mu) { const float c = bf2f(*cur); const float p = bf2f(*prv); return c + (p - c) * mu; }

__device__ __forceinline__ void rw_prep_item(const Args& a, LAS unsigned char* wl  , int tt, int h, int lane) {
    unsigned char* ws = a.ws;
    const bf16_t* P = (const bf16_t*)(ws + WS_P);
    const int l15 = lane & 15, quad = lane >> 4;
    const bool sample = tt >= 1024;
    const int row_base = sample ? MP + (tt - 1024) * 16 : tt * 16;
    const float* mu = a.in[I_MU];
    bf16x8 Aw[2], Aa[2];
    {
        const int m = row_base + l15;
        const bf16_t* cur = P + (size_t)m * NP + O_SH;
        const bf16_t* zrow = (const bf16_t*)(ws + WS_WIN + (size_t)NCOLS * D * 2);
        const bf16_t* prv = sample ? P + (size_t)(m + MS) * NP + O_SH : ((m & (T - 1)) ? cur - NP : zrow + O_SH);
#pragma unroll
        for (int which = 0; which < 2; ++which)
#pragma unroll
            for (int ks = 0; ks < 2; ++ks) {
                const int col = 3072 + which * 64 + ks * 32 + quad * 8;
                const u32x4 cw = *(const u32x4*)(cur + col); const u32x4 pw = *(const u32x4*)(prv + col);
                const f32x4 m0 = *(const f32x4*)(mu + col), m1 = *(const f32x4*)(mu + col + 4);
                float z[8];
                const unsigned cws[4] = {cw.x, cw.y, cw.z, cw.w}, pws[4] = {pw.x, pw.y, pw.z, pw.w};
#pragma unroll
                for (int j = 0; j < 4; ++j) {
                    const float c0 = bflo(cws[j]), c1 = bfhi(cws[j]), p0 = bflo(pws[j]), p1 = bfhi(pws[j]);
                    const float mm0 = (j < 2) ? m0[2 * j] : m1[2 * j - 4], mm1 = (j < 2) ? m0[2 * j + 1] : m1[2 * j - 3];
                    z[2 * j] = c0 + (p0 - c0) * mm0; z[2 * j + 1] = c1 + (p1 - c1) * mm1;
                }
                if (which == 0) {
#pragma unroll
                    for (int j = 0; j < 8; ++j) z[j] = 1.f - 2.f / (__expf(2.f * z[j]) + 1.f);
                }
                u32x4 o; o.x = pk2(z[0], z[1]); o.y = pk2(z[2], z[3]); o.z = pk2(z[4], z[5]); o.w = pk2(z[6], z[7]);
                if (which == 0) Aw[ks] = __builtin_bit_cast(bf16x8, o); else Aa[ks] = __builtin_bit_cast(bf16x8, o);
            }
    }
    const bf16_t* W2T = (const bf16_t*)(ws + WS_W2T); const bf16_t* A2T = (const bf16_t*)(ws + WS_A2T);
    unsigned char* rec = ws + WS_CH + ((size_t)((tt >> 7) * 16 + h) * 128 + (tt & 127)) * REC;
    LAS bf16_t* LA = (LAS bf16_t*)wl;
    LAS bf16_t* LR = LA + 16 * 72;
    LAS bf16_t* LB = LR + 16 * 72;
    LAS bf16_t* LK = LB + 16 * 72;
    LAS float* LN = (LAS float*)(wl + 9216);
    float tA[4][4], tBi[4][4], tBp[4][4];
    float ssq[4] = {0.f, 0.f, 0.f, 0.f}, bon[4] = {0.f, 0.f, 0.f, 0.f};
#pragma unroll
    for (int nt = 0; nt < 4; ++nt) {
        const int ch = h * 64 + nt * 16 + l15, cc = nt * 16 + l15;
        f32x4 cw = {0.f, 0.f, 0.f, 0.f}, ca = {0.f, 0.f, 0.f, 0.f};
#pragma unroll
        for (int ks = 0; ks < 2; ++ks) {
            const bf16x8 bw = *(const bf16x8*)(W2T + (size_t)ch * 64 + ks * 32 + quad * 8), ba = *(const bf16x8*)(A2T + (size_t)ch * 64 + ks * 32 + quad * 8);
            cw = MFMA32(Aw[ks], bw, cw); ca = MFMA32(Aa[ks], ba, ca);
        }
        const float w0 = a.in[I_W0][ch], a0 = a.in[I_A0][ch], k_k = a.in[I_KK][ch], k_a = a.in[I_KA][ch], r_k = a.in[I_RK][ch];
        const float mur = mu[ch], muk = mu[1024 + ch], muv = mu[2048 + ch];
        float lw[4], rr[4], kq[4], vv[4], aa4[4], kr4[4];
#pragma unroll
        for (int r = 0; r < 4; ++r) {
            const int m = row_base + quad * 4 + r;
            const bf16_t* cur = P + (size_t)m * NP + O_SH + ch;
            const bf16_t* prv = sample ? P + (size_t)(m + MS) * NP + O_SH + ch : ((m & (T - 1)) ? cur - NP : (const bf16_t*)(ws + WS_WIN + (size_t)NCOLS * D * 2) + O_SH + ch);
            const float r_ = lerp_bf(cur, prv, mur), k_ = lerp_bf(cur + 1024, prv + 1024, muk), v_ = lerp_bf(cur + 2048, prv + 2048, muv);
            lw[r] = -0.6065306597126334f * sigm(w0 + cw[r]);
            const float aa = sigm(a0 + ca[r]); aa4[r] = aa;
            const float kr = k_ * k_k; kr4[r] = kr; ssq[r] += kr * kr;
            const float kpp = k_ * (1.f + (aa - 1.f) * k_a); kq[r] = kpp;
            rr[r] = r_; vv[r] = v_; bon[r] += r_ * kpp * r_k;
        }
        if (sample) {
#pragma unroll
            for (int r = 0; r < 4; ++r) {
                const int i = (tt - 1024) * 16 + quad * 4 + r;
                float* o = (float*)(ws + WS_OPSS) + ((size_t)(i * 16 + h) * 6) * 64 + cc;
                o[0] = rr[r]; o[64] = __expf(lw[r]); o[128] = kq[r]; o[320] = vv[r];
                tA[nt][r] = kr4[r]; tBi[nt][r] = aa4[r] * kr4[r]; tBp[nt][r] = 0.f;
            }
        } else {
            float c[4]; c[0] = lw[0]; c[1] = c[0] + lw[1]; c[2] = c[1] + lw[2]; c[3] = c[2] + lw[3];
            const float tot = c[3];
            const float s1 = __shfl(tot, (lane - 16) & 63), s2 = __shfl(tot, (lane - 32) & 63), s3 = __shfl(tot, (lane - 48) & 63);
            const float off = (quad >= 1 ? s1 : 0.f) + (quad >= 2 ? s2 : 0.f) + (quad >= 3 ? s3 : 0.f);
            const float total = __shfl(c[3] + off, 48 + l15);
            float kqp[4];
#pragma unroll
            for (int r = 0; r < 4; ++r) {
                const float cum = c[r] + off, cumx = cum - lw[r];
                const float ea = __expf(cumx), er = __expf(cum), ei = __expf(-cum), ep = __expf(total - cum);
                const int tk = quad * 4 + r;
                LR[tk * 72 + cc] = f2bf(rr[r] * er); LK[tk * 72 + cc] = f2bf(kq[r] * ei);
                kqp[r] = kq[r] * ep;
                tA[nt][r] = kr4[r] * ea; tBi[nt][r] = aa4[r] * kr4[r] * ei; tBp[nt][r] = aa4[r] * kr4[r] * ep;
            }
            *(u32x2*)(rec + R_KP + cc * 32 + quad * 8) = (u32x2){pk2(kqp[0], kqp[1]), pk2(kqp[2], kqp[3])};
            *(u32x2*)(rec + R_VT + cc * 32 + quad * 8) = (u32x2){pk2(vv[0], vv[1]), pk2(vv[2], vv[3])};
            if (quad == 0) *(float*)(rec + R_WC + cc * 4) = __expf(total);
        }
        asm volatile("" ::: "memory");
    }
    float inv[4];
#pragma unroll
    for (int r = 0; r < 4; ++r) {
        float s = ssq[r], b = bon[r];
#pragma unroll
        for (int o = 1; o < 16; o <<= 1) { s += __shfl_xor(s, o); b += __shfl_xor(b, o); }
        inv[r] = 1.f / fmaxf(sqrtf(s), 1e-12f);
        if (l15 == 0) ((float*)(ws + WS_BC))[(size_t)(row_base + quad * 4 + r) * 16 + h] = b;
    }
    if (sample) {
#pragma unroll
        for (int nt = 0; nt < 4; ++nt)
#pragma unroll
            for (int r = 0; r < 4; ++r) {
                const int i = (tt - 1024) * 16 + quad * 4 + r;
                float* o = (float*)(ws + WS_OPSS) + ((size_t)(i * 16 + h) * 6) * 64 + nt * 16 + l15;
                o[192] = tA[nt][r] * inv[r]; o[256] = tBi[nt][r] * inv[r];
            }
        return;
    }
#pragma unroll
    for (int nt = 0; nt < 4; ++nt) {
        const int cc = nt * 16 + l15;
        float bp[4];
#pragma unroll
        for (int r = 0; r < 4; ++r) { const int tk = quad * 4 + r;
            LA[tk * 72 + cc] = f2bf(-tA[nt][r] * inv[r]); LB[tk * 72 + cc] = f2bf(tBi[nt][r] * inv[r]); bp[r] = tBp[nt][r] * inv[r]; }
        *(u32x2*)(rec + R_BP + cc * 32 + quad * 8) = (u32x2){pk2(bp[0], bp[1]), pk2(bp[2], bp[3])};
    }
    LDS_WAIT();
#pragma unroll
    for (int i = 0; i < 2; ++i) { const int idx = lane + 64 * i, rr = idx >> 3, c8 = (idx & 7) * 8;
        *(u32x4*)(rec + R_AT + rr * 128 + c8 * 2) = *(const LAS u32x4*)(LA + rr * 72 + c8);
        *(u32x4*)(rec + R_RT + rr * 128 + c8 * 2) = *(const LAS u32x4*)(LR + rr * 72 + c8); }
    f32x4 nab = {0.f, 0.f, 0.f, 0.f}, nak = nab, nrb = nab, nrk = nab;
#pragma unroll
    for (int ks = 0; ks < 2; ++ks) {
        const bf16x8 fa = *(const LAS bf16x8*)(LA + l15 * 72 + ks * 32 + quad * 8), fr_ = *(const LAS bf16x8*)(LR + l15 * 72 + ks * 32 + quad * 8);
        const bf16x8 fb = *(const LAS bf16x8*)(LB + l15 * 72 + ks * 32 + quad * 8), fk = *(const LAS bf16x8*)(LK + l15 * 72 + ks * 32 + quad * 8);
        nab = MFMA32(fa, fb, nab); nak = MFMA32(fa, fk, nak); nrb = MFMA32(fr_, fb, nrb); nrk = MFMA32(fr_, fk, nrk);
    }
#pragma unroll
    for (int r = 0; r < 4; ++r) {
        const int t = quad * 4 + r, j = l15;
        const float vab = (j < t) ? nab[r] : 0.f, vak = (j < t) ? nak[r] : 0.f, vrb = (j <= t) ? nrb[r] : 0.f, vrk = (j <= t) ? nrk[r] : 0.f;
        LN[t * 16 + j] = vab;
        *(bf16_t*)(rec + R_AAK + (t * 16 + j) * 2) = f2bf(vak);
        *(bf16_t*)(rec + R_ARB + (t * 16 + j) * 2) = f2bf(vrb);
        *(bf16_t*)(rec + R_ARK + (t * 16 + j) * 2) = f2bf(vrk);
    }
    LDS_WAIT();
    if (lane < 16) {
        float tc[16];
#pragma unroll
        for (int t = 0; t < 16; ++t) {
            float s = (t == lane) ? 1.f : 0.f;
#pragma unroll
            for (int j = 0; j < t; ++j) s += LN[t * 16 + j] * tc[j];
            tc[t] = s;
            *(bf16_t*)(rec + R_TT + (t * 16 + lane) * 2) = f2bf(s);
        }
    }
    LDS_WAIT();
}

__device__ __forceinline__ bf16x8 k16(u32x2 v) { const u32x4 w = {v.x, v.y, 0u, 0u}; return __builtin_bit_cast(bf16x8, w); }
#define SCAN_DECL(F) bf16x8 F##_at0, F##_at1, F##_rt0, F##_rt1; u32x2 F##_aak, F##_tt, F##_arb, F##_ark, F##_vt, F##_bp0, F##_bp1, F##_bp2, F##_bp3, F##_kp0, F##_kp1, F##_kp2, F##_kp3; float F##_wc0, F##_wc1, F##_wc2, F##_wc3
#define SCAN_LOAD(F, REC_) do { const unsigned char* rec_ = (REC_); \
    F##_at0 = *(const bf16x8*)(rec_ + R_AT + o_nat); F##_at1 = *(const bf16x8*)(rec_ + R_AT + o_nat + 64); \
    F##_rt0 = *(const bf16x8*)(rec_ + R_RT + o_nat); F##_rt1 = *(const bf16x8*)(rec_ + R_RT + o_nat + 64); \
    F##_aak = *(const u32x2*)(rec_ + R_AAK + o_sm); F##_tt = *(const u32x2*)(rec_ + R_TT + o_sm); F##_arb = *(const u32x2*)(rec_ + R_ARB + o_sm); F##_ark = *(const u32x2*)(rec_ + R_ARK + o_sm); \
    F##_vt = *(const u32x2*)(rec_ + R_VT + vt * 512 + o_sm); \
    F##_bp0 = *(const u32x2*)(rec_ + R_BP + o_sm); F##_bp1 = *(const u32x2*)(rec_ + R_BP + 512 + o_sm); F##_bp2 = *(const u32x2*)(rec_ + R_BP + 1024 + o_sm); F##_bp3 = *(const u32x2*)(rec_ + R_BP + 1536 + o_sm); \
    F##_kp0 = *(const u32x2*)(rec_ + R_KP + o_sm); F##_kp1 = *(const u32x2*)(rec_ + R_KP + 512 + o_sm); F##_kp2 = *(const u32x2*)(rec_ + R_KP + 1024 + o_sm); F##_kp3 = *(const u32x2*)(rec_ + R_KP + 1536 + o_sm); \
    F##_wc0 = *(const float*)(rec_ + R_WC + l15 * 4); F##_wc1 = *(const float*)(rec_ + R_WC + 64 + l15 * 4); F##_wc2 = *(const float*)(rec_ + R_WC + 128 + l15 * 4); F##_wc3 = *(const float*)(rec_ + R_WC + 192 + l15 * 4); } while (0)
#define SCAN_UPD(NT, BP, KP, WC) do { f32x4 sn = S##NT * (WC); sn = MFMA32(ua, k16(BP), sn); sn = MFMA32(vtf, k16(KP), sn); S##NT = sn; \
    _Pragma("unroll") for (int r = 0; r < 4; ++r) Sb[(quad * 4 + r) * 72 + NT * 16 + l15] = f2bf(sn[r]); } while (0)
#define SCAN_STEP(F, N, CH) do { const int ch_ = (CH); \
    SCAN_LOAD(N, rec0 + (size_t)(ch_ < 126 ? ch_ + 2 : 127) * REC); \
    const bf16x8 sa0 = *(const LAS bf16x8*)(Sb + l15 * 72 + quad * 8), sa1 = *(const LAS bf16x8*)(Sb + l15 * 72 + 32 + quad * 8); \
    const bf16x8 vtf = k16(F##_vt); const f32x4 z = {0.f, 0.f, 0.f, 0.f}; \
    f32x4 Y = MFMA32(sa0, F##_at0, z); Y = MFMA32(sa1, F##_at1, Y); Y = MFMA32(vtf, k16(F##_aak), Y); \
    _Pragma("unroll") for (int r = 0; r < 4; ++r) Yb[(quad * 4 + r) * 16 + l15] = f2bf(Y[r]); \
    LDS_WAIT(); \
    const bf16x8 ya = k16(*(const LAS u32x2*)(Yb + l15 * 16 + quad * 4)); \
    f32x4 U = MFMA32(ya, k16(F##_tt), z); \
    _Pragma("unroll") for (int r = 0; r < 4; ++r) Ub[(quad * 4 + r) * 16 + l15] = f2bf(U[r]); \
    LDS_WAIT(); \
    const bf16x8 ua = k16(*(const LAS u32x2*)(Ub + l15 * 16 + quad * 4)); \
    f32x4 O = MFMA32(sa0, F##_rt0, z); O = MFMA32(sa1, F##_rt1, O); O = MFMA32(ua, k16(F##_arb), O); O = MFMA32(vtf, k16(F##_ark), O); \
    *(u32x2*)(ob + (size_t)(ch_ * 16 + l15) * D) = (u32x2){pk2(O[0], O[1]), pk2(O[2], O[3])}; \
    SCAN_UPD(0, F##_bp0, F##_kp0, F##_wc0); SCAN_UPD(1, F##_bp1, F##_kp1, F##_wc1); SCAN_UPD(2, F##_bp2, F##_kp2, F##_wc2); SCAN_UPD(3, F##_bp3, F##_kp3, F##_wc3); \
    LDS_WAIT(); __builtin_amdgcn_sched_barrier(0); } while (0)
__device__ __forceinline__ void rw_scan_task(const Args& a, LAS unsigned char* wl  , int b, int h, int vt, int lane) {
    unsigned char* ws = a.ws;
    const int l15 = lane & 15, quad = lane >> 4;
    LAS bf16_t* Sb = (LAS bf16_t*)wl;
    LAS bf16_t* Yb = (LAS bf16_t*)(wl + 2304);
    LAS bf16_t* Ub = (LAS bf16_t*)(wl + 2304 + 512);
    const int o_nat = l15 * 128 + quad * 16, o_sm = l15 * 32 + quad * 8;
    const unsigned char* rec0 = ws + WS_CH + (size_t)((b * 16 + h) * 128) * REC;
    bf16_t* ob = (bf16_t*)(ws + WS_OB) + (size_t)(b * T) * D + h * 64 + vt * 16 + quad * 4;
    f32x4 S0 = {0.f, 0.f, 0.f, 0.f}, S1 = S0, S2 = S0, S3 = S0;
#pragma unroll
    for (int nt = 0; nt < 4; ++nt)
#pragma unroll
        for (int r = 0; r < 4; ++r) Sb[(quad * 4 + r) * 72 + nt * 16 + l15] = 0;
    LDS_WAIT();
    SCAN_DECL(f0); SCAN_DECL(f1); SCAN_DECL(f2);
    SCAN_LOAD(f0, rec0); SCAN_LOAD(f1, rec0 + REC);
    for (int ch = 0; ch < 126; ch += 3) { SCAN_STEP(f0, f2, ch); SCAN_STEP(f1, f0, ch + 1); SCAN_STEP(f2, f1, ch + 2); }
    SCAN_STEP(f0, f2, 126); SCAN_STEP(f1, f0, 127);
    float* so = a.out + OUT_RWP + (size_t)((b * 16 + h) * 64 + vt * 16) * 64;
#pragma unroll
    for (int r = 0; r < 4; ++r) { so[(quad * 4 + r) * 64 + l15] = S0[r]; so[(quad * 4 + r) * 64 + 16 + l15] = S1[r]; so[(quad * 4 + r) * 64 + 32 + l15] = S2[r]; so[(quad * 4 + r) * 64 + 48 + l15] = S3[r]; }
}

__device__ __forceinline__ void rw_sample_wave(const Args& a, int i, int h, int lane) {
    unsigned char* ws = a.ws;
    const float* s0 = a.in[I_SRW] + ((size_t)(i * 16 + h) * 64 + lane) * 64;
    const float* op = (const float*)(ws + WS_OPSS) + (size_t)(i * 16 + h) * 6 * 64;
    float s[64];
#pragma unroll
    for (int j = 0; j < 16; ++j) { const f32x4 t = ((const f32x4*)s0)[j]; s[4 * j] = t.x; s[4 * j + 1] = t.y; s[4 * j + 2] = t.z; s[4 * j + 3] = t.w; }
    const float r_l = op[lane], w_l = op[64 + lane], k_l = op[128 + lane], kk_l = op[192 + lane], b_l = op[256 + lane], v = op[320 + lane];
#define RL(x, j) __builtin_bit_cast(float, __builtin_amdgcn_readlane(__builtin_bit_cast(int, (x)), (j)))
    float sk = 0.f;
#pragma unroll
    for (int j = 0; j < 64; ++j) sk += s[j] * RL(kk_l, j);
    float o = 0.f;
#pragma unroll
    for (int j = 0; j < 64; ++j) { s[j] = s[j] * RL(w_l, j) - sk * RL(b_l, j) + v * RL(k_l, j); o += s[j] * RL(r_l, j); }
#undef RL
    float* so = a.out + OUT_RWS + ((size_t)(i * 16 + h) * 64 + lane) * 64;
#pragma unroll
    for (int j = 0; j < 16; ++j) ((f32x4*)so)[j] = (f32x4){s[4 * j], s[4 * j + 1], s[4 * j + 2], s[4 * j + 3]};
    ((bf16_t*)(ws + WS_OB))[(size_t)(MP + i) * D + h * 64 + lane] = f2bf(o);
}

constexpr int KN_LD = 264, VS_LD = 136, SS_LD = 264;
constexpr int L_KN = 0, L_VS = 128 * KN_LD * 2  , L_SS = L_VS + 64 * VS_LD * 2  , L_RET_END = L_SS + 64 * SS_LD * 2  ;
__device__ __forceinline__ void ret_unit(const Args& a, LAS unsigned char* lds, int unit, int tid) {
    unsigned char* ws = a.ws;
    const bf16_t* P = (const bf16_t*)(ws + WS_P);
    const int dvs = unit & 7, h = (unit >> 3) & 3, b = unit >> 5;
    const int wave = tid >> 6, lane = tid & 63, l15 = lane & 15, quad = lane >> 4;
    LAS bf16_t* KN = (LAS bf16_t*)(lds + L_KN); LAS bf16_t* VS = (LAS bf16_t*)(lds + L_VS); LAS bf16_t* SS = (LAS bf16_t*)(lds + L_SS);
    const float g = 1.f - exp2f(-5.f - (float)h), l2g = __log2f(g);
    const float gC = exp2f(128.f * l2g), ginvC = exp2f(-128.f * l2g);
    const bf16_t* KT = (const bf16_t*)(ws + WS_KT) + (size_t)(b * 4 + h) * 256 * T;
    f32x4 sacc[2][4];
#pragma unroll
    for (int n = 0; n < 2; ++n)
#pragma unroll
        for (int d = 0; d < 4; ++d) sacc[n][d] = (f32x4){0.f, 0.f, 0.f, 0.f};
    for (int i = tid; i < 64 * SS_LD / 2; i += 512) ((LAS unsigned*)SS)[i] = 0u;
    const int it = wave;
    u32x4 stk[8], stv[2];
#define RET_ISSUE(CC) do { const int tok0_ = b * T + (CC) * 128; \
        _Pragma("unroll") for (int i = 0; i < 8; ++i) { const int idx = tid + 512 * i, r = idx >> 5, c8 = (idx & 31) * 8; stk[i] = *(const u32x4*)(P + (size_t)(tok0_ + r) * NP + O_K + h * 256 + c8); } \
        _Pragma("unroll") for (int i = 0; i < 2; ++i) { const int idx = tid + 512 * i, r = idx >> 4, c8 = (idx & 15) * 8; stv[i] = *(const u32x4*)(P + (size_t)(b * T + h * 512 + dvs * 64 + r) * NP + O_V + (CC) * 128 + c8); } } while (0)
    bf16x8 qf[8];
#define RET_ISSUE_Q(CC) do { const int tokq_ = b * T + (CC) * 128 + it * 16 + l15; \
        _Pragma("unroll") for (int ks = 0; ks < 8; ++ks) qf[ks] = *(const bf16x8*)(P + (size_t)tokq_ * NP + h * 256 + ks * 32 + quad * 8); } while (0)
    RET_ISSUE(0); RET_ISSUE_Q(0);
    for (int c = 0; c < 16; ++c) {
        const int tok0 = b * T + c * 128;
#pragma unroll
        for (int i = 0; i < 8; ++i) { const int idx = tid + 512 * i, r = idx >> 5, c8 = (idx & 31) * 8; *(LAS u32x4*)(KN + r * KN_LD + c8) = stk[i]; }
#pragma unroll
        for (int i = 0; i < 2; ++i) { const int idx = tid + 512 * i, r = idx >> 4, c8 = (idx & 15) * 8; *(LAS u32x4*)(VS + r * VS_LD + c8) = stv[i]; }
        __syncthreads();
        bf16x8 ktf[2][4];
#pragma unroll
        for (int n = 0; n < 2; ++n)
#pragma unroll
            for (int ks = 0; ks < 4; ++ks) ktf[n][ks] = *(const bf16x8*)(KT + (size_t)((2 * wave + n) * 16 + l15) * T + c * 128 + ks * 32 + quad * 8);
        if (c < 15) RET_ISSUE(c + 1);
        f32x4 oacc[4];
#pragma unroll
        for (int d = 0; d < 4; ++d) oacc[d] = (f32x4){0.f, 0.f, 0.f, 0.f};
#pragma unroll
        for (int ks = 0; ks < 8; ++ks)
#pragma unroll
            for (int d = 0; d < 4; ++d) { const bf16x8 sb = *(const LAS bf16x8*)(SS + (d * 16 + l15) * SS_LD + ks * 32 + quad * 8); oacc[d] = MFMA32(qf[ks], sb, oacc[d]); }
#pragma unroll
        for (int p = 0; p < 4; ++p) {
            if (2 * p <= it) {
                f32x4 s0 = {0.f, 0.f, 0.f, 0.f}, s1 = {0.f, 0.f, 0.f, 0.f};
#pragma unroll
                for (int ks = 0; ks < 8; ++ks) { const bf16x8 ka = *(const LAS bf16x8*)(KN + ((2 * p) * 16 + l15) * KN_LD + ks * 32 + quad * 8); s0 = MFMA32(ka, qf[ks], s0); }
                if (2 * p + 1 <= it) {
#pragma unroll
                    for (int ks = 0; ks < 8; ++ks) { const bf16x8 ka = *(const LAS bf16x8*)(KN + ((2 * p + 1) * 16 + l15) * KN_LD + ks * 32 + quad * 8); s1 = MFMA32(ka, qf[ks], s1); }
                }
#pragma unroll
                for (int r = 0; r < 4; ++r) {
                    const int jl = quad * 4 + r;
                    s0[r] = (2 * p == it && jl > l15) ? 0.f : s0[r] * ginvC;
                    s1[r] = (2 * p + 1 > it || (2 * p + 1 == it && jl > l15)) ? 0.f : s1[r] * ginvC;
                }
                u32x4 aw; aw.x = pk2(s0[0], s0[1]); aw.y = pk2(s0[2], s0[3]); aw.z = pk2(s1[0], s1[1]); aw.w = pk2(s1[2], s1[3]);
                const bf16x8 af = __builtin_bit_cast(bf16x8, aw);
#pragma unroll
                for (int d = 0; d < 4; ++d) {
                    const LAS bf16_t* vr = VS + (d * 16 + l15) * VS_LD + 32 * p + quad * 4;
                    const u32x2 lo = *(const LAS u32x2*)vr, hi = *(const LAS u32x2*)(vr + 16);
                    const u32x4 bw = {lo.x, lo.y, hi.x, hi.y};
                    oacc[d] = MFMA32(af, __builtin_bit_cast(bf16x8, bw), oacc[d]);
                }
            }
        }
        if (c < 15) RET_ISSUE_Q(c + 1);
        {
            bf16_t* OA = (bf16_t*)(ws + WS_OA); float* SQA = (float*)(ws + WS_SQA);
#pragma unroll
            for (int r = 0; r < 4; ++r) {
                const int tok = tok0 + it * 16 + quad * 4 + r;
                float ss = 0.f;
#pragma unroll
                for (int d = 0; d < 4; ++d) { const float v = oacc[d][r]; ss += v * v; OA[(size_t)tok * 2048 + h * 512 + dvs * 64 + d * 16 + l15] = f2bf(v); }
#pragma unroll
                for (int o = 1; o < 16; o <<= 1) ss += __shfl_xor(ss, o);
                if (l15 == 0) SQA[(size_t)tok * 32 + h * 8 + dvs] = ss;
            }
        }
        __syncthreads();
#pragma unroll
        for (int n = 0; n < 2; ++n)
#pragma unroll
            for (int d = 0; d < 4; ++d) {
                f32x4 s = sacc[n][d] * gC;
#pragma unroll
                for (int ks = 0; ks < 4; ++ks) { const bf16x8 va = *(const LAS bf16x8*)(VS + (d * 16 + l15) * VS_LD + ks * 32 + quad * 8); s = MFMA32(va, ktf[n][ks], s); }
                sacc[n][d] = s;
#pragma unroll
                for (int r = 0; r < 4; ++r) SS[(d * 16 + quad * 4 + r) * SS_LD + (2 * wave + n) * 16 + l15] = f2bf(s[r]);
            }
        __syncthreads();
    }
    float* so = a.out + OUT_RETP + (size_t)(b * 4 + h) * 256 * 512;
#pragma unroll
    for (int n = 0; n < 2; ++n)
#pragma unroll
        for (int d = 0; d < 4; ++d) *(f32x4*)(so + (size_t)((2 * wave + n) * 16 + l15) * 512 + dvs * 64 + d * 16 + quad * 4) = sacc[n][d];
}
#undef RET_ISSUE
#undef RET_ISSUE_Q

__device__ __forceinline__ void ret_sample_unit(const Args& a, LAS unsigned char* lds, int i, int h, int tid) {
    unsigned char* ws = a.ws;
    const bf16_t* Prow = (const bf16_t*)(ws + WS_P) + (size_t)(MP + i) * NP;
    LAS float* Q = (LAS float*)lds; LAS float* Kh = Q + 256; LAS float* RED = Kh + 256; LAS float* OS = RED + 16;
    const float g = 1.f - exp2f(-5.f - (float)h);
    const int lane = tid & 63, wave = tid >> 6;
    float qk = 0.f;
    if (tid < 256) { const float q = bf2f(Prow[h * 256 + tid]), k = bf2f(Prow[O_K + h * 256 + tid]); Q[tid] = q; Kh[tid] = k; qk = q * k; }
    qk = wave_sum(qk);
    if (lane == 0) RED[wave] = qk;
    __syncthreads();
    const float qkv = (RED[0] + RED[1] + RED[2] + RED[3]) / g;
    const int dkg = tid >> 7, dv4 = 4 * (tid & 127);
    const u32x2 vw = *(const u32x2*)(Prow + O_V + h * 512 + dv4);
    const f32x4 v = {bflo(vw.x), bfhi(vw.x), bflo(vw.y), bfhi(vw.y)};
    const float* s0 = a.in[I_SRET] + (size_t)(i * 4 + h) * 256 * 512 + dv4;
    float* s1 = a.out + OUT_RETS + (size_t)(i * 4 + h) * 256 * 512 + dv4;
    f32x4 o = {0.f, 0.f, 0.f, 0.f};
#pragma unroll 8
    for (int j = 0; j < 64; ++j) {
        const int dk = dkg * 64 + j;
        const f32x4 s = __builtin_nontemporal_load((const f32x4*)(s0 + (size_t)dk * 512));
        o += s * Q[dk];
        __builtin_nontemporal_store(s * g + v * Kh[dk], (f32x4*)(s1 + (size_t)dk * 512));
    }
    *(LAS f32x4*)(OS + dkg * 512 + dv4) = o;
    __syncthreads();
    float y[4] = {0.f, 0.f, 0.f, 0.f}; float ss = 0.f;
    if (tid < 128) {
        const f32x4 t = *(LAS f32x4*)(OS + dv4) + *(LAS f32x4*)(OS + 512 + dv4) + *(LAS f32x4*)(OS + 1024 + dv4) + *(LAS f32x4*)(OS + 1536 + dv4) + v * qkv;
        y[0] = t.x; y[1] = t.y; y[2] = t.z; y[3] = t.w; ss = t.x * t.x + t.y * t.y + t.z * t.z + t.w * t.w;
    }
    ss = wave_sum(ss);
    if (lane == 0) RED[8 + wave] = ss;
    __syncthreads();
    if (tid < 128) {
        const float rs = 1.0f / sqrtf((RED[8] + RED[9]) * (1.f / 512.f) + EPS);
        const u32x2 gw = *(const u32x2*)(Prow + O_GA + h * 512 + dv4);
        u32x2 ow; ow.x = pk2(y[0] * rs * silu_(bflo(gw.x)), y[1] * rs * silu_(bfhi(gw.x))); ow.y = pk2(y[2] * rs * silu_(bflo(gw.y)), y[3] * rs * silu_(bfhi(gw.y)));
        *(u32x2*)((bf16_t*)(ws + WS_OA) + (size_t)(MP + i) * 2048 + h * 512 + dv4) = ow;
    }
    __syncthreads();
}

__device__ __forceinline__ void ret_sample_wave(const Args& a, int i, int h, int lane) {
    unsigned char* ws = a.ws;
    const bf16_t* Prow = (const bf16_t*)(ws + WS_P) + (size_t)(MP + i) * NP;
    const float g = 1.f - exp2f(-5.f - (float)h);
    float q[4], k[4]; float qk = 0.f;
#pragma unroll
    for (int j = 0; j < 4; ++j) { q[j] = bf2f(Prow[h * 256 + 64 * j + lane]); k[j] = bf2f(Prow[O_K + h * 256 + 64 * j + lane]); qk += q[j] * k[j]; }
    const float qkv = wave_sum(qk) / g;
    f32x4 v[2];
#pragma unroll
    for (int e = 0; e < 2; ++e) { const u32x2 vw = *(const u32x2*)(Prow + O_V + h * 512 + e * 256 + lane * 4); v[e] = (f32x4){bflo(vw.x), bfhi(vw.x), bflo(vw.y), bfhi(vw.y)}; }
    const float* s0 = a.in[I_SRET] + (size_t)(i * 4 + h) * 256 * 512 + lane * 4;
    float* s1 = a.out + OUT_RETS + (size_t)(i * 4 + h) * 256 * 512 + lane * 4;
    f32x4 o[2] = {{0.f, 0.f, 0.f, 0.f}, {0.f, 0.f, 0.f, 0.f}};
#pragma unroll
    for (int j = 0; j < 4; ++j) {
        for (int d0 = 0; d0 < 64; d0 += 16) {
            f32x4 sv[16][2];
#pragma unroll
            for (int d = 0; d < 16; ++d)
#pragma unroll
                for (int e = 0; e < 2; ++e) sv[d][e] = __builtin_nontemporal_load((const f32x4*)(s0 + (size_t)(64 * j + d0 + d) * 512 + e * 256));
#pragma unroll
            for (int d = 0; d < 16; ++d) {
                const float qd = __builtin_bit_cast(float, __builtin_amdgcn_readlane(__builtin_bit_cast(int, q[j]), d0 + d));
                const float kd = __builtin_bit_cast(float, __builtin_amdgcn_readlane(__builtin_bit_cast(int, k[j]), d0 + d));
#pragma unroll
                for (int e = 0; e < 2; ++e) { o[e] += sv[d][e] * qd; __builtin_nontemporal_store(sv[d][e] * g + v[e] * kd, (f32x4*)(s1 + (size_t)(64 * j + d0 + d) * 512 + e * 256)); }
            }
        }
    }
    float ss = 0.f;
#pragma unroll
    for (int e = 0; e < 2; ++e) { o[e] += v[e] * qkv; ss += (o[e].x * o[e].x + o[e].y * o[e].y) + (o[e].z * o[e].z + o[e].w * o[e].w); }
    const float rs = 1.0f / sqrtf(wave_sum(ss) * (1.f / 512.f) + EPS);
#pragma unroll
    for (int e = 0; e < 2; ++e) { const u32x2 gw = *(const u32x2*)(Prow + O_GA + h * 512 + e * 256 + lane * 4);
        u32x2 ow; ow.x = pk2(o[e].x * rs * silu_(bflo(gw.x)), o[e].y * rs * silu_(bfhi(gw.x))); ow.y = pk2(o[e].z * rs * silu_(bflo(gw.y)), o[e].w * rs * silu_(bfhi(gw.y)));
        *(u32x2*)((bf16_t*)(ws + WS_OA) + (size_t)(MP + i) * 2048 + h * 512 + e * 256 + lane * 4) = ow; }
}

__device__ __forceinline__ void phase25_row(const Args& a, int m, int lane) {
    unsigned char* ws = a.ws;
    const bf16_t* Prow = (const bf16_t*)(ws + WS_P) + (size_t)m * NP;
    bf16_t* oa = (bf16_t*)(ws + WS_OA) + (size_t)m * 2048;
    const float* sq = (const float*)(ws + WS_SQA) + (size_t)m * 32;
    const bool prompt = m < MP;
    f32x4 sqv[8]; u32x4 ow[4], gw4[4];
    if (prompt) {
#pragma unroll
        for (int j = 0; j < 8; ++j) sqv[j] = ((const f32x4*)sq)[j];
#pragma unroll
        for (int hh = 0; hh < 4; ++hh) { ow[hh] = *(const u32x4*)(oa + hh * 512 + lane * 8); gw4[hh] = *(const u32x4*)(Prow + O_GA + hh * 512 + lane * 8); }
    }
    const bf16_t* ob = (const bf16_t*)(ws + WS_OB) + (size_t)m * D + lane * 16;
    f32x4 ov[4];
    { const u32x4 w0 = ((const u32x4*)ob)[0], w1 = ((const u32x4*)ob)[1];
      ov[0] = (f32x4){bflo(w0.x), bfhi(w0.x), bflo(w0.y), bfhi(w0.y)}; ov[1] = (f32x4){bflo(w0.z), bfhi(w0.z), bflo(w0.w), bfhi(w0.w)};
      ov[2] = (f32x4){bflo(w1.x), bfhi(w1.x), bflo(w1.y), bfhi(w1.y)}; ov[3] = (f32x4){bflo(w1.z), bfhi(w1.z), bflo(w1.w), bfhi(w1.w)}; }
    const float bc = ((const float*)(ws + WS_BC))[(size_t)m * 16 + (lane >> 2)];
    const bf16_t* cur = Prow + O_SH + 2048 + lane * 16;
    const bool hasp = (m >= MP) || (m & (T - 1));
    const bf16_t* prv = (m >= MP) ? cur + (size_t)MS * NP : cur - NP;
    u32x4 cw[2], pw[2] = {{0u, 0u, 0u, 0u}, {0u, 0u, 0u, 0u}}, gbw[2];
    cw[0] = ((const u32x4*)cur)[0]; cw[1] = ((const u32x4*)cur)[1];
    if (hasp) { pw[0] = ((const u32x4*)prv)[0]; pw[1] = ((const u32x4*)prv)[1]; }
    gbw[0] = ((const u32x4*)(Prow + O_GB + lane * 16))[0]; gbw[1] = ((const u32x4*)(Prow + O_GB + lane * 16))[1];
    f32x4 lw4[4], lb4[4], mu4[4];
#pragma unroll
    for (int j = 0; j < 4; ++j) { lw4[j] = ((const f32x4*)(a.in[I_LNW] + lane * 16))[j]; lb4[j] = ((const f32x4*)(a.in[I_LNB] + lane * 16))[j]; mu4[j] = ((const f32x4*)(a.in[I_MU] + 2048 + lane * 16))[j]; }
    if (prompt) {
#pragma unroll
        for (int hh = 0; hh < 4; ++hh) {
            const f32x4 s0 = sqv[2 * hh], s1 = sqv[2 * hh + 1];
            const float rs = 1.0f / sqrtf(((s0.x + s0.y) + (s0.z + s0.w) + (s1.x + s1.y) + (s1.z + s1.w)) * (1.f / 512.f) + EPS);
            const u32x4 o4 = ow[hh], g4 = gw4[hh];
            u32x4 r;
            r.x = pk2(bflo(o4.x) * rs * silu_(bflo(g4.x)), bfhi(o4.x) * rs * silu_(bfhi(g4.x))); r.y = pk2(bflo(o4.y) * rs * silu_(bflo(g4.y)), bfhi(o4.y) * rs * silu_(bfhi(g4.y)));
            r.z = pk2(bflo(o4.z) * rs * silu_(bflo(g4.z)), bfhi(o4.z) * rs * silu_(bfhi(g4.z))); r.w = pk2(bflo(o4.w) * rs * silu_(bflo(g4.w)), bfhi(o4.w) * rs * silu_(bfhi(g4.w)));
            *(u32x4*)(oa + hh * 512 + lane * 8) = r;
        }
    }
    float o[16], lw[16], lb[16], mu[16];
#pragma unroll
    for (int j = 0; j < 4; ++j) { o[4 * j] = ov[j].x; o[4 * j + 1] = ov[j].y; o[4 * j + 2] = ov[j].z; o[4 * j + 3] = ov[j].w;
        lw[4 * j] = lw4[j].x; lw[4 * j + 1] = lw4[j].y; lw[4 * j + 2] = lw4[j].z; lw[4 * j + 3] = lw4[j].w;
        lb[4 * j] = lb4[j].x; lb[4 * j + 1] = lb4[j].y; lb[4 * j + 2] = lb4[j].z; lb[4 * j + 3] = lb4[j].w;
        mu[4 * j] = mu4[j].x; mu[4 * j + 1] = mu4[j].y; mu[4 * j + 2] = mu4[j].z; mu[4 * j + 3] = mu4[j].w; }
    float s = 0.f;
#pragma unroll
    for (int j = 0; j < 16; ++j) s += o[j];
    s += __shfl_xor(s, 1); s += __shfl_xor(s, 2);
    const float mean = s * (1.f / 64.f);
    float q = 0.f;
#pragma unroll
    for (int j = 0; j < 16; ++j) { const float d = o[j] - mean; q += d * d; }
    q += __shfl_xor(q, 1); q += __shfl_xor(q, 2);
    const float rstd = 1.0f / sqrtf(q * (1.f / 64.f) + 64e-5f);
    const unsigned cws[8] = {cw[0].x, cw[0].y, cw[0].z, cw[0].w, cw[1].x, cw[1].y, cw[1].z, cw[1].w};
    const unsigned pws[8] = {pw[0].x, pw[0].y, pw[0].z, pw[0].w, pw[1].x, pw[1].y, pw[1].z, pw[1].w};
    const unsigned gws[8] = {gbw[0].x, gbw[0].y, gbw[0].z, gbw[0].w, gbw[1].x, gbw[1].y, gbw[1].z, gbw[1].w};
    unsigned outw[8];
#pragma unroll
    for (int j = 0; j < 8; ++j) {
        const float c0 = bflo(cws[j]), c1 = bfhi(cws[j]), p0 = bflo(pws[j]), p1 = bfhi(pws[j]);
        const float v0 = c0 + (p0 - c0) * mu[2 * j], v1 = c1 + (p1 - c1) * mu[2 * j + 1];
        const float y0 = ((o[2 * j] - mean) * rstd * lw[2 * j] + lb[2 * j] + bc * v0) * silu_(bflo(gws[j]));
        const float y1 = ((o[2 * j + 1] - mean) * rstd * lw[2 * j + 1] + lb[2 * j + 1] + bc * v1) * silu_(bfhi(gws[j]));
        outw[j] = pk2(y0, y1);
    }
    bf16_t* yb = (bf16_t*)(ws + WS_H) + (size_t)m * D + lane * 16;
    *(u32x4*)yb = (u32x4){outw[0], outw[1], outw[2], outw[3]}; *(u32x4*)(yb + 8) = (u32x4){outw[4], outw[5], outw[6], outw[7]};
}

struct EpiT1 {
    static constexpr bool PERM = false;
    const bf16_t* P; bf16_t* T1;
    __device__ __forceinline__ void operator()(const f32x4 (&acc)[2][2][4][2], const Unit& u, int wr, int wc, int fr, int fq) const {
        const int row0 = u.pm * 256 + wr * 64 + fr, col0 = u.pn * 256 + wc * 32 + 4 * fq;
#pragma unroll
        for (int ai = 0; ai < 2; ++ai)
#pragma unroll
            for (int m = 0; m < 4; ++m) { const int row = row0 + ai * 128 + m * 16; if (row >= MR) continue;
#pragma unroll
                for (int bj = 0; bj < 2; ++bj)
#pragma unroll
                    for (int n = 0; n < 2; ++n) { const int col = col0 + bj * 128 + n * 16;
                        const u32x2 gw = *(const u32x2*)(P + (size_t)row * NP + O_MA + col);
                        const f32x4 gt = {sigm(bflo(gw.x)), sigm(bfhi(gw.x)), sigm(bflo(gw.y)), sigm(bfhi(gw.y))};
                        const f32x4 t = acc[ai][bj][m][n] * gt; *(u32x2*)(T1 + (size_t)row * D + col) = (u32x2){pk2(t.x, t.y), pk2(t.z, t.w)}; } asm volatile("" ::: "memory"); }
    }
};
struct EpiMG {
    static constexpr bool PERM = false;
    const bf16_t* P; const bf16_t* T1; bf16_t* MG;
    __device__ __forceinline__ void operator()(const f32x4 (&acc)[2][2][4][2], const Unit& u, int wr, int wc, int fr, int fq) const {
        const int row0 = u.pm * 256 + wr * 64 + fr, col0 = u.pn * 256 + wc * 32 + 4 * fq;
#pragma unroll
        for (int ai = 0; ai < 2; ++ai)
#pragma unroll
            for (int m = 0; m < 4; ++m) { const int row = row0 + ai * 128 + m * 16; if (row >= MR) continue;
#pragma unroll
                for (int bj = 0; bj < 2; ++bj)
#pragma unroll
                    for (int n = 0; n < 2; ++n) { const int col = col0 + bj * 128 + n * 16;
                        const u32x2 gw = *(const u32x2*)(P + (size_t)row * NP + O_MB + col);
                        const f32x4 gt = {sigm(bflo(gw.x)), sigm(bfhi(gw.x)), sigm(bflo(gw.y)), sigm(bfhi(gw.y))};
                        const u32x2 tw = *(const u32x2*)(T1 + (size_t)row * D + col);
                        const f32x4 v = (f32x4){bflo(tw.x), bfhi(tw.x), bflo(tw.y), bfhi(tw.y)} + acc[ai][bj][m][n] * gt;
                        *(u32x2*)(MG + (size_t)row * D + col) = (u32x2){pk2(v.x, v.y), pk2(v.z, v.w)}; } asm volatile("" ::: "memory"); }
    }
};
struct EpiX1 {
    static constexpr bool PERM = false;
    const float* xp; const float* xs; float* X1; bf16_t* X1B; float* SQ;
    __device__ __forceinline__ void operator()(const f32x4 (&acc)[2][2][4][2], const Unit& u, int wr, int wc, int fr, int fq) const {
        const int row0 = u.pm * 256 + wr * 64 + fr, col0 = u.pn * 256 + wc * 32 + 4 * fq;
#pragma unroll
        for (int ai = 0; ai < 2; ++ai)
#pragma unroll
            for (int m = 0; m < 4; ++m) { const int row = row0 + ai * 128 + m * 16; const bool ok = row < MR;
                const float* xr = (row < MP) ? xp + (size_t)row * D : xs + (size_t)(row - MP) * D;
                float ss = 0.f;
                if (ok) {
#pragma unroll
                    for (int bj = 0; bj < 2; ++bj)
#pragma unroll
                        for (int n = 0; n < 2; ++n) { const int col = col0 + bj * 128 + n * 16;
                            const f32x4 v = *(const f32x4*)(xr + col) + acc[ai][bj][m][n];
                            ss += (v.x * v.x + v.y * v.y) + (v.z * v.z + v.w * v.w);
                            *(u32x2*)(X1B + (size_t)row * D + col) = (u32x2){pk2(v.x, v.y), pk2(v.z, v.w)}; }
                }
                ss += __shfl_xor(ss, 16); ss += __shfl_xor(ss, 32);
                if (ok && fq == 0) SQ[(size_t)row * 16 + u.pn * 4 + wc] = ss; asm volatile("" ::: "memory"); }
    }
};
struct EpiGT {
    static constexpr bool PERM = false;
    const float* SQ; bf16_t* GT;
    __device__ __forceinline__ void operator()(const f32x4 (&acc)[2][2][4][2], const Unit& u, int wr, int wc, int fr, int fq) const {
        const int row0 = u.pm * 256 + wr * 64 + fr, col0 = u.pn * 256 + wc * 32 + 4 * fq;
#pragma unroll
        for (int ai = 0; ai < 2; ++ai)
#pragma unroll
            for (int m = 0; m < 4; ++m) { const int row = row0 + ai * 128 + m * 16; if (row >= MR) continue;
                const f32x4* sp = (const f32x4*)(SQ + (size_t)row * 16); const f32x4 q0 = sp[0], q1 = sp[1], q2 = sp[2], q3 = sp[3];
                const float rs = 1.0f / sqrtf((((q0.x + q0.y) + (q0.z + q0.w)) + ((q1.x + q1.y) + (q1.z + q1.w)) + ((q2.x + q2.y) + (q2.z + q2.w)) + ((q3.x + q3.y) + (q3.z + q3.w))) * (1.f / D) + EPS);
#pragma unroll
                for (int bj = 0; bj < 2; ++bj)
#pragma unroll
                    for (int n = 0; n < 2; ++n) { const int col = col0 + bj * 128 + n * 16; const f32x4 t = acc[ai][bj][m][n] * rs;
                        *(u32x2*)(GT + (size_t)row * D + col) = (u32x2){pk2(sigm(t.x), sigm(t.y)), pk2(sigm(t.z), sigm(t.w))}; } asm volatile("" ::: "memory"); }
    }
};
struct EpiX2 {
    static constexpr bool PERM = false;
    const bf16_t* X1; const bf16_t* GT; float* out; float* SQ;
    __device__ __forceinline__ void operator()(const f32x4 (&acc)[2][2][4][2], const Unit& u, int wr, int wc, int fr, int fq) const {
        const int row0 = u.pm * 256 + wr * 64 + fr, col0 = u.pn * 256 + wc * 32 + 4 * fq;
#pragma unroll
        for (int ai = 0; ai < 2; ++ai)
#pragma unroll
            for (int m = 0; m < 4; ++m) { int row = row0 + ai * 128 + m * 16; asm volatile("" : "+v"(row)); const bool ok = row < MR;
                float ss = 0.f;
                if (ok) {
#pragma unroll
                    for (int bj = 0; bj < 2; ++bj)
#pragma unroll
                        for (int n = 0; n < 2; ++n) { const int col = col0 + bj * 128 + n * 16;
                            const u32x2 gw = *(const u32x2*)(GT + (size_t)row * D + col);
                            const u32x2 xw = *(const u32x2*)(X1 + (size_t)row * D + col);
                            const f32x4 v = (f32x4){bflo(xw.x), bfhi(xw.x), bflo(xw.y), bfhi(xw.y)} + acc[ai][bj][m][n] * (f32x4){bflo(gw.x), bfhi(gw.x), bflo(gw.y), bfhi(gw.y)};
                            ss += (v.x * v.x + v.y * v.y) + (v.z * v.z + v.w * v.w);
                            *(f32x4*)(out + (size_t)row * D + col) = v; asm volatile("" ::: "memory"); }
                }
                ss += __shfl_xor(ss, 16); ss += __shfl_xor(ss, 32);
                if (ok && fq == 0) SQ[(size_t)row * 16 + u.pn * 4 + wc] = ss; asm volatile("" ::: "memory"); }
    }
};


__device__ __forceinline__ f32x4 mini_acc(const bf16_t* A, int lda, const bf16_t* Bt, int K, int kq, int l15, int quad) {
    f32x4 acc = {0.f, 0.f, 0.f, 0.f};
    const int kn = K / 128;
    const bf16_t* ap = A + (size_t)l15 * lda + kq * (K / 4) + quad * 8;
    const bf16_t* bp = Bt + (size_t)l15 * K + kq * (K / 4) + quad * 8;
#pragma unroll 4
    for (int ks = 0; ks < kn; ++ks) acc = MFMA32(*(const bf16x8*)(ap + ks * 32), *(const bf16x8*)(bp + ks * 32), acc);
    return acc;
}
__device__ __forceinline__ f32x4 mini_reduce(LAS f32x4* red, int half, int lane) { return (red[(half * 4 + 0) * 64 + lane] + red[(half * 4 + 1) * 64 + lane]) + (red[(half * 4 + 2) * 64 + lane] + red[(half * 4 + 3) * 64 + lane]); }
template <int PH> __device__ __forceinline__ void mini_phase(const Args& a, LAS unsigned char* lds, int bx, int G, int wave, int lane) {
    unsigned char* ws = a.ws;
    const int l15 = lane & 15, quad = lane >> 4, half = wave >> 2, kq = wave & 3;
    LAS f32x4* red1 = (LAS f32x4*)lds; LAS f32x4* red2 = red1 + 8 * 64;
    const bf16_t* P = (const bf16_t*)(ws + WS_P);
    for (int tp = bx; tp < 256; tp += G) {
        const int tl = tp * 2 + half, mt = tl >> 6, nt = tl & 63, row0 = MP + mt * 16, col0 = nt * 16;
        f32x4 a1, a2 = {0.f, 0.f, 0.f, 0.f};
        if (PH == 0) { a1 = mini_acc((const bf16_t*)(ws + WS_OA) + (size_t)row0 * 2048, 2048, (const bf16_t*)(ws + WS_WDA) + (size_t)col0 * 2048, 2048, kq, l15, quad);
                       a2 = mini_acc((const bf16_t*)(ws + WS_H) + (size_t)row0 * D, D, (const bf16_t*)(ws + WS_WDB) + (size_t)col0 * D, D, kq, l15, quad); }
        if (PH == 1) { a1 = mini_acc((const bf16_t*)(ws + WS_MG) + (size_t)row0 * D, D, (const bf16_t*)(ws + WS_WOUT) + (size_t)col0 * D, D, kq, l15, quad); }
        if (PH == 2) { a1 = mini_acc((const bf16_t*)(ws + WS_X1B) + (size_t)row0 * D, D, (const bf16_t*)(ws + WS_WGATE) + (size_t)col0 * D, D, kq, l15, quad);
                       a2 = mini_acc((const bf16_t*)(ws + WS_PB) + (size_t)row0 * PLE, PLE, (const bf16_t*)(ws + WS_WPLE) + (size_t)col0 * PLE, PLE, kq, l15, quad); }
        red1[wave * 64 + lane] = a1; red2[wave * 64 + lane] = a2;
        __syncthreads();
        if (kq == 0) {
            a1 = mini_reduce(red1, half, lane); a2 = mini_reduce(red2, half, lane);
            const int col = col0 + l15;
            float rs1[4] = {0.f, 0.f, 0.f, 0.f};
            if (PH == 2) {
#pragma unroll
                for (int r = 0; r < 4; ++r) { const f32x4 q = *(const f32x4*)((const float*)(ws + WS_SQS1) + (size_t)(row0 - MP + quad * 4 + r) * 64 + l15 * 4); float t = (q.x + q.y) + (q.z + q.w);
#pragma unroll
                    for (int o = 1; o < 16; o <<= 1) t += __shfl_xor(t, o);
                    rs1[r] = 1.0f / sqrtf(t * (1.f / D) + EPS); }
            }
#pragma unroll
            for (int r = 0; r < 4; ++r) {
                const int row = row0 + quad * 4 + r;
                float ss = 0.f;
                if (PH == 0) { const float ga = sigm(bf2f(P[(size_t)row * NP + O_MA + col])), gb = sigm(bf2f(P[(size_t)row * NP + O_MB + col]));
                    ((bf16_t*)(ws + WS_MG))[(size_t)row * D + col] = f2bf(a1[r] * ga + a2[r] * gb); }
                if (PH == 1) { const float x1 = a.in[I_XS][(size_t)(row - MP) * D + col] + a1[r]; ss = x1 * x1;
                    ((bf16_t*)(ws + WS_X1B))[(size_t)row * D + col] = f2bf(x1); }
                if (PH == 2) { const float x2 = bf2f(((const bf16_t*)(ws + WS_X1B))[(size_t)row * D + col]) + a2[r] * sigm(rs1[r] * a1[r]); ss = x2 * x2;
                    a.out[OUT_Y + (size_t)row * D + col] = x2; }
                if (PH != 0) {
#pragma unroll
                    for (int o = 1; o < 16; o <<= 1) ss += __shfl_xor(ss, o);
                    if (l15 == 0) ((float*)(ws + (PH == 1 ? WS_SQS1 : WS_SQS2)))[(size_t)(row - MP) * 64 + nt] = ss;
                }
            }
        }
        __syncthreads();
    }
}

#define XB_TMO      128
#define XB_XCNT(j)  (256  + 64 * (j))
#define XB_XSUB(j)  (1280 + 64 * (j))
#define XB_XGEN(j)  (2304 + 64 * (j))
#define XB_TOP      3328
#define XB_TOPGEN   3392
#define XCD_BAR_WORDS 3456
#define XB_SPIN_CAP (1u << 22)
__device__ __forceinline__ unsigned xb_ld(unsigned* p)              { return __hip_atomic_load(p, __ATOMIC_RELAXED, __HIP_MEMORY_SCOPE_AGENT); }
__device__ __forceinline__ unsigned xb_add(unsigned* p, unsigned v) { return __hip_atomic_fetch_add(p, v, __ATOMIC_RELAXED, __HIP_MEMORY_SCOPE_AGENT); }
__device__ __forceinline__ unsigned xb_xcc_id() { return (unsigned)__builtin_amdgcn_s_getreg((3 << 11) | 20) & 0xFu; }
#define XB_SPIN(cond, bar) do { unsigned _sp = 0; while (cond) { __builtin_amdgcn_s_sleep(1); \
    if ((++_sp & 255u) == 0u) { if (xb_ld(&(bar)[XB_TMO])) break; if (_sp > XB_SPIN_CAP) { atomicAdd(&(bar)[XB_TMO], 1u); break; } } } } while (0)
struct XcdBarrier { unsigned* bar; unsigned x; volatile LAS unsigned* st; };
__device__ __forceinline__ XcdBarrier xcd_barrier_post(unsigned* bar, volatile LAS unsigned* st) {
    XcdBarrier b; b.bar = bar; b.x = xb_xcc_id(); b.st = st;
    if (threadIdx.x == 0) (void)xb_add(&bar[XB_XCNT(b.x)], 1u);
    return b;
}
__device__ __forceinline__ void xcd_barrier_complete(unsigned* bar, unsigned x, unsigned& nloc, unsigned& nx) {
    const unsigned G = gridDim.x * gridDim.y * gridDim.z;
    unsigned sum, cnt, mine, sp = 0u;
    for (;;) {
        sum = 0u; cnt = 0u; mine = 0u;
#pragma unroll
        for (unsigned j = 0; j < 16; ++j) { const unsigned c = xb_ld(&bar[XB_XCNT(j)]); sum += c; cnt += (c > 0u) ? 1u : 0u; mine = (j == x) ? c : mine; }
        if (sum == G) break;
        __builtin_amdgcn_s_sleep(1);
        if ((++sp & 255u) == 0u) { if (xb_ld(&bar[XB_TMO])) break; if (sp > XB_SPIN_CAP) { atomicAdd(&bar[XB_TMO], 1u); break; } }
    }
    nloc = mine > 0u ? mine : 1u; nx = cnt > 0u ? cnt : 1u;
}
__device__ __forceinline__ void xcd_barrier(const XcdBarrier& b) {
    asm volatile("s_waitcnt vmcnt(0)" ::: "memory");
    __syncthreads();
    if (threadIdx.x == 0) {
        unsigned* bar = b.bar;
        __builtin_amdgcn_s_waitcnt(0);
        unsigned nloc = b.st[0], nx = b.st[1];
        if (nloc == 0u) { xcd_barrier_complete(bar, b.x, nloc, nx); b.st[0] = nloc; b.st[1] = nx; }
        const unsigned old = xb_add(&bar[XB_XSUB(b.x)], 1u);
        const unsigned gen = old / nloc;
        if (old + 1u == (gen + 1u) * nloc) {
            __builtin_amdgcn_fence(__ATOMIC_RELEASE, "agent");
            asm volatile("s_waitcnt vmcnt(0)" ::: "memory");
            const unsigned og = xb_add(&bar[XB_TOP], 1u);
            const unsigned tg = og / nx;
            if (og + 1u == (tg + 1u) * nx) xb_add(&bar[XB_TOPGEN], 1u);
            else XB_SPIN(xb_ld(&bar[XB_TOPGEN]) == tg, bar);
            __builtin_amdgcn_fence(__ATOMIC_ACQUIRE, "agent");
            xb_add(&bar[XB_XGEN(b.x)], 1u);
            asm volatile("s_waitcnt vmcnt(0)" ::: "memory");
        } else {
            XB_SPIN(xb_ld(&bar[XB_XGEN(b.x)]) == gen, bar);
            __builtin_amdgcn_fence(__ATOMIC_ACQUIRE, "agent");
            asm volatile("s_waitcnt vmcnt(0)" ::: "memory");
        }
    }
    __syncthreads();
}

constexpr int LDS_BYTES = 147456;
constexpr int CTL_SQ1 = 0, CTL_SQ2 = 32768, CTL_CNT = 65536;

#define GRID_SYNC() xcd_barrier(xbar)
__global__ void __launch_bounds__(512, 2) fwd_mega(Args a) {
    extern __shared__ __attribute__((aligned(16))) unsigned char lds_raw[];
    LAS unsigned char* lds = (LAS unsigned char*)lds_raw;
    cg::grid_group grid = cg::this_grid();
    const int tid = threadIdx.x, lane = tid & 63, wave = __builtin_amdgcn_readfirstlane(tid >> 6);
    const int G = gridDim.x, bx = blockIdx.x;
    const int gw = bx * 8 + wave, NGW = G * 8;
    unsigned char* ws = a.ws;
    if (tid < 16) ((LAS unsigned*)(lds + 131072 + 64))[tid] = 0u;
    __syncthreads();
    XcdBarrier xbar = xcd_barrier_post((unsigned*)(ws + WS_BAR), (volatile LAS unsigned*)(lds + 131072 + 64));
    grid.sync();

#if !defined(ONLY_PH) || ONLY_PH == 0
    phase0(a, lds, gw, NGW, wave, lane);
    GRID_SYNC();
#endif
#if !defined(ONLY_PH) || ONLY_PH == 1
    {
        pg8::Gemm g{(const bf16_t*)(ws + WS_H), (const bf16_t*)(ws + WS_WIN), MALL, NP, D}; pg8::StaticOrder S; S.init(MALL, NP, G, bx);
        EpiP E{(bf16_t*)(ws + WS_P), (bf16_t*)(ws + WS_KT), (const f32x2*)(ws + WS_ROPE)};
        pg8::gemm_phase<EpiP>(lds, g, S, E);
    }
    GRID_SYNC();
#endif
#if !defined(ONLY_PH) || ONLY_PH == 2
    for (int it = gw; it < 1032 * 16; it += NGW) rw_prep_item(a, lds + wave * 10240, it >> 4, it & 15, lane);
    GRID_SYNC();
#endif
#if !defined(ONLY_PH) || ONLY_PH == 3
    {
        if (G < 128) for (int u = gw; u < MS * 16; u += NGW) rw_sample_wave(a, u >> 4, u & 15, lane);
        if (bx < 128) { if (wave < 4) rw_scan_task(a, lds + wave * 4096, bx >> 4, bx & 15, wave, lane); else if (G >= 128) { const int u = bx * 4 + (wave - 4); ret_sample_wave(a, u >> 2, u & 3, lane); }
            if (G >= 128) { for (int u = bx * 8 + wave; u < MS * 16; u += 1024) rw_sample_wave(a, u >> 4, u & 15, lane);
                p0_late(a, (LAS float*)(lds + 16384 + wave * 14336), bx * 8 + wave, 1024, lane); }
        }
        __syncthreads();
        {
            unsigned* cnt2 = (unsigned*)(ws + WS_CTL) + CTL_CNT + 32;
            LAS unsigned* lu = (LAS unsigned*)(lds + 131072);
            for (;;) {
                if (tid == 0) *lu = atomicAdd(cnt2, 1u);
                __syncthreads();
                const unsigned unit = *lu;
                __syncthreads();
                if (unit >= (unsigned)(MS * 4) || G >= 128) break;
                ret_sample_unit(a, lds, (int)(unit >> 2), (int)(unit & 3), tid);
            }
        }
        {
            unsigned* cnt = (unsigned*)(ws + WS_CTL) + CTL_CNT;
            LAS unsigned* lu = (LAS unsigned*)(lds + 131072);
            for (;;) {
                if (tid == 0) *lu = atomicAdd(cnt, 1u);
                __syncthreads();
                const unsigned unit = *lu;
                __syncthreads();
                if (unit >= 256u) break;
                ret_unit(a, lds, (int)unit, tid);
            }
        }
    }
    GRID_SYNC();
#endif
#if !defined(ONLY_PH) || ONLY_PH == 4
    for (int m = gw; m < MR; m += NGW) phase25_row(a, m, lane);
    GRID_SYNC();
#endif
#if !defined(ONLY_PH) || ONLY_PH == 5
    {
        mini_phase<0>(a, lds, bx, G, wave, lane);
        pg8::StaticOrder S; S.init(MP, D, G, bx);
        { pg8::Gemm g{(const bf16_t*)(ws + WS_OA), (const bf16_t*)(ws + WS_WDA), MP, D, 2048}; EpiT1 E{(const bf16_t*)(ws + WS_P), (bf16_t*)(ws + WS_T1)}; pg8::gemm_phase<EpiT1>(lds, g, S, E); }
        { pg8::Gemm g{(const bf16_t*)(ws + WS_H), (const bf16_t*)(ws + WS_WDB), MP, D, D}; EpiMG E{(const bf16_t*)(ws + WS_P), (const bf16_t*)(ws + WS_T1), (bf16_t*)(ws + WS_MG)}; pg8::gemm_phase<EpiMG>(lds, g, S, E); }
    }
    GRID_SYNC();
#endif
#if !defined(ONLY_PH) || ONLY_PH == 6
    {
        mini_phase<1>(a, lds, bx, G, wave, lane);
        pg8::StaticOrder S; S.init(MP, D, G, bx);
        pg8::Gemm g{(const bf16_t*)(ws + WS_MG), (const bf16_t*)(ws + WS_WOUT), MP, D, D};
        EpiX1 E{a.in[I_XP], a.in[I_XS], (float*)(ws + WS_X1), (bf16_t*)(ws + WS_X1B), (float*)(ws + WS_SQ1P)};
        pg8::gemm_phase<EpiX1>(lds, g, S, E);
    }
    GRID_SYNC();
#endif
#if !defined(ONLY_PH) || ONLY_PH == 7
    {
        mini_phase<2>(a, lds, bx, G, wave, lane);
        pg8::StaticOrder S; S.init(MP, D, G, bx);
        { pg8::Gemm g{(const bf16_t*)(ws + WS_X1B), (const bf16_t*)(ws + WS_WGATE), MP, D, D}; EpiGT E{(const float*)(ws + WS_SQ1P), (bf16_t*)(ws + WS_GT)}; pg8::gemm_phase<EpiGT>(lds, g, S, E); }
        { pg8::Gemm g{(const bf16_t*)(ws + WS_PB), (const bf16_t*)(ws + WS_WPLE), MP, D, PLE}; EpiX2 E{(const bf16_t*)(ws + WS_X1B), (const bf16_t*)(ws + WS_GT), a.out + OUT_Y, (float*)(ws + WS_SQ2P)}; pg8::gemm_phase<EpiX2>(lds, g, S, E); }
    }
    GRID_SYNC();
#endif
#if !defined(ONLY_PH) || ONLY_PH == 8
    {
        const float* sq2 = (const float*)(ws + WS_SQ2P); const float* fg = a.in[I_FNG];
        for (int m0 = gw; m0 < MR; m0 += 2 * NGW) {
            const int m1 = m0 + NGW; const bool two = m1 < MR;
            float tot[2]; f32x4 xv[2][4];
#pragma unroll
            for (int e = 0; e < 2; ++e) {
                const int m = e ? m1 : m0;
                if (e == 0 || two) {
                    if (m < MP) { const f32x4* sp = (const f32x4*)(sq2 + (size_t)m * 16); const f32x4 q0 = sp[0], q1 = sp[1], q2 = sp[2], q3 = sp[3];
                        tot[e] = (((q0.x + q0.y) + (q0.z + q0.w)) + ((q1.x + q1.y) + (q1.z + q1.w)) + ((q2.x + q2.y) + (q2.z + q2.w)) + ((q3.x + q3.y) + (q3.z + q3.w))); }
                    else tot[e] = wave_sum(((const float*)(ws + WS_SQS2))[(size_t)(m - MP) * 64 + lane]);
                    const f32x4* o = (const f32x4*)(a.out + OUT_Y + (size_t)m * D);
#pragma unroll
                    for (int j = 0; j < 4; ++j) xv[e][j] = o[lane + 64 * j];
                }
            }
#pragma unroll
            for (int e = 0; e < 2; ++e) {
                const int m = e ? m1 : m0;
                if (e == 0 || two) {
                    const float rs = 1.0f / sqrtf(tot[e] * (1.f / D) + EPS);
                    f32x4* o = (f32x4*)(a.out + OUT_Y + (size_t)m * D);
#pragma unroll
                    for (int j = 0; j < 4; ++j) o[lane + 64 * j] = xv[e][j] * rs * ((const f32x4*)fg)[lane + 64 * j];
                }
            }
        }
    }
#endif

}

extern "C" void kernel_launch(void* const* d_in, const int* in_sizes, int n_in, void* d_out, int out_size, void* d_ws, size_t ws_size, hipStream_t stream) {
    static int grid = 0;
    if (grid == 0) {
        if (n_in != 26 || ws_size < WS_END) { fprintf(stderr, "kernel_launch: unexpected n_in %d or ws_size %zu (need %zu)\n", n_in, ws_size, (size_t)WS_END); grid = -1; return; }
        int dev = 0, cus = 0, per_cu = 0;
        hipGetDevice(&dev); hipDeviceGetAttribute(&cus, hipDeviceAttributeMultiprocessorCount, dev);
        if (hipFuncSetAttribute((const void*)fwd_mega, hipFuncAttributeMaxDynamicSharedMemorySize, LDS_BYTES) != hipSuccess) { fprintf(stderr, "kernel_launch: hipFuncSetAttribute failed\n"); grid = -1; return; }
        hipOccupancyMaxActiveBlocksPerMultiprocessor(&per_cu, (const void*)fwd_mega, 512, LDS_BYTES);
        if (per_cu < 1) { fprintf(stderr, "kernel_launch: occupancy query says %d blocks per CU\n", per_cu); per_cu = 1; }
        (void)hipGetLastError();
        grid = cus * 1;
        fprintf(stderr, "kernel_launch: grid %d (cus %d, per_cu %d), ws %zu\n", grid, cus, per_cu, ws_size);
    }
    if (grid < 0) return;
    Args a{};
    for (int i = 0; i < 26; ++i) a.in[i] = (const float*)d_in[i];
    a.out = (float*)d_out; a.ws = (unsigned char*)d_ws;
    if (hipMemsetAsync((char*)d_ws + WS_BAR, 0, XCD_BAR_WORDS * 4, stream) != hipSuccess) { fprintf(stderr, "kernel_launch: memset failed\n"); return; }
    void* args[] = {&a};
    hipError_t e = hipLaunchCooperativeKernel((const void*)fwd_mega, dim3(grid), dim3(512), args, LDS_BYTES, stream);
    if (e != hipSuccess) fprintf(stderr, "kernel_launch: cooperative launch failed: %s\n", hipGetErrorString(e));
}
```

```cpp
#include <hip/hip_runtime.h>
#include <hip/hip_cooperative_groups.h>
#include <cstdio>
#include <cstdint>
namespace cg = cooperative_groups;

#define LAS __attribute__((address_space(3)))
typedef unsigned short bf16_t;
typedef short bf16x8 __attribute__((ext_vector_type(8)));
typedef short bf16x4 __attribute__((ext_vector_type(4)));
typedef float f32x4 __attribute__((ext_vector_type(4)));
typedef float f32x2 __attribute__((ext_vector_type(2)));
typedef unsigned u32x4 __attribute__((ext_vector_type(4)));
typedef unsigned u32x2 __attribute__((ext_vector_type(2)));
typedef __bf16 nbf2 __attribute__((ext_vector_type(2)));

constexpr int D = 1024, NB = 8, T = 2048, MP = NB * T  , MS = 128, MR = MP + MS  , MALL = 16640  ;
constexpr int NCOLS = 12416, NP = 12544  ;
constexpr int O_K = 1024, O_V = 2048, O_GA = 4096, O_SH = 6144, O_GB = 9344, O_MA = 10368, O_MB = 11392;
constexpr int RH = 4, RDK = 256, RDV = 512, RCH = 128;
constexpr int WH = 16, WN = 64;
constexpr int PLE = 256;
constexpr float EPS = 1e-6f;
constexpr int REC = 12544;
constexpr int R_AT = 0, R_RT = 2048, R_BP = 4096, R_KP = 6144, R_VT = 8192, R_AAK = 10240, R_TT = 10752, R_ARB = 11264, R_ARK = 11776, R_WC = 12288;

constexpr size_t MiB = 1u << 20;
constexpr size_t WS_CTL = 0;
constexpr size_t WS_ROPE = 1 * MiB;
constexpr size_t WS_W2T = 4 * MiB, WS_A2T = WS_W2T + 131072;
constexpr size_t WS_WPLE = 5 * MiB, WS_WDB = 6 * MiB, WS_WOUT = 8 * MiB, WS_WGATE = 10 * MiB, WS_WDA = 12 * MiB, WS_WIN = 16 * MiB;
constexpr size_t WS_PB = 41 * MiB, WS_H = 50 * MiB  , WS_KT = 83 * MiB, WS_SQA = 115 * MiB, WS_BC = 117 * MiB, WS_OPSS = 119 * MiB  ;
constexpr size_t WS_OA = 122 * MiB, WS_P = 188 * MiB, WS_CH = 587 * MiB  , WS_OB = 786 * MiB  ;
constexpr size_t WS_T1 = WS_CH, WS_MG = WS_CH + 65 * MiB, WS_X1B = WS_CH + 98 * MiB, WS_GT = WS_CH + 131 * MiB, WS_X1 = WS_OB + 65 * MiB  ;
constexpr size_t WS_END = 916 * MiB;
constexpr size_t WS_BAR = 512 * 1024;
constexpr size_t WS_SQS1 = 640 * 1024, WS_SQS2 = 704 * 1024;
constexpr size_t WS_SQ1P = WS_KT, WS_SQ2P = WS_KT + 2 * MiB;

constexpr size_t OUT_Y = 0, OUT_RETP = 16908288, OUT_RWP = 21102592, OUT_SHP = 21626880, OUT_RETS = 21635072, OUT_RWS = 88743936, OUT_SHS = 97132544;

__device__ __forceinline__ unsigned pk2(float lo, float hi) { f32x2 v = {lo, hi}; nbf2 r = __builtin_convertvector(v, nbf2); return __builtin_bit_cast(unsigned, r); }
__device__ __forceinline__ unsigned short f2bf(float f) { return (unsigned short)(pk2(f, 0.f) & 0xffffu); }
__device__ __forceinline__ float bf2f(unsigned short b) { return __uint_as_float(((unsigned)b) << 16); }
__device__ __forceinline__ float bflo(unsigned w) { return __uint_as_float(w << 16); }
__device__ __forceinline__ float bfhi(unsigned w) { return __uint_as_float(w & 0xffff0000u); }
__device__ __forceinline__ float sigm(float x) { return __builtin_amdgcn_rcpf(1.f + __expf(-x)); }
__device__ __forceinline__ float silu_(float x) { return x * sigm(x); }
__device__ __forceinline__ float wave_sum(float v) {
#pragma unroll
    for (int o = 1; o < 64; o <<= 1) v += __shfl_xor(v, o);
    return v;
}
#define MFMA32(a, b, c) __builtin_amdgcn_mfma_f32_16x16x32_bf16((a), (b), (c), 0, 0, 0)
#define LDS_WAIT() asm volatile("s_waitcnt lgkmcnt(0)" ::: "memory")

namespace pg8 {
constexpr int BM = 256, BK = 64, HALF = 128, HTB = HALF * BK * 2, STAGE_BYTES = 8 * HTB, NXCD = 8, WGM = 8;
__host__ __device__ __forceinline__ int lds_byte(int r, int c) { const int st = (r >> 4) * 2 + (c >> 5), rr = r & 15, cc = c & 31, ob = rr * 64 + cc * 2; return st * 1024 + (ob ^ (((ob >> 9) & 1) << 5)); }
__host__ __device__ __forceinline__ void stage_rc(int b, int& R, int& C) { const int st = b / 1024, sb = b % 1024, swz = sb ^ (((sb >> 9) & 1) << 5); R = (st >> 1) * 16 + swz / 64; C = (st & 1) * 32 + (swz % 64) / 2; }
__host__ __device__ __forceinline__ int perm32(int rho) { const int n = rho >> 4, i = rho & 15; return 8 * (i >> 2) + 4 * n + (i & 3); }
struct Unit { int pm, pn; };
struct Gemm { const bf16_t* A; const bf16_t* Bt; int M, N, K; };
struct StaticOrder {
    int nM, nN, nwg, G, c;
    __host__ __device__ void init(int M, int N, int G_, int c_) { nM = M / BM; nN = N / BM; nwg = nM * nN; G = G_; c = c_; }
    __host__ __device__ bool next(int i, Unit& u) const {
        const long L = (long)i * G + c; if (L >= nwg) return false;
        int wgid = (int)L; { const int q = nwg / NXCD, r = nwg % NXCD, xcd = wgid % NXCD, off = wgid / NXCD; wgid = (xcd < r ? xcd * (q + 1) : r * (q + 1) + (xcd - r) * q) + off; }
        const int nig = WGM * nN, gid = wgid / nig, fm = gid * WGM, gsz = (nM - fm) < WGM ? (nM - fm) : WGM;
        u.pm = fm + ((wgid % nig) % gsz); u.pn = (wgid % nig) / gsz; return true;
    }
};
template <class Epi>
__device__ __forceinline__ void gemm_phase(LAS unsigned char* lds, const Gemm g, const StaticOrder& S, const Epi& E) {
    int tid = threadIdx.x; asm volatile("" : "+v"(tid));
    const int wid = __builtin_amdgcn_readfirstlane(tid >> 6), lane = tid & 63, wr = wid >> 2, wc = wid & 3, fr = lane & 15, fq = lane >> 4;
    const int K = g.K, nt = K / BK;
    unsigned voffA[2], voffB[2];
#pragma unroll
    for (int i = 0; i < 2; ++i) { int R, C; stage_rc(tid * 16 + i * 8192, R, C); const int Rb = Epi::PERM ? ((R & ~31) + perm32(R & 31)) : R;
        voffA[i] = (unsigned)(R * K + C) * 2u; voffB[i] = (unsigned)(Rb * K + C) * 2u; }
    const size_t kstep = (size_t)(BK * 2);
    const size_t hstep = (size_t)HALF * K * 2;
    const size_t tstep = 2 * hstep;
    const unsigned ldsw = (unsigned)wid * 1024u;
    const int aoff = lds_byte(wr * 64 + fr, fq * 8), boff = lds_byte(wc * 32 + fr, fq * 8);
#define PG8_SA(b, h) (((b) * 2 + (h)) * HTB)
#define PG8_SB(b, h) ((4 + (b) * 2 + (h)) * HTB)
#define PG8_STAGE(bufoff, gbase, voff) do { _Pragma("unroll") for (int _i = 0; _i < 2; ++_i) \
        __builtin_amdgcn_global_load_lds((const unsigned*)((const char*)(gbase) + (voff)[_i]), (LAS unsigned*)(lds + (bufoff) + ldsw + _i * 8192), 16, 0, 0); } while (0)
#define PG8_LDA(dst, b, h) do { _Pragma("unroll") for (int m = 0; m < 4; ++m) _Pragma("unroll") for (int k = 0; k < 2; ++k) dst[m][k] = *(const LAS bf16x8*)(lds + PG8_SA(b, h) + aoff + m * 2048 + k * 1024); } while (0)
#define PG8_LDB(dst, b, h) do { _Pragma("unroll") for (int n = 0; n < 2; ++n) _Pragma("unroll") for (int k = 0; k < 2; ++k) dst[n][k] = *(const LAS bf16x8*)(lds + PG8_SB(b, h) + boff + n * 2048 + k * 1024); } while (0)
#define PG8_MMA(ai, bj, At, Bt) do { __builtin_amdgcn_s_setprio(1); _Pragma("unroll") for (int m = 0; m < 4; ++m) _Pragma("unroll") for (int n = 0; n < 2; ++n) _Pragma("unroll") for (int k = 0; k < 2; ++k) \
        acc[ai][bj][m][n] = __builtin_amdgcn_mfma_f32_16x16x32_bf16(Bt[n][k], At[m][k], acc[ai][bj][m][n], 0, 0, 0); __builtin_amdgcn_s_setprio(0); } while (0)
#define PG8_WAIT_V(n) asm volatile("s_waitcnt vmcnt(" #n ")" ::: "memory")
#define PG8_WAIT_L(n) asm volatile("s_waitcnt lgkmcnt(" #n ")" ::: "memory")
#define PG8_BAR __builtin_amdgcn_s_barrier()
#define PG8_SCHED __builtin_amdgcn_sched_barrier(0)
    Unit cur, nxt; int ui = 0;
    if (!S.next(0, cur)) return;
    f32x4 acc[2][2][4][2];
#pragma unroll
    for (int a = 0; a < 2; ++a)
#pragma unroll
        for (int b = 0; b < 2; ++b)
#pragma unroll
            for (int m = 0; m < 4; ++m)
#pragma unroll
                for (int n = 0; n < 2; ++n) acc[a][b][m][n] = (f32x4){0.f, 0.f, 0.f, 0.f};
    bf16x8 At[4][2], B0[2][2], B1[2][2];
    const char* cA = (const char*)g.A + (size_t)cur.pm * tstep; const char* cB = (const char*)g.Bt + (size_t)cur.pn * tstep;
    PG8_STAGE(PG8_SB(0, 0), cB, voffB); PG8_STAGE(PG8_SA(0, 0), cA, voffA); PG8_STAGE(PG8_SB(0, 1), cB + hstep, voffB); PG8_STAGE(PG8_SA(0, 1), cA + hstep, voffA);
    if (wr == 1) PG8_BAR;
    PG8_WAIT_V(4); PG8_BAR;
    PG8_STAGE(PG8_SB(1, 0), cB + kstep, voffB); PG8_STAGE(PG8_SA(1, 0), cA + kstep, voffA); PG8_STAGE(PG8_SB(1, 1), cB + hstep + kstep, voffB);
    PG8_WAIT_V(6); PG8_BAR;
    for (;;) {
        const bool has_next = S.next(ui + 1, nxt);
        const char* nA = has_next ? (const char*)g.A + (size_t)nxt.pm * tstep : cA; const char* nB = has_next ? (const char*)g.Bt + (size_t)nxt.pn * tstep : cB;
#pragma unroll 1
        for (int t = 0; t < nt; t += 2) {
            const bool last = (t == nt - 2);
            const char* a1 = cA + (size_t)(t + 1) * kstep;
            const char* a2 = last ? nA : cA + (size_t)(t + 2) * kstep; const char* b2 = last ? nB : cB + (size_t)(t + 2) * kstep;
            const char* a3 = a2 + kstep; const char* b3 = b2 + kstep;
            PG8_LDB(B0, 0, 0); PG8_SCHED; PG8_LDA(At, 0, 0); PG8_STAGE(PG8_SA(1, 1), a1 + hstep, voffA);
            PG8_WAIT_L(8); PG8_BAR; PG8_WAIT_L(0); PG8_MMA(0, 0, At, B0); PG8_BAR; PG8_SCHED;
            PG8_LDB(B1, 0, 1); PG8_STAGE(PG8_SB(0, 0), b2, voffB);
            PG8_BAR; PG8_WAIT_L(0); PG8_MMA(0, 1, At, B1); PG8_BAR;
            PG8_LDA(At, 0, 1); PG8_STAGE(PG8_SA(0, 0), a2, voffA);
            PG8_BAR; PG8_WAIT_L(0); PG8_MMA(1, 0, At, B0); PG8_BAR; PG8_SCHED;
            PG8_STAGE(PG8_SB(0, 1), b2 + hstep, voffB);
            PG8_WAIT_V(6); PG8_BAR; PG8_MMA(1, 1, At, B1); PG8_BAR;
            PG8_LDB(B0, 1, 0); PG8_SCHED; PG8_LDA(At, 1, 0); PG8_STAGE(PG8_SA(0, 1), a2 + hstep, voffA);
            PG8_WAIT_L(8); PG8_BAR; PG8_WAIT_L(0); PG8_MMA(0, 0, At, B0); PG8_BAR; PG8_SCHED;
            PG8_LDB(B1, 1, 1); PG8_STAGE(PG8_SB(1, 0), b3, voffB);
            PG8_BAR; PG8_WAIT_L(0); PG8_MMA(0, 1, At, B1); PG8_BAR;
            PG8_LDA(At, 1, 1); PG8_STAGE(PG8_SA(1, 0), a3, voffA);
            PG8_BAR; PG8_WAIT_L(0); PG8_MMA(1, 0, At, B0); PG8_BAR; PG8_SCHED;
            PG8_STAGE(PG8_SB(1, 1), b3 + hstep, voffB);
            PG8_WAIT_V(6); PG8_BAR; PG8_MMA(1, 1, At, B1); PG8_BAR;
        }
        E(acc, cur, wr, wc, fr, fq);
        if (!has_next) break;
#pragma unroll
        for (int a = 0; a < 2; ++a)
#pragma unroll
            for (int b = 0; b < 2; ++b)
#pragma unroll
                for (int m = 0; m < 4; ++m)
#pragma unroll
                    for (int n = 0; n < 2; ++n) acc[a][b][m][n] = (f32x4){0.f, 0.f, 0.f, 0.f};
        cur = nxt; cA = nA; cB = nB; ++ui;
    }
    PG8_WAIT_V(0);
    if (wr == 0) PG8_BAR;
    PG8_BAR;
#undef PG8_SA
#undef PG8_SB
#undef PG8_STAGE
#undef PG8_LDA
#undef PG8_LDB
#undef PG8_MMA
#undef PG8_WAIT_V
#undef PG8_WAIT_L
#undef PG8_BAR
#undef PG8_SCHED
}
}
using pg8::Unit;

struct Args {
    const float* in[26];
    float* out; unsigned char* ws;
};
#define KAS __attribute__((address_space(4)))
__device__ __forceinline__ const KAS char* kargp() { const KAS char* p = (const KAS char*)__builtin_amdgcn_kernarg_segment_ptr(); asm volatile("" : "+s"(p)); return p; }


enum { I_XP = 0, I_XS, I_SRET, I_SRW, I_SSH, I_PP, I_PS, I_NG, I_WIN, I_MU, I_W0, I_W2, I_A0, I_A2, I_KK, I_KA, I_RK, I_LNW, I_LNB, I_WDA, I_WDB, I_WOUT, I_WPLE, I_PNG, I_WPG, I_FNG };

__device__ __forceinline__ void p0_transpose_item(const float* W, int K, int N, bf16_t* WT, LAS float* scr, int item, int lane, const float* kscale) {
    const int nblk = N / 32, kb = item / nblk, nb = item % nblk, k0 = 64 * kb, n0 = 32 * nb;
#pragma unroll 8
    for (int i = 0; i < 32; ++i) { const int kk = 2 * i + (lane >> 5); float v = W[(size_t)(k0 + kk) * N + n0 + (lane & 31)]; if (kscale) v *= kscale[k0 + kk]; scr[kk * 33 + (lane & 31)] = v; }
    LDS_WAIT();
    const int c = lane & 7;
#pragma unroll
    for (int j = 0; j < 4; ++j) { const int n = (lane >> 3) + 8 * j; const LAS float* s = scr + (8 * c) * 33 + n;
        u32x4 o; o.x = pk2(s[0 * 33], s[1 * 33]); o.y = pk2(s[2 * 33], s[3 * 33]); o.z = pk2(s[4 * 33], s[5 * 33]); o.w = pk2(s[6 * 33], s[7 * 33]);
        *(u32x4*)(WT + (size_t)(n0 + n) * K + k0 + 8 * c) = o; }
    LDS_WAIT();
}

__device__ __forceinline__ void phase0(const Args& a, LAS unsigned char* lds, int gw, int NGW, int wave, int lane) {
    unsigned char* ws = a.ws;
    LAS float* scr = (LAS float*)(lds + wave * 16384);
    constexpr int I_IN = (D / 64) * (NCOLS / 32), I_DA = (2048 / 64) * (D / 32), I_SQ = (D / 64) * (D / 32), I_PL = (PLE / 64) * (D / 32), I_LR = 1 * (D / 32);
    constexpr int NITEMS = I_IN + I_DA + 3 * I_SQ + I_PL + 2 * I_LR;
    const bool defer3 = NGW >= 128 * 8;
    for (int it = gw; it < NITEMS; it += NGW) {
        int r = it;
        if (defer3 && r >= I_IN && r < I_IN + I_DA + 3 * I_SQ + I_PL) continue;
        if (r < I_IN) { p0_transpose_item(a.in[I_WIN], D, NCOLS, (bf16_t*)(ws + WS_WIN), scr, r, lane, nullptr); continue; } r -= I_IN;
        if (r < I_DA) { p0_transpose_item(a.in[I_WDA], 2048, D, (bf16_t*)(ws + WS_WDA), scr, r, lane, nullptr); continue; } r -= I_DA;
        if (r < I_SQ) { p0_transpose_item(a.in[I_WDB], D, D, (bf16_t*)(ws + WS_WDB), scr, r, lane, nullptr); continue; } r -= I_SQ;
        if (r < I_SQ) { p0_transpose_item(a.in[I_WOUT], D, D, (bf16_t*)(ws + WS_WOUT), scr, r, lane, nullptr); continue; } r -= I_SQ;
        if (r < I_SQ) { p0_transpose_item(a.in[I_WPG], D, D, (bf16_t*)(ws + WS_WGATE), scr, r, lane, a.in[I_PNG]); continue; } r -= I_SQ;
        if (r < I_PL) { p0_transpose_item(a.in[I_WPLE], PLE, D, (bf16_t*)(ws + WS_WPLE), scr, r, lane, nullptr); continue; } r -= I_PL;
        if (r < I_LR) { p0_transpose_item(a.in[I_W2], 64, D, (bf16_t*)(ws + WS_W2T), scr, r, lane, nullptr); continue; } r -= I_LR;
        p0_transpose_item(a.in[I_A2], 64, D, (bf16_t*)(ws + WS_A2T), scr, r, lane, nullptr);
    }
    for (int i = gw * 64 + lane; i < 128 * D / 8; i += NGW * 64) ((u32x4*)(ws + WS_WIN + (size_t)NCOLS * D * 2))[i] = (u32x4){0u, 0u, 0u, 0u};
    bf16_t* H = (bf16_t*)(ws + WS_H);
    const float* ng = a.in[I_NG];
    for (int m = gw; m < MALL; m += NGW) {
        if (m < MR) {
            const float* xr = (m < MP) ? a.in[I_XP] + (size_t)m * D : a.in[I_XS] + (size_t)(m - MP) * D;
            f32x4 v[4]; float s = 0.f;
#pragma unroll
            for (int j = 0; j < 4; ++j) { v[j] = ((const f32x4*)xr)[lane + 64 * j]; s += (v[j].x * v[j].x + v[j].y * v[j].y) + (v[j].z * v[j].z + v[j].w * v[j].w); }
            const float rs = 1.0f / sqrtf(wave_sum(s) * (1.f / D) + EPS);
            float* so = nullptr;
            if (m < MP) { if ((m & (T - 1)) == T - 1) so = a.out + OUT_SHP + (size_t)(m >> 11) * D; } else so = a.out + OUT_SHS + (size_t)(m - MP) * D;
#pragma unroll
            for (int j = 0; j < 4; ++j) { const f32x4 gg = ((const f32x4*)ng)[lane + 64 * j]; f32x4 h = v[j] * rs * gg;
                if (so) ((f32x4*)so)[lane + 64 * j] = h;
                u32x2 o; o.x = pk2(h.x, h.y); o.y = pk2(h.z, h.w); ((u32x2*)(H + (size_t)m * D))[lane + 64 * j] = o; }
        } else {
            const float* xr = a.in[I_SSH] + (size_t)(m - MR) * D;
#pragma unroll
            for (int j = 0; j < 4; ++j) { const f32x4 h = ((const f32x4*)xr)[lane + 64 * j]; u32x2 o; o.x = pk2(h.x, h.y); o.y = pk2(h.z, h.w); ((u32x2*)(H + (size_t)m * D))[lane + 64 * j] = o; }
        }
        u32x2 o = {0u, 0u};
        if (m < MR) { const float* pr = (m < MP) ? a.in[I_PP] + (size_t)m * PLE : a.in[I_PS] + (size_t)(m - MP) * PLE; const f32x4 p = ((const f32x4*)pr)[lane]; o.x = pk2(p.x, p.y); o.y = pk2(p.z, p.w); }
        ((u32x2*)(ws + WS_PB + (size_t)m * PLE * 2))[lane] = o;
    }
    for (int i = gw * 64 + lane; i < 2049 * 128; i += NGW * 64) {
        const int pos = i >> 7, j = i & 127; const double p = (pos == 2048) ? 16384.0 : (double)pos;
        double inv = 1.0, base = 0.9305720409296989; int e = j;
        while (e) { if (e & 1) inv *= base; base *= base; e >>= 1; }
        double rev = p * inv * 0.15915494309189535; rev -= floor(rev);
        const float fr = (float)rev;
        ((f32x2*)(ws + WS_ROPE))[i] = (f32x2){__builtin_amdgcn_cosf(fr), __builtin_amdgcn_sinf(fr)};
    }
    for (int i = gw * 64 + lane; i < 65536 + 64; i += NGW * 64) ((float*)(ws + WS_CTL))[i] = 0.f;
}

__device__ __forceinline__ void p0_late(const Args& a, LAS float* scr, int w, int nw, int lane) {
    unsigned char* ws = a.ws;
    constexpr int I_DA = (2048 / 64) * (D / 32), I_SQ = (D / 64) * (D / 32), I_PL = (PLE / 64) * (D / 32);
    for (int it = w; it < I_DA + 3 * I_SQ + I_PL; it += nw) {
        int r = it;
        if (r < I_DA) { p0_transpose_item(a.in[I_WDA], 2048, D, (bf16_t*)(ws + WS_WDA), scr, r, lane, nullptr); continue; } r -= I_DA;
        if (r < I_SQ) { p0_transpose_item(a.in[I_WDB], D, D, (bf16_t*)(ws + WS_WDB), scr, r, lane, nullptr); continue; } r -= I_SQ;
        if (r < I_SQ) { p0_transpose_item(a.in[I_WOUT], D, D, (bf16_t*)(ws + WS_WOUT), scr, r, lane, nullptr); continue; } r -= I_SQ;
        if (r < I_SQ) { p0_transpose_item(a.in[I_WPG], D, D, (bf16_t*)(ws + WS_WGATE), scr, r, lane, a.in[I_PNG]); continue; } r -= I_SQ;
        p0_transpose_item(a.in[I_WPLE], PLE, D, (bf16_t*)(ws + WS_WPLE), scr, r, lane, nullptr);
    }
}

struct EpiP {
    static constexpr bool PERM = true;
    bf16_t* P; bf16_t* KT; const f32x2* rope;
    __device__ __forceinline__ void operator()(const f32x4 (&acc)[2][2][4][2], const Unit& u, int wr, int wc, int fr, int fq) const {
        const int pn = u.pn, pm = u.pm;
        const int row0 = pm * 256 + wr * 64 + fr, cl0 = wc * 32 + 8 * fq;
        const bool sample = (pm == 64);
        if (pn < 8) {
            const int h = pn & 3; const bool isk = pn >= 4;
            const float l2g = __log2f(1.f - exp2f(-5.f - (float)h));
#pragma unroll
            for (int ai = 0; ai < 2; ++ai)
#pragma unroll
                for (int m = 0; m < 4; ++m) {
                    const int row = row0 + ai * 128 + m * 16;
                    int pos, ex;
                    if (sample) { pos = 2048; ex = isk ? 0 : 1; } else { pos = row & (T - 1); const int idx = pos & 127; ex = isk ? 127 - idx : idx + 1; }
                    const float sc = exp2f((float)ex * l2g) * (isk ? 0.0625f : 1.0f);
                    const f32x4* rp = (const f32x4*)(rope + pos * 128 + cl0);
                    f32x4 cs[4]; cs[0] = rp[0]; cs[1] = rp[1]; cs[2] = rp[2]; cs[3] = rp[3];
                    float y1[8], y2[8];
#pragma unroll
                    for (int n = 0; n < 2; ++n)
#pragma unroll
                        for (int e = 0; e < 4; ++e) {
                            const float c = (e & 1) ? cs[n * 2 + (e >> 1)].z : cs[n * 2 + (e >> 1)].x, s = (e & 1) ? cs[n * 2 + (e >> 1)].w : cs[n * 2 + (e >> 1)].y;
                            const float x1 = acc[ai][0][m][n][e], x2 = acc[ai][1][m][n][e];
                            y1[n * 4 + e] = (x1 * c - x2 * s) * sc; y2[n * 4 + e] = (x2 * c + x1 * s) * sc;
                        }
                    u32x4 w1, w2;
                    w1.x = pk2(y1[0], y1[1]); w1.y = pk2(y1[2], y1[3]); w1.z = pk2(y1[4], y1[5]); w1.w = pk2(y1[6], y1[7]);
                    w2.x = pk2(y2[0], y2[1]); w2.y = pk2(y2[2], y2[3]); w2.z = pk2(y2[4], y2[5]); w2.w = pk2(y2[6], y2[7]);
                    bf16_t* rowp = P + (size_t)row * NP + pn * 256 + cl0;
                    *(u32x4*)rowp = w1; *(u32x4*)(rowp + 128) = w2;
                    if (isk && !sample) {
                        bf16_t* kt = KT + ((size_t)((row >> 11) * 4 + h) * 256 + cl0) * T + pos;
#pragma unroll
                        for (int j = 0; j < 8; ++j) { kt[(size_t)j * T] = f2bf(y1[j]); kt[(size_t)(j + 128) * T] = f2bf(y2[j]); }
                    }
                }
            return;
        }
#pragma unroll
        for (int bj = 0; bj < 2; ++bj) {
            const int cb = pn * 2 + bj;
            if (cb >= 97) continue;
            const int mode = 0;
            const bool vt = (cb < 32) && !sample;
#pragma unroll
            for (int ai = 0; ai < 2; ++ai)
#pragma unroll
                for (int m = 0; m < 4; ++m) {
                    const int row = row0 + ai * 128 + m * 16;
                    float y[8];
#pragma unroll
                    for (int n = 0; n < 2; ++n)
#pragma unroll
                        for (int e = 0; e < 4; ++e) { float x = acc[ai][bj][m][n][e]; if (mode == 1) x = x * sigm(x); else if (mode == 2) x = sigm(x); y[n * 4 + e] = x; }
                    if (vt) {
                        const int hd = cb * 128 + cl0 - O_V;
                        bf16_t* vp = P + ((size_t)(row >> 11) * T + hd) * NP + O_V + (row & (T - 1));
#pragma unroll
                        for (int j = 0; j < 8; ++j) vp[(size_t)j * NP] = f2bf(y[j]);
                    } else {
                        u32x4 w; w.x = pk2(y[0], y[1]); w.y = pk2(y[2], y[3]); w.z = pk2(y[4], y[5]); w.w = pk2(y[6], y[7]);
                        *(u32x4*)(P + (size_t)row * NP + cb * 128 + cl0) = w;
                    }
                }
        }
    }
};

__device__ __forceinline__ float lerp_bf(const bf16_t* cur, const bf16_t* prv, float mu) { const float c = bf2f(*cur); const float p = bf2f(*prv); return c + (p - c) * mu; }

__device__ __forceinline__ void rw_prep_item(const Args& a, LAS unsigned char* wl  , int tt, int h, int lane) {
    unsigned char* ws = a.ws;
    const bf16_t* P = (const bf16_t*)(ws + WS_P);
    const int l15 = lane & 15, quad = lane >> 4;
    const bool sample = tt >= 1024;
    const int row_base = sample ? MP + (tt - 1024) * 16 : tt * 16;
    const float* mu = a.in[I_MU];
    bf16x8 Aw[2], Aa[2];
    {
        const int m = row_base + l15;
        const bf16_t* cur = P + (size_t)m * NP + O_SH;
        const bf16_t* zrow = (const bf16_t*)(ws + WS_WIN + (size_t)NCOLS * D * 2);
        const bf16_t* prv = sample ? P + (size_t)(m + MS) * NP + O_SH : ((m & (T - 1)) ? cur - NP : zrow + O_SH);
#pragma unroll
        for (int which = 0; which < 2; ++which)
#pragma unroll
            for (int ks = 0; ks < 2; ++ks) {
                const int col = 3072 + which * 64 + ks * 32 + quad * 8;
                const u32x4 cw = *(const u32x4*)(cur + col); const u32x4 pw = *(const u32x4*)(prv + col);
                const f32x4 m0 = *(const f32x4*)(mu + col), m1 = *(const f32x4*)(mu + col + 4);
                float z[8];
                const unsigned cws[4] = {cw.x, cw.y, cw.z, cw.w}, pws[4] = {pw.x, pw.y, pw.z, pw.w};
#pragma unroll
                for (int j = 0; j < 4; ++j) {
                    const float c0 = bflo(cws[j]), c1 = bfhi(cws[j]), p0 = bflo(pws[j]), p1 = bfhi(pws[j]);
                    const float mm0 = (j < 2) ? m0[2 * j] : m1[2 * j - 4], mm1 = (j < 2) ? m0[2 * j + 1] : m1[2 * j - 3];
                    z[2 * j] = c0 + (p0 - c0) * mm0; z[2 * j + 1] = c1 + (p1 - c1) * mm1;
                }
                if (which == 0) {
#pragma unroll
                    for (int j = 0; j < 8; ++j) z[j] = 1.f - 2.f / (__expf(2.f * z[j]) + 1.f);
                }
                u32x4 o; o.x = pk2(z[0], z[1]); o.y = pk2(z[2], z[3]); o.z = pk2(z[4], z[5]); o.w = pk2(z[6], z[7]);
                if (which == 0) Aw[ks] = __builtin_bit_cast(bf16x8, o); else Aa[ks] = __builtin_bit_cast(bf16x8, o);
            }
    }
    const bf16_t* W2T = (const bf16_t*)(ws + WS_W2T); const bf16_t* A2T = (const bf16_t*)(ws + WS_A2T);
    unsigned char* rec = ws + WS_CH + ((size_t)((tt >> 7) * 16 + h) * 128 + (tt & 127)) * REC;
    LAS bf16_t* LA = (LAS bf16_t*)wl;
    LAS bf16_t* LR = LA + 16 * 72;
    LAS bf16_t* LB = LR + 16 * 72;
    LAS bf16_t* LK = LB + 16 * 72;
    LAS float* LN = (LAS float*)(wl + 9216);
    float tA[4][4], tBi[4][4], tBp[4][4];
    float ssq[4] = {0.f, 0.f, 0.f, 0.f}, bon[4] = {0.f, 0.f, 0.f, 0.f};
#pragma unroll
    for (int nt = 0; nt < 4; ++nt) {
        const int ch = h * 64 + nt * 16 + l15, cc = nt * 16 + l15;
        f32x4 cw = {0.f, 0.f, 0.f, 0.f}, ca = {0.f, 0.f, 0.f, 0.f};
#pragma unroll
        for (int ks = 0; ks < 2; ++ks) {
            const bf16x8 bw = *(const bf16x8*)(W2T + (size_t)ch * 64 + ks * 32 + quad * 8), ba = *(const bf16x8*)(A2T + (size_t)ch * 64 + ks * 32 + quad * 8);
            cw = MFMA32(Aw[ks], bw, cw); ca = MFMA32(Aa[ks], ba, ca);
        }
        const float w0 = a.in[I_W0][ch], a0 = a.in[I_A0][ch], k_k = a.in[I_KK][ch], k_a = a.in[I_KA][ch], r_k = a.in[I_RK][ch];
        const float mur = mu[ch], muk = mu[1024 + ch], muv = mu[2048 + ch];
        float lw[4], rr[4], kq[4], vv[4], aa4[4], kr4[4];
#pragma unroll
        for (int r = 0; r < 4; ++r) {
            const int m = row_base + quad * 4 + r;
            const bf16_t* cur = P + (size_t)m * NP + O_SH + ch;
            const bf16_t* prv = sample ? P + (size_t)(m + MS) * NP + O_SH + ch : ((m & (T - 1)) ? cur - NP : (const bf16_t*)(ws + WS_WIN + (size_t)NCOLS * D * 2) + O_SH + ch);
            const float r_ = lerp_bf(cur, prv, mur), k_ = lerp_bf(cur + 1024, prv + 1024, muk), v_ = lerp_bf(cur + 2048, prv + 2048, muv);
            lw[r] = -0.6065306597126334f * sigm(w0 + cw[r]);
            const float aa = sigm(a0 + ca[r]); aa4[r] = aa;
            const float kr = k_ * k_k; kr4[r] = kr; ssq[r] += kr * kr;
            const float kpp = k_ * (1.f + (aa - 1.f) * k_a); kq[r] = kpp;
            rr[r] = r_; vv[r] = v_; bon[r] += r_ * kpp * r_k;
        }
        if (sample) {
#pragma unroll
            for (int r = 0; r < 4; ++r) {
                const int i = (tt - 1024) * 16 + quad * 4 + r;
                float* o = (float*)(ws + WS_OPSS) + ((size_t)(i * 16 + h) * 6) * 64 + cc;
                o[0] = rr[r]; o[64] = __expf(lw[r]); o[128] = kq[r]; o[320] = vv[r];
                tA[nt][r] = kr4[r]; tBi[nt][r] = aa4[r] * kr4[r]; tBp[nt][r] = 0.f;
            }
        } else {
            float c[4]; c[0] = lw[0]; c[1] = c[0] + lw[1]; c[2] = c[1] + lw[2]; c[3] = c[2] + lw[3];
            const float tot = c[3];
            const float s1 = __shfl(tot, (lane - 16) & 63), s2 = __shfl(tot, (lane - 32) & 63), s3 = __shfl(tot, (lane - 48) & 63);
            const float off = (quad >= 1 ? s1 : 0.f) + (quad >= 2 ? s2 : 0.f) + (quad >= 3 ? s3 : 0.f);
            const float total = __shfl(c[3] + off, 48 + l15);
            float kqp[4];
#pragma unroll
            for (int r = 0; r < 4; ++r) {
                const float cum = c[r] + off, cumx = cum - lw[r];
                const float ea = __expf(cumx), er = __expf(cum), ei = __expf(-cum), ep = __expf(total - cum);
                const int tk = quad * 4 + r;
                LR[tk * 72 + cc] = f2bf(rr[r] * er); LK[tk * 72 + cc] = f2bf(kq[r] * ei);
                kqp[r] = kq[r] * ep;
                tA[nt][r] = kr4[r] * ea; tBi[nt][r] = aa4[r] * kr4[r] * ei; tBp[nt][r] = aa4[r] * kr4[r] * ep;
            }
            *(u32x2*)(rec + R_KP + cc * 32 + quad * 8) = (u32x2){pk2(kqp[0], kqp[1]), pk2(kqp[2], kqp[3])};
            *(u32x2*)(rec + R_VT + cc * 32 + quad * 8) = (u32x2){pk2(vv[0], vv[1]), pk2(vv[2], vv[3])};
            if (quad == 0) *(float*)(rec + R_WC + cc * 4) = __expf(total);
        }
        asm volatile("" ::: "memory");
    }
    float inv[4];
#pragma unroll
    for (int r = 0; r < 4; ++r) {
        float s = ssq[r], b = bon[r];
#pragma unroll
        for (int o = 1; o < 16; o <<= 1) { s += __shfl_xor(s, o); b += __shfl_xor(b, o); }
        inv[r] = 1.f / fmaxf(sqrtf(s), 1e-12f);
        if (l15 == 0) ((float*)(ws + WS_BC))[(size_t)(row_base + quad * 4 + r) * 16 + h] = b;
    }
    if (sample) {
#pragma unroll
        for (int nt = 0; nt < 4; ++nt)
#pragma unroll
            for (int r = 0; r < 4; ++r) {
                const int i = (tt - 1024) * 16 + quad * 4 + r;
                float* o = (float*)(ws + WS_OPSS) + ((size_t)(i * 16 + h) * 6) * 64 + nt * 16 + l15;
                o[192] = tA[nt][r] * inv[r]; o[256] = tBi[nt][r] * inv[r];
            }
        return;
    }
#pragma unroll
    for (int nt = 0; nt < 4; ++nt) {
        const int cc = nt * 16 + l15;
        float bp[4];
#pragma unroll
        for (int r = 0; r < 4; ++r) { const int tk = quad * 4 + r;
            LA[tk * 72 + cc] = f2bf(-tA[nt][r] * inv[r]); LB[tk * 72 + cc] = f2bf(tBi[nt][r] * inv[r]); bp[r] = tBp[nt][r] * inv[r]; }
        *(u32x2*)(rec + R_BP + cc * 32 + quad * 8) = (u32x2){pk2(bp[0], bp[1]), pk2(bp[2], bp[3])};
    }
    LDS_WAIT();
#pragma unroll
    for (int i = 0; i < 2; ++i) { const int idx = lane + 64 * i, rr = idx >> 3, c8 = (idx & 7) * 8;
        *(u32x4*)(rec + R_AT + rr * 128 + c8 * 2) = *(const LAS u32x4*)(LA + rr * 72 + c8);
        *(u32x4*)(rec + R_RT + rr * 128 + c8 * 2) = *(const LAS u32x4*)(LR + rr * 72 + c8); }
    f32x4 nab = {0.f, 0.f, 0.f, 0.f}, nak = nab, nrb = nab, nrk = nab;
#pragma unroll
    for (int ks = 0; ks < 2; ++ks) {
        const bf16x8 fa = *(const LAS bf16x8*)(LA + l15 * 72 + ks * 32 + quad * 8), fr_ = *(const LAS bf16x8*)(LR + l15 * 72 + ks * 32 + quad * 8);
        const bf16x8 fb = *(const LAS bf16x8*)(LB + l15 * 72 + ks * 32 + quad * 8), fk = *(const LAS bf16x8*)(LK + l15 * 72 + ks * 32 + quad * 8);
        nab = MFMA32(fa, fb, nab); nak = MFMA32(fa, fk, nak); nrb = MFMA32(fr_, fb, nrb); nrk = MFMA32(fr_, fk, nrk);
    }
#pragma unroll
    for (int r = 0; r < 4; ++r) {
        const int t = quad * 4 + r, j = l15;
        const float vab = (j < t) ? nab[r] : 0.f, vak = (j < t) ? nak[r] : 0.f, vrb = (j <= t) ? nrb[r] : 0.f, vrk = (j <= t) ? nrk[r] : 0.f;
        LN[t * 16 + j] = vab;
        *(bf16_t*)(rec + R_AAK + (t * 16 + j) * 2) = f2bf(vak);
        *(bf16_t*)(rec + R_ARB + (t * 16 + j) * 2) = f2bf(vrb);
        *(bf16_t*)(rec + R_ARK + (t * 16 + j) * 2) = f2bf(vrk);
    }
    LDS_WAIT();
    if (lane < 16) {
        float tc[16];
#pragma unroll
        for (int t = 0; t < 16; ++t) {
            float s = (t == lane) ? 1.f : 0.f;
#pragma unroll
            for (int j = 0; j < t; ++j) s += LN[t * 16 + j] * tc[j];
            tc[t] = s;
            *(bf16_t*)(rec + R_TT + (t * 16 + lane) * 2) = f2bf(s);
        }
    }
    LDS_WAIT();
}

__device__ __forceinline__ bf16x8 k16(u32x2 v) { const u32x4 w = {v.x, v.y, 0u, 0u}; return __builtin_bit_cast(bf16x8, w); }
#define SCAN_DECL(F) bf16x8 F##_at0, F##_at1, F##_rt0, F##_rt1; u32x2 F##_aak, F##_tt, F##_arb, F##_ark, F##_vt, F##_bp0, F##_bp1, F##_bp2, F##_bp3, F##_kp0, F##_kp1, F##_kp2, F##_kp3; float F##_wc0, F##_wc1, F##_wc2, F##_wc3
#define SCAN_LOAD(F, REC_) do { const unsigned char* rec_ = (REC_); \
    F##_at0 = *(const bf16x8*)(rec_ + R_AT + o_nat); F##_at1 = *(const bf16x8*)(rec_ + R_AT + o_nat + 64); \
    F##_rt0 = *(const bf16x8*)(rec_ + R_RT + o_nat); F##_rt1 = *(const bf16x8*)(rec_ + R_RT + o_nat + 64); \
    F##_aak = *(const u32x2*)(rec_ + R_AAK + o_sm); F##_tt = *(const u32x2*)(rec_ + R_TT + o_sm); F##_arb = *(const u32x2*)(rec_ + R_ARB + o_sm); F##_ark = *(const u32x2*)(rec_ + R_ARK + o_sm); \
    F##_vt = *(const u32x2*)(rec_ + R_VT + vt * 512 + o_sm); \
    F##_bp0 = *(const u32x2*)(rec_ + R_BP + o_sm); F##_bp1 = *(const u32x2*)(rec_ + R_BP + 512 + o_sm); F##_bp2 = *(const u32x2*)(rec_ + R_BP + 1024 + o_sm); F##_bp3 = *(const u32x2*)(rec_ + R_BP + 1536 + o_sm); \
    F##_kp0 = *(const u32x2*)(rec_ + R_KP + o_sm); F##_kp1 = *(const u32x2*)(rec_ + R_KP + 512 + o_sm); F##_kp2 = *(const u32x2*)(rec_ + R_KP + 1024 + o_sm); F##_kp3 = *(const u32x2*)(rec_ + R_KP + 1536 + o_sm); \
    F##_wc0 = *(const float*)(rec_ + R_WC + l15 * 4); F##_wc1 = *(const float*)(rec_ + R_WC + 64 + l15 * 4); F##_wc2 = *(const float*)(rec_ + R_WC + 128 + l15 * 4); F##_wc3 = *(const float*)(rec_ + R_WC + 192 + l15 * 4); } while (0)
#define SCAN_UPD(NT, BP, KP, WC) do { f32x4 sn = S##NT * (WC); sn = MFMA32(ua, k16(BP), sn); sn = MFMA32(vtf, k16(KP), sn); S##NT = sn; \
    _Pragma("unroll") for (int r = 0; r < 4; ++r) Sb[(quad * 4 + r) * 72 + NT * 16 + l15] = f2bf(sn[r]); } while (0)
#define SCAN_STEP(F, N, CH) do { const int ch_ = (CH); \
    SCAN_LOAD(N, rec0 + (size_t)(ch_ < 126 ? ch_ + 2 : 127) * REC); \
    const bf16x8 sa0 = *(const LAS bf16x8*)(Sb + l15 * 72 + quad * 8), sa1 = *(const LAS bf16x8*)(Sb + l15 * 72 + 32 + quad * 8); \
    const bf16x8 vtf = k16(F##_vt); const f32x4 z = {0.f, 0.f, 0.f, 0.f}; \
    f32x4 Y = MFMA32(sa0, F##_at0, z); Y = MFMA32(sa1, F##_at1, Y); Y = MFMA32(vtf, k16(F##_aak), Y); \
    _Pragma("unroll") for (int r = 0; r < 4; ++r) Yb[(quad * 4 + r) * 16 + l15] = f2bf(Y[r]); \
    LDS_WAIT(); \
    const bf16x8 ya = k16(*(const LAS u32x2*)(Yb + l15 * 16 + quad * 4)); \
    f32x4 U = MFMA32(ya, k16(F##_tt), z); \
    _Pragma("unroll") for (int r = 0; r < 4; ++r) Ub[(quad * 4 + r) * 16 + l15] = f2bf(U[r]); \
    LDS_WAIT(); \
    const bf16x8 ua = k16(*(const LAS u32x2*)(Ub + l15 * 16 + quad * 4)); \
    f32x4 O = MFMA32(sa0, F##_rt0, z); O = MFMA32(sa1, F##_rt1, O); O = MFMA32(ua, k16(F##_arb), O); O = MFMA32(vtf, k16(F##_ark), O); \
    *(u32x2*)(ob + (size_t)(ch_ * 16 + l15) * D) = (u32x2){pk2(O[0], O[1]), pk2(O[2], O[3])}; \
    SCAN_UPD(0, F##_bp0, F##_kp0, F##_wc0); SCAN_UPD(1, F##_bp1, F##_kp1, F##_wc1); SCAN_UPD(2, F##_bp2, F##_kp2, F##_wc2); SCAN_UPD(3, F##_bp3, F##_kp3, F##_wc3); \
    LDS_WAIT(); __builtin_amdgcn_sched_barrier(0); } while (0)
__device__ __forceinline__ void rw_scan_task(const Args& a, LAS unsigned char* wl  , int b, int h, int vt, int lane) {
    unsigned char* ws = a.ws;
    const int l15 = lane & 15, quad = lane >> 4;
    LAS bf16_t* Sb = (LAS bf16_t*)wl;
    LAS bf16_t* Yb = (LAS bf16_t*)(wl + 2304);
    LAS bf16_t* Ub = (LAS bf16_t*)(wl + 2304 + 512);
    const int o_nat = l15 * 128 + quad * 16, o_sm = l15 * 32 + quad * 8;
    const unsigned char* rec0 = ws + WS_CH + (size_t)((b * 16 + h) * 128) * REC;
    bf16_t* ob = (bf16_t*)(ws + WS_OB) + (size_t)(b * T) * D + h * 64 + vt * 16 + quad * 4;
    f32x4 S0 = {0.f, 0.f, 0.f, 0.f}, S1 = S0, S2 = S0, S3 = S0;
#pragma unroll
    for (int nt = 0; nt < 4; ++nt)
#pragma unroll
        for (int r = 0; r < 4; ++r) Sb[(quad * 4 + r) * 72 + nt * 16 + l15] = 0;
    LDS_WAIT();
    SCAN_DECL(f0); SCAN_DECL(f1); SCAN_DECL(f2);
    SCAN_LOAD(f0, rec0); SCAN_LOAD(f1, rec0 + REC);
    for (int ch = 0; ch < 126; ch += 3) { SCAN_STEP(f0, f2, ch); SCAN_STEP(f1, f0, ch + 1); SCAN_STEP(f2, f1, ch + 2); }
    SCAN_STEP(f0, f2, 126); SCAN_STEP(f1, f0, 127);
    float* so = a.out + OUT_RWP + (size_t)((b * 16 + h) * 64 + vt * 16) * 64;
#pragma unroll
    for (int r = 0; r < 4; ++r) { so[(quad * 4 + r) * 64 + l15] = S0[r]; so[(quad * 4 + r) * 64 + 16 + l15] = S1[r]; so[(quad * 4 + r) * 64 + 32 + l15] = S2[r]; so[(quad * 4 + r) * 64 + 48 + l15] = S3[r]; }
}

__device__ __forceinline__ void rw_sample_wave(const Args& a, int i, int h, int lane) {
    unsigned char* ws = a.ws;
    const float* s0 = a.in[I_SRW] + ((size_t)(i * 16 + h) * 64 + lane) * 64;
    const float* op = (const float*)(ws + WS_OPSS) + (size_t)(i * 16 + h) * 6 * 64;
    float s[64];
#pragma unroll
    for (int j = 0; j < 16; ++j) { const f32x4 t = ((const f32x4*)s0)[j]; s[4 * j] = t.x; s[4 * j + 1] = t.y; s[4 * j + 2] = t.z; s[4 * j + 3] = t.w; }
    const float r_l = op[lane], w_l = op[64 + lane], k_l = op[128 + lane], kk_l = op[192 + lane], b_l = op[256 + lane], v = op[320 + lane];
#define RL(x, j) __builtin_bit_cast(float, __builtin_amdgcn_readlane(__builtin_bit_cast(int, (x)), (j)))
    float sk = 0.f;
#pragma unroll
    for (int j = 0; j < 64; ++j) sk += s[j] * RL(kk_l, j);
    float o = 0.f;
#pragma unroll
    for (int j = 0; j < 64; ++j) { s[j] = s[j] * RL(w_l, j) - sk * RL(b_l, j) + v * RL(k_l, j); o += s[j] * RL(r_l, j); }
#undef RL
    float* so = a.out + OUT_RWS + ((size_t)(i * 16 + h) * 64 + lane) * 64;
#pragma unroll
    for (int j = 0; j < 16; ++j) ((f32x4*)so)[j] = (f32x4){s[4 * j], s[4 * j + 1], s[4 * j + 2], s[4 * j + 3]};
    ((bf16_t*)(ws + WS_OB))[(size_t)(MP + i) * D + h * 64 + lane] = f2bf(o);
}

constexpr int KN_LD = 264, VS_LD = 136, SS_LD = 264;
constexpr int L_KN = 0, L_VS = 128 * KN_LD * 2  , L_SS = L_VS + 64 * VS_LD * 2  , L_RET_END = L_SS + 64 * SS_LD * 2  ;
__device__ __forceinline__ void ret_unit(const Args& a, LAS unsigned char* lds, int unit, int tid) {
    unsigned char* ws = a.ws;
    const bf16_t* P = (const bf16_t*)(ws + WS_P);
    const int dvs = unit & 7, h = (unit >> 3) & 3, b = unit >> 5;
    const int wave = tid >> 6, lane = tid & 63, l15 = lane & 15, quad = lane >> 4;
    LAS bf16_t* KN = (LAS bf16_t*)(lds + L_KN); LAS bf16_t* VS = (LAS bf16_t*)(lds + L_VS); LAS bf16_t* SS = (LAS bf16_t*)(lds + L_SS);
    const float g = 1.f - exp2f(-5.f - (float)h), l2g = __log2f(g);
    const float gC = exp2f(128.f * l2g), ginvC = exp2f(-128.f * l2g);
    const bf16_t* KT = (const bf16_t*)(ws + WS_KT) + (size_t)(b * 4 + h) * 256 * T;
    f32x4 sacc[2][4];
#pragma unroll
    for (int n = 0; n < 2; ++n)
#pragma unroll
        for (int d = 0; d < 4; ++d) sacc[n][d] = (f32x4){0.f, 0.f, 0.f, 0.f};
    for (int i = tid; i < 64 * SS_LD / 2; i += 512) ((LAS unsigned*)SS)[i] = 0u;
    const int it = wave;
    u32x4 stk[8], stv[2];
#define RET_ISSUE(CC) do { const int tok0_ = b * T + (CC) * 128; \
        _Pragma("unroll") for (int i = 0; i < 8; ++i) { const int idx = tid + 512 * i, r = idx >> 5, c8 = (idx & 31) * 8; stk[i] = *(const u32x4*)(P + (size_t)(tok0_ + r) * NP + O_K + h * 256 + c8); } \
        _Pragma("unroll") for (int i = 0; i < 2; ++i) { const int idx = tid + 512 * i, r = idx >> 4, c8 = (idx & 15) * 8; stv[i] = *(const u32x4*)(P + (size_t)(b * T + h * 512 + dvs * 64 + r) * NP + O_V + (CC) * 128 + c8); } } while (0)
    bf16x8 qf[8];
#define RET_ISSUE_Q(CC) do { const int tokq_ = b * T + (CC) * 128 + it * 16 + l15; \
        _Pragma("unroll") for (int ks = 0; ks < 8; ++ks) qf[ks] = *(const bf16x8*)(P + (size_t)tokq_ * NP + h * 256 + ks * 32 + quad * 8); } while (0)
    RET_ISSUE(0); RET_ISSUE_Q(0);
    for (int c = 0; c < 16; ++c) {
        const int tok0 = b * T + c * 128;
#pragma unroll
        for (int i = 0; i < 8; ++i) { const int idx = tid + 512 * i, r = idx >> 5, c8 = (idx & 31) * 8; *(LAS u32x4*)(KN + r * KN_LD + c8) = stk[i]; }
#pragma unroll
        for (int i = 0; i < 2; ++i) { const int idx = tid + 512 * i, r = idx >> 4, c8 = (idx & 15) * 8; *(LAS u32x4*)(VS + r * VS_LD + c8) = stv[i]; }
        __syncthreads();
        bf16x8 ktf[2][4];
#pragma unroll
        for (int n = 0; n < 2; ++n)
#pragma unroll
            for (int ks = 0; ks < 4; ++ks) ktf[n][ks] = *(const bf16x8*)(KT + (size_t)((2 * wave + n) * 16 + l15) * T + c * 128 + ks * 32 + quad * 8);
        if (c < 15) RET_ISSUE(c + 1);
        f32x4 oacc[4];
#pragma unroll
        for (int d = 0; d < 4; ++d) oacc[d] = (f32x4){0.f, 0.f, 0.f, 0.f};
#pragma unroll
        for (int ks = 0; ks < 8; ++ks)
#pragma unroll
            for (int d = 0; d < 4; ++d) { const bf16x8 sb = *(const LAS bf16x8*)(SS + (d * 16 + l15) * SS_LD + ks * 32 + quad * 8); oacc[d] = MFMA32(qf[ks], sb, oacc[d]); }
#pragma unroll
        for (int p = 0; p < 4; ++p) {
            if (2 * p <= it) {
                f32x4 s0 = {0.f, 0.f, 0.f, 0.f}, s1 = {0.f, 0.f, 0.f, 0.f};
#pragma unroll
                for (int ks = 0; ks < 8; ++ks) { const bf16x8 ka = *(const LAS bf16x8*)(KN + ((2 * p) * 16 + l15) * KN_LD + ks * 32 + quad * 8); s0 = MFMA32(ka, qf[ks], s0); }
                if (2 * p + 1 <= it) {
#pragma unroll
                    for (int ks = 0; ks < 8; ++ks) { const bf16x8 ka = *(const LAS bf16x8*)(KN + ((2 * p + 1) * 16 + l15) * KN_LD + ks * 32 + quad * 8); s1 = MFMA32(ka, qf[ks], s1); }
                }
#pragma unroll
                for (int r = 0; r < 4; ++r) {
                    const int jl = quad * 4 + r;
                    s0[r] = (2 * p == it && jl > l15) ? 0.f : s0[r] * ginvC;
                    s1[r] = (2 * p + 1 > it || (2 * p + 1 == it && jl > l15)) ? 0.f : s1[r] * ginvC;
                }
                u32x4 aw; aw.x = pk2(s0[0], s0[1]); aw.y = pk2(s0[2], s0[3]); aw.z = pk2(s1[0], s1[1]); aw.w = pk2(s1[2], s1[3]);
                const bf16x8 af = __builtin_bit_cast(bf16x8, aw);
#pragma unroll
                for (int d = 0; d < 4; ++d) {
                    const LAS bf16_t* vr = VS + (d * 16 + l15) * VS_LD + 32 * p + quad * 4;
                    const u32x2 lo = *(const LAS u32x2*)vr, hi = *(const LAS u32x2*)(vr + 16);
                    const u32x4 bw = {lo.x, lo.y, hi.x, hi.y};
                    oacc[d] = MFMA32(af, __builtin_bit_cast(bf16x8, bw), oacc[d]);
                }
            }
        }
        if (c < 15) RET_ISSUE_Q(c + 1);
        {
            bf16_t* OA = (bf16_t*)(ws + WS_OA); float* SQA = (float*)(ws + WS_SQA);
#pragma unroll
            for (int r = 0; r < 4; ++r) {
                const int tok = tok0 + it * 16 + quad * 4 + r;
                float ss = 0.f;
#pragma unroll
                for (int d = 0; d < 4; ++d) { const float v = oacc[d][r]; ss += v * v; OA[(size_t)tok * 2048 + h * 512 + dvs * 64 + d * 16 + l15] = f2bf(v); }
#pragma unroll
                for (int o = 1; o < 16; o <<= 1) ss += __shfl_xor(ss, o);
                if (l15 == 0) SQA[(size_t)tok * 32 + h * 8 + dvs] = ss;
            }
        }
        __syncthreads();
#pragma unroll
        for (int n = 0; n < 2; ++n)
#pragma unroll
            for (int d = 0; d < 4; ++d) {
                f32x4 s = sacc[n][d] * gC;
#pragma unroll
                for (int ks = 0; ks < 4; ++ks) { const bf16x8 va = *(const LAS bf16x8*)(VS + (d * 16 + l15) * VS_LD + ks * 32 + quad * 8); s = MFMA32(va, ktf[n][ks], s); }
                sacc[n][d] = s;
#pragma unroll
                for (int r = 0; r < 4; ++r) SS[(d * 16 + quad * 4 + r) * SS_LD + (2 * wave + n) * 16 + l15] = f2bf(s[r]);
            }
        __syncthreads();
    }
    float* so = a.out + OUT_RETP + (size_t)(b * 4 + h) * 256 * 512;
#pragma unroll
    for (int n = 0; n < 2; ++n)
#pragma unroll
        for (int d = 0; d < 4; ++d) *(f32x4*)(so + (size_t)((2 * wave + n) * 16 + l15) * 512 + dvs * 64 + d * 16 + quad * 4) = sacc[n][d];
}
#undef RET_ISSUE
#undef RET_ISSUE_Q

__device__ __forceinline__ void ret_sample_unit(const Args& a, LAS unsigned char* lds, int i, int h, int tid) {
    unsigned char* ws = a.ws;
    const bf16_t* Prow = (const bf16_t*)(ws + WS_P) + (size_t)(MP + i) * NP;
    LAS float* Q = (LAS float*)lds; LAS float* Kh = Q + 256; LAS float* RED = Kh + 256; LAS float* OS = RED + 16;
    const float g = 1.f - exp2f(-5.f - (float)h);
    const int lane = tid & 63, wave = tid >> 6;
    float qk = 0.f;
    if (tid < 256) { const float q = bf2f(Prow[h * 256 + tid]), k = bf2f(Prow[O_K + h * 256 + tid]); Q[tid] = q; Kh[tid] = k; qk = q * k; }
    qk = wave_sum(qk);
    if (lane == 0) RED[wave] = qk;
    __syncthreads();
    const float qkv = (RED[0] + RED[1] + RED[2] + RED[3]) / g;
    const int dkg = tid >> 7, dv4 = 4 * (tid & 127);
    const u32x2 vw = *(const u32x2*)(Prow + O_V + h * 512 + dv4);
    const f32x4 v = {bflo(vw.x), bfhi(vw.x), bflo(vw.y), bfhi(vw.y)};
    const float* s0 = a.in[I_SRET] + (size_t)(i * 4 + h) * 256 * 512 + dv4;
    float* s1 = a.out + OUT_RETS + (size_t)(i * 4 + h) * 256 * 512 + dv4;
    f32x4 o = {0.f, 0.f, 0.f, 0.f};
#pragma unroll 8
    for (int j = 0; j < 64; ++j) {
        const int dk = dkg * 64 + j;
        const f32x4 s = __builtin_nontemporal_load((const f32x4*)(s0 + (size_t)dk * 512));
        o += s * Q[dk];
        __builtin_nontemporal_store(s * g + v * Kh[dk], (f32x4*)(s1 + (size_t)dk * 512));
    }
    *(LAS f32x4*)(OS + dkg * 512 + dv4) = o;
    __syncthreads();
    float y[4] = {0.f, 0.f, 0.f, 0.f}; float ss = 0.f;
    if (tid < 128) {
        const f32x4 t = *(LAS f32x4*)(OS + dv4) + *(LAS f32x4*)(OS + 512 + dv4) + *(LAS f32x4*)(OS + 1024 + dv4) + *(LAS f32x4*)(OS + 1536 + dv4) + v * qkv;
        y[0] = t.x; y[1] = t.y; y[2] = t.z; y[3] = t.w; ss = t.x * t.x + t.y * t.y + t.z * t.z + t.w * t.w;
    }
    ss = wave_sum(ss);
    if (lane == 0) RED[8 + wave] = ss;
    __syncthreads();
    if (tid < 128) {
        const float rs = 1.0f / sqrtf((RED[8] + RED[9]) * (1.f / 512.f) + EPS);
        const u32x2 gw = *(const u32x2*)(Prow + O_GA + h * 512 + dv4);
        u32x2 ow; ow.x = pk2(y[0] * rs * silu_(bflo(gw.x)), y[1] * rs * silu_(bfhi(gw.x))); ow.y = pk2(y[2] * rs * silu_(bflo(gw.y)), y[3] * rs * silu_(bfhi(gw.y)));
        *(u32x2*)((bf16_t*)(ws + WS_OA) + (size_t)(MP + i) * 2048 + h * 512 + dv4) = ow;
    }
    __syncthreads();
}

__device__ __forceinline__ void ret_sample_wave(const Args& a, int i, int h, int lane) {
    unsigned char* ws = a.ws;
    const bf16_t* Prow = (const bf16_t*)(ws + WS_P) + (size_t)(MP + i) * NP;
    const float g = 1.f - exp2f(-5.f - (float)h);
    float q[4], k[4]; float qk = 0.f;
#pragma unroll
    for (int j = 0; j < 4; ++j) { q[j] = bf2f(Prow[h * 256 + 64 * j + lane]); k[j] = bf2f(Prow[O_K + h * 256 + 64 * j + lane]); qk += q[j] * k[j]; }
    const float qkv = wave_sum(qk) / g;
    f32x4 v[2];
#pragma unroll
    for (int e = 0; e < 2; ++e) { const u32x2 vw = *(const u32x2*)(Prow + O_V + h * 512 + e * 256 + lane * 4); v[e] = (f32x4){bflo(vw.x), bfhi(vw.x), bflo(vw.y), bfhi(vw.y)}; }
    const float* s0 = a.in[I_SRET] + (size_t)(i * 4 + h) * 256 * 512 + lane * 4;
    float* s1 = a.out + OUT_RETS + (size_t)(i * 4 + h) * 256 * 512 + lane * 4;
    f32x4 o[2] = {{0.f, 0.f, 0.f, 0.f}, {0.f, 0.f, 0.f, 0.f}};
#pragma unroll
    for (int j = 0; j < 4; ++j) {
        for (int d0 = 0; d0 < 64; d0 += 16) {
            f32x4 sv[16][2];
#pragma unroll
            for (int d = 0; d < 16; ++d)
#pragma unroll
                for (int e = 0; e < 2; ++e) sv[d][e] = __builtin_nontemporal_load((const f32x4*)(s0 + (size_t)(64 * j + d0 + d) * 512 + e * 256));
#pragma unroll
            for (int d = 0; d < 16; ++d) {
                const float qd = __builtin_bit_cast(float, __builtin_amdgcn_readlane(__builtin_bit_cast(int, q[j]), d0 + d));
                const float kd = __builtin_bit_cast(float, __builtin_amdgcn_readlane(__builtin_bit_cast(int, k[j]), d0 + d));
#pragma unroll
                for (int e = 0; e < 2; ++e) { o[e] += sv[d][e] * qd; __builtin_nontemporal_store(sv[d][e] * g + v[e] * kd, (f32x4*)(s1 + (size_t)(64 * j + d0 + d) * 512 + e * 256)); }
            }
        }
    }
    float ss = 0.f;
#pragma unroll
    for (int e = 0; e < 2; ++e) { o[e] += v[e] * qkv; ss += (o[e].x * o[e].x + o[e].y * o[e].y) + (o[e].z * o[e].z + o[e].w * o[e].w); }
    const float rs = 1.0f / sqrtf(wave_sum(ss) * (1.f / 512.f) + EPS);
#pragma unroll
    for (int e = 0; e < 2; ++e) { const u32x2 gw = *(const u32x2*)(Prow + O_GA + h * 512 + e * 256 + lane * 4);
        u32x2 ow; ow.x = pk2(o[e].x * rs * silu_(bflo(gw.x)), o[e].y * rs * silu_(bfhi(gw.x))); ow.y = pk2(o[e].z * rs * silu_(bflo(gw.y)), o[e].w * rs * silu_(bfhi(gw.y)));
        *(u32x2*)((bf16_t*)(ws + WS_OA) + (size_t)(MP + i) * 2048 + h * 512 + e * 256 + lane * 4) = ow; }
}

__device__ __forceinline__ void phase25_row(const Args& a, int m, int lane) {
    unsigned char* ws = a.ws;
    const bf16_t* Prow = (const bf16_t*)(ws + WS_P) + (size_t)m * NP;
    bf16_t* oa = (bf16_t*)(ws + WS_OA) + (size_t)m * 2048;
    const float* sq = (const float*)(ws + WS_SQA) + (size_t)m * 32;
    const bool prompt = m < MP;
    f32x4 sqv[8]; u32x4 ow[4], gw4[4];
    if (prompt) {
#pragma unroll
        for (int j = 0; j < 8; ++j) sqv[j] = ((const f32x4*)sq)[j];
#pragma unroll
        for (int hh = 0; hh < 4; ++hh) { ow[hh] = *(const u32x4*)(oa + hh * 512 + lane * 8); gw4[hh] = *(const u32x4*)(Prow + O_GA + hh * 512 + lane * 8); }
    }
    const bf16_t* ob = (const bf16_t*)(ws + WS_OB) + (size_t)m * D + lane * 16;
    f32x4 ov[4];
    { const u32x4 w0 = ((const u32x4*)ob)[0], w1 = ((const u32x4*)ob)[1];
      ov[0] = (f32x4){bflo(w0.x), bfhi(w0.x), bflo(w0.y), bfhi(w0.y)}; ov[1] = (f32x4){bflo(w0.z), bfhi(w0.z), bflo(w0.w), bfhi(w0.w)};
      ov[2] = (f32x4){bflo(w1.x), bfhi(w1.x), bflo(w1.y), bfhi(w1.y)}; ov[3] = (f32x4){bflo(w1.z), bfhi(w1.z), bflo(w1.w), bfhi(w1.w)}; }
    const float bc = ((const float*)(ws + WS_BC))[(size_t)m * 16 + (lane >> 2)];
    const bf16_t* cur = Prow + O_SH + 2048 + lane * 16;
    const bool hasp = (m >= MP) || (m & (T - 1));
    const bf16_t* prv = (m >= MP) ? cur + (size_t)MS * NP : cur - NP;
    u32x4 cw[2], pw[2] = {{0u, 0u, 0u, 0u}, {0u, 0u, 0u, 0u}}, gbw[2];
    cw[0] = ((const u32x4*)cur)[0]; cw[1] = ((const u32x4*)cur)[1];
    if (hasp) { pw[0] = ((const u32x4*)prv)[0]; pw[1] = ((const u32x4*)prv)[1]; }
    gbw[0] = ((const u32x4*)(Prow + O_GB + lane * 16))[0]; gbw[1] = ((const u32x4*)(Prow + O_GB + lane * 16))[1];
    f32x4 lw4[4], lb4[4], mu4[4];
#pragma unroll
    for (int j = 0; j < 4; ++j) { lw4[j] = ((const f32x4*)(a.in[I_LNW] + lane * 16))[j]; lb4[j] = ((const f32x4*)(a.in[I_LNB] + lane * 16))[j]; mu4[j] = ((const f32x4*)(a.in[I_MU] + 2048 + lane * 16))[j]; }
    if (prompt) {
#pragma unroll
        for (int hh = 0; hh < 4; ++hh) {
            const f32x4 s0 = sqv[2 * hh], s1 = sqv[2 * hh + 1];
            const float rs = 1.0f / sqrtf(((s0.x + s0.y) + (s0.z + s0.w) + (s1.x + s1.y) + (s1.z + s1.w)) * (1.f / 512.f) + EPS);
            const u32x4 o4 = ow[hh], g4 = gw4[hh];
            u32x4 r;
            r.x = pk2(bflo(o4.x) * rs * silu_(bflo(g4.x)), bfhi(o4.x) * rs * silu_(bfhi(g4.x))); r.y = pk2(bflo(o4.y) * rs * silu_(bflo(g4.y)), bfhi(o4.y) * rs * silu_(bfhi(g4.y)));
            r.z = pk2(bflo(o4.z) * rs * silu_(bflo(g4.z)), bfhi(o4.z) * rs * silu_(bfhi(g4.z))); r.w = pk2(bflo(o4.w) * rs * silu_(bflo(g4.w)), bfhi(o4.w) * rs * silu_(bfhi(g4.w)));
            *(u32x4*)(oa + hh * 512 + lane * 8) = r;
        }
    }
    float o[16], lw[16], lb[16], mu[16];
#pragma unroll
    for (int j = 0; j < 4; ++j) { o[4 * j] = ov[j].x; o[4 * j + 1] = ov[j].y; o[4 * j + 2] = ov[j].z; o[4 * j + 3] = ov[j].w;
        lw[4 * j] = lw4[j].x; lw[4 * j + 1] = lw4[j].y; lw[4 * j + 2] = lw4[j].z; lw[4 * j + 3] = lw4[j].w;
        lb[4 * j] = lb4[j].x; lb[4 * j + 1] = lb4[j].y; lb[4 * j + 2] = lb4[j].z; lb[4 * j + 3] = lb4[j].w;
        mu[4 * j] = mu4[j].x; mu[4 * j + 1] = mu4[j].y; mu[4 * j + 2] = mu4[j].z; mu[4 * j + 3] = mu4[j].w; }
    float s = 0.f;
#pragma unroll
    for (int j = 0; j < 16; ++j) s += o[j];
    s += __shfl_xor(s, 1); s += __shfl_xor(s, 2);
    const float mean = s * (1.f / 64.f);
    float q = 0.f;
#pragma unroll
    for (int j = 0; j < 16; ++j) { const float d = o[j] - mean; q += d * d; }
    q += __shfl_xor(q, 1); q += __shfl_xor(q, 2);
    const float rstd = 1.0f / sqrtf(q * (1.f / 64.f) + 64e-5f);
    const unsigned cws[8] = {cw[0].x, cw[0].y, cw[0].z, cw[0].w, cw[1].x, cw[1].y, cw[1].z, cw[1].w};
    const unsigned pws[8] = {pw[0].x, pw[0].y, pw[0].z, pw[0].w, pw[1].x, pw[1].y, pw[1].z, pw[1].w};
    const unsigned gws[8] = {gbw[0].x, gbw[0].y, gbw[0].z, gbw[0].w, gbw[1].x, gbw[1].y, gbw[1].z, gbw[1].w};
    unsigned outw[8];
#pragma unroll
    for (int j = 0; j < 8; ++j) {
        const float c0 = bflo(cws[j]), c1 = bfhi(cws[j]), p0 = bflo(pws[j]), p1 = bfhi(pws[j]);
        const float v0 = c0 + (p0 - c0) * mu[2 * j], v1 = c1 + (p1 - c1) * mu[2 * j + 1];
        const float y0 = ((o[2 * j] - mean) * rstd * lw[2 * j] + lb[2 * j] + bc * v0) * silu_(bflo(gws[j]));
        const float y1 = ((o[2 * j + 1] - mean) * rstd * lw[2 * j + 1] + lb[2 * j + 1] + bc * v1) * silu_(bfhi(gws[j]));
        outw[j] = pk2(y0, y1);
    }
    bf16_t* yb = (bf16_t*)(ws + WS_H) + (size_t)m * D + lane * 16;
    *(u32x4*)yb = (u32x4){outw[0], outw[1], outw[2], outw[3]}; *(u32x4*)(yb + 8) = (u32x4){outw[4], outw[5], outw[6], outw[7]};
}

struct EpiT1 {
    static constexpr bool PERM = false;
    const bf16_t* P; bf16_t* T1;
    __device__ __forceinline__ void operator()(const f32x4 (&acc)[2][2][4][2], const Unit& u, int wr, int wc, int fr, int fq) const {
        const int row0 = u.pm * 256 + wr * 64 + fr, col0 = u.pn * 256 + wc * 32 + 4 * fq;
#pragma unroll
        for (int ai = 0; ai < 2; ++ai)
#pragma unroll
            for (int m = 0; m < 4; ++m) { const int row = row0 + ai * 128 + m * 16; if (row >= MR) continue;
#pragma unroll
                for (int bj = 0; bj < 2; ++bj)
#pragma unroll
                    for (int n = 0; n < 2; ++n) { const int col = col0 + bj * 128 + n * 16;
                        const u32x2 gw = *(const u32x2*)(P + (size_t)row * NP + O_MA + col);
                        const f32x4 gt = {sigm(bflo(gw.x)), sigm(bfhi(gw.x)), sigm(bflo(gw.y)), sigm(bfhi(gw.y))};
                        const f32x4 t = acc[ai][bj][m][n] * gt; *(u32x2*)(T1 + (size_t)row * D + col) = (u32x2){pk2(t.x, t.y), pk2(t.z, t.w)}; } asm volatile("" ::: "memory"); }
    }
};
struct EpiMG {
    static constexpr bool PERM = false;
    const bf16_t* P; const bf16_t* T1; bf16_t* MG;
    __device__ __forceinline__ void operator()(const f32x4 (&acc)[2][2][4][2], const Unit& u, int wr, int wc, int fr, int fq) const {
        const int row0 = u.pm * 256 + wr * 64 + fr, col0 = u.pn * 256 + wc * 32 + 4 * fq;
#pragma unroll
        for (int ai = 0; ai < 2; ++ai)
#pragma unroll
            for (int m = 0; m < 4; ++m) { const int row = row0 + ai * 128 + m * 16; if (row >= MR) continue;
#pragma unroll
                for (int bj = 0; bj < 2; ++bj)
#pragma unroll
                    for (int n = 0; n < 2; ++n) { const int col = col0 + bj * 128 + n * 16;
                        const u32x2 gw = *(const u32x2*)(P + (size_t)row * NP + O_MB + col);
                        const f32x4 gt = {sigm(bflo(gw.x)), sigm(bfhi(gw.x)), sigm(bflo(gw.y)), sigm(bfhi(gw.y))};
                        const u32x2 tw = *(const u32x2*)(T1 + (size_t)row * D + col);
                        const f32x4 v = (f32x4){bflo(tw.x), bfhi(tw.x), bflo(tw.y), bfhi(tw.y)} + acc[ai][bj][m][n] * gt;
                        *(u32x2*)(MG + (size_t)row * D + col) = (u32x2){pk2(v.x, v.y), pk2(v.z, v.w)}; } asm volatile("" ::: "memory"); }
    }
};
struct EpiX1 {
    static constexpr bool PERM = false;
    const float* xp; const float* xs; float* X1; bf16_t* X1B; float* SQ;
    __device__ __forceinline__ void operator()(const f32x4 (&acc)[2][2][4][2], const Unit& u, int wr, int wc, int fr, int fq) const {
        const int row0 = u.pm * 256 + wr * 64 + fr, col0 = u.pn * 256 + wc * 32 + 4 * fq;
#pragma unroll
        for (int ai = 0; ai < 2; ++ai)
#pragma unroll
            for (int m = 0; m < 4; ++m) { const int row = row0 + ai * 128 + m * 16; const bool ok = row < MR;
                const float* xr = (row < MP) ? xp + (size_t)row * D : xs + (size_t)(row - MP) * D;
                float ss = 0.f;
                if (ok) {
#pragma unroll
                    for (int bj = 0; bj < 2; ++bj)
#pragma unroll
                        for (int n = 0; n < 2; ++n) { const int col = col0 + bj * 128 + n * 16;
                            const f32x4 v = *(const f32x4*)(xr + col) + acc[ai][bj][m][n];
                            ss += (v.x * v.x + v.y * v.y) + (v.z * v.z + v.w * v.w);
                            *(u32x2*)(X1B + (size_t)row * D + col) = (u32x2){pk2(v.x, v.y), pk2(v.z, v.w)}; }
                }
                ss += __shfl_xor(ss, 16); ss += __shfl_xor(ss, 32);
                if (ok && fq == 0) SQ[(size_t)row * 16 + u.pn * 4 + wc] = ss; asm volatile("" ::: "memory"); }
    }
};
struct EpiGT {
    static constexpr bool PERM = false;
    const float* SQ; bf16_t* GT;
    __device__ __forceinline__ void operator()(const f32x4 (&acc)[2][2][4][2], const Unit& u, int wr, int wc, int fr, int fq) const {
        const int row0 = u.pm * 256 + wr * 64 + fr, col0 = u.pn * 256 + wc * 32 + 4 * fq;
#pragma unroll
        for (int ai = 0; ai < 2; ++ai)
#pragma unroll
            for (int m = 0; m < 4; ++m) { const int row = row0 + ai * 128 + m * 16; if (row >= MR) continue;
                const f32x4* sp = (const f32x4*)(SQ + (size_t)row * 16); const f32x4 q0 = sp[0], q1 = sp[1], q2 = sp[2], q3 = sp[3];
                const float rs = 1.0f / sqrtf((((q0.x + q0.y) + (q0.z + q0.w)) + ((q1.x + q1.y) + (q1.z + q1.w)) + ((q2.x + q2.y) + (q2.z + q2.w)) + ((q3.x + q3.y) + (q3.z + q3.w))) * (1.f / D) + EPS);
#pragma unroll
                for (int bj = 0; bj < 2; ++bj)
#pragma unroll
                    for (int n = 0; n < 2; ++n) { const int col = col0 + bj * 128 + n * 16; const f32x4 t = acc[ai][bj][m][n] * rs;
                        *(u32x2*)(GT + (size_t)row * D + col) = (u32x2){pk2(sigm(t.x), sigm(t.y)), pk2(sigm(t.z), sigm(t.w))}; } asm volatile("" ::: "memory"); }
    }
};
struct EpiX2 {
    static constexpr bool PERM = false;
    const bf16_t* X1; const bf16_t* GT; float* out; float* SQ;
    __device__ __forceinline__ void operator()(const f32x4 (&acc)[2][2][4][2], const Unit& u, int wr, int wc, int fr, int fq) const {
        const int row0 = u.pm * 256 + wr * 64 + fr, col0 = u.pn * 256 + wc * 32 + 4 * fq;
#pragma unroll
        for (int ai = 0; ai < 2; ++ai)
#pragma unroll
            for (int m = 0; m < 4; ++m) { int row = row0 + ai * 128 + m * 16; asm volatile("" : "+v"(row)); const bool ok = row < MR;
                float ss = 0.f;
                if (ok) {
#pragma unroll
                    for (int bj = 0; bj < 2; ++bj)
#pragma unroll
                        for (int n = 0; n < 2; ++n) { const int col = col0 + bj * 128 + n * 16;
                            const u32x2 gw = *(const u32x2*)(GT + (size_t)row * D + col);
                            const u32x2 xw = *(const u32x2*)(X1 + (size_t)row * D + col);
                            const f32x4 v = (f32x4){bflo(xw.x), bfhi(xw.x), bflo(xw.y), bfhi(xw.y)} + acc[ai][bj][m][n] * (f32x4){bflo(gw.x), bfhi(gw.x), bflo(gw.y), bfhi(gw.y)};
                            ss += (v.x * v.x + v.y * v.y) + (v.z * v.z + v.w * v.w);
                            *(f32x4*)(out + (size_t)row * D + col) = v; asm volatile("" ::: "memory"); }
                }
                ss += __shfl_xor(ss, 16); ss += __shfl_xor(ss, 32);
                if (ok && fq == 0) SQ[(size_t)row * 16 + u.pn * 4 + wc] = ss; asm volatile("" ::: "memory"); }
    }
};


__device__ __forceinline__ f32x4 mini_acc(const bf16_t* A, int lda, const bf16_t* Bt, int K, int kq, int l15, int quad) {
    f32x4 acc = {0.f, 0.f, 0.f, 0.f};
    const int kn = K / 128;
    const bf16_t* ap = A + (size_t)l15 * lda + kq * (K / 4) + quad * 8;
    const bf16_t* bp = Bt + (size_t)l15 * K + kq * (K / 4) + quad * 8;
#pragma unroll 4
    for (int ks = 0; ks < kn; ++ks) acc = MFMA32(*(const bf16x8*)(ap + ks * 32), *(const bf16x8*)(bp + ks * 32), acc);
    return acc;
}
__device__ __forceinline__ f32x4 mini_reduce(LAS f32x4* red, int half, int lane) { return (red[(half * 4 + 0) * 64 + lane] + red[(half * 4 + 1) * 64 + lane]) + (red[(half * 4 + 2) * 64 + lane] + red[(half * 4 + 3) * 64 + lane]); }
template <int PH> __device__ __forceinline__ void mini_phase(const Args& a, LAS unsigned char* lds, int bx, int G, int wave, int lane) {
    unsigned char* ws = a.ws;
    const int l15 = lane & 15, quad = lane >> 4, half = wave >> 2, kq = wave & 3;
    LAS f32x4* red1 = (LAS f32x4*)lds; LAS f32x4* red2 = red1 + 8 * 64;
    const bf16_t* P = (const bf16_t*)(ws + WS_P);
    for (int tp = bx; tp < 256; tp += G) {
        const int tl = tp * 2 + half, mt = tl >> 6, nt = tl & 63, row0 = MP + mt * 16, col0 = nt * 16;
        f32x4 a1, a2 = {0.f, 0.f, 0.f, 0.f};
        if (PH == 0) { a1 = mini_acc((const bf16_t*)(ws + WS_OA) + (size_t)row0 * 2048, 2048, (const bf16_t*)(ws + WS_WDA) + (size_t)col0 * 2048, 2048, kq, l15, quad);
                       a2 = mini_acc((const bf16_t*)(ws + WS_H) + (size_t)row0 * D, D, (const bf16_t*)(ws + WS_WDB) + (size_t)col0 * D, D, kq, l15, quad); }
        if (PH == 1) { a1 = mini_acc((const bf16_t*)(ws + WS_MG) + (size_t)row0 * D, D, (const bf16_t*)(ws + WS_WOUT) + (size_t)col0 * D, D, kq, l15, quad); }
        if (PH == 2) { a1 = mini_acc((const bf16_t*)(ws + WS_X1B) + (size_t)row0 * D, D, (const bf16_t*)(ws + WS_WGATE) + (size_t)col0 * D, D, kq, l15, quad);
                       a2 = mini_acc((const bf16_t*)(ws + WS_PB) + (size_t)row0 * PLE, PLE, (const bf16_t*)(ws + WS_WPLE) + (size_t)col0 * PLE, PLE, kq, l15, quad); }
        red1[wave * 64 + lane] = a1; red2[wave * 64 + lane] = a2;
        __syncthreads();
        if (kq == 0) {
            a1 = mini_reduce(red1, half, lane); a2 = mini_reduce(red2, half, lane);
            const int col = col0 + l15;
            float rs1[4] = {0.f, 0.f, 0.f, 0.f};
            if (PH == 2) {
#pragma unroll
                for (int r = 0; r < 4; ++r) { const f32x4 q = *(const f32x4*)((const float*)(ws + WS_SQS1) + (size_t)(row0 - MP + quad * 4 + r) * 64 + l15 * 4); float t = (q.x + q.y) + (q.z + q.w);
#pragma unroll
                    for (int o = 1; o < 16; o <<= 1) t += __shfl_xor(t, o);
                    rs1[r] = 1.0f / sqrtf(t * (1.f / D) + EPS); }
            }
#pragma unroll
            for (int r = 0; r < 4; ++r) {
                const int row = row0 + quad * 4 + r;
                float ss = 0.f;
                if (PH == 0) { const float ga = sigm(bf2f(P[(size_t)row * NP + O_MA + col])), gb = sigm(bf2f(P[(size_t)row * NP + O_MB + col]));
                    ((bf16_t*)(ws + WS_MG))[(size_t)row * D + col] = f2bf(a1[r] * ga + a2[r] * gb); }
                if (PH == 1) { const float x1 = a.in[I_XS][(size_t)(row - MP) * D + col] + a1[r]; ss = x1 * x1;
                    ((bf16_t*)(ws + WS_X1B))[(size_t)row * D + col] = f2bf(x1); }
                if (PH == 2) { const float x2 = bf2f(((const bf16_t*)(ws + WS_X1B))[(size_t)row * D + col]) + a2[r] * sigm(rs1[r] * a1[r]); ss = x2 * x2;
                    a.out[OUT_Y + (size_t)row * D + col] = x2; }
                if (PH != 0) {
#pragma unroll
                    for (int o = 1; o < 16; o <<= 1) ss += __shfl_xor(ss, o);
                    if (l15 == 0) ((float*)(ws + (PH == 1 ? WS_SQS1 : WS_SQS2)))[(size_t)(row - MP) * 64 + nt] = ss;
                }
            }
        }
        __syncthreads();
    }
}

#define XB_TMO      128
#define XB_XCNT(j)  (256  + 64 * (j))
#define XB_XSUB(j)  (1280 + 64 * (j))
#define XB_XGEN(j)  (2304 + 64 * (j))
#define XB_TOP      3328
#define XB_TOPGEN   3392
#define XCD_BAR_WORDS 3456
#define XB_SPIN_CAP (1u << 22)
__device__ __forceinline__ unsigned xb_ld(unsigned* p)              { return __hip_atomic_load(p, __ATOMIC_RELAXED, __HIP_MEMORY_SCOPE_AGENT); }
__device__ __forceinline__ unsigned xb_add(unsigned* p, unsigned v) { return __hip_atomic_fetch_add(p, v, __ATOMIC_RELAXED, __HIP_MEMORY_SCOPE_AGENT); }
__device__ __forceinline__ unsigned xb_xcc_id() { return (unsigned)__builtin_amdgcn_s_getreg((3 << 11) | 20) & 0xFu; }
#define XB_SPIN(cond, bar) do { unsigned _sp = 0; while (cond) { __builtin_amdgcn_s_sleep(1); \
    if ((++_sp & 255u) == 0u) { if (xb_ld(&(bar)[XB_TMO])) break; if (_sp > XB_SPIN_CAP) { atomicAdd(&(bar)[XB_TMO], 1u); break; } } } } while (0)
struct XcdBarrier { unsigned* bar; unsigned x; volatile LAS unsigned* st; };
__device__ __forceinline__ XcdBarrier xcd_barrier_post(unsigned* bar, volatile LAS unsigned* st) {
    XcdBarrier b; b.bar = bar; b.x = xb_xcc_id(); b.st = st;
    if (threadIdx.x == 0) (void)xb_add(&bar[XB_XCNT(b.x)], 1u);
    return b;
}
__device__ __forceinline__ void xcd_barrier_complete(unsigned* bar, unsigned x, unsigned& nloc, unsigned& nx) {
    const unsigned G = gridDim.x * gridDim.y * gridDim.z;
    unsigned sum, cnt, mine, sp = 0u;
    for (;;) {
        sum = 0u; cnt = 0u; mine = 0u;
#pragma unroll
        for (unsigned j = 0; j < 16; ++j) { const unsigned c = xb_ld(&bar[XB_XCNT(j)]); sum += c; cnt += (c > 0u) ? 1u : 0u; mine = (j == x) ? c : mine; }
        if (sum == G) break;
        __builtin_amdgcn_s_sleep(1);
        if ((++sp & 255u) == 0u) { if (xb_ld(&bar[XB_TMO])) break; if (sp > XB_SPIN_CAP) { atomicAdd(&bar[XB_TMO], 1u); break; } }
    }
    nloc = mine > 0u ? mine : 1u; nx = cnt > 0u ? cnt : 1u;
}
__device__ __forceinline__ void xcd_barrier(const XcdBarrier& b) {
    asm volatile("s_waitcnt vmcnt(0)" ::: "memory");
    __syncthreads();
    if (threadIdx.x == 0) {
        unsigned* bar = b.bar;
        __builtin_amdgcn_s_waitcnt(0);
        unsigned nloc = b.st[0], nx = b.st[1];
        if (nloc == 0u) { xcd_barrier_complete(bar, b.x, nloc, nx); b.st[0] = nloc; b.st[1] = nx; }
        const unsigned old = xb_add(&bar[XB_XSUB(b.x)], 1u);
        const unsigned gen = old / nloc;
        if (old + 1u == (gen + 1u) * nloc) {
            __builtin_amdgcn_fence(__ATOMIC_RELEASE, "agent");
            asm volatile("s_waitcnt vmcnt(0)" ::: "memory");
            const unsigned og = xb_add(&bar[XB_TOP], 1u);
            const unsigned tg = og / nx;
            if (og + 1u == (tg + 1u) * nx) xb_add(&bar[XB_TOPGEN], 1u);
            else XB_SPIN(xb_ld(&bar[XB_TOPGEN]) == tg, bar);
            __builtin_amdgcn_fence(__ATOMIC_ACQUIRE, "agent");
            xb_add(&bar[XB_XGEN(b.x)], 1u);
            asm volatile("s_waitcnt vmcnt(0)" ::: "memory");
        } else {
            XB_SPIN(xb_ld(&bar[XB_XGEN(b.x)]) == gen, bar);
            __builtin_amdgcn_fence(__ATOMIC_ACQUIRE, "agent");
            asm volatile("s_waitcnt vmcnt(0)" ::: "memory");
        }
    }
    __syncthreads();
}

constexpr int LDS_BYTES = 147456;
constexpr int CTL_SQ1 = 0, CTL_SQ2 = 32768, CTL_CNT = 65536;

#define GRID_SYNC() xcd_barrier(xbar)
__global__ void __launch_bounds__(512, 2) fwd_mega(Args a) {
    extern __shared__ __attribute__((aligned(16))) unsigned char lds_raw[];
    LAS unsigned char* lds = (LAS unsigned char*)lds_raw;
    cg::grid_group grid = cg::this_grid();
    const int tid = threadIdx.x, lane = tid & 63, wave = __builtin_amdgcn_readfirstlane(tid >> 6);
    const int G = gridDim.x, bx = blockIdx.x;
    const int gw = bx * 8 + wave, NGW = G * 8;
    unsigned char* ws = a.ws;
    if (tid < 16) ((LAS unsigned*)(lds + 131072 + 64))[tid] = 0u;
    __syncthreads();
    XcdBarrier xbar = xcd_barrier_post((unsigned*)(ws + WS_BAR), (volatile LAS unsigned*)(lds + 131072 + 64));
    grid.sync();

#if !defined(ONLY_PH) || ONLY_PH == 0
    phase0(a, lds, gw, NGW, wave, lane);
    GRID_SYNC();
#endif
#if !defined(ONLY_PH) || ONLY_PH == 1
    {
        pg8::Gemm g{(const bf16_t*)(ws + WS_H), (const bf16_t*)(ws + WS_WIN), MALL, NP, D}; pg8::StaticOrder S; S.init(MALL, NP, G, bx);
        EpiP E{(bf16_t*)(ws + WS_P), (bf16_t*)(ws + WS_KT), (const f32x2*)(ws + WS_ROPE)};
        pg8::gemm_phase<EpiP>(lds, g, S, E);
    }
    GRID_SYNC();
#endif
#if !defined(ONLY_PH) || ONLY_PH == 2
    for (int it = gw; it < 1032 * 16; it += NGW) rw_prep_item(a, lds + wave * 10240, it >> 4, it & 15, lane);
    GRID_SYNC();
#endif
#if !defined(ONLY_PH) || ONLY_PH == 3
    {
        if (G < 128) for (int u = gw; u < MS * 16; u += NGW) rw_sample_wave(a, u >> 4, u & 15, lane);
        if (bx < 128) { if (wave < 4) rw_scan_task(a, lds + wave * 4096, bx >> 4, bx & 15, wave, lane); else if (G >= 128) { const int u = bx * 4 + (wave - 4); ret_sample_wave(a, u >> 2, u & 3, lane); }
            if (G >= 128) { for (int u = bx * 8 + wave; u < MS * 16; u += 1024) rw_sample_wave(a, u >> 4, u & 15, lane);
                p0_late(a, (LAS float*)(lds + 16384 + wave * 14336), bx * 8 + wave, 1024, lane); }
        }
        __syncthreads();
        {
            unsigned* cnt2 = (unsigned*)(ws + WS_CTL) + CTL_CNT + 32;
            LAS unsigned* lu = (LAS unsigned*)(lds + 131072);
            for (;;) {
                if (tid == 0) *lu = atomicAdd(cnt2, 1u);
                __syncthreads();
                const unsigned unit = *lu;
                __syncthreads();
                if (unit >= (unsigned)(MS * 4) || G >= 128) break;
                ret_sample_unit(a, lds, (int)(unit >> 2), (int)(unit & 3), tid);
            }
        }
        if (G == 256) {
            if (bx >= 128) {
                const int x = bx & 7, j = (bx - 128) >> 3;
                for (int r = 0; r < 2; ++r) { const int k = r * 16 + j, g = (k >> 3) * 8 + x; ret_unit(a, lds, g * 8 + (k & 7), tid); }
            }
        } else {
            unsigned* cnt = (unsigned*)(ws + WS_CTL) + CTL_CNT;
            LAS unsigned* lu = (LAS unsigned*)(lds + 131072);
            for (;;) {
                if (tid == 0) *lu = atomicAdd(cnt, 1u);
                __syncthreads();
                const unsigned unit = *lu;
                __syncthreads();
                if (unit >= 256u) break;
                ret_unit(a, lds, (int)unit, tid);
            }
        }
    }
    GRID_SYNC();
#endif
#if !defined(ONLY_PH) || ONLY_PH == 4
    for (int m = gw; m < MR; m += NGW) phase25_row(a, m, lane);
    GRID_SYNC();
#endif
#if !defined(ONLY_PH) || ONLY_PH == 5
    {
        mini_phase<0>(a, lds, bx, G, wave, lane);
        pg8::StaticOrder S; S.init(MP, D, G, bx);
        { pg8::Gemm g{(const bf16_t*)(ws + WS_OA), (const bf16_t*)(ws + WS_WDA), MP, D, 2048}; EpiT1 E{(const bf16_t*)(ws + WS_P), (bf16_t*)(ws + WS_T1)}; pg8::gemm_phase<EpiT1>(lds, g, S, E); }
        { pg8::Gemm g{(const bf16_t*)(ws + WS_H), (const bf16_t*)(ws + WS_WDB), MP, D, D}; EpiMG E{(const bf16_t*)(ws + WS_P), (const bf16_t*)(ws + WS_T1), (bf16_t*)(ws + WS_MG)}; pg8::gemm_phase<EpiMG>(lds, g, S, E); }
    }
    GRID_SYNC();
#endif
#if !defined(ONLY_PH) || ONLY_PH == 6
    {
        mini_phase<1>(a, lds, bx, G, wave, lane);
        pg8::StaticOrder S; S.init(MP, D, G, bx);
        pg8::Gemm g{(const bf16_t*)(ws + WS_MG), (const bf16_t*)(ws + WS_WOUT), MP, D, D};
        EpiX1 E{a.in[I_XP], a.in[I_XS], (float*)(ws + WS_X1), (bf16_t*)(ws + WS_X1B), (float*)(ws + WS_SQ1P)};
        pg8::gemm_phase<EpiX1>(lds, g, S, E);
    }
    GRID_SYNC();
#endif
#if !defined(ONLY_PH) || ONLY_PH == 7
    {
        mini_phase<2>(a, lds, bx, G, wave, lane);
        pg8::StaticOrder S; S.init(MP, D, G, bx);
        { pg8::Gemm g{(const bf16_t*)(ws + WS_X1B), (const bf16_t*)(ws + WS_WGATE), MP, D, D}; EpiGT E{(const float*)(ws + WS_SQ1P), (bf16_t*)(ws + WS_GT)}; pg8::gemm_phase<EpiGT>(lds, g, S, E); }
        { pg8::Gemm g{(const bf16_t*)(ws + WS_PB), (const bf16_t*)(ws + WS_WPLE), MP, D, PLE}; EpiX2 E{(const bf16_t*)(ws + WS_X1B), (const bf16_t*)(ws + WS_GT), a.out + OUT_Y, (float*)(ws + WS_SQ2P)}; pg8::gemm_phase<EpiX2>(lds, g, S, E); }
    }
    GRID_SYNC();
#endif
#if !defined(ONLY_PH) || ONLY_PH == 8
    {
        const float* sq2 = (const float*)(ws + WS_SQ2P); const float* fg = a.in[I_FNG];
        for (int m0 = gw; m0 < MR; m0 += 2 * NGW) {
            const int m1 = m0 + NGW; const bool two = m1 < MR;
            float tot[2]; f32x4 xv[2][4];
#pragma unroll
            for (int e = 0; e < 2; ++e) {
                const int m = e ? m1 : m0;
                if (e == 0 || two) {
                    if (m < MP) { const f32x4* sp = (const f32x4*)(sq2 + (size_t)m * 16); const f32x4 q0 = sp[0], q1 = sp[1], q2 = sp[2], q3 = sp[3];
                        tot[e] = (((q0.x + q0.y) + (q0.z + q0.w)) + ((q1.x + q1.y) + (q1.z + q1.w)) + ((q2.x + q2.y) + (q2.z + q2.w)) + ((q3.x + q3.y) + (q3.z + q3.w))); }
                    else tot[e] = wave_sum(((const float*)(ws + WS_SQS2))[(size_t)(m - MP) * 64 + lane]);
                    const f32x4* o = (const f32x4*)(a.out + OUT_Y + (size_t)m * D);
#pragma unroll
                    for (int j = 0; j < 4; ++j) xv[e][j] = o[lane + 64 * j];
                }
            }
#pragma unroll
            for (int e = 0; e < 2; ++e) {
                const int m = e ? m1 : m0;
                if (e == 0 || two) {
                    const float rs = 1.0f / sqrtf(tot[e] * (1.f / D) + EPS);
                    f32x4* o = (f32x4*)(a.out + OUT_Y + (size_t)m * D);
#pragma unroll
                    for (int j = 0; j < 4; ++j) o[lane + 64 * j] = xv[e][j] * rs * ((const f32x4*)fg)[lane + 64 * j];
                }
            }
        }
    }
#endif

}

extern "C" void kernel_launch(void* const* d_in, const int* in_sizes, int n_in, void* d_out, int out_size, void* d_ws, size_t ws_size, hipStream_t stream) {
    static int grid = 0;
    if (grid == 0) {
        if (n_in != 26 || ws_size < WS_END) { fprintf(stderr, "kernel_launch: unexpected n_in %d or ws_size %zu (need %zu)\n", n_in, ws_size, (size_t)WS_END); grid = -1; return; }
        int dev = 0, cus = 0, per_cu = 0;
        hipGetDevice(&dev); hipDeviceGetAttribute(&cus, hipDeviceAttributeMultiprocessorCount, dev);
        if (hipFuncSetAttribute((const void*)fwd_mega, hipFuncAttributeMaxDynamicSharedMemorySize, LDS_BYTES) != hipSuccess) { fprintf(stderr, "kernel_launch: hipFuncSetAttribute failed\n"); grid = -1; return; }
        hipOccupancyMaxActiveBlocksPerMultiprocessor(&per_cu, (const void*)fwd_mega, 512, LDS_BYTES);
        if (per_cu < 1) { fprintf(stderr, "kernel_launch: occupancy query says %d blocks per CU\n", per_cu); per_cu = 1; }
        (void)hipGetLastError();
        grid = cus * 1;
        fprintf(stderr, "kernel_launch: grid %d (cus %d, per_cu %d), ws %zu\n", grid, cus, per_cu, ws_size);
    }
    if (grid < 0) return;
    Args a{};
    for (int i = 0; i < 26; ++i) a.in[i] = (const float*)d_in[i];
    a.out = (float*)d_out; a.ws = (unsigned char*)d_ws;
    if (hipMemsetAsync((char*)d_ws + WS_BAR, 0, XCD_BAR_WORDS * 4, stream) != hipSuccess) { fprintf(stderr, "kernel_launch: memset failed\n"); return; }
    void* args[] = {&a};
    hipError_t e = hipLaunchCooperativeKernel((const void*)fwd_mega, dim3(grid), dim3(512), args, LDS_BYTES, stream);
    if (e != hipSuccess) fprintf(stderr, "kernel_launch: cooperative launch failed: %s\n", hipGetErrorString(e));
}
```

```cpp
#include <hip/hip_runtime.h>
#include <hip/hip_cooperative_groups.h>
#include <cstdio>
#include <cstdint>
namespace cg = cooperative_groups;

#define LAS __attribute__((address_space(3)))
typedef unsigned short bf16_t;
typedef short bf16x8 __attribute__((ext_vector_type(8)));
typedef short bf16x4 __attribute__((ext_vector_type(4)));
typedef float f32x4 __attribute__((ext_vector_type(4)));
typedef float f32x2 __attribute__((ext_vector_type(2)));
typedef unsigned u32x4 __attribute__((ext_vector_type(4)));
typedef unsigned u32x2 __attribute__((ext_vector_type(2)));
typedef __bf16 nbf2 __attribute__((ext_vector_type(2)));

constexpr int D = 1024, NB = 8, T = 2048, MP = NB * T  , MS = 128, MR = MP + MS  , MALL = 16640  ;
constexpr int NCOLS = 12416, NP = 12544  ;
constexpr int O_K = 1024, O_V = 2048, O_GA = 4096, O_SH = 6144, O_GB = 9344, O_MA = 10368, O_MB = 11392;
constexpr int RH = 4, RDK = 256, RDV = 512, RCH = 128;
constexpr int WH = 16, WN = 64;
constexpr int PLE = 256;
constexpr float EPS = 1e-6f;
constexpr int REC = 12544;
constexpr int R_AT = 0, R_RT = 2048, R_BP = 4096, R_KP = 6144, R_VT = 8192, R_AAK = 10240, R_TT = 10752, R_ARB = 11264, R_ARK = 11776, R_WC = 12288;

constexpr size_t MiB = 1u << 20;
constexpr size_t WS_CTL = 0;
constexpr size_t WS_ROPE = 1 * MiB;
constexpr size_t WS_W2T = 4 * MiB, WS_A2T = WS_W2T + 131072;
constexpr size_t WS_WPLE = 5 * MiB, WS_WDB = 6 * MiB, WS_WOUT = 8 * MiB, WS_WGATE = 10 * MiB, WS_WDA = 12 * MiB, WS_WIN = 16 * MiB;
constexpr size_t WS_PB = 41 * MiB, WS_H = 50 * MiB  , WS_KT = 83 * MiB, WS_SQA = 115 * MiB, WS_BC = 117 * MiB, WS_OPSS = 119 * MiB  ;
constexpr size_t WS_OA = 122 * MiB, WS_P = 188 * MiB, WS_CH = 587 * MiB  , WS_OB = 786 * MiB  ;
constexpr size_t WS_T1 = WS_CH, WS_MG = WS_CH + 65 * MiB, WS_X1B = WS_CH + 98 * MiB, WS_GT = WS_CH + 131 * MiB, WS_X1 = WS_OB + 65 * MiB  ;
constexpr size_t WS_END = 916 * MiB;
constexpr size_t WS_BAR = 512 * 1024;
constexpr size_t WS_SQS1 = 640 * 1024, WS_SQS2 = 704 * 1024;
constexpr size_t WS_SQ1P = WS_KT, WS_SQ2P = WS_KT + 2 * MiB;

constexpr size_t OUT_Y = 0, OUT_RETP = 16908288, OUT_RWP = 21102592, OUT_SHP = 21626880, OUT_RETS = 21635072, OUT_RWS = 88743936, OUT_SHS = 97132544;

__device__ __forceinline__ unsigned pk2(float lo, float hi) { f32x2 v = {lo, hi}; nbf2 r = __builtin_convertvector(v, nbf2); return __builtin_bit_cast(unsigned, r); }
__device__ __forceinline__ unsigned short f2bf(float f) { return (unsigned short)(pk2(f, 0.f) & 0xffffu); }
__device__ __forceinline__ float bf2f(unsigned short b) { return __uint_as_float(((unsigned)b) << 16); }
__device__ __forceinline__ float bflo(unsigned w) { return __uint_as_float(w << 16); }
__device__ __forceinline__ float bfhi(unsigned w) { return __uint_as_float(w & 0xffff0000u); }
__device__ __forceinline__ float sigm(float x) { return __builtin_amdgcn_rcpf(1.f + __expf(-x)); }
__device__ __forceinline__ float silu_(float x) { return x * sigm(x); }
__device__ __forceinline__ float wave_sum(float v) {
#pragma unroll
    for (int o = 1; o < 64; o <<= 1) v += __shfl_xor(v, o);
    return v;
}
#define MFMA32(a, b, c) __builtin_amdgcn_mfma_f32_16x16x32_bf16((a), (b), (c), 0, 0, 0)
#define LDS_WAIT() asm volatile("s_waitcnt lgkmcnt(0)" ::: "memory")

namespace pg8 {
constexpr int BM = 256, BK = 64, HALF = 128, HTB = HALF * BK * 2, STAGE_BYTES = 8 * HTB, NXCD = 8, WGM = 8;
__host__ __device__ __forceinline__ int lds_byte(int r, int c) { const int st = (r >> 4) * 2 + (c >> 5), rr = r & 15, cc = c & 31, ob = rr * 64 + cc * 2; return st * 1024 + (ob ^ (((ob >> 9) & 1) << 5)); }
__host__ __device__ __forceinline__ void stage_rc(int b, int& R, int& C) { const int st = b / 1024, sb = b % 1024, swz = sb ^ (((sb >> 9) & 1) << 5); R = (st >> 1) * 16 + swz / 64; C = (st & 1) * 32 + (swz % 64) / 2; }
__host__ __device__ __forceinline__ int perm32(int rho) { const int n = rho >> 4, i = rho & 15; return 8 * (i >> 2) + 4 * n + (i & 3); }
struct Unit { int pm, pn; };
struct Gemm { const bf16_t* A; const bf16_t* Bt; int M, N, K; };
struct StaticOrder {
    int nM, nN, nwg, G, c;
    __host__ __device__ void init(int M, int N, int G_, int c_) { nM = M / BM; nN = N / BM; nwg = nM * nN; G = G_; c = c_; }
    __host__ __device__ bool next(int i, Unit& u) const {
        const long L = (long)i * G + c; if (L >= nwg) return false;
        int wgid = (int)L; { const int q = nwg / NXCD, r = nwg % NXCD, xcd = wgid % NXCD, off = wgid / NXCD; wgid = (xcd < r ? xcd * (q + 1) : r * (q + 1) + (xcd - r) * q) + off; }
        const int nig = WGM * nN, gid = wgid / nig, fm = gid * WGM, gsz = (nM - fm) < WGM ? (nM - fm) : WGM;
        u.pm = fm + ((wgid % nig) % gsz); u.pn = (wgid % nig) / gsz; return true;
    }
};
template <class Epi>
__device__ __forceinline__ void gemm_phase(LAS unsigned char* lds, const Gemm g, const StaticOrder& S, const Epi& E) {
    int tid = threadIdx.x; asm volatile("" : "+v"(tid));
    const int wid = __builtin_amdgcn_readfirstlane(tid >> 6), lane = tid & 63, wr = wid >> 2, wc = wid & 3, fr = lane & 15, fq = lane >> 4;
    const int K = g.K, nt = K / BK;
    unsigned voffA[2], voffB[2];
#pragma unroll
    for (int i = 0; i < 2; ++i) { int R, C; stage_rc(tid * 16 + i * 8192, R, C); const int Rb = Epi::PERM ? ((R & ~31) + perm32(R & 31)) : R;
        voffA[i] = (unsigned)(R * K + C) * 2u; voffB[i] = (unsigned)(Rb * K + C) * 2u; }
    const size_t kstep = (size_t)(BK * 2);
    const size_t hstep = (size_t)HALF * K * 2;
    const size_t tstep = 2 * hstep;
    const unsigned ldsw = (unsigned)wid * 1024u;
    const int aoff = lds_byte(wr * 64 + fr, fq * 8), boff = lds_byte(wc * 32 + fr, fq * 8);
#define PG8_SA(b, h) (((b) * 2 + (h)) * HTB)
#define PG8_SB(b, h) ((4 + (b) * 2 + (h)) * HTB)
#define PG8_STAGE(bufoff, gbase, voff) do { _Pragma("unroll") for (int _i = 0; _i < 2; ++_i) \
        __builtin_amdgcn_global_load_lds((const unsigned*)((const char*)(gbase) + (voff)[_i]), (LAS unsigned*)(lds + (bufoff) + ldsw + _i * 8192), 16, 0, 0); } while (0)
#define PG8_LDA(dst, b, h) do { _Pragma("unroll") for (int m = 0; m < 4; ++m) _Pragma("unroll") for (int k = 0; k < 2; ++k) dst[m][k] = *(const LAS bf16x8*)(lds + PG8_SA(b, h) + aoff + m * 2048 + k * 1024); } while (0)
#define PG8_LDB(dst, b, h) do { _Pragma("unroll") for (int n = 0; n < 2; ++n) _Pragma("unroll") for (int k = 0; k < 2; ++k) dst[n][k] = *(const LAS bf16x8*)(lds + PG8_SB(b, h) + boff + n * 2048 + k * 1024); } while (0)
#define PG8_MMA(ai, bj, At, Bt) do { __builtin_amdgcn_s_setprio(1); _Pragma("unroll") for (int m = 0; m < 4; ++m) _Pragma("unroll") for (int n = 0; n < 2; ++n) _Pragma("unroll") for (int k = 0; k < 2; ++k) \
        acc[ai][bj][m][n] = __builtin_amdgcn_mfma_f32_16x16x32_bf16(Bt[n][k], At[m][k], acc[ai][bj][m][n], 0, 0, 0); __builtin_amdgcn_s_setprio(0); } while (0)
#define PG8_WAIT_V(n) asm volatile("s_waitcnt vmcnt(" #n ")" ::: "memory")
#define PG8_WAIT_L(n) asm volatile("s_waitcnt lgkmcnt(" #n ")" ::: "memory")
#define PG8_BAR __builtin_amdgcn_s_barrier()
#define PG8_SCHED __builtin_amdgcn_sched_barrier(0)
    Unit cur, nxt; int ui = 0;
    if (!S.next(0, cur)) return;
    f32x4 acc[2][2][4][2];
#pragma unroll
    for (int a = 0; a < 2; ++a)
#pragma unroll
        for (int b = 0; b < 2; ++b)
#pragma unroll
            for (int m = 0; m < 4; ++m)
#pragma unroll
                for (int n = 0; n < 2; ++n) acc[a][b][m][n] = (f32x4){0.f, 0.f, 0.f, 0.f};
    bf16x8 At[4][2], B0[2][2], B1[2][2];
    const char* cA = (const char*)g.A + (size_t)cur.pm * tstep; const char* cB = (const char*)g.Bt + (size_t)cur.pn * tstep;
    PG8_STAGE(PG8_SB(0, 0), cB, voffB); PG8_STAGE(PG8_SA(0, 0), cA, voffA); PG8_STAGE(PG8_SB(0, 1), cB + hstep, voffB); PG8_STAGE(PG8_SA(0, 1), cA + hstep, voffA);
    if (wr == 1) PG8_BAR;
    PG8_WAIT_V(4); PG8_BAR;
    PG8_STAGE(PG8_SB(1, 0), cB + kstep, voffB); PG8_STAGE(PG8_SA(1, 0), cA + kstep, voffA); PG8_STAGE(PG8_SB(1, 1), cB + hstep + kstep, voffB);
    PG8_WAIT_V(6); PG8_BAR;
    for (;;) {
        const bool has_next = S.next(ui + 1, nxt);
        const char* nA = has_next ? (const char*)g.A + (size_t)nxt.pm * tstep : cA; const char* nB = has_next ? (const char*)g.Bt + (size_t)nxt.pn * tstep : cB;
#pragma unroll 1
        for (int t = 0; t < nt; t += 2) {
            const bool last = (t == nt - 2);
            const char* a1 = cA + (size_t)(t + 1) * kstep;
            const char* a2 = last ? nA : cA + (size_t)(t + 2) * kstep; const char* b2 = last ? nB : cB + (size_t)(t + 2) * kstep;
            const char* a3 = a2 + kstep; const char* b3 = b2 + kstep;
            PG8_LDB(B0, 0, 0); PG8_SCHED; PG8_LDA(At, 0, 0); PG8_STAGE(PG8_SA(1, 1), a1 + hstep, voffA);
            PG8_WAIT_L(8); PG8_BAR; PG8_WAIT_L(0); PG8_MMA(0, 0, At, B0); PG8_BAR; PG8_SCHED;
            PG8_LDB(B1, 0, 1); PG8_STAGE(PG8_SB(0, 0), b2, voffB);
            PG8_BAR; PG8_WAIT_L(0); PG8_MMA(0, 1, At, B1); PG8_BAR;
            PG8_LDA(At, 0, 1); PG8_STAGE(PG8_SA(0, 0), a2, voffA);
            PG8_BAR; PG8_WAIT_L(0); PG8_MMA(1, 0, At, B0); PG8_BAR; PG8_SCHED;
            PG8_STAGE(PG8_SB(0, 1), b2 + hstep, voffB);
            PG8_WAIT_V(6); PG8_BAR; PG8_MMA(1, 1, At, B1); PG8_BAR;
            PG8_LDB(B0, 1, 0); PG8_SCHED; PG8_LDA(At, 1, 0); PG8_STAGE(PG8_SA(0, 1), a2 + hstep, voffA);
            PG8_WAIT_L(8); PG8_BAR; PG8_WAIT_L(0); PG8_MMA(0, 0, At, B0); PG8_BAR; PG8_SCHED;
            PG8_LDB(B1, 1, 1); PG8_STAGE(PG8_SB(1, 0), b3, voffB);
            PG8_BAR; PG8_WAIT_L(0); PG8_MMA(0, 1, At, B1); PG8_BAR;
            PG8_LDA(At, 1, 1); PG8_STAGE(PG8_SA(1, 0), a3, voffA);
            PG8_BAR; PG8_WAIT_L(0); PG8_MMA(1, 0, At, B0); PG8_BAR; PG8_SCHED;
            PG8_STAGE(PG8_SB(1, 1), b3 + hstep, voffB);
            PG8_WAIT_V(6); PG8_BAR; PG8_MMA(1, 1, At, B1); PG8_BAR;
        }
        E(acc, cur, wr, wc, fr, fq);
        if (!has_next) break;
#pragma unroll
        for (int a = 0; a < 2; ++a)
#pragma unroll
            for (int b = 0; b < 2; ++b)
#pragma unroll
                for (int m = 0; m < 4; ++m)
#pragma unroll
                    for (int n = 0; n < 2; ++n) acc[a][b][m][n] = (f32x4){0.f, 0.f, 0.f, 0.f};
        cur = nxt; cA = nA; cB = nB; ++ui;
    }
    PG8_WAIT_V(0);
    if (wr == 0) PG8_BAR;
    PG8_BAR;
#undef PG8_SA
#undef PG8_SB
#undef PG8_STAGE
#undef PG8_LDA
#undef PG8_LDB
#undef PG8_MMA
#undef PG8_WAIT_V
#undef PG8_WAIT_L
#undef PG8_BAR
#undef PG8_SCHED
}
}
using pg8::Unit;

struct Args {
    const float* in[26];
    float* out; unsigned char* ws;
};
#define KAS __attribute__((address_space(4)))
__device__ __forceinline__ const KAS char* kargp() { const KAS char* p = (const KAS char*)__builtin_amdgcn_kernarg_segment_ptr(); asm volatile("" : "+s"(p)); return p; }


enum { I_XP = 0, I_XS, I_SRET, I_SRW, I_SSH, I_PP, I_PS, I_NG, I_WIN, I_MU, I_W0, I_W2, I_A0, I_A2, I_KK, I_KA, I_RK, I_LNW, I_LNB, I_WDA, I_WDB, I_WOUT, I_WPLE, I_PNG, I_WPG, I_FNG };

__device__ __forceinline__ void p0_transpose_item(const float* W, int K, int N, bf16_t* WT, LAS float* scr, int item, int lane, const float* kscale) {
    const int nblk = N / 32, kb = item / nblk, nb = item % nblk, k0 = 64 * kb, n0 = 32 * nb;
#pragma unroll 8
    for (int i = 0; i < 32; ++i) { const int kk = 2 * i + (lane >> 5); float v = W[(size_t)(k0 + kk) * N + n0 + (lane & 31)]; if (kscale) v *= kscale[k0 + kk]; scr[kk * 33 + (lane & 31)] = v; }
    LDS_WAIT();
    const int c = lane & 7;
#pragma unroll
    for (int j = 0; j < 4; ++j) { const int n = (lane >> 3) + 8 * j; const LAS float* s = scr + (8 * c) * 33 + n;
        u32x4 o; o.x = pk2(s[0 * 33], s[1 * 33]); o.y = pk2(s[2 * 33], s[3 * 33]); o.z = pk2(s[4 * 33], s[5 * 33]); o.w = pk2(s[6 * 33], s[7 * 33]);
        *(u32x4*)(WT + (size_t)(n0 + n) * K + k0 + 8 * c) = o; }
    LDS_WAIT();
}

__device__ __forceinline__ void phase0(const Args& a, LAS unsigned char* lds, int gw, int NGW, int wave, int lane) {
    unsigned char* ws = a.ws;
    LAS float* scr = (LAS float*)(lds + wave * 16384);
    constexpr int I_IN = (D / 64) * (NCOLS / 32), I_DA = (2048 / 64) * (D / 32), I_SQ = (D / 64) * (D / 32), I_PL = (PLE / 64) * (D / 32), I_LR = 1 * (D / 32);
    constexpr int NITEMS = I_IN + I_DA + 3 * I_SQ + I_PL + 2 * I_LR;
    const bool defer3 = NGW >= 128 * 8;
    for (int it = gw; it < NITEMS; it += NGW) {
        int r = it;
        if (defer3 && r >= I_IN && r < I_IN + I_DA + 3 * I_SQ + I_PL) continue;
        if (r < I_IN) { p0_transpose_item(a.in[I_WIN], D, NCOLS, (bf16_t*)(ws + WS_WIN), scr, r, lane, nullptr); continue; } r -= I_IN;
        if (r < I_DA) { p0_transpose_item(a.in[I_WDA], 2048, D, (bf16_t*)(ws + WS_WDA), scr, r, lane, nullptr); continue; } r -= I_DA;
        if (r < I_SQ) { p0_transpose_item(a.in[I_WDB], D, D, (bf16_t*)(ws + WS_WDB), scr, r, lane, nullptr); continue; } r -= I_SQ;
        if (r < I_SQ) { p0_transpose_item(a.in[I_WOUT], D, D, (bf16_t*)(ws + WS_WOUT), scr, r, lane, nullptr); continue; } r -= I_SQ;
        if (r < I_SQ) { p0_transpose_item(a.in[I_WPG], D, D, (bf16_t*)(ws + WS_WGATE), scr, r, lane, a.in[I_PNG]); continue; } r -= I_SQ;
        if (r < I_PL) { p0_transpose_item(a.in[I_WPLE], PLE, D, (bf16_t*)(ws + WS_WPLE), scr, r, lane, nullptr); continue; } r -= I_PL;
        if (r < I_LR) { p0_transpose_item(a.in[I_W2], 64, D, (bf16_t*)(ws + WS_W2T), scr, r, lane, nullptr); continue; } r -= I_LR;
        p0_transpose_item(a.in[I_A2], 64, D, (bf16_t*)(ws + WS_A2T), scr, r, lane, nullptr);
    }
    for (int i = gw * 64 + lane; i < 128 * D / 8; i += NGW * 64) ((u32x4*)(ws + WS_WIN + (size_t)NCOLS * D * 2))[i] = (u32x4){0u, 0u, 0u, 0u};
    bf16_t* H = (bf16_t*)(ws + WS_H);
    const float* ng = a.in[I_NG];
    for (int m = gw; m < MALL; m += NGW) {
        if (m < MR) {
            const float* xr = (m < MP) ? a.in[I_XP] + (size_t)m * D : a.in[I_XS] + (size_t)(m - MP) * D;
            f32x4 v[4]; float s = 0.f;
#pragma unroll
            for (int j = 0; j < 4; ++j) { v[j] = ((const f32x4*)xr)[lane + 64 * j]; s += (v[j].x * v[j].x + v[j].y * v[j].y) + (v[j].z * v[j].z + v[j].w * v[j].w); }
            const float rs = 1.0f / sqrtf(wave_sum(s) * (1.f / D) + EPS);
            float* so = nullptr;
            if (m < MP) { if ((m & (T - 1)) == T - 1) so = a.out + OUT_SHP + (size_t)(m >> 11) * D; } else so = a.out + OUT_SHS + (size_t)(m - MP) * D;
#pragma unroll
            for (int j = 0; j < 4; ++j) { const f32x4 gg = ((const f32x4*)ng)[lane + 64 * j]; f32x4 h = v[j] * rs * gg;
                if (so) ((f32x4*)so)[lane + 64 * j] = h;
                u32x2 o; o.x = pk2(h.x, h.y); o.y = pk2(h.z, h.w); ((u32x2*)(H + (size_t)m * D))[lane + 64 * j] = o; }
        } else {
            const float* xr = a.in[I_SSH] + (size_t)(m - MR) * D;
#pragma unroll
            for (int j = 0; j < 4; ++j) { const f32x4 h = ((const f32x4*)xr)[lane + 64 * j]; u32x2 o; o.x = pk2(h.x, h.y); o.y = pk2(h.z, h.w); ((u32x2*)(H + (size_t)m * D))[lane + 64 * j] = o; }
        }
        u32x2 o = {0u, 0u};
        if (m < MR) { const float* pr = (m < MP) ? a.in[I_PP] + (size_t)m * PLE : a.in[I_PS] + (size_t)(m - MP) * PLE; const f32x4 p = ((const f32x4*)pr)[lane]; o.x = pk2(p.x, p.y); o.y = pk2(p.z, p.w); }
        ((u32x2*)(ws + WS_PB + (size_t)m * PLE * 2))[lane] = o;
    }
    for (int i = gw * 64 + lane; i < 2049 * 128; i += NGW * 64) {
        const int pos = i >> 7, j = i & 127; const double p = (pos == 2048) ? 16384.0 : (double)pos;
        double inv = 1.0, base = 0.9305720409296989; int e = j;
        while (e) { if (e & 1) inv *= base; base *= base; e >>= 1; }
        double rev = p * inv * 0.15915494309189535; rev -= floor(rev);
        const float fr = (float)rev;
        ((f32x2*)(ws + WS_ROPE))[i] = (f32x2){__builtin_amdgcn_cosf(fr), __builtin_amdgcn_sinf(fr)};
    }
    for (int i = gw * 64 + lane; i < 65536 + 64; i += NGW * 64) ((float*)(ws + WS_CTL))[i] = 0.f;
}

__device__ __forceinline__ void p0_late(const Args& a, LAS float* scr, int w, int nw, int lane) {
    unsigned char* ws = a.ws;
    constexpr int I_DA = (2048 / 64) * (D / 32), I_SQ = (D / 64) * (D / 32), I_PL = (PLE / 64) * (D / 32);
    for (int it = w; it < I_DA + 3 * I_SQ + I_PL; it += nw) {
        int r = it;
        if (r < I_DA) { p0_transpose_item(a.in[I_WDA], 2048, D, (bf16_t*)(ws + WS_WDA), scr, r, lane, nullptr); continue; } r -= I_DA;
        if (r < I_SQ) { p0_transpose_item(a.in[I_WDB], D, D, (bf16_t*)(ws + WS_WDB), scr, r, lane, nullptr); continue; } r -= I_SQ;
        if (r < I_SQ) { p0_transpose_item(a.in[I_WOUT], D, D, (bf16_t*)(ws + WS_WOUT), scr, r, lane, nullptr); continue; } r -= I_SQ;
        if (r < I_SQ) { p0_transpose_item(a.in[I_WPG], D, D, (bf16_t*)(ws + WS_WGATE), scr, r, lane, a.in[I_PNG]); continue; } r -= I_SQ;
        p0_transpose_item(a.in[I_WPLE], PLE, D, (bf16_t*)(ws + WS_WPLE), scr, r, lane, nullptr);
    }
}

struct EpiP {
    static constexpr bool PERM = true;
    bf16_t* P; bf16_t* KT; const f32x2* rope;
    __device__ __forceinline__ void operator()(const f32x4 (&acc)[2][2][4][2], const Unit& u, int wr, int wc, int fr, int fq) const {
        const int pn = u.pn, pm = u.pm;
        const int row0 = pm * 256 + wr * 64 + fr, cl0 = wc * 32 + 8 * fq;
        const bool sample = (pm == 64);
        if (pn < 8) {
            const int h = pn & 3; const bool isk = pn >= 4;
            const float l2g = __log2f(1.f - exp2f(-5.f - (float)h));
#pragma unroll
            for (int ai = 0; ai < 2; ++ai)
#pragma unroll
                for (int m = 0; m < 4; ++m) {
                    const int row = row0 + ai * 128 + m * 16;
                    int pos, ex;
                    if (sample) { pos = 2048; ex = isk ? 0 : 1; } else { pos = row & (T - 1); const int idx = pos & 127; ex = isk ? 127 - idx : idx + 1; }
                    const float sc = exp2f((float)ex * l2g) * (isk ? 0.0625f : 1.0f);
                    const f32x4* rp = (const f32x4*)(rope + pos * 128 + cl0);
                    f32x4 cs[4]; cs[0] = rp[0]; cs[1] = rp[1]; cs[2] = rp[2]; cs[3] = rp[3];
                    float y1[8], y2[8];
#pragma unroll
                    for (int n = 0; n < 2; ++n)
#pragma unroll
                        for (int e = 0; e < 4; ++e) {
                            const float c = (e & 1) ? cs[n * 2 + (e >> 1)].z : cs[n * 2 + (e >> 1)].x, s = (e & 1) ? cs[n * 2 + (e >> 1)].w : cs[n * 2 + (e >> 1)].y;
                            const float x1 = acc[ai][0][m][n][e], x2 = acc[ai][1][m][n][e];
                            y1[n * 4 + e] = (x1 * c - x2 * s) * sc; y2[n * 4 + e] = (x2 * c + x1 * s) * sc;
                        }
                    u32x4 w1, w2;
                    w1.x = pk2(y1[0], y1[1]); w1.y = pk2(y1[2], y1[3]); w1.z = pk2(y1[4], y1[5]); w1.w = pk2(y1[6], y1[7]);
                    w2.x = pk2(y2[0], y2[1]); w2.y = pk2(y2[2], y2[3]); w2.z = pk2(y2[4], y2[5]); w2.w = pk2(y2[6], y2[7]);
                    bf16_t* rowp = P + (size_t)row * NP + pn * 256 + cl0;
                    *(u32x4*)rowp = w1; *(u32x4*)(rowp + 128) = w2;
                    if (isk && !sample) {
                        bf16_t* kt = KT + ((size_t)((row >> 11) * 4 + h) * 256 + cl0) * T + pos;
#pragma unroll
                        for (int j = 0; j < 8; ++j) { kt[(size_t)j * T] = f2bf(y1[j]); kt[(size_t)(j + 128) * T] = f2bf(y2[j]); }
                    }
                }
            return;
        }
#pragma unroll
        for (int bj = 0; bj < 2; ++bj) {
            const int cb = pn * 2 + bj;
            if (cb >= 97) continue;
            const int mode = 0;
            const bool vt = (cb < 32) && !sample;
#pragma unroll
            for (int ai = 0; ai < 2; ++ai)
#pragma unroll
                for (int m = 0; m < 4; ++m) {
                    const int row = row0 + ai * 128 + m * 16;
                    float y[8];
#pragma unroll
                    for (int n = 0; n < 2; ++n)
#pragma unroll
                        for (int e = 0; e < 4; ++e) { float x = acc[ai][bj][m][n][e]; if (mode == 1) x = x * sigm(x); else if (mode == 2) x = sigm(x); y[n * 4 + e] = x; }
                    if (vt) {
                        const int hd = cb * 128 + cl0 - O_V;
                        bf16_t* vp = P + ((size_t)(row >> 11) * T + hd) * NP + O_V + (row & (T - 1));
#pragma unroll
                        for (int j = 0; j < 8; ++j) vp[(size_t)j * NP] = f2bf(y[j]);
                    } else {
                        u32x4 w; w.x = pk2(y[0], y[1]); w.y = pk2(y[2], y[3]); w.z = pk2(y[4], y[5]); w.w = pk2(y[6], y[7]);
                        *(u32x4*)(P + (size_t)row * NP + cb * 128 + cl0) = w;
                    }
                }
        }
    }
};

__device__ __forceinline__ float lerp_bf(const bf16_t* cur, const bf16_t* prv, float mu) { const float c = bf2f(*cur); const float p = bf2f(*prv); return c + (p - c) * mu; }

__device__ __forceinline__ void rw_prep_item(const Args& a, LAS unsigned char* wl  , int tt, int h, int lane) {
    unsigned char* ws = a.ws;
    const bf16_t* P = (const bf16_t*)(ws + WS_P);
    const int l15 = lane & 15, quad = lane >> 4;
    const bool sample = tt >= 1024;
    const int row_base = sample ? MP + (tt - 1024) * 16 : tt * 16;
    const float* mu = a.in[I_MU];
    bf16x8 Aw[2], Aa[2];
    {
        const int m = row_base + l15;
        const bf16_t* cur = P + (size_t)m * NP + O_SH;
        const bf16_t* zrow = (const bf16_t*)(ws + WS_WIN + (size_t)NCOLS * D * 2);
        const bf16_t* prv = sample ? P + (size_t)(m + MS) * NP + O_SH : ((m & (T - 1)) ? cur - NP : zrow + O_SH);
#pragma unroll
        for (int which = 0; which < 2; ++which)
#pragma unroll
            for (int ks = 0; ks < 2; ++ks) {
                const int col = 3072 + which * 64 + ks * 32 + quad * 8;
                const u32x4 cw = *(const u32x4*)(cur + col); const u32x4 pw = *(const u32x4*)(prv + col);
                const f32x4 m0 = *(const f32x4*)(mu + col), m1 = *(const f32x4*)(mu + col + 4);
                float z[8];
                const unsigned cws[4] = {cw.x, cw.y, cw.z, cw.w}, pws[4] = {pw.x, pw.y, pw.z, pw.w};
#pragma unroll
                for (int j = 0; j < 4; ++j) {
                    const float c0 = bflo(cws[j]), c1 = bfhi(cws[j]), p0 = bflo(pws[j]), p1 = bfhi(pws[j]);
                    const float mm0 = (j < 2) ? m0[2 * j] : m1[2 * j - 4], mm1 = (j < 2) ? m0[2 * j + 1] : m1[2 * j - 3];
                    z[2 * j] = c0 + (p0 - c0) * mm0; z[2 * j + 1] = c1 + (p1 - c1) * mm1;
                }
                if (which == 0) {
#pragma unroll
                    for (int j = 0; j < 8; ++j) z[j] = 1.f - 2.f / (__expf(2.f * z[j]) + 1.f);
                }
                u32x4 o; o.x = pk2(z[0], z[1]); o.y = pk2(z[2], z[3]); o.z = pk2(z[4], z[5]); o.w = pk2(z[6], z[7]);
                if (which == 0) Aw[ks] = __builtin_bit_cast(bf16x8, o); else Aa[ks] = __builtin_bit_cast(bf16x8, o);
            }
    }
    const bf16_t* W2T = (const bf16_t*)(ws + WS_W2T); const bf16_t* A2T = (const bf16_t*)(ws + WS_A2T);
    unsigned char* rec = ws + WS_CH + ((size_t)((tt >> 7) * 16 + h) * 128 + (tt & 127)) * REC;
    LAS bf16_t* LA = (LAS bf16_t*)wl;
    LAS bf16_t* LR = LA + 16 * 72;
    LAS bf16_t* LB = LR + 16 * 72;
    LAS bf16_t* LK = LB + 16 * 72;
    LAS float* LN = (LAS float*)(wl + 9216);
    float tA[4][4], tBi[4][4], tBp[4][4];
    float ssq[4] = {0.f, 0.f, 0.f, 0.f}, bon[4] = {0.f, 0.f, 0.f, 0.f};
#pragma unroll
    for (int nt = 0; nt < 4; ++nt) {
        const int ch = h * 64 + nt * 16 + l15, cc = nt * 16 + l15;
        f32x4 cw = {0.f, 0.f, 0.f, 0.f}, ca = {0.f, 0.f, 0.f, 0.f};
#pragma unroll
        for (int ks = 0; ks < 2; ++ks) {
            const bf16x8 bw = *(const bf16x8*)(W2T + (size_t)ch * 64 + ks * 32 + quad * 8), ba = *(const bf16x8*)(A2T + (size_t)ch * 64 + ks * 32 + quad * 8);
            cw = MFMA32(Aw[ks], bw, cw); ca = MFMA32(Aa[ks], ba, ca);
        }
        const float w0 = a.in[I_W0][ch], a0 = a.in[I_A0][ch], k_k = a.in[I_KK][ch], k_a = a.in[I_KA][ch], r_k = a.in[I_RK][ch];
        const float mur = mu[ch], muk = mu[1024 + ch], muv = mu[2048 + ch];
        float lw[4], rr[4], kq[4], vv[4], aa4[4], kr4[4];
#pragma unroll
        for (int r = 0; r < 4; ++r) {
            const int m = row_base + quad * 4 + r;
            const bf16_t* cur = P + (size_t)m * NP + O_SH + ch;
            const bf16_t* prv = sample ? P + (size_t)(m + MS) * NP + O_SH + ch : ((m & (T - 1)) ? cur - NP : (const bf16_t*)(ws + WS_WIN + (size_t)NCOLS * D * 2) + O_SH + ch);
            const float r_ = lerp_bf(cur, prv, mur), k_ = lerp_bf(cur + 1024, prv + 1024, muk), v_ = lerp_bf(cur + 2048, prv + 2048, muv);
            lw[r] = -0.6065306597126334f * sigm(w0 + cw[r]);
            const float aa = sigm(a0 + ca[r]); aa4[r] = aa;
            const float kr = k_ * k_k; kr4[r] = kr; ssq[r] += kr * kr;
            const float kpp = k_ * (1.f + (aa - 1.f) * k_a); kq[r] = kpp;
            rr[r] = r_; vv[r] = v_; bon[r] += r_ * kpp * r_k;
        }
        if (sample) {
#pragma unroll
            for (int r = 0; r < 4; ++r) {
                const int i = (tt - 1024) * 16 + quad * 4 + r;
                float* o = (float*)(ws + WS_OPSS) + ((size_t)(i * 16 + h) * 6) * 64 + cc;
                o[0] = rr[r]; o[64] = __expf(lw[r]); o[128] = kq[r]; o[320] = vv[r];
                tA[nt][r] = kr4[r]; tBi[nt][r] = aa4[r] * kr4[r]; tBp[nt][r] = 0.f;
            }
        } else {
            float c[4]; c[0] = lw[0]; c[1] = c[0] + lw[1]; c[2] = c[1] + lw[2]; c[3] = c[2] + lw[3];
            const float tot = c[3];
            const float s1 = __shfl(tot, (lane - 16) & 63), s2 = __shfl(tot, (lane - 32) & 63), s3 = __shfl(tot, (lane - 48) & 63);
            const float off = (quad >= 1 ? s1 : 0.f) + (quad >= 2 ? s2 : 0.f) + (quad >= 3 ? s3 : 0.f);
            const float total = __shfl(c[3] + off, 48 + l15);
            float kqp[4];
#pragma unroll
            for (int r = 0; r < 4; ++r) {
                const float cum = c[r] + off, cumx = cum - lw[r];
                const float ea = __expf(cumx), er = __expf(cum), ei = __expf(-cum), ep = __expf(total - cum);
                const int tk = quad * 4 + r;
                LR[tk * 72 + cc] = f2bf(rr[r] * er); LK[tk * 72 + cc] = f2bf(kq[r] * ei);
                kqp[r] = kq[r] * ep;
                tA[nt][r] = kr4[r] * ea; tBi[nt][r] = aa4[r] * kr4[r] * ei; tBp[nt][r] = aa4[r] * kr4[r] * ep;
            }
            *(u32x2*)(rec + R_KP + cc * 32 + quad * 8) = (u32x2){pk2(kqp[0], kqp[1]), pk2(kqp[2], kqp[3])};
            *(u32x2*)(rec + R_VT + cc * 32 + quad * 8) = (u32x2){pk2(vv[0], vv[1]), pk2(vv[2], vv[3])};
            if (quad == 0) *(float*)(rec + R_WC + cc * 4) = __expf(total);
        }
        asm volatile("" ::: "memory");
    }
    float inv[4];
#pragma unroll
    for (int r = 0; r < 4; ++r) {
        float s = ssq[r], b = bon[r];
#pragma unroll
        for (int o = 1; o < 16; o <<= 1) { s += __shfl_xor(s, o); b += __shfl_xor(b, o); }
        inv[r] = 1.f / fmaxf(sqrtf(s), 1e-12f);
        if (l15 == 0) ((float*)(ws + WS_BC))[(size_t)(row_base + quad * 4 + r) * 16 + h] = b;
    }
    if (sample) {
#pragma unroll
        for (int nt = 0; nt < 4; ++nt)
#pragma unroll
            for (int r = 0; r < 4; ++r) {
                const int i = (tt - 1024) * 16 + quad * 4 + r;
                float* o = (float*)(ws + WS_OPSS) + ((size_t)(i * 16 + h) * 6) * 64 + nt * 16 + l15;
                o[192] = tA[nt][r] * inv[r]; o[256] = tBi[nt][r] * inv[r];
            }
        return;
    }
#pragma unroll
    for (int nt = 0; nt < 4; ++nt) {
        const int cc = nt * 16 + l15;
        float bp[4];
#pragma unroll
        for (int r = 0; r < 4; ++r) { const int tk = quad * 4 + r;
            LA[tk * 72 + cc] = f2bf(-tA[nt][r] * inv[r]); LB[tk * 72 + cc] = f2bf(tBi[nt][r] * inv[r]); bp[r] = tBp[nt][r] * inv[r]; }
        *(u32x2*)(rec + R_BP + cc * 32 + quad * 8) = (u32x2){pk2(bp[0], bp[1]), pk2(bp[2], bp[3])};
    }
    LDS_WAIT();
#pragma unroll
    for (int i = 0; i < 2; ++i) { const int idx = lane + 64 * i, rr = idx >> 3, c8 = (idx & 7) * 8;
        *(u32x4*)(rec + R_AT + rr * 128 + c8 * 2) = *(const LAS u32x4*)(LA + rr * 72 + c8);
        *(u32x4*)(rec + R_RT + rr * 128 + c8 * 2) = *(const LAS u32x4*)(LR + rr * 72 + c8); }
    f32x4 nab = {0.f, 0.f, 0.f, 0.f}, nak = nab, nrb = nab, nrk = nab;
#pragma unroll
    for (int ks = 0; ks < 2; ++ks) {
        const bf16x8 fa = *(const LAS bf16x8*)(LA + l15 * 72 + ks * 32 + quad * 8), fr_ = *(const LAS bf16x8*)(LR + l15 * 72 + ks * 32 + quad * 8);
        const bf16x8 fb = *(const LAS bf16x8*)(LB + l15 * 72 + ks * 32 + quad * 8), fk = *(const LAS bf16x8*)(LK + l15 * 72 + ks * 32 + quad * 8);
        nab = MFMA32(fa, fb, nab); nak = MFMA32(fa, fk, nak); nrb = MFMA32(fr_, fb, nrb); nrk = MFMA32(fr_, fk, nrk);
    }
#pragma unroll
    for (int r = 0; r < 4; ++r) {
        const int t = quad * 4 + r, j = l15;
        const float vab = (j < t) ? nab[r] : 0.f, vak = (j < t) ? nak[r] : 0.f, vrb = (j <= t) ? nrb[r] : 0.f, vrk = (j <= t) ? nrk[r] : 0.f;
        LN[t * 16 + j] = vab;
        *(bf16_t*)(rec + R_AAK + (t * 16 + j) * 2) = f2bf(vak);
        *(bf16_t*)(rec + R_ARB + (t * 16 + j) * 2) = f2bf(vrb);
        *(bf16_t*)(rec + R_ARK + (t * 16 + j) * 2) = f2bf(vrk);
    }
    LDS_WAIT();
    if (lane < 16) {
        float tc[16];
#pragma unroll
        for (int t = 0; t < 16; ++t) {
            float s = (t == lane) ? 1.f : 0.f;
#pragma unroll
            for (int j = 0; j < t; ++j) s += LN[t * 16 + j] * tc[j];
            tc[t] = s;
            *(bf16_t*)(rec + R_TT + (t * 16 + lane) * 2) = f2bf(s);
        }
    }
    LDS_WAIT();
}

__device__ __forceinline__ bf16x8 k16(u32x2 v) { const u32x4 w = {v.x, v.y, 0u, 0u}; return __builtin_bit_cast(bf16x8, w); }
#define SCAN_DECL(F) bf16x8 F##_at0, F##_at1, F##_rt0, F##_rt1; u32x2 F##_aak, F##_tt, F##_arb, F##_ark, F##_vt, F##_bp0, F##_bp1, F##_bp2, F##_bp3, F##_kp0, F##_kp1, F##_kp2, F##_kp3; float F##_wc0, F##_wc1, F##_wc2, F##_wc3
#define SCAN_LOAD(F, REC_) do { const unsigned char* rec_ = (REC_); \
    F##_at0 = *(const bf16x8*)(rec_ + R_AT + o_nat); F##_at1 = *(const bf16x8*)(rec_ + R_AT + o_nat + 64); \
    F##_rt0 = *(const bf16x8*)(rec_ + R_RT + o_nat); F##_rt1 = *(const bf16x8*)(rec_ + R_RT + o_nat + 64); \
    F##_aak = *(const u32x2*)(rec_ + R_AAK + o_sm); F##_tt = *(const u32x2*)(rec_ + R_TT + o_sm); F##_arb = *(const u32x2*)(rec_ + R_ARB + o_sm); F##_ark = *(const u32x2*)(rec_ + R_ARK + o_sm); \
    F##_vt = *(const u32x2*)(rec_ + R_VT + vt * 512 + o_sm); \
    F##_bp0 = *(const u32x2*)(rec_ + R_BP + o_sm); F##_bp1 = *(const u32x2*)(rec_ + R_BP + 512 + o_sm); F##_bp2 = *(const u32x2*)(rec_ + R_BP + 1024 + o_sm); F##_bp3 = *(const u32x2*)(rec_ + R_BP + 1536 + o_sm); \
    F##_kp0 = *(const u32x2*)(rec_ + R_KP + o_sm); F##_kp1 = *(const u32x2*)(rec_ + R_KP + 512 + o_sm); F##_kp2 = *(const u32x2*)(rec_ + R_KP + 1024 + o_sm); F##_kp3 = *(const u32x2*)(rec_ + R_KP + 1536 + o_sm); \
    F##_wc0 = *(const float*)(rec_ + R_WC + l15 * 4); F##_wc1 = *(const float*)(rec_ + R_WC + 64 + l15 * 4); F##_wc2 = *(const float*)(rec_ + R_WC + 128 + l15 * 4); F##_wc3 = *(const float*)(rec_ + R_WC + 192 + l15 * 4); } while (0)
#define SCAN_UPD(NT, BP, KP, WC) do { f32x4 sn = S##NT * (WC); sn = MFMA32(ua, k16(BP), sn); sn = MFMA32(vtf, k16(KP), sn); S##NT = sn; \
    _Pragma("unroll") for (int r = 0; r < 4; ++r) Sb[(quad * 4 + r) * 72 + NT * 16 + l15] = f2bf(sn[r]); } while (0)
#define SCAN_STEP(F, N, CH) do { const int ch_ = (CH); \
    SCAN_LOAD(N, rec0 + (size_t)(ch_ < 126 ? ch_ + 2 : 127) * REC); \
    const bf16x8 sa0 = *(const LAS bf16x8*)(Sb + l15 * 72 + quad * 8), sa1 = *(const LAS bf16x8*)(Sb + l15 * 72 + 32 + quad * 8); \
    const bf16x8 vtf = k16(F##_vt); const f32x4 z = {0.f, 0.f, 0.f, 0.f}; \
    f32x4 Y = MFMA32(sa0, F##_at0, z); Y = MFMA32(sa1, F##_at1, Y); Y = MFMA32(vtf, k16(F##_aak), Y); \
    _Pragma("unroll") for (int r = 0; r < 4; ++r) Yb[(quad * 4 + r) * 16 + l15] = f2bf(Y[r]); \
    LDS_WAIT(); \
    const bf16x8 ya = k16(*(const LAS u32x2*)(Yb + l15 * 16 + quad * 4)); \
    f32x4 U = MFMA32(ya, k16(F##_tt), z); \
    _Pragma("unroll") for (int r = 0; r < 4; ++r) Ub[(quad * 4 + r) * 16 + l15] = f2bf(U[r]); \
    LDS_WAIT(); \
    const bf16x8 ua = k16(*(const LAS u32x2*)(Ub + l15 * 16 + quad * 4)); \
    f32x4 O = MFMA32(sa0, F##_rt0, z); O = MFMA32(sa1, F##_rt1, O); O = MFMA32(ua, k16(F##_arb), O); O = MFMA32(vtf, k16(F##_ark), O); \
    *(u32x2*)(ob + (size_t)(ch_ * 16 + l15) * D) = (u32x2){pk2(O[0], O[1]), pk2(O[2], O[3])}; \
    SCAN_UPD(0, F##_bp0, F##_kp0, F##_wc0); SCAN_UPD(1, F##_bp1, F##_kp1, F##_wc1); SCAN_UPD(2, F##_bp2, F##_kp2, F##_wc2); SCAN_UPD(3, F##_bp3, F##_kp3, F##_wc3); \
    LDS_WAIT(); __builtin_amdgcn_sched_barrier(0); } while (0)
__device__ __forceinline__ void rw_scan_task(const Args& a, LAS unsigned char* wl  , int b, int h, int vt, int lane) {
    unsigned char* ws = a.ws;
    const int l15 = lane & 15, quad = lane >> 4;
    LAS bf16_t* Sb = (LAS bf16_t*)wl;
    LAS bf16_t* Yb = (LAS bf16_t*)(wl + 2304);
    LAS bf16_t* Ub = (LAS bf16_t*)(wl + 2304 + 512);
    const int o_nat = l15 * 128 + quad * 16, o_sm = l15 * 32 + quad * 8;
    const unsigned char* rec0 = ws + WS_CH + (size_t)((b * 16 + h) * 128) * REC;
    bf16_t* ob = (bf16_t*)(ws + WS_OB) + (size_t)(b * T) * D + h * 64 + vt * 16 + quad * 4;
    f32x4 S0 = {0.f, 0.f, 0.f, 0.f}, S1 = S0, S2 = S0, S3 = S0;
#pragma unroll
    for (int nt = 0; nt < 4; ++nt)
#pragma unroll
        for (int r = 0; r < 4; ++r) Sb[(quad * 4 + r) * 72 + nt * 16 + l15] = 0;
    LDS_WAIT();
    SCAN_DECL(f0); SCAN_DECL(f1); SCAN_DECL(f2);
    SCAN_LOAD(f0, rec0); SCAN_LOAD(f1, rec0 + REC);
    for (int ch = 0; ch < 126; ch += 3) { SCAN_STEP(f0, f2, ch); SCAN_STEP(f1, f0, ch + 1); SCAN_STEP(f2, f1, ch + 2); }
    SCAN_STEP(f0, f2, 126); SCAN_STEP(f1, f0, 127);
    float* so = a.out + OUT_RWP + (size_t)((b * 16 + h) * 64 + vt * 16) * 64;
#pragma unroll
    for (int r = 0; r < 4; ++r) { so[(quad * 4 + r) * 64 + l15] = S0[r]; so[(quad * 4 + r) * 64 + 16 + l15] = S1[r]; so[(quad * 4 + r) * 64 + 32 + l15] = S2[r]; so[(quad * 4 + r) * 64 + 48 + l15] = S3[r]; }
}

__device__ __forceinline__ void rw_sample_wave(const Args& a, int i, int h, int lane) {
    unsigned char* ws = a.ws;
    const float* s0 = a.in[I_SRW] + ((size_t)(i * 16 + h) * 64 + lane) * 64;
    const float* op = (const float*)(ws + WS_OPSS) + (size_t)(i * 16 + h) * 6 * 64;
    float s[64];
#pragma unroll
    for (int j = 0; j < 16; ++j) { const f32x4 t = ((const f32x4*)s0)[j]; s[4 * j] = t.x; s[4 * j + 1] = t.y; s[4 * j + 2] = t.z; s[4 * j + 3] = t.w; }
    const float r_l = op[lane], w_l = op[64 + lane], k_l = op[128 + lane], kk_l = op[192 + lane], b_l = op[256 + lane], v = op[320 + lane];
#define RL(x, j) __builtin_bit_cast(float, __builtin_amdgcn_readlane(__builtin_bit_cast(int, (x)), (j)))
    float sk = 0.f;
#pragma unroll
    for (int j = 0; j < 64; ++j) sk += s[j] * RL(kk_l, j);
    float o = 0.f;
#pragma unroll
    for (int j = 0; j < 64; ++j) { s[j] = s[j] * RL(w_l, j) - sk * RL(b_l, j) + v * RL(k_l, j); o += s[j] * RL(r_l, j); }
#undef RL
    float* so = a.out + OUT_RWS + ((size_t)(i * 16 + h) * 64 + lane) * 64;
#pragma unroll
    for (int j = 0; j < 16; ++j) ((f32x4*)so)[j] = (f32x4){s[4 * j], s[4 * j + 1], s[4 * j + 2], s[4 * j + 3]};
    ((bf16_t*)(ws + WS_OB))[(size_t)(MP + i) * D + h * 64 + lane] = f2bf(o);
}

constexpr int KN_LD = 264, VS_LD = 136, SS_LD = 264;
constexpr int L_KN = 0, L_VS = 128 * KN_LD * 2  , L_SS = L_VS + 64 * VS_LD * 2  , L_RET_END = L_SS + 64 * SS_LD * 2  ;
__device__ __forceinline__ void ret_unit(const Args& a, LAS unsigned char* lds, int unit, int tid) {
    unsigned char* ws = a.ws;
    const bf16_t* P = (const bf16_t*)(ws + WS_P);
    const int dvs = unit & 7, h = (unit >> 3) & 3, b = unit >> 5;
    const int wave = tid >> 6, lane = tid & 63, l15 = lane & 15, quad = lane >> 4;
    LAS bf16_t* KN = (LAS bf16_t*)(lds + L_KN); LAS bf16_t* VS = (LAS bf16_t*)(lds + L_VS); LAS bf16_t* SS = (LAS bf16_t*)(lds + L_SS);
    const float g = 1.f - exp2f(-5.f - (float)h), l2g = __log2f(g);
    const float gC = exp2f(128.f * l2g), ginvC = exp2f(-128.f * l2g);
    const bf16_t* KT = (const bf16_t*)(ws + WS_KT) + (size_t)(b * 4 + h) * 256 * T;
    f32x4 sacc[2][4];
#pragma unroll
    for (int n = 0; n < 2; ++n)
#pragma unroll
        for (int d = 0; d < 4; ++d) sacc[n][d] = (f32x4){0.f, 0.f, 0.f, 0.f};
    for (int i = tid; i < 64 * SS_LD / 2; i += 512) ((LAS unsigned*)SS)[i] = 0u;
    const int it = wave;
    u32x4 stk[8], stv[2];
#define RET_ISSUE(CC) do { const int tok0_ = b * T + (CC) * 128; \
        _Pragma("unroll") for (int i = 0; i < 8; ++i) { const int idx = tid + 512 * i, r = idx >> 5, c8 = (idx & 31) * 8; stk[i] = *(const u32x4*)(P + (size_t)(tok0_ + r) * NP + O_K + h * 256 + c8); } \
        _Pragma("unroll") for (int i = 0; i < 2; ++i) { const int idx = tid + 512 * i, r = idx >> 4, c8 = (idx & 15) * 8; stv[i] = *(const u32x4*)(P + (size_t)(b * T + h * 512 + dvs * 64 + r) * NP + O_V + (CC) * 128 + c8); } } while (0)
    bf16x8 qf[8];
#define RET_ISSUE_Q(CC) do { const int tokq_ = b * T + (CC) * 128 + it * 16 + l15; \
        _Pragma("unroll") for (int ks = 0; ks < 8; ++ks) qf[ks] = *(const bf16x8*)(P + (size_t)tokq_ * NP + h * 256 + ks * 32 + quad * 8); } while (0)
    RET_ISSUE(0); RET_ISSUE_Q(0);
    for (int c = 0; c < 16; ++c) {
        const int tok0 = b * T + c * 128;
#pragma unroll
        for (int i = 0; i < 8; ++i) { const int idx = tid + 512 * i, r = idx >> 5, c8 = (idx & 31) * 8; *(LAS u32x4*)(KN + r * KN_LD + c8) = stk[i]; }
#pragma unroll
        for (int i = 0; i < 2; ++i) { const int idx = tid + 512 * i, r = idx >> 4, c8 = (idx & 15) * 8; *(LAS u32x4*)(VS + r * VS_LD + c8) = stv[i]; }
        __syncthreads();
        bf16x8 ktf[2][4];
#pragma unroll
        for (int n = 0; n < 2; ++n)
#pragma unroll
            for (int ks = 0; ks < 4; ++ks) ktf[n][ks] = *(const bf16x8*)(KT + (size_t)((2 * wave + n) * 16 + l15) * T + c * 128 + ks * 32 + quad * 8);
        if (c < 15) RET_ISSUE(c + 1);
        f32x4 oacc[4];
#pragma unroll
        for (int d = 0; d < 4; ++d) oacc[d] = (f32x4){0.f, 0.f, 0.f, 0.f};
#pragma unroll
        for (int ks = 0; ks < 8; ++ks)
#pragma unroll
            for (int d = 0; d < 4; ++d) { const bf16x8 sb = *(const LAS bf16x8*)(SS + (d * 16 + l15) * SS_LD + ks * 32 + quad * 8); oacc[d] = MFMA32(qf[ks], sb, oacc[d]); }
#pragma unroll
        for (int p = 0; p < 4; ++p) {
            if (2 * p <= it) {
                f32x4 s0 = {0.f, 0.f, 0.f, 0.f}, s1 = {0.f, 0.f, 0.f, 0.f};
#pragma unroll
                for (int ks = 0; ks < 8; ++ks) { const bf16x8 ka = *(const LAS bf16x8*)(KN + ((2 * p) * 16 + l15) * KN_LD + ks * 32 + quad * 8); s0 = MFMA32(ka, qf[ks], s0); }
                if (2 * p + 1 <= it) {
#pragma unroll
                    for (int ks = 0; ks < 8; ++ks) { const bf16x8 ka = *(const LAS bf16x8*)(KN + ((2 * p + 1) * 16 + l15) * KN_LD + ks * 32 + quad * 8); s1 = MFMA32(ka, qf[ks], s1); }
                }
#pragma unroll
                for (int r = 0; r < 4; ++r) {
                    const int jl = quad * 4 + r;
                    s0[r] = (2 * p == it && jl > l15) ? 0.f : s0[r] * ginvC;
                    s1[r] = (2 * p + 1 > it || (2 * p + 1 == it && jl > l15)) ? 0.f : s1[r] * ginvC;
                }
                u32x4 aw; aw.x = pk2(s0[0], s0[1]); aw.y = pk2(s0[2], s0[3]); aw.z = pk2(s1[0], s1[1]); aw.w = pk2(s1[2], s1[3]);
                const bf16x8 af = __builtin_bit_cast(bf16x8, aw);
#pragma unroll
                for (int d = 0; d < 4; ++d) {
                    const LAS bf16_t* vr = VS + (d * 16 + l15) * VS_LD + 32 * p + quad * 4;
                    const u32x2 lo = *(const LAS u32x2*)vr, hi = *(const LAS u32x2*)(vr + 16);
                    const u32x4 bw = {lo.x, lo.y, hi.x, hi.y};
                    oacc[d] = MFMA32(af, __builtin_bit_cast(bf16x8, bw), oacc[d]);
                }
            }
        }
        if (c < 15) RET_ISSUE_Q(c + 1);
        {
            bf16_t* OA = (bf16_t*)(ws + WS_OA); float* SQA = (float*)(ws + WS_SQA);
#pragma unroll
            for (int r = 0; r < 4; ++r) {
                const int tok = tok0 + it * 16 + quad * 4 + r;
                float ss = 0.f;
#pragma unroll
                for (int d = 0; d < 4; ++d) { const float v = oacc[d][r]; ss += v * v; OA[(size_t)tok * 2048 + h * 512 + dvs * 64 + d * 16 + l15] = f2bf(v); }
#pragma unroll
                for (int o = 1; o < 16; o <<= 1) ss += __shfl_xor(ss, o);
                if (l15 == 0) SQA[(size_t)tok * 32 + h * 8 + dvs] = ss;
            }
        }
        __syncthreads();
#pragma unroll
        for (int n = 0; n < 2; ++n)
#pragma unroll
            for (int d = 0; d < 4; ++d) {
                f32x4 s = sacc[n][d] * gC;
#pragma unroll
                for (int ks = 0; ks < 4; ++ks) { const bf16x8 va = *(const LAS bf16x8*)(VS + (d * 16 + l15) * VS_LD + ks * 32 + quad * 8); s = MFMA32(va, ktf[n][ks], s); }
                sacc[n][d] = s;
#pragma unroll
                for (int r = 0; r < 4; ++r) SS[(d * 16 + quad * 4 + r) * SS_LD + (2 * wave + n) * 16 + l15] = f2bf(s[r]);
            }
        __syncthreads();
    }
    float* so = a.out + OUT_RETP + (size_t)(b * 4 + h) * 256 * 512;
#pragma unroll
    for (int n = 0; n < 2; ++n)
#pragma unroll
        for (int d = 0; d < 4; ++d) *(f32x4*)(so + (size_t)((2 * wave + n) * 16 + l15) * 512 + dvs * 64 + d * 16 + quad * 4) = sacc[n][d];
}
#undef RET_ISSUE
#undef RET_ISSUE_Q

__device__ __forceinline__ void ret_sample_unit(const Args& a, LAS unsigned char* lds, int i, int h, int tid) {
    unsigned char* ws = a.ws;
    const bf16_t* Prow = (const bf16_t*)(ws + WS_P) + (size_t)(MP + i) * NP;
    LAS float* Q = (LAS float*)lds; LAS float* Kh = Q + 256; LAS float* RED = Kh + 256; LAS float* OS = RED + 16;
    const float g = 1.f - exp2f(-5.f - (float)h);
    const int lane = tid & 63, wave = tid >> 6;
    float qk = 0.f;
    if (tid < 256) { const float q = bf2f(Prow[h * 256 + tid]), k = bf2f(Prow[O_K + h * 256 + tid]); Q[tid] = q; Kh[tid] = k; qk = q * k; }
    qk = wave_sum(qk);
    if (lane == 0) RED[wave] = qk;
    __syncthreads();
    const float qkv = (RED[0] + RED[1] + RED[2] + RED[3]) / g;
    const int dkg = tid >> 7, dv4 = 4 * (tid & 127);
    const u32x2 vw = *(const u32x2*)(Prow + O_V + h * 512 + dv4);
    const f32x4 v = {bflo(vw.x), bfhi(vw.x), bflo(vw.y), bfhi(vw.y)};
    const float* s0 = a.in[I_SRET] + (size_t)(i * 4 + h) * 256 * 512 + dv4;
    float* s1 = a.out + OUT_RETS + (size_t)(i * 4 + h) * 256 * 512 + dv4;
    f32x4 o = {0.f, 0.f, 0.f, 0.f};
#pragma unroll 8
    for (int j = 0; j < 64; ++j) {
        const int dk = dkg * 64 + j;
        const f32x4 s = __builtin_nontemporal_load((const f32x4*)(s0 + (size_t)dk * 512));
        o += s * Q[dk];
        __builtin_nontemporal_store(s * g + v * Kh[dk], (f32x4*)(s1 + (size_t)dk * 512));
    }
    *(LAS f32x4*)(OS + dkg * 512 + dv4) = o;
    __syncthreads();
    float y[4] = {0.f, 0.f, 0.f, 0.f}; float ss = 0.f;
    if (tid < 128) {
        const f32x4 t = *(LAS f32x4*)(OS + dv4) + *(LAS f32x4*)(OS + 512 + dv4) + *(LAS f32x4*)(OS + 1024 + dv4) + *(LAS f32x4*)(OS + 1536 + dv4) + v * qkv;
        y[0] = t.x; y[1] = t.y; y[2] = t.z; y[3] = t.w; ss = t.x * t.x + t.y * t.y + t.z * t.z + t.w * t.w;
    }
    ss = wave_sum(ss);
    if (lane == 0) RED[8 + wave] = ss;
    __syncthreads();
    if (tid < 128) {
        const float rs = 1.0f / sqrtf((RED[8] + RED[9]) * (1.f / 512.f) + EPS);
        const u32x2 gw = *(const u32x2*)(Prow + O_GA + h * 512 + dv4);
        u32x2 ow; ow.x = pk2(y[0] * rs * silu_(bflo(gw.x)), y[1] * rs * silu_(bfhi(gw.x))); ow.y = pk2(y[2] * rs * silu_(bflo(gw.y)), y[3] * rs * silu_(bfhi(gw.y)));
        *(u32x2*)((bf16_t*)(ws + WS_OA) + (size_t)(MP + i) * 2048 + h * 512 + dv4) = ow;
    }
    __syncthreads();
}

__device__ __forceinline__ void ret_sample_wave(const Args& a, int i, int h, int lane) {
    unsigned char* ws = a.ws;
    const bf16_t* Prow = (const bf16_t*)(ws + WS_P) + (size_t)(MP + i) * NP;
    const float g = 1.f - exp2f(-5.f - (float)h);
    float q[4], k[4]; float qk = 0.f;
#pragma unroll
    for (int j = 0; j < 4; ++j) { q[j] = bf2f(Prow[h * 256 + 64 * j + lane]); k[j] = bf2f(Prow[O_K + h * 256 + 64 * j + lane]); qk += q[j] * k[j]; }
    const float qkv = wave_sum(qk) / g;
    f32x4 v[2];
#pragma unroll
    for (int e = 0; e < 2; ++e) { const u32x2 vw = *(const u32x2*)(Prow + O_V + h * 512 + e * 256 + lane * 4); v[e] = (f32x4){bflo(vw.x), bfhi(vw.x), bflo(vw.y), bfhi(vw.y)}; }
    const float* s0 = a.in[I_SRET] + (size_t)(i * 4 + h) * 256 * 512 + lane * 4;
    float* s1 = a.out + OUT_RETS + (size_t)(i * 4 + h) * 256 * 512 + lane * 4;
    f32x4 o[2] = {{0.f, 0.f, 0.f, 0.f}, {0.f, 0.f, 0.f, 0.f}};
#pragma unroll
    for (int j = 0; j < 4; ++j) {
        for (int d0 = 0; d0 < 64; d0 += 16) {
            f32x4 sv[16][2];
#pragma unroll
            for (int d = 0; d < 16; ++d)
#pragma unroll
                for (int e = 0; e < 2; ++e) sv[d][e] = __builtin_nontemporal_load((const f32x4*)(s0 + (size_t)(64 * j + d0 + d) * 512 + e * 256));
#pragma unroll
            for (int d = 0; d < 16; ++d) {
                const float qd = __builtin_bit_cast(float, __builtin_amdgcn_readlane(__builtin_bit_cast(int, q[j]), d0 + d));
                const float kd = __builtin_bit_cast(float, __builtin_amdgcn_readlane(__builtin_bit_cast(int, k[j]), d0 + d));
#pragma unroll
                for (int e = 0; e < 2; ++e) { o[e] += sv[d][e] * qd; __builtin_nontemporal_store(sv[d][e] * g + v[e] * kd, (f32x4*)(s1 + (size_t)(64 * j + d0 + d) * 512 + e * 256)); }
            }
        }
    }
    float ss = 0.f;
#pragma unroll
    for (int e = 0; e < 2; ++e) { o[e] += v[e] * qkv; ss += (o[e].x * o[e].x + o[e].y * o[e].y) + (o[e].z * o[e].z + o[e].w * o[e].w); }
    const float rs = 1.0f / sqrtf(wave_sum(ss) * (1.f / 512.f) + EPS);
#pragma unroll
    for (int e = 0; e < 2; ++e) { const u32x2 gw = *(const u32x2*)(Prow + O_GA + h * 512 + e * 256 + lane * 4);
        u32x2 ow; ow.x = pk2(o[e].x * rs * silu_(bflo(gw.x)), o[e].y * rs * silu_(bfhi(gw.x))); ow.y = pk2(o[e].z * rs * silu_(bflo(gw.y)), o[e].w * rs * silu_(bfhi(gw.y)));
        *(u32x2*)((bf16_t*)(ws + WS_OA) + (size_t)(MP + i) * 2048 + h * 512 + e * 256 + lane * 4) = ow; }
}

__device__ __forceinline__ void phase25_row(const Args& a, int m, int lane) {
    unsigned char* ws = a.ws;
    const bf16_t* Prow = (const bf16_t*)(ws + WS_P) + (size_t)m * NP;
    bf16_t* oa = (bf16_t*)(ws + WS_OA) + (size_t)m * 2048;
    const float* sq = (const float*)(ws + WS_SQA) + (size_t)m * 32;
    const bool prompt = m < MP;
    f32x4 sqv[8]; u32x4 ow[4], gw4[4];
    if (prompt) {
#pragma unroll
        for (int j = 0; j < 8; ++j) sqv[j] = ((const f32x4*)sq)[j];
#pragma unroll
        for (int hh = 0; hh < 4; ++hh) { ow[hh] = *(const u32x4*)(oa + hh * 512 + lane * 8); gw4[hh] = *(const u32x4*)(Prow + O_GA + hh * 512 + lane * 8); }
    }
    const bf16_t* ob = (const bf16_t*)(ws + WS_OB) + (size_t)m * D + lane * 16;
    f32x4 ov[4];
    { const u32x4 w0 = ((const u32x4*)ob)[0], w1 = ((const u32x4*)ob)[1];
      ov[0] = (f32x4){bflo(w0.x), bfhi(w0.x), bflo(w0.y), bfhi(w0.y)}; ov[1] = (f32x4){bflo(w0.z), bfhi(w0.z), bflo(w0.w), bfhi(w0.w)};
      ov[2] = (f32x4){bflo(w1.x), bfhi(w1.x), bflo(w1.y), bfhi(w1.y)}; ov[3] = (f32x4){bflo(w1.z), bfhi(w1.z), bflo(w1.w), bfhi(w1.w)}; }
    const float bc = ((const float*)(ws + WS_BC))[(size_t)m * 16 + (lane >> 2)];
    const bf16_t* cur = Prow + O_SH + 2048 + lane * 16;
    const bool hasp = (m >= MP) || (m & (T - 1));
    const bf16_t* prv = (m >= MP) ? cur + (size_t)MS * NP : cur - NP;
    u32x4 cw[2], pw[2] = {{0u, 0u, 0u, 0u}, {0u, 0u, 0u, 0u}}, gbw[2];
    cw[0] = ((const u32x4*)cur)[0]; cw[1] = ((const u32x4*)cur)[1];
    if (hasp) { pw[0] = ((const u32x4*)prv)[0]; pw[1] = ((const u32x4*)prv)[1]; }
    gbw[0] = ((const u32x4*)(Prow + O_GB + lane * 16))[0]; gbw[1] = ((const u32x4*)(Prow + O_GB + lane * 16))[1];
    f32x4 lw4[4], lb4[4], mu4[4];
#pragma unroll
    for (int j = 0; j < 4; ++j) { lw4[j] = ((const f32x4*)(a.in[I_LNW] + lane * 16))[j]; lb4[j] = ((const f32x4*)(a.in[I_LNB] + lane * 16))[j]; mu4[j] = ((const f32x4*)(a.in[I_MU] + 2048 + lane * 16))[j]; }
    if (prompt) {
#pragma unroll
        for (int hh = 0; hh < 4; ++hh) {
            const f32x4 s0 = sqv[2 * hh], s1 = sqv[2 * hh + 1];
            const float rs = 1.0f / sqrtf(((s0.x + s0.y) + (s0.z + s0.w) + (s1.x + s1.y) + (s1.z + s1.w)) * (1.f / 512.f) + EPS);
            const u32x4 o4 = ow[hh], g4 = gw4[hh];
            u32x4 r;
            r.x = pk2(bflo(o4.x) * rs * silu_(bflo(g4.x)), bfhi(o4.x) * rs * silu_(bfhi(g4.x))); r.y = pk2(bflo(o4.y) * rs * silu_(bflo(g4.y)), bfhi(o4.y) * rs * silu_(bfhi(g4.y)));
            r.z = pk2(bflo(o4.z) * rs * silu_(bflo(g4.z)), bfhi(o4.z) * rs * silu_(bfhi(g4.z))); r.w = pk2(bflo(o4.w) * rs * silu_(bflo(g4.w)), bfhi(o4.w) * rs * silu_(bfhi(g4.w)));
            *(u32x4*)(oa + hh * 512 + lane * 8) = r;
        }
    }
    float o[16], lw[16], lb[16], mu[16];
#pragma unroll
    for (int j = 0; j < 4; ++j) { o[4 * j] = ov[j].x; o[4 * j + 1] = ov[j].y; o[4 * j + 2] = ov[j].z; o[4 * j + 3] = ov[j].w;
        lw[4 * j] = lw4[j].x; lw[4 * j + 1] = lw4[j].y; lw[4 * j + 2] = lw4[j].z; lw[4 * j + 3] = lw4[j].w;
        lb[4 * j] = lb4[j].x; lb[4 * j + 1] = lb4[j].y; lb[4 * j + 2] = lb4[j].z; lb[4 * j + 3] = lb4[j].w;
        mu[4 * j] = mu4[j].x; mu[4 * j + 1] = mu4[j].y; mu[4 * j + 2] = mu4[j].z; mu[4 * j + 3] = mu4[j].w; }
    float s = 0.f;
#pragma unroll
    for (int j = 0; j < 16; ++j) s += o[j];
    s += __shfl_xor(s, 1); s += __shfl_xor(s, 2);
    const float mean = s * (1.f / 64.f);
    float q = 0.f;
#pragma unroll
    for (int j = 0; j < 16; ++j) { const float d = o[j] - mean; q += d * d; }
    q += __shfl_xor(q, 1); q += __shfl_xor(q, 2);
    const float rstd = 1.0f / sqrtf(q * (1.f / 64.f) + 64e-5f);
    const unsigned cws[8] = {cw[0].x, cw[0].y, cw[0].z, cw[0].w, cw[1].x, cw[1].y, cw[1].z, cw[1].w};
    const unsigned pws[8] = {pw[0].x, pw[0].y, pw[0].z, pw[0].w, pw[1].x, pw[1].y, pw[1].z, pw[1].w};
    const unsigned gws[8] = {gbw[0].x, gbw[0].y, gbw[0].z, gbw[0].w, gbw[1].x, gbw[1].y, gbw[1].z, gbw[1].w};
    unsigned outw[8];
#pragma unroll
    for (int j = 0; j < 8; ++j) {
        const float c0 = bflo(cws[j]), c1 = bfhi(cws[j]), p0 = bflo(pws[j]), p1 = bfhi(pws[j]);
        const float v0 = c0 + (p0 - c0) * mu[2 * j], v1 = c1 + (p1 - c1) * mu[2 * j + 1];
        const float y0 = ((o[2 * j] - mean) * rstd * lw[2 * j] + lb[2 * j] + bc * v0) * silu_(bflo(gws[j]));
        const float y1 = ((o[2 * j + 1] - mean) * rstd * lw[2 * j + 1] + lb[2 * j + 1] + bc * v1) * silu_(bfhi(gws[j]));
        outw[j] = pk2(y0, y1);
    }
    bf16_t* yb = (bf16_t*)(ws + WS_H) + (size_t)m * D + lane * 16;
    *(u32x4*)yb = (u32x4){outw[0], outw[1], outw[2], outw[3]}; *(u32x4*)(yb + 8) = (u32x4){outw[4], outw[5], outw[6], outw[7]};
}

struct EpiT1 {
    static constexpr bool PERM = false;
    const bf16_t* P; bf16_t* T1;
    __device__ __forceinline__ void operator()(const f32x4 (&acc)[2][2][4][2], const Unit& u, int wr, int wc, int fr, int fq) const {
        const int row0 = u.pm * 256 + wr * 64 + fr, col0 = u.pn * 256 + wc * 32 + 4 * fq;
#pragma unroll
        for (int ai = 0; ai < 2; ++ai)
#pragma unroll
            for (int m = 0; m < 4; ++m) { const int row = row0 + ai * 128 + m * 16; if (row >= MR) continue;
#pragma unroll
                for (int bj = 0; bj < 2; ++bj)
#pragma unroll
                    for (int n = 0; n < 2; ++n) { const int col = col0 + bj * 128 + n * 16;
                        const u32x2 gw = *(const u32x2*)(P + (size_t)row * NP + O_MA + col);
                        const f32x4 gt = {sigm(bflo(gw.x)), sigm(bfhi(gw.x)), sigm(bflo(gw.y)), sigm(bfhi(gw.y))};
                        const f32x4 t = acc[ai][bj][m][n] * gt; *(u32x2*)(T1 + (size_t)row * D + col) = (u32x2){pk2(t.x, t.y), pk2(t.z, t.w)}; } asm volatile("" ::: "memory"); }
    }
};
struct EpiMG {
    static constexpr bool PERM = false;
    const bf16_t* P; const bf16_t* T1; bf16_t* MG;
    __device__ __forceinline__ void operator()(const f32x4 (&acc)[2][2][4][2], const Unit& u, int wr, int wc, int fr, int fq) const {
        const int row0 = u.pm * 256 + wr * 64 + fr, col0 = u.pn * 256 + wc * 32 + 4 * fq;
#pragma unroll
        for (int ai = 0; ai < 2; ++ai)
#pragma unroll
            for (int m = 0; m < 4; ++m) { const int row = row0 + ai * 128 + m * 16; if (row >= MR) continue;
#pragma unroll
                for (int bj = 0; bj < 2; ++bj)
#pragma unroll
                    for (int n = 0; n < 2; ++n) { const int col = col0 + bj * 128 + n * 16;
                        const u32x2 gw = *(const u32x2*)(P + (size_t)row * NP + O_MB + col);
                        const f32x4 gt = {sigm(bflo(gw.x)), sigm(bfhi(gw.x)), sigm(bflo(gw.y)), sigm(bfhi(gw.y))};
                        const u32x2 tw = *(const u32x2*)(T1 + (size_t)row * D + col);
                        const f32x4 v = (f32x4){bflo(tw.x), bfhi(tw.x), bflo(tw.y), bfhi(tw.y)} + acc[ai][bj][m][n] * gt;
                        *(u32x2*)(MG + (size_t)row * D + col) = (u32x2){pk2(v.x, v.y), pk2(v.z, v.w)}; } asm volatile("" ::: "memory"); }
    }
};
struct EpiX1 {
    static constexpr bool PERM = false;
    const float* xp; const float* xs; float* X1; bf16_t* X1B; float* SQ;
    __device__ __forceinline__ void operator()(const f32x4 (&acc)[2][2][4][2], const Unit& u, int wr, int wc, int fr, int fq) const {
        const int row0 = u.pm * 256 + wr * 64 + fr, col0 = u.pn * 256 + wc * 32 + 4 * fq;
#pragma unroll
        for (int ai = 0; ai < 2; ++ai)
#pragma unroll
            for (int m = 0; m < 4; ++m) { const int row = row0 + ai * 128 + m * 16; const bool ok = row < MR;
                const float* xr = (row < MP) ? xp + (size_t)row * D : xs + (size_t)(row - MP) * D;
                float ss = 0.f;
                if (ok) {
#pragma unroll
                    for (int bj = 0; bj < 2; ++bj)
#pragma unroll
                        for (int n = 0; n < 2; ++n) { const int col = col0 + bj * 128 + n * 16;
                            const f32x4 v = *(const f32x4*)(xr + col) + acc[ai][bj][m][n];
                            ss += (v.x * v.x + v.y * v.y) + (v.z * v.z + v.w * v.w);
                            *(u32x2*)(X1B + (size_t)row * D + col) = (u32x2){pk2(v.x, v.y), pk2(v.z, v.w)}; }
                }
                ss += __shfl_xor(ss, 16); ss += __shfl_xor(ss, 32);
                if (ok && fq == 0) SQ[(size_t)row * 16 + u.pn * 4 + wc] = ss; asm volatile("" ::: "memory"); }
    }
};
struct EpiGT {
    static constexpr bool PERM = false;
    const float* SQ; bf16_t* GT;
    __device__ __forceinline__ void operator()(const f32x4 (&acc)[2][2][4][2], const Unit& u, int wr, int wc, int fr, int fq) const {
        const int row0 = u.pm * 256 + wr * 64 + fr, col0 = u.pn * 256 + wc * 32 + 4 * fq;
#pragma unroll
        for (int ai = 0; ai < 2; ++ai)
#pragma unroll
            for (int m = 0; m < 4; ++m) { const int row = row0 + ai * 128 + m * 16; if (row >= MR) continue;
                const f32x4* sp = (const f32x4*)(SQ + (size_t)row * 16); const f32x4 q0 = sp[0], q1 = sp[1], q2 = sp[2], q3 = sp[3];
                const float rs = 1.0f / sqrtf((((q0.x + q0.y) + (q0.z + q0.w)) + ((q1.x + q1.y) + (q1.z + q1.w)) + ((q2.x + q2.y) + (q2.z + q2.w)) + ((q3.x + q3.y) + (q3.z + q3.w))) * (1.f / D) + EPS);
#pragma unroll
                for (int bj = 0; bj < 2; ++bj)
#pragma unroll
                    for (int n = 0; n < 2; ++n) { const int col = col0 + bj * 128 + n * 16; const f32x4 t = acc[ai][bj][m][n] * rs;
                        *(u32x2*)(GT + (size_t)row * D + col) = (u32x2){pk2(sigm(t.x), sigm(t.y)), pk2(sigm(t.z), sigm(t.w))}; } asm volatile("" ::: "memory"); }
    }
};
struct EpiX2 {
    static constexpr bool PERM = false;
    const bf16_t* X1; const bf16_t* GT; float* out; float* SQ;
    __device__ __forceinline__ void operator()(const f32x4 (&acc)[2][2][4][2], const Unit& u, int wr, int wc, int fr, int fq) const {
        const int row0 = u.pm * 256 + wr * 64 + fr, col0 = u.pn * 256 + wc * 32 + 4 * fq;
#pragma unroll
        for (int ai = 0; ai < 2; ++ai)
#pragma unroll
            for (int m = 0; m < 4; ++m) { int row = row0 + ai * 128 + m * 16; asm volatile("" : "+v"(row)); const bool ok = row < MR;
                float ss = 0.f;
                if (ok) {
#pragma unroll
                    for (int bj = 0; bj < 2; ++bj)
#pragma unroll
                        for (int n = 0; n < 2; ++n) { const int col = col0 + bj * 128 + n * 16;
                            const u32x2 gw = *(const u32x2*)(GT + (size_t)row * D + col);
                            const u32x2 xw = *(const u32x2*)(X1 + (size_t)row * D + col);
                            const f32x4 v = (f32x4){bflo(xw.x), bfhi(xw.x), bflo(xw.y), bfhi(xw.y)} + acc[ai][bj][m][n] * (f32x4){bflo(gw.x), bfhi(gw.x), bflo(gw.y), bfhi(gw.y)};
                            ss += (v.x * v.x + v.y * v.y) + (v.z * v.z + v.w * v.w);
                            *(f32x4*)(out + (size_t)row * D + col) = v; asm volatile("" ::: "memory"); }
                }
                ss += __shfl_xor(ss, 16); ss += __shfl_xor(ss, 32);
                if (ok && fq == 0) SQ[(size_t)row * 16 + u.pn * 4 + wc] = ss; asm volatile("" ::: "memory"); }
    }
};


__device__ __forceinline__ f32x4 mini_acc(const bf16_t* A, int lda, const bf16_t* Bt, int K, int kq, int l15, int quad) {
    f32x4 acc = {0.f, 0.f, 0.f, 0.f};
    const int kn = K / 128;
    const bf16_t* ap = A + (size_t)l15 * lda + kq * (K / 4) + quad * 8;
    const bf16_t* bp = Bt + (size_t)l15 * K + kq * (K / 4) + quad * 8;
#pragma unroll 4
    for (int ks = 0; ks < kn; ++ks) acc = MFMA32(*(const bf16x8*)(ap + ks * 32), *(const bf16x8*)(bp + ks * 32), acc);
    return acc;
}
__device__ __forceinline__ f32x4 mini_reduce(LAS f32x4* red, int half, int lane) { return (red[(half * 4 + 0) * 64 + lane] + red[(half * 4 + 1) * 64 + lane]) + (red[(half * 4 + 2) * 64 + lane] + red[(half * 4 + 3) * 64 + lane]); }
template <int PH> __device__ __forceinline__ void mini_phase(const Args& a, LAS unsigned char* lds, int bx, int G, int wave, int lane) {
    unsigned char* ws = a.ws;
    const int l15 = lane & 15, quad = lane >> 4, half = wave >> 2, kq = wave & 3;
    LAS f32x4* red1 = (LAS f32x4*)lds; LAS f32x4* red2 = red1 + 8 * 64;
    const bf16_t* P = (const bf16_t*)(ws + WS_P);
    for (int tp = bx; tp < 256; tp += G) {
        const int tl = tp * 2 + half, mt = tl >> 6, nt = tl & 63, row0 = MP + mt * 16, col0 = nt * 16;
        f32x4 a1, a2 = {0.f, 0.f, 0.f, 0.f};
        if (PH == 0) { a1 = mini_acc((const bf16_t*)(ws + WS_OA) + (size_t)row0 * 2048, 2048, (const bf16_t*)(ws + WS_WDA) + (size_t)col0 * 2048, 2048, kq, l15, quad);
                       a2 = mini_acc((const bf16_t*)(ws + WS_H) + (size_t)row0 * D, D, (const bf16_t*)(ws + WS_WDB) + (size_t)col0 * D, D, kq, l15, quad); }
        if (PH == 1) { a1 = mini_acc((const bf16_t*)(ws + WS_MG) + (size_t)row0 * D, D, (const bf16_t*)(ws + WS_WOUT) + (size_t)col0 * D, D, kq, l15, quad); }
        if (PH == 2) { a1 = mini_acc((const bf16_t*)(ws + WS_X1B) + (size_t)row0 * D, D, (const bf16_t*)(ws + WS_WGATE) + (size_t)col0 * D, D, kq, l15, quad);
                       a2 = mini_acc((const bf16_t*)(ws + WS_PB) + (size_t)row0 * PLE, PLE, (const bf16_t*)(ws + WS_WPLE) + (size_t)col0 * PLE, PLE, kq, l15, quad); }
        red1[wave * 64 + lane] = a1; red2[wave * 64 + lane] = a2;
        __syncthreads();
        if (kq == 0) {
            a1 = mini_reduce(red1, half, lane); a2 = mini_reduce(red2, half, lane);
            const int col = col0 + l15;
            float rs1[4] = {0.f, 0.f, 0.f, 0.f};
            if (PH == 2) {
#pragma unroll
                for (int r = 0; r < 4; ++r) { const f32x4 q = *(const f32x4*)((const float*)(ws + WS_SQS1) + (size_t)(row0 - MP + quad * 4 + r) * 64 + l15 * 4); float t = (q.x + q.y) + (q.z + q.w);
#pragma unroll
                    for (int o = 1; o < 16; o <<= 1) t += __shfl_xor(t, o);
                    rs1[r] = 1.0f / sqrtf(t * (1.f / D) + EPS); }
            }
#pragma unroll
            for (int r = 0; r < 4; ++r) {
                const int row = row0 + quad * 4 + r;
                float ss = 0.f;
                if (PH == 0) { const float ga = sigm(bf2f(P[(size_t)row * NP + O_MA + col])), gb = sigm(bf2f(P[(size_t)row * NP + O_MB + col]));
                    ((bf16_t*)(ws + WS_MG))[(size_t)row * D + col] = f2bf(a1[r] * ga + a2[r] * gb); }
                if (PH == 1) { const float x1 = a.in[I_XS][(size_t)(row - MP) * D + col] + a1[r]; ss = x1 * x1;
                    ((bf16_t*)(ws + WS_X1B))[(size_t)row * D + col] = f2bf(x1); }
                if (PH == 2) { const float x2 = bf2f(((const bf16_t*)(ws + WS_X1B))[(size_t)row * D + col]) + a2[r] * sigm(rs1[r] * a1[r]); ss = x2 * x2;
                    a.out[OUT_Y + (size_t)row * D + col] = x2; }
                if (PH != 0) {
#pragma unroll
                    for (int o = 1; o < 16; o <<= 1) ss += __shfl_xor(ss, o);
                    if (l15 == 0) ((float*)(ws + (PH == 1 ? WS_SQS1 : WS_SQS2)))[(size_t)(row - MP) * 64 + nt] = ss;
                }
            }
        }
        __syncthreads();
    }
}

#define XB_TMO      128
#define XB_XCNT(j)  (256  + 64 * (j))
#define XB_XSUB(j)  (1280 + 64 * (j))
#define XB_XGEN(j)  (2304 + 64 * (j))
#define XB_TOP      3328
#define XB_TOPGEN   3392
#define XCD_BAR_WORDS 3456
#define XB_SPIN_CAP (1u << 22)
__device__ __forceinline__ unsigned xb_ld(unsigned* p)              { return __hip_atomic_load(p, __ATOMIC_RELAXED, __HIP_MEMORY_SCOPE_AGENT); }
__device__ __forceinline__ unsigned xb_add(unsigned* p, unsigned v) { return __hip_atomic_fetch_add(p, v, __ATOMIC_RELAXED, __HIP_MEMORY_SCOPE_AGENT); }
__device__ __forceinline__ unsigned xb_xcc_id() { return (unsigned)__builtin_amdgcn_s_getreg((3 << 11) | 20) & 0xFu; }
#define XB_SPIN(cond, bar) do { unsigned _sp = 0; while (cond) { __builtin_amdgcn_s_sleep(1); \
    if ((++_sp & 255u) == 0u) { if (xb_ld(&(bar)[XB_TMO])) break; if (_sp > XB_SPIN_CAP) { atomicAdd(&(bar)[XB_TMO], 1u); break; } } } } while (0)
struct XcdBarrier { unsigned* bar; unsigned x; volatile LAS unsigned* st; };
__device__ __forceinline__ XcdBarrier xcd_barrier_post(unsigned* bar, volatile LAS unsigned* st) {
    XcdBarrier b; b.bar = bar; b.x = xb_xcc_id(); b.st = st;
    if (threadIdx.x == 0) (void)xb_add(&bar[XB_XCNT(b.x)], 1u);
    return b;
}
__device__ __forceinline__ void xcd_barrier_complete(unsigned* bar, unsigned x, unsigned& nloc, unsigned& nx) {
    const unsigned G = gridDim.x * gridDim.y * gridDim.z;
    unsigned sum, cnt, mine, sp = 0u;
    for (;;) {
        sum = 0u; cnt = 0u; mine = 0u;
#pragma unroll
        for (unsigned j = 0; j < 16; ++j) { const unsigned c = xb_ld(&bar[XB_XCNT(j)]); sum += c; cnt += (c > 0u) ? 1u : 0u; mine = (j == x) ? c : mine; }
        if (sum == G) break;
        __builtin_amdgcn_s_sleep(1);
        if ((++sp & 255u) == 0u) { if (xb_ld(&bar[XB_TMO])) break; if (sp > XB_SPIN_CAP) { atomicAdd(&bar[XB_TMO], 1u); break; } }
    }
    nloc = mine > 0u ? mine : 1u; nx = cnt > 0u ? cnt : 1u;
}
__device__ __forceinline__ void xcd_barrier(const XcdBarrier& b) {
    asm volatile("s_waitcnt vmcnt(0)" ::: "memory");
    __syncthreads();
    if (threadIdx.x == 0) {
        unsigned* bar = b.bar;
        __builtin_amdgcn_s_waitcnt(0);
        unsigned nloc = b.st[0], nx = b.st[1];
        if (nloc == 0u) { xcd_barrier_complete(bar, b.x, nloc, nx); b.st[0] = nloc; b.st[1] = nx; }
        const unsigned old = xb_add(&bar[XB_XSUB(b.x)], 1u);
        const unsigned gen = old / nloc;
        if (old + 1u == (gen + 1u) * nloc) {
            __builtin_amdgcn_fence(__ATOMIC_RELEASE, "agent");
            asm volatile("s_waitcnt vmcnt(0)" ::: "memory");
            const unsigned og = xb_add(&bar[XB_TOP], 1u);
            const unsigned tg = og / nx;
            if (og + 1u == (tg + 1u) * nx) xb_add(&bar[XB_TOPGEN], 1u);
            else XB_SPIN(xb_ld(&bar[XB_TOPGEN]) == tg, bar);
            __builtin_amdgcn_fence(__ATOMIC_ACQUIRE, "agent");
            xb_add(&bar[XB_XGEN(b.x)], 1u);
            asm volatile("s_waitcnt vmcnt(0)" ::: "memory");
        } else {
            XB_SPIN(xb_ld(&bar[XB_XGEN(b.x)]) == gen, bar);
            __builtin_amdgcn_fence(__ATOMIC_ACQUIRE, "agent");
            asm volatile("s_waitcnt vmcnt(0)" ::: "memory");
        }
    }
    __syncthreads();
}

constexpr int LDS_BYTES = 147456;
constexpr int CTL_SQ1 = 0, CTL_SQ2 = 32768, CTL_CNT = 65536;

#define GRID_SYNC() xcd_barrier(xbar)
__global__ void __launch_bounds__(512, 2) fwd_mega(Args a) {
    extern __shared__ __attribute__((aligned(16))) unsigned char lds_raw[];
    LAS unsigned char* lds = (LAS unsigned char*)lds_raw;
    cg::grid_group grid = cg::this_grid();
    const int tid = threadIdx.x, lane = tid & 63, wave = __builtin_amdgcn_readfirstlane(tid >> 6);
    const int G = gridDim.x, bx = blockIdx.x;
    const int gw = bx * 8 + wave, NGW = G * 8;
    unsigned char* ws = a.ws;
    if (tid < 16) ((LAS unsigned*)(lds + 131072 + 64))[tid] = 0u;
    __syncthreads();
    XcdBarrier xbar = xcd_barrier_post((unsigned*)(ws + WS_BAR), (volatile LAS unsigned*)(lds + 131072 + 64));
    if (gridDim.x == 0x7fffffffu) grid.sync();

#if !defined(ONLY_PH) || ONLY_PH == 0
    phase0(a, lds, gw, NGW, wave, lane);
    GRID_SYNC();
#endif
#if !defined(ONLY_PH) || ONLY_PH == 1
    {
        pg8::Gemm g{(const bf16_t*)(ws + WS_H), (const bf16_t*)(ws + WS_WIN), MALL, NP, D}; pg8::StaticOrder S; S.init(MALL, NP, G, bx);
        EpiP E{(bf16_t*)(ws + WS_P), (bf16_t*)(ws + WS_KT), (const f32x2*)(ws + WS_ROPE)};
        pg8::gemm_phase<EpiP>(lds, g, S, E);
    }
    GRID_SYNC();
#endif
#if !defined(ONLY_PH) || ONLY_PH == 2
    for (int it = gw; it < 1032 * 16; it += NGW) rw_prep_item(a, lds + wave * 10240, it >> 4, it & 15, lane);
    GRID_SYNC();
#endif
#if !defined(ONLY_PH) || ONLY_PH == 3
    {
        if (G < 128) for (int u = gw; u < MS * 16; u += NGW) rw_sample_wave(a, u >> 4, u & 15, lane);
        if (bx < 128) { if (wave < 4) rw_scan_task(a, lds + wave * 4096, bx >> 4, bx & 15, wave, lane); else if (G >= 128) { const int u = bx * 4 + (wave - 4); ret_sample_wave(a, u >> 2, u & 3, lane); }
            if (G >= 128) { for (int u = bx * 8 + wave; u < MS * 16; u += 1024) rw_sample_wave(a, u >> 4, u & 15, lane);
                p0_late(a, (LAS float*)(lds + 16384 + wave * 14336), bx * 8 + wave, 1024, lane); }
        }
        __syncthreads();
        {
            unsigned* cnt2 = (unsigned*)(ws + WS_CTL) + CTL_CNT + 32;
            LAS unsigned* lu = (LAS unsigned*)(lds + 131072);
            for (;;) {
                if (tid == 0) *lu = atomicAdd(cnt2, 1u);
                __syncthreads();
                const unsigned unit = *lu;
                __syncthreads();
                if (unit >= (unsigned)(MS * 4) || G >= 128) break;
                ret_sample_unit(a, lds, (int)(unit >> 2), (int)(unit & 3), tid);
            }
        }
        if (G == 256) {
            if (bx >= 128) {
                const int x = bx & 7, j = (bx - 128) >> 3;
                for (int r = 0; r < 2; ++r) { const int k = r * 16 + j, g = (k >> 3) * 8 + x; ret_unit(a, lds, g * 8 + (k & 7), tid); }
            }
        } else {
            unsigned* cnt = (unsigned*)(ws + WS_CTL) + CTL_CNT;
            LAS unsigned* lu = (LAS unsigned*)(lds + 131072);
            for (;;) {
                if (tid == 0) *lu = atomicAdd(cnt, 1u);
                __syncthreads();
                const unsigned unit = *lu;
                __syncthreads();
                if (unit >= 256u) break;
                ret_unit(a, lds, (int)unit, tid);
            }
        }
    }
    GRID_SYNC();
#endif
#if !defined(ONLY_PH) || ONLY_PH == 4
    for (int m = gw; m < MR; m += NGW) phase25_row(a, m, lane);
    GRID_SYNC();
#endif
#if !defined(ONLY_PH) || ONLY_PH == 5
    {
        mini_phase<0>(a, lds, bx, G, wave, lane);
        pg8::StaticOrder S; S.init(MP, D, G, bx);
        { pg8::Gemm g{(const bf16_t*)(ws + WS_OA), (const bf16_t*)(ws + WS_WDA), MP, D, 2048}; EpiT1 E{(const bf16_t*)(ws + WS_P), (bf16_t*)(ws + WS_T1)}; pg8::gemm_phase<EpiT1>(lds, g, S, E); }
        { pg8::Gemm g{(const bf16_t*)(ws + WS_H), (const bf16_t*)(ws + WS_WDB), MP, D, D}; EpiMG E{(const bf16_t*)(ws + WS_P), (const bf16_t*)(ws + WS_T1), (bf16_t*)(ws + WS_MG)}; pg8::gemm_phase<EpiMG>(lds, g, S, E); }
    }
    GRID_SYNC();
#endif
#if !defined(ONLY_PH) || ONLY_PH == 6
    {
        mini_phase<1>(a, lds, bx, G, wave, lane);
        pg8::StaticOrder S; S.init(MP, D, G, bx);
        pg8::Gemm g{(const bf16_t*)(ws + WS_MG), (const bf16_t*)(ws + WS_WOUT), MP, D, D};
        EpiX1 E{a.in[I_XP], a.in[I_XS], (float*)(ws + WS_X1), (bf16_t*)(ws + WS_X1B), (float*)(ws + WS_SQ1P)};
        pg8::gemm_phase<EpiX1>(lds, g, S, E);
    }
    GRID_SYNC();
#endif
#if !defined(ONLY_PH) || ONLY_PH == 7
    {
        mini_phase<2>(a, lds, bx, G, wave, lane);
        pg8::StaticOrder S; S.init(MP, D, G, bx);
        { pg8::Gemm g{(const bf16_t*)(ws + WS_X1B), (const bf16_t*)(ws + WS_WGATE), MP, D, D}; EpiGT E{(const float*)(ws + WS_SQ1P), (bf16_t*)(ws + WS_GT)}; pg8::gemm_phase<EpiGT>(lds, g, S, E); }
        { pg8::Gemm g{(const bf16_t*)(ws + WS_PB), (const bf16_t*)(ws + WS_WPLE), MP, D, PLE}; EpiX2 E{(const bf16_t*)(ws + WS_X1B), (const bf16_t*)(ws + WS_GT), a.out + OUT_Y, (float*)(ws + WS_SQ2P)}; pg8::gemm_phase<EpiX2>(lds, g, S, E); }
    }
    GRID_SYNC();
#endif
#if !defined(ONLY_PH) || ONLY_PH == 8
    {
        const float* sq2 = (const float*)(ws + WS_SQ2P); const float* fg = a.in[I_FNG];
        for (int m0 = gw; m0 < MR; m0 += 2 * NGW) {
            const int m1 = m0 + NGW; const bool two = m1 < MR;
            float tot[2]; f32x4 xv[2][4];
#pragma unroll
            for (int e = 0; e < 2; ++e) {
                const int m = e ? m1 : m0;
                if (e == 0 || two) {
                    if (m < MP) { const f32x4* sp = (const f32x4*)(sq2 + (size_t)m * 16); const f32x4 q0 = sp[0], q1 = sp[1], q2 = sp[2], q3 = sp[3];
                        tot[e] = (((q0.x + q0.y) + (q0.z + q0.w)) + ((q1.x + q1.y) + (q1.z + q1.w)) + ((q2.x + q2.y) + (q2.z + q2.w)) + ((q3.x + q3.y) + (q3.z + q3.w))); }
                    else tot[e] = wave_sum(((const float*)(ws + WS_SQS2))[(size_t)(m - MP) * 64 + lane]);
                    const f32x4* o = (const f32x4*)(a.out + OUT_Y + (size_t)m * D);
#pragma unroll
                    for (int j = 0; j < 4; ++j) xv[e][j] = o[lane + 64 * j];
                }
            }
#pragma unroll
            for (int e = 0; e < 2; ++e) {
                const int m = e ? m1 : m0;
                if (e == 0 || two) {
                    const float rs = 1.0f / sqrtf(tot[e] * (1.f / D) + EPS);
                    f32x4* o = (f32x4*)(a.out + OUT_Y + (size_t)m * D);
#pragma unroll
                    for (int j = 0; j < 4; ++j) o[lane + 64 * j] = xv[e][j] * rs * ((const f32x4*)fg)[lane + 64 * j];
                }
            }
        }
    }
#endif

}

extern "C" void kernel_launch(void* const* d_in, const int* in_sizes, int n_in, void* d_out, int out_size, void* d_ws, size_t ws_size, hipStream_t stream) {
    static int grid = 0;
    if (grid == 0) {
        if (n_in != 26 || ws_size < WS_END) { fprintf(stderr, "kernel_launch: unexpected n_in %d or ws_size %zu (need %zu)\n", n_in, ws_size, (size_t)WS_END); grid = -1; return; }
        int dev = 0, cus = 0, per_cu = 0;
        hipGetDevice(&dev); hipDeviceGetAttribute(&cus, hipDeviceAttributeMultiprocessorCount, dev);
        if (hipFuncSetAttribute((const void*)fwd_mega, hipFuncAttributeMaxDynamicSharedMemorySize, LDS_BYTES) != hipSuccess) { fprintf(stderr, "kernel_launch: hipFuncSetAttribute failed\n"); grid = -1; return; }
        hipOccupancyMaxActiveBlocksPerMultiprocessor(&per_cu, (const void*)fwd_mega, 512, LDS_BYTES);
        if (per_cu < 1) { fprintf(stderr, "kernel_launch: occupancy query says %d blocks per CU\n", per_cu); per_cu = 1; }
        (void)hipGetLastError();
        grid = cus * 1;
        fprintf(stderr, "kernel_launch: grid %d (cus %d, per_cu %d), ws %zu\n", grid, cus, per_cu, ws_size);
    }
    if (grid < 0) return;
    Args a{};
    for (int i = 0; i < 26; ++i) a.in[i] = (const float*)d_in[i];
    a.out = (float*)d_out; a.ws = (unsigned char*)d_ws;
    if (hipMemsetAsync((char*)d_ws + WS_BAR, 0, XCD_BAR_WORDS * 4, stream) != hipSuccess) { fprintf(stderr, "kernel_launch: memset failed\n"); return; }
    void* args[] = {&a};
    hipError_t e = hipLaunchCooperativeKernel((const void*)fwd_mega, dim3(grid), dim3(512), args, LDS_BYTES, stream);
    if (e != hipSuccess) fprintf(stderr, "kernel_launch: cooperative launch failed: %s\n", hipGetErrorString(e));
}
```

```cpp
#include <hip/hip_runtime.h>
#include <hip/hip_cooperative_groups.h>
#include <cstdio>
#include <cstdint>
namespace cg = cooperative_groups;

#define LAS __attribute__((address_space(3)))
typedef unsigned short bf16_t;
typedef short bf16x8 __attribute__((ext_vector_type(8)));
typedef short bf16x4 __attribute__((ext_vector_type(4)));
typedef float f32x4 __attribute__((ext_vector_type(4)));
typedef float f32x2 __attribute__((ext_vector_type(2)));
typedef unsigned u32x4 __attribute__((ext_vector_type(4)));
typedef unsigned u32x2 __attribute__((ext_vector_type(2)));
typedef __bf16 nbf2 __attribute__((ext_vector_type(2)));

constexpr int D = 1024, NB = 8, T = 2048, MP = NB * T  , MS = 128, MR = MP + MS  , MALL = 16640  ;
constexpr int NCOLS = 12416, NP = 12544  ;
constexpr int O_K = 1024, O_V = 2048, O_GA = 4096, O_SH = 6144, O_GB = 9344, O_MA = 10368, O_MB = 11392;
constexpr int RH = 4, RDK = 256, RDV = 512, RCH = 128;
constexpr int WH = 16, WN = 64;
constexpr int PLE = 256;
constexpr float EPS = 1e-6f;
constexpr int REC = 12544;
constexpr int R_AT = 0, R_RT = 2048, R_BP = 4096, R_KP = 6144, R_VT = 8192, R_AAK = 10240, R_TT = 10752, R_ARB = 11264, R_ARK = 11776, R_WC = 12288;

constexpr size_t MiB = 1u << 20;
constexpr size_t WS_CTL = 0;
constexpr size_t WS_ROPE = 1 * MiB;
constexpr size_t WS_W2T = 4 * MiB, WS_A2T = WS_W2T + 131072;
constexpr size_t WS_WPLE = 5 * MiB, WS_WDB = 6 * MiB, WS_WOUT = 8 * MiB, WS_WGATE = 10 * MiB, WS_WDA = 12 * MiB, WS_WIN = 16 * MiB;
constexpr size_t WS_PB = 41 * MiB, WS_H = 50 * MiB  , WS_KT = 83 * MiB, WS_SQA = 115 * MiB, WS_BC = 117 * MiB, WS_OPSS = 119 * MiB  ;
constexpr size_t WS_OA = 122 * MiB, WS_P = 188 * MiB, WS_CH = 587 * MiB  , WS_OB = 786 * MiB  ;
constexpr size_t WS_T1 = WS_CH, WS_MG = WS_CH + 65 * MiB, WS_X1B = WS_CH + 98 * MiB, WS_GT = WS_CH + 131 * MiB, WS_X1 = WS_OB + 65 * MiB  ;
constexpr size_t WS_END = 916 * MiB;
constexpr size_t WS_BAR = 512 * 1024;
constexpr size_t WS_SQS1 = 640 * 1024, WS_SQS2 = 704 * 1024;
constexpr size_t WS_SQ1P = WS_KT, WS_SQ2P = WS_KT + 2 * MiB;

constexpr size_t OUT_Y = 0, OUT_RETP = 16908288, OUT_RWP = 21102592, OUT_SHP = 21626880, OUT_RETS = 21635072, OUT_RWS = 88743936, OUT_SHS = 97132544;

__device__ __forceinline__ unsigned pk2(float lo, float hi) { f32x2 v = {lo, hi}; nbf2 r = __builtin_convertvector(v, nbf2); return __builtin_bit_cast(unsigned, r); }
__device__ __forceinline__ unsigned short f2bf(float f) { return (unsigned short)(pk2(f, 0.f) & 0xffffu); }
__device__ __forceinline__ float bf2f(unsigned short b) { return __uint_as_float(((unsigned)b) << 16); }
__device__ __forceinline__ float bflo(unsigned w) { return __uint_as_float(w << 16); }
__device__ __forceinline__ float bfhi(unsigned w) { return __uint_as_float(w & 0xffff0000u); }
__device__ __forceinline__ float sigm(float x) { return __builtin_amdgcn_rcpf(1.f + __expf(-x)); }
__device__ __forceinline__ float silu_(float x) { return x * sigm(x); }
__device__ __forceinline__ float wave_sum(float v) {
#pragma unroll
    for (int o = 1; o < 64; o <<= 1) v += __shfl_xor(v, o);
    return v;
}
#define MFMA32(a, b, c) __builtin_amdgcn_mfma_f32_16x16x32_bf16((a), (b), (c), 0, 0, 0)
#define LDS_WAIT() asm volatile("s_waitcnt lgkmcnt(0)" ::: "memory")

namespace pg8 {
constexpr int BM = 256, BK = 64, HALF = 128, HTB = HALF * BK * 2, STAGE_BYTES = 8 * HTB, NXCD = 8, WGM = 8;
__host__ __device__ __forceinline__ int lds_byte(int r, int c) { const int st = (r >> 4) * 2 + (c >> 5), rr = r & 15, cc = c & 31, ob = rr * 64 + cc * 2; return st * 1024 + (ob ^ (((ob >> 9) & 1) << 5)); }
__host__ __device__ __forceinline__ void stage_rc(int b, int& R, int& C) { const int st = b / 1024, sb = b % 1024, swz = sb ^ (((sb >> 9) & 1) << 5); R = (st >> 1) * 16 + swz / 64; C = (st & 1) * 32 + (swz % 64) / 2; }
__host__ __device__ __forceinline__ int perm32(int rho) { const int n = rho >> 4, i = rho & 15; return 8 * (i >> 2) + 4 * n + (i & 3); }
struct Unit { int pm, pn; };
struct Gemm { const bf16_t* A; const bf16_t* Bt; int M, N, K; };
struct StaticOrder {
    int nM, nN, nwg, G, c;
    __host__ __device__ void init(int M, int N, int G_, int c_) { nM = M / BM; nN = N / BM; nwg = nM * nN; G = G_; c = c_; }
    __host__ __device__ bool next(int i, Unit& u) const {
        const long L = (long)i * G + c; if (L >= nwg) return false;
        int wgid = (int)L; { const int q = nwg / NXCD, r = nwg % NXCD, xcd = wgid % NXCD, off = wgid / NXCD; wgid = (xcd < r ? xcd * (q + 1) : r * (q + 1) + (xcd - r) * q) + off; }
        const int nig = WGM * nN, gid = wgid / nig, fm = gid * WGM, gsz = (nM - fm) < WGM ? (nM - fm) : WGM;
        u.pm = fm + ((wgid % nig) % gsz); u.pn = (wgid % nig) / gsz; return true;
    }
};
template <class Epi>
__device__ __forceinline__ void gemm_phase(LAS unsigned char* lds, const Gemm g, const StaticOrder& S, const Epi& E) {
    int tid = threadIdx.x; asm volatile("" : "+v"(tid));
    const int wid = __builtin_amdgcn_readfirstlane(tid >> 6), lane = tid & 63, wr = wid >> 2, wc = wid & 3, fr = lane & 15, fq = lane >> 4;
    const int K = g.K, nt = K / BK;
    unsigned voffA[2], voffB[2];
#pragma unroll
    for (int i = 0; i < 2; ++i) { int R, C; stage_rc(tid * 16 + i * 8192, R, C); const int Rb = Epi::PERM ? ((R & ~31) + perm32(R & 31)) : R;
        voffA[i] = (unsigned)(R * K + C) * 2u; voffB[i] = (unsigned)(Rb * K + C) * 2u; }
    const size_t kstep = (size_t)(BK * 2);
    const size_t hstep = (size_t)HALF * K * 2;
    const size_t tstep = 2 * hstep;
    const unsigned ldsw = (unsigned)wid * 1024u;
    const int aoff = lds_byte(wr * 64 + fr, fq * 8), boff = lds_byte(wc * 32 + fr, fq * 8);
#define PG8_SA(b, h) (((b) * 2 + (h)) * HTB)
#define PG8_SB(b, h) ((4 + (b) * 2 + (h)) * HTB)
#define PG8_STAGE(bufoff, gbase, voff) do { _Pragma("unroll") for (int _i = 0; _i < 2; ++_i) \
        __builtin_amdgcn_global_load_lds((const unsigned*)((const char*)(gbase) + (voff)[_i]), (LAS unsigned*)(lds + (bufoff) + ldsw + _i * 8192), 16, 0, 0); } while (0)
#define PG8_LDA(dst, b, h) do { _Pragma("unroll") for (int m = 0; m < 4; ++m) _Pragma("unroll") for (int k = 0; k < 2; ++k) dst[m][k] = *(const LAS bf16x8*)(lds + PG8_SA(b, h) + aoff + m * 2048 + k * 1024); } while (0)
#define PG8_LDB(dst, b, h) do { _Pragma("unroll") for (int n = 0; n < 2; ++n) _Pragma("unroll") for (int k = 0; k < 2; ++k) dst[n][k] = *(const LAS bf16x8*)(lds + PG8_SB(b, h) + boff + n * 2048 + k * 1024); } while (0)
#define PG8_MMA(ai, bj, At, Bt) do { __builtin_amdgcn_s_setprio(1); _Pragma("unroll") for (int m = 0; m < 4; ++m) _Pragma("unroll") for (int n = 0; n < 2; ++n) _Pragma("unroll") for (int k = 0; k < 2; ++k) \
        acc[ai][bj][m][n] = __builtin_amdgcn_mfma_f32_16x16x32_bf16(Bt[n][k], At[m][k], acc[ai][bj][m][n], 0, 0, 0); __builtin_amdgcn_s_setprio(0); } while (0)
#define PG8_WAIT_V(n) asm volatile("s_waitcnt vmcnt(" #n ")" ::: "memory")
#define PG8_WAIT_L(n) asm volatile("s_waitcnt lgkmcnt(" #n ")" ::: "memory")
#define PG8_BAR __builtin_amdgcn_s_barrier()
#define PG8_SCHED __builtin_amdgcn_sched_barrier(0)
    Unit cur, nxt; int ui = 0;
    if (!S.next(0, cur)) return;
    f32x4 acc[2][2][4][2];
#pragma unroll
    for (int a = 0; a < 2; ++a)
#pragma unroll
        for (int b = 0; b < 2; ++b)
#pragma unroll
            for (int m = 0; m < 4; ++m)
#pragma unroll
                for (int n = 0; n < 2; ++n) acc[a][b][m][n] = (f32x4){0.f, 0.f, 0.f, 0.f};
    bf16x8 At[4][2], B0[2][2], B1[2][2];
    const char* cA = (const char*)g.A + (size_t)cur.pm * tstep; const char* cB = (const char*)g.Bt + (size_t)cur.pn * tstep;
    PG8_STAGE(PG8_SB(0, 0), cB, voffB); PG8_STAGE(PG8_SA(0, 0), cA, voffA); PG8_STAGE(PG8_SB(0, 1), cB + hstep, voffB); PG8_STAGE(PG8_SA(0, 1), cA + hstep, voffA);
    if (wr == 1) PG8_BAR;
    PG8_WAIT_V(4); PG8_BAR;
    PG8_STAGE(PG8_SB(1, 0), cB + kstep, voffB); PG8_STAGE(PG8_SA(1, 0), cA + kstep, voffA); PG8_STAGE(PG8_SB(1, 1), cB + hstep + kstep, voffB);
    PG8_WAIT_V(6); PG8_BAR;
    for (;;) {
        const bool has_next = S.next(ui + 1, nxt);
        const char* nA = has_next ? (const char*)g.A + (size_t)nxt.pm * tstep : cA; const char* nB = has_next ? (const char*)g.Bt + (size_t)nxt.pn * tstep : cB;
#pragma unroll 1
        for (int t = 0; t < nt; t += 2) {
            const bool last = (t == nt - 2);
            const char* a1 = cA + (size_t)(t + 1) * kstep;
            const char* a2 = last ? nA : cA + (size_t)(t + 2) * kstep; const char* b2 = last ? nB : cB + (size_t)(t + 2) * kstep;
            const char* a3 = a2 + kstep; const char* b3 = b2 + kstep;
            PG8_LDB(B0, 0, 0); PG8_SCHED; PG8_LDA(At, 0, 0); PG8_STAGE(PG8_SA(1, 1), a1 + hstep, voffA);
            PG8_WAIT_L(8); PG8_BAR; PG8_WAIT_L(0); PG8_MMA(0, 0, At, B0); PG8_BAR; PG8_SCHED;
            PG8_LDB(B1, 0, 1); PG8_STAGE(PG8_SB(0, 0), b2, voffB);
            PG8_BAR; PG8_WAIT_L(0); PG8_MMA(0, 1, At, B1); PG8_BAR;
            PG8_LDA(At, 0, 1); PG8_STAGE(PG8_SA(0, 0), a2, voffA);
            PG8_BAR; PG8_WAIT_L(0); PG8_MMA(1, 0, At, B0); PG8_BAR; PG8_SCHED;
            PG8_STAGE(PG8_SB(0, 1), b2 + hstep, voffB);
            PG8_WAIT_V(6); PG8_BAR; PG8_MMA(1, 1, At, B1); PG8_BAR;
            PG8_LDB(B0, 1, 0); PG8_SCHED; PG8_LDA(At, 1, 0); PG8_STAGE(PG8_SA(0, 1), a2 + hstep, voffA);
            PG8_WAIT_L(8); PG8_BAR; PG8_WAIT_L(0); PG8_MMA(0, 0, At, B0); PG8_BAR; PG8_SCHED;
            PG8_LDB(B1, 1, 1); PG8_STAGE(PG8_SB(1, 0), b3, voffB);
            PG8_BAR; PG8_WAIT_L(0); PG8_MMA(0, 1, At, B1); PG8_BAR;
            PG8_LDA(At, 1, 1); PG8_STAGE(PG8_SA(1, 0), a3, voffA);
            PG8_BAR; PG8_WAIT_L(0); PG8_MMA(1, 0, At, B0); PG8_BAR; PG8_SCHED;
            PG8_STAGE(PG8_SB(1, 1), b3 + hstep, voffB);
            PG8_WAIT_V(6); PG8_BAR; PG8_MMA(1, 1, At, B1); PG8_BAR;
        }
        E(acc, cur, wr, wc, fr, fq);
        if (!has_next) break;
#pragma unroll
        for (int a = 0; a < 2; ++a)
#pragma unroll
            for (int b = 0; b < 2; ++b)
#pragma unroll
                for (int m = 0; m < 4; ++m)
#pragma unroll
                    for (int n = 0; n < 2; ++n) acc[a][b][m][n] = (f32x4){0.f, 0.f, 0.f, 0.f};
        cur = nxt; cA = nA; cB = nB; ++ui;
    }
    PG8_WAIT_V(0);
    if (wr == 0) PG8_BAR;
    PG8_BAR;
#undef PG8_SA
#undef PG8_SB
#undef PG8_STAGE
#undef PG8_LDA
#undef PG8_LDB
#undef PG8_MMA
#undef PG8_WAIT_V
#undef PG8_WAIT_L
#undef PG8_BAR
#undef PG8_SCHED
}
}
using pg8::Unit;

struct Args {
    const float* in[26];
    float* out; unsigned char* ws;
};
#define KAS __attribute__((address_space(4)))
__device__ __forceinline__ const KAS char* kargp() { const KAS char* p = (const KAS char*)__builtin_amdgcn_kernarg_segment_ptr(); asm volatile("" : "+s"(p)); return p; }


enum { I_XP = 0, I_XS, I_SRET, I_SRW, I_SSH, I_PP, I_PS, I_NG, I_WIN, I_MU, I_W0, I_W2, I_A0, I_A2, I_KK, I_KA, I_RK, I_LNW, I_LNB, I_WDA, I_WDB, I_WOUT, I_WPLE, I_PNG, I_WPG, I_FNG };

__device__ __forceinline__ void p0_transpose_item(const float* W, int K, int N, bf16_t* WT, LAS float* scr, int item, int lane, const float* kscale) {
    const int nblk = N / 32, kb = item / nblk, nb = item % nblk, k0 = 64 * kb, n0 = 32 * nb;
#pragma unroll 8
    for (int i = 0; i < 32; ++i) { const int kk = 2 * i + (lane >> 5); float v = W[(size_t)(k0 + kk) * N + n0 + (lane & 31)]; if (kscale) v *= kscale[k0 + kk]; scr[kk * 33 + (lane & 31)] = v; }
    LDS_WAIT();
    const int c = lane & 7;
#pragma unroll
    for (int j = 0; j < 4; ++j) { const int n = (lane >> 3) + 8 * j; const LAS float* s = scr + (8 * c) * 33 + n;
        u32x4 o; o.x = pk2(s[0 * 33], s[1 * 33]); o.y = pk2(s[2 * 33], s[3 * 33]); o.z = pk2(s[4 * 33], s[5 * 33]); o.w = pk2(s[6 * 33], s[7 * 33]);
        *(u32x4*)(WT + (size_t)(n0 + n) * K + k0 + 8 * c) = o; }
    LDS_WAIT();
}

__device__ __forceinline__ void p_row_bf16(const Args& a, int m, int lane) {
    u32x2 o = {0u, 0u};
    if (m < MR) { const float* pr = (m < MP) ? a.in[I_PP] + (size_t)m * PLE : a.in[I_PS] + (size_t)(m - MP) * PLE; const f32x4 p = ((const f32x4*)pr)[lane]; o.x = pk2(p.x, p.y); o.y = pk2(p.z, p.w); }
    ((u32x2*)(a.ws + WS_PB + (size_t)m * PLE * 2))[lane] = o;
}
__device__ __forceinline__ void phase0(const Args& a, LAS unsigned char* lds, int gw, int NGW, int wave, int lane) {
    unsigned char* ws = a.ws;
    LAS float* scr = (LAS float*)(lds + wave * 16384);
    constexpr int I_IN = (D / 64) * (NCOLS / 32), I_DA = (2048 / 64) * (D / 32), I_SQ = (D / 64) * (D / 32), I_PL = (PLE / 64) * (D / 32), I_LR = 1 * (D / 32);
    constexpr int NITEMS = I_IN + I_DA + 3 * I_SQ + I_PL + 2 * I_LR;
    const bool defer3 = NGW >= 128 * 8;
    for (int it = gw; it < NITEMS; it += NGW) {
        int r = it;
        if (defer3 && r >= I_IN && r < I_IN + I_DA + 3 * I_SQ + I_PL) continue;
        if (r < I_IN) { p0_transpose_item(a.in[I_WIN], D, NCOLS, (bf16_t*)(ws + WS_WIN), scr, r, lane, nullptr); continue; } r -= I_IN;
        if (r < I_DA) { p0_transpose_item(a.in[I_WDA], 2048, D, (bf16_t*)(ws + WS_WDA), scr, r, lane, nullptr); continue; } r -= I_DA;
        if (r < I_SQ) { p0_transpose_item(a.in[I_WDB], D, D, (bf16_t*)(ws + WS_WDB), scr, r, lane, nullptr); continue; } r -= I_SQ;
        if (r < I_SQ) { p0_transpose_item(a.in[I_WOUT], D, D, (bf16_t*)(ws + WS_WOUT), scr, r, lane, nullptr); continue; } r -= I_SQ;
        if (r < I_SQ) { p0_transpose_item(a.in[I_WPG], D, D, (bf16_t*)(ws + WS_WGATE), scr, r, lane, a.in[I_PNG]); continue; } r -= I_SQ;
        if (r < I_PL) { p0_transpose_item(a.in[I_WPLE], PLE, D, (bf16_t*)(ws + WS_WPLE), scr, r, lane, nullptr); continue; } r -= I_PL;
        if (r < I_LR) { p0_transpose_item(a.in[I_W2], 64, D, (bf16_t*)(ws + WS_W2T), scr, r, lane, nullptr); continue; } r -= I_LR;
        p0_transpose_item(a.in[I_A2], 64, D, (bf16_t*)(ws + WS_A2T), scr, r, lane, nullptr);
    }
    for (int i = gw * 64 + lane; i < 128 * D / 8; i += NGW * 64) ((u32x4*)(ws + WS_WIN + (size_t)NCOLS * D * 2))[i] = (u32x4){0u, 0u, 0u, 0u};
    bf16_t* H = (bf16_t*)(ws + WS_H);
    const float* ng = a.in[I_NG];
    for (int m = gw; m < MALL; m += NGW) {
        if (m < MR) {
            const float* xr = (m < MP) ? a.in[I_XP] + (size_t)m * D : a.in[I_XS] + (size_t)(m - MP) * D;
            f32x4 v[4]; float s = 0.f;
#pragma unroll
            for (int j = 0; j < 4; ++j) { v[j] = ((const f32x4*)xr)[lane + 64 * j]; s += (v[j].x * v[j].x + v[j].y * v[j].y) + (v[j].z * v[j].z + v[j].w * v[j].w); }
            const float rs = 1.0f / sqrtf(wave_sum(s) * (1.f / D) + EPS);
            float* so = nullptr;
            if (m < MP) { if ((m & (T - 1)) == T - 1) so = a.out + OUT_SHP + (size_t)(m >> 11) * D; } else so = a.out + OUT_SHS + (size_t)(m - MP) * D;
#pragma unroll
            for (int j = 0; j < 4; ++j) { const f32x4 gg = ((const f32x4*)ng)[lane + 64 * j]; f32x4 h = v[j] * rs * gg;
                if (so) ((f32x4*)so)[lane + 64 * j] = h;
                u32x2 o; o.x = pk2(h.x, h.y); o.y = pk2(h.z, h.w); ((u32x2*)(H + (size_t)m * D))[lane + 64 * j] = o; }
        } else {
            const float* xr = a.in[I_SSH] + (size_t)(m - MR) * D;
#pragma unroll
            for (int j = 0; j < 4; ++j) { const f32x4 h = ((const f32x4*)xr)[lane + 64 * j]; u32x2 o; o.x = pk2(h.x, h.y); o.y = pk2(h.z, h.w); ((u32x2*)(H + (size_t)m * D))[lane + 64 * j] = o; }
        }
        if (!defer3) p_row_bf16(a, m, lane);
    }
    for (int i = gw * 64 + lane; i < 2049 * 128; i += NGW * 64) {
        const int pos = i >> 7, j = i & 127; const double p = (pos == 2048) ? 16384.0 : (double)pos;
        double inv = 1.0, base = 0.9305720409296989; int e = j;
        while (e) { if (e & 1) inv *= base; base *= base; e >>= 1; }
        double rev = p * inv * 0.15915494309189535; rev -= floor(rev);
        const float fr = (float)rev;
        ((f32x2*)(ws + WS_ROPE))[i] = (f32x2){__builtin_amdgcn_cosf(fr), __builtin_amdgcn_sinf(fr)};
    }
    for (int i = gw * 64 + lane; i < 65536 + 64; i += NGW * 64) ((float*)(ws + WS_CTL))[i] = 0.f;
}

__device__ __forceinline__ void p0_late(const Args& a, LAS float* scr, int w, int nw, int lane) {
    unsigned char* ws = a.ws;
    constexpr int I_DA = (2048 / 64) * (D / 32), I_SQ = (D / 64) * (D / 32), I_PL = (PLE / 64) * (D / 32);
    for (int it = w; it < I_DA + 3 * I_SQ + I_PL; it += nw) {
        int r = it;
        if (r < I_DA) { p0_transpose_item(a.in[I_WDA], 2048, D, (bf16_t*)(ws + WS_WDA), scr, r, lane, nullptr); continue; } r -= I_DA;
        if (r < I_SQ) { p0_transpose_item(a.in[I_WDB], D, D, (bf16_t*)(ws + WS_WDB), scr, r, lane, nullptr); continue; } r -= I_SQ;
        if (r < I_SQ) { p0_transpose_item(a.in[I_WOUT], D, D, (bf16_t*)(ws + WS_WOUT), scr, r, lane, nullptr); continue; } r -= I_SQ;
        if (r < I_SQ) { p0_transpose_item(a.in[I_WPG], D, D, (bf16_t*)(ws + WS_WGATE), scr, r, lane, a.in[I_PNG]); continue; } r -= I_SQ;
        p0_transpose_item(a.in[I_WPLE], PLE, D, (bf16_t*)(ws + WS_WPLE), scr, r, lane, nullptr);
    }
}

struct EpiP {
    static constexpr bool PERM = true;
    bf16_t* P; bf16_t* KT; const f32x2* rope;
    __device__ __forceinline__ void operator()(const f32x4 (&acc)[2][2][4][2], const Unit& u, int wr, int wc, int fr, int fq) const {
        const int pn = u.pn, pm = u.pm;
        const int row0 = pm * 256 + wr * 64 + fr, cl0 = wc * 32 + 8 * fq;
        const bool sample = (pm == 64);
        if (pn < 8) {
            const int h = pn & 3; const bool isk = pn >= 4;
            const float l2g = __log2f(1.f - exp2f(-5.f - (float)h));
#pragma unroll
            for (int ai = 0; ai < 2; ++ai)
#pragma unroll
                for (int m = 0; m < 4; ++m) {
                    const int row = row0 + ai * 128 + m * 16;
                    int pos, ex;
                    if (sample) { pos = 2048; ex = isk ? 0 : 1; } else { pos = row & (T - 1); const int idx = pos & 127; ex = isk ? 127 - idx : idx + 1; }
                    const float sc = exp2f((float)ex * l2g) * (isk ? 0.0625f : 1.0f);
                    const f32x4* rp = (const f32x4*)(rope + pos * 128 + cl0);
                    f32x4 cs[4]; cs[0] = rp[0]; cs[1] = rp[1]; cs[2] = rp[2]; cs[3] = rp[3];
                    float y1[8], y2[8];
#pragma unroll
                    for (int n = 0; n < 2; ++n)
#pragma unroll
                        for (int e = 0; e < 4; ++e) {
                            const float c = (e & 1) ? cs[n * 2 + (e >> 1)].z : cs[n * 2 + (e >> 1)].x, s = (e & 1) ? cs[n * 2 + (e >> 1)].w : cs[n * 2 + (e >> 1)].y;
                            const float x1 = acc[ai][0][m][n][e], x2 = acc[ai][1][m][n][e];
                            y1[n * 4 + e] = (x1 * c - x2 * s) * sc; y2[n * 4 + e] = (x2 * c + x1 * s) * sc;
                        }
                    u32x4 w1, w2;
                    w1.x = pk2(y1[0], y1[1]); w1.y = pk2(y1[2], y1[3]); w1.z = pk2(y1[4], y1[5]); w1.w = pk2(y1[6], y1[7]);
                    w2.x = pk2(y2[0], y2[1]); w2.y = pk2(y2[2], y2[3]); w2.z = pk2(y2[4], y2[5]); w2.w = pk2(y2[6], y2[7]);
                    bf16_t* rowp = P + (size_t)row * NP + pn * 256 + cl0;
                    *(u32x4*)rowp = w1; *(u32x4*)(rowp + 128) = w2;
                    if (isk && !sample) {
                        bf16_t* kt = KT + ((size_t)((row >> 11) * 4 + h) * 256 + cl0) * T + pos;
#pragma unroll
                        for (int j = 0; j < 8; ++j) { kt[(size_t)j * T] = f2bf(y1[j]); kt[(size_t)(j + 128) * T] = f2bf(y2[j]); }
                    }
                }
            return;
        }
#pragma unroll
        for (int bj = 0; bj < 2; ++bj) {
            const int cb = pn * 2 + bj;
            if (cb >= 97) continue;
            const int mode = 0;
            const bool vt = (cb < 32) && !sample;
#pragma unroll
            for (int ai = 0; ai < 2; ++ai)
#pragma unroll
                for (int m = 0; m < 4; ++m) {
                    const int row = row0 + ai * 128 + m * 16;
                    float y[8];
#pragma unroll
                    for (int n = 0; n < 2; ++n)
#pragma unroll
                        for (int e = 0; e < 4; ++e) { float x = acc[ai][bj][m][n][e]; if (mode == 1) x = x * sigm(x); else if (mode == 2) x = sigm(x); y[n * 4 + e] = x; }
                    if (vt) {
                        const int hd = cb * 128 + cl0 - O_V;
                        bf16_t* vp = P + ((size_t)(row >> 11) * T + hd) * NP + O_V + (row & (T - 1));
#pragma unroll
                        for (int j = 0; j < 8; ++j) vp[(size_t)j * NP] = f2bf(y[j]);
                    } else {
                        u32x4 w; w.x = pk2(y[0], y[1]); w.y = pk2(y[2], y[3]); w.z = pk2(y[4], y[5]); w.w = pk2(y[6], y[7]);
                        *(u32x4*)(P + (size_t)row * NP + cb * 128 + cl0) = w;
                    }
                }
        }
    }
};

__device__ __forceinline__ float lerp_bf(const bf16_t* cur, const bf16_t* prv, float mu) { const float c = bf2f(*cur); const float p = bf2f(*prv); return c + (p - c) * mu; }

__device__ __forceinline__ void rw_prep_item(const Args& a, LAS unsigned char* wl  , int tt, int h, int lane) {
    unsigned char* ws = a.ws;
    const bf16_t* P = (const bf16_t*)(ws + WS_P);
    const int l15 = lane & 15, quad = lane >> 4;
    const bool sample = tt >= 1024;
    const int row_base = sample ? MP + (tt - 1024) * 16 : tt * 16;
    const float* mu = a.in[I_MU];
    bf16x8 Aw[2], Aa[2];
    {
        const int m = row_base + l15;
        const bf16_t* cur = P + (size_t)m * NP + O_SH;
        const bf16_t* zrow = (const bf16_t*)(ws + WS_WIN + (size_t)NCOLS * D * 2);
        const bf16_t* prv = sample ? P + (size_t)(m + MS) * NP + O_SH : ((m & (T - 1)) ? cur - NP : zrow + O_SH);
#pragma unroll
        for (int which = 0; which < 2; ++which)
#pragma unroll
            for (int ks = 0; ks < 2; ++ks) {
                const int col = 3072 + which * 64 + ks * 32 + quad * 8;
                const u32x4 cw = *(const u32x4*)(cur + col); const u32x4 pw = *(const u32x4*)(prv + col);
                const f32x4 m0 = *(const f32x4*)(mu + col), m1 = *(const f32x4*)(mu + col + 4);
                float z[8];
                const unsigned cws[4] = {cw.x, cw.y, cw.z, cw.w}, pws[4] = {pw.x, pw.y, pw.z, pw.w};
#pragma unroll
                for (int j = 0; j < 4; ++j) {
                    const float c0 = bflo(cws[j]), c1 = bfhi(cws[j]), p0 = bflo(pws[j]), p1 = bfhi(pws[j]);
                    const float mm0 = (j < 2) ? m0[2 * j] : m1[2 * j - 4], mm1 = (j < 2) ? m0[2 * j + 1] : m1[2 * j - 3];
                    z[2 * j] = c0 + (p0 - c0) * mm0; z[2 * j + 1] = c1 + (p1 - c1) * mm1;
                }
                if (which == 0) {
#pragma unroll
                    for (int j = 0; j < 8; ++j) z[j] = 1.f - 2.f / (__expf(2.f * z[j]) + 1.f);
                }
                u32x4 o; o.x = pk2(z[0], z[1]); o.y = pk2(z[2], z[3]); o.z = pk2(z[4], z[5]); o.w = pk2(z[6], z[7]);
                if (which == 0) Aw[ks] = __builtin_bit_cast(bf16x8, o); else Aa[ks] = __builtin_bit_cast(bf16x8, o);
            }
    }
    const bf16_t* W2T = (const bf16_t*)(ws + WS_W2T); const bf16_t* A2T = (const bf16_t*)(ws + WS_A2T);
    unsigned char* rec = ws + WS_CH + ((size_t)((tt >> 7) * 16 + h) * 128 + (tt & 127)) * REC;
    LAS bf16_t* LA = (LAS bf16_t*)wl;
    LAS bf16_t* LR = LA + 16 * 72;
    LAS bf16_t* LB = LR + 16 * 72;
    LAS bf16_t* LK = LB + 16 * 72;
    LAS float* LN = (LAS float*)(wl + 9216);
    float tA[4][4], tBi[4][4], tBp[4][4];
    float ssq[4] = {0.f, 0.f, 0.f, 0.f}, bon[4] = {0.f, 0.f, 0.f, 0.f};
#pragma unroll
    for (int nt = 0; nt < 4; ++nt) {
        const int ch = h * 64 + nt * 16 + l15, cc = nt * 16 + l15;
        f32x4 cw = {0.f, 0.f, 0.f, 0.f}, ca = {0.f, 0.f, 0.f, 0.f};
#pragma unroll
        for (int ks = 0; ks < 2; ++ks) {
            const bf16x8 bw = *(const bf16x8*)(W2T + (size_t)ch * 64 + ks * 32 + quad * 8), ba = *(const bf16x8*)(A2T + (size_t)ch * 64 + ks * 32 + quad * 8);
            cw = MFMA32(Aw[ks], bw, cw); ca = MFMA32(Aa[ks], ba, ca);
        }
        const float w0 = a.in[I_W0][ch], a0 = a.in[I_A0][ch], k_k = a.in[I_KK][ch], k_a = a.in[I_KA][ch], r_k = a.in[I_RK][ch];
        const float mur = mu[ch], muk = mu[1024 + ch], muv = mu[2048 + ch];
        float lw[4], rr[4], kq[4], vv[4], aa4[4], kr4[4];
#pragma unroll
        for (int r = 0; r < 4; ++r) {
            const int m = row_base + quad * 4 + r;
            const bf16_t* cur = P + (size_t)m * NP + O_SH + ch;
            const bf16_t* prv = sample ? P + (size_t)(m + MS) * NP + O_SH + ch : ((m & (T - 1)) ? cur - NP : (const bf16_t*)(ws + WS_WIN + (size_t)NCOLS * D * 2) + O_SH + ch);
            const float r_ = lerp_bf(cur, prv, mur), k_ = lerp_bf(cur + 1024, prv + 1024, muk), v_ = lerp_bf(cur + 2048, prv + 2048, muv);
            lw[r] = -0.6065306597126334f * sigm(w0 + cw[r]);
            const float aa = sigm(a0 + ca[r]); aa4[r] = aa;
            const float kr = k_ * k_k; kr4[r] = kr; ssq[r] += kr * kr;
            const float kpp = k_ * (1.f + (aa - 1.f) * k_a); kq[r] = kpp;
            rr[r] = r_; vv[r] = v_; bon[r] += r_ * kpp * r_k;
        }
        if (sample) {
#pragma unroll
            for (int r = 0; r < 4; ++r) {
                const int i = (tt - 1024) * 16 + quad * 4 + r;
                float* o = (float*)(ws + WS_OPSS) + ((size_t)(i * 16 + h) * 6) * 64 + cc;
                o[0] = rr[r]; o[64] = __expf(lw[r]); o[128] = kq[r]; o[320] = vv[r];
                tA[nt][r] = kr4[r]; tBi[nt][r] = aa4[r] * kr4[r]; tBp[nt][r] = 0.f;
            }
        } else {
            float c[4]; c[0] = lw[0]; c[1] = c[0] + lw[1]; c[2] = c[1] + lw[2]; c[3] = c[2] + lw[3];
            const float tot = c[3];
            const float s1 = __shfl(tot, (lane - 16) & 63), s2 = __shfl(tot, (lane - 32) & 63), s3 = __shfl(tot, (lane - 48) & 63);
            const float off = (quad >= 1 ? s1 : 0.f) + (quad >= 2 ? s2 : 0.f) + (quad >= 3 ? s3 : 0.f);
            const float total = __shfl(c[3] + off, 48 + l15);
            float kqp[4];
#pragma unroll
            for (int r = 0; r < 4; ++r) {
                const float cum = c[r] + off, cumx = cum - lw[r];
                const float ea = __expf(cumx), er = __expf(cum), ei = __expf(-cum), ep = __expf(total - cum);
                const int tk = quad * 4 + r;
                LR[tk * 72 + cc] = f2bf(rr[r] * er); LK[tk * 72 + cc] = f2bf(kq[r] * ei);
                kqp[r] = kq[r] * ep;
                tA[nt][r] = kr4[r] * ea; tBi[nt][r] = aa4[r] * kr4[r] * ei; tBp[nt][r] = aa4[r] * kr4[r] * ep;
            }
            *(u32x2*)(rec + R_KP + cc * 32 + quad * 8) = (u32x2){pk2(kqp[0], kqp[1]), pk2(kqp[2], kqp[3])};
            *(u32x2*)(rec + R_VT + cc * 32 + quad * 8) = (u32x2){pk2(vv[0], vv[1]), pk2(vv[2], vv[3])};
            if (quad == 0) *(float*)(rec + R_WC + cc * 4) = __expf(total);
        }
        asm volatile("" ::: "memory");
    }
    float inv[4];
#pragma unroll
    for (int r = 0; r < 4; ++r) {
        float s = ssq[r], b = bon[r];
#pragma unroll
        for (int o = 1; o < 16; o <<= 1) { s += __shfl_xor(s, o); b += __shfl_xor(b, o); }
        inv[r] = 1.f / fmaxf(sqrtf(s), 1e-12f);
        if (l15 == 0) ((float*)(ws + WS_BC))[(size_t)(row_base + quad * 4 + r) * 16 + h] = b;
    }
    if (sample) {
#pragma unroll
        for (int nt = 0; nt < 4; ++nt)
#pragma unroll
            for (int r = 0; r < 4; ++r) {
                const int i = (tt - 1024) * 16 + quad * 4 + r;
                float* o = (float*)(ws + WS_OPSS) + ((size_t)(i * 16 + h) * 6) * 64 + nt * 16 + l15;
                o[192] = tA[nt][r] * inv[r]; o[256] = tBi[nt][r] * inv[r];
            }
        return;
    }
#pragma unroll
    for (int nt = 0; nt < 4; ++nt) {
        const int cc = nt * 16 + l15;
        float bp[4];
#pragma unroll
        for (int r = 0; r < 4; ++r) { const int tk = quad * 4 + r;
            LA[tk * 72 + cc] = f2bf(-tA[nt][r] * inv[r]); LB[tk * 72 + cc] = f2bf(tBi[nt][r] * inv[r]); bp[r] = tBp[nt][r] * inv[r]; }
        *(u32x2*)(rec + R_BP + cc * 32 + quad * 8) = (u32x2){pk2(bp[0], bp[1]), pk2(bp[2], bp[3])};
    }
    LDS_WAIT();
#pragma unroll
    for (int i = 0; i < 2; ++i) { const int idx = lane + 64 * i, rr = idx >> 3, c8 = (idx & 7) * 8;
        *(u32x4*)(rec + R_AT + rr * 128 + c8 * 2) = *(const LAS u32x4*)(LA + rr * 72 + c8);
        *(u32x4*)(rec + R_RT + rr * 128 + c8 * 2) = *(const LAS u32x4*)(LR + rr * 72 + c8); }
    f32x4 nab = {0.f, 0.f, 0.f, 0.f}, nak = nab, nrb = nab, nrk = nab;
#pragma unroll
    for (int ks = 0; ks < 2; ++ks) {
        const bf16x8 fa = *(const LAS bf16x8*)(LA + l15 * 72 + ks * 32 + quad * 8), fr_ = *(const LAS bf16x8*)(LR + l15 * 72 + ks * 32 + quad * 8);
        const bf16x8 fb = *(const LAS bf16x8*)(LB + l15 * 72 + ks * 32 + quad * 8), fk = *(const LAS bf16x8*)(LK + l15 * 72 + ks * 32 + quad * 8);
        nab = MFMA32(fa, fb, nab); nak = MFMA32(fa, fk, nak); nrb = MFMA32(fr_, fb, nrb); nrk = MFMA32(fr_, fk, nrk);
    }
#pragma unroll
    for (int r = 0; r < 4; ++r) {
        const int t = quad * 4 + r, j = l15;
        const float vab = (j < t) ? nab[r] : 0.f, vak = (j < t) ? nak[r] : 0.f, vrb = (j <= t) ? nrb[r] : 0.f, vrk = (j <= t) ? nrk[r] : 0.f;
        LN[t * 16 + j] = vab;
        *(bf16_t*)(rec + R_AAK + (t * 16 + j) * 2) = f2bf(vak);
        *(bf16_t*)(rec + R_ARB + (t * 16 + j) * 2) = f2bf(vrb);
        *(bf16_t*)(rec + R_ARK + (t * 16 + j) * 2) = f2bf(vrk);
    }
    LDS_WAIT();
    if (lane < 16) {
        float tc[16];
#pragma unroll
        for (int t = 0; t < 16; ++t) {
            float s = (t == lane) ? 1.f : 0.f;
#pragma unroll
            for (int j = 0; j < t; ++j) s += LN[t * 16 + j] * tc[j];
            tc[t] = s;
            *(bf16_t*)(rec + R_TT + (t * 16 + lane) * 2) = f2bf(s);
        }
    }
    LDS_WAIT();
}

__device__ __forceinline__ bf16x8 k16(u32x2 v) { const u32x4 w = {v.x, v.y, 0u, 0u}; return __builtin_bit_cast(bf16x8, w); }
#define SCAN_DECL(F) bf16x8 F##_at0, F##_at1, F##_rt0, F##_rt1; u32x2 F##_aak, F##_tt, F##_arb, F##_ark, F##_vt, F##_bp0, F##_bp1, F##_bp2, F##_bp3, F##_kp0, F##_kp1, F##_kp2, F##_kp3; float F##_wc0, F##_wc1, F##_wc2, F##_wc3
#define SCAN_LOAD(F, REC_) do { const unsigned char* rec_ = (REC_); \
    F##_at0 = *(const bf16x8*)(rec_ + R_AT + o_nat); F##_at1 = *(const bf16x8*)(rec_ + R_AT + o_nat + 64); \
    F##_rt0 = *(const bf16x8*)(rec_ + R_RT + o_nat); F##_rt1 = *(const bf16x8*)(rec_ + R_RT + o_nat + 64); \
    F##_aak = *(const u32x2*)(rec_ + R_AAK + o_sm); F##_tt = *(const u32x2*)(rec_ + R_TT + o_sm); F##_arb = *(const u32x2*)(rec_ + R_ARB + o_sm); F##_ark = *(const u32x2*)(rec_ + R_ARK + o_sm); \
    F##_vt = *(const u32x2*)(rec_ + R_VT + vt * 512 + o_sm); \
    F##_bp0 = *(const u32x2*)(rec_ + R_BP + o_sm); F##_bp1 = *(const u32x2*)(rec_ + R_BP + 512 + o_sm); F##_bp2 = *(const u32x2*)(rec_ + R_BP + 1024 + o_sm); F##_bp3 = *(const u32x2*)(rec_ + R_BP + 1536 + o_sm); \
    F##_kp0 = *(const u32x2*)(rec_ + R_KP + o_sm); F##_kp1 = *(const u32x2*)(rec_ + R_KP + 512 + o_sm); F##_kp2 = *(const u32x2*)(rec_ + R_KP + 1024 + o_sm); F##_kp3 = *(const u32x2*)(rec_ + R_KP + 1536 + o_sm); \
    F##_wc0 = *(const float*)(rec_ + R_WC + l15 * 4); F##_wc1 = *(const float*)(rec_ + R_WC + 64 + l15 * 4); F##_wc2 = *(const float*)(rec_ + R_WC + 128 + l15 * 4); F##_wc3 = *(const float*)(rec_ + R_WC + 192 + l15 * 4); } while (0)
#define SCAN_UPD(NT, BP, KP, WC) do { f32x4 sn = S##NT * (WC); sn = MFMA32(ua, k16(BP), sn); sn = MFMA32(vtf, k16(KP), sn); S##NT = sn; \
    _Pragma("unroll") for (int r = 0; r < 4; ++r) Sb[(quad * 4 + r) * 72 + NT * 16 + l15] = f2bf(sn[r]); } while (0)
#define SCAN_STEP(F, N, CH) do { const int ch_ = (CH); \
    SCAN_LOAD(N, rec0 + (size_t)(ch_ < 126 ? ch_ + 2 : 127) * REC); \
    const bf16x8 sa0 = *(const LAS bf16x8*)(Sb + l15 * 72 + quad * 8), sa1 = *(const LAS bf16x8*)(Sb + l15 * 72 + 32 + quad * 8); \
    const bf16x8 vtf = k16(F##_vt); const f32x4 z = {0.f, 0.f, 0.f, 0.f}; \
    f32x4 Y = MFMA32(sa0, F##_at0, z); Y = MFMA32(sa1, F##_at1, Y); Y = MFMA32(vtf, k16(F##_aak), Y); \
    _Pragma("unroll") for (int r = 0; r < 4; ++r) Yb[(quad * 4 + r) * 16 + l15] = f2bf(Y[r]); \
    LDS_WAIT(); \
    const bf16x8 ya = k16(*(const LAS u32x2*)(Yb + l15 * 16 + quad * 4)); \
    f32x4 U = MFMA32(ya, k16(F##_tt), z); \
    _Pragma("unroll") for (int r = 0; r < 4; ++r) Ub[(quad * 4 + r) * 16 + l15] = f2bf(U[r]); \
    LDS_WAIT(); \
    const bf16x8 ua = k16(*(const LAS u32x2*)(Ub + l15 * 16 + quad * 4)); \
    f32x4 O = MFMA32(sa0, F##_rt0, z); O = MFMA32(sa1, F##_rt1, O); O = MFMA32(ua, k16(F##_arb), O); O = MFMA32(vtf, k16(F##_ark), O); \
    *(u32x2*)(ob + (size_t)(ch_ * 16 + l15) * D) = (u32x2){pk2(O[0], O[1]), pk2(O[2], O[3])}; \
    SCAN_UPD(0, F##_bp0, F##_kp0, F##_wc0); SCAN_UPD(1, F##_bp1, F##_kp1, F##_wc1); SCAN_UPD(2, F##_bp2, F##_kp2, F##_wc2); SCAN_UPD(3, F##_bp3, F##_kp3, F##_wc3); \
    LDS_WAIT(); __builtin_amdgcn_sched_barrier(0); } while (0)
__device__ __forceinline__ void rw_scan_task(const Args& a, LAS unsigned char* wl  , int b, int h, int vt, int lane) {
    unsigned char* ws = a.ws;
    const int l15 = lane & 15, quad = lane >> 4;
    LAS bf16_t* Sb = (LAS bf16_t*)wl;
    LAS bf16_t* Yb = (LAS bf16_t*)(wl + 2304);
    LAS bf16_t* Ub = (LAS bf16_t*)(wl + 2304 + 512);
    const int o_nat = l15 * 128 + quad * 16, o_sm = l15 * 32 + quad * 8;
    const unsigned char* rec0 = ws + WS_CH + (size_t)((b * 16 + h) * 128) * REC;
    bf16_t* ob = (bf16_t*)(ws + WS_OB) + (size_t)(b * T) * D + h * 64 + vt * 16 + quad * 4;
    f32x4 S0 = {0.f, 0.f, 0.f, 0.f}, S1 = S0, S2 = S0, S3 = S0;
#pragma unroll
    for (int nt = 0; nt < 4; ++nt)
#pragma unroll
        for (int r = 0; r < 4; ++r) Sb[(quad * 4 + r) * 72 + nt * 16 + l15] = 0;
    LDS_WAIT();
    SCAN_DECL(f0); SCAN_DECL(f1); SCAN_DECL(f2);
    SCAN_LOAD(f0, rec0); SCAN_LOAD(f1, rec0 + REC);
    for (int ch = 0; ch < 126; ch += 3) { SCAN_STEP(f0, f2, ch); SCAN_STEP(f1, f0, ch + 1); SCAN_STEP(f2, f1, ch + 2); }
    SCAN_STEP(f0, f2, 126); SCAN_STEP(f1, f0, 127);
    float* so = a.out + OUT_RWP + (size_t)((b * 16 + h) * 64 + vt * 16) * 64;
#pragma unroll
    for (int r = 0; r < 4; ++r) { so[(quad * 4 + r) * 64 + l15] = S0[r]; so[(quad * 4 + r) * 64 + 16 + l15] = S1[r]; so[(quad * 4 + r) * 64 + 32 + l15] = S2[r]; so[(quad * 4 + r) * 64 + 48 + l15] = S3[r]; }
}

__device__ __forceinline__ void rw_sample_wave(const Args& a, int i, int h, int lane) {
    unsigned char* ws = a.ws;
    const float* s0 = a.in[I_SRW] + ((size_t)(i * 16 + h) * 64 + lane) * 64;
    const float* op = (const float*)(ws + WS_OPSS) + (size_t)(i * 16 + h) * 6 * 64;
    float s[64];
#pragma unroll
    for (int j = 0; j < 16; ++j) { const f32x4 t = ((const f32x4*)s0)[j]; s[4 * j] = t.x; s[4 * j + 1] = t.y; s[4 * j + 2] = t.z; s[4 * j + 3] = t.w; }
    const float r_l = op[lane], w_l = op[64 + lane], k_l = op[128 + lane], kk_l = op[192 + lane], b_l = op[256 + lane], v = op[320 + lane];
#define RL(x, j) __builtin_bit_cast(float, __builtin_amdgcn_readlane(__builtin_bit_cast(int, (x)), (j)))
    float sk = 0.f;
#pragma unroll
    for (int j = 0; j < 64; ++j) sk += s[j] * RL(kk_l, j);
    float o = 0.f;
#pragma unroll
    for (int j = 0; j < 64; ++j) { s[j] = s[j] * RL(w_l, j) - sk * RL(b_l, j) + v * RL(k_l, j); o += s[j] * RL(r_l, j); }
#undef RL
    float* so = a.out + OUT_RWS + ((size_t)(i * 16 + h) * 64 + lane) * 64;
#pragma unroll
    for (int j = 0; j < 16; ++j) ((f32x4*)so)[j] = (f32x4){s[4 * j], s[4 * j + 1], s[4 * j + 2], s[4 * j + 3]};
    ((bf16_t*)(ws + WS_OB))[(size_t)(MP + i) * D + h * 64 + lane] = f2bf(o);
}

constexpr int KN_LD = 264, VS_LD = 136, SS_LD = 264;
constexpr int L_KN = 0, L_VS = 128 * KN_LD * 2  , L_SS = L_VS + 64 * VS_LD * 2  , L_RET_END = L_SS + 64 * SS_LD * 2  ;
__device__ __forceinline__ void ret_unit(const Args& a, LAS unsigned char* lds, int unit, int tid) {
    unsigned char* ws = a.ws;
    const bf16_t* P = (const bf16_t*)(ws + WS_P);
    const int dvs = unit & 7, h = (unit >> 3) & 3, b = unit >> 5;
    const int wave = tid >> 6, lane = tid & 63, l15 = lane & 15, quad = lane >> 4;
    LAS bf16_t* KN = (LAS bf16_t*)(lds + L_KN); LAS bf16_t* VS = (LAS bf16_t*)(lds + L_VS); LAS bf16_t* SS = (LAS bf16_t*)(lds + L_SS);
    const float g = 1.f - exp2f(-5.f - (float)h), l2g = __log2f(g);
    const float gC = exp2f(128.f * l2g), ginvC = exp2f(-128.f * l2g);
    const bf16_t* KT = (const bf16_t*)(ws + WS_KT) + (size_t)(b * 4 + h) * 256 * T;
    f32x4 sacc[2][4];
#pragma unroll
    for (int n = 0; n < 2; ++n)
#pragma unroll
        for (int d = 0; d < 4; ++d) sacc[n][d] = (f32x4){0.f, 0.f, 0.f, 0.f};
    for (int i = tid; i < 64 * SS_LD / 2; i += 512) ((LAS unsigned*)SS)[i] = 0u;
    const int it = wave;
    u32x4 stk[8], stv[2];
#define RET_ISSUE(CC) do { const int tok0_ = b * T + (CC) * 128; \
        _Pragma("unroll") for (int i = 0; i < 8; ++i) { const int idx = tid + 512 * i, r = idx >> 5, c8 = (idx & 31) * 8; stk[i] = *(const u32x4*)(P + (size_t)(tok0_ + r) * NP + O_K + h * 256 + c8); } \
        _Pragma("unroll") for (int i = 0; i < 2; ++i) { const int idx = tid + 512 * i, r = idx >> 4, c8 = (idx & 15) * 8; stv[i] = *(const u32x4*)(P + (size_t)(b * T + h * 512 + dvs * 64 + r) * NP + O_V + (CC) * 128 + c8); } } while (0)
    bf16x8 qf[8];
#define RET_ISSUE_Q(CC) do { const int tokq_ = b * T + (CC) * 128 + it * 16 + l15; \
        _Pragma("unroll") for (int ks = 0; ks < 8; ++ks) qf[ks] = *(const bf16x8*)(P + (size_t)tokq_ * NP + h * 256 + ks * 32 + quad * 8); } while (0)
    RET_ISSUE(0); RET_ISSUE_Q(0);
    for (int c = 0; c < 16; ++c) {
        const int tok0 = b * T + c * 128;
#pragma unroll
        for (int i = 0; i < 8; ++i) { const int idx = tid + 512 * i, r = idx >> 5, c8 = (idx & 31) * 8; *(LAS u32x4*)(KN + r * KN_LD + c8) = stk[i]; }
#pragma unroll
        for (int i = 0; i < 2; ++i) { const int idx = tid + 512 * i, r = idx >> 4, c8 = (idx & 15) * 8; *(LAS u32x4*)(VS + r * VS_LD + c8) = stv[i]; }
        __syncthreads();
        bf16x8 ktf[2][4];
#pragma unroll
        for (int n = 0; n < 2; ++n)
#pragma unroll
            for (int ks = 0; ks < 4; ++ks) ktf[n][ks] = *(const bf16x8*)(KT + (size_t)((2 * wave + n) * 16 + l15) * T + c * 128 + ks * 32 + quad * 8);
        if (c < 15) RET_ISSUE(c + 1);
        f32x4 oacc[4];
#pragma unroll
        for (int d = 0; d < 4; ++d) oacc[d] = (f32x4){0.f, 0.f, 0.f, 0.f};
#pragma unroll
        for (int ks = 0; ks < 8; ++ks)
#pragma unroll
            for (int d = 0; d < 4; ++d) { const bf16x8 sb = *(const LAS bf16x8*)(SS + (d * 16 + l15) * SS_LD + ks * 32 + quad * 8); oacc[d] = MFMA32(qf[ks], sb, oacc[d]); }
#pragma unroll
        for (int p = 0; p < 4; ++p) {
            if (2 * p <= it) {
                f32x4 s0 = {0.f, 0.f, 0.f, 0.f}, s1 = {0.f, 0.f, 0.f, 0.f};
#pragma unroll
                for (int ks = 0; ks < 8; ++ks) { const bf16x8 ka = *(const LAS bf16x8*)(KN + ((2 * p) * 16 + l15) * KN_LD + ks * 32 + quad * 8); s0 = MFMA32(ka, qf[ks], s0); }
                if (2 * p + 1 <= it) {
#pragma unroll
                    for (int ks = 0; ks < 8; ++ks) { const bf16x8 ka = *(const LAS bf16x8*)(KN + ((2 * p + 1) * 16 + l15) * KN_LD + ks * 32 + quad * 8); s1 = MFMA32(ka, qf[ks], s1); }
                }
#pragma unroll
                for (int r = 0; r < 4; ++r) {
                    const int jl = quad * 4 + r;
                    s0[r] = (2 * p == it && jl > l15) ? 0.f : s0[r] * ginvC;
                    s1[r] = (2 * p + 1 > it || (2 * p + 1 == it && jl > l15)) ? 0.f : s1[r] * ginvC;
                }
                u32x4 aw; aw.x = pk2(s0[0], s0[1]); aw.y = pk2(s0[2], s0[3]); aw.z = pk2(s1[0], s1[1]); aw.w = pk2(s1[2], s1[3]);
                const bf16x8 af = __builtin_bit_cast(bf16x8, aw);
#pragma unroll
                for (int d = 0; d < 4; ++d) {
                    const LAS bf16_t* vr = VS + (d * 16 + l15) * VS_LD + 32 * p + quad * 4;
                    const u32x2 lo = *(const LAS u32x2*)vr, hi = *(const LAS u32x2*)(vr + 16);
                    const u32x4 bw = {lo.x, lo.y, hi.x, hi.y};
                    oacc[d] = MFMA32(af, __builtin_bit_cast(bf16x8, bw), oacc[d]);
                }
            }
        }
        if (c < 15) RET_ISSUE_Q(c + 1);
        {
            bf16_t* OA = (bf16_t*)(ws + WS_OA); float* SQA = (float*)(ws + WS_SQA);
#pragma unroll
            for (int r = 0; r < 4; ++r) {
                const int tok = tok0 + it * 16 + quad * 4 + r;
                float ss = 0.f;
#pragma unroll
                for (int d = 0; d < 4; ++d) { const float v = oacc[d][r]; ss += v * v; OA[(size_t)tok * 2048 + h * 512 + dvs * 64 + d * 16 + l15] = f2bf(v); }
#pragma unroll
                for (int o = 1; o < 16; o <<= 1) ss += __shfl_xor(ss, o);
                if (l15 == 0) SQA[(size_t)tok * 32 + h * 8 + dvs] = ss;
            }
        }
        __syncthreads();
#pragma unroll
        for (int n = 0; n < 2; ++n)
#pragma unroll
            for (int d = 0; d < 4; ++d) {
                f32x4 s = sacc[n][d] * gC;
#pragma unroll
                for (int ks = 0; ks < 4; ++ks) { const bf16x8 va = *(const LAS bf16x8*)(VS + (d * 16 + l15) * VS_LD + ks * 32 + quad * 8); s = MFMA32(va, ktf[n][ks], s); }
                sacc[n][d] = s;
#pragma unroll
                for (int r = 0; r < 4; ++r) SS[(d * 16 + quad * 4 + r) * SS_LD + (2 * wave + n) * 16 + l15] = f2bf(s[r]);
            }
        __syncthreads();
    }
    float* so = a.out + OUT_RETP + (size_t)(b * 4 + h) * 256 * 512;
#pragma unroll
    for (int n = 0; n < 2; ++n)
#pragma unroll
        for (int d = 0; d < 4; ++d) *(f32x4*)(so + (size_t)((2 * wave + n) * 16 + l15) * 512 + dvs * 64 + d * 16 + quad * 4) = sacc[n][d];
}
#undef RET_ISSUE
#undef RET_ISSUE_Q

__device__ __forceinline__ void ret_sample_unit(const Args& a, LAS unsigned char* lds, int i, int h, int tid) {
    unsigned char* ws = a.ws;
    const bf16_t* Prow = (const bf16_t*)(ws + WS_P) + (size_t)(MP + i) * NP;
    LAS float* Q = (LAS float*)lds; LAS float* Kh = Q + 256; LAS float* RED = Kh + 256; LAS float* OS = RED + 16;
    const float g = 1.f - exp2f(-5.f - (float)h);
    const int lane = tid & 63, wave = tid >> 6;
    float qk = 0.f;
    if (tid < 256) { const float q = bf2f(Prow[h * 256 + tid]), k = bf2f(Prow[O_K + h * 256 + tid]); Q[tid] = q; Kh[tid] = k; qk = q * k; }
    qk = wave_sum(qk);
    if (lane == 0) RED[wave] = qk;
    __syncthreads();
    const float qkv = (RED[0] + RED[1] + RED[2] + RED[3]) / g;
    const int dkg = tid >> 7, dv4 = 4 * (tid & 127);
    const u32x2 vw = *(const u32x2*)(Prow + O_V + h * 512 + dv4);
    const f32x4 v = {bflo(vw.x), bfhi(vw.x), bflo(vw.y), bfhi(vw.y)};
    const float* s0 = a.in[I_SRET] + (size_t)(i * 4 + h) * 256 * 512 + dv4;
    float* s1 = a.out + OUT_RETS + (size_t)(i * 4 + h) * 256 * 512 + dv4;
    f32x4 o = {0.f, 0.f, 0.f, 0.f};
#pragma unroll 8
    for (int j = 0; j < 64; ++j) {
        const int dk = dkg * 64 + j;
        const f32x4 s = __builtin_nontemporal_load((const f32x4*)(s0 + (size_t)dk * 512));
        o += s * Q[dk];
        __builtin_nontemporal_store(s * g + v * Kh[dk], (f32x4*)(s1 + (size_t)dk * 512));
    }
    *(LAS f32x4*)(OS + dkg * 512 + dv4) = o;
    __syncthreads();
    float y[4] = {0.f, 0.f, 0.f, 0.f}; float ss = 0.f;
    if (tid < 128) {
        const f32x4 t = *(LAS f32x4*)(OS + dv4) + *(LAS f32x4*)(OS + 512 + dv4) + *(LAS f32x4*)(OS + 1024 + dv4) + *(LAS f32x4*)(OS + 1536 + dv4) + v * qkv;
        y[0] = t.x; y[1] = t.y; y[2] = t.z; y[3] = t.w; ss = t.x * t.x + t.y * t.y + t.z * t.z + t.w * t.w;
    }
    ss = wave_sum(ss);
    if (lane == 0) RED[8 + wave] = ss;
    __syncthreads();
    if (tid < 128) {
        const float rs = 1.0f / sqrtf((RED[8] + RED[9]) * (1.f / 512.f) + EPS);
        const u32x2 gw = *(const u32x2*)(Prow + O_GA + h * 512 + dv4);
        u32x2 ow; ow.x = pk2(y[0] * rs * silu_(bflo(gw.x)), y[1] * rs * silu_(bfhi(gw.x))); ow.y = pk2(y[2] * rs * silu_(bflo(gw.y)), y[3] * rs * silu_(bfhi(gw.y)));
        *(u32x2*)((bf16_t*)(ws + WS_OA) + (size_t)(MP + i) * 2048 + h * 512 + dv4) = ow;
    }
    __syncthreads();
}

__device__ __forceinline__ void ret_sample_wave(const Args& a, int i, int h, int lane) {
    unsigned char* ws = a.ws;
    const bf16_t* Prow = (const bf16_t*)(ws + WS_P) + (size_t)(MP + i) * NP;
    const float g = 1.f - exp2f(-5.f - (float)h);
    float q[4], k[4]; float qk = 0.f;
#pragma unroll
    for (int j = 0; j < 4; ++j) { q[j] = bf2f(Prow[h * 256 + 64 * j + lane]); k[j] = bf2f(Prow[O_K + h * 256 + 64 * j + lane]); qk += q[j] * k[j]; }
    const float qkv = wave_sum(qk) / g;
    f32x4 v[2];
#pragma unroll
    for (int e = 0; e < 2; ++e) { const u32x2 vw = *(const u32x2*)(Prow + O_V + h * 512 + e * 256 + lane * 4); v[e] = (f32x4){bflo(vw.x), bfhi(vw.x), bflo(vw.y), bfhi(vw.y)}; }
    const float* s0 = a.in[I_SRET] + (size_t)(i * 4 + h) * 256 * 512 + lane * 4;
    float* s1 = a.out + OUT_RETS + (size_t)(i * 4 + h) * 256 * 512 + lane * 4;
    f32x4 o[2] = {{0.f, 0.f, 0.f, 0.f}, {0.f, 0.f, 0.f, 0.f}};
#pragma unroll
    for (int j = 0; j < 4; ++j) {
        for (int d0 = 0; d0 < 64; d0 += 16) {
            f32x4 sv[16][2];
#pragma unroll
            for (int d = 0; d < 16; ++d)
#pragma unroll
                for (int e = 0; e < 2; ++e) sv[d][e] = __builtin_nontemporal_load((const f32x4*)(s0 + (size_t)(64 * j + d0 + d) * 512 + e * 256));
#pragma unroll
            for (int d = 0; d < 16; ++d) {
                const float qd = __builtin_bit_cast(float, __builtin_amdgcn_readlane(__builtin_bit_cast(int, q[j]), d0 + d));
                const float kd = __builtin_bit_cast(float, __builtin_amdgcn_readlane(__builtin_bit_cast(int, k[j]), d0 + d));
#pragma unroll
                for (int e = 0; e < 2; ++e) { o[e] += sv[d][e] * qd; __builtin_nontemporal_store(sv[d][e] * g + v[e] * kd, (f32x4*)(s1 + (size_t)(64 * j + d0 + d) * 512 + e * 256)); }
            }
        }
    }
    float ss = 0.f;
#pragma unroll
    for (int e = 0; e < 2; ++e) { o[e] += v[e] * qkv; ss += (o[e].x * o[e].x + o[e].y * o[e].y) + (o[e].z * o[e].z + o[e].w * o[e].w); }
    const float rs = 1.0f / sqrtf(wave_sum(ss) * (1.f / 512.f) + EPS);
#pragma unroll
    for (int e = 0; e < 2; ++e) { const u32x2 gw = *(const u32x2*)(Prow + O_GA + h * 512 + e * 256 + lane * 4);
        u32x2 ow; ow.x = pk2(o[e].x * rs * silu_(bflo(gw.x)), o[e].y * rs * silu_(bfhi(gw.x))); ow.y = pk2(o[e].z * rs * silu_(bflo(gw.y)), o[e].w * rs * silu_(bfhi(gw.y)));
        *(u32x2*)((bf16_t*)(ws + WS_OA) + (size_t)(MP + i) * 2048 + h * 512 + e * 256 + lane * 4) = ow; }
}

__device__ __forceinline__ void phase25_row(const Args& a, int m, int lane) {
    unsigned char* ws = a.ws;
    const bf16_t* Prow = (const bf16_t*)(ws + WS_P) + (size_t)m * NP;
    bf16_t* oa = (bf16_t*)(ws + WS_OA) + (size_t)m * 2048;
    const float* sq = (const float*)(ws + WS_SQA) + (size_t)m * 32;
    const bool prompt = m < MP;
    f32x4 sqv[8]; u32x4 ow[4], gw4[4];
    if (prompt) {
#pragma unroll
        for (int j = 0; j < 8; ++j) sqv[j] = ((const f32x4*)sq)[j];
#pragma unroll
        for (int hh = 0; hh < 4; ++hh) { ow[hh] = *(const u32x4*)(oa + hh * 512 + lane * 8); gw4[hh] = *(const u32x4*)(Prow + O_GA + hh * 512 + lane * 8); }
    }
    const bf16_t* ob = (const bf16_t*)(ws + WS_OB) + (size_t)m * D + lane * 16;
    f32x4 ov[4];
    { const u32x4 w0 = ((const u32x4*)ob)[0], w1 = ((const u32x4*)ob)[1];
      ov[0] = (f32x4){bflo(w0.x), bfhi(w0.x), bflo(w0.y), bfhi(w0.y)}; ov[1] = (f32x4){bflo(w0.z), bfhi(w0.z), bflo(w0.w), bfhi(w0.w)};
      ov[2] = (f32x4){bflo(w1.x), bfhi(w1.x), bflo(w1.y), bfhi(w1.y)}; ov[3] = (f32x4){bflo(w1.z), bfhi(w1.z), bflo(w1.w), bfhi(w1.w)}; }
    const float bc = ((const float*)(ws + WS_BC))[(size_t)m * 16 + (lane >> 2)];
    const bf16_t* cur = Prow + O_SH + 2048 + lane * 16;
    const bool hasp = (m >= MP) || (m & (T - 1));
    const bf16_t* prv = (m >= MP) ? cur + (size_t)MS * NP : cur - NP;
    u32x4 cw[2], pw[2] = {{0u, 0u, 0u, 0u}, {0u, 0u, 0u, 0u}}, gbw[2];
    cw[0] = ((const u32x4*)cur)[0]; cw[1] = ((const u32x4*)cur)[1];
    if (hasp) { pw[0] = ((const u32x4*)prv)[0]; pw[1] = ((const u32x4*)prv)[1]; }
    gbw[0] = ((const u32x4*)(Prow + O_GB + lane * 16))[0]; gbw[1] = ((const u32x4*)(Prow + O_GB + lane * 16))[1];
    f32x4 lw4[4], lb4[4], mu4[4];
#pragma unroll
    for (int j = 0; j < 4; ++j) { lw4[j] = ((const f32x4*)(a.in[I_LNW] + lane * 16))[j]; lb4[j] = ((const f32x4*)(a.in[I_LNB] + lane * 16))[j]; mu4[j] = ((const f32x4*)(a.in[I_MU] + 2048 + lane * 16))[j]; }
    if (prompt) {
#pragma unroll
        for (int hh = 0; hh < 4; ++hh) {
            const f32x4 s0 = sqv[2 * hh], s1 = sqv[2 * hh + 1];
            const float rs = 1.0f / sqrtf(((s0.x + s0.y) + (s0.z + s0.w) + (s1.x + s1.y) + (s1.z + s1.w)) * (1.f / 512.f) + EPS);
            const u32x4 o4 = ow[hh], g4 = gw4[hh];
            u32x4 r;
            r.x = pk2(bflo(o4.x) * rs * silu_(bflo(g4.x)), bfhi(o4.x) * rs * silu_(bfhi(g4.x))); r.y = pk2(bflo(o4.y) * rs * silu_(bflo(g4.y)), bfhi(o4.y) * rs * silu_(bfhi(g4.y)));
            r.z = pk2(bflo(o4.z) * rs * silu_(bflo(g4.z)), bfhi(o4.z) * rs * silu_(bfhi(g4.z))); r.w = pk2(bflo(o4.w) * rs * silu_(bflo(g4.w)), bfhi(o4.w) * rs * silu_(bfhi(g4.w)));
            *(u32x4*)(oa + hh * 512 + lane * 8) = r;
        }
    }
    float o[16], lw[16], lb[16], mu[16];
#pragma unroll
    for (int j = 0; j < 4; ++j) { o[4 * j] = ov[j].x; o[4 * j + 1] = ov[j].y; o[4 * j + 2] = ov[j].z; o[4 * j + 3] = ov[j].w;
        lw[4 * j] = lw4[j].x; lw[4 * j + 1] = lw4[j].y; lw[4 * j + 2] = lw4[j].z; lw[4 * j + 3] = lw4[j].w;
        lb[4 * j] = lb4[j].x; lb[4 * j + 1] = lb4[j].y; lb[4 * j + 2] = lb4[j].z; lb[4 * j + 3] = lb4[j].w;
        mu[4 * j] = mu4[j].x; mu[4 * j + 1] = mu4[j].y; mu[4 * j + 2] = mu4[j].z; mu[4 * j + 3] = mu4[j].w; }
    float s = 0.f;
#pragma unroll
    for (int j = 0; j < 16; ++j) s += o[j];
    s += __shfl_xor(s, 1); s += __shfl_xor(s, 2);
    const float mean = s * (1.f / 64.f);
    float q = 0.f;
#pragma unroll
    for (int j = 0; j < 16; ++j) { const float d = o[j] - mean; q += d * d; }
    q += __shfl_xor(q, 1); q += __shfl_xor(q, 2);
    const float rstd = 1.0f / sqrtf(q * (1.f / 64.f) + 64e-5f);
    const unsigned cws[8] = {cw[0].x, cw[0].y, cw[0].z, cw[0].w, cw[1].x, cw[1].y, cw[1].z, cw[1].w};
    const unsigned pws[8] = {pw[0].x, pw[0].y, pw[0].z, pw[0].w, pw[1].x, pw[1].y, pw[1].z, pw[1].w};
    const unsigned gws[8] = {gbw[0].x, gbw[0].y, gbw[0].z, gbw[0].w, gbw[1].x, gbw[1].y, gbw[1].z, gbw[1].w};
    unsigned outw[8];
#pragma unroll
    for (int j = 0; j < 8; ++j) {
        const float c0 = bflo(cws[j]), c1 = bfhi(cws[j]), p0 = bflo(pws[j]), p1 = bfhi(pws[j]);
        const float v0 = c0 + (p0 - c0) * mu[2 * j], v1 = c1 + (p1 - c1) * mu[2 * j + 1];
        const float y0 = ((o[2 * j] - mean) * rstd * lw[2 * j] + lb[2 * j] + bc * v0) * silu_(bflo(gws[j]));
        const float y1 = ((o[2 * j + 1] - mean) * rstd * lw[2 * j + 1] + lb[2 * j + 1] + bc * v1) * silu_(bfhi(gws[j]));
        outw[j] = pk2(y0, y1);
    }
    bf16_t* yb = (bf16_t*)(ws + WS_H) + (size_t)m * D + lane * 16;
    *(u32x4*)yb = (u32x4){outw[0], outw[1], outw[2], outw[3]}; *(u32x4*)(yb + 8) = (u32x4){outw[4], outw[5], outw[6], outw[7]};
}

struct EpiT1 {
    static constexpr bool PERM = false;
    const bf16_t* P; bf16_t* T1;
    __device__ __forceinline__ void operator()(const f32x4 (&acc)[2][2][4][2], const Unit& u, int wr, int wc, int fr, int fq) const {
        const int row0 = u.pm * 256 + wr * 64 + fr, col0 = u.pn * 256 + wc * 32 + 4 * fq;
#pragma unroll
        for (int ai = 0; ai < 2; ++ai)
#pragma unroll
            for (int m = 0; m < 4; ++m) { const int row = row0 + ai * 128 + m * 16; if (row >= MR) continue;
#pragma unroll
                for (int bj = 0; bj < 2; ++bj)
#pragma unroll
                    for (int n = 0; n < 2; ++n) { const int col = col0 + bj * 128 + n * 16;
                        const u32x2 gw = *(const u32x2*)(P + (size_t)row * NP + O_MA + col);
                        const f32x4 gt = {sigm(bflo(gw.x)), sigm(bfhi(gw.x)), sigm(bflo(gw.y)), sigm(bfhi(gw.y))};
                        const f32x4 t = acc[ai][bj][m][n] * gt; *(u32x2*)(T1 + (size_t)row * D + col) = (u32x2){pk2(t.x, t.y), pk2(t.z, t.w)}; } asm volatile("" ::: "memory"); }
    }
};
struct EpiMG {
    static constexpr bool PERM = false;
    const bf16_t* P; const bf16_t* T1; bf16_t* MG;
    __device__ __forceinline__ void operator()(const f32x4 (&acc)[2][2][4][2], const Unit& u, int wr, int wc, int fr, int fq) const {
        const int row0 = u.pm * 256 + wr * 64 + fr, col0 = u.pn * 256 + wc * 32 + 4 * fq;
#pragma unroll
        for (int ai = 0; ai < 2; ++ai)
#pragma unroll
            for (int m = 0; m < 4; ++m) { const int row = row0 + ai * 128 + m * 16; if (row >= MR) continue;
#pragma unroll
                for (int bj = 0; bj < 2; ++bj)
#pragma unroll
                    for (int n = 0; n < 2; ++n) { const int col = col0 + bj * 128 + n * 16;
                        const u32x2 gw = *(const u32x2*)(P + (size_t)row * NP + O_MB + col);
                        const f32x4 gt = {sigm(bflo(gw.x)), sigm(bfhi(gw.x)), sigm(bflo(gw.y)), sigm(bfhi(gw.y))};
                        const u32x2 tw = *(const u32x2*)(T1 + (size_t)row * D + col);
                        const f32x4 v = (f32x4){bflo(tw.x), bfhi(tw.x), bflo(tw.y), bfhi(tw.y)} + acc[ai][bj][m][n] * gt;
                        *(u32x2*)(MG + (size_t)row * D + col) = (u32x2){pk2(v.x, v.y), pk2(v.z, v.w)}; } asm volatile("" ::: "memory"); }
    }
};
struct EpiX1 {
    static constexpr bool PERM = false;
    const float* xp; const float* xs; float* X1; bf16_t* X1B; float* SQ;
    __device__ __forceinline__ void operator()(const f32x4 (&acc)[2][2][4][2], const Unit& u, int wr, int wc, int fr, int fq) const {
        const int row0 = u.pm * 256 + wr * 64 + fr, col0 = u.pn * 256 + wc * 32 + 4 * fq;
#pragma unroll
        for (int ai = 0; ai < 2; ++ai)
#pragma unroll
            for (int m = 0; m < 4; ++m) { const int row = row0 + ai * 128 + m * 16; const bool ok = row < MR;
                const float* xr = (row < MP) ? xp + (size_t)row * D : xs + (size_t)(row - MP) * D;
                float ss = 0.f;
                if (ok) {
#pragma unroll
                    for (int bj = 0; bj < 2; ++bj)
#pragma unroll
                        for (int n = 0; n < 2; ++n) { const int col = col0 + bj * 128 + n * 16;
                            const f32x4 v = *(const f32x4*)(xr + col) + acc[ai][bj][m][n];
                            ss += (v.x * v.x + v.y * v.y) + (v.z * v.z + v.w * v.w);
                            *(u32x2*)(X1B + (size_t)row * D + col) = (u32x2){pk2(v.x, v.y), pk2(v.z, v.w)}; }
                }
                ss += __shfl_xor(ss, 16); ss += __shfl_xor(ss, 32);
                if (ok && fq == 0) SQ[(size_t)row * 16 + u.pn * 4 + wc] = ss; asm volatile("" ::: "memory"); }
    }
};
struct EpiGT {
    static constexpr bool PERM = false;
    const float* SQ; bf16_t* GT;
    __device__ __forceinline__ void operator()(const f32x4 (&acc)[2][2][4][2], const Unit& u, int wr, int wc, int fr, int fq) const {
        const int row0 = u.pm * 256 + wr * 64 + fr, col0 = u.pn * 256 + wc * 32 + 4 * fq;
#pragma unroll
        for (int ai = 0; ai < 2; ++ai)
#pragma unroll
            for (int m = 0; m < 4; ++m) { const int row = row0 + ai * 128 + m * 16; if (row >= MR) continue;
                const f32x4* sp = (const f32x4*)(SQ + (size_t)row * 16); const f32x4 q0 = sp[0], q1 = sp[1], q2 = sp[2], q3 = sp[3];
                const float rs = 1.0f / sqrtf((((q0.x + q0.y) + (q0.z + q0.w)) + ((q1.x + q1.y) + (q1.z + q1.w)) + ((q2.x + q2.y) + (q2.z + q2.w)) + ((q3.x + q3.y) + (q3.z + q3.w))) * (1.f / D) + EPS);
#pragma unroll
                for (int bj = 0; bj < 2; ++bj)
#pragma unroll
                    for (int n = 0; n < 2; ++n) { const int col = col0 + bj * 128 + n * 16; const f32x4 t = acc[ai][bj][m][n] * rs;
                        *(u32x2*)(GT + (size_t)row * D + col) = (u32x2){pk2(sigm(t.x), sigm(t.y)), pk2(sigm(t.z), sigm(t.w))}; } asm volatile("" ::: "memory"); }
    }
};
struct EpiX2 {
    static constexpr bool PERM = false;
    const bf16_t* X1; const bf16_t* GT; float* out; float* SQ;
    __device__ __forceinline__ void operator()(const f32x4 (&acc)[2][2][4][2], const Unit& u, int wr, int wc, int fr, int fq) const {
        const int row0 = u.pm * 256 + wr * 64 + fr, col0 = u.pn * 256 + wc * 32 + 4 * fq;
#pragma unroll
        for (int ai = 0; ai < 2; ++ai)
#pragma unroll
            for (int m = 0; m < 4; ++m) { int row = row0 + ai * 128 + m * 16; asm volatile("" : "+v"(row)); const bool ok = row < MR;
                float ss = 0.f;
                if (ok) {
#pragma unroll
                    for (int bj = 0; bj < 2; ++bj)
#pragma unroll
                        for (int n = 0; n < 2; ++n) { const int col = col0 + bj * 128 + n * 16;
                            const u32x2 gw = *(const u32x2*)(GT + (size_t)row * D + col);
                            const u32x2 xw = *(const u32x2*)(X1 + (size_t)row * D + col);
                            const f32x4 v = (f32x4){bflo(xw.x), bfhi(xw.x), bflo(xw.y), bfhi(xw.y)} + acc[ai][bj][m][n] * (f32x4){bflo(gw.x), bfhi(gw.x), bflo(gw.y), bfhi(gw.y)};
                            ss += (v.x * v.x + v.y * v.y) + (v.z * v.z + v.w * v.w);
                            *(f32x4*)(out + (size_t)row * D + col) = v; asm volatile("" ::: "memory"); }
                }
                ss += __shfl_xor(ss, 16); ss += __shfl_xor(ss, 32);
                if (ok && fq == 0) SQ[(size_t)row * 16 + u.pn * 4 + wc] = ss; asm volatile("" ::: "memory"); }
    }
};


__device__ __forceinline__ f32x4 mini_acc(const bf16_t* A, int lda, const bf16_t* Bt, int K, int kq, int l15, int quad) {
    f32x4 acc = {0.f, 0.f, 0.f, 0.f};
    const int kn = K / 128;
    const bf16_t* ap = A + (size_t)l15 * lda + kq * (K / 4) + quad * 8;
    const bf16_t* bp = Bt + (size_t)l15 * K + kq * (K / 4) + quad * 8;
#pragma unroll 4
    for (int ks = 0; ks < kn; ++ks) acc = MFMA32(*(const bf16x8*)(ap + ks * 32), *(const bf16x8*)(bp + ks * 32), acc);
    return acc;
}
__device__ __forceinline__ f32x4 mini_reduce(LAS f32x4* red, int half, int lane) { return (red[(half * 4 + 0) * 64 + lane] + red[(half * 4 + 1) * 64 + lane]) + (red[(half * 4 + 2) * 64 + lane] + red[(half * 4 + 3) * 64 + lane]); }
template <int PH> __device__ __forceinline__ void mini_phase(const Args& a, LAS unsigned char* lds, int bx, int G, int wave, int lane) {
    unsigned char* ws = a.ws;
    const int l15 = lane & 15, quad = lane >> 4, half = wave >> 2, kq = wave & 3;
    LAS f32x4* red1 = (LAS f32x4*)lds; LAS f32x4* red2 = red1 + 8 * 64;
    const bf16_t* P = (const bf16_t*)(ws + WS_P);
    for (int tp = bx; tp < 256; tp += G) {
        const int tl = tp * 2 + half, mt = tl >> 6, nt = tl & 63, row0 = MP + mt * 16, col0 = nt * 16;
        f32x4 a1, a2 = {0.f, 0.f, 0.f, 0.f};
        if (PH == 0) { a1 = mini_acc((const bf16_t*)(ws + WS_OA) + (size_t)row0 * 2048, 2048, (const bf16_t*)(ws + WS_WDA) + (size_t)col0 * 2048, 2048, kq, l15, quad);
                       a2 = mini_acc((const bf16_t*)(ws + WS_H) + (size_t)row0 * D, D, (const bf16_t*)(ws + WS_WDB) + (size_t)col0 * D, D, kq, l15, quad); }
        if (PH == 1) { a1 = mini_acc((const bf16_t*)(ws + WS_MG) + (size_t)row0 * D, D, (const bf16_t*)(ws + WS_WOUT) + (size_t)col0 * D, D, kq, l15, quad); }
        if (PH == 2) { a1 = mini_acc((const bf16_t*)(ws + WS_X1B) + (size_t)row0 * D, D, (const bf16_t*)(ws + WS_WGATE) + (size_t)col0 * D, D, kq, l15, quad);
                       a2 = mini_acc((const bf16_t*)(ws + WS_PB) + (size_t)row0 * PLE, PLE, (const bf16_t*)(ws + WS_WPLE) + (size_t)col0 * PLE, PLE, kq, l15, quad); }
        red1[wave * 64 + lane] = a1; red2[wave * 64 + lane] = a2;
        __syncthreads();
        if (kq == 0) {
            a1 = mini_reduce(red1, half, lane); a2 = mini_reduce(red2, half, lane);
            const int col = col0 + l15;
            float rs1[4] = {0.f, 0.f, 0.f, 0.f};
            if (PH == 2) {
#pragma unroll
                for (int r = 0; r < 4; ++r) { const f32x4 q = *(const f32x4*)((const float*)(ws + WS_SQS1) + (size_t)(row0 - MP + quad * 4 + r) * 64 + l15 * 4); float t = (q.x + q.y) + (q.z + q.w);
#pragma unroll
                    for (int o = 1; o < 16; o <<= 1) t += __shfl_xor(t, o);
                    rs1[r] = 1.0f / sqrtf(t * (1.f / D) + EPS); }
            }
#pragma unroll
            for (int r = 0; r < 4; ++r) {
                const int row = row0 + quad * 4 + r;
                float ss = 0.f;
                if (PH == 0) { const float ga = sigm(bf2f(P[(size_t)row * NP + O_MA + col])), gb = sigm(bf2f(P[(size_t)row * NP + O_MB + col]));
                    ((bf16_t*)(ws + WS_MG))[(size_t)row * D + col] = f2bf(a1[r] * ga + a2[r] * gb); }
                if (PH == 1) { const float x1 = a.in[I_XS][(size_t)(row - MP) * D + col] + a1[r]; ss = x1 * x1;
                    ((bf16_t*)(ws + WS_X1B))[(size_t)row * D + col] = f2bf(x1); }
                if (PH == 2) { const float x2 = bf2f(((const bf16_t*)(ws + WS_X1B))[(size_t)row * D + col]) + a2[r] * sigm(rs1[r] * a1[r]); ss = x2 * x2;
                    a.out[OUT_Y + (size_t)row * D + col] = x2; }
                if (PH != 0) {
#pragma unroll
                    for (int o = 1; o < 16; o <<= 1) ss += __shfl_xor(ss, o);
                    if (l15 == 0) ((float*)(ws + (PH == 1 ? WS_SQS1 : WS_SQS2)))[(size_t)(row - MP) * 64 + nt] = ss;
                }
            }
        }
        __syncthreads();
    }
}

#define XB_TMO      128
#define XB_XCNT(j)  (256  + 64 * (j))
#define XB_XSUB(j)  (1280 + 64 * (j))
#define XB_XGEN(j)  (2304 + 64 * (j))
#define XB_TOP      3328
#define XB_TOPGEN   3392
#define XCD_BAR_WORDS 3456
#define XB_SPIN_CAP (1u << 22)
__device__ __forceinline__ unsigned xb_ld(unsigned* p)              { return __hip_atomic_load(p, __ATOMIC_RELAXED, __HIP_MEMORY_SCOPE_AGENT); }
__device__ __forceinline__ unsigned xb_add(unsigned* p, unsigned v) { return __hip_atomic_fetch_add(p, v, __ATOMIC_RELAXED, __HIP_MEMORY_SCOPE_AGENT); }
__device__ __forceinline__ unsigned xb_xcc_id() { return (unsigned)__builtin_amdgcn_s_getreg((3 << 11) | 20) & 0xFu; }
#define XB_SPIN(cond, bar) do { unsigned _sp = 0; while (cond) { __builtin_amdgcn_s_sleep(1); \
    if ((++_sp & 255u) == 0u) { if (xb_ld(&(bar)[XB_TMO])) break; if (_sp > XB_SPIN_CAP) { atomicAdd(&(bar)[XB_TMO], 1u); break; } } } } while (0)
struct XcdBarrier { unsigned* bar; unsigned x; volatile LAS unsigned* st; };
__device__ __forceinline__ XcdBarrier xcd_barrier_post(unsigned* bar, volatile LAS unsigned* st) {
    XcdBarrier b; b.bar = bar; b.x = xb_xcc_id(); b.st = st;
    if (threadIdx.x == 0) (void)xb_add(&bar[XB_XCNT(b.x)], 1u);
    return b;
}
__device__ __forceinline__ void xcd_barrier_complete(unsigned* bar, unsigned x, unsigned& nloc, unsigned& nx) {
    const unsigned G = gridDim.x * gridDim.y * gridDim.z;
    unsigned sum, cnt, mine, sp = 0u;
    for (;;) {
        sum = 0u; cnt = 0u; mine = 0u;
#pragma unroll
        for (unsigned j = 0; j < 16; ++j) { const unsigned c = xb_ld(&bar[XB_XCNT(j)]); sum += c; cnt += (c > 0u) ? 1u : 0u; mine = (j == x) ? c : mine; }
        if (sum == G) break;
        __builtin_amdgcn_s_sleep(1);
        if ((++sp & 255u) == 0u) { if (xb_ld(&bar[XB_TMO])) break; if (sp > XB_SPIN_CAP) { atomicAdd(&bar[XB_TMO], 1u); break; } }
    }
    nloc = mine > 0u ? mine : 1u; nx = cnt > 0u ? cnt : 1u;
}
__device__ __forceinline__ void xcd_barrier(const XcdBarrier& b) {
    asm volatile("s_waitcnt vmcnt(0)" ::: "memory");
    __syncthreads();
    if (threadIdx.x == 0) {
        unsigned* bar = b.bar;
        __builtin_amdgcn_s_waitcnt(0);
        unsigned nloc = b.st[0], nx = b.st[1];
        if (nloc == 0u) { xcd_barrier_complete(bar, b.x, nloc, nx); b.st[0] = nloc; b.st[1] = nx; }
        const unsigned old = xb_add(&bar[XB_XSUB(b.x)], 1u);
        const unsigned gen = old / nloc;
        if (old + 1u == (gen + 1u) * nloc) {
            __builtin_amdgcn_fence(__ATOMIC_RELEASE, "agent");
            asm volatile("s_waitcnt vmcnt(0)" ::: "memory");
            const unsigned og = xb_add(&bar[XB_TOP], 1u);
            const unsigned tg = og / nx;
            if (og + 1u == (tg + 1u) * nx) xb_add(&bar[XB_TOPGEN], 1u);
            else XB_SPIN(xb_ld(&bar[XB_TOPGEN]) == tg, bar);
            __builtin_amdgcn_fence(__ATOMIC_ACQUIRE, "agent");
            xb_add(&bar[XB_XGEN(b.x)], 1u);
            asm volatile("s_waitcnt vmcnt(0)" ::: "memory");
        } else {
            XB_SPIN(xb_ld(&bar[XB_XGEN(b.x)]) == gen, bar);
            __builtin_amdgcn_fence(__ATOMIC_ACQUIRE, "agent");
            asm volatile("s_waitcnt vmcnt(0)" ::: "memory");
        }
    }
    __syncthreads();
}

constexpr int LDS_BYTES = 147456;
constexpr int CTL_SQ1 = 0, CTL_SQ2 = 32768, CTL_CNT = 65536;

#define GRID_SYNC() xcd_barrier(xbar)
__global__ void __launch_bounds__(512, 2) fwd_mega(Args a) {
    extern __shared__ __attribute__((aligned(16))) unsigned char lds_raw[];
    LAS unsigned char* lds = (LAS unsigned char*)lds_raw;
    cg::grid_group grid = cg::this_grid();
    const int tid = threadIdx.x, lane = tid & 63, wave = __builtin_amdgcn_readfirstlane(tid >> 6);
    const int G = gridDim.x, bx = blockIdx.x;
    const int gw = bx * 8 + wave, NGW = G * 8;
    unsigned char* ws = a.ws;
    if (tid < 16) ((LAS unsigned*)(lds + 131072 + 64))[tid] = 0u;
    __syncthreads();
    XcdBarrier xbar = xcd_barrier_post((unsigned*)(ws + WS_BAR), (volatile LAS unsigned*)(lds + 131072 + 64));
    if (gridDim.x == 0x7fffffffu) grid.sync();

#if !defined(ONLY_PH) || ONLY_PH == 0
    phase0(a, lds, gw, NGW, wave, lane);
    GRID_SYNC();
#endif
#if !defined(ONLY_PH) || ONLY_PH == 1
    {
        pg8::Gemm g{(const bf16_t*)(ws + WS_H), (const bf16_t*)(ws + WS_WIN), MALL, NP, D}; pg8::StaticOrder S; S.init(MALL, NP, G, bx);
        EpiP E{(bf16_t*)(ws + WS_P), (bf16_t*)(ws + WS_KT), (const f32x2*)(ws + WS_ROPE)};
        pg8::gemm_phase<EpiP>(lds, g, S, E);
    }
    GRID_SYNC();
#endif
#if !defined(ONLY_PH) || ONLY_PH == 2
    for (int it = gw; it < 1032 * 16; it += NGW) rw_prep_item(a, lds + wave * 10240, it >> 4, it & 15, lane);
    GRID_SYNC();
#endif
#if !defined(ONLY_PH) || ONLY_PH == 3
    {
        if (G < 128) for (int u = gw; u < MS * 16; u += NGW) rw_sample_wave(a, u >> 4, u & 15, lane);
        if (bx < 128) { if (wave < 4) rw_scan_task(a, lds + wave * 4096, bx >> 4, bx & 15, wave, lane); else if (G >= 128) { const int u = bx * 4 + (wave - 4); ret_sample_wave(a, u >> 2, u & 3, lane); }
            if (G >= 128) { for (int u = bx * 8 + wave; u < MS * 16; u += 1024) rw_sample_wave(a, u >> 4, u & 15, lane);
                p0_late(a, (LAS float*)(lds + 16384 + wave * 14336), bx * 8 + wave, 1024, lane);
                for (int m = bx * 8 + wave; m < MALL; m += 1024) p_row_bf16(a, m, lane); }
        }
        __syncthreads();
        {
            unsigned* cnt2 = (unsigned*)(ws + WS_CTL) + CTL_CNT + 32;
            LAS unsigned* lu = (LAS unsigned*)(lds + 131072);
            for (;;) {
                if (tid == 0) *lu = atomicAdd(cnt2, 1u);
                __syncthreads();
                const unsigned unit = *lu;
                __syncthreads();
                if (unit >= (unsigned)(MS * 4) || G >= 128) break;
                ret_sample_unit(a, lds, (int)(unit >> 2), (int)(unit & 3), tid);
            }
        }
        if (G == 256) {
            if (bx >= 128) {
                const int x = bx & 7, j = (bx - 128) >> 3;
                for (int r = 0; r < 2; ++r) { const int k = r * 16 + j, g = (k >> 3) * 8 + x; ret_unit(a, lds, g * 8 + (k & 7), tid); }
            }
        } else {
            unsigned* cnt = (unsigned*)(ws + WS_CTL) + CTL_CNT;
            LAS unsigned* lu = (LAS unsigned*)(lds + 131072);
            for (;;) {
                if (tid == 0) *lu = atomicAdd(cnt, 1u);
                __syncthreads();
                const unsigned unit = *lu;
                __syncthreads();
                if (unit >= 256u) break;
                ret_unit(a, lds, (int)unit, tid);
            }
        }
    }
    GRID_SYNC();
#endif
#if !defined(ONLY_PH) || ONLY_PH == 4
    for (int m = gw; m < MR; m += NGW) phase25_row(a, m, lane);
    GRID_SYNC();
#endif
#if !defined(ONLY_PH) || ONLY_PH == 5
    {
        mini_phase<0>(a, lds, bx, G, wave, lane);
        pg8::StaticOrder S; S.init(MP, D, G, bx);
        { pg8::Gemm g{(const bf16_t*)(ws + WS_OA), (const bf16_t*)(ws + WS_WDA), MP, D, 2048}; EpiT1 E{(const bf16_t*)(ws + WS_P), (bf16_t*)(ws + WS_T1)}; pg8::gemm_phase<EpiT1>(lds, g, S, E); }
        { pg8::Gemm g{(const bf16_t*)(ws + WS_H), (const bf16_t*)(ws + WS_WDB), MP, D, D}; EpiMG E{(const bf16_t*)(ws + WS_P), (const bf16_t*)(ws + WS_T1), (bf16_t*)(ws + WS_MG)}; pg8::gemm_phase<EpiMG>(lds, g, S, E); }
    }
    GRID_SYNC();
#endif
#if !defined(ONLY_PH) || ONLY_PH == 6
    {
        mini_phase<1>(a, lds, bx, G, wave, lane);
        pg8::StaticOrder S; S.init(MP, D, G, bx);
        pg8::Gemm g{(const bf16_t*)(ws + WS_MG), (const bf16_t*)(ws + WS_WOUT), MP, D, D};
        EpiX1 E{a.in[I_XP], a.in[I_XS], (float*)(ws + WS_X1), (bf16_t*)(ws + WS_X1B), (float*)(ws + WS_SQ1P)};
        pg8::gemm_phase<EpiX1>(lds, g, S, E);
    }
    GRID_SYNC();
#endif
#if !defined(ONLY_PH) || ONLY_PH == 7
    {
        mini_phase<2>(a, lds, bx, G, wave, lane);
        pg8::StaticOrder S; S.init(MP, D, G, bx);
        { pg8::Gemm g{(const bf16_t*)(ws + WS_X1B), (const bf16_t*)(ws + WS_WGATE), MP, D, D}; EpiGT E{(const float*)(ws + WS_SQ1P), (bf16_t*)(ws + WS_GT)}; pg8::gemm_phase<EpiGT>(lds, g, S, E); }
        { pg8::Gemm g{(const bf16_t*)(ws + WS_PB), (const bf16_t*)(ws + WS_WPLE), MP, D, PLE}; EpiX2 E{(const bf16_t*)(ws + WS_X1B), (const bf16_t*)(ws + WS_GT), a.out + OUT_Y, (float*)(ws + WS_SQ2P)}; pg8::gemm_phase<EpiX2>(lds, g, S, E); }
    }
    GRID_SYNC();
#endif
#if !defined(ONLY_PH) || ONLY_PH == 8
    {
        const float* sq2 = (const float*)(ws + WS_SQ2P); const float* fg = a.in[I_FNG];
        for (int m0 = gw; m0 < MR; m0 += 2 * NGW) {
            const int m1 = m0 + NGW; const bool two = m1 < MR;
            float tot[2]; f32x4 xv[2][4];
#pragma unroll
            for (int e = 0; e < 2; ++e) {
                const int m = e ? m1 : m0;
                if (e == 0 || two) {
                    if (m < MP) { const f32x4* sp = (const f32x4*)(sq2 + (size_t)m * 16); const f32x4 q0 = sp[0], q1 = sp[1], q2 = sp[2], q3 = sp[3];
                        tot[e] = (((q0.x + q0.y) + (q0.z + q0.w)) + ((q1.x + q1.y) + (q1.z + q1.w)) + ((q2.x + q2.y) + (q2.z + q2.w)) + ((q3.x + q3.y) + (q3.z + q3.w))); }
                    else tot[e] = wave_sum(((const float*)(ws + WS_SQS2))[(size_t)(m - MP) * 64 + lane]);
                    const f32x4* o = (const f32x4*)(a.out + OUT_Y + (size_t)m * D);
#pragma unroll
                    for (int j = 0; j < 4; ++j) xv[e][j] = o[lane + 64 * j];
                }
            }
#pragma unroll
            for (int e = 0; e < 2; ++e) {
                const int m = e ? m1 : m0;
                if (e == 0 || two) {
                    const float rs = 1.0f / sqrtf(tot[e] * (1.f / D) + EPS);
                    f32x4* o = (f32x4*)(a.out + OUT_Y + (size_t)m * D);
#pragma unroll
                    for (int j = 0; j < 4; ++j) o[lane + 64 * j] = xv[e][j] * rs * ((const f32x4*)fg)[lane + 64 * j];
                }
            }
        }
    }
#endif

}

extern "C" void kernel_launch(void* const* d_in, const int* in_sizes, int n_in, void* d_out, int out_size, void* d_ws, size_t ws_size, hipStream_t stream) {
    static int grid = 0;
    if (grid == 0) {
        if (n_in != 26 || ws_size < WS_END) { fprintf(stderr, "kernel_launch: unexpected n_in %d or ws_size %zu (need %zu)\n", n_in, ws_size, (size_t)WS_END); grid = -1; return; }
        int dev = 0, cus = 0, per_cu = 0;
        hipGetDevice(&dev); hipDeviceGetAttribute(&cus, hipDeviceAttributeMultiprocessorCount, dev);
        if (hipFuncSetAttribute((const void*)fwd_mega, hipFuncAttributeMaxDynamicSharedMemorySize, LDS_BYTES) != hipSuccess) { fprintf(stderr, "kernel_launch: hipFuncSetAttribute failed\n"); grid = -1; return; }
        hipOccupancyMaxActiveBlocksPerMultiprocessor(&per_cu, (const void*)fwd_mega, 512, LDS_BYTES);
        if (per_cu < 1) { fprintf(stderr, "kernel_launch: occupancy query says %d blocks per CU\n", per_cu); per_cu = 1; }
        (void)hipGetLastError();
        grid = cus * 1;
        fprintf(stderr, "kernel_launch: grid %d (cus %d, per_cu %d), ws %zu\n", grid, cus, per_cu, ws_size);
    }
    if (grid < 0) return;
    Args a{};
    for (int i = 0; i < 26; ++i) a.in[i] = (const float*)d_in[i];
    a.out = (float*)d_out; a.ws = (unsigned char*)d_ws;
    if (hipMemsetAsync((char*)d_ws + WS_BAR, 0, XCD_BAR_WORDS * 4, stream) != hipSuccess) { fprintf(stderr, "kernel_launch: memset failed\n"); return; }
    void* args[] = {&a};
    hipError_t e = hipLaunchCooperativeKernel((const void*)fwd_mega, dim3(grid), dim3(512), args, LDS_BYTES, stream);
    if (e != hipSuccess) fprintf(stderr, "kernel_launch: cooperative launch failed: %s\n", hipGetErrorString(e));
}
```
